# Optimizing an MI355X kernel written in HIP

```python
import math
import jax, jax.numpy as jnp
from jax import lax
import numpy as np

D_MODEL = 1024
BATCH = 32
SEQ = 2048
DEPTH = 2

N_EVEN = (DEPTH + 1) // 2
N_ODD = DEPTH // 2
CHUNK = 64
CONV_K = 4
LN_EPS = 1e-5
NORM_EPS = 1e-6
RET_H = 4
RET_DK = D_MODEL // 8
RET_DV = D_MODEL // 4
ROPE_BASE = 10000.0
ML_H = 4
ML_DK = D_MODEL // 8
ML_DV = D_MODEL // 4
GLA_H = 4
GLA_DK = D_MODEL // 8
GLA_DV = D_MODEL // 4
GLA_RANK = 16
GLA_TAU = 16.0
SSD_HEADDIM = 64
SSD_DINNER = D_MODEL
SSD_H = SSD_DINNER // SSD_HEADDIM
SSD_GROUPS = 4
SSD_HPG = SSD_H // SSD_GROUPS
SSD_N = 128
N_EXPERTS = 16
N_EXPERT_GROUPS = 4
EXPERTS_PER_GROUP = N_EXPERTS // N_EXPERT_GROUPS
TOP_K = 2
GROUP_SCORE_TOPK = 2
D_FF = D_MODEL // 2
DEEPNORM_ALPHA = (2.0 * DEPTH) ** 0.25
DEEPNORM_BETA = (8.0 * DEPTH) ** -0.25
RET_SPLITS = (RET_H * RET_DK, RET_H * RET_DK, RET_H * RET_DV, RET_H * RET_DV)
ML_SPLITS = (ML_H * ML_DK, ML_H * ML_DK, ML_H * ML_DV, ML_H * ML_DV, ML_H, ML_H)
P_AB = sum(RET_SPLITS) + sum(ML_SPLITS)
MIX_AB = RET_H * RET_DV + ML_H * ML_DV
GLA_SPLITS = (GLA_H * GLA_DK, GLA_H * GLA_DK, GLA_H * GLA_DV, GLA_H * GLA_DV, GLA_RANK)
SSD_SPLITS = (SSD_DINNER, SSD_DINNER + 2 * SSD_GROUPS * SSD_N, SSD_H)
P_CD = sum(GLA_SPLITS) + sum(SSD_SPLITS)
MIX_CD = GLA_H * GLA_DV + SSD_DINNER

kernel_name = 'hybrid_retention_mlstm_gla_ssd_grouped_moe_deepnorm'


def _split(t, sizes):
    return jnp.split(t, np.cumsum(sizes)[:-1].tolist(), axis=-1)


def _heads(t, h):
    b, s, hd = t.shape
    return t.reshape(b, s, h, hd // h).transpose(0, 2, 1, 3)


def _chunks(t):
    b, h, s = t.shape[:3]
    return jnp.moveaxis(t.reshape(b, h, s // CHUNK, CHUNK, *t.shape[3:]), 2, 0)


def _unchunk(t):
    nc, b, h, c, d = t.shape
    return t.transpose(1, 0, 3, 2, 4).reshape(b, nc * c, h * d)


def _seq_chunks(t):
    b, s = t.shape[:2]
    return jnp.moveaxis(t.reshape(b, s // CHUNK, CHUNK, *t.shape[2:]), 1, 0)


def _layernorm(x, g, b):
    xf = x.astype(jnp.float32)
    mu = xf.mean(-1, keepdims=True)
    var = jnp.square(xf - mu).mean(-1, keepdims=True)
    return ((xf - mu) * lax.rsqrt(var + LN_EPS) * g.astype(jnp.float32) + b.astype(jnp.float32)).astype(x.dtype)


def _head_norm(y, n_groups, g, center):
    b, s, w = y.shape
    yf = y.astype(jnp.float32).reshape(b, s, n_groups, w // n_groups)
    if center:
        yf = yf - yf.mean(-1, keepdims=True)
    yf = yf * lax.rsqrt(jnp.square(yf).mean(-1, keepdims=True) + NORM_EPS)
    return yf.reshape(b, s, w) * g.astype(jnp.float32)


def _causal_conv(u, w, bias):
    ch = u.shape[-1]
    out = lax.conv_general_dilated(u, w[:, None, :].astype(u.dtype), window_strides=(1,),
                                   padding=[(CONV_K - 1, 0)], dimension_numbers=('NWC', 'WIO', 'NWC'),
                                   feature_group_count=ch)
    return out + bias


def _rotary(t, pos):
    d = t.shape[-1]
    inv_freq = ROPE_BASE ** (-jnp.arange(0, d, 2, dtype=jnp.float32) / d)
    ang = pos.astype(jnp.float32)[:, None, :, None] * inv_freq
    cos, sin = jnp.cos(ang), jnp.sin(ang)
    t1, t2 = t[..., 0::2], t[..., 1::2]
    return jnp.stack([t1 * cos - t2 * sin, t1 * sin + t2 * cos], axis=-1).reshape(t.shape)


def _retention(q, k, v):
    b, h, s, dk = q.shape
    dv = v.shape[-1]
    log_g = jnp.log(1.0 - 2.0 ** (-5.0 - jnp.arange(h, dtype=jnp.float32)))
    idx = jnp.arange(CHUNK, dtype=jnp.float32)
    diff = idx[:, None] - idx[None, :]
    mask = diff >= 0
    decay_intra = jnp.where(mask, jnp.exp(log_g[:, None, None] * jnp.where(mask, diff, 0.0)), 0.0)
    q_decay = jnp.exp(log_g[:, None] * (idx + 1.0))[..., None]
    k_decay = jnp.exp(log_g[:, None] * (CHUNK - 1.0 - idx))[..., None]
    chunk_decay = jnp.exp(log_g * CHUNK)[:, None, None]

    def step(state, inp):
        qi, ki, vi = inp
        scores = jnp.einsum('bhtd,bhsd->bhts', qi, ki) * decay_intra
        y = jnp.einsum('bhts,bhsv->bhtv', scores, vi) + jnp.einsum('bhtd,bhdv->bhtv', qi * q_decay, state)
        state = chunk_decay * state + jnp.einsum('bhsd,bhsv->bhdv', ki * k_decay, vi)
        return state, y

    state0 = jnp.zeros((b, h, dk, dv), jnp.float32)
    _, y = lax.scan(step, state0, (_chunks(q), _chunks(k), _chunks(v)))
    return _unchunk(y)


def _mlstm(q, k, v, i_pre, logf):
    b, h, s, dk = q.shape
    dv = v.shape[-1]
    causal = jnp.tril(jnp.ones((CHUNK, CHUNK), bool))

    def step(carry, inp):
        c_st, n_st, m_st = carry
        qi, ki, vi, ii, fi = inp
        bcum = jnp.cumsum(fi, axis=-1)
        a = bcum + m_st[..., None]
        d = jnp.where(causal, bcum[..., :, None] - bcum[..., None, :] + ii[..., None, :], -jnp.inf)
        m_t = jnp.maximum(a, d.max(-1))
        w_inter = jnp.exp(a - m_t)
        qk = jnp.einsum('bhtd,bhsd->bhts', qi, ki) * jnp.exp(d - m_t[..., None])
        num = jnp.einsum('bhts,bhsv->bhtv', qk, vi) + w_inter[..., None] * jnp.einsum('bhtd,bhdv->bhtv', qi, c_st)
        den = qk.sum(-1) + w_inter * jnp.einsum('bhtd,bhd->bht', qi, n_st)
        h_t = num / jnp.maximum(jnp.abs(den), jnp.exp(-m_t))[..., None]
        b_tot = bcum[..., -1]
        log_ws = b_tot[..., None] - bcum + ii
        m_new = jnp.maximum(b_tot + m_st, log_ws.max(-1))
        ks = ki * jnp.exp(log_ws - m_new[..., None])[..., None]
        decay = jnp.exp(b_tot + m_st - m_new)
        c_new = decay[..., None, None] * c_st + jnp.einsum('bhsd,bhsv->bhdv', ks, vi)
        n_new = decay[..., None] * n_st + ks.sum(-2)
        return (c_new, n_new, m_new), h_t

    carry0 = (jnp.zeros((b, h, dk, dv), jnp.float32), jnp.zeros((b, h, dk), jnp.float32),
              jnp.zeros((b, h), jnp.float32))
    _, y = lax.scan(step, carry0, (_chunks(q), _chunks(k), _chunks(v), _chunks(i_pre), _chunks(logf)))
    return _unchunk(y)


def _gla(q, k, v, log_alpha):
    b, h, s, dk = q.shape
    dv = v.shape[-1]
    causal = jnp.tril(jnp.ones((CHUNK, CHUNK), bool))[:, :, None]

    def step(state, inp):
        qi, ki, vi, gi = inp
        bcum = jnp.cumsum(gi, axis=-2)
        rel = jnp.where(causal, bcum[..., :, None, :] - bcum[..., None, :, :], -jnp.inf)
        scores = jnp.einsum('bhtd,bhsd,bhtsd->bhts', qi, ki, jnp.exp(rel))
        y = jnp.einsum('bhts,bhsv->bhtv', scores, vi) + jnp.einsum('bhtd,bhdv->bhtv', qi * jnp.exp(bcum), state)
        b_tot = bcum[..., -1:, :]
        state = jnp.exp(b_tot)[..., 0, :, None] * state + jnp.einsum('bhsd,bhsv->bhdv', ki * jnp.exp(b_tot - bcum), vi)
        return state, y

    state0 = jnp.zeros((b, h, dk, dv), jnp.float32)
    _, y = lax.scan(step, state0, (_chunks(q), _chunks(k), _chunks(v), _chunks(log_alpha)))
    return _unchunk(y)


def _ssd(xdt, log_a, bm, cm):
    b, s, g, r, p = xdt.shape
    n = bm.shape[-1]
    causal = jnp.tril(jnp.ones((CHUNK, CHUNK), bool))[None, :, :, None, None]

    def step(state, inp):
        xi, lai, bi, ci = inp
        cum = jnp.cumsum(lai, axis=1)
        seg = jnp.where(causal, cum[:, :, None] - cum[:, None, :], -jnp.inf)
        w = jnp.einsum('btgn,bsgn->btsg', ci, bi)[..., None] * jnp.exp(seg)
        y = jnp.einsum('btsgr,bsgrp->btgrp', w, xi) + jnp.exp(cum)[..., None] * jnp.einsum('btgn,bgrnp->btgrp', ci, state)
        last = cum[:, -1]
        xs = xi * jnp.exp(last[:, None] - cum)[..., None]
        state = jnp.exp(last)[..., None, None] * state + jnp.einsum('bsgn,bsgrp->bgrnp', bi, xs)
        return state, y

    state0 = jnp.zeros((b, g, r, n, p), jnp.float32)
    _, y = lax.scan(step, state0, (_seq_chunks(xdt), _seq_chunks(log_a), _seq_chunks(bm), _seq_chunks(cm)))
    return jnp.moveaxis(y, 0, 1).reshape(b, s, g * r, p)


def _mixer_ab(x, pos, w_in, ret_norm_g, ml_conv_w, ml_conv_b, ml_b_i, ml_b_f, ml_norm_g, w_out):
    f32 = jnp.float32
    proj = x @ w_in
    rq, rk, rv, rg, mq, mk, mv, mo, mi, mf = _split(proj, RET_SPLITS + ML_SPLITS)
    q = _rotary(_heads(rq, RET_H).astype(f32), pos)
    k = _rotary(_heads(rk, RET_H).astype(f32), pos) * RET_DK ** -0.5
    v = _heads(rv, RET_H).astype(f32)
    y_ret = _head_norm(_retention(q, k, v), RET_H, ret_norm_g, True) * jax.nn.silu(rg.astype(f32))
    qk = jax.nn.silu(_causal_conv(jnp.concatenate([mq, mk], axis=-1), ml_conv_w, ml_conv_b))
    cq, ck = jnp.split(qk, 2, axis=-1)
    q = _heads(cq, ML_H).astype(f32)
    k = _heads(ck, ML_H).astype(f32) * ML_DK ** -0.5
    v = _heads(mv, ML_H).astype(f32)
    i_pre = (mi + ml_b_i).astype(f32).transpose(0, 2, 1)
    logf = jax.nn.log_sigmoid((mf + ml_b_f).astype(f32)).transpose(0, 2, 1)
    h = _mlstm(q, k, v, i_pre, logf) * jax.nn.sigmoid(mo.astype(f32))
    y_ml = _head_norm(h, ML_H, ml_norm_g, True)
    y = jnp.concatenate([y_ret, y_ml], axis=-1).astype(x.dtype)
    return y @ w_out


def _mixer_cd(x, w_in, gla_w_alpha, gla_b_alpha, gla_norm_g, ssd_conv_w, ssd_conv_b, ssd_dt_bias, ssd_a_log,
              ssd_d, ssd_norm_g, w_out):
    f32 = jnp.float32
    b, s, _ = x.shape
    proj = x @ w_in
    gq, gk, gv, gr, ga, sz, sxbc, sdt = _split(proj, GLA_SPLITS + SSD_SPLITS)
    log_alpha = jax.nn.log_sigmoid((ga @ gla_w_alpha + gla_b_alpha).astype(f32)) / GLA_TAU
    q = _heads(gq, GLA_H).astype(f32) * GLA_DK ** -0.5
    k = _heads(gk, GLA_H).astype(f32)
    v = _heads(gv, GLA_H).astype(f32)
    y_gla = _head_norm(_gla(q, k, v, _heads(log_alpha, GLA_H)), GLA_H, gla_norm_g, False) * jax.nn.silu(gr.astype(f32))
    xbc = jax.nn.silu(_causal_conv(sxbc, ssd_conv_w, ssd_conv_b)).astype(f32)
    xs, bm, cm = _split(xbc, (SSD_DINNER, SSD_GROUPS * SSD_N, SSD_GROUPS * SSD_N))
    dt = jax.nn.softplus((sdt + ssd_dt_bias).astype(f32))
    a = -jnp.exp(ssd_a_log.astype(f32))
    xs_h = xs.reshape(b, s, SSD_H, SSD_HEADDIM)
    y = _ssd((xs_h * dt[..., None]).reshape(b, s, SSD_GROUPS, SSD_HPG, SSD_HEADDIM),
             (dt * a).reshape(b, s, SSD_GROUPS, SSD_HPG),
             bm.reshape(b, s, SSD_GROUPS, SSD_N), cm.reshape(b, s, SSD_GROUPS, SSD_N))
    y = (y + ssd_d.astype(f32)[:, None] * xs_h).reshape(b, s, SSD_DINNER) * jax.nn.silu(sz.astype(f32))
    y_ssd = _head_norm(y, SSD_GROUPS, ssd_norm_g, False)
    out = jnp.concatenate([y_gla, y_ssd], axis=-1).astype(x.dtype)
    return out @ w_out


def _moe(x, w_router, b_router, w_gate, w_up, w_down):
    b, s, d = x.shape
    xt = x.reshape(b * s, d)
    probs = jax.nn.softmax((xt @ w_router).astype(jnp.float32), axis=-1)
    sel = probs + b_router.astype(jnp.float32)
    grp_score = lax.top_k(sel.reshape(-1, N_EXPERT_GROUPS, EXPERTS_PER_GROUP), GROUP_SCORE_TOPK)[0].sum(-1)
    g_best = jnp.argmax(grp_score, axis=-1)
    in_group = (jnp.arange(N_EXPERTS) // EXPERTS_PER_GROUP)[None, :] == g_best[:, None]
    _, e_idx = lax.top_k(jnp.where(in_group, sel, -jnp.inf), TOP_K)
    gate = jnp.take_along_axis(probs, e_idx, axis=-1)
    gate = gate / gate.sum(-1, keepdims=True)
    combine = jnp.einsum('tk,tke->te', gate, jax.nn.one_hot(e_idx, N_EXPERTS, dtype=jnp.float32))
    y = jnp.zeros((b * s, d), jnp.float32)
    for e in range(N_EXPERTS):
        h = jax.nn.silu(xt @ w_gate[e]) * (xt @ w_up[e])
        y = y + combine[:, e:e + 1] * (h @ w_down[e]).astype(jnp.float32)
    return y.astype(x.dtype).reshape(b, s, d)


def setup_inputs(seed: int = 0) -> dict:
    key = jax.random.key(seed)
    ks = iter(jax.random.split(key, 40))
    f32 = jnp.float32

    def nrm(shape, scale):
        return scale * jax.random.normal(next(ks), shape, f32)

    def gain(shape):
        return 1.0 + nrm(shape, 0.02)

    x = jax.random.normal(next(ks), (BATCH, SEQ, D_MODEL), f32)
    offset = jax.random.randint(next(ks), (BATCH, 1), 0, 4096, dtype=jnp.int32)
    positions = (offset + jnp.arange(SEQ, dtype=jnp.int32)[None, :]).astype(jnp.int32)
    dt0 = jnp.exp(jax.random.uniform(next(ks), (N_ODD, SSD_H), f32, math.log(1e-3), math.log(1e-1)))
    return {
        'x': x,
        'positions': positions,
        'w_in_ab': nrm((N_EVEN, D_MODEL, P_AB), D_MODEL ** -0.5),
        'ret_norm_g': gain((N_EVEN, RET_H * RET_DV)),
        'ml_conv_w': nrm((N_EVEN, CONV_K, 2 * ML_H * ML_DK), CONV_K ** -0.5),
        'ml_conv_b': nrm((N_EVEN, 2 * ML_H * ML_DK), 0.02),
        'ml_b_i': nrm((N_EVEN, ML_H), 0.1),
        'ml_b_f': jnp.linspace(3.0, 6.0, ML_H, dtype=f32)[None, :] + nrm((N_EVEN, ML_H), 0.02),
        'ml_norm_g': gain((N_EVEN, ML_H * ML_DV)),
        'w_out_ab': nrm((N_EVEN, MIX_AB, D_MODEL), DEEPNORM_BETA * MIX_AB ** -0.5),
        'w_in_cd': nrm((N_ODD, D_MODEL, P_CD), D_MODEL ** -0.5),
        'gla_w_alpha': nrm((N_ODD, GLA_RANK, GLA_H * GLA_DK), GLA_RANK ** -0.5),
        'gla_b_alpha': nrm((N_ODD, GLA_H * GLA_DK), 0.02),
        'gla_norm_g': gain((N_ODD, GLA_H * GLA_DV)),
        'ssd_conv_w': nrm((N_ODD, CONV_K, SSD_DINNER + 2 * SSD_GROUPS * SSD_N), CONV_K ** -0.5),
        'ssd_conv_b': nrm((N_ODD, SSD_DINNER + 2 * SSD_GROUPS * SSD_N), 0.02),
        'ssd_dt_bias': dt0 + jnp.log(-jnp.expm1(-dt0)),
        'ssd_a_log': jnp.log(jax.random.uniform(next(ks), (N_ODD, SSD_H), f32, 1.0, 16.0)),
        'ssd_d': gain((N_ODD, SSD_H)),
        'ssd_norm_g': gain((N_ODD, SSD_DINNER)),
        'w_out_cd': nrm((N_ODD, MIX_CD, D_MODEL), DEEPNORM_BETA * MIX_CD ** -0.5),
        'w_router': nrm((D_MODEL, N_EXPERTS), D_MODEL ** -0.5),
        'b_router': nrm((N_EXPERTS,), 0.01),
        'moe_w_gate': nrm((DEPTH, N_EXPERTS, D_MODEL, D_FF), D_MODEL ** -0.5),
        'moe_w_up': nrm((DEPTH, N_EXPERTS, D_MODEL, D_FF), D_MODEL ** -0.5),
        'moe_w_down': nrm((DEPTH, N_EXPERTS, D_FF, D_MODEL), DEEPNORM_BETA * D_FF ** -0.5),
        'ln_mix_g': gain((DEPTH, D_MODEL)),
        'ln_mix_b': nrm((DEPTH, D_MODEL), 0.02),
        'ln_ffn_g': gain((DEPTH, D_MODEL)),
        'ln_ffn_b': nrm((DEPTH, D_MODEL), 0.02),
    }


def reference(x, positions, w_in_ab, ret_norm_g, ml_conv_w, ml_conv_b, ml_b_i, ml_b_f, ml_norm_g, w_out_ab,
              w_in_cd, gla_w_alpha, gla_b_alpha, gla_norm_g, ssd_conv_w, ssd_conv_b, ssd_dt_bias, ssd_a_log, ssd_d,
              ssd_norm_g, w_out_cd, w_router, b_router, moe_w_gate, moe_w_up, moe_w_down,
              ln_mix_g, ln_mix_b, ln_ffn_g, ln_ffn_b):
    h = x
    for layer in range(DEPTH):
        j = layer // 2
        if layer % 2 == 0:
            mix = _mixer_ab(h, positions, w_in_ab[j], ret_norm_g[j], ml_conv_w[j], ml_conv_b[j], ml_b_i[j],
                            ml_b_f[j], ml_norm_g[j], w_out_ab[j])
        else:
            mix = _mixer_cd(h, w_in_cd[j], gla_w_alpha[j], gla_b_alpha[j], gla_norm_g[j], ssd_conv_w[j],
                            ssd_conv_b[j], ssd_dt_bias[j], ssd_a_log[j], ssd_d[j], ssd_norm_g[j], w_out_cd[j])
        h = _layernorm(DEEPNORM_ALPHA * h + mix, ln_mix_g[layer], ln_mix_b[layer])
        ffn = _moe(h, w_router, b_router, moe_w_gate[layer], moe_w_up[layer], moe_w_down[layer])
        h = _layernorm(DEEPNORM_ALPHA * h + ffn, ln_ffn_g[layer], ln_ffn_b[layer])
    return h
```

```cpp
#include <hip/hip_runtime.h>
#include <cstdio>
#include <cstdint>

#define GAS __attribute__((address_space(1)))
#define LAS __attribute__((address_space(3)))
typedef unsigned short bf16_t;
typedef short bf16x8 __attribute__((ext_vector_type(8)));
typedef float f32x4 __attribute__((ext_vector_type(4)));
typedef unsigned u32x4 __attribute__((ext_vector_type(4)));

constexpr int BATCH = 32, SEQ = 2048, T = BATCH * SEQ, D = 1024;
constexpr int NP = 6400;
constexpr int YOFF = 1024;
constexpr int NCLS = 24, MAXTILES = 280;
constexpr float LN_EPS = 1e-5f, NORM_EPS = 1e-6f;
constexpr float ALPHA = 1.41421356237f;

constexpr int C0_RQ = 0, C0_RK = 512, C0_RV = 1024, C0_MV = 2048, C0_RG = 3072, C0_MQ = 4096, C0_MK = 4608, C0_MO = 5120, C0_MI = 6144, C0_MF = 6148;
constexpr int C1_GQ = 0, C1_GK = 512, C1_GV = 1024, C1_SZ = 2048, C1_GR = 3072, C1_XS = 4096, C1_BM = 5120, C1_CM = 5632, C1_GA = 6144, C1_DT = 6160;

constexpr size_t MiB = 1u << 20;
constexpr size_t WS_CTL = 0, CTL_BYTES = 1 * MiB;
constexpr size_t WS_WIN0 = 2 * MiB;
constexpr size_t WS_WIN1 = 15 * MiB;
constexpr size_t WS_WOUT0 = 28 * MiB;
constexpr size_t WS_WOUT1 = 32 * MiB;
constexpr size_t WS_WGU = 36 * MiB;
constexpr size_t WS_WD = 100 * MiB;
constexpr size_t WS_TOKCLS = 132 * MiB;
constexpr size_t WS_TOKPOS = WS_TOKCLS + (size_t)T * 4;
constexpr size_t WS_TOKDST = WS_TOKPOS + (size_t)T * 4;
constexpr size_t WS_TOKGATE = WS_TOKDST + (size_t)T * 4;
constexpr size_t WS_ROWGATE = WS_TOKGATE + (size_t)T * 8;
constexpr size_t WS_TILECLS = WS_ROWGATE + (size_t)MAXTILES * 256 * 8;
constexpr size_t WS_BIG = 136 * MiB;
constexpr size_t BIG_HS = 0, BIG_H = 160 * MiB, BIG_PRE2 = 320 * MiB;
constexpr size_t WS_END = WS_BIG + (size_t)T * NP * 2;
static_assert(WS_TILECLS + (MAXTILES + 8) * 4 <= WS_BIG, "ws map");
static_assert(WS_END <= 1024 * MiB, "ws map");
constexpr size_t OUT_H = 0, OUT_PRE1 = 128 * MiB;
constexpr int CW_CNT = 1024;
constexpr int CW_BAR = 4096;

__device__ __forceinline__ unsigned f2bf(float f) { unsigned u = __builtin_bit_cast(unsigned, f); return (u + 0x7fffu + ((u >> 16) & 1u)) >> 16; }
__device__ __forceinline__ unsigned pk2(float lo, float hi) { return f2bf(lo) | (f2bf(hi) << 16); }
__device__ __forceinline__ float bf2f(unsigned short b) { return __builtin_bit_cast(float, ((unsigned)b) << 16); }
__device__ __forceinline__ float bflo(unsigned w) { return __builtin_bit_cast(float, w << 16); }
__device__ __forceinline__ float bfhi(unsigned w) { return __builtin_bit_cast(float, w & 0xffff0000u); }
__device__ __forceinline__ float sigmoidf_(float x) { return 1.f / (1.f + __expf(-x)); }
__device__ __forceinline__ float siluf_(float x) { return x / (1.f + __expf(-x)); }
__device__ __forceinline__ float softplusf_(float x) { return x > 20.f ? x : log1pf(expf(x)); }
__device__ __forceinline__ float logsigmoidf_(float x) { return -softplusf_(-x); }
__device__ __forceinline__ float wave_sum(float v) {
#pragma unroll
    for (int o = 1; o < 64; o <<= 1) v += __shfl_xor(v, o);
    return v;
}
#define LDS_WAIT() asm volatile("s_waitcnt lgkmcnt(0)" ::: "memory")

namespace pg8 {
constexpr int BM = 256, BK = 64, HALF = 128, HTB = HALF * BK * 2, STAGE_BYTES = 8 * HTB, NXCD = 8, WGM = 8;
__host__ __device__ __forceinline__ int lds_byte(int r, int c) { const int st = (r >> 4) * 2 + (c >> 5), rr = r & 15, cc = c & 31, ob = rr * 64 + cc * 2; return st * 1024 + (ob ^ (((ob >> 9) & 1) << 5)); }
__host__ __device__ __forceinline__ void stage_rc(int b, int& R, int& C) { const int st = b / 1024, sb = b % 1024, swz = sb ^ (((sb >> 9) & 1) << 5); R = (st >> 1) * 16 + swz / 64; C = (st & 1) * 32 + (swz % 64) / 2; }
__host__ __device__ __forceinline__ int perm32(int rho) { const int n = rho >> 4, i = rho & 15; return 8 * (i >> 2) + 4 * n + (i & 3); }

struct Unit { int pm, pn; const char* a; const char* b0; const char* b1; };

__device__ __forceinline__ bool static_tile(int i, int G, int c, int nM, int nN, int& pm, int& pn) {
    const int nwg = nM * nN; const long L = (long)i * G + c; if (L >= nwg) return false;
    int wgid = (int)L; { const int q = nwg / NXCD, r = nwg % NXCD, xcd = wgid % NXCD, off = wgid / NXCD; wgid = (xcd < r ? xcd * (q + 1) : r * (q + 1) + (xcd - r) * q) + off; }
    const int nig = WGM * nN, gid = wgid / nig, fm = gid * WGM, gsz = (nM - fm) < WGM ? (nM - fm) : WGM;
    pm = fm + ((wgid % nig) % gsz); pn = (wgid % nig) / gsz; return true;
}
__device__ __forceinline__ unsigned cvt_pk_bf16(float lo, float hi) { unsigned r; asm volatile("v_cvt_pk_bf16_f32 %0, %1, %2" : "=v"(r) : "v"(lo), "v"(hi)); return r; }

template <class Epi, class Sched>
__device__ __forceinline__ void gemm_phase(LAS unsigned char* lds, const Sched& S, const Epi& E, const int K, const int lda, const int ldb) {
    const int tid = threadIdx.x, wid = __builtin_amdgcn_readfirstlane(tid >> 6), lane = tid & 63, wr = wid >> 2, wc = wid & 3, fr = lane & 15, fq = lane >> 4;
    const int nt = K / BK;
    constexpr int KS = Sched::KSPLIT;
    unsigned voffA[2], voffB[2];
#pragma unroll
    for (int i = 0; i < 2; ++i) { int R, C; stage_rc(tid * 16 + i * 8192, R, C); const int Rb = (R & ~31) + perm32(R & 31);
        voffA[i] = (unsigned)(R * lda + C) * 2u; voffB[i] = (unsigned)(Rb * ldb + C) * 2u; }
    const size_t kstep = (size_t)(BK * 2);
    const size_t hstepA = (size_t)HALF * lda * 2, hstepB = (size_t)HALF * ldb * 2;
    const unsigned ldsw = (unsigned)wid * 1024u;
    const int aoff = lds_byte(wr * 64 + fr, fq * 8), boff = lds_byte(wc * 32 + fr, fq * 8);
#define PG8_BP(u, kt) ((KS > 0 && (kt) >= KS) ? (u).b1 + (size_t)((kt) - KS) * kstep : (u).b0 + (size_t)(kt) * kstep)
#define PG8_SA(b, h) (((b) * 2 + (h)) * HTB)
#define PG8_SB(b, h) ((4 + (b) * 2 + (h)) * HTB)
#define PG8_STAGE(bufoff, gbase, voff) do { _Pragma("unroll") for (int _i = 0; _i < 2; ++_i) \
        __builtin_amdgcn_global_load_lds((const unsigned*)((const char*)(gbase) + (voff)[_i]), (LAS unsigned*)(lds + (bufoff) + ldsw + _i * 8192), 16, 0, 0); } while (0)
#define PG8_LDA(dst, b, h) do { _Pragma("unroll") for (int m = 0; m < 4; ++m) _Pragma("unroll") for (int k = 0; k < 2; ++k) dst[m][k] = *(const LAS bf16x8*)(lds + PG8_SA(b, h) + aoff + m * 2048 + k * 1024); } while (0)
#define PG8_LDB(dst, b, h) do { _Pragma("unroll") for (int n = 0; n < 2; ++n) _Pragma("unroll") for (int k = 0; k < 2; ++k) dst[n][k] = *(const LAS bf16x8*)(lds + PG8_SB(b, h) + boff + n * 2048 + k * 1024); } while (0)
#define PG8_MMA(ai, bj, At, Bt) do { __builtin_amdgcn_s_setprio(1); _Pragma("unroll") for (int m = 0; m < 4; ++m) _Pragma("unroll") for (int n = 0; n < 2; ++n) _Pragma("unroll") for (int k = 0; k < 2; ++k) \
        acc[ai][bj][m][n] = __builtin_amdgcn_mfma_f32_16x16x32_bf16(Bt[n][k], At[m][k], acc[ai][bj][m][n], 0, 0, 0); __builtin_amdgcn_s_setprio(0); } while (0)
#define PG8_WAIT_V(n) asm volatile("s_waitcnt vmcnt(" #n ")" ::: "memory")
#define PG8_WAIT_L(n) asm volatile("s_waitcnt lgkmcnt(" #n ")" ::: "memory")
#define PG8_BAR __builtin_amdgcn_s_barrier()
#define PG8_SCHED __builtin_amdgcn_sched_barrier(0)
    Unit cur, nxt; int ui = 0;
    if (!S.next(0, cur)) return;
    f32x4 acc[2][2][4][2];
#pragma unroll
    for (int a = 0; a < 2; ++a)
#pragma unroll
        for (int b = 0; b < 2; ++b)
#pragma unroll
            for (int m = 0; m < 4; ++m)
#pragma unroll
                for (int n = 0; n < 2; ++n) acc[a][b][m][n] = (f32x4){0.f, 0.f, 0.f, 0.f};
    bf16x8 At[4][2], B0[2][2], B1[2][2];
    const char* cA = cur.a;
    { const char* cB0 = PG8_BP(cur, 0); const char* cB1 = PG8_BP(cur, 1);
    PG8_STAGE(PG8_SB(0, 0), cB0, voffB); PG8_STAGE(PG8_SA(0, 0), cA, voffA); PG8_STAGE(PG8_SB(0, 1), cB0 + hstepB, voffB); PG8_STAGE(PG8_SA(0, 1), cA + hstepA, voffA);
    if (wr == 1) PG8_BAR;
    PG8_WAIT_V(4); PG8_BAR;
    PG8_STAGE(PG8_SB(1, 0), cB1, voffB); PG8_STAGE(PG8_SA(1, 0), cA + kstep, voffA); PG8_STAGE(PG8_SB(1, 1), cB1 + hstepB, voffB);
    PG8_WAIT_V(6); PG8_BAR; }
    for (;;) {
        const bool has_next = S.next(ui + 1, nxt);
        if (!has_next) nxt = cur;
        for (int t = 0; t < nt; t += 2) {
            const bool last = (t == nt - 2);
            const char* a1 = cA + (size_t)(t + 1) * kstep;
            const char* a2 = last ? nxt.a : cA + (size_t)(t + 2) * kstep;
            const char* b2 = last ? PG8_BP(nxt, 0) : PG8_BP(cur, t + 2);
            const char* a3 = a2 + kstep;
            const char* b3 = last ? PG8_BP(nxt, 1) : PG8_BP(cur, t + 3);
            PG8_LDB(B0, 0, 0); PG8_SCHED; PG8_LDA(At, 0, 0); PG8_STAGE(PG8_SA(1, 1), a1 + hstepA, voffA);
            PG8_WAIT_L(8); PG8_BAR; PG8_WAIT_L(0); PG8_MMA(0, 0, At, B0); PG8_BAR; PG8_SCHED;
            PG8_LDB(B1, 0, 1); PG8_STAGE(PG8_SB(0, 0), b2, voffB);
            PG8_BAR; PG8_WAIT_L(0); PG8_MMA(0, 1, At, B1); PG8_BAR;
            PG8_LDA(At, 0, 1); PG8_STAGE(PG8_SA(0, 0), a2, voffA);
            PG8_BAR; PG8_WAIT_L(0); PG8_MMA(1, 0, At, B0); PG8_BAR; PG8_SCHED;
            PG8_STAGE(PG8_SB(0, 1), b2 + hstepB, voffB);
            PG8_WAIT_V(6); PG8_BAR; PG8_MMA(1, 1, At, B1); PG8_BAR;
            PG8_LDB(B0, 1, 0); PG8_SCHED; PG8_LDA(At, 1, 0); PG8_STAGE(PG8_SA(0, 1), a2 + hstepA, voffA);
            PG8_WAIT_L(8); PG8_BAR; PG8_WAIT_L(0); PG8_MMA(0, 0, At, B0); PG8_BAR; PG8_SCHED;
            PG8_LDB(B1, 1, 1); PG8_STAGE(PG8_SB(1, 0), b3, voffB);
            PG8_BAR; PG8_WAIT_L(0); PG8_MMA(0, 1, At, B1); PG8_BAR;
            PG8_LDA(At, 1, 1); PG8_STAGE(PG8_SA(1, 0), a3, voffA);
            PG8_BAR; PG8_WAIT_L(0); PG8_MMA(1, 0, At, B0); PG8_BAR; PG8_SCHED;
            PG8_STAGE(PG8_SB(1, 1), b3 + hstepB, voffB);
            PG8_WAIT_V(6); PG8_BAR; PG8_MMA(1, 1, At, B1); PG8_BAR;
        }
        E(acc, cur, wr, wc, fr, fq);
        if (!has_next) break;
#pragma unroll
        for (int a = 0; a < 2; ++a)
#pragma unroll
            for (int b = 0; b < 2; ++b)
#pragma unroll
                for (int m = 0; m < 4; ++m)
#pragma unroll
                    for (int n = 0; n < 2; ++n) acc[a][b][m][n] = (f32x4){0.f, 0.f, 0.f, 0.f};
        cur = nxt; cA = cur.a; ++ui;
    }
    PG8_WAIT_V(0);
    if (wr == 0) PG8_BAR;
    PG8_BAR;
#undef PG8_BP
#undef PG8_SA
#undef PG8_SB
#undef PG8_STAGE
#undef PG8_LDA
#undef PG8_LDB
#undef PG8_MMA
#undef PG8_WAIT_V
#undef PG8_WAIT_L
#undef PG8_BAR
#undef PG8_SCHED
}

struct SchedPlain {
    static constexpr int KSPLIT = 0;
    const char* A; const char* B; int lda, ldb, nM, nN, G, c;
    __device__ __forceinline__ bool next(int i, Unit& u) const {
        if (!static_tile(i, G, c, nM, nN, u.pm, u.pn)) return false;
        u.a = A + (size_t)u.pm * BM * lda * 2; u.b0 = B + (size_t)u.pn * BM * ldb * 2; u.b1 = u.b0; return true;
    }
};
__device__ __forceinline__ void cls_experts(int cls, int& e0, int& e1) {
    const int g = cls / 6, p = cls % 6;
    const int a = p < 3 ? 0 : (p < 5 ? 1 : 2);
    const int b = p < 3 ? p + 1 : (p < 5 ? p - 1 : 3);
    e0 = 4 * g + a; e1 = 4 * g + b;
}
struct SchedMoeA {
    static constexpr int KSPLIT = 0;
    const char* A; const char* Wgu; const int* tilecls; int nM, G, c;
    __device__ __forceinline__ bool next(int i, Unit& u) const {
        if (!static_tile(i, G, c, nM, 8, u.pm, u.pn)) return false;
        int e0, e1; cls_experts(tilecls[8 + u.pm], e0, e1); const int e = (u.pn >> 2) ? e1 : e0;
        u.a = A + (size_t)u.pm * BM * 1024 * 2; u.b0 = Wgu + ((size_t)e * 1024 + (size_t)(u.pn & 3) * 256) * 1024 * 2; u.b1 = u.b0; return true;
    }
};
struct SchedMoeB {
    static constexpr int KSPLIT = 8;
    const char* A; const char* Wd; const int* tilecls; int nM, G, c;
    __device__ __forceinline__ bool next(int i, Unit& u) const {
        if (!static_tile(i, G, c, nM, 4, u.pm, u.pn)) return false;
        int e0, e1; cls_experts(tilecls[8 + u.pm], e0, e1);
        u.a = A + (size_t)u.pm * BM * 1024 * 2;
        u.b0 = Wd + ((size_t)e0 * 1024 + (size_t)u.pn * 256) * 512 * 2; u.b1 = Wd + ((size_t)e1 * 1024 + (size_t)u.pn * 256) * 512 * 2; return true;
    }
};

struct EpiStore {
    bf16_t* O; int ldc;
    __device__ __forceinline__ void operator()(const f32x4 (&acc)[2][2][4][2], const Unit& u, int wr, int wc, int fr, int fq) const {
        const int row0 = u.pm * BM + wr * 64 + fr, col0 = u.pn * BM + wc * 32 + 8 * fq;
#pragma unroll
        for (int ai = 0; ai < 2; ++ai)
#pragma unroll
            for (int m = 0; m < 4; ++m) { bf16_t* rowp = O + (size_t)(row0 + ai * HALF + m * 16) * ldc + col0;
#pragma unroll
                for (int bj = 0; bj < 2; ++bj) { const f32x4 v0 = acc[ai][bj][m][0], v1 = acc[ai][bj][m][1];
                    u32x4 w; w.x = cvt_pk_bf16(v0[0], v0[1]); w.y = cvt_pk_bf16(v0[2], v0[3]); w.z = cvt_pk_bf16(v1[0], v1[1]); w.w = cvt_pk_bf16(v1[2], v1[3]);
                    *(u32x4*)(rowp + bj * HALF) = w; } }
    }
};
struct EpiResid {
    bf16_t* O; const bf16_t* R;
    __device__ __forceinline__ void operator()(const f32x4 (&acc)[2][2][4][2], const Unit& u, int wr, int wc, int fr, int fq) const {
        const int row0 = u.pm * BM + wr * 64 + fr, col0 = u.pn * BM + wc * 32 + 8 * fq;
#pragma unroll
        for (int ai = 0; ai < 2; ++ai)
#pragma unroll
            for (int m = 0; m < 4; ++m) { const size_t off = (size_t)(row0 + ai * HALF + m * 16) * 1024 + col0;
#pragma unroll
                for (int bj = 0; bj < 2; ++bj) { const f32x4 v0 = acc[ai][bj][m][0], v1 = acc[ai][bj][m][1];
                    const u32x4 r = *(const u32x4*)(R + off + bj * HALF);
                    u32x4 w; w.x = cvt_pk_bf16(v0[0] + ALPHA * bflo(r.x), v0[1] + ALPHA * bfhi(r.x)); w.y = cvt_pk_bf16(v0[2] + ALPHA * bflo(r.y), v0[3] + ALPHA * bfhi(r.y));
                    w.z = cvt_pk_bf16(v1[0] + ALPHA * bflo(r.z), v1[1] + ALPHA * bfhi(r.z)); w.w = cvt_pk_bf16(v1[2] + ALPHA * bflo(r.w), v1[3] + ALPHA * bfhi(r.w));
                    *(u32x4*)(O + off + bj * HALF) = w; } }
    }
};
struct EpiSwiglu {
    bf16_t* H; const float* rowgate;
    __device__ __forceinline__ void operator()(const f32x4 (&acc)[2][2][4][2], const Unit& u, int wr, int wc, int fr, int fq) const {
        const int row0 = u.pm * BM + wr * 64 + fr, ke = u.pn >> 2, col0 = 512 * ke + 128 * (u.pn & 3) + wc * 32 + 8 * fq;
#pragma unroll
        for (int ai = 0; ai < 2; ++ai)
#pragma unroll
            for (int m = 0; m < 4; ++m) { const int row = row0 + ai * HALF + m * 16; const float gt = rowgate[(size_t)row * 2 + ke];
                const f32x4 g0 = acc[ai][0][m][0], g1 = acc[ai][0][m][1], u0 = acc[ai][1][m][0], u1 = acc[ai][1][m][1];
                float o[8];
#pragma unroll
                for (int j = 0; j < 4; ++j) { o[j] = siluf_(g0[j]) * u0[j] * gt; o[4 + j] = siluf_(g1[j]) * u1[j] * gt; }
                u32x4 w; w.x = cvt_pk_bf16(o[0], o[1]); w.y = cvt_pk_bf16(o[2], o[3]); w.z = cvt_pk_bf16(o[4], o[5]); w.w = cvt_pk_bf16(o[6], o[7]);
                *(u32x4*)(H + (size_t)row * 1024 + col0) = w; }
    }
};
}

struct Params {
    const float* in[30];
    unsigned char* out;
    unsigned char* ws;
};
enum { I_X = 0, I_POS, I_WINAB, I_RETG, I_MLCW, I_MLCB, I_MLBI, I_MLBF, I_MLG, I_WOUTAB, I_WINCD, I_GLAWA, I_GLABA, I_GLAG, I_SSDCW, I_SSDCB, I_SSDDTB, I_SSDALOG, I_SSDD, I_SSDG,
       I_WOUTCD, I_WR, I_BR, I_MOEG, I_MOEU, I_MOED, I_LNMG, I_LNMB, I_LNFG, I_LNFB };

template <class ColPtr>
__device__ __forceinline__ void tr_item(const ColPtr& cp, int ldw, bf16_t* WT, int ldt, int n0, int k0, LAS float* scr, int lane) {
    const float* p = cp(n0 + (lane & 31));
#pragma unroll 8
    for (int i = 0; i < 32; ++i) { const int kk = 2 * i + (lane >> 5); scr[kk * 33 + (lane & 31)] = p ? p[(size_t)(k0 + kk) * ldw] : 0.f; }
    LDS_WAIT();
    const int c = lane & 7;
#pragma unroll
    for (int j = 0; j < 4; ++j) { const int n = (lane >> 3) + 8 * j; const LAS float* s = scr + (8 * c) * 33 + n;
        u32x4 o; o.x = pk2(s[0 * 33], s[1 * 33]); o.y = pk2(s[2 * 33], s[3 * 33]); o.z = pk2(s[4 * 33], s[5 * 33]); o.w = pk2(s[6 * 33], s[7 * 33]);
        *(u32x4*)(WT + (size_t)(n0 + n) * ldt + k0 + 8 * c) = o; }
    LDS_WAIT();
}
__device__ __forceinline__ int map_ab(int n) {
    if (n < 2048) return n;
    if (n < 3072) return 4096 + (n - 2048);
    if (n < 4096) return 2048 + (n - 3072);
    if (n < 4608) return 3072 + (n - 4096);
    if (n < 5120) return 3584 + (n - 4608);
    if (n < 6152) return n;
    return -1;
}
__device__ __forceinline__ int map_cd(int n) {
    if (n < 2048) return n;
    if (n < 3072) return 3088 + (n - 2048);
    if (n < 4096) return 2048 + (n - 3072);
    if (n < 5120) return 4112 + (n - 4096);
    if (n < 5632) return 5136 + (n - 5120);
    if (n < 6144) return 5648 + (n - 5632);
    if (n < 6160) return 3072 + (n - 6144);
    if (n < 6176) return 6160 + (n - 6160);
    return -1;
}
__device__ __forceinline__ void phase_convert(const Params& P, LAS unsigned char* lds, int bid, int nb) {
    const int tid = threadIdx.x, lane = tid & 63, wave = tid >> 6, nw = blockDim.x >> 6;
    LAS float* scr = (LAS float*)(lds + wave * 16384);
    const int gw = bid * nw + wave, NGW = nb * nw;
    unsigned char* ws = P.ws;
    constexpr int I_IN = (NP / 32) * (D / 64);
    constexpr int I_OUT = (1024 / 32) * (2048 / 64);
    constexpr int I_GU = (1024 / 32) * (1024 / 64);
    constexpr int I_DN = (1024 / 32) * (512 / 64);
    constexpr int NITEMS = 2 * I_IN + 2 * I_OUT + 32 * I_GU + 32 * I_DN;
    for (int it = gw; it < NITEMS; it += NGW) {
        int r = it;
        if (r < 2 * I_IN) { const int l = r / I_IN; r %= I_IN; const int nbk = r / (D / 64), kb = r % (D / 64);
            const float* W = P.in[l ? I_WINCD : I_WINAB]; const int ldw = l ? 6176 : 6152;
            if (l == 0) tr_item([&](int n) { const int s = map_ab(n); return s < 0 ? (const float*)nullptr : W + s; }, ldw, (bf16_t*)(ws + WS_WIN0), D, nbk * 32, kb * 64, scr, lane);
            else        tr_item([&](int n) { const int s = map_cd(n); return s < 0 ? (const float*)nullptr : W + s; }, ldw, (bf16_t*)(ws + WS_WIN1), D, nbk * 32, kb * 64, scr, lane);
            continue; }
        r -= 2 * I_IN;
        if (r < 2 * I_OUT) { const int l = r / I_OUT; r %= I_OUT; const int nbk = r / 32, kb = r % 32;
            const float* W = P.in[l ? I_WOUTCD : I_WOUTAB];
            tr_item([&](int n) { return W + n; }, 1024, (bf16_t*)(ws + (l ? WS_WOUT1 : WS_WOUT0)), 2048, nbk * 32, kb * 64, scr, lane);
            continue; }
        r -= 2 * I_OUT;
        if (r < 32 * I_GU) { const int le = r / I_GU; r %= I_GU; const int nbk = r / 16, kb = r % 16;
            const int n0 = nbk * 32, j = n0 >> 8, w = n0 & 255;
            const float* W = (w < 128 ? P.in[I_MOEG] : P.in[I_MOEU]) + (size_t)le * 1024 * 512 + 128 * j + (w & 127) - n0;
            tr_item([&](int n) { return W + n; }, 512, (bf16_t*)(ws + WS_WGU) + (size_t)le * 1024 * 1024, 1024, n0, kb * 64, scr, lane);
            continue; }
        r -= 32 * I_GU;
        { const int le = r / I_DN; r %= I_DN; const int nbk = r / 8, kb = r % 8;
            const float* W = P.in[I_MOED] + (size_t)le * 512 * 1024;
            tr_item([&](int n) { return W + n; }, 1024, (bf16_t*)(ws + WS_WD) + (size_t)le * 1024 * 512, 512, nbk * 32, kb * 64, scr, lane); }
    }
    const float* x = P.in[I_X]; bf16_t* h = (bf16_t*)(P.out + OUT_H);
    const size_t n8 = (size_t)T * D / 8;
    for (size_t i = (size_t)bid * blockDim.x + tid; i < n8; i += (size_t)nb * blockDim.x) {
        const f32x4 a = *(const f32x4*)(x + i * 8), b = *(const f32x4*)(x + i * 8 + 4);
        u32x4 o; o.x = pk2(a[0], a[1]); o.y = pk2(a[2], a[3]); o.z = pk2(b[0], b[1]); o.w = pk2(b[2], b[3]);
        *(u32x4*)(h + i * 8) = o;
    }
}

__device__ __forceinline__ void load_row_bf16(const bf16_t* row, int lane, float (&v)[16]) {
#pragma unroll
    for (int j = 0; j < 2; ++j) { const u32x4 w = *(const u32x4*)(row + 8 * lane + 512 * j);
        v[8 * j + 0] = bflo(w.x); v[8 * j + 1] = bfhi(w.x); v[8 * j + 2] = bflo(w.y); v[8 * j + 3] = bfhi(w.y);
        v[8 * j + 4] = bflo(w.z); v[8 * j + 5] = bfhi(w.z); v[8 * j + 6] = bflo(w.w); v[8 * j + 7] = bfhi(w.w); }
}
__device__ __forceinline__ void ln_row(float (&v)[16], const float* g, const float* b, int lane) {
    float s = 0.f;
#pragma unroll
    for (int i = 0; i < 16; ++i) s += v[i];
    const float mean = wave_sum(s) * (1.f / D); float q = 0.f;
#pragma unroll
    for (int i = 0; i < 16; ++i) { v[i] -= mean; q += v[i] * v[i]; }
    const float rstd = rsqrtf(wave_sum(q) * (1.f / D) + LN_EPS);
#pragma unroll
    for (int j = 0; j < 2; ++j) {
        const f32x4 g0 = *(const f32x4*)(g + 8 * lane + 512 * j), g1 = *(const f32x4*)(g + 8 * lane + 512 * j + 4);
        const f32x4 b0 = *(const f32x4*)(b + 8 * lane + 512 * j), b1 = *(const f32x4*)(b + 8 * lane + 512 * j + 4);
#pragma unroll
        for (int i = 0; i < 4; ++i) { v[8 * j + i] = v[8 * j + i] * rstd * g0[i] + b0[i]; v[8 * j + 4 + i] = v[8 * j + 4 + i] * rstd * g1[i] + b1[i]; }
    }
}
__device__ __forceinline__ void store_row_bf16(bf16_t* row, int lane, const float (&v)[16]) {
#pragma unroll
    for (int j = 0; j < 2; ++j) { u32x4 o; o.x = pk2(v[8 * j + 0], v[8 * j + 1]); o.y = pk2(v[8 * j + 2], v[8 * j + 3]); o.z = pk2(v[8 * j + 4], v[8 * j + 5]); o.w = pk2(v[8 * j + 6], v[8 * j + 7]);
        *(u32x4*)(row + 8 * lane + 512 * j) = o; }
}

__device__ __forceinline__ void phase_route(const Params& P, int layer, LAS unsigned char* lds, int bid, int nb) {
    const int tid = threadIdx.x, lane = tid & 63, wave = tid >> 6, nw = blockDim.x >> 6;
    LAS int* lcnt = (LAS int*)lds;
    LAS int* lbase = lcnt + 32;
    LAS int* rcls = lbase + 32;
    LAS int* rpos = rcls + 256;
    const bf16_t* pre1 = (const bf16_t*)(P.out + OUT_PRE1);
    const float* g = P.in[I_LNMG] + layer * D; const float* b = P.in[I_LNMB] + layer * D;
    const float* Wr = P.in[I_WR]; const float* br = P.in[I_BR];
    int* tokcls = (int*)(P.ws + WS_TOKCLS); int* tokpos = (int*)(P.ws + WS_TOKPOS); float* tokgate = (float*)(P.ws + WS_TOKGATE);
    unsigned* gcnt = (unsigned*)(P.ws + WS_CTL) + CW_CNT + 64 * layer;
    for (int r0 = bid * 256; r0 < T; r0 += nb * 256) {
        if (tid < 32) lcnt[tid] = 0;
        __syncthreads();
        for (int rr = wave; rr < 256; rr += nw) {
            const int t = r0 + rr;
            float v[16]; load_row_bf16(pre1 + (size_t)t * D, lane, v); ln_row(v, g, b, lane);
            float lg[16];
#pragma unroll
            for (int e = 0; e < 16; ++e) lg[e] = 0.f;
#pragma unroll
            for (int j = 0; j < 2; ++j)
#pragma unroll
                for (int i = 0; i < 8; ++i) { const float* wr_ = Wr + (size_t)(8 * lane + 512 * j + i) * 16; const float hv = v[8 * j + i];
#pragma unroll
                    for (int q = 0; q < 4; ++q) { const f32x4 w4 = *(const f32x4*)(wr_ + 4 * q); lg[4 * q] += hv * w4[0]; lg[4 * q + 1] += hv * w4[1]; lg[4 * q + 2] += hv * w4[2]; lg[4 * q + 3] += hv * w4[3]; } }
#pragma unroll
            for (int e = 0; e < 16; ++e) lg[e] = wave_sum(lg[e]);
            float mx = lg[0];
#pragma unroll
            for (int e = 1; e < 16; ++e) mx = fmaxf(mx, lg[e]);
            float pr[16], sel[16], sum = 0.f;
#pragma unroll
            for (int e = 0; e < 16; ++e) { pr[e] = expf(lg[e] - mx); sum += pr[e]; }
            const float inv = 1.f / sum;
#pragma unroll
            for (int e = 0; e < 16; ++e) { pr[e] *= inv; sel[e] = pr[e] + br[e]; }
            int gbest = 0; float gs_best = -3.0e38f;
#pragma unroll
            for (int gi = 0; gi < 4; ++gi) {
                float m1 = -3.0e38f, m2 = -3.0e38f;
#pragma unroll
                for (int i = 0; i < 4; ++i) { const float s = sel[4 * gi + i]; if (s > m1) { m2 = m1; m1 = s; } else if (s > m2) m2 = s; }
                const float gs = m1 + m2; if (gs > gs_best) { gs_best = gs; gbest = gi; }
            }
            float s4[4], p4[4];
#pragma unroll
            for (int i = 0; i < 4; ++i) { s4[i] = gbest == 0 ? sel[i] : gbest == 1 ? sel[4 + i] : gbest == 2 ? sel[8 + i] : sel[12 + i];
                                          p4[i] = gbest == 0 ? pr[i] : gbest == 1 ? pr[4 + i] : gbest == 2 ? pr[8 + i] : pr[12 + i]; }
            int e1 = 0; float b1 = s4[0];
#pragma unroll
            for (int i = 1; i < 4; ++i) if (s4[i] > b1) { b1 = s4[i]; e1 = i; }
            int e2 = -1; float b2 = -3.0e38f;
#pragma unroll
            for (int i = 0; i < 4; ++i) if (i != e1 && s4[i] > b2) { b2 = s4[i]; e2 = i; }
            const int ea = e1 < e2 ? e1 : e2, eb = e1 < e2 ? e2 : e1;
            const int pidx = ea == 0 ? eb - 1 : (ea == 1 ? eb + 1 : 5);
            const int cls = gbest * 6 + pidx;
            const float pa = ea == 0 ? p4[0] : ea == 1 ? p4[1] : p4[2];
            const float pb = eb == 1 ? p4[1] : eb == 2 ? p4[2] : p4[3];
            const float ga = pa / (pa + pb), gb = pb / (pa + pb);
            if (lane == 0) { const int lp = atomicAdd((int*)&lcnt[cls], 1); rcls[rr] = cls; rpos[rr] = lp; tokgate[(size_t)t * 2] = ga; tokgate[(size_t)t * 2 + 1] = gb; }
        }
        __syncthreads();
        if (tid < NCLS) lbase[tid] = (int)atomicAdd(&gcnt[tid], (unsigned)lcnt[tid]);
        __syncthreads();
        if (tid < 256) { const int t = r0 + tid; const int c = rcls[tid]; tokcls[t] = c; tokpos[t] = lbase[c] + rpos[tid]; }
        __syncthreads();
    }
}
__device__ __forceinline__ void phase_permute(const Params& P, int layer, LAS unsigned char* lds, int bid, int nb) {
    const int tid = threadIdx.x, lane = tid & 63, wave = tid >> 6, nw = blockDim.x >> 6;
    LAS int* off = (LAS int*)lds;
    const unsigned* gcnt = (const unsigned*)(P.ws + WS_CTL) + CW_CNT + 64 * layer;
    int* tilecls = (int*)(P.ws + WS_TILECLS);
    if (tid == 0) { int o = 0; for (int c = 0; c < NCLS; ++c) { off[c] = o * 256; const int nt = ((int)gcnt[c] + 255) >> 8;
            if (bid == 0) for (int i = 0; i < nt; ++i) tilecls[8 + o + i] = c;
            o += nt; }
        if (bid == 0) tilecls[0] = o; }
    __syncthreads();
    const bf16_t* pre1 = (const bf16_t*)(P.out + OUT_PRE1); bf16_t* hs = (bf16_t*)(P.ws + WS_BIG + BIG_HS);
    const float* g = P.in[I_LNMG] + layer * D; const float* b = P.in[I_LNMB] + layer * D;
    const int* tokcls = (const int*)(P.ws + WS_TOKCLS); const int* tokpos = (const int*)(P.ws + WS_TOKPOS); int* tokdst = (int*)(P.ws + WS_TOKDST);
    const float* tokgate = (const float*)(P.ws + WS_TOKGATE); float* rowgate = (float*)(P.ws + WS_ROWGATE);
    for (int t = bid * nw + wave; t < T; t += nb * nw) {
        const int dst = off[tokcls[t]] + tokpos[t];
        float v[16]; load_row_bf16(pre1 + (size_t)t * D, lane, v); ln_row(v, g, b, lane);
        store_row_bf16(hs + (size_t)dst * D, lane, v);
        if (lane == 0) { tokdst[t] = dst; rowgate[(size_t)dst * 2] = tokgate[(size_t)t * 2]; rowgate[(size_t)dst * 2 + 1] = tokgate[(size_t)t * 2 + 1]; }
    }
}
__device__ __forceinline__ void phase_lnffn(const Params& P, int layer, int bid, int nb) {
    const int tid = threadIdx.x, lane = tid & 63, wave = tid >> 6, nw = blockDim.x >> 6;
    const bf16_t* pre2 = (const bf16_t*)(P.ws + WS_BIG + BIG_PRE2);
    const float* g = P.in[I_LNFG] + layer * D; const float* b = P.in[I_LNFB] + layer * D;
    const int* tokdst = (const int*)(P.ws + WS_TOKDST);
    for (int t = bid * nw + wave; t < T; t += nb * nw) {
        float v[16]; load_row_bf16(pre2 + (size_t)tokdst[t] * D, lane, v); ln_row(v, g, b, lane);
        if (layer == 0) store_row_bf16((bf16_t*)(P.out + OUT_H) + (size_t)t * D, lane, v);
        else { float* o = (float*)P.out + (size_t)t * D;
#pragma unroll
            for (int j = 0; j < 2; ++j) { *(f32x4*)(o + 8 * lane + 512 * j) = (f32x4){v[8 * j], v[8 * j + 1], v[8 * j + 2], v[8 * j + 3]}; *(f32x4*)(o + 8 * lane + 512 * j + 4) = (f32x4){v[8 * j + 4], v[8 * j + 5], v[8 * j + 6], v[8 * j + 7]}; } }
    }
}

__device__ __forceinline__ float block_sum256(float a, float* red, int tid) {
    a = wave_sum(a);
    if ((tid & 63) == 0) red[tid >> 6] = a;
    __syncthreads();
    const float r = (red[0] + red[1]) + (red[2] + red[3]);
    __syncthreads();
    return r;
}
__global__ void __launch_bounds__(256) k_mix_ret_naive(Params P) {
    __shared__ float qs[128], ks[128], red[8];
    const int b = blockIdx.x >> 2, h = blockIdx.x & 3, v = threadIdx.x;
    bf16_t* proj = (bf16_t*)(P.ws + WS_BIG); const int* pos = (const int*)P.in[I_POS];
    const float gamma = 1.f - exp2f(-5.f - (float)h);
    const float gn = P.in[I_RETG][h * 256 + v];
    float S[128];
#pragma unroll
    for (int d = 0; d < 128; ++d) S[d] = 0.f;
    for (int t = 0; t < SEQ; ++t) {
        bf16_t* row = proj + (size_t)(b * SEQ + t) * NP;
        if (v < 64) { const float inv = exp2f(-(float)(2 * v) * (13.287712379549449f / 128.f)); const float ang = (float)pos[b * SEQ + t] * inv; float sn, cs; sincosf(ang, &sn, &cs);
            const float q0 = bf2f(row[C0_RQ + h * 128 + 2 * v]), q1 = bf2f(row[C0_RQ + h * 128 + 2 * v + 1]);
            const float k0 = bf2f(row[C0_RK + h * 128 + 2 * v]), k1 = bf2f(row[C0_RK + h * 128 + 2 * v + 1]);
            qs[2 * v] = q0 * cs - q1 * sn; qs[2 * v + 1] = q0 * sn + q1 * cs;
            ks[2 * v] = (k0 * cs - k1 * sn) * 0.08838834764831845f; ks[2 * v + 1] = (k0 * sn + k1 * cs) * 0.08838834764831845f; }
        __syncthreads();
        const float vv = bf2f(row[C0_RV + h * 256 + v]); float y = 0.f;
#pragma unroll
        for (int d = 0; d < 128; ++d) { S[d] = gamma * S[d] + ks[d] * vv; y += qs[d] * S[d]; }
        const float mean = block_sum256(y, red, v) * (1.f / 256.f); const float dv = y - mean;
        const float var = block_sum256(dv * dv, red, v) * (1.f / 256.f);
        const float o = dv * rsqrtf(var + NORM_EPS) * gn * siluf_(bf2f(row[C0_RG + h * 256 + v]));
        row[C0_RV + h * 256 + v] = (bf16_t)f2bf(o);
    }
}
__global__ void __launch_bounds__(256) k_mix_ml_naive(Params P) {
    __shared__ float qs[128], ks[128], red[8];
    const int b = blockIdx.x >> 2, h = blockIdx.x & 3, v = threadIdx.x;
    bf16_t* proj = (bf16_t*)(P.ws + WS_BIG);
    const float* cw = P.in[I_MLCW]; const float* cb = P.in[I_MLCB];
    const float bi = P.in[I_MLBI][h], bfg = P.in[I_MLBF][h];
    const float gn = P.in[I_MLG][h * 256 + v];
    float S[128];
#pragma unroll
    for (int d = 0; d < 128; ++d) S[d] = 0.f;
    float nst = 0.f;
    for (int t = 0; t < SEQ; ++t) {
        bf16_t* row = proj + (size_t)(b * SEQ + t) * NP;
        if (v < 128) { const int cq = h * 128 + v, ck = 512 + h * 128 + v; float aq = cb[cq], ak = cb[ck];
#pragma unroll
            for (int j = 0; j < 4; ++j) { const int tt = t - 3 + j; if (tt >= 0) { const bf16_t* r2 = proj + (size_t)(b * SEQ + tt) * NP; aq += cw[j * 1024 + cq] * bf2f(r2[C0_MQ + h * 128 + v]); ak += cw[j * 1024 + ck] * bf2f(r2[C0_MK + h * 128 + v]); } }
            qs[v] = siluf_(aq); ks[v] = siluf_(ak) * 0.08838834764831845f; }
        __syncthreads();
        const float ip = bf2f(row[C0_MI + h]) + bi, fp = bf2f(row[C0_MF + h]) + bfg;
        const float f = sigmoidf_(fp), ei = expf(ip);
        const float vv = bf2f(row[C0_MV + h * 256 + v]); float num = 0.f;
#pragma unroll
        for (int d = 0; d < 128; ++d) { S[d] = f * S[d] + (ei * ks[d]) * vv; num += qs[d] * S[d]; }
        float part = 0.f;
        if (v < 128) { nst = f * nst + ei * ks[v]; part = qs[v] * nst; }
        const float den = block_sum256(part, red, v);
        float hv = num / fmaxf(fabsf(den), 1.f);
        hv *= sigmoidf_(bf2f(row[C0_MO + h * 256 + v]));
        const float mean = block_sum256(hv, red, v) * (1.f / 256.f); const float dv = hv - mean;
        const float var = block_sum256(dv * dv, red, v) * (1.f / 256.f);
        row[C0_MV + h * 256 + v] = (bf16_t)f2bf(dv * rsqrtf(var + NORM_EPS) * gn);
    }
}
__global__ void __launch_bounds__(256) k_mix_gla_naive(Params P) {
    __shared__ float qs[128], ks[128], al[128], red[8];
    const int b = blockIdx.x >> 2, h = blockIdx.x & 3, v = threadIdx.x;
    bf16_t* proj = (bf16_t*)(P.ws + WS_BIG);
    const float* wa = P.in[I_GLAWA]; const float* ba = P.in[I_GLABA];
    const float gn = P.in[I_GLAG][h * 256 + v];
    float S[128];
#pragma unroll
    for (int d = 0; d < 128; ++d) S[d] = 0.f;
    for (int t = 0; t < SEQ; ++t) {
        bf16_t* row = proj + (size_t)(b * SEQ + t) * NP;
        if (v < 128) { const int ch = h * 128 + v; float a = ba[ch];
#pragma unroll
            for (int r = 0; r < 16; ++r) a += bf2f(row[C1_GA + r]) * wa[r * 512 + ch];
            al[v] = expf(logsigmoidf_(a) * (1.f / 16.f));
            qs[v] = bf2f(row[C1_GQ + ch]) * 0.08838834764831845f; ks[v] = bf2f(row[C1_GK + ch]); }
        __syncthreads();
        const float vv = bf2f(row[C1_GV + h * 256 + v]); float y = 0.f;
#pragma unroll
        for (int d = 0; d < 128; ++d) { S[d] = al[d] * S[d] + ks[d] * vv; y += qs[d] * S[d]; }
        const float ms = block_sum256(y * y, red, v) * (1.f / 256.f);
        row[C1_GV + h * 256 + v] = (bf16_t)f2bf(y * rsqrtf(ms + NORM_EPS) * gn * siluf_(bf2f(row[C1_GR + h * 256 + v])));
    }
}
__global__ void __launch_bounds__(256) k_mix_ssd_naive(Params P) {
    __shared__ float Bs[128], Cs[128], red[8];
    const int b = blockIdx.x >> 2, g = blockIdx.x & 3, v = threadIdx.x, r = v >> 6, p = v & 63, hd = g * 4 + r;
    bf16_t* proj = (bf16_t*)(P.ws + WS_BIG);
    const float* cw = P.in[I_SSDCW]; const float* cb = P.in[I_SSDCB];
    const float dtb = P.in[I_SSDDTB][hd], A = -expf(P.in[I_SSDALOG][hd]), Dp = P.in[I_SSDD][hd];
    const float gn = P.in[I_SSDG][g * 256 + v];
    float S[128];
#pragma unroll
    for (int d = 0; d < 128; ++d) S[d] = 0.f;
    for (int t = 0; t < SEQ; ++t) {
        bf16_t* row = proj + (size_t)(b * SEQ + t) * NP;
        { const int n = v & 127; const int ch = (v < 128 ? 1024 : 1536) + g * 128 + n; const int col = (v < 128 ? C1_BM : C1_CM) + g * 128 + n; float a = cb[ch];
#pragma unroll
            for (int j = 0; j < 4; ++j) { const int tt = t - 3 + j; if (tt >= 0) a += cw[j * 2048 + ch] * bf2f(proj[(size_t)(b * SEQ + tt) * NP + col]); }
            a = siluf_(a); if (v < 128) Bs[n] = a; else Cs[n] = a; }
        float xv; { const int ch = hd * 64 + p; float a = cb[ch];
#pragma unroll
            for (int j = 0; j < 4; ++j) { const int tt = t - 3 + j; if (tt >= 0) a += cw[j * 2048 + ch] * bf2f(proj[(size_t)(b * SEQ + tt) * NP + C1_XS + ch]); }
            xv = siluf_(a); }
        const float dt = softplusf_(bf2f(row[C1_DT + hd]) + dtb); const float dec = expf(dt * A); const float xd = xv * dt;
        __syncthreads();
        float y = 0.f;
#pragma unroll
        for (int n = 0; n < 128; ++n) { S[n] = dec * S[n] + Bs[n] * xd; y += Cs[n] * S[n]; }
        y += Dp * xv; y *= siluf_(bf2f(row[C1_SZ + hd * 64 + p]));
        const float ms = block_sum256(y * y, red, v) * (1.f / 256.f);
        row[C1_SZ + hd * 64 + p] = (bf16_t)f2bf(y * rsqrtf(ms + NORM_EPS) * gn);
    }
}

constexpr int NTHREADS = 512;
constexpr int LDS_BYTES = 147456;

__global__ void __launch_bounds__(NTHREADS, 2) k_convert(Params P) {
    extern __shared__ __attribute__((aligned(16))) unsigned char lds[];
    phase_convert(P, (LAS unsigned char*)lds, blockIdx.x, gridDim.x);
}
__global__ void __launch_bounds__(NTHREADS, 2) k_gemm_in(Params P, int layer) {
    extern __shared__ __attribute__((aligned(16))) unsigned char lds[];
    pg8::SchedPlain S; S.A = (const char*)(P.out + OUT_H); S.B = (const char*)(P.ws + (layer ? WS_WIN1 : WS_WIN0)); S.lda = D; S.ldb = D; S.nM = T / 256; S.nN = NP / 256; S.G = gridDim.x; S.c = blockIdx.x;
    pg8::EpiStore E{(bf16_t*)(P.ws + WS_BIG), NP};
    pg8::gemm_phase(( LAS unsigned char*)lds, S, E, D, D, D);
}
__global__ void __launch_bounds__(NTHREADS, 2) k_gemm_out(Params P, int layer) {
    extern __shared__ __attribute__((aligned(16))) unsigned char lds[];
    pg8::SchedPlain S; S.A = (const char*)(P.ws + WS_BIG) + YOFF * 2; S.B = (const char*)(P.ws + (layer ? WS_WOUT1 : WS_WOUT0)); S.lda = NP; S.ldb = 2048; S.nM = T / 256; S.nN = 4; S.G = gridDim.x; S.c = blockIdx.x;
    pg8::EpiResid E{(bf16_t*)(P.out + OUT_PRE1), (const bf16_t*)(P.out + OUT_H)};
    pg8::gemm_phase((LAS unsigned char*)lds, S, E, 2048, NP, 2048);
}
__global__ void __launch_bounds__(NTHREADS, 2) k_route(Params P, int layer) {
    extern __shared__ __attribute__((aligned(16))) unsigned char lds[];
    phase_route(P, layer, (LAS unsigned char*)lds, blockIdx.x, gridDim.x);
}
__global__ void __launch_bounds__(NTHREADS, 2) k_permute(Params P, int layer) {
    extern __shared__ __attribute__((aligned(16))) unsigned char lds[];
    phase_permute(P, layer, (LAS unsigned char*)lds, blockIdx.x, gridDim.x);
}
__global__ void __launch_bounds__(NTHREADS, 2) k_moe_a(Params P, int layer) {
    extern __shared__ __attribute__((aligned(16))) unsigned char lds[];
    const int* tilecls = (const int*)(P.ws + WS_TILECLS);
    pg8::SchedMoeA S; S.A = (const char*)(P.ws + WS_BIG + BIG_HS); S.Wgu = (const char*)(P.ws + WS_WGU) + (size_t)layer * 16 * 1024 * 1024 * 2; S.tilecls = tilecls; S.nM = tilecls[0]; S.G = gridDim.x; S.c = blockIdx.x;
    pg8::EpiSwiglu E{(bf16_t*)(P.ws + WS_BIG + BIG_H), (const float*)(P.ws + WS_ROWGATE)};
    pg8::gemm_phase((LAS unsigned char*)lds, S, E, D, D, D);
}
__global__ void __launch_bounds__(NTHREADS, 2) k_moe_b(Params P, int layer) {
    extern __shared__ __attribute__((aligned(16))) unsigned char lds[];
    const int* tilecls = (const int*)(P.ws + WS_TILECLS);
    pg8::SchedMoeB S; S.A = (const char*)(P.ws + WS_BIG + BIG_H); S.Wd = (const char*)(P.ws + WS_WD) + (size_t)layer * 16 * 1024 * 512 * 2; S.tilecls = tilecls; S.nM = tilecls[0]; S.G = gridDim.x; S.c = blockIdx.x;
    pg8::EpiResid E{(bf16_t*)(P.ws + WS_BIG + BIG_PRE2), (const bf16_t*)(P.ws + WS_BIG + BIG_HS)};
    pg8::gemm_phase((LAS unsigned char*)lds, S, E, D, D, 512);
}
__global__ void __launch_bounds__(NTHREADS, 2) k_lnffn(Params P, int layer) {
    phase_lnffn(P, layer, blockIdx.x, gridDim.x);
}

extern "C" void kernel_launch(void* const* d_in, const int* in_sizes, int n_in, void* d_out, int out_size, void* d_ws, size_t ws_size, hipStream_t stream) {
    static int grid = 0;
    if (!grid) {
        if (n_in != 30 || ws_size < WS_END || out_size != T * D) { fprintf(stderr, "kernel_launch: unexpected shapes n_in %d ws %zu out %d\n", n_in, ws_size, out_size); grid = -1; return; }
        int dev = 0, cus = 0; hipGetDevice(&dev); hipDeviceGetAttribute(&cus, hipDeviceAttributeMultiprocessorCount, dev);
        hipFuncSetAttribute((const void*)k_convert, hipFuncAttributeMaxDynamicSharedMemorySize, LDS_BYTES);
        hipFuncSetAttribute((const void*)k_gemm_in, hipFuncAttributeMaxDynamicSharedMemorySize, LDS_BYTES);
        hipFuncSetAttribute((const void*)k_gemm_out, hipFuncAttributeMaxDynamicSharedMemorySize, LDS_BYTES);
        hipFuncSetAttribute((const void*)k_route, hipFuncAttributeMaxDynamicSharedMemorySize, LDS_BYTES);
        hipFuncSetAttribute((const void*)k_permute, hipFuncAttributeMaxDynamicSharedMemorySize, LDS_BYTES);
        hipFuncSetAttribute((const void*)k_moe_a, hipFuncAttributeMaxDynamicSharedMemorySize, LDS_BYTES);
        hipFuncSetAttribute((const void*)k_moe_b, hipFuncAttributeMaxDynamicSharedMemorySize, LDS_BYTES);
        grid = cus > 0 ? cus : 256;
    }
    if (grid < 0) return;
    Params P{};
    for (int i = 0; i < 30; ++i) P.in[i] = (const float*)d_in[i];
    P.out = (unsigned char*)d_out; P.ws = (unsigned char*)d_ws;
    hipMemsetAsync((char*)d_ws + WS_CTL, 0, CTL_BYTES, stream);
    hipLaunchKernelGGL(k_convert, dim3(grid), dim3(NTHREADS), LDS_BYTES, stream, P);
    for (int layer = 0; layer < 2; ++layer) {
        hipLaunchKernelGGL(k_gemm_in, dim3(grid), dim3(NTHREADS), LDS_BYTES, stream, P, layer);
        if (layer == 0) { hipLaunchKernelGGL(k_mix_ret_naive, dim3(BATCH * 4), dim3(256), 0, stream, P); hipLaunchKernelGGL(k_mix_ml_naive, dim3(BATCH * 4), dim3(256), 0, stream, P); }
        else { hipLaunchKernelGGL(k_mix_gla_naive, dim3(BATCH * 4), dim3(256), 0, stream, P); hipLaunchKernelGGL(k_mix_ssd_naive, dim3(BATCH * 4), dim3(256), 0, stream, P); }
        hipLaunchKernelGGL(k_gemm_out, dim3(grid), dim3(NTHREADS), LDS_BYTES, stream, P, layer);
        hipLaunchKernelGGL(k_route, dim3(grid), dim3(NTHREADS), LDS_BYTES, stream, P, layer);
        hipLaunchKernelGGL(k_permute, dim3(grid), dim3(NTHREADS), LDS_BYTES, stream, P, layer);
        hipLaunchKernelGGL(k_moe_a, dim3(grid), dim3(NTHREADS), LDS_BYTES, stream, P, layer);
        hipLaunchKernelGGL(k_moe_b, dim3(grid), dim3(NTHREADS), LDS_BYTES, stream, P, layer);
        hipLaunchKernelGGL(k_lnffn, dim3(grid), dim3(NTHREADS), 0, stream, P, layer);
    }
}
```

```cpp
#include <hip/hip_runtime.h>
#include <cstdio>
#include <cstdint>

#define GAS __attribute__((address_space(1)))
#define LAS __attribute__((address_space(3)))
typedef unsigned short bf16_t;
typedef short bf16x8 __attribute__((ext_vector_type(8)));
typedef float f32x4 __attribute__((ext_vector_type(4)));
typedef unsigned u32x4 __attribute__((ext_vector_type(4)));

constexpr int BATCH = 32, SEQ = 2048, T = BATCH * SEQ, D = 1024;
constexpr int NP = 6400;
constexpr int YOFF = 1024;
constexpr int NCLS = 24, MAXTILES = 280;
constexpr float LN_EPS = 1e-5f, NORM_EPS = 1e-6f;
constexpr float ALPHA = 1.41421356237f;
constexpr int NTHREADS_C = 512;

constexpr int C0_RQ = 0, C0_RK = 512, C0_RV = 1024, C0_MV = 2048, C0_RG = 3072, C0_MQ = 4096, C0_MK = 4608, C0_MO = 5120, C0_MI = 6144, C0_MF = 6148;
constexpr int C1_GQ = 0, C1_GK = 512, C1_GV = 1024, C1_SZ = 2048, C1_GR = 3072, C1_XS = 4096, C1_BM = 5120, C1_CM = 5632, C1_GA = 6144, C1_DT = 6160;

constexpr size_t MiB = 1u << 20;
constexpr size_t WS_CTL = 0, CTL_BYTES = 1 * MiB;
constexpr size_t WS_WIN0 = 2 * MiB;
constexpr size_t WS_WIN1 = 15 * MiB;
constexpr size_t WS_WOUT0 = 28 * MiB;
constexpr size_t WS_WOUT1 = 32 * MiB;
constexpr size_t WS_WGU = 36 * MiB;
constexpr size_t WS_WD = 100 * MiB;
constexpr size_t WS_TOKCLS = 132 * MiB;
constexpr size_t WS_TOKPOS = WS_TOKCLS + (size_t)T * 4;
constexpr size_t WS_TOKDST = WS_TOKPOS + (size_t)T * 4;
constexpr size_t WS_TOKGATE = WS_TOKDST + (size_t)T * 4;
constexpr size_t WS_ROWGATE = WS_TOKGATE + (size_t)T * 8;
constexpr size_t WS_TILECLS = WS_ROWGATE + (size_t)MAXTILES * 256 * 8;
constexpr size_t WS_BIG = 136 * MiB;
constexpr size_t BIG_HS = 0, BIG_H = 160 * MiB, BIG_PRE2 = 320 * MiB;
constexpr size_t WS_END = WS_BIG + (size_t)T * NP * 2;
static_assert(WS_TILECLS + (MAXTILES + 8) * 4 <= WS_BIG, "ws map");
static_assert(WS_END <= 1024 * MiB, "ws map");
constexpr size_t OUT_H = 0, OUT_PRE1 = 128 * MiB;
constexpr int CW_CNT = 1024;
constexpr int CW_BAR = 4096;

__device__ __forceinline__ unsigned f2bf(float f) { unsigned u = __builtin_bit_cast(unsigned, f); return (u + 0x7fffu + ((u >> 16) & 1u)) >> 16; }
__device__ __forceinline__ unsigned pk2(float lo, float hi) { return f2bf(lo) | (f2bf(hi) << 16); }
__device__ __forceinline__ float bf2f(unsigned short b) { return __builtin_bit_cast(float, ((unsigned)b) << 16); }
__device__ __forceinline__ float bflo(unsigned w) { return __builtin_bit_cast(float, w << 16); }
__device__ __forceinline__ float bfhi(unsigned w) { return __builtin_bit_cast(float, w & 0xffff0000u); }
__device__ __forceinline__ float sigmoidf_(float x) { return 1.f / (1.f + __expf(-x)); }
__device__ __forceinline__ float siluf_(float x) { return x / (1.f + __expf(-x)); }
__device__ __forceinline__ float softplusf_(float x) { return x > 20.f ? x : log1pf(expf(x)); }
__device__ __forceinline__ float logsigmoidf_(float x) { return -softplusf_(-x); }
__device__ __forceinline__ float wave_sum(float v) {
#pragma unroll
    for (int o = 1; o < 64; o <<= 1) v += __shfl_xor(v, o);
    return v;
}
#define LDS_WAIT() asm volatile("s_waitcnt lgkmcnt(0)" ::: "memory")
__device__ __forceinline__ int opaque_tid() { int t = threadIdx.x; asm volatile("" : "+v"(t)); return t; }

namespace pg8 {
constexpr int BM = 256, BK = 64, HALF = 128, HTB = HALF * BK * 2, STAGE_BYTES = 8 * HTB, NXCD = 8, WGM = 8;
__host__ __device__ __forceinline__ int lds_byte(int r, int c) { const int st = (r >> 4) * 2 + (c >> 5), rr = r & 15, cc = c & 31, ob = rr * 64 + cc * 2; return st * 1024 + (ob ^ (((ob >> 9) & 1) << 5)); }
__host__ __device__ __forceinline__ void stage_rc(int b, int& R, int& C) { const int st = b / 1024, sb = b % 1024, swz = sb ^ (((sb >> 9) & 1) << 5); R = (st >> 1) * 16 + swz / 64; C = (st & 1) * 32 + (swz % 64) / 2; }
__host__ __device__ __forceinline__ int perm32(int rho) { const int n = rho >> 4, i = rho & 15; return 8 * (i >> 2) + 4 * n + (i & 3); }

struct Unit { int pm, pn; const char* a; const char* b0; const char* b1; };

__device__ __forceinline__ bool static_tile(int i, int G, int c, int nM, int nN, int& pm, int& pn) {
    const int nwg = nM * nN; const long L = (long)i * G + c; if (L >= nwg) return false;
    int wgid = (int)L; { const int q = nwg / NXCD, r = nwg % NXCD, xcd = wgid % NXCD, off = wgid / NXCD; wgid = (xcd < r ? xcd * (q + 1) : r * (q + 1) + (xcd - r) * q) + off; }
    const int nig = WGM * nN, gid = wgid / nig, fm = gid * WGM, gsz = (nM - fm) < WGM ? (nM - fm) : WGM;
    pm = fm + ((wgid % nig) % gsz); pn = (wgid % nig) / gsz; return true;
}
__device__ __forceinline__ unsigned cvt_pk_bf16(float lo, float hi) { unsigned r; asm volatile("v_cvt_pk_bf16_f32 %0, %1, %2" : "=v"(r) : "v"(lo), "v"(hi)); return r; }

template <class Epi, class Sched>
__device__ __forceinline__ void gemm_phase(LAS unsigned char* lds, const Sched& S, const Epi& E, const int K, const int lda, const int ldb) {
    const int tid = opaque_tid(), wid = __builtin_amdgcn_readfirstlane(tid >> 6), lane = tid & 63, wr = wid >> 2, wc = wid & 3, fr = lane & 15, fq = lane >> 4;
    const int nt = K / BK;
    constexpr int KS = Sched::KSPLIT;
    unsigned voffA[2], voffB[2];
#pragma unroll
    for (int i = 0; i < 2; ++i) { int R, C; stage_rc(tid * 16 + i * 8192, R, C); const int Rb = (R & ~31) + perm32(R & 31);
        voffA[i] = (unsigned)(R * lda + C) * 2u; voffB[i] = (unsigned)(Rb * ldb + C) * 2u; }
    const size_t kstep = (size_t)(BK * 2);
    const size_t hstepA = (size_t)HALF * lda * 2, hstepB = (size_t)HALF * ldb * 2;
    const unsigned ldsw = (unsigned)wid * 1024u;
    const int aoff = lds_byte(wr * 64 + fr, fq * 8), boff = lds_byte(wc * 32 + fr, fq * 8);
#define PG8_BP(u, kt) ((KS > 0 && (kt) >= KS) ? (u).b1 + (size_t)((kt) - KS) * kstep : (u).b0 + (size_t)(kt) * kstep)
#define PG8_SA(b, h) (((b) * 2 + (h)) * HTB)
#define PG8_SB(b, h) ((4 + (b) * 2 + (h)) * HTB)
#define PG8_STAGE(bufoff, gbase, voff) do { _Pragma("unroll") for (int _i = 0; _i < 2; ++_i) \
        __builtin_amdgcn_global_load_lds((const unsigned*)((const char*)(gbase) + (voff)[_i]), (LAS unsigned*)(lds + (bufoff) + ldsw + _i * 8192), 16, 0, 0); } while (0)
#define PG8_LDA(dst, b, h) do { _Pragma("unroll") for (int m = 0; m < 4; ++m) _Pragma("unroll") for (int k = 0; k < 2; ++k) dst[m][k] = *(const LAS bf16x8*)(lds + PG8_SA(b, h) + aoff + m * 2048 + k * 1024); } while (0)
#define PG8_LDB(dst, b, h) do { _Pragma("unroll") for (int n = 0; n < 2; ++n) _Pragma("unroll") for (int k = 0; k < 2; ++k) dst[n][k] = *(const LAS bf16x8*)(lds + PG8_SB(b, h) + boff + n * 2048 + k * 1024); } while (0)
#define PG8_MMA(ai, bj, At, Bt) do { __builtin_amdgcn_s_setprio(1); _Pragma("unroll") for (int m = 0; m < 4; ++m) _Pragma("unroll") for (int n = 0; n < 2; ++n) _Pragma("unroll") for (int k = 0; k < 2; ++k) \
        acc[ai][bj][m][n] = __builtin_amdgcn_mfma_f32_16x16x32_bf16(Bt[n][k], At[m][k], acc[ai][bj][m][n], 0, 0, 0); __builtin_amdgcn_s_setprio(0); } while (0)
#define PG8_WAIT_V(n) asm volatile("s_waitcnt vmcnt(" #n ")" ::: "memory")
#define PG8_WAIT_L(n) asm volatile("s_waitcnt lgkmcnt(" #n ")" ::: "memory")
#define PG8_BAR __builtin_amdgcn_s_barrier()
#define PG8_SCHED __builtin_amdgcn_sched_barrier(0)
    Unit cur, nxt; int ui = 0;
    if (!S.next(0, cur)) return;
    f32x4 acc[2][2][4][2];
#pragma unroll
    for (int a = 0; a < 2; ++a)
#pragma unroll
        for (int b = 0; b < 2; ++b)
#pragma unroll
            for (int m = 0; m < 4; ++m)
#pragma unroll
                for (int n = 0; n < 2; ++n) acc[a][b][m][n] = (f32x4){0.f, 0.f, 0.f, 0.f};
    bf16x8 At[4][2], B0[2][2], B1[2][2];
    const char* cA = cur.a;
    { const char* cB0 = PG8_BP(cur, 0); const char* cB1 = PG8_BP(cur, 1);
    PG8_STAGE(PG8_SB(0, 0), cB0, voffB); PG8_STAGE(PG8_SA(0, 0), cA, voffA); PG8_STAGE(PG8_SB(0, 1), cB0 + hstepB, voffB); PG8_STAGE(PG8_SA(0, 1), cA + hstepA, voffA);
    if (wr == 1) PG8_BAR;
    PG8_WAIT_V(4); PG8_BAR;
    PG8_STAGE(PG8_SB(1, 0), cB1, voffB); PG8_STAGE(PG8_SA(1, 0), cA + kstep, voffA); PG8_STAGE(PG8_SB(1, 1), cB1 + hstepB, voffB);
    PG8_WAIT_V(6); PG8_BAR; }
    for (;;) {
        const bool has_next = S.next(ui + 1, nxt);
        if (!has_next) nxt = cur;
        for (int t = 0; t < nt; t += 2) {
            const bool last = (t == nt - 2);
            const char* a1 = cA + (size_t)(t + 1) * kstep;
            const char* a2 = last ? nxt.a : cA + (size_t)(t + 2) * kstep;
            const char* b2 = last ? PG8_BP(nxt, 0) : PG8_BP(cur, t + 2);
            const char* a3 = a2 + kstep;
            const char* b3 = last ? PG8_BP(nxt, 1) : PG8_BP(cur, t + 3);
            PG8_LDB(B0, 0, 0); PG8_SCHED; PG8_LDA(At, 0, 0); PG8_STAGE(PG8_SA(1, 1), a1 + hstepA, voffA);
            PG8_WAIT_L(8); PG8_BAR; PG8_WAIT_L(0); PG8_MMA(0, 0, At, B0); PG8_BAR; PG8_SCHED;
            PG8_LDB(B1, 0, 1); PG8_STAGE(PG8_SB(0, 0), b2, voffB);
            PG8_BAR; PG8_WAIT_L(0); PG8_MMA(0, 1, At, B1); PG8_BAR;
            PG8_LDA(At, 0, 1); PG8_STAGE(PG8_SA(0, 0), a2, voffA);
            PG8_BAR; PG8_WAIT_L(0); PG8_MMA(1, 0, At, B0); PG8_BAR; PG8_SCHED;
            PG8_STAGE(PG8_SB(0, 1), b2 + hstepB, voffB);
            PG8_WAIT_V(6); PG8_BAR; PG8_MMA(1, 1, At, B1); PG8_BAR;
            PG8_LDB(B0, 1, 0); PG8_SCHED; PG8_LDA(At, 1, 0); PG8_STAGE(PG8_SA(0, 1), a2 + hstepA, voffA);
            PG8_WAIT_L(8); PG8_BAR; PG8_WAIT_L(0); PG8_MMA(0, 0, At, B0); PG8_BAR; PG8_SCHED;
            PG8_LDB(B1, 1, 1); PG8_STAGE(PG8_SB(1, 0), b3, voffB);
            PG8_BAR; PG8_WAIT_L(0); PG8_MMA(0, 1, At, B1); PG8_BAR;
            PG8_LDA(At, 1, 1); PG8_STAGE(PG8_SA(1, 0), a3, voffA);
            PG8_BAR; PG8_WAIT_L(0); PG8_MMA(1, 0, At, B0); PG8_BAR; PG8_SCHED;
            PG8_STAGE(PG8_SB(1, 1), b3 + hstepB, voffB);
            PG8_WAIT_V(6); PG8_BAR; PG8_MMA(1, 1, At, B1); PG8_BAR;
        }
        E(acc, cur, wr, wc, fr, fq);
        if (!has_next) break;
#pragma unroll
        for (int a = 0; a < 2; ++a)
#pragma unroll
            for (int b = 0; b < 2; ++b)
#pragma unroll
                for (int m = 0; m < 4; ++m)
#pragma unroll
                    for (int n = 0; n < 2; ++n) acc[a][b][m][n] = (f32x4){0.f, 0.f, 0.f, 0.f};
        cur = nxt; cA = cur.a; ++ui;
    }
    PG8_WAIT_V(0);
    if (wr == 0) PG8_BAR;
    PG8_BAR;
#undef PG8_BP
#undef PG8_SA
#undef PG8_SB
#undef PG8_STAGE
#undef PG8_LDA
#undef PG8_LDB
#undef PG8_MMA
#undef PG8_WAIT_V
#undef PG8_WAIT_L
#undef PG8_BAR
#undef PG8_SCHED
}

struct SchedPlain {
    static constexpr int KSPLIT = 0;
    const char* A; const char* B; int lda, ldb, nM, nN, G, c;
    __device__ __forceinline__ bool next(int i, Unit& u) const {
        if (!static_tile(i, G, c, nM, nN, u.pm, u.pn)) return false;
        u.a = A + (size_t)u.pm * BM * lda * 2; u.b0 = B + (size_t)u.pn * BM * ldb * 2; u.b1 = u.b0; return true;
    }
};
__device__ __forceinline__ void cls_experts(int cls, int& e0, int& e1) {
    const int g = cls / 6, p = cls % 6;
    const int a = p < 3 ? 0 : (p < 5 ? 1 : 2);
    const int b = p < 3 ? p + 1 : (p < 5 ? p - 1 : 3);
    e0 = 4 * g + a; e1 = 4 * g + b;
}
struct SchedMoeA {
    static constexpr int KSPLIT = 0;
    const char* A; const char* Wgu; const int* tilecls; int nM, G, c;
    __device__ __forceinline__ bool next(int i, Unit& u) const {
        if (!static_tile(i, G, c, nM, 8, u.pm, u.pn)) return false;
        int e0, e1; cls_experts(tilecls[8 + u.pm], e0, e1); const int e = (u.pn >> 2) ? e1 : e0;
        u.a = A + (size_t)u.pm * BM * 1024 * 2; u.b0 = Wgu + ((size_t)e * 1024 + (size_t)(u.pn & 3) * 256) * 1024 * 2; u.b1 = u.b0; return true;
    }
};
struct SchedMoeB {
    static constexpr int KSPLIT = 8;
    const char* A; const char* Wd; const int* tilecls; int nM, G, c;
    __device__ __forceinline__ bool next(int i, Unit& u) const {
        if (!static_tile(i, G, c, nM, 4, u.pm, u.pn)) return false;
        int e0, e1; cls_experts(tilecls[8 + u.pm], e0, e1);
        u.a = A + (size_t)u.pm * BM * 1024 * 2;
        u.b0 = Wd + ((size_t)e0 * 1024 + (size_t)u.pn * 256) * 512 * 2; u.b1 = Wd + ((size_t)e1 * 1024 + (size_t)u.pn * 256) * 512 * 2; return true;
    }
};

struct EpiStore {
    bf16_t* O; int ldc;
    __device__ __forceinline__ void operator()(const f32x4 (&acc)[2][2][4][2], const Unit& u, int wr, int wc, int fr, int fq) const {
        const int row0 = u.pm * BM + wr * 64 + fr, col0 = u.pn * BM + wc * 32 + 8 * fq;
#pragma unroll
        for (int ai = 0; ai < 2; ++ai)
#pragma unroll
            for (int m = 0; m < 4; ++m) { bf16_t* rowp = O + (size_t)(row0 + ai * HALF + m * 16) * ldc + col0;
#pragma unroll
                for (int bj = 0; bj < 2; ++bj) { const f32x4 v0 = acc[ai][bj][m][0], v1 = acc[ai][bj][m][1];
                    u32x4 w; w.x = cvt_pk_bf16(v0[0], v0[1]); w.y = cvt_pk_bf16(v0[2], v0[3]); w.z = cvt_pk_bf16(v1[0], v1[1]); w.w = cvt_pk_bf16(v1[2], v1[3]);
                    *(u32x4*)(rowp + bj * HALF) = w; } }
    }
};
struct EpiResid {
    bf16_t* O; const bf16_t* R;
    __device__ __forceinline__ void operator()(const f32x4 (&acc)[2][2][4][2], const Unit& u, int wr, int wc, int fr, int fq) const {
        const int row0 = u.pm * BM + wr * 64 + fr, col0 = u.pn * BM + wc * 32 + 8 * fq;
#pragma unroll
        for (int ai = 0; ai < 2; ++ai)
#pragma unroll
            for (int m = 0; m < 4; ++m) { const size_t off = (size_t)(row0 + ai * HALF + m * 16) * 1024 + col0;
#pragma unroll
                for (int bj = 0; bj < 2; ++bj) { const f32x4 v0 = acc[ai][bj][m][0], v1 = acc[ai][bj][m][1];
                    const u32x4 r = *(const u32x4*)(R + off + bj * HALF);
                    u32x4 w; w.x = cvt_pk_bf16(v0[0] + ALPHA * bflo(r.x), v0[1] + ALPHA * bfhi(r.x)); w.y = cvt_pk_bf16(v0[2] + ALPHA * bflo(r.y), v0[3] + ALPHA * bfhi(r.y));
                    w.z = cvt_pk_bf16(v1[0] + ALPHA * bflo(r.z), v1[1] + ALPHA * bfhi(r.z)); w.w = cvt_pk_bf16(v1[2] + ALPHA * bflo(r.w), v1[3] + ALPHA * bfhi(r.w));
                    *(u32x4*)(O + off + bj * HALF) = w; } }
    }
};
struct EpiSwiglu {
    bf16_t* H; const float* rowgate;
    __device__ __forceinline__ void operator()(const f32x4 (&acc)[2][2][4][2], const Unit& u, int wr, int wc, int fr, int fq) const {
        const int row0 = u.pm * BM + wr * 64 + fr, ke = u.pn >> 2, col0 = 512 * ke + 128 * (u.pn & 3) + wc * 32 + 8 * fq;
#pragma unroll
        for (int ai = 0; ai < 2; ++ai)
#pragma unroll
            for (int m = 0; m < 4; ++m) { const int row = row0 + ai * HALF + m * 16; const float gt = rowgate[(size_t)row * 2 + ke];
                const f32x4 g0 = acc[ai][0][m][0], g1 = acc[ai][0][m][1], u0 = acc[ai][1][m][0], u1 = acc[ai][1][m][1];
                float o[8];
#pragma unroll
                for (int j = 0; j < 4; ++j) { o[j] = siluf_(g0[j]) * u0[j] * gt; o[4 + j] = siluf_(g1[j]) * u1[j] * gt; }
                u32x4 w; w.x = cvt_pk_bf16(o[0], o[1]); w.y = cvt_pk_bf16(o[2], o[3]); w.z = cvt_pk_bf16(o[4], o[5]); w.w = cvt_pk_bf16(o[6], o[7]);
                *(u32x4*)(H + (size_t)row * 1024 + col0) = w; }
    }
};
}

struct Params {
    const float* in[30];
    unsigned char* out;
    unsigned char* ws;
};
enum { I_X = 0, I_POS, I_WINAB, I_RETG, I_MLCW, I_MLCB, I_MLBI, I_MLBF, I_MLG, I_WOUTAB, I_WINCD, I_GLAWA, I_GLABA, I_GLAG, I_SSDCW, I_SSDCB, I_SSDDTB, I_SSDALOG, I_SSDD, I_SSDG,
       I_WOUTCD, I_WR, I_BR, I_MOEG, I_MOEU, I_MOED, I_LNMG, I_LNMB, I_LNFG, I_LNFB };

template <class ColPtr>
__device__ __forceinline__ void tr_item(const ColPtr& cp, int ldw, bf16_t* WT, int ldt, int n0, int k0, LAS float* scr, int lane) {
    const float* p = cp(n0 + (lane & 31));
#pragma unroll 8
    for (int i = 0; i < 32; ++i) { const int kk = 2 * i + (lane >> 5); scr[kk * 33 + (lane & 31)] = p ? p[(size_t)(k0 + kk) * ldw] : 0.f; }
    LDS_WAIT();
    const int c = lane & 7;
#pragma unroll
    for (int j = 0; j < 4; ++j) { const int n = (lane >> 3) + 8 * j; const LAS float* s = scr + (8 * c) * 33 + n;
        u32x4 o; o.x = pk2(s[0 * 33], s[1 * 33]); o.y = pk2(s[2 * 33], s[3 * 33]); o.z = pk2(s[4 * 33], s[5 * 33]); o.w = pk2(s[6 * 33], s[7 * 33]);
        *(u32x4*)(WT + (size_t)(n0 + n) * ldt + k0 + 8 * c) = o; }
    LDS_WAIT();
}
__device__ __forceinline__ int map_ab(int n) {
    if (n < 2048) return n;
    if (n < 3072) return 4096 + (n - 2048);
    if (n < 4096) return 2048 + (n - 3072);
    if (n < 4608) return 3072 + (n - 4096);
    if (n < 5120) return 3584 + (n - 4608);
    if (n < 6152) return n;
    return -1;
}
__device__ __forceinline__ int map_cd(int n) {
    if (n < 2048) return n;
    if (n < 3072) return 3088 + (n - 2048);
    if (n < 4096) return 2048 + (n - 3072);
    if (n < 5120) return 4112 + (n - 4096);
    if (n < 5632) return 5136 + (n - 5120);
    if (n < 6144) return 5648 + (n - 5632);
    if (n < 6160) return 3072 + (n - 6144);
    if (n < 6176) return 6160 + (n - 6160);
    return -1;
}
__device__ __forceinline__ void phase_convert(const Params& P, LAS unsigned char* lds, int bid, int nb) {
    const int tid = opaque_tid(), lane = tid & 63, wave = tid >> 6, nw = blockDim.x >> 6;
    LAS float* scr = (LAS float*)(lds + wave * 16384);
    const int gw = bid * nw + wave, NGW = nb * nw;
    unsigned char* ws = P.ws;
    constexpr int I_IN = (NP / 32) * (D / 64);
    constexpr int I_OUT = (1024 / 32) * (2048 / 64);
    constexpr int I_GU = (1024 / 32) * (1024 / 64);
    constexpr int I_DN = (1024 / 32) * (512 / 64);
    constexpr int NITEMS = 2 * I_IN + 2 * I_OUT + 32 * I_GU + 32 * I_DN;
    for (int it = gw; it < NITEMS; it += NGW) {
        int r = it;
        if (r < 2 * I_IN) { const int l = r / I_IN; r %= I_IN; const int nbk = r / (D / 64), kb = r % (D / 64);
            const float* W = P.in[l ? I_WINCD : I_WINAB]; const int ldw = l ? 6176 : 6152;
            if (l == 0) tr_item([&](int n) { const int s = map_ab(n); return s < 0 ? (const float*)nullptr : W + s; }, ldw, (bf16_t*)(ws + WS_WIN0), D, nbk * 32, kb * 64, scr, lane);
            else        tr_item([&](int n) { const int s = map_cd(n); return s < 0 ? (const float*)nullptr : W + s; }, ldw, (bf16_t*)(ws + WS_WIN1), D, nbk * 32, kb * 64, scr, lane);
            continue; }
        r -= 2 * I_IN;
        if (r < 2 * I_OUT) { const int l = r / I_OUT; r %= I_OUT; const int nbk = r / 32, kb = r % 32;
            const float* W = P.in[l ? I_WOUTCD : I_WOUTAB];
            tr_item([&](int n) { return W + n; }, 1024, (bf16_t*)(ws + (l ? WS_WOUT1 : WS_WOUT0)), 2048, nbk * 32, kb * 64, scr, lane);
            continue; }
        r -= 2 * I_OUT;
        if (r < 32 * I_GU) { const int le = r / I_GU; r %= I_GU; const int nbk = r / 16, kb = r % 16;
            const int n0 = nbk * 32, j = n0 >> 8, w = n0 & 255;
            const float* W = (w < 128 ? P.in[I_MOEG] : P.in[I_MOEU]) + (size_t)le * 1024 * 512 + 128 * j + (w & 127) - n0;
            tr_item([&](int n) { return W + n; }, 512, (bf16_t*)(ws + WS_WGU) + (size_t)le * 1024 * 1024, 1024, n0, kb * 64, scr, lane);
            continue; }
        r -= 32 * I_GU;
        { const int le = r / I_DN; r %= I_DN; const int nbk = r / 8, kb = r % 8;
            const float* W = P.in[I_MOED] + (size_t)le * 512 * 1024;
            tr_item([&](int n) { return W + n; }, 1024, (bf16_t*)(ws + WS_WD) + (size_t)le * 1024 * 512, 512, nbk * 32, kb * 64, scr, lane); }
    }
    const float* x = P.in[I_X]; bf16_t* h = (bf16_t*)(P.out + OUT_H);
    const size_t n8 = (size_t)T * D / 8;
    for (size_t i = (size_t)bid * blockDim.x + tid; i < n8; i += (size_t)nb * blockDim.x) {
        const f32x4 a = *(const f32x4*)(x + i * 8), b = *(const f32x4*)(x + i * 8 + 4);
        u32x4 o; o.x = pk2(a[0], a[1]); o.y = pk2(a[2], a[3]); o.z = pk2(b[0], b[1]); o.w = pk2(b[2], b[3]);
        *(u32x4*)(h + i * 8) = o;
    }
}

__device__ __forceinline__ void load_row_bf16(const bf16_t* row, int lane, float (&v)[16]) {
#pragma unroll
    for (int j = 0; j < 2; ++j) { const u32x4 w = *(const u32x4*)(row + 8 * lane + 512 * j);
        v[8 * j + 0] = bflo(w.x); v[8 * j + 1] = bfhi(w.x); v[8 * j + 2] = bflo(w.y); v[8 * j + 3] = bfhi(w.y);
        v[8 * j + 4] = bflo(w.z); v[8 * j + 5] = bfhi(w.z); v[8 * j + 6] = bflo(w.w); v[8 * j + 7] = bfhi(w.w); }
}
__device__ __forceinline__ void ln_row(float (&v)[16], const float* g, const float* b, int lane) {
    float s = 0.f;
#pragma unroll
    for (int i = 0; i < 16; ++i) s += v[i];
    const float mean = wave_sum(s) * (1.f / D); float q = 0.f;
#pragma unroll
    for (int i = 0; i < 16; ++i) { v[i] -= mean; q += v[i] * v[i]; }
    const float rstd = rsqrtf(wave_sum(q) * (1.f / D) + LN_EPS);
#pragma unroll
    for (int j = 0; j < 2; ++j) {
        const f32x4 g0 = *(const f32x4*)(g + 8 * lane + 512 * j), g1 = *(const f32x4*)(g + 8 * lane + 512 * j + 4);
        const f32x4 b0 = *(const f32x4*)(b + 8 * lane + 512 * j), b1 = *(const f32x4*)(b + 8 * lane + 512 * j + 4);
#pragma unroll
        for (int i = 0; i < 4; ++i) { v[8 * j + i] = v[8 * j + i] * rstd * g0[i] + b0[i]; v[8 * j + 4 + i] = v[8 * j + 4 + i] * rstd * g1[i] + b1[i]; }
    }
}
__device__ __forceinline__ void store_row_bf16(bf16_t* row, int lane, const float (&v)[16]) {
#pragma unroll
    for (int j = 0; j < 2; ++j) { u32x4 o; o.x = pk2(v[8 * j + 0], v[8 * j + 1]); o.y = pk2(v[8 * j + 2], v[8 * j + 3]); o.z = pk2(v[8 * j + 4], v[8 * j + 5]); o.w = pk2(v[8 * j + 6], v[8 * j + 7]);
        *(u32x4*)(row + 8 * lane + 512 * j) = o; }
}

__device__ __forceinline__ void phase_route(const Params& P, int layer, LAS unsigned char* lds, int bid, int nb) {
    const int tid = opaque_tid(), lane = tid & 63, wave = tid >> 6;
    LAS unsigned char* Bhi = lds; LAS unsigned char* Blo = lds + 32768;
    LAS float* cd = (LAS float*)(lds + 65536);
    LAS float* part = cd + 32;
    LAS int* lcnt = (LAS int*)(part + 1024);
    LAS int* lbase = lcnt + 32; LAS int* rcls = lbase + 32; LAS int* rpos = rcls + 256;
    const bf16_t* pre1 = (const bf16_t*)(P.out + OUT_PRE1);
    const float* g = P.in[I_LNMG] + layer * D; const float* b = P.in[I_LNMB] + layer * D;
    const float* Wr = P.in[I_WR]; const float* br = P.in[I_BR];
    int* tokcls = (int*)(P.ws + WS_TOKCLS); int* tokpos = (int*)(P.ws + WS_TOKPOS); float* tokgate = (float*)(P.ws + WS_TOKGATE);
    unsigned* gcnt = (unsigned*)(P.ws + WS_CTL) + CW_CNT + 64 * layer;
#pragma unroll 1
    for (int idx = tid; idx < 2048; idx += NTHREADS_C) {
        const int s = idx >> 6, l = idx & 63, e = l & 15, k0 = 32 * s + 8 * (l >> 4);
        unsigned hi[4], lo[4];
#pragma unroll
        for (int j = 0; j < 4; ++j) {
            const float w0 = g[k0 + 2 * j] * Wr[(k0 + 2 * j) * 16 + e], w1 = g[k0 + 2 * j + 1] * Wr[(k0 + 2 * j + 1) * 16 + e];
            const unsigned h0 = f2bf(w0), h1 = f2bf(w1);
            hi[j] = h0 | (h1 << 16); lo[j] = pk2(w0 - bf2f((unsigned short)h0), w1 - bf2f((unsigned short)h1)); }
        *(LAS u32x4*)(Bhi + idx * 16) = (u32x4){hi[0], hi[1], hi[2], hi[3]};
        *(LAS u32x4*)(Blo + idx * 16) = (u32x4){lo[0], lo[1], lo[2], lo[3]};
    }
    { const int e = tid & 15, pt = tid >> 4; float cs = 0.f, ds = 0.f;
#pragma unroll 4
      for (int kk = 0; kk < 32; ++kk) { const int k = pt * 32 + kk; const float w = Wr[k * 16 + e]; cs += g[k] * w; ds += b[k] * w; }
      part[pt * 32 + e] = cs; part[pt * 32 + 16 + e] = ds; }
    __syncthreads();
    if (tid < 32) { float sacc = 0.f;
#pragma unroll 4
        for (int pt = 0; pt < 32; ++pt) sacc += part[pt * 32 + tid];
        cd[tid] = sacc; }
    __syncthreads();
    const int e = lane & 15, q = lane >> 4;
    const float ce = cd[e], de = cd[16 + e], bre = br[e];
    for (int r0 = bid * 256; r0 < T; r0 += nb * 256) {
        if (tid < 32) lcnt[tid] = 0;
        __syncthreads();
#pragma unroll 1
        for (int tile = 0; tile < 2; ++tile) {
            const int tr0 = wave * 32 + tile * 16;
            const bf16_t* arow = pre1 + (size_t)(r0 + tr0 + e) * D + 8 * q;
            f32x4 acc = (f32x4){0.f, 0.f, 0.f, 0.f}; float s1 = 0.f, s2 = 0.f;
#pragma unroll 1
            for (int s0 = 0; s0 < 32; s0 += 8) {
                u32x4 a[8];
#pragma unroll
                for (int u = 0; u < 8; ++u) a[u] = *(const u32x4*)(arow + 32 * (s0 + u));
#pragma unroll
                for (int u = 0; u < 8; ++u) {
                    const bf16x8 bh = *(const LAS bf16x8*)(Bhi + ((s0 + u) * 64 + lane) * 16), bl = *(const LAS bf16x8*)(Blo + ((s0 + u) * 64 + lane) * 16);
                    const bf16x8 af = __builtin_bit_cast(bf16x8, a[u]);
                    acc = __builtin_amdgcn_mfma_f32_16x16x32_bf16(af, bh, acc, 0, 0, 0);
                    acc = __builtin_amdgcn_mfma_f32_16x16x32_bf16(af, bl, acc, 0, 0, 0);
                    const float x0 = bflo(a[u].x), x1 = bfhi(a[u].x), x2 = bflo(a[u].y), x3 = bfhi(a[u].y), x4 = bflo(a[u].z), x5 = bfhi(a[u].z), x6 = bflo(a[u].w), x7 = bfhi(a[u].w);
                    s1 += ((x0 + x1) + (x2 + x3)) + ((x4 + x5) + (x6 + x7));
                    s2 += ((x0 * x0 + x1 * x1) + (x2 * x2 + x3 * x3)) + ((x4 * x4 + x5 * x5) + (x6 * x6 + x7 * x7));
                }
            }
            s1 += __shfl_xor(s1, 16); s1 += __shfl_xor(s1, 32); s2 += __shfl_xor(s2, 16); s2 += __shfl_xor(s2, 32);
            const float mean = s1 * (1.f / D); const float rstd = rsqrtf(fmaxf(s2 * (1.f / D) - mean * mean, 0.f) + LN_EPS);
#pragma unroll
            for (int r = 0; r < 4; ++r) {
                const int R = 4 * q + r;
                const float mr = __shfl(mean, R), rr = __shfl(rstd, R);
                const float lg = rr * (acc[r] - mr * ce) + de;
                float mx = lg;
#pragma unroll
                for (int o = 1; o < 16; o <<= 1) mx = fmaxf(mx, __shfl_xor(mx, o));
                float p = expf(lg - mx), sum = p;
#pragma unroll
                for (int o = 1; o < 16; o <<= 1) sum += __shfl_xor(sum, o);
                p = p / sum;
                const float sel = p + bre;
                int rank = 0;
#pragma unroll
                for (int o = 1; o < 4; ++o) { const float so = __shfl_xor(sel, o); const int eo = e ^ o; rank += (so > sel || (so == sel && eo < e)) ? 1 : 0; }
                float gs = rank < 2 ? sel : 0.f;
                gs += __shfl_xor(gs, 1); gs += __shfl_xor(gs, 2);
                int gi = e >> 2;
#pragma unroll
                for (int o = 4; o < 16; o <<= 1) { const float go = __shfl_xor(gs, o); const int io = __shfl_xor(gi, o); if (go > gs || (go == gs && io < gi)) { gs = go; gi = io; } }
                const bool chosen = ((e >> 2) == gi) && rank < 2;
                const unsigned long long bm = __ballot(chosen);
                const unsigned m4 = (unsigned)(bm >> (16 * q + 4 * gi)) & 0xFu;
                const int ea = __ffs((int)m4) - 1, eb = 31 - __clz((int)m4);
                const int pidx = ea == 0 ? eb - 1 : (ea == 1 ? eb + 1 : 5);
                const float pa = __shfl(p, 16 * q + 4 * gi + ea), pb = __shfl(p, 16 * q + 4 * gi + eb);
                if (e == r) { const int cls = gi * 6 + pidx; const int rl = tr0 + R; const int lp = atomicAdd((int*)&lcnt[cls], 1); rcls[rl] = cls; rpos[rl] = lp;
                    const float inv = 1.f / (pa + pb); const size_t t = (size_t)(r0 + rl); tokgate[t * 2] = pa * inv; tokgate[t * 2 + 1] = pb * inv; }
            }
        }
        __syncthreads();
        if (tid < NCLS) lbase[tid] = (int)atomicAdd(&gcnt[tid], (unsigned)lcnt[tid]);
        __syncthreads();
        if (tid < 256) { const int t = r0 + tid; const int c = rcls[tid]; tokcls[t] = c; tokpos[t] = lbase[c] + rpos[tid]; }
        __syncthreads();
    }
}
__device__ __forceinline__ void phase_permute(const Params& P, int layer, LAS unsigned char* lds, int bid, int nb) {
    const int tid = opaque_tid(), lane = tid & 63, wave = tid >> 6, nw = blockDim.x >> 6;
    LAS int* off = (LAS int*)lds;
    const unsigned* gcnt = (const unsigned*)(P.ws + WS_CTL) + CW_CNT + 64 * layer;
    int* tilecls = (int*)(P.ws + WS_TILECLS);
    if (tid == 0) { int o = 0; for (int c = 0; c < NCLS; ++c) { off[c] = o * 256; const int nt = ((int)gcnt[c] + 255) >> 8;
            if (bid == 0) for (int i = 0; i < nt; ++i) tilecls[8 + o + i] = c;
            o += nt; }
        if (bid == 0) tilecls[0] = o; }
    __syncthreads();
    const bf16_t* pre1 = (const bf16_t*)(P.out + OUT_PRE1); bf16_t* hs = (bf16_t*)(P.ws + WS_BIG + BIG_HS);
    const float* g = P.in[I_LNMG] + layer * D; const float* b = P.in[I_LNMB] + layer * D;
    const int* tokcls = (const int*)(P.ws + WS_TOKCLS); const int* tokpos = (const int*)(P.ws + WS_TOKPOS); int* tokdst = (int*)(P.ws + WS_TOKDST);
    const float* tokgate = (const float*)(P.ws + WS_TOKGATE); float* rowgate = (float*)(P.ws + WS_ROWGATE);
    for (int t = bid * nw + wave; t < T; t += nb * nw) {
        const int dst = off[tokcls[t]] + tokpos[t];
        float v[16]; load_row_bf16(pre1 + (size_t)t * D, lane, v); ln_row(v, g, b, lane);
        store_row_bf16(hs + (size_t)dst * D, lane, v);
        if (lane == 0) { tokdst[t] = dst; rowgate[(size_t)dst * 2] = tokgate[(size_t)t * 2]; rowgate[(size_t)dst * 2 + 1] = tokgate[(size_t)t * 2 + 1]; }
    }
}
__device__ __forceinline__ void phase_lnffn(const Params& P, int layer, int bid, int nb) {
    const int tid = opaque_tid(), lane = tid & 63, wave = tid >> 6, nw = blockDim.x >> 6;
    const bf16_t* pre2 = (const bf16_t*)(P.ws + WS_BIG + BIG_PRE2);
    const float* g = P.in[I_LNFG] + layer * D; const float* b = P.in[I_LNFB] + layer * D;
    const int* tokdst = (const int*)(P.ws + WS_TOKDST);
    for (int t = bid * nw + wave; t < T; t += nb * nw) {
        float v[16]; load_row_bf16(pre2 + (size_t)tokdst[t] * D, lane, v); ln_row(v, g, b, lane);
        if (layer == 0) store_row_bf16((bf16_t*)(P.out + OUT_H) + (size_t)t * D, lane, v);
        else { float* o = (float*)P.out + (size_t)t * D;
#pragma unroll
            for (int j = 0; j < 2; ++j) { *(f32x4*)(o + 8 * lane + 512 * j) = (f32x4){v[8 * j], v[8 * j + 1], v[8 * j + 2], v[8 * j + 3]}; *(f32x4*)(o + 8 * lane + 512 * j + 4) = (f32x4){v[8 * j + 4], v[8 * j + 5], v[8 * j + 6], v[8 * j + 7]}; } }
    }
}

__device__ __forceinline__ float block_sum512(float a, LAS float* red, int tid) {
    a = wave_sum(a);
    if ((tid & 63) == 0) red[tid >> 6] = a;
    __syncthreads();
    const float r = ((red[0] + red[1]) + (red[2] + red[3])) + ((red[4] + red[5]) + (red[6] + red[7]));
    __syncthreads();
    return r;
}
__device__ __forceinline__ void mix_ret_naive(const Params& P, int b, int h, LAS unsigned char* lds) {
    LAS float* qs = (LAS float*)lds; LAS float* ks = qs + 128; LAS float* yp = qs + 384; LAS float* red = qs + 896;
    const int tid = opaque_tid(), v = tid & 255, hf = tid >> 8;
    bf16_t* proj = (bf16_t*)(P.ws + WS_BIG); const int* pos = (const int*)P.in[I_POS];
    const float gamma = 1.f - exp2f(-5.f - (float)h);
    const float gn = P.in[I_RETG][h * 256 + v];
    float S[64];
#pragma unroll
    for (int d = 0; d < 64; ++d) S[d] = 0.f;
    for (int t = 0; t < SEQ; ++t) {
        bf16_t* row = proj + (size_t)(b * SEQ + t) * NP;
        if (tid < 64) { const float inv = exp2f(-(float)(2 * tid) * (13.287712379549449f / 128.f)); const float ang = (float)pos[b * SEQ + t] * inv; float sn, cs; sincosf(ang, &sn, &cs);
            const float q0 = bf2f(row[C0_RQ + h * 128 + 2 * tid]), q1 = bf2f(row[C0_RQ + h * 128 + 2 * tid + 1]);
            const float k0 = bf2f(row[C0_RK + h * 128 + 2 * tid]), k1 = bf2f(row[C0_RK + h * 128 + 2 * tid + 1]);
            qs[2 * tid] = q0 * cs - q1 * sn; qs[2 * tid + 1] = q0 * sn + q1 * cs;
            ks[2 * tid] = (k0 * cs - k1 * sn) * 0.08838834764831845f; ks[2 * tid + 1] = (k0 * sn + k1 * cs) * 0.08838834764831845f; }
        __syncthreads();
        const float vv = bf2f(row[C0_RV + h * 256 + v]); float y = 0.f;
#pragma unroll
        for (int d = 0; d < 64; ++d) { S[d] = gamma * S[d] + ks[64 * hf + d] * vv; y += qs[64 * hf + d] * S[d]; }
        yp[tid] = y;
        __syncthreads();
        const float yt = hf == 0 ? yp[v] + yp[v + 256] : 0.f;
        const float mean = block_sum512(yt, red, tid) * (1.f / 256.f); const float dv = hf == 0 ? yt - mean : 0.f;
        const float var = block_sum512(dv * dv, red, tid) * (1.f / 256.f);
        if (hf == 0) row[C0_RV + h * 256 + v] = (bf16_t)f2bf(dv * rsqrtf(var + NORM_EPS) * gn * siluf_(bf2f(row[C0_RG + h * 256 + v])));
    }
}
__device__ __forceinline__ void mix_ml_naive(const Params& P, int b, int h, LAS unsigned char* lds) {
    LAS float* qs = (LAS float*)lds; LAS float* ks = qs + 128; LAS float* yp = qs + 384; LAS float* red = qs + 896;
    const int tid = opaque_tid(), v = tid & 255, hf = tid >> 8;
    bf16_t* proj = (bf16_t*)(P.ws + WS_BIG);
    const float* cw = P.in[I_MLCW]; const float* cb = P.in[I_MLCB];
    const float bi = P.in[I_MLBI][h], bfg = P.in[I_MLBF][h];
    const float gn = P.in[I_MLG][h * 256 + v];
    float S[64];
#pragma unroll
    for (int d = 0; d < 64; ++d) S[d] = 0.f;
    float nst = 0.f;
    for (int t = 0; t < SEQ; ++t) {
        bf16_t* row = proj + (size_t)(b * SEQ + t) * NP;
        if (tid < 256) { const int c = tid & 127, isk = tid >> 7; const int ch = isk * 512 + h * 128 + c; const int col = (isk ? C0_MK : C0_MQ) + h * 128 + c; float a = cb[ch];
#pragma unroll
            for (int j = 0; j < 4; ++j) { const int tt = t - 3 + j; if (tt >= 0) a += cw[j * 1024 + ch] * bf2f(proj[(size_t)(b * SEQ + tt) * NP + col]); }
            a = siluf_(a); if (isk) ks[c] = a * 0.08838834764831845f; else qs[c] = a; }
        __syncthreads();
        const float ip = bf2f(row[C0_MI + h]) + bi, fp = bf2f(row[C0_MF + h]) + bfg;
        const float f = sigmoidf_(fp), ei = expf(ip);
        const float vv = bf2f(row[C0_MV + h * 256 + v]); float num = 0.f;
#pragma unroll
        for (int d = 0; d < 64; ++d) { S[d] = f * S[d] + (ei * ks[64 * hf + d]) * vv; num += qs[64 * hf + d] * S[d]; }
        yp[tid] = num;
        float part = 0.f;
        if (tid < 128) { nst = f * nst + ei * ks[tid]; part = qs[tid] * nst; }
        const float den = block_sum512(part, red, tid);
        float hv = 0.f;
        if (hf == 0) { hv = (yp[v] + yp[v + 256]) / fmaxf(fabsf(den), 1.f); hv *= sigmoidf_(bf2f(row[C0_MO + h * 256 + v])); }
        const float mean = block_sum512(hv, red, tid) * (1.f / 256.f); const float dv = hf == 0 ? hv - mean : 0.f;
        const float var = block_sum512(dv * dv, red, tid) * (1.f / 256.f);
        if (hf == 0) row[C0_MV + h * 256 + v] = (bf16_t)f2bf(dv * rsqrtf(var + NORM_EPS) * gn);
    }
}
__device__ __forceinline__ void mix_gla_naive(const Params& P, int b, int h, LAS unsigned char* lds) {
    LAS float* qs = (LAS float*)lds; LAS float* ks = qs + 128; LAS float* al = qs + 256; LAS float* yp = qs + 384; LAS float* red = qs + 896;
    const int tid = opaque_tid(), v = tid & 255, hf = tid >> 8;
    bf16_t* proj = (bf16_t*)(P.ws + WS_BIG);
    const float* wa = P.in[I_GLAWA]; const float* ba = P.in[I_GLABA];
    const float gn = P.in[I_GLAG][h * 256 + v];
    float S[64];
#pragma unroll
    for (int d = 0; d < 64; ++d) S[d] = 0.f;
    for (int t = 0; t < SEQ; ++t) {
        bf16_t* row = proj + (size_t)(b * SEQ + t) * NP;
        if (tid < 128) { const int ch = h * 128 + tid; float a = ba[ch];
#pragma unroll
            for (int r = 0; r < 16; ++r) a += bf2f(row[C1_GA + r]) * wa[r * 512 + ch];
            al[tid] = expf(logsigmoidf_(a) * (1.f / 16.f));
            qs[tid] = bf2f(row[C1_GQ + ch]) * 0.08838834764831845f; ks[tid] = bf2f(row[C1_GK + ch]); }
        __syncthreads();
        const float vv = bf2f(row[C1_GV + h * 256 + v]); float y = 0.f;
#pragma unroll
        for (int d = 0; d < 64; ++d) { S[d] = al[64 * hf + d] * S[d] + ks[64 * hf + d] * vv; y += qs[64 * hf + d] * S[d]; }
        yp[tid] = y;
        __syncthreads();
        const float yt = hf == 0 ? yp[v] + yp[v + 256] : 0.f;
        const float ms = block_sum512(yt * yt, red, tid) * (1.f / 256.f);
        if (hf == 0) row[C1_GV + h * 256 + v] = (bf16_t)f2bf(yt * rsqrtf(ms + NORM_EPS) * gn * siluf_(bf2f(row[C1_GR + h * 256 + v])));
    }
}
__device__ __forceinline__ void mix_ssd_naive(const Params& P, int b, int g, LAS unsigned char* lds) {
    LAS float* Bs = (LAS float*)lds; LAS float* Cs = Bs + 128; LAS float* yp = Bs + 384; LAS float* red = Bs + 896;
    const int tid = opaque_tid(), v = tid & 255, hf = tid >> 8, r = v >> 6, p = v & 63, hd = g * 4 + r;
    bf16_t* proj = (bf16_t*)(P.ws + WS_BIG);
    const float* cw = P.in[I_SSDCW]; const float* cb = P.in[I_SSDCB];
    const float dtb = P.in[I_SSDDTB][hd], A = -expf(P.in[I_SSDALOG][hd]), Dp = P.in[I_SSDD][hd];
    const float gn = P.in[I_SSDG][g * 256 + v];
    float S[64];
#pragma unroll
    for (int d = 0; d < 64; ++d) S[d] = 0.f;
    for (int t = 0; t < SEQ; ++t) {
        bf16_t* row = proj + (size_t)(b * SEQ + t) * NP;
        if (tid < 256) { const int n = tid & 127; const int ch = (tid < 128 ? 1024 : 1536) + g * 128 + n; const int col = (tid < 128 ? C1_BM : C1_CM) + g * 128 + n; float a = cb[ch];
#pragma unroll
            for (int j = 0; j < 4; ++j) { const int tt = t - 3 + j; if (tt >= 0) a += cw[j * 2048 + ch] * bf2f(proj[(size_t)(b * SEQ + tt) * NP + col]); }
            a = siluf_(a); if (tid < 128) Bs[n] = a; else Cs[n] = a; }
        float xv; { const int ch = hd * 64 + p; float a = cb[ch];
#pragma unroll
            for (int j = 0; j < 4; ++j) { const int tt = t - 3 + j; if (tt >= 0) a += cw[j * 2048 + ch] * bf2f(proj[(size_t)(b * SEQ + tt) * NP + C1_XS + ch]); }
            xv = siluf_(a); }
        const float dt = softplusf_(bf2f(row[C1_DT + hd]) + dtb); const float dec = expf(dt * A); const float xd = xv * dt;
        __syncthreads();
        float y = 0.f;
#pragma unroll
        for (int n = 0; n < 64; ++n) { S[n] = dec * S[n] + Bs[64 * hf + n] * xd; y += Cs[64 * hf + n] * S[n]; }
        yp[tid] = y;
        __syncthreads();
        float yt = 0.f;
        if (hf == 0) { yt = yp[v] + yp[v + 256] + Dp * xv; yt *= siluf_(bf2f(row[C1_SZ + hd * 64 + p])); }
        const float ms = block_sum512(yt * yt, red, tid) * (1.f / 256.f);
        if (hf == 0) row[C1_SZ + hd * 64 + p] = (bf16_t)f2bf(yt * rsqrtf(ms + NORM_EPS) * gn);
    }
}

#define XB_TMO      128
#define XB_XCNT(j)  (256  + 64 * (j))
#define XB_XSUB(j)  (1280 + 64 * (j))
#define XB_XGEN(j)  (2304 + 64 * (j))
#define XB_TOP      3328
#define XB_TOPGEN   3392
#define XCD_BAR_WORDS 3456
#define XB_SPIN_CAP (1u << 18)
__device__ __forceinline__ unsigned xb_ld(unsigned* p)              { return __hip_atomic_load(p, __ATOMIC_RELAXED, __HIP_MEMORY_SCOPE_AGENT); }
__device__ __forceinline__ unsigned xb_add(unsigned* p, unsigned v) { return __hip_atomic_fetch_add(p, v, __ATOMIC_RELAXED, __HIP_MEMORY_SCOPE_AGENT); }
__device__ __forceinline__ unsigned xb_xcc_id() { return (unsigned)__builtin_amdgcn_s_getreg((3 << 11) | 20) & 0xFu; }
#define XB_SPIN(cond, bar) do { unsigned _sp = 0; while (cond) { __builtin_amdgcn_s_sleep(1); \
    if ((++_sp & 255u) == 0u) { if (xb_ld(&(bar)[XB_TMO])) break; if (_sp > XB_SPIN_CAP) { atomicAdd(&(bar)[XB_TMO], 1u); break; } } } } while (0)
struct XcdBarrier { unsigned* bar; unsigned x; volatile LAS unsigned* st; };
__device__ __forceinline__ XcdBarrier xcd_barrier_post(unsigned* bar, volatile LAS unsigned* st) {
    XcdBarrier b; b.bar = bar; b.x = xb_xcc_id(); b.st = st;
    if (threadIdx.x == 0) (void)xb_add(&bar[XB_XCNT(b.x)], 1u);
    return b;
}
__device__ __forceinline__ void xcd_barrier_complete(unsigned* bar, unsigned x, unsigned& nloc, unsigned& nx) {
    const unsigned G = gridDim.x * gridDim.y * gridDim.z;
    unsigned sum, cnt, mine, sp = 0u;
    for (;;) {
        sum = 0u; cnt = 0u; mine = 0u;
#pragma unroll
        for (unsigned j = 0; j < 16; ++j) { const unsigned c = xb_ld(&bar[XB_XCNT(j)]); sum += c; cnt += (c > 0u) ? 1u : 0u; mine = (j == x) ? c : mine; }
        if (sum == G) break;
        __builtin_amdgcn_s_sleep(1);
        if ((++sp & 255u) == 0u) { if (xb_ld(&bar[XB_TMO])) break; if (sp > XB_SPIN_CAP) { atomicAdd(&bar[XB_TMO], 1u); break; } }
    }
    nloc = mine > 0u ? mine : 1u; nx = cnt > 0u ? cnt : 1u;
}
__device__ __forceinline__ void xcd_barrier(const XcdBarrier& b) {
    asm volatile("s_waitcnt vmcnt(0)" ::: "memory");
    __syncthreads();
    if (threadIdx.x == 0) {
        unsigned* bar = b.bar;
        __builtin_amdgcn_s_waitcnt(0);
        unsigned nloc = b.st[0], nx = b.st[1];
        if (nloc == 0u) { xcd_barrier_complete(bar, b.x, nloc, nx); b.st[0] = nloc; b.st[1] = nx; }
        const unsigned old = xb_add(&bar[XB_XSUB(b.x)], 1u);
        const unsigned gen = old / nloc;
        if (old + 1u == (gen + 1u) * nloc) {
            __builtin_amdgcn_fence(__ATOMIC_RELEASE, "agent");
            asm volatile("s_waitcnt vmcnt(0)" ::: "memory");
            const unsigned og = xb_add(&bar[XB_TOP], 1u);
            const unsigned tg = og / nx;
            if (og + 1u == (tg + 1u) * nx) xb_add(&bar[XB_TOPGEN], 1u);
            else XB_SPIN(xb_ld(&bar[XB_TOPGEN]) == tg, bar);
            __builtin_amdgcn_fence(__ATOMIC_ACQUIRE, "agent");
            xb_add(&bar[XB_XGEN(b.x)], 1u);
            asm volatile("s_waitcnt vmcnt(0)" ::: "memory");
        } else {
            XB_SPIN(xb_ld(&bar[XB_XGEN(b.x)]) == gen, bar);
            __builtin_amdgcn_fence(__ATOMIC_ACQUIRE, "agent");
            asm volatile("s_waitcnt vmcnt(0)" ::: "memory");
        }
    }
    __syncthreads();
}

constexpr int NTHREADS = 512;
constexpr int RING_BYTES = 131072;
constexpr int LDS_BYTES = 147456;
constexpr int LDS_BARW = RING_BYTES;
constexpr int NPHASES = 17;
#ifndef MK_N_LAUNCHES
#define MK_N_LAUNCHES 1
#endif

struct Args { Params P; int ph_lo, ph_hi; };
typedef __attribute__((address_space(4))) const unsigned char* kargp_t;
__device__ __forceinline__ const Params& kparams() {
    kargp_t p = (kargp_t)__builtin_amdgcn_kernarg_segment_ptr();
    asm volatile("" : "+s"(p));
    return *(const Params*)p;
}

template <int LAYER>
__device__ __forceinline__ void layer_phases(LAS unsigned char* lds, const XcdBarrier& bar, const int lo, const int hi) {
#define IN(k) (lo <= (k) && (k) < hi)
#define SEAM(k) do { if (IN(k) && IN((k) + 1)) xcd_barrier(bar); } while (0)
    constexpr int PB = 1 + 8 * LAYER;
    const int bid = blockIdx.x, nb = gridDim.x;
    if (IN(PB + 0)) {
        const Params& P = kparams();
        pg8::SchedPlain S; S.A = (const char*)(P.out + OUT_H); S.B = (const char*)(P.ws + (LAYER ? WS_WIN1 : WS_WIN0)); S.lda = D; S.ldb = D; S.nM = T / 256; S.nN = NP / 256; S.G = nb; S.c = bid;
        pg8::EpiStore E{(bf16_t*)(P.ws + WS_BIG), NP};
        pg8::gemm_phase(lds, S, E, D, D, D);
    }
    SEAM(PB + 0);
    if (IN(PB + 1)) {
        const Params& P = kparams();
        for (int u = bid; u < 256; u += nb) {
            const int b = (u & 127) >> 2, h = u & 3;
            if (LAYER == 0) { if (u < 128) mix_ret_naive(P, b, h, lds); else mix_ml_naive(P, b, h, lds); }
            else { if (u < 128) mix_gla_naive(P, b, h, lds); else mix_ssd_naive(P, b, h, lds); }
            __syncthreads();
        }
    }
    SEAM(PB + 1);
    if (IN(PB + 2)) {
        const Params& P = kparams();
        pg8::SchedPlain S; S.A = (const char*)(P.ws + WS_BIG) + YOFF * 2; S.B = (const char*)(P.ws + (LAYER ? WS_WOUT1 : WS_WOUT0)); S.lda = NP; S.ldb = 2048; S.nM = T / 256; S.nN = 4; S.G = nb; S.c = bid;
        pg8::EpiResid E{(bf16_t*)(P.out + OUT_PRE1), (const bf16_t*)(P.out + OUT_H)};
        pg8::gemm_phase(lds, S, E, 2048, NP, 2048);
    }
    SEAM(PB + 2);
    if (IN(PB + 3)) phase_route(kparams(), LAYER, lds, bid, nb);
    SEAM(PB + 3);
    if (IN(PB + 4)) phase_permute(kparams(), LAYER, lds, bid, nb);
    SEAM(PB + 4);
    if (IN(PB + 5)) {
        const Params& P = kparams();
        const int* tilecls = (const int*)(P.ws + WS_TILECLS);
        pg8::SchedMoeA S; S.A = (const char*)(P.ws + WS_BIG + BIG_HS); S.Wgu = (const char*)(P.ws + WS_WGU) + (size_t)LAYER * 16 * 1024 * 1024 * 2; S.tilecls = tilecls; S.nM = tilecls[0]; S.G = nb; S.c = bid;
        pg8::EpiSwiglu E{(bf16_t*)(P.ws + WS_BIG + BIG_H), (const float*)(P.ws + WS_ROWGATE)};
        pg8::gemm_phase(lds, S, E, D, D, D);
    }
    SEAM(PB + 5);
    if (IN(PB + 6)) {
        const Params& P = kparams();
        const int* tilecls = (const int*)(P.ws + WS_TILECLS);
        pg8::SchedMoeB S; S.A = (const char*)(P.ws + WS_BIG + BIG_H); S.Wd = (const char*)(P.ws + WS_WD) + (size_t)LAYER * 16 * 1024 * 512 * 2; S.tilecls = tilecls; S.nM = tilecls[0]; S.G = nb; S.c = bid;
        pg8::EpiResid E{(bf16_t*)(P.ws + WS_BIG + BIG_PRE2), (const bf16_t*)(P.ws + WS_BIG + BIG_HS)};
        pg8::gemm_phase(lds, S, E, D, D, 512);
    }
    SEAM(PB + 6);
    if (IN(PB + 7)) phase_lnffn(kparams(), LAYER, bid, nb);
    if (LAYER == 0) SEAM(PB + 7);
#undef IN
#undef SEAM
}

__global__ void __launch_bounds__(NTHREADS, 2) mega_fwd(Args a) {
    extern __shared__ __attribute__((aligned(16))) unsigned char lds_raw[];
    LAS unsigned char* lds = (LAS unsigned char*)lds_raw;
    if (threadIdx.x < 4) ((LAS unsigned*)(lds + LDS_BARW))[threadIdx.x] = 0u;
    __syncthreads();
    const int lo = a.ph_lo, hi = a.ph_hi;
    XcdBarrier bar;
    { unsigned* bw = (unsigned*)(kparams().ws + WS_CTL) + CW_BAR; bar.bar = bw; bar.x = 0; bar.st = nullptr;
      if (hi - lo > 1) bar = xcd_barrier_post(bw, (volatile LAS unsigned*)(lds + LDS_BARW)); }
    if (lo <= 0 && 0 < hi) { phase_convert(kparams(), lds, blockIdx.x, gridDim.x); if (1 < hi) xcd_barrier(bar); }
    layer_phases<0>(lds, bar, lo, hi);
    layer_phases<1>(lds, bar, lo, hi);
}

extern "C" void kernel_launch(void* const* d_in, const int* in_sizes, int n_in, void* d_out, int out_size, void* d_ws, size_t ws_size, hipStream_t stream) {
    static int grid = 0;
    if (!grid) {
        if (n_in != 30 || ws_size < WS_END || out_size != T * D) { fprintf(stderr, "kernel_launch: unexpected shapes n_in %d ws %zu out %d\n", n_in, ws_size, out_size); grid = -1; return; }
        int dev = 0, cus = 0, per_cu = 0;
        if (hipGetDevice(&dev) != hipSuccess || hipDeviceGetAttribute(&cus, hipDeviceAttributeMultiprocessorCount, dev) != hipSuccess) { grid = -1; return; }
        if (hipFuncSetAttribute((const void*)mega_fwd, hipFuncAttributeMaxDynamicSharedMemorySize, LDS_BYTES) != hipSuccess) { fprintf(stderr, "kernel_launch: hipFuncSetAttribute failed\n"); grid = -1; return; }
        if (hipOccupancyMaxActiveBlocksPerMultiprocessor(&per_cu, (const void*)mega_fwd, NTHREADS, LDS_BYTES) != hipSuccess || per_cu < 1)
            fprintf(stderr, "kernel_launch: note: occupancy query reports %d workgroups per CU\n", per_cu);
        grid = cus > 0 ? cus : 256;
    }
    if (grid < 0) return;
    Args a{};
    for (int i = 0; i < 30; ++i) a.P.in[i] = (const float*)d_in[i];
    a.P.out = (unsigned char*)d_out; a.P.ws = (unsigned char*)d_ws;
    (void)hipMemsetAsync((char*)d_ws + WS_CTL, 0, CTL_BYTES, stream);
    constexpr int NL = MK_N_LAUNCHES;
    if (NL == 1) { a.ph_lo = 0; a.ph_hi = NPHASES; hipLaunchKernelGGL(mega_fwd, dim3(grid), dim3(NTHREADS), LDS_BYTES, stream, a); }
    else for (int p = 0; p < NPHASES; ++p) { a.ph_lo = p; a.ph_hi = p + 1; hipLaunchKernelGGL(mega_fwd, dim3(grid), dim3(NTHREADS), LDS_BYTES, stream, a); }
}
```

```cpp
#include <hip/hip_runtime.h>
#include <cstdio>
#include <cstdint>

#define GAS __attribute__((address_space(1)))
#define LAS __attribute__((address_space(3)))
typedef unsigned short bf16_t;
typedef short bf16x8 __attribute__((ext_vector_type(8)));
typedef float f32x4 __attribute__((ext_vector_type(4)));
typedef unsigned u32x4 __attribute__((ext_vector_type(4)));

constexpr int BATCH = 32, SEQ = 2048, T = BATCH * SEQ, D = 1024;
constexpr int NP = 6400;
constexpr int YOFF = 1024;
constexpr int NCLS = 24, MAXTILES = 280;
constexpr float LN_EPS = 1e-5f, NORM_EPS = 1e-6f;
constexpr float ALPHA = 1.41421356237f;
constexpr int NTHREADS_C = 512;

constexpr int C0_RQ = 0, C0_RK = 512, C0_RV = 1024, C0_MV = 2048, C0_RG = 3072, C0_MQ = 4096, C0_MK = 4608, C0_MO = 5120, C0_MI = 6144, C0_MF = 6148;
constexpr int C1_GQ = 0, C1_GK = 512, C1_GV = 1024, C1_SZ = 2048, C1_GR = 3072, C1_XS = 4096, C1_BM = 5120, C1_CM = 5632, C1_GA = 6144, C1_DT = 6160;

constexpr size_t MiB = 1u << 20;
constexpr size_t WS_CTL = 0, CTL_BYTES = 1 * MiB;
constexpr size_t WS_WIN0 = 2 * MiB;
constexpr size_t WS_WIN1 = 15 * MiB;
constexpr size_t WS_WOUT0 = 28 * MiB;
constexpr size_t WS_WOUT1 = 32 * MiB;
constexpr size_t WS_WGU = 36 * MiB;
constexpr size_t WS_WD = 100 * MiB;
constexpr size_t WS_TOKCLS = 132 * MiB;
constexpr size_t WS_TOKPOS = WS_TOKCLS + (size_t)T * 4;
constexpr size_t WS_TOKDST = WS_TOKPOS + (size_t)T * 4;
constexpr size_t WS_TOKGATE = WS_TOKDST + (size_t)T * 4;
constexpr size_t WS_ROWGATE = WS_TOKGATE + (size_t)T * 8;
constexpr size_t WS_TILECLS = WS_ROWGATE + (size_t)MAXTILES * 256 * 8;
constexpr size_t WS_BIG = 136 * MiB;
constexpr size_t BIG_HS = 0, BIG_H = 160 * MiB, BIG_PRE2 = 320 * MiB;
constexpr size_t WS_END = WS_BIG + (size_t)T * NP * 2;
static_assert(WS_TILECLS + (MAXTILES + 8) * 4 <= WS_BIG, "ws map");
static_assert(WS_END <= 1024 * MiB, "ws map");
constexpr size_t OUT_H = 0, OUT_PRE1 = 128 * MiB;
constexpr int CW_CNT = 1024;
constexpr int CW_BAR = 4096;

__device__ __forceinline__ unsigned f2bf(float f) { unsigned u = __builtin_bit_cast(unsigned, f); return (u + 0x7fffu + ((u >> 16) & 1u)) >> 16; }
__device__ __forceinline__ unsigned pk2(float lo, float hi) { return f2bf(lo) | (f2bf(hi) << 16); }
__device__ __forceinline__ float bf2f(unsigned short b) { return __builtin_bit_cast(float, ((unsigned)b) << 16); }
__device__ __forceinline__ float bflo(unsigned w) { return __builtin_bit_cast(float, w << 16); }
__device__ __forceinline__ float bfhi(unsigned w) { return __builtin_bit_cast(float, w & 0xffff0000u); }
__device__ __forceinline__ float sigmoidf_(float x) { return 1.f / (1.f + __expf(-x)); }
__device__ __forceinline__ float siluf_(float x) { return x / (1.f + __expf(-x)); }
__device__ __forceinline__ float softplusf_(float x) { return x > 20.f ? x : log1pf(expf(x)); }
__device__ __forceinline__ float logsigmoidf_(float x) { return -softplusf_(-x); }
__device__ __forceinline__ float wave_sum(float v) {
#pragma unroll
    for (int o = 1; o < 64; o <<= 1) v += __shfl_xor(v, o);
    return v;
}
#define LDS_WAIT() asm volatile("s_waitcnt lgkmcnt(0)" ::: "memory")
__device__ __forceinline__ int opaque_tid() { int t = threadIdx.x; asm volatile("" : "+v"(t)); return t; }

namespace pg8 {
constexpr int BM = 256, BK = 64, HALF = 128, HTB = HALF * BK * 2, STAGE_BYTES = 8 * HTB, NXCD = 8, WGM = 8;
__host__ __device__ __forceinline__ int lds_byte(int r, int c) { const int st = (r >> 4) * 2 + (c >> 5), rr = r & 15, cc = c & 31, ob = rr * 64 + cc * 2; return st * 1024 + (ob ^ (((ob >> 9) & 1) << 5)); }
__host__ __device__ __forceinline__ void stage_rc(int b, int& R, int& C) { const int st = b / 1024, sb = b % 1024, swz = sb ^ (((sb >> 9) & 1) << 5); R = (st >> 1) * 16 + swz / 64; C = (st & 1) * 32 + (swz % 64) / 2; }
__host__ __device__ __forceinline__ int perm32(int rho) { const int n = rho >> 4, i = rho & 15; return 8 * (i >> 2) + 4 * n + (i & 3); }

struct Unit { int pm, pn; const char* a; const char* b0; const char* b1; };

__device__ __forceinline__ bool static_tile(int i, int G, int c, int nM, int nN, int& pm, int& pn) {
    const int nwg = nM * nN; const long L = (long)i * G + c; if (L >= nwg) return false;
    int wgid = (int)L; { const int q = nwg / NXCD, r = nwg % NXCD, xcd = wgid % NXCD, off = wgid / NXCD; wgid = (xcd < r ? xcd * (q + 1) : r * (q + 1) + (xcd - r) * q) + off; }
    const int nig = WGM * nN, gid = wgid / nig, fm = gid * WGM, gsz = (nM - fm) < WGM ? (nM - fm) : WGM;
    pm = fm + ((wgid % nig) % gsz); pn = (wgid % nig) / gsz; return true;
}
__device__ __forceinline__ unsigned cvt_pk_bf16(float lo, float hi) { unsigned r; asm volatile("v_cvt_pk_bf16_f32 %0, %1, %2" : "=v"(r) : "v"(lo), "v"(hi)); return r; }

template <class Epi, class Sched>
__device__ __forceinline__ void gemm_phase(LAS unsigned char* lds, const Sched& S, const Epi& E, const int K, const int lda, const int ldb) {
    const int tid = opaque_tid(), wid = __builtin_amdgcn_readfirstlane(tid >> 6), lane = tid & 63, wr = wid >> 2, wc = wid & 3, fr = lane & 15, fq = lane >> 4;
    const int nt = K / BK;
    constexpr int KS = Sched::KSPLIT;
    unsigned voffA[2], voffB[2];
#pragma unroll
    for (int i = 0; i < 2; ++i) { int R, C; stage_rc(tid * 16 + i * 8192, R, C); const int Rb = (R & ~31) + perm32(R & 31);
        voffA[i] = (unsigned)(R * lda + C) * 2u; voffB[i] = (unsigned)(Rb * ldb + C) * 2u; }
    const size_t kstep = (size_t)(BK * 2);
    const size_t hstepA = (size_t)HALF * lda * 2, hstepB = (size_t)HALF * ldb * 2;
    const unsigned ldsw = (unsigned)wid * 1024u;
    const int aoff = lds_byte(wr * 64 + fr, fq * 8), boff = lds_byte(wc * 32 + fr, fq * 8);
#define PG8_BP(u, kt) ((KS > 0 && (kt) >= KS) ? (u).b1 + (size_t)((kt) - KS) * kstep : (u).b0 + (size_t)(kt) * kstep)
#define PG8_SA(b, h) (((b) * 2 + (h)) * HTB)
#define PG8_SB(b, h) ((4 + (b) * 2 + (h)) * HTB)
#define PG8_STAGE(bufoff, gbase, voff) do { _Pragma("unroll") for (int _i = 0; _i < 2; ++_i) \
        __builtin_amdgcn_global_load_lds((const unsigned*)((const char*)(gbase) + (voff)[_i]), (LAS unsigned*)(lds + (bufoff) + ldsw + _i * 8192), 16, 0, 0); } while (0)
#define PG8_LDA(dst, b, h) do { _Pragma("unroll") for (int m = 0; m < 4; ++m) _Pragma("unroll") for (int k = 0; k < 2; ++k) dst[m][k] = *(const LAS bf16x8*)(lds + PG8_SA(b, h) + aoff + m * 2048 + k * 1024); } while (0)
#define PG8_LDB(dst, b, h) do { _Pragma("unroll") for (int n = 0; n < 2; ++n) _Pragma("unroll") for (int k = 0; k < 2; ++k) dst[n][k] = *(const LAS bf16x8*)(lds + PG8_SB(b, h) + boff + n * 2048 + k * 1024); } while (0)
#define PG8_MMA(ai, bj, At, Bt) do { __builtin_amdgcn_s_setprio(1); _Pragma("unroll") for (int m = 0; m < 4; ++m) _Pragma("unroll") for (int n = 0; n < 2; ++n) _Pragma("unroll") for (int k = 0; k < 2; ++k) \
        acc[ai][bj][m][n] = __builtin_amdgcn_mfma_f32_16x16x32_bf16(Bt[n][k], At[m][k], acc[ai][bj][m][n], 0, 0, 0); __builtin_amdgcn_s_setprio(0); } while (0)
#define PG8_WAIT_V(n) asm volatile("s_waitcnt vmcnt(" #n ")" ::: "memory")
#define PG8_WAIT_L(n) asm volatile("s_waitcnt lgkmcnt(" #n ")" ::: "memory")
#define PG8_BAR __builtin_amdgcn_s_barrier()
#define PG8_SCHED __builtin_amdgcn_sched_barrier(0)
    Unit cur, nxt; int ui = 0;
    if (!S.next(0, cur)) return;
    f32x4 acc[2][2][4][2];
#pragma unroll
    for (int a = 0; a < 2; ++a)
#pragma unroll
        for (int b = 0; b < 2; ++b)
#pragma unroll
            for (int m = 0; m < 4; ++m)
#pragma unroll
                for (int n = 0; n < 2; ++n) acc[a][b][m][n] = (f32x4){0.f, 0.f, 0.f, 0.f};
    bf16x8 At[4][2], B0[2][2], B1[2][2];
    const char* cA = cur.a;
    { const char* cB0 = PG8_BP(cur, 0); const char* cB1 = PG8_BP(cur, 1);
    PG8_STAGE(PG8_SB(0, 0), cB0, voffB); PG8_STAGE(PG8_SA(0, 0), cA, voffA); PG8_STAGE(PG8_SB(0, 1), cB0 + hstepB, voffB); PG8_STAGE(PG8_SA(0, 1), cA + hstepA, voffA);
    if (wr == 1) PG8_BAR;
    PG8_WAIT_V(4); PG8_BAR;
    PG8_STAGE(PG8_SB(1, 0), cB1, voffB); PG8_STAGE(PG8_SA(1, 0), cA + kstep, voffA); PG8_STAGE(PG8_SB(1, 1), cB1 + hstepB, voffB);
    PG8_WAIT_V(6); PG8_BAR; }
    for (;;) {
        const bool has_next = S.next(ui + 1, nxt);
        if (!has_next) nxt = cur;
        for (int t = 0; t < nt; t += 2) {
            const bool last = (t == nt - 2);
            const char* a1 = cA + (size_t)(t + 1) * kstep;
            const char* a2 = last ? nxt.a : cA + (size_t)(t + 2) * kstep;
            const char* b2 = last ? PG8_BP(nxt, 0) : PG8_BP(cur, t + 2);
            const char* a3 = a2 + kstep;
            const char* b3 = last ? PG8_BP(nxt, 1) : PG8_BP(cur, t + 3);
            PG8_LDB(B0, 0, 0); PG8_SCHED; PG8_LDA(At, 0, 0); PG8_STAGE(PG8_SA(1, 1), a1 + hstepA, voffA);
            PG8_WAIT_L(8); PG8_BAR; PG8_WAIT_L(0); PG8_MMA(0, 0, At, B0); PG8_BAR; PG8_SCHED;
            PG8_LDB(B1, 0, 1); PG8_STAGE(PG8_SB(0, 0), b2, voffB);
            PG8_BAR; PG8_WAIT_L(0); PG8_MMA(0, 1, At, B1); PG8_BAR;
            PG8_LDA(At, 0, 1); PG8_STAGE(PG8_SA(0, 0), a2, voffA);
            PG8_BAR; PG8_WAIT_L(0); PG8_MMA(1, 0, At, B0); PG8_BAR; PG8_SCHED;
            PG8_STAGE(PG8_SB(0, 1), b2 + hstepB, voffB);
            PG8_WAIT_V(6); PG8_BAR; PG8_MMA(1, 1, At, B1); PG8_BAR;
            PG8_LDB(B0, 1, 0); PG8_SCHED; PG8_LDA(At, 1, 0); PG8_STAGE(PG8_SA(0, 1), a2 + hstepA, voffA);
            PG8_WAIT_L(8); PG8_BAR; PG8_WAIT_L(0); PG8_MMA(0, 0, At, B0); PG8_BAR; PG8_SCHED;
            PG8_LDB(B1, 1, 1); PG8_STAGE(PG8_SB(1, 0), b3, voffB);
            PG8_BAR; PG8_WAIT_L(0); PG8_MMA(0, 1, At, B1); PG8_BAR;
            PG8_LDA(At, 1, 1); PG8_STAGE(PG8_SA(1, 0), a3, voffA);
            PG8_BAR; PG8_WAIT_L(0); PG8_MMA(1, 0, At, B0); PG8_BAR; PG8_SCHED;
            PG8_STAGE(PG8_SB(1, 1), b3 + hstepB, voffB);
            PG8_WAIT_V(6); PG8_BAR; PG8_MMA(1, 1, At, B1); PG8_BAR;
        }
        E(acc, cur, wr, wc, fr, fq);
        if (!has_next) break;
#pragma unroll
        for (int a = 0; a < 2; ++a)
#pragma unroll
            for (int b = 0; b < 2; ++b)
#pragma unroll
                for (int m = 0; m < 4; ++m)
#pragma unroll
                    for (int n = 0; n < 2; ++n) acc[a][b][m][n] = (f32x4){0.f, 0.f, 0.f, 0.f};
        cur = nxt; cA = cur.a; ++ui;
    }
    PG8_WAIT_V(0);
    if (wr == 0) PG8_BAR;
    PG8_BAR;
#undef PG8_BP
#undef PG8_SA
#undef PG8_SB
#undef PG8_STAGE
#undef PG8_LDA
#undef PG8_LDB
#undef PG8_MMA
#undef PG8_WAIT_V
#undef PG8_WAIT_L
#undef PG8_BAR
#undef PG8_SCHED
}

struct SchedPlain {
    static constexpr int KSPLIT = 0;
    const char* A; const char* B; int lda, ldb, nM, nN, G, c;
    __device__ __forceinline__ bool next(int i, Unit& u) const {
        if (!static_tile(i, G, c, nM, nN, u.pm, u.pn)) return false;
        u.a = A + (size_t)u.pm * BM * lda * 2; u.b0 = B + (size_t)u.pn * BM * ldb * 2; u.b1 = u.b0; return true;
    }
};
__device__ __forceinline__ void cls_experts(int cls, int& e0, int& e1) {
    const int g = cls / 6, p = cls % 6;
    const int a = p < 3 ? 0 : (p < 5 ? 1 : 2);
    const int b = p < 3 ? p + 1 : (p < 5 ? p - 1 : 3);
    e0 = 4 * g + a; e1 = 4 * g + b;
}
struct SchedMoeA {
    static constexpr int KSPLIT = 0;
    const char* A; const char* Wgu; const int* tilecls; int nM, G, c;
    __device__ __forceinline__ bool next(int i, Unit& u) const {
        if (!static_tile(i, G, c, nM, 8, u.pm, u.pn)) return false;
        int e0, e1; cls_experts(tilecls[8 + u.pm], e0, e1); const int e = (u.pn >> 2) ? e1 : e0;
        u.a = A + (size_t)u.pm * BM * 1024 * 2; u.b0 = Wgu + ((size_t)e * 1024 + (size_t)(u.pn & 3) * 256) * 1024 * 2; u.b1 = u.b0; return true;
    }
};
struct SchedMoeB {
    static constexpr int KSPLIT = 8;
    const char* A; const char* Wd; const int* tilecls; int nM, G, c;
    __device__ __forceinline__ bool next(int i, Unit& u) const {
        if (!static_tile(i, G, c, nM, 4, u.pm, u.pn)) return false;
        int e0, e1; cls_experts(tilecls[8 + u.pm], e0, e1);
        u.a = A + (size_t)u.pm * BM * 1024 * 2;
        u.b0 = Wd + ((size_t)e0 * 1024 + (size_t)u.pn * 256) * 512 * 2; u.b1 = Wd + ((size_t)e1 * 1024 + (size_t)u.pn * 256) * 512 * 2; return true;
    }
};

struct EpiStore {
    bf16_t* O; int ldc;
    __device__ __forceinline__ void operator()(const f32x4 (&acc)[2][2][4][2], const Unit& u, int wr, int wc, int fr, int fq) const {
        const int row0 = u.pm * BM + wr * 64 + fr, col0 = u.pn * BM + wc * 32 + 8 * fq;
#pragma unroll
        for (int ai = 0; ai < 2; ++ai)
#pragma unroll
            for (int m = 0; m < 4; ++m) { bf16_t* rowp = O + (size_t)(row0 + ai * HALF + m * 16) * ldc + col0;
#pragma unroll
                for (int bj = 0; bj < 2; ++bj) { const f32x4 v0 = acc[ai][bj][m][0], v1 = acc[ai][bj][m][1];
                    u32x4 w; w.x = cvt_pk_bf16(v0[0], v0[1]); w.y = cvt_pk_bf16(v0[2], v0[3]); w.z = cvt_pk_bf16(v1[0], v1[1]); w.w = cvt_pk_bf16(v1[2], v1[3]);
                    *(u32x4*)(rowp + bj * HALF) = w; } }
    }
};
struct EpiResid {
    bf16_t* O; const bf16_t* R;
    __device__ __forceinline__ void operator()(const f32x4 (&acc)[2][2][4][2], const Unit& u, int wr, int wc, int fr, int fq) const {
        const int row0 = u.pm * BM + wr * 64 + fr, col0 = u.pn * BM + wc * 32 + 8 * fq;
#pragma unroll
        for (int ai = 0; ai < 2; ++ai)
#pragma unroll
            for (int m = 0; m < 4; ++m) { const size_t off = (size_t)(row0 + ai * HALF + m * 16) * 1024 + col0;
#pragma unroll
                for (int bj = 0; bj < 2; ++bj) { const f32x4 v0 = acc[ai][bj][m][0], v1 = acc[ai][bj][m][1];
                    const u32x4 r = *(const u32x4*)(R + off + bj * HALF);
                    u32x4 w; w.x = cvt_pk_bf16(v0[0] + ALPHA * bflo(r.x), v0[1] + ALPHA * bfhi(r.x)); w.y = cvt_pk_bf16(v0[2] + ALPHA * bflo(r.y), v0[3] + ALPHA * bfhi(r.y));
                    w.z = cvt_pk_bf16(v1[0] + ALPHA * bflo(r.z), v1[1] + ALPHA * bfhi(r.z)); w.w = cvt_pk_bf16(v1[2] + ALPHA * bflo(r.w), v1[3] + ALPHA * bfhi(r.w));
                    *(u32x4*)(O + off + bj * HALF) = w; } }
    }
};
struct EpiSwiglu {
    bf16_t* H; const float* rowgate;
    __device__ __forceinline__ void operator()(const f32x4 (&acc)[2][2][4][2], const Unit& u, int wr, int wc, int fr, int fq) const {
        const int row0 = u.pm * BM + wr * 64 + fr, ke = u.pn >> 2, col0 = 512 * ke + 128 * (u.pn & 3) + wc * 32 + 8 * fq;
#pragma unroll
        for (int ai = 0; ai < 2; ++ai)
#pragma unroll
            for (int m = 0; m < 4; ++m) { const int row = row0 + ai * HALF + m * 16; const float gt = rowgate[(size_t)row * 2 + ke];
                const f32x4 g0 = acc[ai][0][m][0], g1 = acc[ai][0][m][1], u0 = acc[ai][1][m][0], u1 = acc[ai][1][m][1];
                float o[8];
#pragma unroll
                for (int j = 0; j < 4; ++j) { o[j] = siluf_(g0[j]) * u0[j] * gt; o[4 + j] = siluf_(g1[j]) * u1[j] * gt; }
                u32x4 w; w.x = cvt_pk_bf16(o[0], o[1]); w.y = cvt_pk_bf16(o[2], o[3]); w.z = cvt_pk_bf16(o[4], o[5]); w.w = cvt_pk_bf16(o[6], o[7]);
                *(u32x4*)(H + (size_t)row * 1024 + col0) = w; }
    }
};
}

struct Params {
    const float* in[30];
    unsigned char* out;
    unsigned char* ws;
};
enum { I_X = 0, I_POS, I_WINAB, I_RETG, I_MLCW, I_MLCB, I_MLBI, I_MLBF, I_MLG, I_WOUTAB, I_WINCD, I_GLAWA, I_GLABA, I_GLAG, I_SSDCW, I_SSDCB, I_SSDDTB, I_SSDALOG, I_SSDD, I_SSDG,
       I_WOUTCD, I_WR, I_BR, I_MOEG, I_MOEU, I_MOED, I_LNMG, I_LNMB, I_LNFG, I_LNFB };

template <class ColPtr>
__device__ __forceinline__ void tr_item(const ColPtr& cp, int ldw, bf16_t* WT, int ldt, int n0, int k0, LAS float* scr, int lane) {
    const float* p = cp(n0 + (lane & 31));
#pragma unroll 8
    for (int i = 0; i < 32; ++i) { const int kk = 2 * i + (lane >> 5); scr[kk * 33 + (lane & 31)] = p ? p[(size_t)(k0 + kk) * ldw] : 0.f; }
    LDS_WAIT();
    const int c = lane & 7;
#pragma unroll
    for (int j = 0; j < 4; ++j) { const int n = (lane >> 3) + 8 * j; const LAS float* s = scr + (8 * c) * 33 + n;
        u32x4 o; o.x = pk2(s[0 * 33], s[1 * 33]); o.y = pk2(s[2 * 33], s[3 * 33]); o.z = pk2(s[4 * 33], s[5 * 33]); o.w = pk2(s[6 * 33], s[7 * 33]);
        *(u32x4*)(WT + (size_t)(n0 + n) * ldt + k0 + 8 * c) = o; }
    LDS_WAIT();
}
__device__ __forceinline__ int map_ab(int n) {
    if (n < 2048) return n;
    if (n < 3072) return 4096 + (n - 2048);
    if (n < 4096) return 2048 + (n - 3072);
    if (n < 4608) return 3072 + (n - 4096);
    if (n < 5120) return 3584 + (n - 4608);
    if (n < 6152) return n;
    return -1;
}
__device__ __forceinline__ int map_cd(int n) {
    if (n < 2048) return n;
    if (n < 3072) return 3088 + (n - 2048);
    if (n < 4096) return 2048 + (n - 3072);
    if (n < 5120) return 4112 + (n - 4096);
    if (n < 5632) return 5136 + (n - 5120);
    if (n < 6144) return 5648 + (n - 5632);
    if (n < 6160) return 3072 + (n - 6144);
    if (n < 6176) return 6160 + (n - 6160);
    return -1;
}
__device__ __forceinline__ void phase_convert(const Params& P, LAS unsigned char* lds, int bid, int nb) {
    const int tid = opaque_tid(), lane = tid & 63, wave = tid >> 6, nw = blockDim.x >> 6;
    LAS float* scr = (LAS float*)(lds + wave * 16384);
    const int gw = bid * nw + wave, NGW = nb * nw;
    unsigned char* ws = P.ws;
    constexpr int I_IN = (NP / 32) * (D / 64);
    constexpr int I_OUT = (1024 / 32) * (2048 / 64);
    constexpr int I_GU = (1024 / 32) * (1024 / 64);
    constexpr int I_DN = (1024 / 32) * (512 / 64);
    constexpr int NITEMS = 2 * I_IN + 2 * I_OUT + 32 * I_GU + 32 * I_DN;
    for (int it = gw; it < NITEMS; it += NGW) {
        int r = it;
        if (r < 2 * I_IN) { const int l = r / I_IN; r %= I_IN; const int nbk = r / (D / 64), kb = r % (D / 64);
            const float* W = P.in[l ? I_WINCD : I_WINAB]; const int ldw = l ? 6176 : 6152;
            if (l == 0) tr_item([&](int n) { const int s = map_ab(n); return s < 0 ? (const float*)nullptr : W + s; }, ldw, (bf16_t*)(ws + WS_WIN0), D, nbk * 32, kb * 64, scr, lane);
            else        tr_item([&](int n) { const int s = map_cd(n); return s < 0 ? (const float*)nullptr : W + s; }, ldw, (bf16_t*)(ws + WS_WIN1), D, nbk * 32, kb * 64, scr, lane);
            continue; }
        r -= 2 * I_IN;
        if (r < 2 * I_OUT) { const int l = r / I_OUT; r %= I_OUT; const int nbk = r / 32, kb = r % 32;
            const float* W = P.in[l ? I_WOUTCD : I_WOUTAB];
            tr_item([&](int n) { return W + n; }, 1024, (bf16_t*)(ws + (l ? WS_WOUT1 : WS_WOUT0)), 2048, nbk * 32, kb * 64, scr, lane);
            continue; }
        r -= 2 * I_OUT;
        if (r < 32 * I_GU) { const int le = r / I_GU; r %= I_GU; const int nbk = r / 16, kb = r % 16;
            const int n0 = nbk * 32, j = n0 >> 8, w = n0 & 255;
            const float* W = (w < 128 ? P.in[I_MOEG] : P.in[I_MOEU]) + (size_t)le * 1024 * 512 + 128 * j + (w & 127) - n0;
            tr_item([&](int n) { return W + n; }, 512, (bf16_t*)(ws + WS_WGU) + (size_t)le * 1024 * 1024, 1024, n0, kb * 64, scr, lane);
            continue; }
        r -= 32 * I_GU;
        { const int le = r / I_DN; r %= I_DN; const int nbk = r / 8, kb = r % 8;
            const float* W = P.in[I_MOED] + (size_t)le * 512 * 1024;
            tr_item([&](int n) { return W + n; }, 1024, (bf16_t*)(ws + WS_WD) + (size_t)le * 1024 * 512, 512, nbk * 32, kb * 64, scr, lane); }
    }
    const float* x = P.in[I_X]; bf16_t* h = (bf16_t*)(P.out + OUT_H);
    const size_t n8 = (size_t)T * D / 8;
    for (size_t i = (size_t)bid * blockDim.x + tid; i < n8; i += (size_t)nb * blockDim.x) {
        const f32x4 a = *(const f32x4*)(x + i * 8), b = *(const f32x4*)(x + i * 8 + 4);
        u32x4 o; o.x = pk2(a[0], a[1]); o.y = pk2(a[2], a[3]); o.z = pk2(b[0], b[1]); o.w = pk2(b[2], b[3]);
        *(u32x4*)(h + i * 8) = o;
    }
}

__device__ __forceinline__ void load_row_bf16(const bf16_t* row, int lane, float (&v)[16]) {
#pragma unroll
    for (int j = 0; j < 2; ++j) { const u32x4 w = *(const u32x4*)(row + 8 * lane + 512 * j);
        v[8 * j + 0] = bflo(w.x); v[8 * j + 1] = bfhi(w.x); v[8 * j + 2] = bflo(w.y); v[8 * j + 3] = bfhi(w.y);
        v[8 * j + 4] = bflo(w.z); v[8 * j + 5] = bfhi(w.z); v[8 * j + 6] = bflo(w.w); v[8 * j + 7] = bfhi(w.w); }
}
__device__ __forceinline__ void ln_row(float (&v)[16], const float* g, const float* b, int lane) {
    float s = 0.f;
#pragma unroll
    for (int i = 0; i < 16; ++i) s += v[i];
    const float mean = wave_sum(s) * (1.f / D); float q = 0.f;
#pragma unroll
    for (int i = 0; i < 16; ++i) { v[i] -= mean; q += v[i] * v[i]; }
    const float rstd = rsqrtf(wave_sum(q) * (1.f / D) + LN_EPS);
#pragma unroll
    for (int j = 0; j < 2; ++j) {
        const f32x4 g0 = *(const f32x4*)(g + 8 * lane + 512 * j), g1 = *(const f32x4*)(g + 8 * lane + 512 * j + 4);
        const f32x4 b0 = *(const f32x4*)(b + 8 * lane + 512 * j), b1 = *(const f32x4*)(b + 8 * lane + 512 * j + 4);
#pragma unroll
        for (int i = 0; i < 4; ++i) { v[8 * j + i] = v[8 * j + i] * rstd * g0[i] + b0[i]; v[8 * j + 4 + i] = v[8 * j + 4 + i] * rstd * g1[i] + b1[i]; }
    }
}
__device__ __forceinline__ void store_row_bf16(bf16_t* row, int lane, const float (&v)[16]) {
#pragma unroll
    for (int j = 0; j < 2; ++j) { u32x4 o; o.x = pk2(v[8 * j + 0], v[8 * j + 1]); o.y = pk2(v[8 * j + 2], v[8 * j + 3]); o.z = pk2(v[8 * j + 4], v[8 * j + 5]); o.w = pk2(v[8 * j + 6], v[8 * j + 7]);
        *(u32x4*)(row + 8 * lane + 512 * j) = o; }
}

__device__ __forceinline__ void phase_route(const Params& P, int layer, LAS unsigned char* lds, int bid, int nb) {
    const int tid = opaque_tid(), lane = tid & 63, wave = tid >> 6;
    LAS unsigned char* Bhi = lds; LAS unsigned char* Blo = lds + 32768;
    LAS float* cd = (LAS float*)(lds + 65536);
    LAS float* part = cd + 32;
    LAS int* lcnt = (LAS int*)(part + 1024);
    LAS int* lbase = lcnt + 32; LAS int* rcls = lbase + 32; LAS int* rpos = rcls + 256;
    const bf16_t* pre1 = (const bf16_t*)(P.out + OUT_PRE1);
    const float* g = P.in[I_LNMG] + layer * D; const float* b = P.in[I_LNMB] + layer * D;
    const float* Wr = P.in[I_WR]; const float* br = P.in[I_BR];
    int* tokcls = (int*)(P.ws + WS_TOKCLS); int* tokpos = (int*)(P.ws + WS_TOKPOS); float* tokgate = (float*)(P.ws + WS_TOKGATE);
    unsigned* gcnt = (unsigned*)(P.ws + WS_CTL) + CW_CNT + 64 * layer;
#pragma unroll 1
    for (int idx = tid; idx < 2048; idx += NTHREADS_C) {
        const int s = idx >> 6, l = idx & 63, e = l & 15, k0 = 32 * s + 8 * (l >> 4);
        unsigned hi[4], lo[4];
#pragma unroll
        for (int j = 0; j < 4; ++j) {
            const float w0 = g[k0 + 2 * j] * Wr[(k0 + 2 * j) * 16 + e], w1 = g[k0 + 2 * j + 1] * Wr[(k0 + 2 * j + 1) * 16 + e];
            const unsigned h0 = f2bf(w0), h1 = f2bf(w1);
            hi[j] = h0 | (h1 << 16); lo[j] = pk2(w0 - bf2f((unsigned short)h0), w1 - bf2f((unsigned short)h1)); }
        *(LAS u32x4*)(Bhi + idx * 16) = (u32x4){hi[0], hi[1], hi[2], hi[3]};
        *(LAS u32x4*)(Blo + idx * 16) = (u32x4){lo[0], lo[1], lo[2], lo[3]};
    }
    { const int e = tid & 15, pt = tid >> 4; float cs = 0.f, ds = 0.f;
#pragma unroll 4
      for (int kk = 0; kk < 32; ++kk) { const int k = pt * 32 + kk; const float w = Wr[k * 16 + e]; cs += g[k] * w; ds += b[k] * w; }
      part[pt * 32 + e] = cs; part[pt * 32 + 16 + e] = ds; }
    __syncthreads();
    if (tid < 32) { float sacc = 0.f;
#pragma unroll 4
        for (int pt = 0; pt < 32; ++pt) sacc += part[pt * 32 + tid];
        cd[tid] = sacc; }
    __syncthreads();
    const int e = lane & 15, q = lane >> 4;
    const float ce = cd[e], de = cd[16 + e], bre = br[e];
    for (int r0 = bid * 256; r0 < T; r0 += nb * 256) {
        if (tid < 32) lcnt[tid] = 0;
        __syncthreads();
#pragma unroll 1
        for (int tile = 0; tile < 2; ++tile) {
            const int tr0 = wave * 32 + tile * 16;
            const bf16_t* arow = pre1 + (size_t)(r0 + tr0 + e) * D + 8 * q;
            f32x4 acc = (f32x4){0.f, 0.f, 0.f, 0.f}; float s1 = 0.f, s2 = 0.f;
#pragma unroll 1
            for (int s0 = 0; s0 < 32; s0 += 8) {
                u32x4 a[8];
#pragma unroll
                for (int u = 0; u < 8; ++u) a[u] = *(const u32x4*)(arow + 32 * (s0 + u));
#pragma unroll
                for (int u = 0; u < 8; ++u) {
                    const bf16x8 bh = *(const LAS bf16x8*)(Bhi + ((s0 + u) * 64 + lane) * 16), bl = *(const LAS bf16x8*)(Blo + ((s0 + u) * 64 + lane) * 16);
                    const bf16x8 af = __builtin_bit_cast(bf16x8, a[u]);
                    acc = __builtin_amdgcn_mfma_f32_16x16x32_bf16(af, bh, acc, 0, 0, 0);
                    acc = __builtin_amdgcn_mfma_f32_16x16x32_bf16(af, bl, acc, 0, 0, 0);
                    const float x0 = bflo(a[u].x), x1 = bfhi(a[u].x), x2 = bflo(a[u].y), x3 = bfhi(a[u].y), x4 = bflo(a[u].z), x5 = bfhi(a[u].z), x6 = bflo(a[u].w), x7 = bfhi(a[u].w);
                    s1 += ((x0 + x1) + (x2 + x3)) + ((x4 + x5) + (x6 + x7));
                    s2 += ((x0 * x0 + x1 * x1) + (x2 * x2 + x3 * x3)) + ((x4 * x4 + x5 * x5) + (x6 * x6 + x7 * x7));
                }
            }
            s1 += __shfl_xor(s1, 16); s1 += __shfl_xor(s1, 32); s2 += __shfl_xor(s2, 16); s2 += __shfl_xor(s2, 32);
            const float mean = s1 * (1.f / D); const float rstd = rsqrtf(fmaxf(s2 * (1.f / D) - mean * mean, 0.f) + LN_EPS);
#pragma unroll
            for (int r = 0; r < 4; ++r) {
                const int R = 4 * q + r;
                const float mr = __shfl(mean, R), rr = __shfl(rstd, R);
                const float lg = rr * (acc[r] - mr * ce) + de;
                float mx = lg;
#pragma unroll
                for (int o = 1; o < 16; o <<= 1) mx = fmaxf(mx, __shfl_xor(mx, o));
                float p = expf(lg - mx), sum = p;
#pragma unroll
                for (int o = 1; o < 16; o <<= 1) sum += __shfl_xor(sum, o);
                p = p / sum;
                const float sel = p + bre;
                int rank = 0;
#pragma unroll
                for (int o = 1; o < 4; ++o) { const float so = __shfl_xor(sel, o); const int eo = e ^ o; rank += (so > sel || (so == sel && eo < e)) ? 1 : 0; }
                float gs = rank < 2 ? sel : 0.f;
                gs += __shfl_xor(gs, 1); gs += __shfl_xor(gs, 2);
                int gi = e >> 2;
#pragma unroll
                for (int o = 4; o < 16; o <<= 1) { const float go = __shfl_xor(gs, o); const int io = __shfl_xor(gi, o); if (go > gs || (go == gs && io < gi)) { gs = go; gi = io; } }
                const bool chosen = ((e >> 2) == gi) && rank < 2;
                const unsigned long long bm = __ballot(chosen);
                const unsigned m4 = (unsigned)(bm >> (16 * q + 4 * gi)) & 0xFu;
                const int ea = __ffs((int)m4) - 1, eb = 31 - __clz((int)m4);
                const int pidx = ea == 0 ? eb - 1 : (ea == 1 ? eb + 1 : 5);
                const float pa = __shfl(p, 16 * q + 4 * gi + ea), pb = __shfl(p, 16 * q + 4 * gi + eb);
                if (e == r) { const int cls = gi * 6 + pidx; const int rl = tr0 + R; const int lp = atomicAdd((int*)&lcnt[cls], 1); rcls[rl] = cls; rpos[rl] = lp;
                    const float inv = 1.f / (pa + pb); const size_t t = (size_t)(r0 + rl); tokgate[t * 2] = pa * inv; tokgate[t * 2 + 1] = pb * inv; }
            }
        }
        __syncthreads();
        if (tid < NCLS) lbase[tid] = (int)atomicAdd(&gcnt[tid], (unsigned)lcnt[tid]);
        __syncthreads();
        if (tid < 256) { const int t = r0 + tid; const int c = rcls[tid]; tokcls[t] = c; tokpos[t] = lbase[c] + rpos[tid]; }
        __syncthreads();
    }
}
__device__ __forceinline__ void phase_permute(const Params& P, int layer, LAS unsigned char* lds, int bid, int nb) {
    const int tid = opaque_tid(), lane = tid & 63, wave = tid >> 6, nw = blockDim.x >> 6;
    LAS int* off = (LAS int*)lds;
    const unsigned* gcnt = (const unsigned*)(P.ws + WS_CTL) + CW_CNT + 64 * layer;
    int* tilecls = (int*)(P.ws + WS_TILECLS);
    if (tid == 0) { int o = 0; for (int c = 0; c < NCLS; ++c) { off[c] = o * 256; const int nt = ((int)gcnt[c] + 255) >> 8;
            if (bid == 0) for (int i = 0; i < nt; ++i) tilecls[8 + o + i] = c;
            o += nt; }
        if (bid == 0) tilecls[0] = o; }
    __syncthreads();
    const bf16_t* pre1 = (const bf16_t*)(P.out + OUT_PRE1); bf16_t* hs = (bf16_t*)(P.ws + WS_BIG + BIG_HS);
    const float* g = P.in[I_LNMG] + layer * D; const float* b = P.in[I_LNMB] + layer * D;
    const int* tokcls = (const int*)(P.ws + WS_TOKCLS); const int* tokpos = (const int*)(P.ws + WS_TOKPOS); int* tokdst = (int*)(P.ws + WS_TOKDST);
    const float* tokgate = (const float*)(P.ws + WS_TOKGATE); float* rowgate = (float*)(P.ws + WS_ROWGATE);
    for (int t = bid * nw + wave; t < T; t += nb * nw) {
        const int dst = off[tokcls[t]] + tokpos[t];
        float v[16]; load_row_bf16(pre1 + (size_t)t * D, lane, v); ln_row(v, g, b, lane);
        store_row_bf16(hs + (size_t)dst * D, lane, v);
        if (lane == 0) { tokdst[t] = dst; rowgate[(size_t)dst * 2] = tokgate[(size_t)t * 2]; rowgate[(size_t)dst * 2 + 1] = tokgate[(size_t)t * 2 + 1]; }
    }
}
__device__ __forceinline__ void phase_lnffn(const Params& P, int layer, int bid, int nb) {
    const int tid = opaque_tid(), lane = tid & 63, wave = tid >> 6, nw = blockDim.x >> 6;
    const bf16_t* pre2 = (const bf16_t*)(P.ws + WS_BIG + BIG_PRE2);
    const float* g = P.in[I_LNFG] + layer * D; const float* b = P.in[I_LNFB] + layer * D;
    const int* tokdst = (const int*)(P.ws + WS_TOKDST);
    for (int t = bid * nw + wave; t < T; t += nb * nw) {
        float v[16]; load_row_bf16(pre2 + (size_t)tokdst[t] * D, lane, v); ln_row(v, g, b, lane);
        if (layer == 0) store_row_bf16((bf16_t*)(P.out + OUT_H) + (size_t)t * D, lane, v);
        else { float* o = (float*)P.out + (size_t)t * D;
#pragma unroll
            for (int j = 0; j < 2; ++j) { *(f32x4*)(o + 8 * lane + 512 * j) = (f32x4){v[8 * j], v[8 * j + 1], v[8 * j + 2], v[8 * j + 3]}; *(f32x4*)(o + 8 * lane + 512 * j + 4) = (f32x4){v[8 * j + 4], v[8 * j + 5], v[8 * j + 6], v[8 * j + 7]}; } }
    }
}

__device__ __forceinline__ float block_sum512(float a, LAS float* red, int tid) {
    a = wave_sum(a);
    if ((tid & 63) == 0) red[tid >> 6] = a;
    __syncthreads();
    const float r = ((red[0] + red[1]) + (red[2] + red[3])) + ((red[4] + red[5]) + (red[6] + red[7]));
    __syncthreads();
    return r;
}
__device__ __forceinline__ void mix_ret_naive(const Params& P, int b, int h, LAS unsigned char* lds) {
    LAS float* qs = (LAS float*)lds; LAS float* ks = qs + 128; LAS float* yp = qs + 384; LAS float* red = qs + 896;
    const int tid = opaque_tid(), v = tid & 255, hf = tid >> 8;
    bf16_t* proj = (bf16_t*)(P.ws + WS_BIG); const int* pos = (const int*)P.in[I_POS];
    const float gamma = 1.f - exp2f(-5.f - (float)h);
    const float gn = P.in[I_RETG][h * 256 + v];
    float S[64];
#pragma unroll
    for (int d = 0; d < 64; ++d) S[d] = 0.f;
    for (int t = 0; t < SEQ; ++t) {
        bf16_t* row = proj + (size_t)(b * SEQ + t) * NP;
        if (tid < 64) { const float inv = exp2f(-(float)(2 * tid) * (13.287712379549449f / 128.f)); const float ang = (float)pos[b * SEQ + t] * inv; float sn, cs; sincosf(ang, &sn, &cs);
            const float q0 = bf2f(row[C0_RQ + h * 128 + 2 * tid]), q1 = bf2f(row[C0_RQ + h * 128 + 2 * tid + 1]);
            const float k0 = bf2f(row[C0_RK + h * 128 + 2 * tid]), k1 = bf2f(row[C0_RK + h * 128 + 2 * tid + 1]);
            qs[2 * tid] = q0 * cs - q1 * sn; qs[2 * tid + 1] = q0 * sn + q1 * cs;
            ks[2 * tid] = (k0 * cs - k1 * sn) * 0.08838834764831845f; ks[2 * tid + 1] = (k0 * sn + k1 * cs) * 0.08838834764831845f; }
        __syncthreads();
        const float vv = bf2f(row[C0_RV + h * 256 + v]); float y = 0.f;
#pragma unroll
        for (int d = 0; d < 64; ++d) { S[d] = gamma * S[d] + ks[64 * hf + d] * vv; y += qs[64 * hf + d] * S[d]; }
        yp[tid] = y;
        __syncthreads();
        const float yt = hf == 0 ? yp[v] + yp[v + 256] : 0.f;
        const float mean = block_sum512(yt, red, tid) * (1.f / 256.f); const float dv = hf == 0 ? yt - mean : 0.f;
        const float var = block_sum512(dv * dv, red, tid) * (1.f / 256.f);
        if (hf == 0) row[C0_RV + h * 256 + v] = (bf16_t)f2bf(dv * rsqrtf(var + NORM_EPS) * gn * siluf_(bf2f(row[C0_RG + h * 256 + v])));
    }
}
__device__ __forceinline__ void mix_ml_naive(const Params& P, int b, int h, LAS unsigned char* lds) {
    LAS float* qs = (LAS float*)lds; LAS float* ks = qs + 128; LAS float* yp = qs + 384; LAS float* red = qs + 896;
    const int tid = opaque_tid(), v = tid & 255, hf = tid >> 8;
    bf16_t* proj = (bf16_t*)(P.ws + WS_BIG);
    const float* cw = P.in[I_MLCW]; const float* cb = P.in[I_MLCB];
    const float bi = P.in[I_MLBI][h], bfg = P.in[I_MLBF][h];
    const float gn = P.in[I_MLG][h * 256 + v];
    float S[64];
#pragma unroll
    for (int d = 0; d < 64; ++d) S[d] = 0.f;
    float nst = 0.f;
    for (int t = 0; t < SEQ; ++t) {
        bf16_t* row = proj + (size_t)(b * SEQ + t) * NP;
        if (tid < 256) { const int c = tid & 127, isk = tid >> 7; const int ch = isk * 512 + h * 128 + c; const int col = (isk ? C0_MK : C0_MQ) + h * 128 + c; float a = cb[ch];
#pragma unroll
            for (int j = 0; j < 4; ++j) { const int tt = t - 3 + j; if (tt >= 0) a += cw[j * 1024 + ch] * bf2f(proj[(size_t)(b * SEQ + tt) * NP + col]); }
            a = siluf_(a); if (isk) ks[c] = a * 0.08838834764831845f; else qs[c] = a; }
        __syncthreads();
        const float ip = bf2f(row[C0_MI + h]) + bi, fp = bf2f(row[C0_MF + h]) + bfg;
        const float f = sigmoidf_(fp), ei = expf(ip);
        const float vv = bf2f(row[C0_MV + h * 256 + v]); float num = 0.f;
#pragma unroll
        for (int d = 0; d < 64; ++d) { S[d] = f * S[d] + (ei * ks[64 * hf + d]) * vv; num += qs[64 * hf + d] * S[d]; }
        yp[tid] = num;
        float part = 0.f;
        if (tid < 128) { nst = f * nst + ei * ks[tid]; part = qs[tid] * nst; }
        const float den = block_sum512(part, red, tid);
        float hv = 0.f;
        if (hf == 0) { hv = (yp[v] + yp[v + 256]) / fmaxf(fabsf(den), 1.f); hv *= sigmoidf_(bf2f(row[C0_MO + h * 256 + v])); }
        const float mean = block_sum512(hv, red, tid) * (1.f / 256.f); const float dv = hf == 0 ? hv - mean : 0.f;
        const float var = block_sum512(dv * dv, red, tid) * (1.f / 256.f);
        if (hf == 0) row[C0_MV + h * 256 + v] = (bf16_t)f2bf(dv * rsqrtf(var + NORM_EPS) * gn);
    }
}
__device__ __forceinline__ void mix_gla_naive(const Params& P, int b, int h, LAS unsigned char* lds) {
    LAS float* qs = (LAS float*)lds; LAS float* ks = qs + 128; LAS float* al = qs + 256; LAS float* yp = qs + 384; LAS float* red = qs + 896;
    const int tid = opaque_tid(), v = tid & 255, hf = tid >> 8;
    bf16_t* proj = (bf16_t*)(P.ws + WS_BIG);
    const float* wa = P.in[I_GLAWA]; const float* ba = P.in[I_GLABA];
    const float gn = P.in[I_GLAG][h * 256 + v];
    float S[64];
#pragma unroll
    for (int d = 0; d < 64; ++d) S[d] = 0.f;
    for (int t = 0; t < SEQ; ++t) {
        bf16_t* row = proj + (size_t)(b * SEQ + t) * NP;
        if (tid < 128) { const int ch = h * 128 + tid; float a = ba[ch];
#pragma unroll
            for (int r = 0; r < 16; ++r) a += bf2f(row[C1_GA + r]) * wa[r * 512 + ch];
            al[tid] = expf(logsigmoidf_(a) * (1.f / 16.f));
            qs[tid] = bf2f(row[C1_GQ + ch]) * 0.08838834764831845f; ks[tid] = bf2f(row[C1_GK + ch]); }
        __syncthreads();
        const float vv = bf2f(row[C1_GV + h * 256 + v]); float y = 0.f;
#pragma unroll
        for (int d = 0; d < 64; ++d) { S[d] = al[64 * hf + d] * S[d] + ks[64 * hf + d] * vv; y += qs[64 * hf + d] * S[d]; }
        yp[tid] = y;
        __syncthreads();
        const float yt = hf == 0 ? yp[v] + yp[v + 256] : 0.f;
        const float ms = block_sum512(yt * yt, red, tid) * (1.f / 256.f);
        if (hf == 0) row[C1_GV + h * 256 + v] = (bf16_t)f2bf(yt * rsqrtf(ms + NORM_EPS) * gn * siluf_(bf2f(row[C1_GR + h * 256 + v])));
    }
}
__device__ __forceinline__ void mix_ssd_naive(const Params& P, int b, int g, LAS unsigned char* lds) {
    LAS float* Bs = (LAS float*)lds; LAS float* Cs = Bs + 128; LAS float* yp = Bs + 384; LAS float* red = Bs + 896;
    const int tid = opaque_tid(), v = tid & 255, hf = tid >> 8, r = v >> 6, p = v & 63, hd = g * 4 + r;
    bf16_t* proj = (bf16_t*)(P.ws + WS_BIG);
    const float* cw = P.in[I_SSDCW]; const float* cb = P.in[I_SSDCB];
    const float dtb = P.in[I_SSDDTB][hd], A = -expf(P.in[I_SSDALOG][hd]), Dp = P.in[I_SSDD][hd];
    const float gn = P.in[I_SSDG][g * 256 + v];
    float S[64];
#pragma unroll
    for (int d = 0; d < 64; ++d) S[d] = 0.f;
    for (int t = 0; t < SEQ; ++t) {
        bf16_t* row = proj + (size_t)(b * SEQ + t) * NP;
        if (tid < 256) { const int n = tid & 127; const int ch = (tid < 128 ? 1024 : 1536) + g * 128 + n; const int col = (tid < 128 ? C1_BM : C1_CM) + g * 128 + n; float a = cb[ch];
#pragma unroll
            for (int j = 0; j < 4; ++j) { const int tt = t - 3 + j; if (tt >= 0) a += cw[j * 2048 + ch] * bf2f(proj[(size_t)(b * SEQ + tt) * NP + col]); }
            a = siluf_(a); if (tid < 128) Bs[n] = a; else Cs[n] = a; }
        float xv; { const int ch = hd * 64 + p; float a = cb[ch];
#pragma unroll
            for (int j = 0; j < 4; ++j) { const int tt = t - 3 + j; if (tt >= 0) a += cw[j * 2048 + ch] * bf2f(proj[(size_t)(b * SEQ + tt) * NP + C1_XS + ch]); }
            xv = siluf_(a); }
        const float dt = softplusf_(bf2f(row[C1_DT + hd]) + dtb); const float dec = expf(dt * A); const float xd = xv * dt;
        __syncthreads();
        float y = 0.f;
#pragma unroll
        for (int n = 0; n < 64; ++n) { S[n] = dec * S[n] + Bs[64 * hf + n] * xd; y += Cs[64 * hf + n] * S[n]; }
        yp[tid] = y;
        __syncthreads();
        float yt = 0.f;
        if (hf == 0) { yt = yp[v] + yp[v + 256] + Dp * xv; yt *= siluf_(bf2f(row[C1_SZ + hd * 64 + p])); }
        const float ms = block_sum512(yt * yt, red, tid) * (1.f / 256.f);
        if (hf == 0) row[C1_SZ + hd * 64 + p] = (bf16_t)f2bf(yt * rsqrtf(ms + NORM_EPS) * gn);
    }
}

enum { MIX_RET = 0, MIX_ML = 1, MIX_GLA = 2, MIX_SSD = 3 };
typedef short s16x4 __attribute__((ext_vector_type(4)));
__device__ __forceinline__ bf16x8 tr_frag(LAS unsigned char* p0, LAS unsigned char* p1) {
    const s16x4 a = __builtin_amdgcn_ds_read_tr16_b64_v4i16((LAS s16x4*)p0), b = __builtin_amdgcn_ds_read_tr16_b64_v4i16((LAS s16x4*)p1);
    return (bf16x8){a[0], a[1], a[2], a[3], b[0], b[1], b[2], b[3]};
}
__device__ __forceinline__ bf16x8 cat_frag(LAS unsigned char* p0, LAS unsigned char* p1) {
    const s16x4 a = *(LAS s16x4*)p0, b = *(LAS s16x4*)p1;
    return (bf16x8){a[0], a[1], a[2], a[3], b[0], b[1], b[2], b[3]};
}
__device__ __forceinline__ bf16x8 pack_acc(const f32x4& lo, const f32x4& hi) {
    u32x4 w; w.x = pg8::cvt_pk_bf16(lo[0], lo[1]); w.y = pg8::cvt_pk_bf16(lo[2], lo[3]); w.z = pg8::cvt_pk_bf16(hi[0], hi[1]); w.w = pg8::cvt_pk_bf16(hi[2], hi[3]);
    return __builtin_bit_cast(bf16x8, w);
}
__device__ __forceinline__ void unpack8(const u32x4& w, float (&v)[8]) {
    v[0] = bflo(w.x); v[1] = bfhi(w.x); v[2] = bflo(w.y); v[3] = bfhi(w.y); v[4] = bflo(w.z); v[5] = bfhi(w.z); v[6] = bflo(w.w); v[7] = bfhi(w.w);
}
__device__ __forceinline__ u32x4 pack8(const float (&v)[8]) {
    u32x4 w; w.x = pg8::cvt_pk_bf16(v[0], v[1]); w.y = pg8::cvt_pk_bf16(v[2], v[3]); w.z = pg8::cvt_pk_bf16(v[4], v[5]); w.w = pg8::cvt_pk_bf16(v[6], v[7]); return w;
}

__device__ __forceinline__ void conv8_silu(const bf16_t* src, const int nprev  , const float* cw, const int ldw, const float* cb, float (&o)[8]) {
    { const f32x4 b0 = *(const f32x4*)cb, b1 = *(const f32x4*)(cb + 4);
#pragma unroll
      for (int j = 0; j < 4; ++j) { o[j] = b0[j]; o[4 + j] = b1[j]; } }
#pragma unroll
    for (int k = 0; k < 4; ++k) {
        if (3 - k <= nprev) {
            const u32x4 xw = *(const u32x4*)(src - (size_t)(3 - k) * NP); float x[8]; unpack8(xw, x);
            const f32x4 w0 = *(const f32x4*)(cw + k * ldw), w1 = *(const f32x4*)(cw + k * ldw + 4);
#pragma unroll
            for (int j = 0; j < 4; ++j) { o[j] += w0[j] * x[j]; o[4 + j] += w1[j] * x[4 + j]; }
        }
    }
#pragma unroll
    for (int j = 0; j < 8; ++j) o[j] = siluf_(o[j]);
}

template <int MIX>
__device__ __forceinline__ void mixer_unit(const Params& P, const int b, const int h, LAS unsigned char* lds) {
    const int tid = opaque_tid(), lane = tid & 63, w = __builtin_amdgcn_readfirstlane(tid >> 6), c = lane & 15, g = lane >> 4, q4 = (lane >> 2) & 3, p4 = lane & 3;
    typedef unsigned u32x2 __attribute__((ext_vector_type(2)));
    constexpr int RSQ = 272, RSV = 528, RSP = 144;
    constexpr int OQ = 0, OK1 = 17408, OV = 34816, O3 = 68608;
    constexpr int OK2 = (MIX == MIX_ML || MIX == MIX_GLA) ? O3 : OK1;
    constexpr int OV2 = (MIX == MIX_SSD) ? O3 : OV;
    constexpr int OP = MIX == MIX_RET ? O3 : (MIX == MIX_SSD ? O3 + 33792 : O3 + 17408);
    constexpr int NPV = MIX == MIX_SSD ? 4 : 1;
    constexpr int OT = OP + NPV * 9216;
    constexpr int OY = OV2;
    LAS float* tab = (LAS float*)(lds + OT);
    static_assert(OT + (MIX == MIX_GLA ? 35328 : 4096) <= 163840 - 16, "lds map");
    bf16_t* proj = (bf16_t*)(P.ws + WS_BIG);
    const size_t row0b = (size_t)b * SEQ;
    f32x4 Sacc[8][2];
#pragma unroll
    for (int rt = 0; rt < 8; ++rt)
#pragma unroll
        for (int ct = 0; ct < 2; ++ct) Sacc[rt][ct] = (f32x4){0.f, 0.f, 0.f, 0.f};
    float gam = 1.f, lg2gam = 0.f;
    if constexpr (MIX == MIX_RET) { gam = 1.f - exp2f(-5.f - (float)h); lg2gam = log2f(gam); }
    if constexpr (MIX == MIX_ML) { if (tid < 128) tab[512 + tid] = 0.f; if (tid == 0) tab[641] = 0.f; __syncthreads(); }

#pragma unroll 1
    for (int ch = 0; ch < SEQ / 64; ++ch) {
        const size_t row0 = row0b + (size_t)ch * 64;
        if constexpr (MIX == MIX_RET) {
            const int* pos = (const int*)P.in[I_POS];
#pragma unroll
            for (int i = 0; i < 2; ++i) {
                const int pi = tid + 512 * i, r = pi >> 4, c8 = pi & 15;
                const bf16_t* rp = proj + (row0 + r) * NP + h * 128 + 8 * c8;
                const u32x4 qw = *(const u32x4*)(rp + C0_RQ), kw = *(const u32x4*)(rp + C0_RK);
                float qv[8], kv[8]; unpack8(qw, qv); unpack8(kw, kv);
                const float ps = (float)pos[row0 + r];
                const float fq = exp2f((float)r * lg2gam), fk = 0.08838834764831845f / fq;
#pragma unroll
                for (int i2 = 0; i2 < 4; ++i2) {
                    const float inv = exp2f(-(float)(2 * (4 * c8 + i2)) * (13.287712379549449f / 128.f));
                    float sn, cs; sincosf(ps * inv, &sn, &cs);
                    const float q0 = qv[2 * i2], q1 = qv[2 * i2 + 1], k0 = kv[2 * i2], k1 = kv[2 * i2 + 1];
                    qv[2 * i2] = (q0 * cs - q1 * sn) * fq; qv[2 * i2 + 1] = (q0 * sn + q1 * cs) * fq;
                    kv[2 * i2] = (k0 * cs - k1 * sn) * fk; kv[2 * i2 + 1] = (k0 * sn + k1 * cs) * fk;
                }
                *(LAS u32x4*)(lds + OQ + RSQ * r + 16 * c8) = pack8(qv);
                *(LAS u32x4*)(lds + OK1 + RSQ * r + 16 * c8) = pack8(kv);
            }
#pragma unroll
            for (int i = 0; i < 4; ++i) {
                const int pi = tid + 512 * i, r = pi >> 5, c8 = pi & 31;
                *(LAS u32x4*)(lds + OV + RSV * r + 16 * c8) = *(const u32x4*)(proj + (row0 + r) * NP + C0_RV + h * 256 + 8 * c8);
            }
        }
        if constexpr (MIX == MIX_GLA) {
            {
                const int d = tid & 127, tq = tid >> 7;
                const float* wa = P.in[I_GLAWA] + h * 128 + d; const float ba = P.in[I_GLABA][h * 128 + d];
                float wv[16];
#pragma unroll
                for (int r = 0; r < 16; ++r) wv[r] = wa[r * 512];
                float run = 0.f;
#pragma unroll 4
                for (int i = 0; i < 16; ++i) {
                    const int t = 16 * tq + i;
                    const bf16_t* gp = proj + (row0 + t) * NP + C1_GA;
                    const u32x4 g0 = *(const u32x4*)gp, g1 = *(const u32x4*)(gp + 8); float gv[8], gv2[8]; unpack8(g0, gv); unpack8(g1, gv2);
                    float a = ba;
#pragma unroll
                    for (int r = 0; r < 8; ++r) a += gv[r] * wv[r] + gv2[r] * wv[8 + r];
                    run += logsigmoidf_(a) * (1.f / 16.f);
                    tab[t * 128 + d] = run;
                }
                tab[8192 + tq * 128 + d] = run;
            }
            __syncthreads();
            if (tid < 128) tab[8704 + tid] = expf((tab[8192 + tid] + tab[8192 + 128 + tid]) + (tab[8192 + 256 + tid] + tab[8192 + 384 + tid]));
#pragma unroll
            for (int i = 0; i < 2; ++i) {
                const int pi = tid + 512 * i, r = pi >> 4, c8 = pi & 15, tq = r >> 4;
                const bf16_t* rp = proj + (row0 + r) * NP + h * 128 + 8 * c8;
                const u32x4 qw = *(const u32x4*)(rp + C1_GQ), kw = *(const u32x4*)(rp + C1_GK);
                float qv[8], kv[8], k2[8]; unpack8(qw, qv); unpack8(kw, kv);
#pragma unroll
                for (int hh = 0; hh < 2; ++hh) {
                    const int d0 = 8 * c8 + 4 * hh;
                    f32x4 bc = *(LAS f32x4*)(tab + r * 128 + d0);
                    const f32x4 t0 = *(LAS f32x4*)(tab + 8192 + d0), t1 = *(LAS f32x4*)(tab + 8192 + 128 + d0), t2 = *(LAS f32x4*)(tab + 8192 + 256 + d0), t3 = *(LAS f32x4*)(tab + 8192 + 384 + d0);
                    if (tq > 0) bc = bc + t0; if (tq > 1) bc = bc + t1; if (tq > 2) bc = bc + t2;
                    const f32x4 bt = (t0 + t1) + (t2 + t3);
#pragma unroll
                    for (int j = 0; j < 4; ++j) { const float eb = expf(bc[j]); const float kk = kv[4 * hh + j];
                        qv[4 * hh + j] = qv[4 * hh + j] * 0.08838834764831845f * eb; kv[4 * hh + j] = kk / eb; k2[4 * hh + j] = kk * expf(bt[j] - bc[j]); }
                }
                *(LAS u32x4*)(lds + OQ + RSQ * r + 16 * c8) = pack8(qv);
                *(LAS u32x4*)(lds + OK1 + RSQ * r + 16 * c8) = pack8(kv);
                *(LAS u32x4*)(lds + OK2 + RSQ * r + 16 * c8) = pack8(k2);
            }
#pragma unroll
            for (int i = 0; i < 4; ++i) {
                const int pi = tid + 512 * i, r = pi >> 5, c8 = pi & 31;
                *(LAS u32x4*)(lds + OV + RSV * r + 16 * c8) = *(const u32x4*)(proj + (row0 + r) * NP + C1_GV + h * 256 + 8 * c8);
            }
        }
        if constexpr (MIX == MIX_ML) {
            if (w == 0) {
                const bf16_t* rp = proj + (row0 + lane) * NP;
                const float ip = bf2f(rp[C0_MI + h]) + P.in[I_MLBI][h], lf = logsigmoidf_(bf2f(rp[C0_MF + h]) + P.in[I_MLBF][h]);
                float bc = lf;
#pragma unroll
                for (int o = 1; o < 64; o <<= 1) { const float v = __shfl_up(bc, o); if (lane >= o) bc += v; }
                const float u = ip - bc; float pm = u;
#pragma unroll
                for (int o = 1; o < 64; o <<= 1) { const float v = __shfl_up(pm, o); if (lane >= o) pm = fmaxf(pm, v); }
                const float mst = tab[641];
                const float M = fmaxf(mst, pm), M63 = __shfl(M, 63), bt = __shfl(bc, 63);
                tab[lane] = u; tab[64 + lane] = M; tab[128 + lane] = expf(u - M63); tab[192 + lane] = expf(mst - M); tab[256 + lane] = expf(-bc - M);
                if (lane == 0) { tab[640] = expf(mst - M63); tab[642] = bt + M63; }
            }
            const float* cw = P.in[I_MLCW]; const float* cb = P.in[I_MLCB];
#pragma unroll
            for (int i = 0; i < 4; ++i) {
                const int pi = tid + 512 * (i & 1), r = pi >> 4, c8 = pi & 15, isk = i >> 1;
                const int chn = isk * 512 + h * 128 + 8 * c8;
                float o[8]; conv8_silu(proj + (row0 + r) * NP + (isk ? C0_MK : C0_MQ) + h * 128 + 8 * c8, ch * 64 + r, cw + chn, 1024, cb + chn, o);
                if (isk) {
#pragma unroll
                    for (int j = 0; j < 8; ++j) o[j] *= 0.08838834764831845f; }
                *(LAS u32x4*)(lds + (isk ? OK1 : OQ) + RSQ * r + 16 * c8) = pack8(o);
            }
#pragma unroll
            for (int i = 0; i < 4; ++i) {
                const int pi = tid + 512 * i, r = pi >> 5, c8 = pi & 31;
                *(LAS u32x4*)(lds + OV + RSV * r + 16 * c8) = *(const u32x4*)(proj + (row0 + r) * NP + C0_MV + h * 256 + 8 * c8);
            }
            __syncthreads();
#pragma unroll
            for (int i = 0; i < 2; ++i) {
                const int pi = tid + 512 * i, r = pi >> 4, c8 = pi & 15;
                const u32x4 kw = *(LAS u32x4*)(lds + OK1 + RSQ * r + 16 * c8); float kv[8]; unpack8(kw, kv); const float es = tab[128 + r];
#pragma unroll
                for (int j = 0; j < 8; ++j) kv[j] *= es;
                *(LAS u32x4*)(lds + OK2 + RSQ * r + 16 * c8) = pack8(kv);
            }
            {
                const int t = tid >> 3, part = tid & 7; float a = 0.f;
#pragma unroll
                for (int i = 0; i < 2; ++i) { const u32x4 qw = *(LAS u32x4*)(lds + OQ + RSQ * t + 2 * (16 * part + 8 * i)); float qv[8]; unpack8(qw, qv);
                    const f32x4 n0 = *(LAS f32x4*)(tab + 512 + 16 * part + 8 * i), n1 = *(LAS f32x4*)(tab + 512 + 16 * part + 8 * i + 4);
#pragma unroll
                    for (int j = 0; j < 4; ++j) a += qv[j] * n0[j] + qv[4 + j] * n1[j]; }
                a += __shfl_xor(a, 1); a += __shfl_xor(a, 2); a += __shfl_xor(a, 4);
                if (part == 0) tab[448 + t] = a;
            }
        }
        if constexpr (MIX == MIX_SSD) {
            if (w < 4) {
                const int hd = 4 * h + w;
                const float dt = softplusf_(bf2f(proj[(row0 + lane) * NP + C1_DT + hd]) + P.in[I_SSDDTB][hd]);
                float cm = dt * (-expf(P.in[I_SSDALOG][hd]));
#pragma unroll
                for (int o = 1; o < 64; o <<= 1) { const float v = __shfl_up(cm, o); if (lane >= o) cm += v; }
                tab[lane * 4 + w] = cm; tab[256 + lane * 4 + w] = dt;
            }
            const float* cw = P.in[I_SSDCW]; const float* cb = P.in[I_SSDCB];
#pragma unroll
            for (int i = 0; i < 4; ++i) {
                const int pi = tid + 512 * (i & 1), r = pi >> 4, c8 = pi & 15, isb = i >> 1;
                const int chn = (isb ? 1024 : 1536) + h * 128 + 8 * c8;
                float o[8]; conv8_silu(proj + (row0 + r) * NP + (isb ? C1_BM : C1_CM) + h * 128 + 8 * c8, ch * 64 + r, cw + chn, 2048, cb + chn, o);
                *(LAS u32x4*)(lds + (isb ? OK1 : OQ) + RSQ * r + 16 * c8) = pack8(o);
            }
            __syncthreads();
#pragma unroll
            for (int i = 0; i < 4; ++i) {
                const int pi = tid + 512 * i, r = pi >> 5, c8 = pi & 31, hr = c8 >> 3;
                const int chn = h * 256 + 8 * c8;
                float o[8], o2[8]; conv8_silu(proj + (row0 + r) * NP + C1_XS + chn, ch * 64 + r, cw + chn, 2048, cb + chn, o);
                const float dt = tab[256 + r * 4 + hr], e2 = expf(tab[63 * 4 + hr] - tab[r * 4 + hr]);
#pragma unroll
                for (int j = 0; j < 8; ++j) { o[j] *= dt; o2[j] = o[j] * e2; }
                *(LAS u32x4*)(lds + OV + RSV * r + 16 * c8) = pack8(o);
                *(LAS u32x4*)(lds + OV2 + RSV * r + 16 * c8) = pack8(o2);
            }
        }
        __syncthreads();
        {
            const int tt = w >> 1; float rsum = 0.f;
#pragma unroll
            for (int si = 0; si < 2; ++si) {
                const int ss = 2 * (w & 1) + si;
                f32x4 acc = (f32x4){0.f, 0.f, 0.f, 0.f};
#pragma unroll
                for (int ks = 0; ks < 4; ++ks) {
                    const bf16x8 a = *(LAS bf16x8*)(lds + OK1 + RSQ * (16 * ss + c) + 2 * (32 * ks + 8 * g));
                    const bf16x8 bq = *(LAS bf16x8*)(lds + OQ + RSQ * (16 * tt + c) + 2 * (32 * ks + 8 * g));
                    acc = __builtin_amdgcn_mfma_f32_16x16x32_bf16(a, bq, acc, 0, 0, 0);
                }
                const int t = 16 * tt + c, s0 = 16 * ss + 4 * g;
                if constexpr (MIX == MIX_SSD) {
                    const f32x4 ct_ = *(LAS f32x4*)(tab + t * 4);
#pragma unroll
                    for (int hr = 0; hr < 4; ++hr) { float pv[4];
#pragma unroll
                        for (int r = 0; r < 4; ++r) pv[r] = (s0 + r <= t) ? acc[r] * expf(ct_[hr] - tab[(s0 + r) * 4 + hr]) : 0.f;
                        *(LAS u32x2*)(lds + OP + hr * 9216 + RSP * t + 2 * s0) = (u32x2){pg8::cvt_pk_bf16(pv[0], pv[1]), pg8::cvt_pk_bf16(pv[2], pv[3])}; }
                } else {
                    float pv[4];
                    if constexpr (MIX == MIX_ML) { const f32x4 us = *(LAS f32x4*)(tab + s0); const float Mt = tab[64 + t];
#pragma unroll
                        for (int r = 0; r < 4; ++r) { pv[r] = (s0 + r <= t) ? acc[r] * expf(us[r] - Mt) : 0.f; rsum += pv[r]; } }
                    else {
#pragma unroll
                        for (int r = 0; r < 4; ++r) pv[r] = (s0 + r <= t) ? acc[r] : 0.f; }
                    *(LAS u32x2*)(lds + OP + RSP * t + 2 * s0) = (u32x2){pg8::cvt_pk_bf16(pv[0], pv[1]), pg8::cvt_pk_bf16(pv[2], pv[3])};
                }
            }
            if constexpr (MIX == MIX_ML) { rsum += __shfl_xor(rsum, 16); rsum += __shfl_xor(rsum, 32); if (g == 0) tab[320 + (w & 1) * 64 + 16 * tt + c] = rsum; }
        }
        __syncthreads();
        f32x4 Yacc[2][4];
#pragma unroll
        for (int ct = 0; ct < 2; ++ct)
#pragma unroll
            for (int tt = 0; tt < 4; ++tt) Yacc[ct][tt] = (f32x4){0.f, 0.f, 0.f, 0.f};
#pragma unroll
        for (int kd = 0; kd < 4; ++kd) {
            bf16x8 qf[4];
#pragma unroll
            for (int tt = 0; tt < 4; ++tt) { LAS unsigned char* qp = lds + OQ + RSQ * (16 * tt + c) + 2 * (32 * kd + 4 * g); qf[tt] = cat_frag(qp, qp + 32); }
#pragma unroll
            for (int ct = 0; ct < 2; ++ct) { const bf16x8 sf = pack_acc(Sacc[2 * kd][ct], Sacc[2 * kd + 1][ct]);
#pragma unroll
                for (int tt = 0; tt < 4; ++tt) Yacc[ct][tt] = __builtin_amdgcn_mfma_f32_16x16x32_bf16(sf, qf[tt], Yacc[ct][tt], 0, 0, 0); }
        }
        if constexpr (MIX != MIX_GLA) {
#pragma unroll
            for (int tt = 0; tt < 4; ++tt) {
                float rs = gam;
                if constexpr (MIX == MIX_ML) rs = tab[192 + 16 * tt + c];
                if constexpr (MIX == MIX_SSD) rs = expf(tab[(16 * tt + c) * 4 + (w >> 1)]);
#pragma unroll
                for (int ct = 0; ct < 2; ++ct) Yacc[ct][tt] = Yacc[ct][tt] * rs;
            }
        }
        bf16x8 Vf[2][2];
#pragma unroll
        for (int ks = 0; ks < 2; ++ks)
#pragma unroll
            for (int ct = 0; ct < 2; ++ct) { LAS unsigned char* vp = lds + OV + RSV * (32 * ks + 8 * g + q4) + 2 * (32 * w + 16 * ct) + 8 * p4; Vf[ks][ct] = tr_frag(vp, vp + 4 * RSV); }
#pragma unroll
        for (int ks = 0; ks < 2; ++ks)
#pragma unroll
            for (int tt = 0; tt < 4; ++tt) { const bf16x8 pf = *(LAS bf16x8*)(lds + OP + (MIX == MIX_SSD ? (w >> 1) * 9216 : 0) + RSP * (16 * tt + c) + 2 * (32 * ks + 8 * g));
#pragma unroll
                for (int ct = 0; ct < 2; ++ct) Yacc[ct][tt] = __builtin_amdgcn_mfma_f32_16x16x32_bf16(Vf[ks][ct], pf, Yacc[ct][tt], 0, 0, 0); }
        if constexpr (MIX == MIX_GLA) {
#pragma unroll
            for (int rt = 0; rt < 8; ++rt) { const f32x4 dc = *(LAS f32x4*)(tab + 8704 + 16 * rt + 4 * g);
#pragma unroll
                for (int ct = 0; ct < 2; ++ct) Sacc[rt][ct] = Sacc[rt][ct] * dc; }
        } else {
            float dc = gam;
            if constexpr (MIX == MIX_ML) dc = tab[640];
            if constexpr (MIX == MIX_SSD) dc = expf(tab[63 * 4 + (w >> 1)]);
#pragma unroll
            for (int rt = 0; rt < 8; ++rt)
#pragma unroll
                for (int ct = 0; ct < 2; ++ct) Sacc[rt][ct] = Sacc[rt][ct] * dc;
        }
        if constexpr (MIX == MIX_SSD) {
#pragma unroll
            for (int ks = 0; ks < 2; ++ks)
#pragma unroll
                for (int ct = 0; ct < 2; ++ct) { LAS unsigned char* vp = lds + OV2 + RSV * (32 * ks + 8 * g + q4) + 2 * (32 * w + 16 * ct) + 8 * p4; Vf[ks][ct] = tr_frag(vp, vp + 4 * RSV); }
        }
#pragma unroll
        for (int rt = 0; rt < 8; ++rt)
#pragma unroll
            for (int ks = 0; ks < 2; ++ks) { LAS unsigned char* kp = lds + OK2 + RSQ * (32 * ks + 8 * g + q4) + 2 * (16 * rt) + 8 * p4; const bf16x8 kf = tr_frag(kp, kp + 4 * RSQ);
#pragma unroll
                for (int ct = 0; ct < 2; ++ct) Sacc[rt][ct] = __builtin_amdgcn_mfma_f32_16x16x32_bf16(kf, Vf[ks][ct], Sacc[rt][ct], 0, 0, 0); }
        if constexpr (MIX == MIX_RET) {
            const float g63 = exp2f(63.f * lg2gam);
#pragma unroll
            for (int rt = 0; rt < 8; ++rt)
#pragma unroll
                for (int ct = 0; ct < 2; ++ct) Sacc[rt][ct] = Sacc[rt][ct] * g63;
        }
        if constexpr (MIX == MIX_ML) {
            if (tid < 128) { float a = 0.f;
#pragma unroll 8
                for (int s = 0; s < 64; ++s) a += bf2f(*(LAS unsigned short*)(lds + OK2 + RSQ * s + 2 * tid));
                tab[512 + tid] = tab[640] * tab[512 + tid] + a; }
        }
        __syncthreads();
#pragma unroll
        for (int ct = 0; ct < 2; ++ct)
#pragma unroll
            for (int tt = 0; tt < 4; ++tt)
                *(LAS u32x2*)(lds + OY + RSV * (16 * tt + c) + 2 * (32 * w + 16 * ct + 4 * g)) = (u32x2){pg8::cvt_pk_bf16(Yacc[ct][tt][0], Yacc[ct][tt][1]), pg8::cvt_pk_bf16(Yacc[ct][tt][2], Yacc[ct][tt][3])};
        __syncthreads();
        {
            const int t = tid >> 3, part = tid & 7;
            float y[32];
#pragma unroll
            for (int i = 0; i < 4; ++i) { const u32x4 yw = *(LAS u32x4*)(lds + OY + RSV * t + 2 * (32 * part + 8 * i)); float t8[8]; unpack8(yw, t8);
#pragma unroll
                for (int j = 0; j < 8; ++j) y[8 * i + j] = t8[j]; }
            constexpr int GCOL = MIX == MIX_RET ? C0_RG : MIX == MIX_ML ? C0_MO : MIX == MIX_GLA ? C1_GR : C1_SZ;
            constexpr int OCOL = MIX == MIX_RET ? C0_RV : MIX == MIX_ML ? C0_MV : MIX == MIX_GLA ? C1_GV : C1_SZ;
            constexpr int GIDX = MIX == MIX_RET ? I_RETG : MIX == MIX_ML ? I_MLG : MIX == MIX_GLA ? I_GLAG : I_SSDG;
            bf16_t* rp = proj + (row0 + t) * NP + h * 256 + 32 * part;
            const float* gp = P.in[GIDX] + h * 256 + 32 * part;
            float gt[32];
#pragma unroll
            for (int i = 0; i < 4; ++i) { const u32x4 gw = *(const u32x4*)(rp + GCOL + 8 * i); float t8[8]; unpack8(gw, t8);
#pragma unroll
                for (int j = 0; j < 8; ++j) gt[8 * i + j] = t8[j]; }
            if constexpr (MIX == MIX_ML) {
                const float den = (tab[320 + t] + tab[384 + t]) + tab[192 + t] * tab[448 + t];
                const float idn = 1.f / fmaxf(fabsf(den), tab[256 + t]);
#pragma unroll
                for (int j = 0; j < 32; ++j) y[j] = y[j] * idn * sigmoidf_(gt[j]);
            }
            if constexpr (MIX == MIX_SSD) {
                const int hd = 4 * h + (part >> 1); const float dsk = P.in[I_SSDD][hd] / tab[256 + t * 4 + (part >> 1)];
#pragma unroll
                for (int i = 0; i < 4; ++i) { const u32x4 xw = *(LAS u32x4*)(lds + OV + RSV * t + 2 * (32 * part + 8 * i)); float t8[8]; unpack8(xw, t8);
#pragma unroll
                    for (int j = 0; j < 8; ++j) y[8 * i + j] = (y[8 * i + j] + dsk * t8[j]) * siluf_(gt[8 * i + j]); }
            }
            float mean = 0.f;
            if constexpr (MIX == MIX_RET || MIX == MIX_ML) {
                float s1 = 0.f;
#pragma unroll
                for (int j = 0; j < 32; ++j) s1 += y[j];
                s1 += __shfl_xor(s1, 1); s1 += __shfl_xor(s1, 2); s1 += __shfl_xor(s1, 4);
                mean = s1 * (1.f / 256.f);
            }
            float s2 = 0.f;
#pragma unroll
            for (int j = 0; j < 32; ++j) { y[j] -= mean; s2 += y[j] * y[j]; }
            s2 += __shfl_xor(s2, 1); s2 += __shfl_xor(s2, 2); s2 += __shfl_xor(s2, 4);
            const float rstd = rsqrtf(s2 * (1.f / 256.f) + NORM_EPS);
#pragma unroll
            for (int i = 0; i < 4; ++i) {
                const f32x4 n0 = *(const f32x4*)(gp + 8 * i), n1 = *(const f32x4*)(gp + 8 * i + 4); float o[8];
#pragma unroll
                for (int j = 0; j < 4; ++j) { o[j] = y[8 * i + j] * rstd * n0[j]; o[4 + j] = y[8 * i + 4 + j] * rstd * n1[j]; }
                if constexpr (MIX == MIX_RET || MIX == MIX_GLA) {
#pragma unroll
                    for (int j = 0; j < 8; ++j) o[j] *= siluf_(gt[8 * i + j]); }
                *(u32x4*)(rp + OCOL + 8 * i) = pack8(o);
            }
            if constexpr (MIX == MIX_ML) { if (tid == 0) tab[641] = tab[642]; }
        }
        __syncthreads();
    }
}

#define XB_TMO      128
#define XB_XCNT(j)  (256  + 64 * (j))
#define XB_XSUB(j)  (1280 + 64 * (j))
#define XB_XGEN(j)  (2304 + 64 * (j))
#define XB_TOP      3328
#define XB_TOPGEN   3392
#define XCD_BAR_WORDS 3456
#define XB_SPIN_CAP (1u << 18)
__device__ __forceinline__ unsigned xb_ld(unsigned* p)              { return __hip_atomic_load(p, __ATOMIC_RELAXED, __HIP_MEMORY_SCOPE_AGENT); }
__device__ __forceinline__ unsigned xb_add(unsigned* p, unsigned v) { return __hip_atomic_fetch_add(p, v, __ATOMIC_RELAXED, __HIP_MEMORY_SCOPE_AGENT); }
__device__ __forceinline__ unsigned xb_xcc_id() { return (unsigned)__builtin_amdgcn_s_getreg((3 << 11) | 20) & 0xFu; }
#define XB_SPIN(cond, bar) do { unsigned _sp = 0; while (cond) { __builtin_amdgcn_s_sleep(1); \
    if ((++_sp & 255u) == 0u) { if (xb_ld(&(bar)[XB_TMO])) break; if (_sp > XB_SPIN_CAP) { atomicAdd(&(bar)[XB_TMO], 1u); break; } } } } while (0)
struct XcdBarrier { unsigned* bar; unsigned x; volatile LAS unsigned* st; };
__device__ __forceinline__ XcdBarrier xcd_barrier_post(unsigned* bar, volatile LAS unsigned* st) {
    XcdBarrier b; b.bar = bar; b.x = xb_xcc_id(); b.st = st;
    if (threadIdx.x == 0) (void)xb_add(&bar[XB_XCNT(b.x)], 1u);
    return b;
}
__device__ __forceinline__ void xcd_barrier_complete(unsigned* bar, unsigned x, unsigned& nloc, unsigned& nx) {
    const unsigned G = gridDim.x * gridDim.y * gridDim.z;
    unsigned sum, cnt, mine, sp = 0u;
    for (;;) {
        sum = 0u; cnt = 0u; mine = 0u;
#pragma unroll
        for (unsigned j = 0; j < 16; ++j) { const unsigned c = xb_ld(&bar[XB_XCNT(j)]); sum += c; cnt += (c > 0u) ? 1u : 0u; mine = (j == x) ? c : mine; }
        if (sum == G) break;
        __builtin_amdgcn_s_sleep(1);
        if ((++sp & 255u) == 0u) { if (xb_ld(&bar[XB_TMO])) break; if (sp > XB_SPIN_CAP) { atomicAdd(&bar[XB_TMO], 1u); break; } }
    }
    nloc = mine > 0u ? mine : 1u; nx = cnt > 0u ? cnt : 1u;
}
__device__ __forceinline__ void xcd_barrier(const XcdBarrier& b) {
    asm volatile("s_waitcnt vmcnt(0)" ::: "memory");
    __syncthreads();
    if (threadIdx.x == 0) {
        unsigned* bar = b.bar;
        __builtin_amdgcn_s_waitcnt(0);
        unsigned nloc = b.st[0], nx = b.st[1];
        if (nloc == 0u) { xcd_barrier_complete(bar, b.x, nloc, nx); b.st[0] = nloc; b.st[1] = nx; }
        const unsigned old = xb_add(&bar[XB_XSUB(b.x)], 1u);
        const unsigned gen = old / nloc;
        if (old + 1u == (gen + 1u) * nloc) {
            __builtin_amdgcn_fence(__ATOMIC_RELEASE, "agent");
            asm volatile("s_waitcnt vmcnt(0)" ::: "memory");
            const unsigned og = xb_add(&bar[XB_TOP], 1u);
            const unsigned tg = og / nx;
            if (og + 1u == (tg + 1u) * nx) xb_add(&bar[XB_TOPGEN], 1u);
            else XB_SPIN(xb_ld(&bar[XB_TOPGEN]) == tg, bar);
            __builtin_amdgcn_fence(__ATOMIC_ACQUIRE, "agent");
            xb_add(&bar[XB_XGEN(b.x)], 1u);
            asm volatile("s_waitcnt vmcnt(0)" ::: "memory");
        } else {
            XB_SPIN(xb_ld(&bar[XB_XGEN(b.x)]) == gen, bar);
            __builtin_amdgcn_fence(__ATOMIC_ACQUIRE, "agent");
            asm volatile("s_waitcnt vmcnt(0)" ::: "memory");
        }
    }
    __syncthreads();
}

constexpr int NTHREADS = 512;
constexpr int RING_BYTES = 131072;
constexpr int LDS_BYTES = 163840;
constexpr int LDS_BARW = LDS_BYTES - 16;
constexpr int NPHASES = 17;
#ifndef MK_N_LAUNCHES
#define MK_N_LAUNCHES 1
#endif

#ifndef MIXSEL_ML
#define MIXSEL_ML mixer_unit<MIX_ML>
#endif
#ifndef MIXSEL_GLA
#define MIXSEL_GLA mixer_unit<MIX_GLA>
#endif
#ifndef MIXSEL_SSD
#define MIXSEL_SSD mixer_unit<MIX_SSD>
#endif
struct Args { Params P; int ph_lo, ph_hi; };
typedef __attribute__((address_space(4))) const unsigned char* kargp_t;
__device__ __forceinline__ const Params& kparams() {
    kargp_t p = (kargp_t)__builtin_amdgcn_kernarg_segment_ptr();
    asm volatile("" : "+s"(p));
    return *(const Params*)p;
}

template <int LAYER>
__device__ __forceinline__ void layer_phases(LAS unsigned char* lds, const XcdBarrier& bar, const int lo, const int hi) {
#define IN(k) (lo <= (k) && (k) < hi)
#define SEAM(k) do { if (IN(k) && IN((k) + 1)) xcd_barrier(bar); } while (0)
    constexpr int PB = 1 + 8 * LAYER;
    const int bid = blockIdx.x, nb = gridDim.x;
    if (IN(PB + 0)) {
        const Params& P = kparams();
        pg8::SchedPlain S; S.A = (const char*)(P.out + OUT_H); S.B = (const char*)(P.ws + (LAYER ? WS_WIN1 : WS_WIN0)); S.lda = D; S.ldb = D; S.nM = T / 256; S.nN = NP / 256; S.G = nb; S.c = bid;
        pg8::EpiStore E{(bf16_t*)(P.ws + WS_BIG), NP};
        pg8::gemm_phase(lds, S, E, D, D, D);
    }
    SEAM(PB + 0);
    if (IN(PB + 1)) {
        const Params& P = kparams();
        for (int u = bid; u < 256; u += nb) {
            const int b = (u & 127) >> 2, h = u & 3;
            if (LAYER == 0) { if (u < 128) mixer_unit<MIX_RET>(P, b, h, lds); else MIXSEL_ML(P, b, h, lds); }
            else { if (u < 128) MIXSEL_GLA(P, b, h, lds); else MIXSEL_SSD(P, b, h, lds); }
            __syncthreads();
        }
    }
    SEAM(PB + 1);
    if (IN(PB + 2)) {
        const Params& P = kparams();
        pg8::SchedPlain S; S.A = (const char*)(P.ws + WS_BIG) + YOFF * 2; S.B = (const char*)(P.ws + (LAYER ? WS_WOUT1 : WS_WOUT0)); S.lda = NP; S.ldb = 2048; S.nM = T / 256; S.nN = 4; S.G = nb; S.c = bid;
        pg8::EpiResid E{(bf16_t*)(P.out + OUT_PRE1), (const bf16_t*)(P.out + OUT_H)};
        pg8::gemm_phase(lds, S, E, 2048, NP, 2048);
    }
    SEAM(PB + 2);
    if (IN(PB + 3)) phase_route(kparams(), LAYER, lds, bid, nb);
    SEAM(PB + 3);
    if (IN(PB + 4)) phase_permute(kparams(), LAYER, lds, bid, nb);
    SEAM(PB + 4);
    if (IN(PB + 5)) {
        const Params& P = kparams();
        const int* tilecls = (const int*)(P.ws + WS_TILECLS);
        pg8::SchedMoeA S; S.A = (const char*)(P.ws + WS_BIG + BIG_HS); S.Wgu = (const char*)(P.ws + WS_WGU) + (size_t)LAYER * 16 * 1024 * 1024 * 2; S.tilecls = tilecls; S.nM = tilecls[0]; S.G = nb; S.c = bid;
        pg8::EpiSwiglu E{(bf16_t*)(P.ws + WS_BIG + BIG_H), (const float*)(P.ws + WS_ROWGATE)};
        pg8::gemm_phase(lds, S, E, D, D, D);
    }
    SEAM(PB + 5);
    if (IN(PB + 6)) {
        const Params& P = kparams();
        const int* tilecls = (const int*)(P.ws + WS_TILECLS);
        pg8::SchedMoeB S; S.A = (const char*)(P.ws + WS_BIG + BIG_H); S.Wd = (const char*)(P.ws + WS_WD) + (size_t)LAYER * 16 * 1024 * 512 * 2; S.tilecls = tilecls; S.nM = tilecls[0]; S.G = nb; S.c = bid;
        pg8::EpiResid E{(bf16_t*)(P.ws + WS_BIG + BIG_PRE2), (const bf16_t*)(P.ws + WS_BIG + BIG_HS)};
        pg8::gemm_phase(lds, S, E, D, D, 512);
    }
    SEAM(PB + 6);
    if (IN(PB + 7)) phase_lnffn(kparams(), LAYER, bid, nb);
    if (LAYER == 0) SEAM(PB + 7);
#undef IN
#undef SEAM
}

__global__ void __launch_bounds__(NTHREADS, 2) mega_fwd(Args a) {
    extern __shared__ __attribute__((aligned(16))) unsigned char lds_raw[];
    LAS unsigned char* lds = (LAS unsigned char*)lds_raw;
    if (threadIdx.x < 4) ((LAS unsigned*)(lds + LDS_BARW))[threadIdx.x] = 0u;
    __syncthreads();
    const int lo = a.ph_lo, hi = a.ph_hi;
    XcdBarrier bar;
    { unsigned* bw = (unsigned*)(kparams().ws + WS_CTL) + CW_BAR; bar.bar = bw; bar.x = 0; bar.st = nullptr;
      if (hi - lo > 1) bar = xcd_barrier_post(bw, (volatile LAS unsigned*)(lds + LDS_BARW)); }
    if (lo <= 0 && 0 < hi) { phase_convert(kparams(), lds, blockIdx.x, gridDim.x); if (1 < hi) xcd_barrier(bar); }
    layer_phases<0>(lds, bar, lo, hi);
    layer_phases<1>(lds, bar, lo, hi);
}

extern "C" void kernel_launch(void* const* d_in, const int* in_sizes, int n_in, void* d_out, int out_size, void* d_ws, size_t ws_size, hipStream_t stream) {
    static int grid = 0;
    if (!grid) {
        if (n_in != 30 || ws_size < WS_END || out_size != T * D) { fprintf(stderr, "kernel_launch: unexpected shapes n_in %d ws %zu out %d\n", n_in, ws_size, out_size); grid = -1; return; }
        int dev = 0, cus = 0, per_cu = 0;
        if (hipGetDevice(&dev) != hipSuccess || hipDeviceGetAttribute(&cus, hipDeviceAttributeMultiprocessorCount, dev) != hipSuccess) { grid = -1; return; }
        if (hipFuncSetAttribute((const void*)mega_fwd, hipFuncAttributeMaxDynamicSharedMemorySize, LDS_BYTES) != hipSuccess) { fprintf(stderr, "kernel_launch: hipFuncSetAttribute failed\n"); grid = -1; return; }
        if (hipOccupancyMaxActiveBlocksPerMultiprocessor(&per_cu, (const void*)mega_fwd, NTHREADS, LDS_BYTES) != hipSuccess || per_cu < 1)
            fprintf(stderr, "kernel_launch: note: occupancy query reports %d workgroups per CU\n", per_cu);
        grid = cus > 0 ? cus : 256;
    }
    if (grid < 0) return;
    Args a{};
    for (int i = 0; i < 30; ++i) a.P.in[i] = (const float*)d_in[i];
    a.P.out = (unsigned char*)d_out; a.P.ws = (unsigned char*)d_ws;
    (void)hipMemsetAsync((char*)d_ws + WS_CTL, 0, CTL_BYTES, stream);
    constexpr int NL = MK_N_LAUNCHES;
    if (NL == 1) { a.ph_lo = 0; a.ph_hi = NPHASES; hipLaunchKernelGGL(mega_fwd, dim3(grid), dim3(NTHREADS), LDS_BYTES, stream, a); }
    else for (int p = 0; p < NPHASES; ++p) { a.ph_lo = p; a.ph_hi = p + 1; hipLaunchKernelGGL(mega_fwd, dim3(grid), dim3(NTHREADS), LDS_BYTES, stream, a); }
}
```

```cpp
#include <hip/hip_runtime.h>
#include <cstdio>
#include <cstdint>

#ifndef MIX_LREP
#define MIX_LREP 1
#endif
#ifndef MIX_SREP
#define MIX_SREP 1
#endif
#ifndef MIX_EREP
#define MIX_EREP 1
#endif
#define GAS __attribute__((address_space(1)))
#define LAS __attribute__((address_space(3)))
typedef unsigned short bf16_t;
typedef short bf16x8 __attribute__((ext_vector_type(8)));
typedef float f32x4 __attribute__((ext_vector_type(4)));
typedef unsigned u32x4 __attribute__((ext_vector_type(4)));

constexpr int BATCH = 32, SEQ = 2048, T = BATCH * SEQ, D = 1024;
constexpr int NP = 6400;
constexpr int YOFF = 1024;
constexpr int NCLS = 24, MAXTILES = 280;
constexpr float LN_EPS = 1e-5f, NORM_EPS = 1e-6f;
constexpr float ALPHA = 1.41421356237f;
constexpr int NTHREADS_C = 512;

constexpr int C0_RQ = 0, C0_RK = 512, C0_RV = 1024, C0_MV = 2048, C0_RG = 3072, C0_MQ = 4096, C0_MK = 4608, C0_MO = 5120, C0_MI = 6144, C0_MF = 6148;
constexpr int C1_GQ = 0, C1_GK = 512, C1_GV = 1024, C1_SZ = 2048, C1_GR = 3072, C1_XS = 4096, C1_BM = 5120, C1_CM = 5632, C1_GA = 6144, C1_DT = 6160;

constexpr size_t MiB = 1u << 20;
constexpr size_t WS_CTL = 0, CTL_BYTES = 1 * MiB;
constexpr size_t WS_WIN0 = 2 * MiB;
constexpr size_t WS_WIN1 = 15 * MiB;
constexpr size_t WS_WOUT0 = 28 * MiB;
constexpr size_t WS_WOUT1 = 32 * MiB;
constexpr size_t WS_WGU = 36 * MiB;
constexpr size_t WS_WD = 100 * MiB;
constexpr size_t WS_TOKCLS = 132 * MiB;
constexpr size_t WS_TOKPOS = WS_TOKCLS + (size_t)T * 4;
constexpr size_t WS_TOKDST = WS_TOKPOS + (size_t)T * 4;
constexpr size_t WS_TOKGATE = WS_TOKDST + (size_t)T * 4;
constexpr size_t WS_ROWGATE = WS_TOKGATE + (size_t)T * 8;
constexpr size_t WS_TILECLS = WS_ROWGATE + (size_t)MAXTILES * 256 * 8;
constexpr size_t WS_BIG = 136 * MiB;
constexpr size_t BIG_HS = 0, BIG_H = 160 * MiB, BIG_PRE2 = 320 * MiB, BIG_HS8 = 480 * MiB;
constexpr size_t WS_H8 = WS_BIG + (size_t)T * NP * 2;
constexpr size_t WS_WIN8_0 = WS_H8 + (size_t)T * D;
constexpr size_t WS_WIN8_1 = WS_WIN8_0 + (size_t)NP * D;
constexpr size_t WS_END = WS_WIN8_1 + (size_t)NP * D;
static_assert(WS_TILECLS + (MAXTILES + 8) * 4 <= WS_BIG, "ws map");
static_assert(WS_END <= 1024 * MiB, "ws map");
constexpr size_t OUT_H = 0, OUT_PRE1 = 128 * MiB;
constexpr int CW_CNT = 1024;
constexpr int CW_BAR = 4096;

__device__ __forceinline__ unsigned f2bf(float f) { unsigned u = __builtin_bit_cast(unsigned, f); return (u + 0x7fffu + ((u >> 16) & 1u)) >> 16; }
__device__ __forceinline__ unsigned pk2(float lo, float hi) { return f2bf(lo) | (f2bf(hi) << 16); }
__device__ __forceinline__ float bf2f(unsigned short b) { return __builtin_bit_cast(float, ((unsigned)b) << 16); }
__device__ __forceinline__ float bflo(unsigned w) { return __builtin_bit_cast(float, w << 16); }
__device__ __forceinline__ float bfhi(unsigned w) { return __builtin_bit_cast(float, w & 0xffff0000u); }
__device__ __forceinline__ float sigmoidf_(float x) { return 1.f / (1.f + __expf(-x)); }
__device__ __forceinline__ float siluf_(float x) { return x / (1.f + __expf(-x)); }
__device__ __forceinline__ float softplusf_(float x) { return x > 20.f ? x : log1pf(expf(x)); }
__device__ __forceinline__ float logsigmoidf_(float x) { return -softplusf_(-x); }
__device__ __forceinline__ float wave_sum(float v) {
#define WS_DPP(ctrl, rm) v += __builtin_bit_cast(float, __builtin_amdgcn_update_dpp(0, __builtin_bit_cast(int, v), ctrl, rm, 0xf, false))
    WS_DPP(0x111, 0xf); WS_DPP(0x112, 0xf); WS_DPP(0x114, 0xf); WS_DPP(0x118, 0xf); WS_DPP(0x142, 0xa); WS_DPP(0x143, 0xc);
#undef WS_DPP
    return __builtin_bit_cast(float, __builtin_amdgcn_readlane(__builtin_bit_cast(int, v), 63));
}
#define LDS_WAIT() asm volatile("s_waitcnt lgkmcnt(0)" ::: "memory")
__device__ __forceinline__ unsigned pk4_fp8(float a, float b, float c, float d) { int w = __builtin_amdgcn_cvt_pk_fp8_f32(a, b, 0, false); w = __builtin_amdgcn_cvt_pk_fp8_f32(c, d, w, true); return (unsigned)w; }
#ifndef MOE_FP8
#define MOE_FP8(layer) ((layer) >= 0)
#endif
#ifndef MOEA_FP8
#define MOEA_FP8 1
#endif
#ifndef INPROJ_FP8MASK0
#define INPROJ_FP8MASK0 0x00fcfffcu
#endif
#ifndef INPROJ_FP8MASK1
#define INPROJ_FP8MASK1 0x01ffffffu
#endif
constexpr unsigned ALLTILES = 0x01ffffffu;
#ifndef INPROJ_FP8
#define INPROJ_FP8(layer) ((layer) == 1)
#endif
constexpr float H8_SCALE = 8.f, W8_SCALE = 256.f;
#ifndef TPROBE_ID
#define TPROBE_ID 0
#endif
#ifndef TPROBE_BLOCK
#define TPROBE_BLOCK 128
#endif
#ifndef TPROBE_MULT
#define TPROBE_MULT 4
#endif
constexpr int LDS_TPROBE = 163840 - 48;
__device__ __forceinline__ int opaque_tid();
__device__ __forceinline__ void tp_begin(LAS unsigned char* lds, int id) { if (TPROBE_ID != 0 && TPROBE_ID == id && opaque_tid() == 0) ((LAS unsigned long long*)(lds + LDS_TPROBE))[1] = wall_clock64(); }
__device__ __forceinline__ void tp_end(LAS unsigned char* lds, int id) { if (TPROBE_ID != 0 && TPROBE_ID == id && opaque_tid() == 0) { LAS unsigned long long* p = (LAS unsigned long long*)(lds + LDS_TPROBE); p[0] += wall_clock64() - p[1]; } }
extern __shared__ __attribute__((aligned(16))) unsigned char g_lds[];
constexpr int LDS_WIDTAB = 163840 - 512;
__device__ __forceinline__ int hw_wave_key() { return (int)__builtin_amdgcn_s_getreg((5 << 11) | 4) & 63; }
__device__ __forceinline__ int opaque_tid() {
    const int wid = __builtin_amdgcn_readfirstlane(*(volatile LAS int*)((LAS unsigned char*)g_lds + LDS_WIDTAB + 4 * hw_wave_key()));
    int t = wid * 64 + (int)__builtin_amdgcn_mbcnt_hi(~0u, __builtin_amdgcn_mbcnt_lo(~0u, 0u)); asm volatile("" : "+v"(t)); return t; }

namespace pg8 {
constexpr int BM = 256, BK = 64, HALF = 128, HTB = HALF * BK * 2, STAGE_BYTES = 8 * HTB, NXCD = 8, WGM = 8;
__host__ __device__ __forceinline__ int lds_byte(int r, int c) { const int st = (r >> 4) * 2 + (c >> 5), rr = r & 15, cc = c & 31, ob = rr * 64 + cc * 2; return st * 1024 + (ob ^ (((ob >> 9) & 1) << 5)); }
__host__ __device__ __forceinline__ void stage_rc(int b, int& R, int& C) { const int st = b / 1024, sb = b % 1024, swz = sb ^ (((sb >> 9) & 1) << 5); R = (st >> 1) * 16 + swz / 64; C = (st & 1) * 32 + (swz % 64) / 2; }
__host__ __device__ __forceinline__ int perm32(int rho) { const int n = rho >> 4, i = rho & 15; return 8 * (i >> 2) + 4 * n + (i & 3); }

struct Unit { int pm, pn; unsigned a, b0, b1; };

__device__ __forceinline__ bool static_tile(int i, int G, int c, int nM, int nN, int& pm, int& pn) {
    const int nwg = nM * nN; const int L = i * G + c; if (L >= nwg) return false;
    int wgid = L; { const int q = nwg / NXCD, r = nwg % NXCD, xcd = wgid % NXCD, off = wgid / NXCD; wgid = (xcd < r ? xcd * (q + 1) : r * (q + 1) + (xcd - r) * q) + off; }
    const int nig = WGM * nN, gid = wgid / nig, fm = gid * WGM, gsz = (nM - fm) < WGM ? (nM - fm) : WGM;
    pm = fm + ((wgid % nig) % gsz); pn = (wgid % nig) / gsz; return true;
}
template <class Tp> __device__ __forceinline__ Tp* uniform_ptr(Tp* p) {
    const unsigned long long v = (unsigned long long)p;
    const unsigned lo = __builtin_amdgcn_readfirstlane((unsigned)v), hi = __builtin_amdgcn_readfirstlane((unsigned)(v >> 32));
    return (Tp*)(((unsigned long long)hi << 32) | lo); }
__device__ __forceinline__ unsigned cvt_pk_bf16(float lo, float hi) { unsigned r; asm volatile("v_cvt_pk_bf16_f32 %0, %1, %2" : "=v"(r) : "v"(lo), "v"(hi)); return r; }

typedef int i32x8 __attribute__((ext_vector_type(8)));
typedef int i32x4v __attribute__((ext_vector_type(4)));
__device__ __forceinline__ i32x8 cat16(const bf16x8& lo, const bf16x8& hi) { const i32x4v a = __builtin_bit_cast(i32x4v, lo), b = __builtin_bit_cast(i32x4v, hi); return (i32x8){a[0], a[1], a[2], a[3], b[0], b[1], b[2], b[3]}; }
template <class Epi, class Sched, bool FP8 = false, int SCA = 0x7f7f7f7f, int SCB = 0x7f7f7f7f>
__device__ __forceinline__ void gemm_phase(LAS unsigned char* lds, const Sched& S, const Epi& E, const int K, const int lda, const int ldb) {
    const int tid = opaque_tid(), wid = __builtin_amdgcn_readfirstlane(tid >> 6), lane = tid & 63, wr = wid >> 2, wc = wid & 3, fr = lane & 15, fq = lane >> 4;
    int nt = K / BK; asm volatile("" : "+s"(nt));
    constexpr int KS = Sched::KSPLIT;
    unsigned voffA0, voffB0;
    { int R, C; stage_rc(tid * 16, R, C); const int Rb = (R & ~31) + perm32(R & 31); voffA0 = (unsigned)(R * lda + C) * 2u; voffB0 = (unsigned)(Rb * ldb + C) * 2u; }
    const unsigned q64A = 64u * lda * 2u, q64B = 64u * ldb * 2u;
    const unsigned kstep = (unsigned)(BK * 2);
    const unsigned hstepA = (unsigned)HALF * lda * 2, hstepB = (unsigned)HALF * ldb * 2;
    const __amdgpu_buffer_rsrc_t rsA = __builtin_amdgcn_make_buffer_rsrc((void*)S.A, 0, 0xffffffff, 0x00020000), rsB = __builtin_amdgcn_make_buffer_rsrc((void*)S.bbase(), 0, 0xffffffff, 0x00020000);
    const unsigned ldsw = (unsigned)wid * 1024u;
    const int aoff = lds_byte(wr * 64 + fr, fq * 8), boff = lds_byte(wc * 32 + fr, fq * 8);
#define PG8_BP(u, kt) ((KS > 0 && (kt) >= KS) ? (u).b1 + (unsigned)((kt) - KS) * kstep : (u).b0 + (unsigned)(kt) * kstep)
#define PG8_SA(b, h) (((b) * 2 + (h)) * HTB)
#define PG8_SB(b, h) ((4 + (b) * 2 + (h)) * HTB)
#define PG8_STAGEA(bufoff, soff) do { _Pragma("unroll") for (int _i = 0; _i < 2; ++_i) \
        __builtin_amdgcn_raw_ptr_buffer_load_lds(rsA, (LAS void*)(lds + (bufoff) + ldsw + _i * 8192), 16, voffA0, (int)((soff) + _i * q64A), 0, 0); } while (0)
#define PG8_STAGEB(bufoff, soff) do { _Pragma("unroll") for (int _i = 0; _i < 2; ++_i) \
        __builtin_amdgcn_raw_ptr_buffer_load_lds(rsB, (LAS void*)(lds + (bufoff) + ldsw + _i * 8192), 16, voffB0, (int)((soff) + _i * q64B), 0, 0); } while (0)
#define PG8_LDA(dst, b, h) do { _Pragma("unroll") for (int m = 0; m < 4; ++m) _Pragma("unroll") for (int k = 0; k < 2; ++k) dst[m][k] = *(const LAS bf16x8*)(lds + PG8_SA(b, h) + aoff + m * 2048 + k * 1024); } while (0)
#define PG8_LDB(dst, b, h) do { _Pragma("unroll") for (int n = 0; n < 2; ++n) _Pragma("unroll") for (int k = 0; k < 2; ++k) dst[n][k] = *(const LAS bf16x8*)(lds + PG8_SB(b, h) + boff + n * 2048 + k * 1024); } while (0)
#define PG8_MMA(ai, bj, At, Bt) do { __builtin_amdgcn_s_setprio(1); _Pragma("unroll") for (int m = 0; m < 4; ++m) _Pragma("unroll") for (int n = 0; n < 2; ++n) { \
        if constexpr (FP8) acc[ai][bj][m][n] = __builtin_amdgcn_mfma_scale_f32_16x16x128_f8f6f4(cat16(Bt[n][0], Bt[n][1]), cat16(At[m][0], At[m][1]), acc[ai][bj][m][n], 0, 0, 1, ((SCB & 0xff) << 8) | (SCA & 0xff), 0, ((SCB & 0xff) << 8) | (SCA & 0xff)); \
        else { _Pragma("unroll") for (int k = 0; k < 2; ++k) acc[ai][bj][m][n] = __builtin_amdgcn_mfma_f32_16x16x32_bf16(Bt[n][k], At[m][k], acc[ai][bj][m][n], 0, 0, 0); } } \
        __builtin_amdgcn_s_setprio(0); } while (0)
#define PG8_WAIT_V(n) asm volatile("s_waitcnt vmcnt(" #n ")" ::: "memory")
#define PG8_WAIT_L(n) asm volatile("s_waitcnt lgkmcnt(" #n ")" ::: "memory")
#define PG8_BAR __builtin_amdgcn_s_barrier()
#define PG8_SCHED __builtin_amdgcn_sched_barrier(0)
    Unit cur, nxt; int ui = 0;
    if (!S.next(0, cur)) return;
    f32x4 acc[2][2][4][2];
#pragma unroll
    for (int a = 0; a < 2; ++a)
#pragma unroll
        for (int b = 0; b < 2; ++b)
#pragma unroll
            for (int m = 0; m < 4; ++m)
#pragma unroll
                for (int n = 0; n < 2; ++n) acc[a][b][m][n] = (f32x4){0.f, 0.f, 0.f, 0.f};
    bf16x8 At[4][2], B0[2][2], B1[2][2];
    unsigned cA = cur.a;
    { const unsigned cB0 = PG8_BP(cur, 0), cB1 = PG8_BP(cur, 1);
    PG8_STAGEB(PG8_SB(0, 0), cB0); PG8_STAGEA(PG8_SA(0, 0), cA); PG8_STAGEB(PG8_SB(0, 1), cB0 + hstepB); PG8_STAGEA(PG8_SA(0, 1), cA + hstepA);
    if (wr == 1) PG8_BAR;
    PG8_WAIT_V(4); PG8_BAR;
    PG8_STAGEB(PG8_SB(1, 0), cB1); PG8_STAGEA(PG8_SA(1, 0), cA + kstep); PG8_STAGEB(PG8_SB(1, 1), cB1 + hstepB);
    PG8_WAIT_V(6); PG8_BAR; }
    for (;;) {
        const bool has_next = S.next(ui + 1, nxt);
        if (!has_next) nxt = cur;
        for (int t = 0; t < nt; t += 2) {
            const bool last = (t == nt - 2);
            const unsigned a1 = cA + (unsigned)(t + 1) * kstep;
            const unsigned a2 = last ? nxt.a : cA + (unsigned)(t + 2) * kstep;
            const unsigned b2 = last ? PG8_BP(nxt, 0) : PG8_BP(cur, t + 2);
            const unsigned a3 = a2 + kstep;
            const unsigned b3 = last ? PG8_BP(nxt, 1) : PG8_BP(cur, t + 3);
            PG8_LDB(B0, 0, 0); PG8_SCHED; PG8_LDA(At, 0, 0); PG8_STAGEA(PG8_SA(1, 1), a1 + hstepA);
            PG8_WAIT_L(8); PG8_BAR; PG8_WAIT_L(0); PG8_MMA(0, 0, At, B0); PG8_BAR; PG8_SCHED;
            PG8_LDB(B1, 0, 1); PG8_STAGEB(PG8_SB(0, 0), b2);
            PG8_BAR; PG8_WAIT_L(0); PG8_MMA(0, 1, At, B1); PG8_BAR;
            PG8_LDA(At, 0, 1); PG8_STAGEA(PG8_SA(0, 0), a2);
            PG8_BAR; PG8_WAIT_L(0); PG8_MMA(1, 0, At, B0); PG8_BAR; PG8_SCHED;
            PG8_STAGEB(PG8_SB(0, 1), b2 + hstepB);
            PG8_WAIT_V(6); PG8_BAR; PG8_MMA(1, 1, At, B1); PG8_BAR;
            PG8_LDB(B0, 1, 0); PG8_SCHED; PG8_LDA(At, 1, 0); PG8_STAGEA(PG8_SA(0, 1), a2 + hstepA);
            PG8_WAIT_L(8); PG8_BAR; PG8_WAIT_L(0); PG8_MMA(0, 0, At, B0); PG8_BAR; PG8_SCHED;
            PG8_LDB(B1, 1, 1); PG8_STAGEB(PG8_SB(1, 0), b3);
            PG8_BAR; PG8_WAIT_L(0); PG8_MMA(0, 1, At, B1); PG8_BAR;
            PG8_LDA(At, 1, 1); PG8_STAGEA(PG8_SA(1, 0), a3);
            PG8_BAR; PG8_WAIT_L(0); PG8_MMA(1, 0, At, B0); PG8_BAR; PG8_SCHED;
            PG8_STAGEB(PG8_SB(1, 1), b3 + hstepB);
            PG8_WAIT_V(6); PG8_BAR; PG8_MMA(1, 1, At, B1); PG8_BAR;
        }
        E(acc, cur, wr, wc, fr, fq);
        if (!has_next) break;
#pragma unroll
        for (int a = 0; a < 2; ++a)
#pragma unroll
            for (int b = 0; b < 2; ++b)
#pragma unroll
                for (int m = 0; m < 4; ++m)
#pragma unroll
                    for (int n = 0; n < 2; ++n) acc[a][b][m][n] = (f32x4){0.f, 0.f, 0.f, 0.f};
        cur = nxt; cA = cur.a; ++ui;
    }
    PG8_WAIT_V(0);
    if (wr == 0) PG8_BAR;
    PG8_BAR;
#undef PG8_BP
#undef PG8_SA
#undef PG8_SB
#undef PG8_STAGEA
#undef PG8_STAGEB
#undef PG8_LDA
#undef PG8_LDB
#undef PG8_MMA
#undef PG8_WAIT_V
#undef PG8_WAIT_L
#undef PG8_BAR
#undef PG8_SCHED
}

struct SchedPlain {
    static constexpr int KSPLIT = 0;
    const char* A; const char* B; int lda, ldb, nM, nN, G, c;
    __device__ __forceinline__ const char* bbase() const { return B; }
    __device__ __forceinline__ bool next(int i, Unit& u) const {
        if (!static_tile(i, G, c, nM, nN, u.pm, u.pn)) return false;
        u.a = (unsigned)u.pm * BM * lda * 2; u.b0 = (unsigned)u.pn * BM * ldb * 2; u.b1 = u.b0; return true;
    }
};
struct SchedCols {
    static constexpr int KSPLIT = 0;
    const char* A; const char* B; int lda, ldb, nM, nN, G, c; unsigned mask;
    __device__ __forceinline__ const char* bbase() const { return B; }
    __device__ __forceinline__ bool next(int i, Unit& u) const {
        int pnj; if (!static_tile(i, G, c, nM, nN, u.pm, pnj)) return false;
        unsigned m = mask; for (int j = 0; j < pnj; ++j) m &= m - 1u;
        u.pn = __builtin_ctz(m);
        u.a = (unsigned)u.pm * BM * lda * 2; u.b0 = (unsigned)u.pn * BM * ldb * 2; u.b1 = u.b0; return true;
    }
};
__device__ __forceinline__ void cls_experts(int cls, int& e0, int& e1) {
    const int g = cls / 6, p = cls % 6;
    const int a = p < 3 ? 0 : (p < 5 ? 1 : 2);
    const int b = p < 3 ? p + 1 : (p < 5 ? p - 1 : 3);
    e0 = 4 * g + a; e1 = 4 * g + b;
}
template <bool FP8>
struct SchedMoeA {
    static constexpr int KSPLIT = 0;
    static constexpr int RB = FP8 ? 1024 : 2048;
    const char* A; const char* Wgu; const int* tilecls; int nM, G, c;
    __device__ __forceinline__ const char* bbase() const { return Wgu; }
    __device__ __forceinline__ bool next(int i, Unit& u) const {
        if (!static_tile(i, G, c, nM, 8, u.pm, u.pn)) return false;
        int e0, e1; cls_experts(__builtin_amdgcn_readfirstlane(tilecls[8 + u.pm]), e0, e1); const int e = (u.pn >> 2) ? e1 : e0;
        u.a = (unsigned)u.pm * BM * RB; u.b0 = (unsigned)e * 2097152u + (unsigned)(u.pn & 3) * 256 * RB; u.b1 = u.b0; return true;
    }
};
template <bool FP8>
struct SchedMoeB {
    static constexpr int KSPLIT = FP8 ? 4 : 8;
    static constexpr int RA = FP8 ? 1024 : 2048, RBB = FP8 ? 512 : 1024;
    const char* A; const char* Wd; const int* tilecls; int nM, G, c;
    __device__ __forceinline__ const char* bbase() const { return Wd; }
    __device__ __forceinline__ bool next(int i, Unit& u) const {
        if (!static_tile(i, G, c, nM, 4, u.pm, u.pn)) return false;
        int e0, e1; cls_experts(__builtin_amdgcn_readfirstlane(tilecls[8 + u.pm]), e0, e1);
        u.a = (unsigned)u.pm * BM * RA;
        u.b0 = (unsigned)e0 * 1048576u + (unsigned)u.pn * 256 * RBB; u.b1 = (unsigned)e1 * 1048576u + (unsigned)u.pn * 256 * RBB; return true;
    }
};

struct EpiStore {
    bf16_t* O; int ldc;
    __device__ __forceinline__ void operator()(const f32x4 (&acc)[2][2][4][2], const Unit& u, int wr, int wc, int fr, int fq) const {
        const int row0 = u.pm * BM + wr * 64 + fr, col0 = u.pn * BM + wc * 32 + 8 * fq;
#pragma unroll
        for (int ai = 0; ai < 2; ++ai)
#pragma unroll
            for (int m = 0; m < 4; ++m) { bf16_t* rowp = O + (size_t)(row0 + ai * HALF + m * 16) * ldc + col0;
#pragma unroll
                for (int bj = 0; bj < 2; ++bj) { const f32x4 v0 = acc[ai][bj][m][0], v1 = acc[ai][bj][m][1];
                    u32x4 w; w.x = cvt_pk_bf16(v0[0], v0[1]); w.y = cvt_pk_bf16(v0[2], v0[3]); w.z = cvt_pk_bf16(v1[0], v1[1]); w.w = cvt_pk_bf16(v1[2], v1[3]);
                    *(u32x4*)(rowp + bj * HALF) = w; } }
    }
};
struct EpiResid {
    bf16_t* O; const bf16_t* R;
    __device__ __forceinline__ void operator()(const f32x4 (&acc)[2][2][4][2], const Unit& u, int wr, int wc, int fr, int fq) const {
        const int row0 = u.pm * BM + wr * 64 + fr, col0 = u.pn * BM + wc * 32 + 8 * fq;
#pragma unroll
        for (int ai = 0; ai < 2; ++ai)
#pragma unroll
            for (int m = 0; m < 4; ++m) { const size_t off = (size_t)(row0 + ai * HALF + m * 16) * 1024 + col0;
#pragma unroll
                for (int bj = 0; bj < 2; ++bj) { const f32x4 v0 = acc[ai][bj][m][0], v1 = acc[ai][bj][m][1];
                    const u32x4 r = *(const u32x4*)(R + off + bj * HALF);
                    u32x4 w; w.x = cvt_pk_bf16(v0[0] + ALPHA * bflo(r.x), v0[1] + ALPHA * bfhi(r.x)); w.y = cvt_pk_bf16(v0[2] + ALPHA * bflo(r.y), v0[3] + ALPHA * bfhi(r.y));
                    w.z = cvt_pk_bf16(v1[0] + ALPHA * bflo(r.z), v1[1] + ALPHA * bfhi(r.z)); w.w = cvt_pk_bf16(v1[2] + ALPHA * bflo(r.w), v1[3] + ALPHA * bfhi(r.w));
                    *(u32x4*)(O + off + bj * HALF) = w; } }
    }
};
struct EpiSwiglu {
    bf16_t* H; const float* rowgate;
    __device__ __forceinline__ void operator()(const f32x4 (&acc)[2][2][4][2], const Unit& u, int wr, int wc, int fr, int fq) const {
        const int row0 = u.pm * BM + wr * 64 + fr, ke = u.pn >> 2, col0 = 512 * ke + 128 * (u.pn & 3) + wc * 32 + 8 * fq;
#pragma unroll
        for (int ai = 0; ai < 2; ++ai)
#pragma unroll
            for (int m = 0; m < 4; ++m) { const int row = row0 + ai * HALF + m * 16; const float gt = rowgate[(size_t)row * 2 + ke];
                const f32x4 g0 = acc[ai][0][m][0], g1 = acc[ai][0][m][1], u0 = acc[ai][1][m][0], u1 = acc[ai][1][m][1];
                float o[8];
#pragma unroll
                for (int j = 0; j < 4; ++j) { o[j] = siluf_(g0[j]) * u0[j] * gt; o[4 + j] = siluf_(g1[j]) * u1[j] * gt; }
                u32x4 w; w.x = cvt_pk_bf16(o[0], o[1]); w.y = cvt_pk_bf16(o[2], o[3]); w.z = cvt_pk_bf16(o[4], o[5]); w.w = cvt_pk_bf16(o[6], o[7]);
                *(u32x4*)(H + (size_t)row * 1024 + col0) = w; }
    }
};
struct EpiSwiglu8 {
    unsigned char* H; const float* rowgate;
    __device__ __forceinline__ void operator()(const f32x4 (&acc)[2][2][4][2], const Unit& u, int wr, int wc, int fr, int fq) const {
        typedef unsigned u32x2 __attribute__((ext_vector_type(2)));
        const int row0 = u.pm * BM + wr * 64 + fr, ke = u.pn >> 2, col0 = 512 * ke + 128 * (u.pn & 3) + wc * 32 + 8 * fq;
        unsigned char* const H = uniform_ptr(this->H); const float* const rowgate = uniform_ptr(this->rowgate);
#pragma unroll
        for (int ai = 0; ai < 2; ++ai)
#pragma unroll
            for (int m = 0; m < 4; ++m) { const int row = row0 + ai * HALF + m * 16; const float gt = rowgate[(size_t)row * 2 + ke] * 8.f;
                const f32x4 g0 = acc[ai][0][m][0], g1 = acc[ai][0][m][1], u0 = acc[ai][1][m][0], u1 = acc[ai][1][m][1];
                float o[8];
#pragma unroll
                for (int j = 0; j < 4; ++j) { o[j] = __builtin_amdgcn_fmed3f(g0[j] * __builtin_amdgcn_rcpf(1.f + __builtin_amdgcn_exp2f(-1.4426950408889634f * g0[j])) * u0[j] * gt, -440.f, 440.f);
                    o[4 + j] = __builtin_amdgcn_fmed3f(g1[j] * __builtin_amdgcn_rcpf(1.f + __builtin_amdgcn_exp2f(-1.4426950408889634f * g1[j])) * u1[j] * gt, -440.f, 440.f); }
                *(u32x2*)(H + (size_t)row * 1024 + col0) = (u32x2){pk4_fp8(o[0], o[1], o[2], o[3]), pk4_fp8(o[4], o[5], o[6], o[7])}; }
    }
};
}

struct Params {
    const float* in[30];
    unsigned char* out;
    unsigned char* ws;
};
enum { I_X = 0, I_POS, I_WINAB, I_RETG, I_MLCW, I_MLCB, I_MLBI, I_MLBF, I_MLG, I_WOUTAB, I_WINCD, I_GLAWA, I_GLABA, I_GLAG, I_SSDCW, I_SSDCB, I_SSDDTB, I_SSDALOG, I_SSDD, I_SSDG,
       I_WOUTCD, I_WR, I_BR, I_MOEG, I_MOEU, I_MOED, I_LNMG, I_LNMB, I_LNFG, I_LNFB };

template <class ColPtr>
__device__ __forceinline__ void tr_item(const ColPtr& cp, int ldw, bf16_t* WT, int ldt, int n0, int k0, LAS float* scr, int lane) {
    const float* p = cp(n0 + (lane & 31));
#pragma unroll 8
    for (int i = 0; i < 32; ++i) { const int kk = 2 * i + (lane >> 5); scr[kk * 33 + (lane & 31)] = p ? p[(size_t)(k0 + kk) * ldw] : 0.f; }
    LDS_WAIT();
    const int c = lane & 7;
#pragma unroll
    for (int j = 0; j < 4; ++j) { const int n = (lane >> 3) + 8 * j; const LAS float* s = scr + (8 * c) * 33 + n;
        u32x4 o; o.x = pk2(s[0 * 33], s[1 * 33]); o.y = pk2(s[2 * 33], s[3 * 33]); o.z = pk2(s[4 * 33], s[5 * 33]); o.w = pk2(s[6 * 33], s[7 * 33]);
        *(u32x4*)(WT + (size_t)(n0 + n) * ldt + k0 + 8 * c) = o; }
    LDS_WAIT();
}
template <class ColPtr>
__device__ __forceinline__ void tr_item_fp8(const ColPtr& cp, int ldw, unsigned char* WT, int ldt, int n0, int k0, float scale, LAS float* scr, int lane) {
    const float* p = cp(n0 + (lane & 31));
#pragma unroll 8
    for (int i = 0; i < 32; ++i) { const int kk = 2 * i + (lane >> 5); scr[kk * 33 + (lane & 31)] = p ? p[(size_t)(k0 + kk) * ldw] * scale : 0.f; }
    LDS_WAIT();
    const int c = lane & 7;
    typedef unsigned u32x2 __attribute__((ext_vector_type(2)));
#pragma unroll
    for (int j = 0; j < 4; ++j) { const int n = (lane >> 3) + 8 * j; const LAS float* s = scr + (8 * c) * 33 + n;
        *(u32x2*)(WT + (size_t)(n0 + n) * ldt + k0 + 8 * c) = (u32x2){pk4_fp8(s[0 * 33], s[1 * 33], s[2 * 33], s[3 * 33]), pk4_fp8(s[4 * 33], s[5 * 33], s[6 * 33], s[7 * 33])}; }
    LDS_WAIT();
}
__device__ __forceinline__ int map_ab(int n) {
    if (n < 2048) return n;
    if (n < 3072) return 4096 + (n - 2048);
    if (n < 4096) return 2048 + (n - 3072);
    if (n < 4608) return 3072 + (n - 4096);
    if (n < 5120) return 3584 + (n - 4608);
    if (n < 6152) return n;
    return -1;
}
__device__ __forceinline__ int map_cd(int n) {
    if (n < 2048) return n;
    if (n < 3072) return 3088 + (n - 2048);
    if (n < 4096) return 2048 + (n - 3072);
    if (n < 5120) return 4112 + (n - 4096);
    if (n < 5632) return 5136 + (n - 5120);
    if (n < 6144) return 5648 + (n - 5632);
    if (n < 6160) return 3072 + (n - 6144);
    if (n < 6176) return 6160 + (n - 6160);
    return -1;
}
template <bool FP8, class ColPtr>
__device__ __forceinline__ void tr_block(const ColPtr& cp, int ldw, void* WT, int ldt, int n0, int k0, float scale, LAS float* tile, int tid) {
    {   const int c4 = tid & 63, r0 = tid >> 6;
        const float* p = cp(n0 + 4 * c4);
        f32x4 v[8];
#pragma unroll
        for (int i = 0; i < 8; ++i) v[i] = p ? *(const f32x4*)(p + (size_t)(k0 + r0 + 8 * i) * ldw) : (f32x4){0.f, 0.f, 0.f, 0.f};
#pragma unroll
        for (int i = 0; i < 8; ++i) { LAS float* t = tile + (r0 + 8 * i) * 257 + 4 * c4; t[0] = v[i][0] * scale; t[1] = v[i][1] * scale; t[2] = v[i][2] * scale; t[3] = v[i][3] * scale; }
    }
    __syncthreads();
    {   const int kc = tid & 7, nr = tid >> 3;
#pragma unroll
        for (int j = 0; j < 4; ++j) { const int n = nr + 64 * j; const LAS float* t = tile + (8 * kc) * 257 + n;
            if constexpr (FP8) { typedef unsigned u32x2 __attribute__((ext_vector_type(2)));
                *(u32x2*)((unsigned char*)WT + (size_t)(n0 + n) * ldt + k0 + 8 * kc) = (u32x2){pk4_fp8(t[0], t[257], t[514], t[771]), pk4_fp8(t[1028], t[1285], t[1542], t[1799])}; }
            else { u32x4 o; o.x = pk2(t[0], t[257]); o.y = pk2(t[514], t[771]); o.z = pk2(t[1028], t[1285]); o.w = pk2(t[1542], t[1799]);
                *(u32x4*)((bf16_t*)WT + (size_t)(n0 + n) * ldt + k0 + 8 * kc) = o; } }
    }
    __syncthreads();
}
__device__ __forceinline__ void convert_moe(const Params& P, LAS unsigned char* lds, int bid, int nb) {
    const int tid = opaque_tid();
    LAS float* tile = (LAS float*)lds;
    unsigned char* ws = P.ws;
    constexpr int B_GU = (1024 / 256) * (1024 / 64);
    constexpr int B_DN = (1024 / 256) * (512 / 64);
#pragma unroll 1
    for (int it = bid; it < 32 * B_GU + 32 * B_DN; it += nb) {
        int r = it;
        if (r < 32 * B_GU) { const int le = r / B_GU; r %= B_GU; const int nbk = r / 16, kb = r % 16;
            const float* Wg = P.in[I_MOEG] + (size_t)le * 1024 * 512 + 128 * nbk; const float* Wu = P.in[I_MOEU] + (size_t)le * 1024 * 512 + 128 * nbk; const int n0 = nbk * 256;
            auto cp = [&](int n) { const int wdt = n - n0; return wdt < 128 ? Wg + wdt : Wu + (wdt - 128); };
            if (MOE_FP8(le >> 4) && MOEA_FP8) tr_block<true>(cp, 512, ws + WS_WGU + (size_t)le * 2097152, 1024, n0, kb * 64, W8_SCALE, tile, tid);
            else tr_block<false>(cp, 512, ws + WS_WGU + (size_t)le * 2097152, 1024, n0, kb * 64, 1.f, tile, tid);
            continue; }
        r -= 32 * B_GU;
        { const int le = r / B_DN; r %= B_DN; const int nbk = r / 8, kb = r % 8;
            const float* W = P.in[I_MOED] + (size_t)le * 512 * 1024;
            if (MOE_FP8(le >> 4)) tr_block<true>([&](int n) { return W + n; }, 1024, ws + WS_WD + (size_t)le * 1048576, 512, nbk * 256, kb * 64, W8_SCALE, tile, tid);
            else tr_block<false>([&](int n) { return W + n; }, 1024, ws + WS_WD + (size_t)le * 1048576, 512, nbk * 256, kb * 64, 1.f, tile, tid); }
    }
}
__device__ __forceinline__ void phase_convert(const Params& P, LAS unsigned char* lds, int bid, int nb) {
    const int tid = opaque_tid();
    LAS float* tile = (LAS float*)lds;
    unsigned char* ws = P.ws;
    constexpr int B_IN = (NP / 256) * (D / 64);
    constexpr int B_OUT = (1024 / 256) * (2048 / 64);
    constexpr int NITEMS = 2 * B_IN + 2 * B_OUT;
    tp_begin(lds, 910);
#pragma unroll 1
    for (int it = bid; it < NITEMS; it += nb) {
        int r = it;
        if (r < 2 * B_IN) { const int l = r / B_IN; r %= B_IN; const int nbk = r / (D / 64), kb = r % (D / 64);
            const float* W = P.in[l ? I_WINCD : I_WINAB]; const int ldw = l ? 6176 : 6152;
            if (l == 0) { auto cp = [&](int n) { const int sc = map_ab(n); return sc < 0 ? (const float*)nullptr : W + sc; };
                if ((INPROJ_FP8MASK0 >> nbk) & 1u) tr_block<true>(cp, ldw, ws + WS_WIN8_0, D, nbk * 256, kb * 64, W8_SCALE, tile, tid); else tr_block<false>(cp, ldw, ws + WS_WIN0, D, nbk * 256, kb * 64, 1.f, tile, tid); }
            else { auto cp = [&](int n) { const int sc = map_cd(n); return sc < 0 ? (const float*)nullptr : W + sc; };
                if ((INPROJ_FP8MASK1 >> nbk) & 1u) tr_block<true>(cp, ldw, ws + WS_WIN8_1, D, nbk * 256, kb * 64, W8_SCALE, tile, tid); else tr_block<false>(cp, ldw, ws + WS_WIN1, D, nbk * 256, kb * 64, 1.f, tile, tid); }
            continue; }
        r -= 2 * B_IN;
        { const int l = r / B_OUT; r %= B_OUT; const int nbk = r / 32, kb = r % 32;
            const float* W = P.in[l ? I_WOUTCD : I_WOUTAB];
            tr_block<false>([&](int n) { return W + n; }, 1024, ws + (l ? WS_WOUT1 : WS_WOUT0), 2048, nbk * 256, kb * 64, 1.f, tile, tid); }
    }
    const int nw = blockDim.x >> 6; (void)nw;
    asm volatile("s_waitcnt vmcnt(0)" ::: "memory"); tp_end(lds, 910); tp_begin(lds, 911);
    const float* x = P.in[I_X]; bf16_t* h = (bf16_t*)(P.out + OUT_H);
    const size_t n8 = (size_t)T * D / 8;
    const size_t stride = (size_t)nb * blockDim.x;
    for (size_t i0 = (size_t)bid * blockDim.x + tid; i0 < n8; i0 += 4 * stride) {
        f32x4 a[4], b[4];
#pragma unroll
        for (int u = 0; u < 4; ++u) { const size_t i = i0 + u * stride; if (i < n8) { a[u] = *(const f32x4*)(x + i * 8); b[u] = *(const f32x4*)(x + i * 8 + 4); } }
#pragma unroll
        for (int u = 0; u < 4; ++u) { const size_t i = i0 + u * stride; if (i < n8) {
            u32x4 o; o.x = pk2(a[u][0], a[u][1]); o.y = pk2(a[u][2], a[u][3]); o.z = pk2(b[u][0], b[u][1]); o.w = pk2(b[u][2], b[u][3]);
            *(u32x4*)(h + i * 8) = o;
            typedef unsigned u32x2 __attribute__((ext_vector_type(2)));
            *(u32x2*)(ws + WS_H8 + i * 8) = (u32x2){pk4_fp8(a[u][0] * H8_SCALE, a[u][1] * H8_SCALE, a[u][2] * H8_SCALE, a[u][3] * H8_SCALE), pk4_fp8(b[u][0] * H8_SCALE, b[u][1] * H8_SCALE, b[u][2] * H8_SCALE, b[u][3] * H8_SCALE)}; } }
    }
    asm volatile("s_waitcnt vmcnt(0)" ::: "memory"); tp_end(lds, 911);
}

__device__ __forceinline__ void load_row_bf16(const bf16_t* row, int lane, float (&v)[16]) {
#pragma unroll
    for (int j = 0; j < 2; ++j) { const u32x4 w = *(const u32x4*)(row + 8 * lane + 512 * j);
        v[8 * j + 0] = bflo(w.x); v[8 * j + 1] = bfhi(w.x); v[8 * j + 2] = bflo(w.y); v[8 * j + 3] = bfhi(w.y);
        v[8 * j + 4] = bflo(w.z); v[8 * j + 5] = bfhi(w.z); v[8 * j + 6] = bflo(w.w); v[8 * j + 7] = bfhi(w.w); }
}
__device__ __forceinline__ void ln_row(float (&v)[16], const float* g, const float* b, int lane) {
    float s = 0.f;
#pragma unroll
    for (int i = 0; i < 16; ++i) s += v[i];
    const float mean = wave_sum(s) * (1.f / D); float q = 0.f;
#pragma unroll
    for (int i = 0; i < 16; ++i) { v[i] -= mean; q += v[i] * v[i]; }
    const float rstd = rsqrtf(wave_sum(q) * (1.f / D) + LN_EPS);
#pragma unroll
    for (int j = 0; j < 2; ++j) {
        const f32x4 g0 = *(const f32x4*)(g + 8 * lane + 512 * j), g1 = *(const f32x4*)(g + 8 * lane + 512 * j + 4);
        const f32x4 b0 = *(const f32x4*)(b + 8 * lane + 512 * j), b1 = *(const f32x4*)(b + 8 * lane + 512 * j + 4);
#pragma unroll
        for (int i = 0; i < 4; ++i) { v[8 * j + i] = v[8 * j + i] * rstd * g0[i] + b0[i]; v[8 * j + 4 + i] = v[8 * j + 4 + i] * rstd * g1[i] + b1[i]; }
    }
}
__device__ __forceinline__ void load_gb(const float* g, const float* b, int lane, float (&gr)[16], float (&br)[16]) {
#pragma unroll
    for (int j = 0; j < 2; ++j) {
        const f32x4 g0 = *(const f32x4*)(g + 8 * lane + 512 * j), g1 = *(const f32x4*)(g + 8 * lane + 512 * j + 4);
        const f32x4 b0 = *(const f32x4*)(b + 8 * lane + 512 * j), b1 = *(const f32x4*)(b + 8 * lane + 512 * j + 4);
#pragma unroll
        for (int i = 0; i < 4; ++i) { gr[8 * j + i] = g0[i]; gr[8 * j + 4 + i] = g1[i]; br[8 * j + i] = b0[i]; br[8 * j + 4 + i] = b1[i]; }
    }
}
__device__ __forceinline__ void ln_row_r(float (&v)[16], const float (&gr)[16], const float (&br)[16]) {
    float s = 0.f;
#pragma unroll
    for (int i = 0; i < 16; ++i) s += v[i];
    const float mean = wave_sum(s) * (1.f / D); float q = 0.f;
#pragma unroll
    for (int i = 0; i < 16; ++i) { v[i] -= mean; q += v[i] * v[i]; }
    const float rstd = rsqrtf(wave_sum(q) * (1.f / D) + LN_EPS);
#pragma unroll
    for (int i = 0; i < 16; ++i) v[i] = v[i] * rstd * gr[i] + br[i];
}
__device__ __forceinline__ void store_row_bf16(bf16_t* row, int lane, const float (&v)[16]) {
#pragma unroll
    for (int j = 0; j < 2; ++j) { u32x4 o; o.x = pk2(v[8 * j + 0], v[8 * j + 1]); o.y = pk2(v[8 * j + 2], v[8 * j + 3]); o.z = pk2(v[8 * j + 4], v[8 * j + 5]); o.w = pk2(v[8 * j + 6], v[8 * j + 7]);
        *(u32x4*)(row + 8 * lane + 512 * j) = o; }
}

__device__ __forceinline__ void phase_route(const Params& P, int layer, LAS unsigned char* lds, int bid, int nb, int cntoff) {
    const int tid = opaque_tid(), lane = tid & 63, wave = tid >> 6;
    LAS unsigned char* Bhi = lds; LAS unsigned char* Blo = lds + 32768;
    LAS float* cd = (LAS float*)(lds + 65536);
    LAS float* part = cd + 32;
    LAS int* lcnt = (LAS int*)(part + 1024);
    LAS int* lbase = lcnt + 32; LAS int* rcls = lbase + 32; LAS int* rpos = rcls + 256;
    const bf16_t* pre1 = (const bf16_t*)(P.out + OUT_PRE1);
    const float* g = P.in[I_LNMG] + layer * D; const float* b = P.in[I_LNMB] + layer * D;
    const float* Wr = P.in[I_WR]; const float* br = P.in[I_BR];
    int* tokcls = (int*)(P.ws + WS_TOKCLS); int* tokpos = (int*)(P.ws + WS_TOKPOS); float* tokgate = (float*)(P.ws + WS_TOKGATE);
    unsigned* gcnt = (unsigned*)(P.ws + WS_CTL) + CW_CNT + 64 * layer + cntoff;
#pragma unroll 1
    for (int idx = tid; idx < 2048; idx += NTHREADS_C) {
        const int s = idx >> 6, l = idx & 63, e = l & 15, k0 = 32 * s + 8 * (l >> 4);
        unsigned hi[4], lo[4];
#pragma unroll
        for (int j = 0; j < 4; ++j) {
            const float w0 = g[k0 + 2 * j] * Wr[(k0 + 2 * j) * 16 + e], w1 = g[k0 + 2 * j + 1] * Wr[(k0 + 2 * j + 1) * 16 + e];
            const unsigned h0 = f2bf(w0), h1 = f2bf(w1);
            hi[j] = h0 | (h1 << 16); lo[j] = pk2(w0 - bf2f((unsigned short)h0), w1 - bf2f((unsigned short)h1)); }
        *(LAS u32x4*)(Bhi + idx * 16) = (u32x4){hi[0], hi[1], hi[2], hi[3]};
        *(LAS u32x4*)(Blo + idx * 16) = (u32x4){lo[0], lo[1], lo[2], lo[3]};
    }
    { const int e = tid & 15, pt = tid >> 4; float cs = 0.f, ds = 0.f;
#pragma unroll 4
      for (int kk = 0; kk < 32; ++kk) { const int k = pt * 32 + kk; const float w = Wr[k * 16 + e]; cs += g[k] * w; ds += b[k] * w; }
      part[pt * 32 + e] = cs; part[pt * 32 + 16 + e] = ds; }
    __syncthreads();
    if (tid < 32) { float sacc = 0.f;
#pragma unroll 4
        for (int pt = 0; pt < 32; ++pt) sacc += part[pt * 32 + tid];
        cd[tid] = sacc; }
    __syncthreads();
    const int e = lane & 15, q = lane >> 4;
    const float ce = cd[e], de = cd[16 + e], bre = br[e];
    for (int r0 = bid * 256; r0 < T; r0 += nb * 256) {
        if (tid < 32) lcnt[tid] = 0;
        __syncthreads();
#pragma unroll 1
        for (int tile = 0; tile < 2; ++tile) {
            const int tr0 = wave * 32 + tile * 16;
            const bf16_t* arow = pre1 + (size_t)(r0 + tr0 + e) * D + 8 * q;
            f32x4 acc = (f32x4){0.f, 0.f, 0.f, 0.f}; float s1 = 0.f, s2 = 0.f;
#pragma unroll 1
            for (int s0 = 0; s0 < 32; s0 += 8) {
                u32x4 a[8];
#pragma unroll
                for (int u = 0; u < 8; ++u) a[u] = *(const u32x4*)(arow + 32 * (s0 + u));
#pragma unroll
                for (int u = 0; u < 8; ++u) {
                    const bf16x8 bh = *(const LAS bf16x8*)(Bhi + ((s0 + u) * 64 + lane) * 16), bl = *(const LAS bf16x8*)(Blo + ((s0 + u) * 64 + lane) * 16);
                    const bf16x8 af = __builtin_bit_cast(bf16x8, a[u]);
                    acc = __builtin_amdgcn_mfma_f32_16x16x32_bf16(af, bh, acc, 0, 0, 0);
                    acc = __builtin_amdgcn_mfma_f32_16x16x32_bf16(af, bl, acc, 0, 0, 0);
                    const float x0 = bflo(a[u].x), x1 = bfhi(a[u].x), x2 = bflo(a[u].y), x3 = bfhi(a[u].y), x4 = bflo(a[u].z), x5 = bfhi(a[u].z), x6 = bflo(a[u].w), x7 = bfhi(a[u].w);
                    s1 += ((x0 + x1) + (x2 + x3)) + ((x4 + x5) + (x6 + x7));
                    s2 += ((x0 * x0 + x1 * x1) + (x2 * x2 + x3 * x3)) + ((x4 * x4 + x5 * x5) + (x6 * x6 + x7 * x7));
                }
            }
            s1 += __shfl_xor(s1, 16); s1 += __shfl_xor(s1, 32); s2 += __shfl_xor(s2, 16); s2 += __shfl_xor(s2, 32);
            const float mean = s1 * (1.f / D); const float rstd = rsqrtf(fmaxf(s2 * (1.f / D) - mean * mean, 0.f) + LN_EPS);
#pragma unroll
            for (int r = 0; r < 4; ++r) {
                const int R = 4 * q + r;
                const float mr = __shfl(mean, R), rr = __shfl(rstd, R);
                const float lg = rr * (acc[r] - mr * ce) + de;
                float mx = lg;
#pragma unroll
                for (int o = 1; o < 16; o <<= 1) mx = fmaxf(mx, __shfl_xor(mx, o));
                float p = expf(lg - mx), sum = p;
#pragma unroll
                for (int o = 1; o < 16; o <<= 1) sum += __shfl_xor(sum, o);
                p = p / sum;
                const float sel = p + bre;
                int rank = 0;
#pragma unroll
                for (int o = 1; o < 4; ++o) { const float so = __shfl_xor(sel, o); const int eo = e ^ o; rank += (so > sel || (so == sel && eo < e)) ? 1 : 0; }
                float gs = rank < 2 ? sel : 0.f;
                gs += __shfl_xor(gs, 1); gs += __shfl_xor(gs, 2);
                int gi = e >> 2;
#pragma unroll
                for (int o = 4; o < 16; o <<= 1) { const float go = __shfl_xor(gs, o); const int io = __shfl_xor(gi, o); if (go > gs || (go == gs && io < gi)) { gs = go; gi = io; } }
                const bool chosen = ((e >> 2) == gi) && rank < 2;
                const unsigned long long bm = __ballot(chosen);
                const unsigned m4 = (unsigned)(bm >> (16 * q + 4 * gi)) & 0xFu;
                const int ea = __ffs((int)m4) - 1, eb = 31 - __clz((int)m4);
                const int pidx = ea == 0 ? eb - 1 : (ea == 1 ? eb + 1 : 5);
                const float pa = __shfl(p, 16 * q + 4 * gi + ea), pb = __shfl(p, 16 * q + 4 * gi + eb);
                if (e == r) { const int cls = gi * 6 + pidx; const int rl = tr0 + R; const int lp = atomicAdd((int*)&lcnt[cls], 1); rcls[rl] = cls; rpos[rl] = lp;
                    const float inv = 1.f / (pa + pb); const size_t t = (size_t)(r0 + rl); tokgate[t * 2] = pa * inv; tokgate[t * 2 + 1] = pb * inv; }
            }
        }
        __syncthreads();
        if (tid < NCLS) lbase[tid] = (int)atomicAdd(&gcnt[tid], (unsigned)lcnt[tid]);
        __syncthreads();
        if (tid < 256) { const int t = r0 + tid; const int c = rcls[tid]; tokcls[t] = c; tokpos[t] = lbase[c] + rpos[tid]; }
        __syncthreads();
    }
}
__device__ __forceinline__ void phase_permute(const Params& P, int layer, LAS unsigned char* lds, int bid, int nb) {
    const int tid = opaque_tid(), lane = tid & 63, wave = tid >> 6, nw = blockDim.x >> 6;
    LAS int* off = (LAS int*)lds;
    const unsigned* gcnt = (const unsigned*)(P.ws + WS_CTL) + CW_CNT + 64 * layer;
    int* tilecls = (int*)(P.ws + WS_TILECLS);
    if (tid == 0) { int o = 0; for (int c = 0; c < NCLS; ++c) { off[c] = o * 256; const int nt = ((int)gcnt[c] + 255) >> 8;
            if (bid == 0) for (int i = 0; i < nt; ++i) tilecls[8 + o + i] = c;
            o += nt; }
        if (bid == 0) tilecls[0] = o; }
    __syncthreads();
    const bf16_t* pre1 = (const bf16_t*)(P.out + OUT_PRE1); bf16_t* hs = (bf16_t*)(P.ws + WS_BIG + BIG_HS);
    const float* g = P.in[I_LNMG] + layer * D; const float* b = P.in[I_LNMB] + layer * D;
    const int* tokcls = (const int*)(P.ws + WS_TOKCLS); const int* tokpos = (const int*)(P.ws + WS_TOKPOS); int* tokdst = (int*)(P.ws + WS_TOKDST);
    const float* tokgate = (const float*)(P.ws + WS_TOKGATE); float* rowgate = (float*)(P.ws + WS_ROWGATE);
    float gr[16], br[16]; load_gb(g, b, lane, gr, br);
    for (int t0 = bid * nw + wave; t0 < T; t0 += 2 * nb * nw) {
        const int t1 = t0 + nb * nw; const bool has1 = t1 < T;
        float v0[16], v1[16];
        load_row_bf16(pre1 + (size_t)t0 * D, lane, v0);
        if (has1) load_row_bf16(pre1 + (size_t)t1 * D, lane, v1);
        const int dst0 = off[tokcls[t0]] + tokpos[t0]; const int dst1 = has1 ? off[tokcls[t1]] + tokpos[t1] : 0;
#pragma unroll
        for (int rr = 0; rr < 2; ++rr) {
            if (rr == 1 && !has1) break;
            float (&v)[16] = rr ? v1 : v0; const int t = rr ? t1 : t0, dst = rr ? dst1 : dst0;
            ln_row_r(v, gr, br);
            store_row_bf16(hs + (size_t)dst * D, lane, v);
            if (MOE_FP8(layer) && MOEA_FP8) { typedef unsigned u32x2 __attribute__((ext_vector_type(2)));
#pragma unroll
                for (int j = 0; j < 2; ++j) *(u32x2*)(P.ws + WS_BIG + BIG_HS8 + (size_t)dst * D + 8 * lane + 512 * j) = (u32x2){pk4_fp8(v[8 * j] * H8_SCALE, v[8 * j + 1] * H8_SCALE, v[8 * j + 2] * H8_SCALE, v[8 * j + 3] * H8_SCALE), pk4_fp8(v[8 * j + 4] * H8_SCALE, v[8 * j + 5] * H8_SCALE, v[8 * j + 6] * H8_SCALE, v[8 * j + 7] * H8_SCALE)}; }
            if (lane == 0) { tokdst[t] = dst; rowgate[(size_t)dst * 2] = tokgate[(size_t)t * 2]; rowgate[(size_t)dst * 2 + 1] = tokgate[(size_t)t * 2 + 1]; }
        }
    }
}
__device__ __forceinline__ void phase_lnffn(const Params& P, int layer, int bid, int nb) {
    const int tid = opaque_tid(), lane = tid & 63, wave = tid >> 6, nw = blockDim.x >> 6;
    const bf16_t* pre2 = (const bf16_t*)(P.ws + WS_BIG + BIG_PRE2);
    const float* g = P.in[I_LNFG] + layer * D; const float* b = P.in[I_LNFB] + layer * D;
    const int* tokdst = (const int*)(P.ws + WS_TOKDST);
    float gr[16], br[16]; load_gb(g, b, lane, gr, br);
    for (int t0 = bid * nw + wave; t0 < T; t0 += 2 * nb * nw) {
        const int t1 = t0 + nb * nw; const bool has1 = t1 < T;
        float v0[16], v1[16];
        load_row_bf16(pre2 + (size_t)tokdst[t0] * D, lane, v0);
        if (has1) load_row_bf16(pre2 + (size_t)tokdst[t1] * D, lane, v1);
#pragma unroll
        for (int rr = 0; rr < 2; ++rr) {
            if (rr == 1 && !has1) break;
            float (&v)[16] = rr ? v1 : v0; const int t = rr ? t1 : t0;
            ln_row_r(v, gr, br);
            if (layer == 0) { store_row_bf16((bf16_t*)(P.out + OUT_H) + (size_t)t * D, lane, v);
                typedef unsigned u32x2 __attribute__((ext_vector_type(2)));
#pragma unroll
                for (int j = 0; j < 2; ++j) *(u32x2*)(P.ws + WS_H8 + (size_t)t * D + 8 * lane + 512 * j) = (u32x2){pk4_fp8(v[8 * j] * H8_SCALE, v[8 * j + 1] * H8_SCALE, v[8 * j + 2] * H8_SCALE, v[8 * j + 3] * H8_SCALE), pk4_fp8(v[8 * j + 4] * H8_SCALE, v[8 * j + 5] * H8_SCALE, v[8 * j + 6] * H8_SCALE, v[8 * j + 7] * H8_SCALE)}; }
            else { float* o = (float*)P.out + (size_t)t * D;
#pragma unroll
                for (int j = 0; j < 2; ++j) { *(f32x4*)(o + 8 * lane + 512 * j) = (f32x4){v[8 * j], v[8 * j + 1], v[8 * j + 2], v[8 * j + 3]}; *(f32x4*)(o + 8 * lane + 512 * j + 4) = (f32x4){v[8 * j + 4], v[8 * j + 5], v[8 * j + 6], v[8 * j + 7]}; } }
        }
    }
}

enum { MIX_RET = 0, MIX_ML = 1, MIX_GLA = 2, MIX_SSD = 3 };
typedef short s16x4 __attribute__((ext_vector_type(4)));
__device__ __forceinline__ bf16x8 tr_frag(LAS unsigned char* p0, LAS unsigned char* p1) {
    const s16x4 a = __builtin_amdgcn_ds_read_tr16_b64_v4i16((LAS s16x4*)p0), b = __builtin_amdgcn_ds_read_tr16_b64_v4i16((LAS s16x4*)p1);
    return (bf16x8){a[0], a[1], a[2], a[3], b[0], b[1], b[2], b[3]};
}
__device__ __forceinline__ bf16x8 cat_frag(LAS unsigned char* p0, LAS unsigned char* p1) {
    const s16x4 a = *(LAS s16x4*)p0, b = *(LAS s16x4*)p1;
    return (bf16x8){a[0], a[1], a[2], a[3], b[0], b[1], b[2], b[3]};
}
__device__ __forceinline__ bf16x8 pack_acc(const f32x4& lo, const f32x4& hi) {
    u32x4 w; w.x = pg8::cvt_pk_bf16(lo[0], lo[1]); w.y = pg8::cvt_pk_bf16(lo[2], lo[3]); w.z = pg8::cvt_pk_bf16(hi[0], hi[1]); w.w = pg8::cvt_pk_bf16(hi[2], hi[3]);
    return __builtin_bit_cast(bf16x8, w);
}
__device__ __forceinline__ void unpack8(const u32x4& w, float (&v)[8]) {
    v[0] = bflo(w.x); v[1] = bfhi(w.x); v[2] = bflo(w.y); v[3] = bfhi(w.y); v[4] = bflo(w.z); v[5] = bfhi(w.z); v[6] = bflo(w.w); v[7] = bfhi(w.w);
}
__device__ __forceinline__ u32x4 pack8(const float (&v)[8]) {
    u32x4 w; w.x = pg8::cvt_pk_bf16(v[0], v[1]); w.y = pg8::cvt_pk_bf16(v[2], v[3]); w.z = pg8::cvt_pk_bf16(v[4], v[5]); w.w = pg8::cvt_pk_bf16(v[6], v[7]); return w;
}

template <int CTRL, int RM> __device__ __forceinline__ float dpp_take(float old, float v) { return __builtin_bit_cast(float, __builtin_amdgcn_update_dpp(__builtin_bit_cast(int, old), __builtin_bit_cast(int, v), CTRL, RM, 0xf, false)); }
__device__ __forceinline__ float wave_scan_add(float v) {
    v += dpp_take<0x111, 0xf>(0.f, v); v += dpp_take<0x112, 0xf>(0.f, v); v += dpp_take<0x114, 0xf>(0.f, v); v += dpp_take<0x118, 0xf>(0.f, v);
    v += dpp_take<0x142, 0xa>(0.f, v); v += dpp_take<0x143, 0xc>(0.f, v); return v; }
__device__ __forceinline__ float wave_scan_max(float v) {
    const float ni = -3.0e38f;
    v = fmaxf(v, dpp_take<0x111, 0xf>(ni, v)); v = fmaxf(v, dpp_take<0x112, 0xf>(ni, v)); v = fmaxf(v, dpp_take<0x114, 0xf>(ni, v)); v = fmaxf(v, dpp_take<0x118, 0xf>(ni, v));
    v = fmaxf(v, dpp_take<0x142, 0xa>(ni, v)); v = fmaxf(v, dpp_take<0x143, 0xc>(ni, v)); return v; }
__device__ __forceinline__ float fexp(float x) { return __builtin_amdgcn_exp2f(x * 1.4426950408889634f); }
__device__ __forceinline__ float frcp(float x) { return __builtin_amdgcn_rcpf(x); }
__device__ __forceinline__ float fsigmoid(float x) { return frcp(1.f + fexp(-x)); }
__device__ __forceinline__ float fsilu(float x) { return x * fsigmoid(x); }
__device__ __forceinline__ float fsoftplus(float x) {
    const float u = fexp(-fabsf(x));
    const float l = u < 0.01f ? u * (1.f - u * (0.5f - u * 0.33333333f)) : __builtin_amdgcn_logf(1.f + u) * 0.6931471805599453f;
    return fmaxf(x, 0.f) + l;
}
__device__ __forceinline__ float flogsigmoid(float x) { return -fsoftplus(-x); }

template <int NR>
__device__ __forceinline__ void conv_rows(const bf16_t* src, const int trow0, const LAS float* wl, const int ldw, float (&o)[NR][8]) {
    float x[NR + 3][8];
#pragma unroll
    for (int i = 0; i < NR + 3; ++i) {
        if (trow0 + i - 3 >= 0) { const u32x4 xw = *(const u32x4*)(src + (ptrdiff_t)(i - 3) * NP); unpack8(xw, x[i]); }
        else {
#pragma unroll
            for (int j = 0; j < 8; ++j) x[i][j] = 0.f; }
    }
    float wv[5][8];
#pragma unroll
    for (int k = 0; k < 5; ++k) { const f32x4 w0 = *(const LAS f32x4*)(wl + k * ldw), w1 = *(const LAS f32x4*)(wl + k * ldw + 4);
#pragma unroll
        for (int j = 0; j < 4; ++j) { wv[k][j] = w0[j]; wv[k][4 + j] = w1[j]; } }
#pragma unroll
    for (int r = 0; r < NR; ++r)
#pragma unroll
        for (int j = 0; j < 8; ++j) { float a = wv[4][j];
#pragma unroll
            for (int k = 0; k < 4; ++k) a += wv[k][j] * x[r + k][j];
            o[r][j] = fsilu(a); }
}

template <int MIX>
__device__ __forceinline__ void mixer_unit(const Params& P, const int b, const int h, LAS unsigned char* lds, const bool dostore) {
    const int tid0 = opaque_tid(), w = __builtin_amdgcn_readfirstlane(tid0 >> 6);
    typedef unsigned u32x2 __attribute__((ext_vector_type(2)));
    constexpr int RSQ = 288, RSV = 544, RSP = 144;
    constexpr int SZQ = 64 * RSQ, SZV = 64 * RSV, SZP = 64 * RSP;
    constexpr int OQ = 0, OK1 = SZQ, OV = 2 * SZQ, O3 = 2 * SZQ + SZV;
    constexpr int OK2 = (MIX == MIX_ML || MIX == MIX_GLA) ? O3 : OK1;
    constexpr int OV2 = (MIX == MIX_SSD) ? O3 : OV;
    constexpr int OP = MIX == MIX_RET ? O3 : (MIX == MIX_SSD ? O3 + SZV : O3 + SZQ);
    constexpr int NPV = MIX == MIX_SSD ? 4 : 1;
    constexpr int OT = OP + NPV * SZP;
    constexpr int OY = OV2;
    LAS float* tab = (LAS float*)(lds + OT);
    constexpr int TGN = MIX == MIX_GLA ? 8832 : MIX == MIX_ML ? 648 : MIX == MIX_SSD ? 512 : 0;
    constexpr int TCW = MIX == MIX_ML ? 904 : 768;
    static_assert(OT + (MIX == MIX_GLA ? 11776 : MIX == MIX_SSD ? 3328 : 2184) * 4 <= 163840 - 1024, "lds map");
    bf16_t* proj = (bf16_t*)(P.ws + WS_BIG);
    const size_t row0b = (size_t)b * SEQ;
    constexpr int GIDX = MIX == MIX_RET ? I_RETG : MIX == MIX_ML ? I_MLG : MIX == MIX_GLA ? I_GLAG : I_SSDG;
    if (tid0 < 256) tab[TGN + tid0] = P.in[GIDX][h * 256 + tid0];
    if constexpr (MIX == MIX_ML) {
        for (int i = tid0; i < 1280; i += NTHREADS_C) { const int k = i >> 8, j = i & 255; const int chn = (j >> 7) * 512 + h * 128 + (j & 127);
            tab[TCW + i] = k < 4 ? P.in[I_MLCW][k * 1024 + chn] : P.in[I_MLCB][chn]; }
        if (tid0 < 128) tab[512 + tid0] = 0.f; if (tid0 == 0) tab[641] = 0.f;
    }
    if constexpr (MIX == MIX_GLA) {
        for (int i = tid0; i < 2048; i += NTHREADS_C) tab[9088 + i] = P.in[I_GLAWA][(i >> 7) * 512 + h * 128 + (i & 127)];
        if (tid0 < 128) tab[9088 + 2048 + tid0] = P.in[I_GLABA][h * 128 + tid0];
    }
    if constexpr (MIX == MIX_SSD) {
        for (int i = tid0; i < 2560; i += NTHREADS_C) { const int k = i >> 9, j = i & 511; const int chn = j < 256 ? h * 256 + j : (j < 384 ? 1024 + h * 128 + (j - 256) : 1536 + h * 128 + (j - 384));
            tab[TCW + i] = k < 4 ? P.in[I_SSDCW][k * 2048 + chn] : P.in[I_SSDCB][chn]; }
    }
    __syncthreads();
    f32x4 Sacc[8][2];
#pragma unroll
    for (int rt = 0; rt < 8; ++rt)
#pragma unroll
        for (int ct = 0; ct < 2; ++ct) Sacc[rt][ct] = (f32x4){0.f, 0.f, 0.f, 0.f};
    float gam = 1.f, lg2gam = 0.f, g63 = 1.f;
    float rinv[4] = {0.f, 0.f, 0.f, 0.f};
    if constexpr (MIX == MIX_RET) { gam = 1.f - __builtin_amdgcn_exp2f(-5.f - (float)h); lg2gam = __builtin_amdgcn_logf(gam); g63 = __builtin_amdgcn_exp2f(63.f * lg2gam);
#pragma unroll
        for (int i2 = 0; i2 < 4; ++i2) rinv[i2] = __builtin_amdgcn_exp2f(-(float)(2 * (4 * (tid0 & 15) + i2)) * (13.287712379549449f / 128.f)) * 0.15915494309189535f; }

    tp_begin(lds, 100 * MIX + 9);
    unsigned short gpre0 = 0, gpre1 = 0;
    if constexpr (MIX == MIX_ML) { if (w == 0) { const bf16_t* rp = proj + (row0b + (tid0 & 63)) * NP; gpre0 = rp[C0_MI + h]; gpre1 = rp[C0_MF + h]; } }
    if constexpr (MIX == MIX_SSD) { if (w < 4) gpre0 = proj[(row0b + (tid0 & 63)) * NP + C1_DT + 4 * h + w]; }
#pragma unroll 1
    for (int ch = 0; ch < SEQ / 64; ++ch) {
        int tid = tid0; asm volatile("" : "+v"(tid));
        const int lane = tid & 63, c = lane & 15, g = lane >> 4, q4 = (lane >> 2) & 3, p4 = lane & 3;
        const size_t row0 = row0b + (size_t)ch * 64;
        tp_begin(lds, 100 * MIX + 1);
        if constexpr (MIX == MIX_RET) {
            const int* pos = (const int*)P.in[I_POS];
#pragma unroll
            for (int i = 0; i < 2; ++i) {
                const int pi = tid + 512 * i, r = pi >> 4, c8 = pi & 15;
                const bf16_t* rp = proj + (row0 + r) * NP + h * 128 + 8 * c8;
                const u32x4 qw = *(const u32x4*)(rp + C0_RQ), kw = *(const u32x4*)(rp + C0_RK);
                float qv[8], kv[8]; unpack8(qw, qv); unpack8(kw, kv);
                const float ps = (float)pos[row0 + r];
                const float fq = __builtin_amdgcn_exp2f((float)r * lg2gam), fk = 0.08838834764831845f * __builtin_amdgcn_exp2f(-(float)r * lg2gam);
#pragma unroll
                for (int i2 = 0; i2 < 4; ++i2) {
                    const float tr = __builtin_amdgcn_fractf(ps * rinv[i2]);
                    const float sn = __builtin_amdgcn_sinf(tr), cs = __builtin_amdgcn_cosf(tr);
                    const float q0 = qv[2 * i2], q1 = qv[2 * i2 + 1], k0 = kv[2 * i2], k1 = kv[2 * i2 + 1];
                    qv[2 * i2] = (q0 * cs - q1 * sn) * fq; qv[2 * i2 + 1] = (q0 * sn + q1 * cs) * fq;
                    kv[2 * i2] = (k0 * cs - k1 * sn) * fk; kv[2 * i2 + 1] = (k0 * sn + k1 * cs) * fk;
                }
                *(LAS u32x4*)(lds + OQ + RSQ * r + 16 * c8) = pack8(qv);
                *(LAS u32x4*)(lds + OK1 + RSQ * r + 16 * c8) = pack8(kv);
            }
#pragma unroll
            for (int i = 0; i < 4; ++i) {
                const int pi = tid + 512 * i, r = pi >> 5, c8 = pi & 31;
                *(LAS u32x4*)(lds + OV + RSV * r + 16 * c8) = *(const u32x4*)(proj + (row0 + r) * NP + C0_RV + h * 256 + 8 * c8);
            }
        }
        if constexpr (MIX == MIX_GLA) {
            if (tid < 128) *(LAS u32x4*)(tab + 11264 + 4 * tid) = *(const u32x4*)(proj + (row0 + (tid >> 1)) * NP + C1_GA + 8 * (tid & 1));
            __syncthreads();
            {
                const int d = tid & 127, tq = tid >> 7;
                const float ba = tab[9088 + 2048 + d];
                float wv[16];
#pragma unroll
                for (int r = 0; r < 16; ++r) wv[r] = tab[9088 + r * 128 + d];
                float run = 0.f;
#pragma unroll 4
                for (int i = 0; i < 16; ++i) {
                    const int t = 16 * tq + i;
                    const u32x4 g0 = *(LAS u32x4*)(tab + 11264 + 8 * t), g1 = *(LAS u32x4*)(tab + 11264 + 8 * t + 4); float gv[8], gv2[8]; unpack8(g0, gv); unpack8(g1, gv2);
                    float a = ba;
#pragma unroll
                    for (int r = 0; r < 8; ++r) a += gv[r] * wv[r] + gv2[r] * wv[8 + r];
                    run += flogsigmoid(a) * (1.f / 16.f);
                    tab[t * 128 + d] = run;
                }
                tab[8192 + tq * 128 + d] = run;
            }
            __syncthreads();
            if (tid < 128) tab[8704 + tid] = fexp((tab[8192 + tid] + tab[8192 + 128 + tid]) + (tab[8192 + 256 + tid] + tab[8192 + 384 + tid]));
            __syncthreads();
#pragma unroll
            for (int i = 0; i < 2; ++i) {
                const int pi = tid + 512 * i, r = pi >> 4, c8 = pi & 15, tq = r >> 4;
                const bf16_t* rp = proj + (row0 + r) * NP + h * 128 + 8 * c8;
                const u32x4 qw = *(const u32x4*)(rp + C1_GQ), kw = *(const u32x4*)(rp + C1_GK);
                float qv[8], kv[8], k2[8]; unpack8(qw, qv); unpack8(kw, kv);
#pragma unroll
                for (int hh = 0; hh < 2; ++hh) {
                    const int d0 = 8 * c8 + 4 * hh;
                    f32x4 bc = *(LAS f32x4*)(tab + r * 128 + d0);
                    const f32x4 t0 = *(LAS f32x4*)(tab + 8192 + d0), t1 = *(LAS f32x4*)(tab + 8192 + 128 + d0), t2 = *(LAS f32x4*)(tab + 8192 + 256 + d0), t3 = *(LAS f32x4*)(tab + 8192 + 384 + d0);
                    if (tq > 0) bc = bc + t0; if (tq > 1) bc = bc + t1; if (tq > 2) bc = bc + t2;
                    const f32x4 bt = (t0 + t1) + (t2 + t3);
                    const f32x4 dcv = *(LAS f32x4*)(tab + 8704 + d0);
#pragma unroll
                    for (int j = 0; j < 4; ++j) { const float e1 = fexp(bc[j]), e2 = frcp(e1), kk = kv[4 * hh + j] * e2;
                        qv[4 * hh + j] = qv[4 * hh + j] * 0.08838834764831845f * e1; kv[4 * hh + j] = kk; k2[4 * hh + j] = kk * dcv[j]; }
                }
                *(LAS u32x4*)(lds + OQ + RSQ * r + 16 * c8) = pack8(qv);
                *(LAS u32x4*)(lds + OK1 + RSQ * r + 16 * c8) = pack8(kv);
                *(LAS u32x4*)(lds + OK2 + RSQ * r + 16 * c8) = pack8(k2);
            }
#pragma unroll
            for (int i = 0; i < 4; ++i) {
                const int pi = tid + 512 * i, r = pi >> 5, c8 = pi & 31;
                *(LAS u32x4*)(lds + OV + RSV * r + 16 * c8) = *(const u32x4*)(proj + (row0 + r) * NP + C1_GV + h * 256 + 8 * c8);
            }
        }
        if constexpr (MIX == MIX_ML) {
            if (w == 0) {
                const float ip = bf2f(gpre0) + P.in[I_MLBI][h], lf = flogsigmoid(bf2f(gpre1) + P.in[I_MLBF][h]);
                const float bc = wave_scan_add(lf);
                const float u = ip - bc; const float pm = wave_scan_max(u);
                const float mst = tab[641];
                const float M = fmaxf(mst, pm), M63 = __shfl(M, 63), bt = __shfl(bc, 63);
                tab[lane] = u; tab[64 + lane] = M; tab[128 + lane] = fexp(u - M63); tab[192 + lane] = fexp(mst - M); tab[256 + lane] = fexp(-bc - M);
                if (lane == 0) { tab[640] = fexp(mst - M63); tab[642] = bt + M63; }
            }
            {
                const int c16 = tid & 31, r0 = (tid >> 5) * 4, isk = c16 >> 4, c8 = c16 & 15;
                float o[4][8];
                conv_rows<4>(proj + (row0 + r0) * NP + (isk ? C0_MK : C0_MQ) + h * 128 + 8 * c8, ch * 64 + r0, tab + TCW + 8 * c16, 256, o);
#pragma unroll
                for (int r = 0; r < 4; ++r) {
                    if (isk) {
#pragma unroll
                        for (int j = 0; j < 8; ++j) o[r][j] *= 0.08838834764831845f; }
                    *(LAS u32x4*)(lds + (isk ? OK1 : OQ) + RSQ * (r0 + r) + 16 * c8) = pack8(o[r]); }
            }
#pragma unroll
            for (int i = 0; i < 4; ++i) {
                const int pi = tid + 512 * i, r = pi >> 5, c8 = pi & 31;
                *(LAS u32x4*)(lds + OV + RSV * r + 16 * c8) = *(const u32x4*)(proj + (row0 + r) * NP + C0_MV + h * 256 + 8 * c8);
            }
            __syncthreads();
            tp_end(lds, 100 * MIX + 1); tp_begin(lds, 100 * MIX + 6);
#pragma unroll
            for (int i = 0; i < 2; ++i) {
                const int pi = tid + 512 * i, r = pi >> 4, c8 = pi & 15;
                const u32x4 kw = *(LAS u32x4*)(lds + OK1 + RSQ * r + 16 * c8); float kv[8]; unpack8(kw, kv); const float es = tab[128 + r];
#pragma unroll
                for (int j = 0; j < 8; ++j) kv[j] *= es;
                *(LAS u32x4*)(lds + OK2 + RSQ * r + 16 * c8) = pack8(kv);
            }
            {
                const int t = tid >> 3, part = tid & 7; float a = 0.f;
#pragma unroll
                for (int i = 0; i < 2; ++i) { const u32x4 qw = *(LAS u32x4*)(lds + OQ + RSQ * t + 2 * (16 * part + 8 * i)); float qv[8]; unpack8(qw, qv);
                    const f32x4 n0 = *(LAS f32x4*)(tab + 512 + 16 * part + 8 * i), n1 = *(LAS f32x4*)(tab + 512 + 16 * part + 8 * i + 4);
#pragma unroll
                    for (int j = 0; j < 4; ++j) a += qv[j] * n0[j] + qv[4 + j] * n1[j]; }
                a += __shfl_xor(a, 1); a += __shfl_xor(a, 2); a += __shfl_xor(a, 4);
                if (part == 0) tab[448 + t] = a;
            }
        }
        if constexpr (MIX == MIX_SSD) {
            if (w < 4) {
                const int hd = 4 * h + w;
                const float dt = fsoftplus(bf2f(gpre0) + P.in[I_SSDDTB][hd]);
                const float cm = wave_scan_add(dt * (-fexp(P.in[I_SSDALOG][hd])));
                tab[lane * 4 + w] = cm; tab[256 + lane * 4 + w] = dt;
            }
            {
                const int c32 = tid & 31, r0 = (tid >> 5) * 4, isc = c32 >> 4, c8 = c32 & 15, hr = c32 >> 3;
                float o[4][8], ox[4][8];
                conv_rows<4>(proj + (row0 + r0) * NP + (isc ? C1_CM : C1_BM) + h * 128 + 8 * c8, ch * 64 + r0, tab + TCW + 256 + 8 * c32, 512, o);
                conv_rows<4>(proj + (row0 + r0) * NP + C1_XS + h * 256 + 8 * c32, ch * 64 + r0, tab + TCW + 8 * c32, 512, ox);
#pragma unroll
                for (int r = 0; r < 4; ++r) *(LAS u32x4*)(lds + (isc ? OQ : OK1) + RSQ * (r0 + r) + 16 * c8) = pack8(o[r]);
                __syncthreads();
                tp_end(lds, 100 * MIX + 1); tp_begin(lds, 100 * MIX + 6);
                const float last = tab[63 * 4 + hr];
#pragma unroll
                for (int r = 0; r < 4; ++r) { const float dt = tab[256 + (r0 + r) * 4 + hr], e2 = fexp(last - tab[(r0 + r) * 4 + hr]); float o2[8];
#pragma unroll
                    for (int j = 0; j < 8; ++j) { ox[r][j] *= dt; o2[j] = ox[r][j] * e2; }
                    *(LAS u32x4*)(lds + OV + RSV * (r0 + r) + 16 * c32) = pack8(ox[r]);
                    *(LAS u32x4*)(lds + OV2 + RSV * (r0 + r) + 16 * c32) = pack8(o2); }
            }
        }
        __syncthreads();
        tp_end(lds, (MIX == MIX_ML || MIX == MIX_SSD) ? 100 * MIX + 6 : 100 * MIX + 1); tp_begin(lds, 100 * MIX + 2);
        if (ch + 1 < SEQ / 64) {
            const int sl = tid & 15;
            int col = -1;
            if constexpr (MIX == MIX_RET) col = sl < 2 ? C0_RQ + h * 128 + 64 * sl : sl < 4 ? C0_RK + h * 128 + 64 * (sl - 2) : sl < 8 ? C0_RV + h * 256 + 64 * (sl - 4) : sl < 12 ? C0_RG + h * 256 + 64 * (sl - 8) : -1;
            if constexpr (MIX == MIX_ML) col = sl < 2 ? C0_MQ + h * 128 + 64 * sl : sl < 4 ? C0_MK + h * 128 + 64 * (sl - 2) : sl < 8 ? C0_MV + h * 256 + 64 * (sl - 4) : sl < 12 ? C0_MO + h * 256 + 64 * (sl - 8) : sl == 12 ? C0_MI : -1;
            if constexpr (MIX == MIX_GLA) col = sl < 2 ? C1_GQ + h * 128 + 64 * sl : sl < 4 ? C1_GK + h * 128 + 64 * (sl - 2) : sl < 8 ? C1_GV + h * 256 + 64 * (sl - 4) : sl < 12 ? C1_GR + h * 256 + 64 * (sl - 8) : sl == 12 ? C1_GA : -1;
            if constexpr (MIX == MIX_SSD) col = sl < 4 ? C1_XS + h * 256 + 64 * sl : sl < 6 ? C1_BM + h * 128 + 64 * (sl - 4) : sl < 8 ? C1_CM + h * 128 + 64 * (sl - 6) : sl < 12 ? C1_SZ + h * 256 + 64 * (sl - 8) : sl == 12 ? C1_DT : -1;
            if (col >= 0) { const bf16_t* nbp = proj + (row0 + 64 + (tid >> 4)) * NP + col;
                const unsigned pfl = 157696u + (unsigned)w * 512u;
                asm volatile("s_mov_b32 m0, %2\n\ts_nop 0\n\tglobal_load_lds_dword %0, off\n\ts_mov_b32 m0, %3\n\ts_nop 0\n\tglobal_load_lds_dword %1, off"
                             :: "v"(nbp), "v"(nbp + (size_t)32 * NP), "s"(pfl), "s"(pfl + 256u) : "memory", "m0"); }
        }
        {
            const int tt = w >> 1; float rsum = 0.f;
#pragma unroll
            for (int si = 0; si < 2; ++si) {
                const int ss = 2 * (w & 1) + si;
                f32x4 acc = (f32x4){0.f, 0.f, 0.f, 0.f};
#pragma unroll
                for (int ks = 0; ks < 4; ++ks) {
                    const bf16x8 a = *(LAS bf16x8*)(lds + OK1 + RSQ * (16 * ss + c) + 2 * (32 * ks + 8 * g));
                    const bf16x8 bq = *(LAS bf16x8*)(lds + OQ + RSQ * (16 * tt + c) + 2 * (32 * ks + 8 * g));
                    acc = __builtin_amdgcn_mfma_f32_16x16x32_bf16(a, bq, acc, 0, 0, 0);
                }
                const int t = 16 * tt + c, s0 = 16 * ss + 4 * g;
                if constexpr (MIX == MIX_SSD) {
                    const f32x4 ct_ = *(LAS f32x4*)(tab + t * 4);
#pragma unroll
                    for (int hr = 0; hr < 4; ++hr) { float pv[4];
#pragma unroll
                        for (int r = 0; r < 4; ++r) pv[r] = (s0 + r <= t) ? acc[r] * fexp(ct_[hr] - tab[(s0 + r) * 4 + hr]) : 0.f;
                        *(LAS u32x2*)(lds + OP + hr * SZP + RSP * t + 2 * s0) = (u32x2){pg8::cvt_pk_bf16(pv[0], pv[1]), pg8::cvt_pk_bf16(pv[2], pv[3])}; }
                } else {
                    float pv[4];
                    if constexpr (MIX == MIX_ML) { const f32x4 us = *(LAS f32x4*)(tab + s0); const float Mt = tab[64 + t];
#pragma unroll
                        for (int r = 0; r < 4; ++r) { pv[r] = (s0 + r <= t) ? acc[r] * fexp(us[r] - Mt) : 0.f; rsum += pv[r]; } }
                    else {
#pragma unroll
                        for (int r = 0; r < 4; ++r) pv[r] = (s0 + r <= t) ? acc[r] : 0.f; }
                    *(LAS u32x2*)(lds + OP + RSP * t + 2 * s0) = (u32x2){pg8::cvt_pk_bf16(pv[0], pv[1]), pg8::cvt_pk_bf16(pv[2], pv[3])};
                }
            }
            if constexpr (MIX == MIX_ML) { rsum += __shfl_xor(rsum, 16); rsum += __shfl_xor(rsum, 32); if (g == 0) tab[320 + (w & 1) * 64 + 16 * tt + c] = rsum; }
        }
        __syncthreads();
        tp_end(lds, 100 * MIX + 2); tp_begin(lds, 100 * MIX + 3);
        f32x4 Yacc[2][4];
#pragma unroll
        for (int ct = 0; ct < 2; ++ct)
#pragma unroll
            for (int tt = 0; tt < 4; ++tt) Yacc[ct][tt] = (f32x4){0.f, 0.f, 0.f, 0.f};
#pragma unroll
        for (int kd = 0; kd < 4; ++kd) {
            bf16x8 qf[4];
#pragma unroll
            for (int tt = 0; tt < 4; ++tt) { LAS unsigned char* qp = lds + OQ + RSQ * (16 * tt + c) + 2 * (32 * kd + 4 * g); qf[tt] = cat_frag(qp, qp + 32); }
#pragma unroll
            for (int ct = 0; ct < 2; ++ct) { const bf16x8 sf = pack_acc(Sacc[2 * kd][ct], Sacc[2 * kd + 1][ct]);
#pragma unroll
                for (int tt = 0; tt < 4; ++tt) Yacc[ct][tt] = __builtin_amdgcn_mfma_f32_16x16x32_bf16(sf, qf[tt], Yacc[ct][tt], 0, 0, 0); }
        }
        if constexpr (MIX != MIX_GLA) {
#pragma unroll
            for (int tt = 0; tt < 4; ++tt) {
                float rs = gam;
                if constexpr (MIX == MIX_ML) rs = tab[192 + 16 * tt + c];
                if constexpr (MIX == MIX_SSD) rs = fexp(tab[(16 * tt + c) * 4 + (w >> 1)]);
#pragma unroll
                for (int ct = 0; ct < 2; ++ct) Yacc[ct][tt] = Yacc[ct][tt] * rs;
            }
        }
        bf16x8 Vf[2][2];
#pragma unroll
        for (int ks = 0; ks < 2; ++ks)
#pragma unroll
            for (int ct = 0; ct < 2; ++ct) { LAS unsigned char* vp = lds + OV + RSV * (32 * ks + 8 * g + q4) + 2 * (32 * w + 16 * ct) + 8 * p4; Vf[ks][ct] = tr_frag(vp, vp + 4 * RSV); }
#pragma unroll
        for (int ks = 0; ks < 2; ++ks)
#pragma unroll
            for (int tt = 0; tt < 4; ++tt) { const bf16x8 pf = *(LAS bf16x8*)(lds + OP + (MIX == MIX_SSD ? (w >> 1) * SZP : 0) + RSP * (16 * tt + c) + 2 * (32 * ks + 8 * g));
#pragma unroll
                for (int ct = 0; ct < 2; ++ct) Yacc[ct][tt] = __builtin_amdgcn_mfma_f32_16x16x32_bf16(Vf[ks][ct], pf, Yacc[ct][tt], 0, 0, 0); }
        if constexpr (MIX == MIX_GLA) {
#pragma unroll
            for (int rt = 0; rt < 8; ++rt) { const f32x4 dc = *(LAS f32x4*)(tab + 8704 + 16 * rt + 4 * g);
#pragma unroll
                for (int ct = 0; ct < 2; ++ct) Sacc[rt][ct] = Sacc[rt][ct] * dc; }
        } else {
            float dc = gam;
            if constexpr (MIX == MIX_ML) dc = tab[640];
            if constexpr (MIX == MIX_SSD) dc = fexp(tab[63 * 4 + (w >> 1)]);
#pragma unroll
            for (int rt = 0; rt < 8; ++rt)
#pragma unroll
                for (int ct = 0; ct < 2; ++ct) Sacc[rt][ct] = Sacc[rt][ct] * dc;
        }
        if constexpr (MIX == MIX_SSD) {
#pragma unroll
            for (int ks = 0; ks < 2; ++ks)
#pragma unroll
                for (int ct = 0; ct < 2; ++ct) { LAS unsigned char* vp = lds + OV2 + RSV * (32 * ks + 8 * g + q4) + 2 * (32 * w + 16 * ct) + 8 * p4; Vf[ks][ct] = tr_frag(vp, vp + 4 * RSV); }
        }
#pragma unroll
        for (int rt = 0; rt < 8; ++rt)
#pragma unroll
            for (int ks = 0; ks < 2; ++ks) { LAS unsigned char* kp = lds + OK2 + RSQ * (32 * ks + 8 * g + q4) + 2 * (16 * rt) + 8 * p4; const bf16x8 kf = tr_frag(kp, kp + 4 * RSQ);
#pragma unroll
                for (int ct = 0; ct < 2; ++ct) Sacc[rt][ct] = __builtin_amdgcn_mfma_f32_16x16x32_bf16(kf, Vf[ks][ct], Sacc[rt][ct], 0, 0, 0); }
        if constexpr (MIX == MIX_RET) {
#pragma unroll
            for (int rt = 0; rt < 8; ++rt)
#pragma unroll
                for (int ct = 0; ct < 2; ++ct) Sacc[rt][ct] = Sacc[rt][ct] * g63;
        }
        if constexpr (MIX == MIX_ML) {
            if (tid < 128) { float a = 0.f;
#pragma unroll 8
                for (int s = 0; s < 64; ++s) a += bf2f(*(LAS unsigned short*)(lds + OK2 + RSQ * s + 2 * tid));
                tab[512 + tid] = tab[640] * tab[512 + tid] + a; }
        }
        __syncthreads();
        tp_end(lds, 100 * MIX + 3); tp_begin(lds, 100 * MIX + 4);
#pragma unroll
        for (int ct = 0; ct < 2; ++ct)
#pragma unroll
            for (int tt = 0; tt < 4; ++tt)
                *(LAS u32x2*)(lds + OY + RSV * (16 * tt + c) + 2 * (32 * w + 16 * ct + 4 * g)) = (u32x2){pg8::cvt_pk_bf16(Yacc[ct][tt][0], Yacc[ct][tt][1]), pg8::cvt_pk_bf16(Yacc[ct][tt][2], Yacc[ct][tt][3])};
        __syncthreads();
        tp_end(lds, 100 * MIX + 4); tp_begin(lds, 100 * MIX + 5);
        {
            const int t = tid >> 3, part = tid & 7;
            float y[32];
#pragma unroll
            for (int i = 0; i < 4; ++i) { const u32x4 yw = *(LAS u32x4*)(lds + OY + RSV * t + 2 * (32 * part + 8 * i)); float t8[8]; unpack8(yw, t8);
#pragma unroll
                for (int j = 0; j < 8; ++j) y[8 * i + j] = t8[j]; }
            constexpr int GCOL = MIX == MIX_RET ? C0_RG : MIX == MIX_ML ? C0_MO : MIX == MIX_GLA ? C1_GR : C1_SZ;
            constexpr int OCOL = MIX == MIX_RET ? C0_RV : MIX == MIX_ML ? C0_MV : MIX == MIX_GLA ? C1_GV : C1_SZ;
            bf16_t* rp = proj + (row0 + t) * NP + h * 256 + 32 * part;
            u32x4 gw[4];
#pragma unroll
            for (int i = 0; i < 4; ++i) gw[i] = *(const u32x4*)(rp + GCOL + 8 * i);
            if constexpr (MIX == MIX_ML) {
                const float den = (tab[320 + t] + tab[384 + t]) + tab[192 + t] * tab[448 + t];
                const float idn = frcp(fmaxf(fabsf(den), tab[256 + t]));
#pragma unroll
                for (int i = 0; i < 4; ++i) { float gt[8]; unpack8(gw[i], gt);
#pragma unroll
                    for (int j = 0; j < 8; ++j) y[8 * i + j] = y[8 * i + j] * idn * fsigmoid(gt[j]); }
            }
            if constexpr (MIX == MIX_SSD) {
                const int hd = 4 * h + (part >> 1); const float dsk = P.in[I_SSDD][hd] * frcp(tab[256 + t * 4 + (part >> 1)]);
#pragma unroll
                for (int i = 0; i < 4; ++i) { const u32x4 xw = *(LAS u32x4*)(lds + OV + RSV * t + 2 * (32 * part + 8 * i)); float t8[8], gt[8]; unpack8(xw, t8); unpack8(gw[i], gt);
#pragma unroll
                    for (int j = 0; j < 8; ++j) y[8 * i + j] = (y[8 * i + j] + dsk * t8[j]) * fsilu(gt[j]); }
            }
            float mean = 0.f;
            if constexpr (MIX == MIX_RET || MIX == MIX_ML) {
                float s1 = 0.f;
#pragma unroll
                for (int j = 0; j < 32; ++j) s1 += y[j];
                s1 += __shfl_xor(s1, 1); s1 += __shfl_xor(s1, 2); s1 += __shfl_xor(s1, 4);
                mean = s1 * (1.f / 256.f);
            }
            float s2 = 0.f;
#pragma unroll
            for (int j = 0; j < 32; ++j) { y[j] -= mean; s2 += y[j] * y[j]; }
            s2 += __shfl_xor(s2, 1); s2 += __shfl_xor(s2, 2); s2 += __shfl_xor(s2, 4);
            const float rstd = __builtin_amdgcn_rsqf(s2 * (1.f / 256.f) + NORM_EPS);
#pragma unroll
            for (int i = 0; i < 4; ++i) {
                const f32x4 n0 = *(LAS f32x4*)(tab + TGN + 32 * part + 8 * i), n1 = *(LAS f32x4*)(tab + TGN + 32 * part + 8 * i + 4); float o[8];
#pragma unroll
                for (int j = 0; j < 4; ++j) { o[j] = y[8 * i + j] * rstd * n0[j]; o[4 + j] = y[8 * i + 4 + j] * rstd * n1[j]; }
                if constexpr (MIX == MIX_RET || MIX == MIX_GLA) { float gt[8]; unpack8(gw[i], gt);
#pragma unroll
                    for (int j = 0; j < 8; ++j) o[j] *= fsilu(gt[j]); }
                if (dostore) *(u32x4*)(rp + OCOL + 8 * i) = pack8(o);
            }
            if constexpr (MIX == MIX_ML) { if (tid == 0) tab[641] = tab[642]; }
        }
        if (ch + 1 < SEQ / 64) {
            if constexpr (MIX == MIX_ML) { if (w == 0) { const bf16_t* rp = proj + (row0 + 64 + lane) * NP; gpre0 = rp[C0_MI + h]; gpre1 = rp[C0_MF + h]; } }
            if constexpr (MIX == MIX_SSD) { if (w < 4) gpre0 = proj[(row0 + 64 + lane) * NP + C1_DT + 4 * h + w]; }
        }
        __syncthreads();
        tp_end(lds, 100 * MIX + 5);
    }
    tp_end(lds, 100 * MIX + 9);
}

#define XB_TMO      128
#define XB_XCNT(j)  (256  + 64 * (j))
#define XB_XSUB(j)  (1280 + 64 * (j))
#define XB_XGEN(j)  (2304 + 64 * (j))
#define XB_TOP      3328
#define XB_TOPGEN   3392
#define XCD_BAR_WORDS 3456
#define XB_SPIN_CAP (1u << 18)
__device__ __forceinline__ unsigned xb_ld(unsigned* p)              { return __hip_atomic_load(p, __ATOMIC_RELAXED, __HIP_MEMORY_SCOPE_AGENT); }
__device__ __forceinline__ unsigned xb_add(unsigned* p, unsigned v) { return __hip_atomic_fetch_add(p, v, __ATOMIC_RELAXED, __HIP_MEMORY_SCOPE_AGENT); }
__device__ __forceinline__ unsigned xb_xcc_id() { return (unsigned)__builtin_amdgcn_s_getreg((3 << 11) | 20) & 0xFu; }
#define XB_SPIN(cond, bar) do { unsigned _sp = 0; while (cond) { __builtin_amdgcn_s_sleep(1); \
    if ((++_sp & 255u) == 0u) { if (xb_ld(&(bar)[XB_TMO])) break; if (_sp > XB_SPIN_CAP) { atomicAdd(&(bar)[XB_TMO], 1u); break; } } } } while (0)
struct XcdBarrier { unsigned* bar; unsigned x; volatile LAS unsigned* st; };
__device__ __forceinline__ XcdBarrier xcd_barrier_post(unsigned* bar, volatile LAS unsigned* st) {
    XcdBarrier b; b.bar = bar; b.x = xb_xcc_id(); b.st = st;
    if (opaque_tid() == 0) (void)xb_add(&bar[XB_XCNT(b.x)], 1u);
    return b;
}
__device__ __forceinline__ void xcd_barrier_complete(unsigned* bar, unsigned x, unsigned& nloc, unsigned& nx) {
    const unsigned G = gridDim.x * gridDim.y * gridDim.z;
    unsigned sum, cnt, mine, sp = 0u;
    for (;;) {
        sum = 0u; cnt = 0u; mine = 0u;
#pragma unroll
        for (unsigned j = 0; j < 16; ++j) { const unsigned c = xb_ld(&bar[XB_XCNT(j)]); sum += c; cnt += (c > 0u) ? 1u : 0u; mine = (j == x) ? c : mine; }
        if (sum == G) break;
        __builtin_amdgcn_s_sleep(1);
        if ((++sp & 255u) == 0u) { if (xb_ld(&bar[XB_TMO])) break; if (sp > XB_SPIN_CAP) { atomicAdd(&bar[XB_TMO], 1u); break; } }
    }
    nloc = mine > 0u ? mine : 1u; nx = cnt > 0u ? cnt : 1u;
}
__device__ __forceinline__ void xcd_barrier(const XcdBarrier& b) {
    asm volatile("s_waitcnt vmcnt(0)" ::: "memory");
    __syncthreads();
    if (opaque_tid() == 0) {
        unsigned* bar = b.bar;
        __builtin_amdgcn_s_waitcnt(0);
        unsigned nloc = b.st[0], nx = b.st[1];
        if (nloc == 0u) { xcd_barrier_complete(bar, b.x, nloc, nx); b.st[0] = nloc; b.st[1] = nx; }
        const unsigned old = xb_add(&bar[XB_XSUB(b.x)], 1u);
        const unsigned gen = old / nloc;
        if (old + 1u == (gen + 1u) * nloc) {
            __builtin_amdgcn_fence(__ATOMIC_RELEASE, "agent");
            asm volatile("s_waitcnt vmcnt(0)" ::: "memory");
            const unsigned og = xb_add(&bar[XB_TOP], 1u);
            const unsigned tg = og / nx;
            if (og + 1u == (tg + 1u) * nx) xb_add(&bar[XB_TOPGEN], 1u);
            else XB_SPIN(xb_ld(&bar[XB_TOPGEN]) == tg, bar);
            __builtin_amdgcn_fence(__ATOMIC_ACQUIRE, "agent");
            xb_add(&bar[XB_XGEN(b.x)], 1u);
            asm volatile("s_waitcnt vmcnt(0)" ::: "memory");
        } else {
            XB_SPIN(xb_ld(&bar[XB_XGEN(b.x)]) == gen, bar);
            __builtin_amdgcn_fence(__ATOMIC_ACQUIRE, "agent");
            asm volatile("s_waitcnt vmcnt(0)" ::: "memory");
        }
    }
    __syncthreads();
}

constexpr int NTHREADS = 512;
constexpr int RING_BYTES = 131072;
constexpr int LDS_BYTES = 163840;
constexpr int LDS_BARW = LDS_BYTES - 16;
constexpr int NPHASES = 17;
#ifndef MK_N_LAUNCHES
#define MK_N_LAUNCHES 1
#endif

#ifndef REP_ROUTE
#define REP_ROUTE 1
#endif
#ifndef REP_CONV
#define REP_CONV 1
#endif
#ifndef REP_GIN
#define REP_GIN 1
#endif
#ifndef REP_GOUT
#define REP_GOUT 1
#endif
#ifndef REP_PERM
#define REP_PERM 1
#endif
#ifndef REP_MOEA
#define REP_MOEA 1
#endif
#ifndef REP_MOEB
#define REP_MOEB 1
#endif
#ifndef REP_LNF
#define REP_LNF 1
#endif
#ifndef MIXREP_RET
#define MIXREP_RET 1
#endif
#ifndef MIXREP_ML
#define MIXREP_ML 1
#endif
#ifndef MIXREP_GLA
#define MIXREP_GLA 1
#endif
#ifndef MIXREP_SSD
#define MIXREP_SSD 1
#endif
struct Args { Params P; int ph_lo, ph_hi; };
typedef __attribute__((address_space(4))) const unsigned char* kargp_t;
__device__ __forceinline__ const Params& kparams() {
    kargp_t p = (kargp_t)__builtin_amdgcn_kernarg_segment_ptr();
    asm volatile("" : "+s"(p));
    return *(const Params*)p;
}

__device__ __forceinline__ int kphase_lo() { kargp_t p = (kargp_t)__builtin_amdgcn_kernarg_segment_ptr(); asm volatile("" : "+s"(p)); return ((const Args*)p)->ph_lo; }
__device__ __forceinline__ int kphase_hi() { kargp_t p = (kargp_t)__builtin_amdgcn_kernarg_segment_ptr(); asm volatile("" : "+s"(p)); return ((const Args*)p)->ph_hi; }
__device__ __forceinline__ void grid_barrier(LAS unsigned char* lds) {
    XcdBarrier b; b.bar = (unsigned*)(kparams().ws + WS_CTL) + CW_BAR; b.x = xb_xcc_id(); b.st = (volatile LAS unsigned*)(lds + LDS_BARW);
    tp_begin(lds, 900); xcd_barrier(b); tp_end(lds, 900);
}
template <int LAYER>
__device__ __forceinline__ void layer_phases(LAS unsigned char* lds) {
#define IN(k) (kphase_lo() <= (k) && (k) < kphase_hi())
#define SEAM(k) do { if (IN(k) && IN((k) + 1)) grid_barrier(lds); } while (0)
    constexpr int PB = 1 + 8 * LAYER;
    const int bid = blockIdx.x, nb = gridDim.x;
    if (IN(PB + 0)) {
        const Params& P = kparams();
        pg8::EpiStore E{(bf16_t*)(P.ws + WS_BIG), NP};
        constexpr unsigned M8 = LAYER ? INPROJ_FP8MASK1 : INPROJ_FP8MASK0, M16 = ALLTILES & ~M8;
        for (int rep = 0; rep < REP_GIN; ++rep) {
            if constexpr (M16 != 0u) {
                pg8::SchedCols S; S.A = (const char*)(P.out + OUT_H); S.B = (const char*)(P.ws + (LAYER ? WS_WIN1 : WS_WIN0)); S.lda = D; S.ldb = D; S.nM = T / 256; S.nN = __builtin_popcount(M16); S.G = nb; S.c = bid; S.mask = M16;
                pg8::gemm_phase(lds, S, E, D, D, D);
            }
            if constexpr (M8 != 0u) {
                pg8::SchedCols S; S.A = (const char*)(P.ws + WS_H8); S.B = (const char*)(P.ws + (LAYER ? WS_WIN8_1 : WS_WIN8_0)); S.lda = D / 2; S.ldb = D / 2; S.nM = T / 256; S.nN = __builtin_popcount(M8); S.G = nb; S.c = bid; S.mask = M8;
                pg8::gemm_phase<pg8::EpiStore, pg8::SchedCols, true, 0x7c7c7c7c, 0x77777777>(lds, S, E, D / 2, D / 2, D / 2);
            }
        }
    }
    SEAM(PB + 0);
    if (IN(PB + 1)) {
        const Params& P = kparams();
        for (int u = bid; u < 256; u += nb) {
            const int b = (u & 127) >> 2, h = u & 3;
            if (LAYER == 0) { if (u < 128) { for (int rep = 0; rep < MIXREP_RET; ++rep) { mixer_unit<MIX_RET>(P, b, h, lds, rep == MIXREP_RET - 1); __syncthreads(); }
                                               convert_moe(P, lds, u, 128); }
                              else { for (int rep = 0; rep < MIXREP_ML; ++rep) { mixer_unit<MIX_ML>(P, b, h, lds, rep == MIXREP_ML - 1); __syncthreads(); } } }
            else { if (u < 128) { for (int rep = 0; rep < MIXREP_GLA; ++rep) { mixer_unit<MIX_GLA>(P, b, h, lds, rep == MIXREP_GLA - 1); __syncthreads(); } }
                   else { for (int rep = 0; rep < MIXREP_SSD; ++rep) { mixer_unit<MIX_SSD>(P, b, h, lds, rep == MIXREP_SSD - 1); __syncthreads(); } } }
        }
    }
    SEAM(PB + 1);
    if (IN(PB + 2)) {
        const Params& P = kparams();
        pg8::SchedPlain S; S.A = (const char*)(P.ws + WS_BIG) + YOFF * 2; S.B = (const char*)(P.ws + (LAYER ? WS_WOUT1 : WS_WOUT0)); S.lda = NP; S.ldb = 2048; S.nM = T / 256; S.nN = 4; S.G = nb; S.c = bid;
        pg8::EpiResid E{(bf16_t*)(P.out + OUT_PRE1), (const bf16_t*)(P.out + OUT_H)};
        for (int rep = 0; rep < REP_GOUT; ++rep) pg8::gemm_phase(lds, S, E, 2048, NP, 2048);
    }
    SEAM(PB + 2);
    if (IN(PB + 3)) for (int rep = 0; rep < REP_ROUTE; ++rep) { phase_route(kparams(), LAYER, lds, bid, nb, 32 * (REP_ROUTE - 1 - rep)); __syncthreads(); }
    SEAM(PB + 3);
    if (IN(PB + 4)) for (int rep = 0; rep < REP_PERM; ++rep) phase_permute(kparams(), LAYER, lds, bid, nb);
    SEAM(PB + 4);
    if (IN(PB + 5)) {
        const Params& P = kparams();
        const int* tilecls = (const int*)(P.ws + WS_TILECLS);
        if constexpr (MOE_FP8(LAYER) && MOEA_FP8) {
            pg8::SchedMoeA<true> S; S.A = (const char*)(P.ws + WS_BIG + BIG_HS8); S.Wgu = (const char*)(P.ws + WS_WGU) + (size_t)LAYER * 16 * 2097152; S.tilecls = tilecls; S.nM = __builtin_amdgcn_readfirstlane(tilecls[0]); S.G = nb; S.c = bid;
            pg8::EpiSwiglu8 E{P.ws + WS_BIG + BIG_H, (const float*)(P.ws + WS_ROWGATE)};
            for (int rep = 0; rep < REP_MOEA; ++rep) pg8::gemm_phase<pg8::EpiSwiglu8, pg8::SchedMoeA<true>, true, 0x7c7c7c7c, 0x77777777>(lds, S, E, D / 2, D / 2, D / 2);
        } else if constexpr (MOE_FP8(LAYER)) {
            pg8::SchedMoeA<false> S; S.A = (const char*)(P.ws + WS_BIG + BIG_HS); S.Wgu = (const char*)(P.ws + WS_WGU) + (size_t)LAYER * 16 * 2097152; S.tilecls = tilecls; S.nM = __builtin_amdgcn_readfirstlane(tilecls[0]); S.G = nb; S.c = bid;
            pg8::EpiSwiglu8 E{P.ws + WS_BIG + BIG_H, (const float*)(P.ws + WS_ROWGATE)};
            for (int rep = 0; rep < REP_MOEA; ++rep) pg8::gemm_phase(lds, S, E, D, D, D);
        } else {
            pg8::SchedMoeA<false> S; S.A = (const char*)(P.ws + WS_BIG + BIG_HS); S.Wgu = (const char*)(P.ws + WS_WGU) + (size_t)LAYER * 16 * 2097152; S.tilecls = tilecls; S.nM = __builtin_amdgcn_readfirstlane(tilecls[0]); S.G = nb; S.c = bid;
            pg8::EpiSwiglu E{(bf16_t*)(P.ws + WS_BIG + BIG_H), (const float*)(P.ws + WS_ROWGATE)};
            for (int rep = 0; rep < REP_MOEA; ++rep) pg8::gemm_phase(lds, S, E, D, D, D);
        }
    }
    SEAM(PB + 5);
    if (IN(PB + 6)) {
        const Params& P = kparams();
        const int* tilecls = (const int*)(P.ws + WS_TILECLS);
        pg8::EpiResid E{(bf16_t*)(P.ws + WS_BIG + BIG_PRE2), (const bf16_t*)(P.ws + WS_BIG + BIG_HS)};
        if constexpr (MOE_FP8(LAYER)) {
            pg8::SchedMoeB<true> S; S.A = (const char*)(P.ws + WS_BIG + BIG_H); S.Wd = (const char*)(P.ws + WS_WD) + (size_t)LAYER * 16 * 1048576; S.tilecls = tilecls; S.nM = __builtin_amdgcn_readfirstlane(tilecls[0]); S.G = nb; S.c = bid;
            for (int rep = 0; rep < REP_MOEB; ++rep) pg8::gemm_phase<pg8::EpiResid, pg8::SchedMoeB<true>, true, 0x7c7c7c7c, 0x77777777>(lds, S, E, D / 2, D / 2, 256);
        } else {
            pg8::SchedMoeB<false> S; S.A = (const char*)(P.ws + WS_BIG + BIG_H); S.Wd = (const char*)(P.ws + WS_WD) + (size_t)LAYER * 16 * 1048576; S.tilecls = tilecls; S.nM = __builtin_amdgcn_readfirstlane(tilecls[0]); S.G = nb; S.c = bid;
            for (int rep = 0; rep < REP_MOEB; ++rep) pg8::gemm_phase(lds, S, E, D, D, 512);
        }
    }
    SEAM(PB + 6);
    if (IN(PB + 7)) for (int rep = 0; rep < REP_LNF; ++rep) phase_lnffn(kparams(), LAYER, bid, nb);
    if (LAYER == 0) SEAM(PB + 7);
#undef IN
#undef SEAM
}

__global__ void __launch_bounds__(NTHREADS, 2) mega_fwd(Args a) {
    LAS unsigned char* lds = (LAS unsigned char*)g_lds;
    if (threadIdx.x < 4) ((LAS unsigned*)(lds + LDS_BARW))[threadIdx.x] = 0u;
    if (TPROBE_ID != 0 && threadIdx.x < 4) ((LAS unsigned*)(lds + LDS_TPROBE))[threadIdx.x] = 0u;
    if ((threadIdx.x & 63) == 0) *(LAS int*)(lds + LDS_WIDTAB + 4 * hw_wave_key()) = (int)(threadIdx.x >> 6);
    __syncthreads();
    if (a.ph_hi - a.ph_lo > 1) (void)xcd_barrier_post((unsigned*)(kparams().ws + WS_CTL) + CW_BAR, (volatile LAS unsigned*)(lds + LDS_BARW));
    if (kphase_lo() <= 0 && 0 < kphase_hi()) { for (int rep = 0; rep < REP_CONV; ++rep) phase_convert(kparams(), lds, blockIdx.x, gridDim.x); if (1 < kphase_hi()) grid_barrier(lds); }
    layer_phases<0>(lds);
    layer_phases<1>(lds);
    if (TPROBE_ID != 0 && blockIdx.x == TPROBE_BLOCK && opaque_tid() == 0) {
        const unsigned long long need = ((LAS unsigned long long*)(lds + LDS_TPROBE))[0] * TPROBE_MULT, t0 = wall_clock64();
        while (wall_clock64() - t0 < need) __builtin_amdgcn_s_sleep(8);
    }
}

extern "C" void kernel_launch(void* const* d_in, const int* in_sizes, int n_in, void* d_out, int out_size, void* d_ws, size_t ws_size, hipStream_t stream) {
    static int grid = 0;
    if (!grid) {
        if (n_in != 30 || ws_size < WS_END || out_size != T * D) { fprintf(stderr, "kernel_launch: unexpected shapes n_in %d ws %zu out %d\n", n_in, ws_size, out_size); grid = -1; return; }
        int dev = 0, cus = 0, per_cu = 0;
        if (hipGetDevice(&dev) != hipSuccess || hipDeviceGetAttribute(&cus, hipDeviceAttributeMultiprocessorCount, dev) != hipSuccess) { grid = -1; return; }
        if (hipFuncSetAttribute((const void*)mega_fwd, hipFuncAttributeMaxDynamicSharedMemorySize, LDS_BYTES) != hipSuccess) { fprintf(stderr, "kernel_launch: hipFuncSetAttribute failed\n"); grid = -1; return; }
        if (hipOccupancyMaxActiveBlocksPerMultiprocessor(&per_cu, (const void*)mega_fwd, NTHREADS, LDS_BYTES) != hipSuccess || per_cu < 1)
            fprintf(stderr, "kernel_launch: note: occupancy query reports %d workgroups per CU\n", per_cu);
        grid = cus > 0 ? cus : 256;
    }
    if (grid < 0) return;
    Args a{};
    for (int i = 0; i < 30; ++i) a.P.in[i] = (const float*)d_in[i];
    a.P.out = (unsigned char*)d_out; a.P.ws = (unsigned char*)d_ws;
    (void)hipMemsetAsync((char*)d_ws + WS_CTL, 0, CTL_BYTES, stream);
    constexpr int NL = MK_N_LAUNCHES;
    if (NL == 1) { a.ph_lo = 0; a.ph_hi = NPHASES; hipLaunchKernelGGL(mega_fwd, dim3(grid), dim3(NTHREADS), LDS_BYTES, stream, a); }
    else for (int p = 0; p < NPHASES; ++p) { a.ph_lo = p; a.ph_hi = p + 1; hipLaunchKernelGGL(mega_fwd, dim3(grid), dim3(NTHREADS), LDS_BYTES, stream, a); }
}
```

```cpp
#include <hip/hip_runtime.h>
#include <cstdio>
#include <cstdint>

#ifndef MIX_LREP
#define MIX_LREP 1
#endif
#ifndef MIX_SREP
#define MIX_SREP 1
#endif
#ifndef MIX_EREP
#define MIX_EREP 1
#endif
#define GAS __attribute__((address_space(1)))
#define LAS __attribute__((address_space(3)))
typedef unsigned short bf16_t;
typedef short bf16x8 __attribute__((ext_vector_type(8)));
typedef float f32x4 __attribute__((ext_vector_type(4)));
typedef unsigned u32x4 __attribute__((ext_vector_type(4)));

constexpr int BATCH = 32, SEQ = 2048, T = BATCH * SEQ, D = 1024;
constexpr int NP = 6400;
constexpr int YOFF = 1024;
constexpr int NCLS = 24, MAXTILES = 280;
constexpr float LN_EPS = 1e-5f, NORM_EPS = 1e-6f;
constexpr float ALPHA = 1.41421356237f;
constexpr int NTHREADS_C = 512;

constexpr int C0_RQ = 0, C0_RK = 512, C0_RV = 1024, C0_MV = 2048, C0_RG = 3072, C0_MQ = 4096, C0_MK = 4608, C0_MO = 5120, C0_MI = 6144, C0_MF = 6148;
constexpr int C1_GQ = 0, C1_GK = 512, C1_GV = 1024, C1_SZ = 2048, C1_GR = 3072, C1_XS = 4096, C1_BM = 5120, C1_CM = 5632, C1_GA = 6144, C1_DT = 6160;

constexpr size_t MiB = 1u << 20;
constexpr size_t WS_CTL = 0, CTL_BYTES = 1 * MiB;
constexpr size_t WS_WIN0 = 2 * MiB;
constexpr size_t WS_WIN1 = 15 * MiB;
constexpr size_t WS_WOUT0 = 28 * MiB;
constexpr size_t WS_WOUT1 = 32 * MiB;
constexpr size_t WS_WGU = 36 * MiB;
constexpr size_t WS_WD = 100 * MiB;
constexpr size_t WS_TOKCLS = 132 * MiB;
constexpr size_t WS_TOKPOS = WS_TOKCLS + (size_t)T * 4;
constexpr size_t WS_TOKDST = WS_TOKPOS + (size_t)T * 4;
constexpr size_t WS_TOKGATE = WS_TOKDST + (size_t)T * 4;
constexpr size_t WS_ROWGATE = WS_TOKGATE + (size_t)T * 8;
constexpr size_t WS_TILECLS = WS_ROWGATE + (size_t)MAXTILES * 256 * 8;
constexpr size_t WS_BIG = 136 * MiB;
constexpr size_t BIG_HS = 0, BIG_H = 160 * MiB, BIG_PRE2 = 320 * MiB, BIG_HS8 = 480 * MiB;
constexpr size_t WS_H8 = WS_BIG + (size_t)T * NP * 2;
constexpr size_t WS_WIN8_0 = WS_H8 + (size_t)T * D;
constexpr size_t WS_WIN8_1 = WS_WIN8_0 + (size_t)NP * D;
constexpr size_t WS_END = WS_WIN8_1 + (size_t)NP * D;
static_assert(WS_TILECLS + (MAXTILES + 8) * 4 <= WS_BIG, "ws map");
static_assert(WS_END <= 1024 * MiB, "ws map");
constexpr size_t OUT_H = 0, OUT_PRE1 = 128 * MiB;
constexpr int CW_CNT = 1024;
constexpr int CW_BAR = 4096;

__device__ __forceinline__ unsigned f2bf(float f) { unsigned u = __builtin_bit_cast(unsigned, f); return (u + 0x7fffu + ((u >> 16) & 1u)) >> 16; }
__device__ __forceinline__ unsigned pk2(float lo, float hi) { return f2bf(lo) | (f2bf(hi) << 16); }
__device__ __forceinline__ float bf2f(unsigned short b) { return __builtin_bit_cast(float, ((unsigned)b) << 16); }
__device__ __forceinline__ float bflo(unsigned w) { return __builtin_bit_cast(float, w << 16); }
__device__ __forceinline__ float bfhi(unsigned w) { return __builtin_bit_cast(float, w & 0xffff0000u); }
__device__ __forceinline__ float sigmoidf_(float x) { return 1.f / (1.f + __expf(-x)); }
__device__ __forceinline__ float siluf_(float x) { return x / (1.f + __expf(-x)); }
__device__ __forceinline__ float softplusf_(float x) { return x > 20.f ? x : log1pf(expf(x)); }
__device__ __forceinline__ float logsigmoidf_(float x) { return -softplusf_(-x); }
__device__ __forceinline__ float wave_sum(float v) {
#define WS_DPP(ctrl, rm) v += __builtin_bit_cast(float, __builtin_amdgcn_update_dpp(0, __builtin_bit_cast(int, v), ctrl, rm, 0xf, false))
    WS_DPP(0x111, 0xf); WS_DPP(0x112, 0xf); WS_DPP(0x114, 0xf); WS_DPP(0x118, 0xf); WS_DPP(0x142, 0xa); WS_DPP(0x143, 0xc);
#undef WS_DPP
    return __builtin_bit_cast(float, __builtin_amdgcn_readlane(__builtin_bit_cast(int, v), 63));
}
#define LDS_WAIT() asm volatile("s_waitcnt lgkmcnt(0)" ::: "memory")
__device__ __forceinline__ unsigned pk4_fp8(float a, float b, float c, float d) { int w = __builtin_amdgcn_cvt_pk_fp8_f32(a, b, 0, false); w = __builtin_amdgcn_cvt_pk_fp8_f32(c, d, w, true); return (unsigned)w; }
#ifndef MOE_FP8
#define MOE_FP8(layer) ((layer) >= 0)
#endif
#ifndef MOEA_FP8
#define MOEA_FP8 1
#endif
#ifndef INPROJ_FP8MASK0
#define INPROJ_FP8MASK0 0x00fcfffcu
#endif
#ifndef INPROJ_FP8MASK1
#define INPROJ_FP8MASK1 0x01ffffffu
#endif
constexpr unsigned ALLTILES = 0x01ffffffu;
#ifndef INPROJ_FP8
#define INPROJ_FP8(layer) ((layer) == 1)
#endif
constexpr float H8_SCALE = 8.f, W8_SCALE = 256.f;
#ifndef TPROBE_ID
#define TPROBE_ID 0
#endif
#ifndef TPROBE_BLOCK
#define TPROBE_BLOCK 128
#endif
#ifndef TPROBE_MULT
#define TPROBE_MULT 4
#endif
constexpr int LDS_TPROBE = 163840 - 48;
__device__ __forceinline__ int opaque_tid();
__device__ __forceinline__ void tp_begin(LAS unsigned char* lds, int id) { if (TPROBE_ID != 0 && TPROBE_ID == id && opaque_tid() == 0) ((LAS unsigned long long*)(lds + LDS_TPROBE))[1] = wall_clock64(); }
__device__ __forceinline__ void tp_end(LAS unsigned char* lds, int id) { if (TPROBE_ID != 0 && TPROBE_ID == id && opaque_tid() == 0) { LAS unsigned long long* p = (LAS unsigned long long*)(lds + LDS_TPROBE); p[0] += wall_clock64() - p[1]; } }
extern __shared__ __attribute__((aligned(16))) unsigned char g_lds[];
constexpr int LDS_WIDTAB = 163840 - 512;
__device__ __forceinline__ int hw_wave_key() { return (int)__builtin_amdgcn_s_getreg((5 << 11) | 4) & 63; }
__device__ __forceinline__ int opaque_tid() {
    const int wid = __builtin_amdgcn_readfirstlane(*(volatile LAS int*)((LAS unsigned char*)g_lds + LDS_WIDTAB + 4 * hw_wave_key()));
    int t = wid * 64 + (int)__builtin_amdgcn_mbcnt_hi(~0u, __builtin_amdgcn_mbcnt_lo(~0u, 0u)); asm volatile("" : "+v"(t)); return t; }

namespace pg8 {
constexpr int BM = 256, BK = 64, HALF = 128, HTB = HALF * BK * 2, STAGE_BYTES = 8 * HTB, NXCD = 8, WGM = 8;
__host__ __device__ __forceinline__ int lds_byte(int r, int c) { const int st = (r >> 4) * 2 + (c >> 5), rr = r & 15, cc = c & 31, ob = rr * 64 + cc * 2; return st * 1024 + (ob ^ (((ob >> 9) & 1) << 5)); }
__host__ __device__ __forceinline__ void stage_rc(int b, int& R, int& C) { const int st = b / 1024, sb = b % 1024, swz = sb ^ (((sb >> 9) & 1) << 5); R = (st >> 1) * 16 + swz / 64; C = (st & 1) * 32 + (swz % 64) / 2; }
__host__ __device__ __forceinline__ int perm32(int rho) { const int n = rho >> 4, i = rho & 15; return 8 * (i >> 2) + 4 * n + (i & 3); }

struct Unit { int pm, pn; unsigned a, b0, b1; };

__device__ __forceinline__ bool static_tile(int i, int G, int c, int nM, int nN, int& pm, int& pn) {
    const int nwg = nM * nN; const int L = i * G + c; if (L >= nwg) return false;
    int wgid = L; { const int q = nwg / NXCD, r = nwg % NXCD, xcd = wgid % NXCD, off = wgid / NXCD; wgid = (xcd < r ? xcd * (q + 1) : r * (q + 1) + (xcd - r) * q) + off; }
    const int nig = WGM * nN, gid = wgid / nig, fm = gid * WGM, gsz = (nM - fm) < WGM ? (nM - fm) : WGM;
    pm = fm + ((wgid % nig) % gsz); pn = (wgid % nig) / gsz; return true;
}
template <class Tp> __device__ __forceinline__ Tp* uniform_ptr(Tp* p) {
    const unsigned long long v = (unsigned long long)p;
    const unsigned lo = __builtin_amdgcn_readfirstlane((unsigned)v), hi = __builtin_amdgcn_readfirstlane((unsigned)(v >> 32));
    return (Tp*)(((unsigned long long)hi << 32) | lo); }
__device__ __forceinline__ unsigned cvt_pk_bf16(float lo, float hi) { unsigned r; asm volatile("v_cvt_pk_bf16_f32 %0, %1, %2" : "=v"(r) : "v"(lo), "v"(hi)); return r; }

typedef int i32x8 __attribute__((ext_vector_type(8)));
typedef int i32x4v __attribute__((ext_vector_type(4)));
__device__ __forceinline__ i32x8 cat16(const bf16x8& lo, const bf16x8& hi) { const i32x4v a = __builtin_bit_cast(i32x4v, lo), b = __builtin_bit_cast(i32x4v, hi); return (i32x8){a[0], a[1], a[2], a[3], b[0], b[1], b[2], b[3]}; }
template <class Epi, class Sched, bool FP8 = false, int SCA = 0x7f7f7f7f, int SCB = 0x7f7f7f7f>
__device__ __forceinline__ void gemm_phase(LAS unsigned char* lds, const Sched& S, const Epi& E, const int K, const int lda, const int ldb) {
    const int tid = opaque_tid(), wid = __builtin_amdgcn_readfirstlane(tid >> 6), lane = tid & 63, wr = wid >> 2, wc = wid & 3, fr = lane & 15, fq = lane >> 4;
    int nt = K / BK; asm volatile("" : "+s"(nt));
    constexpr int KS = Sched::KSPLIT;
    unsigned voffA0, voffB0;
    { int R, C; stage_rc(tid * 16, R, C); const int Rb = (R & ~31) + perm32(R & 31); voffA0 = (unsigned)(R * lda + C) * 2u; voffB0 = (unsigned)(Rb * ldb + C) * 2u; }
    const unsigned q64A = 64u * lda * 2u, q64B = 64u * ldb * 2u;
    const unsigned kstep = (unsigned)(BK * 2);
    const unsigned hstepA = (unsigned)HALF * lda * 2, hstepB = (unsigned)HALF * ldb * 2;
    const __amdgpu_buffer_rsrc_t rsA = __builtin_amdgcn_make_buffer_rsrc((void*)S.A, 0, 0xffffffff, 0x00020000), rsB = __builtin_amdgcn_make_buffer_rsrc((void*)S.bbase(), 0, 0xffffffff, 0x00020000);
    const unsigned ldsw = (unsigned)wid * 1024u;
    const int aoff = lds_byte(wr * 64 + fr, fq * 8), boff = lds_byte(wc * 32 + fr, fq * 8);
#define PG8_BP(u, kt) ((KS > 0 && (kt) >= KS) ? (u).b1 + (unsigned)((kt) - KS) * kstep : (u).b0 + (unsigned)(kt) * kstep)
#define PG8_SA(b, h) (((b) * 2 + (h)) * HTB)
#define PG8_SB(b, h) ((4 + (b) * 2 + (h)) * HTB)
#define PG8_STAGEA(bufoff, soff) do { _Pragma("unroll") for (int _i = 0; _i < 2; ++_i) \
        __builtin_amdgcn_raw_ptr_buffer_load_lds(rsA, (LAS void*)(lds + (bufoff) + ldsw + _i * 8192), 16, voffA0, (int)((soff) + _i * q64A), 0, 0); } while (0)
#define PG8_STAGEB(bufoff, soff) do { _Pragma("unroll") for (int _i = 0; _i < 2; ++_i) \
        __builtin_amdgcn_raw_ptr_buffer_load_lds(rsB, (LAS void*)(lds + (bufoff) + ldsw + _i * 8192), 16, voffB0, (int)((soff) + _i * q64B), 0, 0); } while (0)
#define PG8_LDA(dst, b, h) do { _Pragma("unroll") for (int m = 0; m < 4; ++m) _Pragma("unroll") for (int k = 0; k < 2; ++k) dst[m][k] = *(const LAS bf16x8*)(lds + PG8_SA(b, h) + aoff + m * 2048 + k * 1024); } while (0)
#define PG8_LDB(dst, b, h) do { _Pragma("unroll") for (int n = 0; n < 2; ++n) _Pragma("unroll") for (int k = 0; k < 2; ++k) dst[n][k] = *(const LAS bf16x8*)(lds + PG8_SB(b, h) + boff + n * 2048 + k * 1024); } while (0)
#define PG8_MMA(ai, bj, At, Bt) do { __builtin_amdgcn_s_setprio(1); _Pragma("unroll") for (int m = 0; m < 4; ++m) _Pragma("unroll") for (int n = 0; n < 2; ++n) { \
        if constexpr (FP8) acc[ai][bj][m][n] = __builtin_amdgcn_mfma_scale_f32_16x16x128_f8f6f4(cat16(Bt[n][0], Bt[n][1]), cat16(At[m][0], At[m][1]), acc[ai][bj][m][n], 0, 0, 1, ((SCB & 0xff) << 8) | (SCA & 0xff), 0, ((SCB & 0xff) << 8) | (SCA & 0xff)); \
        else { _Pragma("unroll") for (int k = 0; k < 2; ++k) acc[ai][bj][m][n] = __builtin_amdgcn_mfma_f32_16x16x32_bf16(Bt[n][k], At[m][k], acc[ai][bj][m][n], 0, 0, 0); } } \
        __builtin_amdgcn_s_setprio(0); } while (0)
#define PG8_WAIT_V(n) asm volatile("s_waitcnt vmcnt(" #n ")" ::: "memory")
#define PG8_WAIT_L(n) asm volatile("s_waitcnt lgkmcnt(" #n ")" ::: "memory")
#define PG8_BAR __builtin_amdgcn_s_barrier()
#define PG8_SCHED __builtin_amdgcn_sched_barrier(0)
    Unit cur, nxt; int ui = 0;
    if (!S.next(0, cur)) return;
    f32x4 acc[2][2][4][2];
#pragma unroll
    for (int a = 0; a < 2; ++a)
#pragma unroll
        for (int b = 0; b < 2; ++b)
#pragma unroll
            for (int m = 0; m < 4; ++m)
#pragma unroll
                for (int n = 0; n < 2; ++n) acc[a][b][m][n] = (f32x4){0.f, 0.f, 0.f, 0.f};
    bf16x8 At[4][2], B0[2][2], B1[2][2];
    unsigned cA = cur.a;
    { const unsigned cB0 = PG8_BP(cur, 0), cB1 = PG8_BP(cur, 1);
    PG8_STAGEB(PG8_SB(0, 0), cB0); PG8_STAGEA(PG8_SA(0, 0), cA); PG8_STAGEB(PG8_SB(0, 1), cB0 + hstepB); PG8_STAGEA(PG8_SA(0, 1), cA + hstepA);
    if (wr == 1) PG8_BAR;
    PG8_WAIT_V(4); PG8_BAR;
    PG8_STAGEB(PG8_SB(1, 0), cB1); PG8_STAGEA(PG8_SA(1, 0), cA + kstep); PG8_STAGEB(PG8_SB(1, 1), cB1 + hstepB);
    PG8_WAIT_V(6); PG8_BAR; }
    for (;;) {
        const bool has_next = S.next(ui + 1, nxt);
        if (!has_next) nxt = cur;
        for (int t = 0; t < nt; t += 2) {
            const bool last = (t == nt - 2);
            const unsigned a1 = cA + (unsigned)(t + 1) * kstep;
            const unsigned a2 = last ? nxt.a : cA + (unsigned)(t + 2) * kstep;
            const unsigned b2 = last ? PG8_BP(nxt, 0) : PG8_BP(cur, t + 2);
            const unsigned a3 = a2 + kstep;
            const unsigned b3 = last ? PG8_BP(nxt, 1) : PG8_BP(cur, t + 3);
            PG8_LDB(B0, 0, 0); PG8_SCHED; PG8_LDA(At, 0, 0); PG8_STAGEA(PG8_SA(1, 1), a1 + hstepA);
            PG8_WAIT_L(8); PG8_BAR; PG8_WAIT_L(0); PG8_MMA(0, 0, At, B0); PG8_BAR; PG8_SCHED;
            PG8_LDB(B1, 0, 1); PG8_STAGEB(PG8_SB(0, 0), b2);
            PG8_BAR; PG8_WAIT_L(0); PG8_MMA(0, 1, At, B1); PG8_BAR;
            PG8_LDA(At, 0, 1); PG8_STAGEA(PG8_SA(0, 0), a2);
            PG8_BAR; PG8_WAIT_L(0); PG8_MMA(1, 0, At, B0); PG8_BAR; PG8_SCHED;
            PG8_STAGEB(PG8_SB(0, 1), b2 + hstepB);
            PG8_WAIT_V(6); PG8_BAR; PG8_MMA(1, 1, At, B1); PG8_BAR;
            PG8_LDB(B0, 1, 0); PG8_SCHED; PG8_LDA(At, 1, 0); PG8_STAGEA(PG8_SA(0, 1), a2 + hstepA);
            PG8_WAIT_L(8); PG8_BAR; PG8_WAIT_L(0); PG8_MMA(0, 0, At, B0); PG8_BAR; PG8_SCHED;
            PG8_LDB(B1, 1, 1); PG8_STAGEB(PG8_SB(1, 0), b3);
            PG8_BAR; PG8_WAIT_L(0); PG8_MMA(0, 1, At, B1); PG8_BAR;
            PG8_LDA(At, 1, 1); PG8_STAGEA(PG8_SA(1, 0), a3);
            PG8_BAR; PG8_WAIT_L(0); PG8_MMA(1, 0, At, B0); PG8_BAR; PG8_SCHED;
            PG8_STAGEB(PG8_SB(1, 1), b3 + hstepB);
            PG8_WAIT_V(6); PG8_BAR; PG8_MMA(1, 1, At, B1); PG8_BAR;
        }
        E(acc, cur, wr, wc, fr, fq);
        if (!has_next) break;
#pragma unroll
        for (int a = 0; a < 2; ++a)
#pragma unroll
            for (int b = 0; b < 2; ++b)
#pragma unroll
                for (int m = 0; m < 4; ++m)
#pragma unroll
                    for (int n = 0; n < 2; ++n) acc[a][b][m][n] = (f32x4){0.f, 0.f, 0.f, 0.f};
        cur = nxt; cA = cur.a; ++ui;
    }
    PG8_WAIT_V(0);
    if (wr == 0) PG8_BAR;
    PG8_BAR;
#undef PG8_BP
#undef PG8_SA
#undef PG8_SB
#undef PG8_STAGEA
#undef PG8_STAGEB
#undef PG8_LDA
#undef PG8_LDB
#undef PG8_MMA
#undef PG8_WAIT_V
#undef PG8_WAIT_L
#undef PG8_BAR
#undef PG8_SCHED
}

struct SchedPlain {
    static constexpr int KSPLIT = 0;
    const char* A; const char* B; int lda, ldb, nM, nN, G, c;
    __device__ __forceinline__ const char* bbase() const { return B; }
    __device__ __forceinline__ bool next(int i, Unit& u) const {
        if (!static_tile(i, G, c, nM, nN, u.pm, u.pn)) return false;
        u.a = (unsigned)u.pm * BM * lda * 2; u.b0 = (unsigned)u.pn * BM * ldb * 2; u.b1 = u.b0; return true;
    }
};
struct SchedCols {
    static constexpr int KSPLIT = 0;
    const char* A; const char* B; int lda, ldb, nM, nN, G, c; unsigned mask;
    __device__ __forceinline__ const char* bbase() const { return B; }
    __device__ __forceinline__ bool next(int i, Unit& u) const {
        int pnj; if (!static_tile(i, G, c, nM, nN, u.pm, pnj)) return false;
        unsigned m = mask; for (int j = 0; j < pnj; ++j) m &= m - 1u;
        u.pn = __builtin_ctz(m);
        u.a = (unsigned)u.pm * BM * lda * 2; u.b0 = (unsigned)u.pn * BM * ldb * 2; u.b1 = u.b0; return true;
    }
};
__device__ __forceinline__ void cls_experts(int cls, int& e0, int& e1) {
    const int g = cls / 6, p = cls % 6;
    const int a = p < 3 ? 0 : (p < 5 ? 1 : 2);
    const int b = p < 3 ? p + 1 : (p < 5 ? p - 1 : 3);
    e0 = 4 * g + a; e1 = 4 * g + b;
}
template <bool FP8>
struct SchedMoeA {
    static constexpr int KSPLIT = 0;
    static constexpr int RB = FP8 ? 1024 : 2048;
    const char* A; const char* Wgu; const int* tilecls; int nM, G, c;
    __device__ __forceinline__ const char* bbase() const { return Wgu; }
    __device__ __forceinline__ bool next(int i, Unit& u) const {
        if (!static_tile(i, G, c, nM, 8, u.pm, u.pn)) return false;
        int e0, e1; cls_experts(__builtin_amdgcn_readfirstlane(tilecls[8 + u.pm]), e0, e1); const int e = (u.pn >> 2) ? e1 : e0;
        u.a = (unsigned)u.pm * BM * RB; u.b0 = (unsigned)e * 2097152u + (unsigned)(u.pn & 3) * 256 * RB; u.b1 = u.b0; return true;
    }
};
template <bool FP8>
struct SchedMoeB {
    static constexpr int KSPLIT = FP8 ? 4 : 8;
    static constexpr int RA = FP8 ? 1024 : 2048, RBB = FP8 ? 512 : 1024;
    const char* A; const char* Wd; const int* tilecls; int nM, G, c;
    __device__ __forceinline__ const char* bbase() const { return Wd; }
    __device__ __forceinline__ bool next(int i, Unit& u) const {
        if (!static_tile(i, G, c, nM, 4, u.pm, u.pn)) return false;
        int e0, e1; cls_experts(__builtin_amdgcn_readfirstlane(tilecls[8 + u.pm]), e0, e1);
        u.a = (unsigned)u.pm * BM * RA;
        u.b0 = (unsigned)e0 * 1048576u + (unsigned)u.pn * 256 * RBB; u.b1 = (unsigned)e1 * 1048576u + (unsigned)u.pn * 256 * RBB; return true;
    }
};

struct EpiStore {
    bf16_t* O; int ldc;
    __device__ __forceinline__ void operator()(const f32x4 (&acc)[2][2][4][2], const Unit& u, int wr, int wc, int fr, int fq) const {
        const int row0 = u.pm * BM + wr * 64 + fr, col0 = u.pn * BM + wc * 32 + 8 * fq;
#pragma unroll
        for (int ai = 0; ai < 2; ++ai)
#pragma unroll
            for (int m = 0; m < 4; ++m) { bf16_t* rowp = O + (size_t)(row0 + ai * HALF + m * 16) * ldc + col0;
#pragma unroll
                for (int bj = 0; bj < 2; ++bj) { const f32x4 v0 = acc[ai][bj][m][0], v1 = acc[ai][bj][m][1];
                    u32x4 w; w.x = cvt_pk_bf16(v0[0], v0[1]); w.y = cvt_pk_bf16(v0[2], v0[3]); w.z = cvt_pk_bf16(v1[0], v1[1]); w.w = cvt_pk_bf16(v1[2], v1[3]);
                    *(u32x4*)(rowp + bj * HALF) = w; } }
    }
};
struct EpiResid {
    bf16_t* O; const bf16_t* R;
    __device__ __forceinline__ void operator()(const f32x4 (&acc)[2][2][4][2], const Unit& u, int wr, int wc, int fr, int fq) const {
        const int row0 = u.pm * BM + wr * 64 + fr, col0 = u.pn * BM + wc * 32 + 8 * fq;
#pragma unroll
        for (int ai = 0; ai < 2; ++ai)
#pragma unroll
            for (int m = 0; m < 4; ++m) { const size_t off = (size_t)(row0 + ai * HALF + m * 16) * 1024 + col0;
#pragma unroll
                for (int bj = 0; bj < 2; ++bj) { const f32x4 v0 = acc[ai][bj][m][0], v1 = acc[ai][bj][m][1];
                    const u32x4 r = *(const u32x4*)(R + off + bj * HALF);
                    u32x4 w; w.x = cvt_pk_bf16(v0[0] + ALPHA * bflo(r.x), v0[1] + ALPHA * bfhi(r.x)); w.y = cvt_pk_bf16(v0[2] + ALPHA * bflo(r.y), v0[3] + ALPHA * bfhi(r.y));
                    w.z = cvt_pk_bf16(v1[0] + ALPHA * bflo(r.z), v1[1] + ALPHA * bfhi(r.z)); w.w = cvt_pk_bf16(v1[2] + ALPHA * bflo(r.w), v1[3] + ALPHA * bfhi(r.w));
                    *(u32x4*)(O + off + bj * HALF) = w; } }
    }
};
struct EpiSwiglu {
    bf16_t* H; const float* rowgate;
    __device__ __forceinline__ void operator()(const f32x4 (&acc)[2][2][4][2], const Unit& u, int wr, int wc, int fr, int fq) const {
        const int row0 = u.pm * BM + wr * 64 + fr, ke = u.pn >> 2, col0 = 512 * ke + 128 * (u.pn & 3) + wc * 32 + 8 * fq;
#pragma unroll
        for (int ai = 0; ai < 2; ++ai)
#pragma unroll
            for (int m = 0; m < 4; ++m) { const int row = row0 + ai * HALF + m * 16; const float gt = rowgate[(size_t)row * 2 + ke];
                const f32x4 g0 = acc[ai][0][m][0], g1 = acc[ai][0][m][1], u0 = acc[ai][1][m][0], u1 = acc[ai][1][m][1];
                float o[8];
#pragma unroll
                for (int j = 0; j < 4; ++j) { o[j] = siluf_(g0[j]) * u0[j] * gt; o[4 + j] = siluf_(g1[j]) * u1[j] * gt; }
                u32x4 w; w.x = cvt_pk_bf16(o[0], o[1]); w.y = cvt_pk_bf16(o[2], o[3]); w.z = cvt_pk_bf16(o[4], o[5]); w.w = cvt_pk_bf16(o[6], o[7]);
                *(u32x4*)(H + (size_t)row * 1024 + col0) = w; }
    }
};
struct EpiSwiglu8 {
    unsigned char* H; const float* rowgate;
    __device__ __forceinline__ void operator()(const f32x4 (&acc)[2][2][4][2], const Unit& u, int wr, int wc, int fr, int fq) const {
        typedef unsigned u32x2 __attribute__((ext_vector_type(2)));
        const int row0 = u.pm * BM + wr * 64 + fr, ke = u.pn >> 2, col0 = 512 * ke + 128 * (u.pn & 3) + wc * 32 + 8 * fq;
        unsigned char* const H = uniform_ptr(this->H); const float* const rowgate = uniform_ptr(this->rowgate);
#pragma unroll
        for (int ai = 0; ai < 2; ++ai)
#pragma unroll
            for (int m = 0; m < 4; ++m) { const int row = row0 + ai * HALF + m * 16; const float gt = rowgate[(size_t)row * 2 + ke] * 8.f;
                const f32x4 g0 = acc[ai][0][m][0], g1 = acc[ai][0][m][1], u0 = acc[ai][1][m][0], u1 = acc[ai][1][m][1];
                float o[8];
#pragma unroll
                for (int j = 0; j < 4; ++j) { o[j] = __builtin_amdgcn_fmed3f(g0[j] * __builtin_amdgcn_rcpf(1.f + __builtin_amdgcn_exp2f(-1.4426950408889634f * g0[j])) * u0[j] * gt, -440.f, 440.f);
                    o[4 + j] = __builtin_amdgcn_fmed3f(g1[j] * __builtin_amdgcn_rcpf(1.f + __builtin_amdgcn_exp2f(-1.4426950408889634f * g1[j])) * u1[j] * gt, -440.f, 440.f); }
                *(u32x2*)(H + (size_t)row * 1024 + col0) = (u32x2){pk4_fp8(o[0], o[1], o[2], o[3]), pk4_fp8(o[4], o[5], o[6], o[7])}; }
    }
};
}

struct Params {
    const float* in[30];
    unsigned char* out;
    unsigned char* ws;
};
enum { I_X = 0, I_POS, I_WINAB, I_RETG, I_MLCW, I_MLCB, I_MLBI, I_MLBF, I_MLG, I_WOUTAB, I_WINCD, I_GLAWA, I_GLABA, I_GLAG, I_SSDCW, I_SSDCB, I_SSDDTB, I_SSDALOG, I_SSDD, I_SSDG,
       I_WOUTCD, I_WR, I_BR, I_MOEG, I_MOEU, I_MOED, I_LNMG, I_LNMB, I_LNFG, I_LNFB };

template <class ColPtr>
__device__ __forceinline__ void tr_item(const ColPtr& cp, int ldw, bf16_t* WT, int ldt, int n0, int k0, LAS float* scr, int lane) {
    const float* p = cp(n0 + (lane & 31));
#pragma unroll 8
    for (int i = 0; i < 32; ++i) { const int kk = 2 * i + (lane >> 5); scr[kk * 33 + (lane & 31)] = p ? p[(size_t)(k0 + kk) * ldw] : 0.f; }
    LDS_WAIT();
    const int c = lane & 7;
#pragma unroll
    for (int j = 0; j < 4; ++j) { const int n = (lane >> 3) + 8 * j; const LAS float* s = scr + (8 * c) * 33 + n;
        u32x4 o; o.x = pk2(s[0 * 33], s[1 * 33]); o.y = pk2(s[2 * 33], s[3 * 33]); o.z = pk2(s[4 * 33], s[5 * 33]); o.w = pk2(s[6 * 33], s[7 * 33]);
        *(u32x4*)(WT + (size_t)(n0 + n) * ldt + k0 + 8 * c) = o; }
    LDS_WAIT();
}
template <class ColPtr>
__device__ __forceinline__ void tr_item_fp8(const ColPtr& cp, int ldw, unsigned char* WT, int ldt, int n0, int k0, float scale, LAS float* scr, int lane) {
    const float* p = cp(n0 + (lane & 31));
#pragma unroll 8
    for (int i = 0; i < 32; ++i) { const int kk = 2 * i + (lane >> 5); scr[kk * 33 + (lane & 31)] = p ? p[(size_t)(k0 + kk) * ldw] * scale : 0.f; }
    LDS_WAIT();
    const int c = lane & 7;
    typedef unsigned u32x2 __attribute__((ext_vector_type(2)));
#pragma unroll
    for (int j = 0; j < 4; ++j) { const int n = (lane >> 3) + 8 * j; const LAS float* s = scr + (8 * c) * 33 + n;
        *(u32x2*)(WT + (size_t)(n0 + n) * ldt + k0 + 8 * c) = (u32x2){pk4_fp8(s[0 * 33], s[1 * 33], s[2 * 33], s[3 * 33]), pk4_fp8(s[4 * 33], s[5 * 33], s[6 * 33], s[7 * 33])}; }
    LDS_WAIT();
}
__device__ __forceinline__ int map_ab(int n) {
    if (n < 2048) return n;
    if (n < 3072) return 4096 + (n - 2048);
    if (n < 4096) return 2048 + (n - 3072);
    if (n < 4608) return 3072 + (n - 4096);
    if (n < 5120) return 3584 + (n - 4608);
    if (n < 6152) return n;
    return -1;
}
__device__ __forceinline__ int map_cd(int n) {
    if (n < 2048) return n;
    if (n < 3072) return 3088 + (n - 2048);
    if (n < 4096) return 2048 + (n - 3072);
    if (n < 5120) return 4112 + (n - 4096);
    if (n < 5632) return 5136 + (n - 5120);
    if (n < 6144) return 5648 + (n - 5632);
    if (n < 6160) return 3072 + (n - 6144);
    if (n < 6176) return 6160 + (n - 6160);
    return -1;
}
template <bool FP8, class ColPtr>
__device__ __forceinline__ void tr_block(const ColPtr& cp, int ldw, void* WT, int ldt, int n0, int k0, float scale, LAS float* tile, int tid) {
    {   const int c4 = tid & 63, r0 = tid >> 6;
        const float* p = cp(n0 + 4 * c4);
        f32x4 v[8];
#pragma unroll
        for (int i = 0; i < 8; ++i) v[i] = p ? *(const f32x4*)(p + (size_t)(k0 + r0 + 8 * i) * ldw) : (f32x4){0.f, 0.f, 0.f, 0.f};
#pragma unroll
        for (int i = 0; i < 8; ++i) { LAS float* t = tile + (r0 + 8 * i) * 257 + 4 * c4; t[0] = v[i][0] * scale; t[1] = v[i][1] * scale; t[2] = v[i][2] * scale; t[3] = v[i][3] * scale; }
    }
    __syncthreads();
    {   const int kc = tid & 7, nr = tid >> 3;
#pragma unroll
        for (int j = 0; j < 4; ++j) { const int n = nr + 64 * j; const LAS float* t = tile + (8 * kc) * 257 + n;
            if constexpr (FP8) { typedef unsigned u32x2 __attribute__((ext_vector_type(2)));
                *(u32x2*)((unsigned char*)WT + (size_t)(n0 + n) * ldt + k0 + 8 * kc) = (u32x2){pk4_fp8(t[0], t[257], t[514], t[771]), pk4_fp8(t[1028], t[1285], t[1542], t[1799])}; }
            else { u32x4 o; o.x = pk2(t[0], t[257]); o.y = pk2(t[514], t[771]); o.z = pk2(t[1028], t[1285]); o.w = pk2(t[1542], t[1799]);
                *(u32x4*)((bf16_t*)WT + (size_t)(n0 + n) * ldt + k0 + 8 * kc) = o; } }
    }
    __syncthreads();
}
__device__ __forceinline__ void convert_moe(const Params& P, LAS unsigned char* lds, int bid, int nb) {
    const int tid = opaque_tid();
    LAS float* tile = (LAS float*)lds;
    unsigned char* ws = P.ws;
    constexpr int B_GU = (1024 / 256) * (1024 / 64);
    constexpr int B_DN = (1024 / 256) * (512 / 64);
    constexpr int B_IN = (NP / 256) * (D / 64);
    constexpr int B_OUT = (1024 / 256) * (2048 / 64);
#pragma unroll 1
    for (int it = bid; it < 32 * B_GU + 32 * B_DN + B_IN + 2 * B_OUT; it += nb) {
        int r = it;
        if (r < B_IN) { const int nbk = r / (D / 64), kb = r % (D / 64);
            const float* W = P.in[I_WINCD];
            auto cp = [&](int n) { const int sc = map_cd(n); return sc < 0 ? (const float*)nullptr : W + sc; };
            if ((INPROJ_FP8MASK1 >> nbk) & 1u) tr_block<true>(cp, 6176, ws + WS_WIN8_1, D, nbk * 256, kb * 64, W8_SCALE, tile, tid); else tr_block<false>(cp, 6176, ws + WS_WIN1, D, nbk * 256, kb * 64, 1.f, tile, tid);
            continue; }
        r -= B_IN;
        if (r < 2 * B_OUT) { const int l = r / B_OUT; r %= B_OUT; const int nbk = r / 32, kb = r % 32;
            const float* W = P.in[l ? I_WOUTCD : I_WOUTAB];
            tr_block<false>([&](int n) { return W + n; }, 1024, ws + (l ? WS_WOUT1 : WS_WOUT0), 2048, nbk * 256, kb * 64, 1.f, tile, tid);
            continue; }
        r -= 2 * B_OUT;
        if (r < 32 * B_GU) { const int le = r / B_GU; r %= B_GU; const int nbk = r / 16, kb = r % 16;
            const float* Wg = P.in[I_MOEG] + (size_t)le * 1024 * 512 + 128 * nbk; const float* Wu = P.in[I_MOEU] + (size_t)le * 1024 * 512 + 128 * nbk; const int n0 = nbk * 256;
            auto cp = [&](int n) { const int wdt = n - n0; return wdt < 128 ? Wg + wdt : Wu + (wdt - 128); };
            if (MOE_FP8(le >> 4) && MOEA_FP8) tr_block<true>(cp, 512, ws + WS_WGU + (size_t)le * 2097152, 1024, n0, kb * 64, W8_SCALE, tile, tid);
            else tr_block<false>(cp, 512, ws + WS_WGU + (size_t)le * 2097152, 1024, n0, kb * 64, 1.f, tile, tid);
            continue; }
        r -= 32 * B_GU;
        { const int le = r / B_DN; r %= B_DN; const int nbk = r / 8, kb = r % 8;
            const float* W = P.in[I_MOED] + (size_t)le * 512 * 1024;
            if (MOE_FP8(le >> 4)) tr_block<true>([&](int n) { return W + n; }, 1024, ws + WS_WD + (size_t)le * 1048576, 512, nbk * 256, kb * 64, W8_SCALE, tile, tid);
            else tr_block<false>([&](int n) { return W + n; }, 1024, ws + WS_WD + (size_t)le * 1048576, 512, nbk * 256, kb * 64, 1.f, tile, tid); }
    }
}
__device__ __forceinline__ void phase_convert(const Params& P, LAS unsigned char* lds, int bid, int nb) {
    const int tid = opaque_tid();
    LAS float* tile = (LAS float*)lds;
    unsigned char* ws = P.ws;
    constexpr int B_IN = (NP / 256) * (D / 64);
    tp_begin(lds, 910);
#pragma unroll 1
    for (int it = bid; it < B_IN; it += nb) {
        const int nbk = it / (D / 64), kb = it % (D / 64);
        const float* W = P.in[I_WINAB];
        auto cp = [&](int n) { const int sc = map_ab(n); return sc < 0 ? (const float*)nullptr : W + sc; };
        if ((INPROJ_FP8MASK0 >> nbk) & 1u) tr_block<true>(cp, 6152, ws + WS_WIN8_0, D, nbk * 256, kb * 64, W8_SCALE, tile, tid); else tr_block<false>(cp, 6152, ws + WS_WIN0, D, nbk * 256, kb * 64, 1.f, tile, tid);
    }
    const int nw = blockDim.x >> 6; (void)nw;
    asm volatile("s_waitcnt vmcnt(0)" ::: "memory"); tp_end(lds, 910); tp_begin(lds, 911);
    const float* x = P.in[I_X]; bf16_t* h = (bf16_t*)(P.out + OUT_H);
    const size_t n8 = (size_t)T * D / 8;
    const size_t stride = (size_t)nb * blockDim.x;
    for (size_t i0 = (size_t)bid * blockDim.x + tid; i0 < n8; i0 += 4 * stride) {
        f32x4 a[4], b[4];
#pragma unroll
        for (int u = 0; u < 4; ++u) { const size_t i = i0 + u * stride; if (i < n8) { a[u] = *(const f32x4*)(x + i * 8); b[u] = *(const f32x4*)(x + i * 8 + 4); } }
#pragma unroll
        for (int u = 0; u < 4; ++u) { const size_t i = i0 + u * stride; if (i < n8) {
            u32x4 o; o.x = pk2(a[u][0], a[u][1]); o.y = pk2(a[u][2], a[u][3]); o.z = pk2(b[u][0], b[u][1]); o.w = pk2(b[u][2], b[u][3]);
            *(u32x4*)(h + i * 8) = o;
            typedef unsigned u32x2 __attribute__((ext_vector_type(2)));
            *(u32x2*)(ws + WS_H8 + i * 8) = (u32x2){pk4_fp8(a[u][0] * H8_SCALE, a[u][1] * H8_SCALE, a[u][2] * H8_SCALE, a[u][3] * H8_SCALE), pk4_fp8(b[u][0] * H8_SCALE, b[u][1] * H8_SCALE, b[u][2] * H8_SCALE, b[u][3] * H8_SCALE)}; } }
    }
    asm volatile("s_waitcnt vmcnt(0)" ::: "memory"); tp_end(lds, 911);
}

__device__ __forceinline__ void load_row_bf16(const bf16_t* row, int lane, float (&v)[16]) {
#pragma unroll
    for (int j = 0; j < 2; ++j) { const u32x4 w = *(const u32x4*)(row + 8 * lane + 512 * j);
        v[8 * j + 0] = bflo(w.x); v[8 * j + 1] = bfhi(w.x); v[8 * j + 2] = bflo(w.y); v[8 * j + 3] = bfhi(w.y);
        v[8 * j + 4] = bflo(w.z); v[8 * j + 5] = bfhi(w.z); v[8 * j + 6] = bflo(w.w); v[8 * j + 7] = bfhi(w.w); }
}
__device__ __forceinline__ void ln_row(float (&v)[16], const float* g, const float* b, int lane) {
    float s = 0.f;
#pragma unroll
    for (int i = 0; i < 16; ++i) s += v[i];
    const float mean = wave_sum(s) * (1.f / D); float q = 0.f;
#pragma unroll
    for (int i = 0; i < 16; ++i) { v[i] -= mean; q += v[i] * v[i]; }
    const float rstd = rsqrtf(wave_sum(q) * (1.f / D) + LN_EPS);
#pragma unroll
    for (int j = 0; j < 2; ++j) {
        const f32x4 g0 = *(const f32x4*)(g + 8 * lane + 512 * j), g1 = *(const f32x4*)(g + 8 * lane + 512 * j + 4);
        const f32x4 b0 = *(const f32x4*)(b + 8 * lane + 512 * j), b1 = *(const f32x4*)(b + 8 * lane + 512 * j + 4);
#pragma unroll
        for (int i = 0; i < 4; ++i) { v[8 * j + i] = v[8 * j + i] * rstd * g0[i] + b0[i]; v[8 * j + 4 + i] = v[8 * j + 4 + i] * rstd * g1[i] + b1[i]; }
    }
}
__device__ __forceinline__ void load_gb(const float* g, const float* b, int lane, float (&gr)[16], float (&br)[16]) {
#pragma unroll
    for (int j = 0; j < 2; ++j) {
        const f32x4 g0 = *(const f32x4*)(g + 8 * lane + 512 * j), g1 = *(const f32x4*)(g + 8 * lane + 512 * j + 4);
        const f32x4 b0 = *(const f32x4*)(b + 8 * lane + 512 * j), b1 = *(const f32x4*)(b + 8 * lane + 512 * j + 4);
#pragma unroll
        for (int i = 0; i < 4; ++i) { gr[8 * j + i] = g0[i]; gr[8 * j + 4 + i] = g1[i]; br[8 * j + i] = b0[i]; br[8 * j + 4 + i] = b1[i]; }
    }
}
__device__ __forceinline__ void ln_row_r(float (&v)[16], const float (&gr)[16], const float (&br)[16]) {
    float s = 0.f;
#pragma unroll
    for (int i = 0; i < 16; ++i) s += v[i];
    const float mean = wave_sum(s) * (1.f / D); float q = 0.f;
#pragma unroll
    for (int i = 0; i < 16; ++i) { v[i] -= mean; q += v[i] * v[i]; }
    const float rstd = rsqrtf(wave_sum(q) * (1.f / D) + LN_EPS);
#pragma unroll
    for (int i = 0; i < 16; ++i) v[i] = v[i] * rstd * gr[i] + br[i];
}
__device__ __forceinline__ void store_row_bf16(bf16_t* row, int lane, const float (&v)[16]) {
#pragma unroll
    for (int j = 0; j < 2; ++j) { u32x4 o; o.x = pk2(v[8 * j + 0], v[8 * j + 1]); o.y = pk2(v[8 * j + 2], v[8 * j + 3]); o.z = pk2(v[8 * j + 4], v[8 * j + 5]); o.w = pk2(v[8 * j + 6], v[8 * j + 7]);
        *(u32x4*)(row + 8 * lane + 512 * j) = o; }
}

__device__ __forceinline__ void phase_route(const Params& P, int layer, LAS unsigned char* lds, int bid, int nb, int cntoff) {
    const int tid = opaque_tid(), lane = tid & 63, wave = tid >> 6;
    LAS unsigned char* Bhi = lds; LAS unsigned char* Blo = lds + 32768;
    LAS float* cd = (LAS float*)(lds + 65536);
    LAS float* part = cd + 32;
    LAS int* lcnt = (LAS int*)(part + 1024);
    LAS int* lbase = lcnt + 32; LAS int* rcls = lbase + 32; LAS int* rpos = rcls + 256;
    const bf16_t* pre1 = (const bf16_t*)(P.out + OUT_PRE1);
    const float* g = P.in[I_LNMG] + layer * D; const float* b = P.in[I_LNMB] + layer * D;
    const float* Wr = P.in[I_WR]; const float* br = P.in[I_BR];
    int* tokcls = (int*)(P.ws + WS_TOKCLS); int* tokpos = (int*)(P.ws + WS_TOKPOS); float* tokgate = (float*)(P.ws + WS_TOKGATE);
    unsigned* gcnt = (unsigned*)(P.ws + WS_CTL) + CW_CNT + 64 * layer + cntoff;
#pragma unroll 1
    for (int idx = tid; idx < 2048; idx += NTHREADS_C) {
        const int s = idx >> 6, l = idx & 63, e = l & 15, k0 = 32 * s + 8 * (l >> 4);
        unsigned hi[4], lo[4];
#pragma unroll
        for (int j = 0; j < 4; ++j) {
            const float w0 = g[k0 + 2 * j] * Wr[(k0 + 2 * j) * 16 + e], w1 = g[k0 + 2 * j + 1] * Wr[(k0 + 2 * j + 1) * 16 + e];
            const unsigned h0 = f2bf(w0), h1 = f2bf(w1);
            hi[j] = h0 | (h1 << 16); lo[j] = pk2(w0 - bf2f((unsigned short)h0), w1 - bf2f((unsigned short)h1)); }
        *(LAS u32x4*)(Bhi + idx * 16) = (u32x4){hi[0], hi[1], hi[2], hi[3]};
        *(LAS u32x4*)(Blo + idx * 16) = (u32x4){lo[0], lo[1], lo[2], lo[3]};
    }
    { const int e = tid & 15, pt = tid >> 4; float cs = 0.f, ds = 0.f;
#pragma unroll 4
      for (int kk = 0; kk < 32; ++kk) { const int k = pt * 32 + kk; const float w = Wr[k * 16 + e]; cs += g[k] * w; ds += b[k] * w; }
      part[pt * 32 + e] = cs; part[pt * 32 + 16 + e] = ds; }
    __syncthreads();
    if (tid < 32) { float sacc = 0.f;
#pragma unroll 4
        for (int pt = 0; pt < 32; ++pt) sacc += part[pt * 32 + tid];
        cd[tid] = sacc; }
    __syncthreads();
    const int e = lane & 15, q = lane >> 4;
    const float ce = cd[e], de = cd[16 + e], bre = br[e];
    for (int r0 = bid * 256; r0 < T; r0 += nb * 256) {
        if (tid < 32) lcnt[tid] = 0;
        __syncthreads();
#pragma unroll 1
        for (int tile = 0; tile < 2; ++tile) {
            const int tr0 = wave * 32 + tile * 16;
            const bf16_t* arow = pre1 + (size_t)(r0 + tr0 + e) * D + 8 * q;
            f32x4 acc = (f32x4){0.f, 0.f, 0.f, 0.f}; float s1 = 0.f, s2 = 0.f;
#pragma unroll 1
            for (int s0 = 0; s0 < 32; s0 += 8) {
                u32x4 a[8];
#pragma unroll
                for (int u = 0; u < 8; ++u) a[u] = *(const u32x4*)(arow + 32 * (s0 + u));
#pragma unroll
                for (int u = 0; u < 8; ++u) {
                    const bf16x8 bh = *(const LAS bf16x8*)(Bhi + ((s0 + u) * 64 + lane) * 16), bl = *(const LAS bf16x8*)(Blo + ((s0 + u) * 64 + lane) * 16);
                    const bf16x8 af = __builtin_bit_cast(bf16x8, a[u]);
                    acc = __builtin_amdgcn_mfma_f32_16x16x32_bf16(af, bh, acc, 0, 0, 0);
                    acc = __builtin_amdgcn_mfma_f32_16x16x32_bf16(af, bl, acc, 0, 0, 0);
                    const float x0 = bflo(a[u].x), x1 = bfhi(a[u].x), x2 = bflo(a[u].y), x3 = bfhi(a[u].y), x4 = bflo(a[u].z), x5 = bfhi(a[u].z), x6 = bflo(a[u].w), x7 = bfhi(a[u].w);
                    s1 += ((x0 + x1) + (x2 + x3)) + ((x4 + x5) + (x6 + x7));
                    s2 += ((x0 * x0 + x1 * x1) + (x2 * x2 + x3 * x3)) + ((x4 * x4 + x5 * x5) + (x6 * x6 + x7 * x7));
                }
            }
            s1 += __shfl_xor(s1, 16); s1 += __shfl_xor(s1, 32); s2 += __shfl_xor(s2, 16); s2 += __shfl_xor(s2, 32);
            const float mean = s1 * (1.f / D); const float rstd = rsqrtf(fmaxf(s2 * (1.f / D) - mean * mean, 0.f) + LN_EPS);
#pragma unroll
            for (int r = 0; r < 4; ++r) {
                const int R = 4 * q + r;
                const float mr = __shfl(mean, R), rr = __shfl(rstd, R);
                const float lg = rr * (acc[r] - mr * ce) + de;
                float mx = lg;
#pragma unroll
                for (int o = 1; o < 16; o <<= 1) mx = fmaxf(mx, __shfl_xor(mx, o));
                float p = expf(lg - mx), sum = p;
#pragma unroll
                for (int o = 1; o < 16; o <<= 1) sum += __shfl_xor(sum, o);
                p = p / sum;
                const float sel = p + bre;
                int rank = 0;
#pragma unroll
                for (int o = 1; o < 4; ++o) { const float so = __shfl_xor(sel, o); const int eo = e ^ o; rank += (so > sel || (so == sel && eo < e)) ? 1 : 0; }
                float gs = rank < 2 ? sel : 0.f;
                gs += __shfl_xor(gs, 1); gs += __shfl_xor(gs, 2);
                int gi = e >> 2;
#pragma unroll
                for (int o = 4; o < 16; o <<= 1) { const float go = __shfl_xor(gs, o); const int io = __shfl_xor(gi, o); if (go > gs || (go == gs && io < gi)) { gs = go; gi = io; } }
                const bool chosen = ((e >> 2) == gi) && rank < 2;
                const unsigned long long bm = __ballot(chosen);
                const unsigned m4 = (unsigned)(bm >> (16 * q + 4 * gi)) & 0xFu;
                const int ea = __ffs((int)m4) - 1, eb = 31 - __clz((int)m4);
                const int pidx = ea == 0 ? eb - 1 : (ea == 1 ? eb + 1 : 5);
                const float pa = __shfl(p, 16 * q + 4 * gi + ea), pb = __shfl(p, 16 * q + 4 * gi + eb);
                if (e == r) { const int cls = gi * 6 + pidx; const int rl = tr0 + R; const int lp = atomicAdd((int*)&lcnt[cls], 1); rcls[rl] = cls; rpos[rl] = lp;
                    const float inv = 1.f / (pa + pb); const size_t t = (size_t)(r0 + rl); tokgate[t * 2] = pa * inv; tokgate[t * 2 + 1] = pb * inv; }
            }
        }
        __syncthreads();
        if (tid < NCLS) lbase[tid] = (int)atomicAdd(&gcnt[tid], (unsigned)lcnt[tid]);
        __syncthreads();
        if (tid < 256) { const int t = r0 + tid; const int c = rcls[tid]; tokcls[t] = c; tokpos[t] = lbase[c] + rpos[tid]; }
        __syncthreads();
    }
}
__device__ __forceinline__ void phase_permute(const Params& P, int layer, LAS unsigned char* lds, int bid, int nb) {
    const int tid = opaque_tid(), lane = tid & 63, wave = tid >> 6, nw = blockDim.x >> 6;
    LAS int* off = (LAS int*)lds;
    const unsigned* gcnt = (const unsigned*)(P.ws + WS_CTL) + CW_CNT + 64 * layer;
    int* tilecls = (int*)(P.ws + WS_TILECLS);
    if (tid == 0) { int o = 0; for (int c = 0; c < NCLS; ++c) { off[c] = o * 256; const int nt = ((int)gcnt[c] + 255) >> 8;
            if (bid == 0) for (int i = 0; i < nt; ++i) tilecls[8 + o + i] = c;
            o += nt; }
        if (bid == 0) tilecls[0] = o; }
    __syncthreads();
    const bf16_t* pre1 = (const bf16_t*)(P.out + OUT_PRE1); bf16_t* hs = (bf16_t*)(P.ws + WS_BIG + BIG_HS);
    const float* g = P.in[I_LNMG] + layer * D; const float* b = P.in[I_LNMB] + layer * D;
    const int* tokcls = (const int*)(P.ws + WS_TOKCLS); const int* tokpos = (const int*)(P.ws + WS_TOKPOS); int* tokdst = (int*)(P.ws + WS_TOKDST);
    const float* tokgate = (const float*)(P.ws + WS_TOKGATE); float* rowgate = (float*)(P.ws + WS_ROWGATE);
    float gr[16], br[16]; load_gb(g, b, lane, gr, br);
    for (int t0 = bid * nw + wave; t0 < T; t0 += 2 * nb * nw) {
        const int t1 = t0 + nb * nw; const bool has1 = t1 < T;
        float v0[16], v1[16];
        load_row_bf16(pre1 + (size_t)t0 * D, lane, v0);
        if (has1) load_row_bf16(pre1 + (size_t)t1 * D, lane, v1);
        const int dst0 = off[tokcls[t0]] + tokpos[t0]; const int dst1 = has1 ? off[tokcls[t1]] + tokpos[t1] : 0;
#pragma unroll
        for (int rr = 0; rr < 2; ++rr) {
            if (rr == 1 && !has1) break;
            float (&v)[16] = rr ? v1 : v0; const int t = rr ? t1 : t0, dst = rr ? dst1 : dst0;
            ln_row_r(v, gr, br);
            store_row_bf16(hs + (size_t)dst * D, lane, v);
            if (MOE_FP8(layer) && MOEA_FP8) { typedef unsigned u32x2 __attribute__((ext_vector_type(2)));
#pragma unroll
                for (int j = 0; j < 2; ++j) *(u32x2*)(P.ws + WS_BIG + BIG_HS8 + (size_t)dst * D + 8 * lane + 512 * j) = (u32x2){pk4_fp8(v[8 * j] * H8_SCALE, v[8 * j + 1] * H8_SCALE, v[8 * j + 2] * H8_SCALE, v[8 * j + 3] * H8_SCALE), pk4_fp8(v[8 * j + 4] * H8_SCALE, v[8 * j + 5] * H8_SCALE, v[8 * j + 6] * H8_SCALE, v[8 * j + 7] * H8_SCALE)}; }
            if (lane == 0) { tokdst[t] = dst; rowgate[(size_t)dst * 2] = tokgate[(size_t)t * 2]; rowgate[(size_t)dst * 2 + 1] = tokgate[(size_t)t * 2 + 1]; }
        }
    }
}
__device__ __forceinline__ void phase_lnffn(const Params& P, int layer, int bid, int nb) {
    const int tid = opaque_tid(), lane = tid & 63, wave = tid >> 6, nw = blockDim.x >> 6;
    const bf16_t* pre2 = (const bf16_t*)(P.ws + WS_BIG + BIG_PRE2);
    const float* g = P.in[I_LNFG] + layer * D; const float* b = P.in[I_LNFB] + layer * D;
    const int* tokdst = (const int*)(P.ws + WS_TOKDST);
    float gr[16], br[16]; load_gb(g, b, lane, gr, br);
    for (int t0 = bid * nw + wave; t0 < T; t0 += 2 * nb * nw) {
        const int t1 = t0 + nb * nw; const bool has1 = t1 < T;
        float v0[16], v1[16];
        load_row_bf16(pre2 + (size_t)tokdst[t0] * D, lane, v0);
        if (has1) load_row_bf16(pre2 + (size_t)tokdst[t1] * D, lane, v1);
#pragma unroll
        for (int rr = 0; rr < 2; ++rr) {
            if (rr == 1 && !has1) break;
            float (&v)[16] = rr ? v1 : v0; const int t = rr ? t1 : t0;
            ln_row_r(v, gr, br);
            if (layer == 0) { store_row_bf16((bf16_t*)(P.out + OUT_H) + (size_t)t * D, lane, v);
                typedef unsigned u32x2 __attribute__((ext_vector_type(2)));
#pragma unroll
                for (int j = 0; j < 2; ++j) *(u32x2*)(P.ws + WS_H8 + (size_t)t * D + 8 * lane + 512 * j) = (u32x2){pk4_fp8(v[8 * j] * H8_SCALE, v[8 * j + 1] * H8_SCALE, v[8 * j + 2] * H8_SCALE, v[8 * j + 3] * H8_SCALE), pk4_fp8(v[8 * j + 4] * H8_SCALE, v[8 * j + 5] * H8_SCALE, v[8 * j + 6] * H8_SCALE, v[8 * j + 7] * H8_SCALE)}; }
            else { float* o = (float*)P.out + (size_t)t * D;
#pragma unroll
                for (int j = 0; j < 2; ++j) { *(f32x4*)(o + 8 * lane + 512 * j) = (f32x4){v[8 * j], v[8 * j + 1], v[8 * j + 2], v[8 * j + 3]}; *(f32x4*)(o + 8 * lane + 512 * j + 4) = (f32x4){v[8 * j + 4], v[8 * j + 5], v[8 * j + 6], v[8 * j + 7]}; } }
        }
    }
}

enum { MIX_RET = 0, MIX_ML = 1, MIX_GLA = 2, MIX_SSD = 3 };
typedef short s16x4 __attribute__((ext_vector_type(4)));
__device__ __forceinline__ bf16x8 tr_frag(LAS unsigned char* p0, LAS unsigned char* p1) {
    const s16x4 a = __builtin_amdgcn_ds_read_tr16_b64_v4i16((LAS s16x4*)p0), b = __builtin_amdgcn_ds_read_tr16_b64_v4i16((LAS s16x4*)p1);
    return (bf16x8){a[0], a[1], a[2], a[3], b[0], b[1], b[2], b[3]};
}
__device__ __forceinline__ bf16x8 cat_frag(LAS unsigned char* p0, LAS unsigned char* p1) {
    const s16x4 a = *(LAS s16x4*)p0, b = *(LAS s16x4*)p1;
    return (bf16x8){a[0], a[1], a[2], a[3], b[0], b[1], b[2], b[3]};
}
__device__ __forceinline__ bf16x8 pack_acc(const f32x4& lo, const f32x4& hi) {
    u32x4 w; w.x = pg8::cvt_pk_bf16(lo[0], lo[1]); w.y = pg8::cvt_pk_bf16(lo[2], lo[3]); w.z = pg8::cvt_pk_bf16(hi[0], hi[1]); w.w = pg8::cvt_pk_bf16(hi[2], hi[3]);
    return __builtin_bit_cast(bf16x8, w);
}
__device__ __forceinline__ void unpack8(const u32x4& w, float (&v)[8]) {
    v[0] = bflo(w.x); v[1] = bfhi(w.x); v[2] = bflo(w.y); v[3] = bfhi(w.y); v[4] = bflo(w.z); v[5] = bfhi(w.z); v[6] = bflo(w.w); v[7] = bfhi(w.w);
}
__device__ __forceinline__ u32x4 pack8(const float (&v)[8]) {
    u32x4 w; w.x = pg8::cvt_pk_bf16(v[0], v[1]); w.y = pg8::cvt_pk_bf16(v[2], v[3]); w.z = pg8::cvt_pk_bf16(v[4], v[5]); w.w = pg8::cvt_pk_bf16(v[6], v[7]); return w;
}

template <int CTRL, int RM> __device__ __forceinline__ float dpp_take(float old, float v) { return __builtin_bit_cast(float, __builtin_amdgcn_update_dpp(__builtin_bit_cast(int, old), __builtin_bit_cast(int, v), CTRL, RM, 0xf, false)); }
__device__ __forceinline__ float wave_scan_add(float v) {
    v += dpp_take<0x111, 0xf>(0.f, v); v += dpp_take<0x112, 0xf>(0.f, v); v += dpp_take<0x114, 0xf>(0.f, v); v += dpp_take<0x118, 0xf>(0.f, v);
    v += dpp_take<0x142, 0xa>(0.f, v); v += dpp_take<0x143, 0xc>(0.f, v); return v; }
__device__ __forceinline__ float wave_scan_max(float v) {
    const float ni = -3.0e38f;
    v = fmaxf(v, dpp_take<0x111, 0xf>(ni, v)); v = fmaxf(v, dpp_take<0x112, 0xf>(ni, v)); v = fmaxf(v, dpp_take<0x114, 0xf>(ni, v)); v = fmaxf(v, dpp_take<0x118, 0xf>(ni, v));
    v = fmaxf(v, dpp_take<0x142, 0xa>(ni, v)); v = fmaxf(v, dpp_take<0x143, 0xc>(ni, v)); return v; }
__device__ __forceinline__ float fexp(float x) { return __builtin_amdgcn_exp2f(x * 1.4426950408889634f); }
__device__ __forceinline__ float frcp(float x) { return __builtin_amdgcn_rcpf(x); }
__device__ __forceinline__ float fsigmoid(float x) { return frcp(1.f + fexp(-x)); }
__device__ __forceinline__ float fsilu(float x) { return x * fsigmoid(x); }
__device__ __forceinline__ float fsoftplus(float x) {
    const float u = fexp(-fabsf(x));
    const float l = u < 0.01f ? u * (1.f - u * (0.5f - u * 0.33333333f)) : __builtin_amdgcn_logf(1.f + u) * 0.6931471805599453f;
    return fmaxf(x, 0.f) + l;
}
__device__ __forceinline__ float flogsigmoid(float x) { return -fsoftplus(-x); }

template <int NR>
__device__ __forceinline__ void conv_rows(const bf16_t* src, const int trow0, const LAS float* wl, const int ldw, float (&o)[NR][8]) {
    float x[NR + 3][8];
#pragma unroll
    for (int i = 0; i < NR + 3; ++i) {
        if (trow0 + i - 3 >= 0) { const u32x4 xw = *(const u32x4*)(src + (ptrdiff_t)(i - 3) * NP); unpack8(xw, x[i]); }
        else {
#pragma unroll
            for (int j = 0; j < 8; ++j) x[i][j] = 0.f; }
    }
    float wv[5][8];
#pragma unroll
    for (int k = 0; k < 5; ++k) { const f32x4 w0 = *(const LAS f32x4*)(wl + k * ldw), w1 = *(const LAS f32x4*)(wl + k * ldw + 4);
#pragma unroll
        for (int j = 0; j < 4; ++j) { wv[k][j] = w0[j]; wv[k][4 + j] = w1[j]; } }
#pragma unroll
    for (int r = 0; r < NR; ++r)
#pragma unroll
        for (int j = 0; j < 8; ++j) { float a = wv[4][j];
#pragma unroll
            for (int k = 0; k < 4; ++k) a += wv[k][j] * x[r + k][j];
            o[r][j] = fsilu(a); }
}

template <int MIX>
__device__ __forceinline__ void mixer_unit(const Params& P, const int b, const int h, LAS unsigned char* lds, const bool dostore) {
    const int tid0 = opaque_tid(), w = __builtin_amdgcn_readfirstlane(tid0 >> 6);
    typedef unsigned u32x2 __attribute__((ext_vector_type(2)));
    constexpr int RSQ = 288, RSV = 544, RSP = 144;
    constexpr int SZQ = 64 * RSQ, SZV = 64 * RSV, SZP = 64 * RSP;
    constexpr int OQ = 0, OK1 = SZQ, OV = 2 * SZQ, O3 = 2 * SZQ + SZV;
    constexpr int OK2 = (MIX == MIX_ML || MIX == MIX_GLA) ? O3 : OK1;
    constexpr int OV2 = (MIX == MIX_SSD) ? O3 : OV;
    constexpr int OP = MIX == MIX_RET ? O3 : (MIX == MIX_SSD ? O3 + SZV : O3 + SZQ);
    constexpr int NPV = MIX == MIX_SSD ? 4 : 1;
    constexpr int OT = OP + NPV * SZP;
    constexpr int OY = OV2;
    LAS float* tab = (LAS float*)(lds + OT);
    constexpr int TGN = MIX == MIX_GLA ? 8832 : MIX == MIX_ML ? 648 : MIX == MIX_SSD ? 512 : 0;
    constexpr int TCW = MIX == MIX_ML ? 904 : 768;
    static_assert(OT + (MIX == MIX_GLA ? 11776 : MIX == MIX_SSD ? 3328 : 2184) * 4 <= 163840 - 1024, "lds map");
    bf16_t* proj = (bf16_t*)(P.ws + WS_BIG);
    const size_t row0b = (size_t)b * SEQ;
    constexpr int GIDX = MIX == MIX_RET ? I_RETG : MIX == MIX_ML ? I_MLG : MIX == MIX_GLA ? I_GLAG : I_SSDG;
    if (tid0 < 256) tab[TGN + tid0] = P.in[GIDX][h * 256 + tid0];
    if constexpr (MIX == MIX_ML) {
        for (int i = tid0; i < 1280; i += NTHREADS_C) { const int k = i >> 8, j = i & 255; const int chn = (j >> 7) * 512 + h * 128 + (j & 127);
            tab[TCW + i] = k < 4 ? P.in[I_MLCW][k * 1024 + chn] : P.in[I_MLCB][chn]; }
        if (tid0 < 128) tab[512 + tid0] = 0.f; if (tid0 == 0) tab[641] = 0.f;
    }
    if constexpr (MIX == MIX_GLA) {
        for (int i = tid0; i < 2048; i += NTHREADS_C) tab[9088 + i] = P.in[I_GLAWA][(i >> 7) * 512 + h * 128 + (i & 127)];
        if (tid0 < 128) tab[9088 + 2048 + tid0] = P.in[I_GLABA][h * 128 + tid0];
    }
    if constexpr (MIX == MIX_SSD) {
        for (int i = tid0; i < 2560; i += NTHREADS_C) { const int k = i >> 9, j = i & 511; const int chn = j < 256 ? h * 256 + j : (j < 384 ? 1024 + h * 128 + (j - 256) : 1536 + h * 128 + (j - 384));
            tab[TCW + i] = k < 4 ? P.in[I_SSDCW][k * 2048 + chn] : P.in[I_SSDCB][chn]; }
    }
    __syncthreads();
    f32x4 Sacc[8][2];
#pragma unroll
    for (int rt = 0; rt < 8; ++rt)
#pragma unroll
        for (int ct = 0; ct < 2; ++ct) Sacc[rt][ct] = (f32x4){0.f, 0.f, 0.f, 0.f};
    float gam = 1.f, lg2gam = 0.f, g63 = 1.f;
    float rinv[4] = {0.f, 0.f, 0.f, 0.f};
    if constexpr (MIX == MIX_RET) { gam = 1.f - __builtin_amdgcn_exp2f(-5.f - (float)h); lg2gam = __builtin_amdgcn_logf(gam); g63 = __builtin_amdgcn_exp2f(63.f * lg2gam);
#pragma unroll
        for (int i2 = 0; i2 < 4; ++i2) rinv[i2] = __builtin_amdgcn_exp2f(-(float)(2 * (4 * (tid0 & 15) + i2)) * (13.287712379549449f / 128.f)) * 0.15915494309189535f; }

    tp_begin(lds, 100 * MIX + 9);
    unsigned short gpre0 = 0, gpre1 = 0;
    if constexpr (MIX == MIX_ML) { if (w == 0) { const bf16_t* rp = proj + (row0b + (tid0 & 63)) * NP; gpre0 = rp[C0_MI + h]; gpre1 = rp[C0_MF + h]; } }
    if constexpr (MIX == MIX_SSD) { if (w < 4) gpre0 = proj[(row0b + (tid0 & 63)) * NP + C1_DT + 4 * h + w]; }
#pragma unroll 1
    for (int ch = 0; ch < SEQ / 64; ++ch) {
        int tid = tid0; asm volatile("" : "+v"(tid));
        const int lane = tid & 63, c = lane & 15, g = lane >> 4, q4 = (lane >> 2) & 3, p4 = lane & 3;
        const size_t row0 = row0b + (size_t)ch * 64;
        tp_begin(lds, 100 * MIX + 1);
        if constexpr (MIX == MIX_RET) {
            const int* pos = (const int*)P.in[I_POS];
#pragma unroll
            for (int i = 0; i < 2; ++i) {
                const int pi = tid + 512 * i, r = pi >> 4, c8 = pi & 15;
                const bf16_t* rp = proj + (row0 + r) * NP + h * 128 + 8 * c8;
                const u32x4 qw = *(const u32x4*)(rp + C0_RQ), kw = *(const u32x4*)(rp + C0_RK);
                float qv[8], kv[8]; unpack8(qw, qv); unpack8(kw, kv);
                const float ps = (float)pos[row0 + r];
                const float fq = __builtin_amdgcn_exp2f((float)r * lg2gam), fk = 0.08838834764831845f * __builtin_amdgcn_exp2f(-(float)r * lg2gam);
#pragma unroll
                for (int i2 = 0; i2 < 4; ++i2) {
                    const float tr = __builtin_amdgcn_fractf(ps * rinv[i2]);
                    const float sn = __builtin_amdgcn_sinf(tr), cs = __builtin_amdgcn_cosf(tr);
                    const float q0 = qv[2 * i2], q1 = qv[2 * i2 + 1], k0 = kv[2 * i2], k1 = kv[2 * i2 + 1];
                    qv[2 * i2] = (q0 * cs - q1 * sn) * fq; qv[2 * i2 + 1] = (q0 * sn + q1 * cs) * fq;
                    kv[2 * i2] = (k0 * cs - k1 * sn) * fk; kv[2 * i2 + 1] = (k0 * sn + k1 * cs) * fk;
                }
                *(LAS u32x4*)(lds + OQ + RSQ * r + 16 * c8) = pack8(qv);
                *(LAS u32x4*)(lds + OK1 + RSQ * r + 16 * c8) = pack8(kv);
            }
#pragma unroll
            for (int i = 0; i < 4; ++i) {
                const int pi = tid + 512 * i, r = pi >> 5, c8 = pi & 31;
                *(LAS u32x4*)(lds + OV + RSV * r + 16 * c8) = *(const u32x4*)(proj + (row0 + r) * NP + C0_RV + h * 256 + 8 * c8);
            }
        }
        if constexpr (MIX == MIX_GLA) {
            if (tid < 128) *(LAS u32x4*)(tab + 11264 + 4 * tid) = *(const u32x4*)(proj + (row0 + (tid >> 1)) * NP + C1_GA + 8 * (tid & 1));
            __syncthreads();
            {
                const int d = tid & 127, tq = tid >> 7;
                const float ba = tab[9088 + 2048 + d];
                float wv[16];
#pragma unroll
                for (int r = 0; r < 16; ++r) wv[r] = tab[9088 + r * 128 + d];
                float run = 0.f;
#pragma unroll 4
                for (int i = 0; i < 16; ++i) {
                    const int t = 16 * tq + i;
                    const u32x4 g0 = *(LAS u32x4*)(tab + 11264 + 8 * t), g1 = *(LAS u32x4*)(tab + 11264 + 8 * t + 4); float gv[8], gv2[8]; unpack8(g0, gv); unpack8(g1, gv2);
                    float a = ba;
#pragma unroll
                    for (int r = 0; r < 8; ++r) a += gv[r] * wv[r] + gv2[r] * wv[8 + r];
                    run += flogsigmoid(a) * (1.f / 16.f);
                    tab[t * 128 + d] = run;
                }
                tab[8192 + tq * 128 + d] = run;
            }
            __syncthreads();
            if (tid < 128) tab[8704 + tid] = fexp((tab[8192 + tid] + tab[8192 + 128 + tid]) + (tab[8192 + 256 + tid] + tab[8192 + 384 + tid]));
            __syncthreads();
#pragma unroll
            for (int i = 0; i < 2; ++i) {
                const int pi = tid + 512 * i, r = pi >> 4, c8 = pi & 15, tq = r >> 4;
                const bf16_t* rp = proj + (row0 + r) * NP + h * 128 + 8 * c8;
                const u32x4 qw = *(const u32x4*)(rp + C1_GQ), kw = *(const u32x4*)(rp + C1_GK);
                float qv[8], kv[8], k2[8]; unpack8(qw, qv); unpack8(kw, kv);
#pragma unroll
                for (int hh = 0; hh < 2; ++hh) {
                    const int d0 = 8 * c8 + 4 * hh;
                    f32x4 bc = *(LAS f32x4*)(tab + r * 128 + d0);
                    const f32x4 t0 = *(LAS f32x4*)(tab + 8192 + d0), t1 = *(LAS f32x4*)(tab + 8192 + 128 + d0), t2 = *(LAS f32x4*)(tab + 8192 + 256 + d0), t3 = *(LAS f32x4*)(tab + 8192 + 384 + d0);
                    if (tq > 0) bc = bc + t0; if (tq > 1) bc = bc + t1; if (tq > 2) bc = bc + t2;
                    const f32x4 bt = (t0 + t1) + (t2 + t3);
                    const f32x4 dcv = *(LAS f32x4*)(tab + 8704 + d0);
#pragma unroll
                    for (int j = 0; j < 4; ++j) { const float e1 = fexp(bc[j]), e2 = frcp(e1), kk = kv[4 * hh + j] * e2;
                        qv[4 * hh + j] = qv[4 * hh + j] * 0.08838834764831845f * e1; kv[4 * hh + j] = kk; k2[4 * hh + j] = kk * dcv[j]; }
                }
                *(LAS u32x4*)(lds + OQ + RSQ * r + 16 * c8) = pack8(qv);
                *(LAS u32x4*)(lds + OK1 + RSQ * r + 16 * c8) = pack8(kv);
                *(LAS u32x4*)(lds + OK2 + RSQ * r + 16 * c8) = pack8(k2);
            }
#pragma unroll
            for (int i = 0; i < 4; ++i) {
                const int pi = tid + 512 * i, r = pi >> 5, c8 = pi & 31;
                *(LAS u32x4*)(lds + OV + RSV * r + 16 * c8) = *(const u32x4*)(proj + (row0 + r) * NP + C1_GV + h * 256 + 8 * c8);
            }
        }
        if constexpr (MIX == MIX_ML) {
            if (w == 0) {
                const float ip = bf2f(gpre0) + P.in[I_MLBI][h], lf = flogsigmoid(bf2f(gpre1) + P.in[I_MLBF][h]);
                const float bc = wave_scan_add(lf);
                const float u = ip - bc; const float pm = wave_scan_max(u);
                const float mst = tab[641];
                const float M = fmaxf(mst, pm), M63 = __shfl(M, 63), bt = __shfl(bc, 63);
                tab[lane] = u; tab[64 + lane] = M; tab[128 + lane] = fexp(u - M63); tab[192 + lane] = fexp(mst - M); tab[256 + lane] = fexp(-bc - M);
                if (lane == 0) { tab[640] = fexp(mst - M63); tab[642] = bt + M63; }
            }
            {
                const int c16 = tid & 31, r0 = (tid >> 5) * 4, isk = c16 >> 4, c8 = c16 & 15;
                float o[4][8];
                conv_rows<4>(proj + (row0 + r0) * NP + (isk ? C0_MK : C0_MQ) + h * 128 + 8 * c8, ch * 64 + r0, tab + TCW + 8 * c16, 256, o);
#pragma unroll
                for (int r = 0; r < 4; ++r) {
                    if (isk) {
#pragma unroll
                        for (int j = 0; j < 8; ++j) o[r][j] *= 0.08838834764831845f; }
                    *(LAS u32x4*)(lds + (isk ? OK1 : OQ) + RSQ * (r0 + r) + 16 * c8) = pack8(o[r]); }
            }
#pragma unroll
            for (int i = 0; i < 4; ++i) {
                const int pi = tid + 512 * i, r = pi >> 5, c8 = pi & 31;
                *(LAS u32x4*)(lds + OV + RSV * r + 16 * c8) = *(const u32x4*)(proj + (row0 + r) * NP + C0_MV + h * 256 + 8 * c8);
            }
            __syncthreads();
            tp_end(lds, 100 * MIX + 1); tp_begin(lds, 100 * MIX + 6);
#pragma unroll
            for (int i = 0; i < 2; ++i) {
                const int pi = tid + 512 * i, r = pi >> 4, c8 = pi & 15;
                const u32x4 kw = *(LAS u32x4*)(lds + OK1 + RSQ * r + 16 * c8); float kv[8]; unpack8(kw, kv); const float es = tab[128 + r];
#pragma unroll
                for (int j = 0; j < 8; ++j) kv[j] *= es;
                *(LAS u32x4*)(lds + OK2 + RSQ * r + 16 * c8) = pack8(kv);
            }
            {
                const int t = tid >> 3, part = tid & 7; float a = 0.f;
#pragma unroll
                for (int i = 0; i < 2; ++i) { const u32x4 qw = *(LAS u32x4*)(lds + OQ + RSQ * t + 2 * (16 * part + 8 * i)); float qv[8]; unpack8(qw, qv);
                    const f32x4 n0 = *(LAS f32x4*)(tab + 512 + 16 * part + 8 * i), n1 = *(LAS f32x4*)(tab + 512 + 16 * part + 8 * i + 4);
#pragma unroll
                    for (int j = 0; j < 4; ++j) a += qv[j] * n0[j] + qv[4 + j] * n1[j]; }
                a += __shfl_xor(a, 1); a += __shfl_xor(a, 2); a += __shfl_xor(a, 4);
                if (part == 0) tab[448 + t] = a;
            }
        }
        if constexpr (MIX == MIX_SSD) {
            if (w < 4) {
                const int hd = 4 * h + w;
                const float dt = fsoftplus(bf2f(gpre0) + P.in[I_SSDDTB][hd]);
                const float cm = wave_scan_add(dt * (-fexp(P.in[I_SSDALOG][hd])));
                tab[lane * 4 + w] = cm; tab[256 + lane * 4 + w] = dt;
            }
            {
                const int c32 = tid & 31, r0 = (tid >> 5) * 4, isc = c32 >> 4, c8 = c32 & 15, hr = c32 >> 3;
                float o[4][8], ox[4][8];
                conv_rows<4>(proj + (row0 + r0) * NP + (isc ? C1_CM : C1_BM) + h * 128 + 8 * c8, ch * 64 + r0, tab + TCW + 256 + 8 * c32, 512, o);
                conv_rows<4>(proj + (row0 + r0) * NP + C1_XS + h * 256 + 8 * c32, ch * 64 + r0, tab + TCW + 8 * c32, 512, ox);
#pragma unroll
                for (int r = 0; r < 4; ++r) *(LAS u32x4*)(lds + (isc ? OQ : OK1) + RSQ * (r0 + r) + 16 * c8) = pack8(o[r]);
                __syncthreads();
                tp_end(lds, 100 * MIX + 1); tp_begin(lds, 100 * MIX + 6);
                const float last = tab[63 * 4 + hr];
#pragma unroll
                for (int r = 0; r < 4; ++r) { const float dt = tab[256 + (r0 + r) * 4 + hr], e2 = fexp(last - tab[(r0 + r) * 4 + hr]); float o2[8];
#pragma unroll
                    for (int j = 0; j < 8; ++j) { ox[r][j] *= dt; o2[j] = ox[r][j] * e2; }
                    *(LAS u32x4*)(lds + OV + RSV * (r0 + r) + 16 * c32) = pack8(ox[r]);
                    *(LAS u32x4*)(lds + OV2 + RSV * (r0 + r) + 16 * c32) = pack8(o2); }
            }
        }
        __syncthreads();
        tp_end(lds, (MIX == MIX_ML || MIX == MIX_SSD) ? 100 * MIX + 6 : 100 * MIX + 1); tp_begin(lds, 100 * MIX + 2);
        if (ch + 1 < SEQ / 64) {
            const int sl = tid & 15;
            int col = -1;
            if constexpr (MIX == MIX_RET) col = sl < 2 ? C0_RQ + h * 128 + 64 * sl : sl < 4 ? C0_RK + h * 128 + 64 * (sl - 2) : sl < 8 ? C0_RV + h * 256 + 64 * (sl - 4) : sl < 12 ? C0_RG + h * 256 + 64 * (sl - 8) : -1;
            if constexpr (MIX == MIX_ML) col = sl < 2 ? C0_MQ + h * 128 + 64 * sl : sl < 4 ? C0_MK + h * 128 + 64 * (sl - 2) : sl < 8 ? C0_MV + h * 256 + 64 * (sl - 4) : sl < 12 ? C0_MO + h * 256 + 64 * (sl - 8) : sl == 12 ? C0_MI : -1;
            if constexpr (MIX == MIX_GLA) col = sl < 2 ? C1_GQ + h * 128 + 64 * sl : sl < 4 ? C1_GK + h * 128 + 64 * (sl - 2) : sl < 8 ? C1_GV + h * 256 + 64 * (sl - 4) : sl < 12 ? C1_GR + h * 256 + 64 * (sl - 8) : sl == 12 ? C1_GA : -1;
            if constexpr (MIX == MIX_SSD) col = sl < 4 ? C1_XS + h * 256 + 64 * sl : sl < 6 ? C1_BM + h * 128 + 64 * (sl - 4) : sl < 8 ? C1_CM + h * 128 + 64 * (sl - 6) : sl < 12 ? C1_SZ + h * 256 + 64 * (sl - 8) : sl == 12 ? C1_DT : -1;
            if (col >= 0) { const bf16_t* nbp = proj + (row0 + 64 + (tid >> 4)) * NP + col;
                const unsigned pfl = 157696u + (unsigned)w * 512u;
                asm volatile("s_mov_b32 m0, %2\n\ts_nop 0\n\tglobal_load_lds_dword %0, off\n\ts_mov_b32 m0, %3\n\ts_nop 0\n\tglobal_load_lds_dword %1, off"
                             :: "v"(nbp), "v"(nbp + (size_t)32 * NP), "s"(pfl), "s"(pfl + 256u) : "memory", "m0"); }
        }
        {
            const int tt = w >> 1; float rsum = 0.f;
#pragma unroll
            for (int si = 0; si < 2; ++si) {
                const int ss = 2 * (w & 1) + si;
                f32x4 acc = (f32x4){0.f, 0.f, 0.f, 0.f};
#pragma unroll
                for (int ks = 0; ks < 4; ++ks) {
                    const bf16x8 a = *(LAS bf16x8*)(lds + OK1 + RSQ * (16 * ss + c) + 2 * (32 * ks + 8 * g));
                    const bf16x8 bq = *(LAS bf16x8*)(lds + OQ + RSQ * (16 * tt + c) + 2 * (32 * ks + 8 * g));
                    acc = __builtin_amdgcn_mfma_f32_16x16x32_bf16(a, bq, acc, 0, 0, 0);
                }
                const int t = 16 * tt + c, s0 = 16 * ss + 4 * g;
                if constexpr (MIX == MIX_SSD) {
                    const f32x4 ct_ = *(LAS f32x4*)(tab + t * 4);
#pragma unroll
                    for (int hr = 0; hr < 4; ++hr) { float pv[4];
#pragma unroll
                        for (int r = 0; r < 4; ++r) pv[r] = (s0 + r <= t) ? acc[r] * fexp(ct_[hr] - tab[(s0 + r) * 4 + hr]) : 0.f;
                        *(LAS u32x2*)(lds + OP + hr * SZP + RSP * t + 2 * s0) = (u32x2){pg8::cvt_pk_bf16(pv[0], pv[1]), pg8::cvt_pk_bf16(pv[2], pv[3])}; }
                } else {
                    float pv[4];
                    if constexpr (MIX == MIX_ML) { const f32x4 us = *(LAS f32x4*)(tab + s0); const float Mt = tab[64 + t];
#pragma unroll
                        for (int r = 0; r < 4; ++r) { pv[r] = (s0 + r <= t) ? acc[r] * fexp(us[r] - Mt) : 0.f; rsum += pv[r]; } }
                    else {
#pragma unroll
                        for (int r = 0; r < 4; ++r) pv[r] = (s0 + r <= t) ? acc[r] : 0.f; }
                    *(LAS u32x2*)(lds + OP + RSP * t + 2 * s0) = (u32x2){pg8::cvt_pk_bf16(pv[0], pv[1]), pg8::cvt_pk_bf16(pv[2], pv[3])};
                }
            }
            if constexpr (MIX == MIX_ML) { rsum += __shfl_xor(rsum, 16); rsum += __shfl_xor(rsum, 32); if (g == 0) tab[320 + (w & 1) * 64 + 16 * tt + c] = rsum; }
        }
        __syncthreads();
        tp_end(lds, 100 * MIX + 2); tp_begin(lds, 100 * MIX + 3);
        f32x4 Yacc[2][4];
#pragma unroll
        for (int ct = 0; ct < 2; ++ct)
#pragma unroll
            for (int tt = 0; tt < 4; ++tt) Yacc[ct][tt] = (f32x4){0.f, 0.f, 0.f, 0.f};
#pragma unroll
        for (int kd = 0; kd < 4; ++kd) {
            bf16x8 qf[4];
#pragma unroll
            for (int tt = 0; tt < 4; ++tt) { LAS unsigned char* qp = lds + OQ + RSQ * (16 * tt + c) + 2 * (32 * kd + 4 * g); qf[tt] = cat_frag(qp, qp + 32); }
#pragma unroll
            for (int ct = 0; ct < 2; ++ct) { const bf16x8 sf = pack_acc(Sacc[2 * kd][ct], Sacc[2 * kd + 1][ct]);
#pragma unroll
                for (int tt = 0; tt < 4; ++tt) Yacc[ct][tt] = __builtin_amdgcn_mfma_f32_16x16x32_bf16(sf, qf[tt], Yacc[ct][tt], 0, 0, 0); }
        }
        if constexpr (MIX != MIX_GLA) {
#pragma unroll
            for (int tt = 0; tt < 4; ++tt) {
                float rs = gam;
                if constexpr (MIX == MIX_ML) rs = tab[192 + 16 * tt + c];
                if constexpr (MIX == MIX_SSD) rs = fexp(tab[(16 * tt + c) * 4 + (w >> 1)]);
#pragma unroll
                for (int ct = 0; ct < 2; ++ct) Yacc[ct][tt] = Yacc[ct][tt] * rs;
            }
        }
        bf16x8 Vf[2][2];
#pragma unroll
        for (int ks = 0; ks < 2; ++ks)
#pragma unroll
            for (int ct = 0; ct < 2; ++ct) { LAS unsigned char* vp = lds + OV + RSV * (32 * ks + 8 * g + q4) + 2 * (32 * w + 16 * ct) + 8 * p4; Vf[ks][ct] = tr_frag(vp, vp + 4 * RSV); }
#pragma unroll
        for (int ks = 0; ks < 2; ++ks)
#pragma unroll
            for (int tt = 0; tt < 4; ++tt) { const bf16x8 pf = *(LAS bf16x8*)(lds + OP + (MIX == MIX_SSD ? (w >> 1) * SZP : 0) + RSP * (16 * tt + c) + 2 * (32 * ks + 8 * g));
#pragma unroll
                for (int ct = 0; ct < 2; ++ct) Yacc[ct][tt] = __builtin_amdgcn_mfma_f32_16x16x32_bf16(Vf[ks][ct], pf, Yacc[ct][tt], 0, 0, 0); }
        if constexpr (MIX == MIX_GLA) {
#pragma unroll
            for (int rt = 0; rt < 8; ++rt) { const f32x4 dc = *(LAS f32x4*)(tab + 8704 + 16 * rt + 4 * g);
#pragma unroll
                for (int ct = 0; ct < 2; ++ct) Sacc[rt][ct] = Sacc[rt][ct] * dc; }
        } else {
            float dc = gam;
            if constexpr (MIX == MIX_ML) dc = tab[640];
            if constexpr (MIX == MIX_SSD) dc = fexp(tab[63 * 4 + (w >> 1)]);
#pragma unroll
            for (int rt = 0; rt < 8; ++rt)
#pragma unroll
                for (int ct = 0; ct < 2; ++ct) Sacc[rt][ct] = Sacc[rt][ct] * dc;
        }
        if constexpr (MIX == MIX_SSD) {
#pragma unroll
            for (int ks = 0; ks < 2; ++ks)
#pragma unroll
                for (int ct = 0; ct < 2; ++ct) { LAS unsigned char* vp = lds + OV2 + RSV * (32 * ks + 8 * g + q4) + 2 * (32 * w + 16 * ct) + 8 * p4; Vf[ks][ct] = tr_frag(vp, vp + 4 * RSV); }
        }
#pragma unroll
        for (int rt = 0; rt < 8; ++rt)
#pragma unroll
            for (int ks = 0; ks < 2; ++ks) { LAS unsigned char* kp = lds + OK2 + RSQ * (32 * ks + 8 * g + q4) + 2 * (16 * rt) + 8 * p4; const bf16x8 kf = tr_frag(kp, kp + 4 * RSQ);
#pragma unroll
                for (int ct = 0; ct < 2; ++ct) Sacc[rt][ct] = __builtin_amdgcn_mfma_f32_16x16x32_bf16(kf, Vf[ks][ct], Sacc[rt][ct], 0, 0, 0); }
        if constexpr (MIX == MIX_RET) {
#pragma unroll
            for (int rt = 0; rt < 8; ++rt)
#pragma unroll
                for (int ct = 0; ct < 2; ++ct) Sacc[rt][ct] = Sacc[rt][ct] * g63;
        }
        if constexpr (MIX == MIX_ML) {
            if (tid < 128) { float a = 0.f;
#pragma unroll 8
                for (int s = 0; s < 64; ++s) a += bf2f(*(LAS unsigned short*)(lds + OK2 + RSQ * s + 2 * tid));
                tab[512 + tid] = tab[640] * tab[512 + tid] + a; }
        }
        __syncthreads();
        tp_end(lds, 100 * MIX + 3); tp_begin(lds, 100 * MIX + 4);
#pragma unroll
        for (int ct = 0; ct < 2; ++ct)
#pragma unroll
            for (int tt = 0; tt < 4; ++tt)
                *(LAS u32x2*)(lds + OY + RSV * (16 * tt + c) + 2 * (32 * w + 16 * ct + 4 * g)) = (u32x2){pg8::cvt_pk_bf16(Yacc[ct][tt][0], Yacc[ct][tt][1]), pg8::cvt_pk_bf16(Yacc[ct][tt][2], Yacc[ct][tt][3])};
        __syncthreads();
        tp_end(lds, 100 * MIX + 4); tp_begin(lds, 100 * MIX + 5);
        {
            const int t = tid >> 3, part = tid & 7;
            float y[32];
#pragma unroll
            for (int i = 0; i < 4; ++i) { const u32x4 yw = *(LAS u32x4*)(lds + OY + RSV * t + 2 * (32 * part + 8 * i)); float t8[8]; unpack8(yw, t8);
#pragma unroll
                for (int j = 0; j < 8; ++j) y[8 * i + j] = t8[j]; }
            constexpr int GCOL = MIX == MIX_RET ? C0_RG : MIX == MIX_ML ? C0_MO : MIX == MIX_GLA ? C1_GR : C1_SZ;
            constexpr int OCOL = MIX == MIX_RET ? C0_RV : MIX == MIX_ML ? C0_MV : MIX == MIX_GLA ? C1_GV : C1_SZ;
            bf16_t* rp = proj + (row0 + t) * NP + h * 256 + 32 * part;
            u32x4 gw[4];
#pragma unroll
            for (int i = 0; i < 4; ++i) gw[i] = *(const u32x4*)(rp + GCOL + 8 * i);
            if constexpr (MIX == MIX_ML) {
                const float den = (tab[320 + t] + tab[384 + t]) + tab[192 + t] * tab[448 + t];
                const float idn = frcp(fmaxf(fabsf(den), tab[256 + t]));
#pragma unroll
                for (int i = 0; i < 4; ++i) { float gt[8]; unpack8(gw[i], gt);
#pragma unroll
                    for (int j = 0; j < 8; ++j) y[8 * i + j] = y[8 * i + j] * idn * fsigmoid(gt[j]); }
            }
            if constexpr (MIX == MIX_SSD) {
                const int hd = 4 * h + (part >> 1); const float dsk = P.in[I_SSDD][hd] * frcp(tab[256 + t * 4 + (part >> 1)]);
#pragma unroll
                for (int i = 0; i < 4; ++i) { const u32x4 xw = *(LAS u32x4*)(lds + OV + RSV * t + 2 * (32 * part + 8 * i)); float t8[8], gt[8]; unpack8(xw, t8); unpack8(gw[i], gt);
#pragma unroll
                    for (int j = 0; j < 8; ++j) y[8 * i + j] = (y[8 * i + j] + dsk * t8[j]) * fsilu(gt[j]); }
            }
            float mean = 0.f;
            if constexpr (MIX == MIX_RET || MIX == MIX_ML) {
                float s1 = 0.f;
#pragma unroll
                for (int j = 0; j < 32; ++j) s1 += y[j];
                s1 += __shfl_xor(s1, 1); s1 += __shfl_xor(s1, 2); s1 += __shfl_xor(s1, 4);
                mean = s1 * (1.f / 256.f);
            }
            float s2 = 0.f;
#pragma unroll
            for (int j = 0; j < 32; ++j) { y[j] -= mean; s2 += y[j] * y[j]; }
            s2 += __shfl_xor(s2, 1); s2 += __shfl_xor(s2, 2); s2 += __shfl_xor(s2, 4);
            const float rstd = __builtin_amdgcn_rsqf(s2 * (1.f / 256.f) + NORM_EPS);
#pragma unroll
            for (int i = 0; i < 4; ++i) {
                const f32x4 n0 = *(LAS f32x4*)(tab + TGN + 32 * part + 8 * i), n1 = *(LAS f32x4*)(tab + TGN + 32 * part + 8 * i + 4); float o[8];
#pragma unroll
                for (int j = 0; j < 4; ++j) { o[j] = y[8 * i + j] * rstd * n0[j]; o[4 + j] = y[8 * i + 4 + j] * rstd * n1[j]; }
                if constexpr (MIX == MIX_RET || MIX == MIX_GLA) { float gt[8]; unpack8(gw[i], gt);
#pragma unroll
                    for (int j = 0; j < 8; ++j) o[j] *= fsilu(gt[j]); }
                if (dostore) *(u32x4*)(rp + OCOL + 8 * i) = pack8(o);
            }
            if constexpr (MIX == MIX_ML) { if (tid == 0) tab[641] = tab[642]; }
        }
        if (ch + 1 < SEQ / 64) {
            if constexpr (MIX == MIX_ML) { if (w == 0) { const bf16_t* rp = proj + (row0 + 64 + lane) * NP; gpre0 = rp[C0_MI + h]; gpre1 = rp[C0_MF + h]; } }
            if constexpr (MIX == MIX_SSD) { if (w < 4) gpre0 = proj[(row0 + 64 + lane) * NP + C1_DT + 4 * h + w]; }
        }
        __syncthreads();
        tp_end(lds, 100 * MIX + 5);
    }
    tp_end(lds, 100 * MIX + 9);
}

#define XB_TMO      128
#define XB_XCNT(j)  (256  + 64 * (j))
#define XB_XSUB(j)  (1280 + 64 * (j))
#define XB_XGEN(j)  (2304 + 64 * (j))
#define XB_TOP      3328
#define XB_TOPGEN   3392
#define XCD_BAR_WORDS 3456
#define XB_SPIN_CAP (1u << 18)
__device__ __forceinline__ unsigned xb_ld(unsigned* p)              { return __hip_atomic_load(p, __ATOMIC_RELAXED, __HIP_MEMORY_SCOPE_AGENT); }
__device__ __forceinline__ unsigned xb_add(unsigned* p, unsigned v) { return __hip_atomic_fetch_add(p, v, __ATOMIC_RELAXED, __HIP_MEMORY_SCOPE_AGENT); }
__device__ __forceinline__ unsigned xb_xcc_id() { return (unsigned)__builtin_amdgcn_s_getreg((3 << 11) | 20) & 0xFu; }
#define XB_SPIN(cond, bar) do { unsigned _sp = 0; while (cond) { __builtin_amdgcn_s_sleep(1); \
    if ((++_sp & 255u) == 0u) { if (xb_ld(&(bar)[XB_TMO])) break; if (_sp > XB_SPIN_CAP) { atomicAdd(&(bar)[XB_TMO], 1u); break; } } } } while (0)
struct XcdBarrier { unsigned* bar; unsigned x; volatile LAS unsigned* st; };
__device__ __forceinline__ XcdBarrier xcd_barrier_post(unsigned* bar, volatile LAS unsigned* st) {
    XcdBarrier b; b.bar = bar; b.x = xb_xcc_id(); b.st = st;
    if (opaque_tid() == 0) (void)xb_add(&bar[XB_XCNT(b.x)], 1u);
    return b;
}
__device__ __forceinline__ void xcd_barrier_complete(unsigned* bar, unsigned x, unsigned& nloc, unsigned& nx) {
    const unsigned G = gridDim.x * gridDim.y * gridDim.z;
    unsigned sum, cnt, mine, sp = 0u;
    for (;;) {
        sum = 0u; cnt = 0u; mine = 0u;
#pragma unroll
        for (unsigned j = 0; j < 16; ++j) { const unsigned c = xb_ld(&bar[XB_XCNT(j)]); sum += c; cnt += (c > 0u) ? 1u : 0u; mine = (j == x) ? c : mine; }
        if (sum == G) break;
        __builtin_amdgcn_s_sleep(1);
        if ((++sp & 255u) == 0u) { if (xb_ld(&bar[XB_TMO])) break; if (sp > XB_SPIN_CAP) { atomicAdd(&bar[XB_TMO], 1u); break; } }
    }
    nloc = mine > 0u ? mine : 1u; nx = cnt > 0u ? cnt : 1u;
}
__device__ __forceinline__ void xcd_barrier(const XcdBarrier& b) {
    asm volatile("s_waitcnt vmcnt(0)" ::: "memory");
    __syncthreads();
    if (opaque_tid() == 0) {
        unsigned* bar = b.bar;
        __builtin_amdgcn_s_waitcnt(0);
        unsigned nloc = b.st[0], nx = b.st[1];
        if (nloc == 0u) { xcd_barrier_complete(bar, b.x, nloc, nx); b.st[0] = nloc; b.st[1] = nx; }
        const unsigned old = xb_add(&bar[XB_XSUB(b.x)], 1u);
        const unsigned gen = old / nloc;
        if (old + 1u == (gen + 1u) * nloc) {
            __builtin_amdgcn_fence(__ATOMIC_RELEASE, "agent");
            asm volatile("s_waitcnt vmcnt(0)" ::: "memory");
            const unsigned og = xb_add(&bar[XB_TOP], 1u);
            const unsigned tg = og / nx;
            if (og + 1u == (tg + 1u) * nx) xb_add(&bar[XB_TOPGEN], 1u);
            else XB_SPIN(xb_ld(&bar[XB_TOPGEN]) == tg, bar);
            __builtin_amdgcn_fence(__ATOMIC_ACQUIRE, "agent");
            xb_add(&bar[XB_XGEN(b.x)], 1u);
            asm volatile("s_waitcnt vmcnt(0)" ::: "memory");
        } else {
            XB_SPIN(xb_ld(&bar[XB_XGEN(b.x)]) == gen, bar);
            __builtin_amdgcn_fence(__ATOMIC_ACQUIRE, "agent");
            asm volatile("s_waitcnt vmcnt(0)" ::: "memory");
        }
    }
    __syncthreads();
}

constexpr int NTHREADS = 512;
constexpr int RING_BYTES = 131072;
constexpr int LDS_BYTES = 163840;
constexpr int LDS_BARW = LDS_BYTES - 16;
constexpr int NPHASES = 17;
#ifndef MK_N_LAUNCHES
#define MK_N_LAUNCHES 1
#endif

#ifndef REP_ROUTE
#define REP_ROUTE 1
#endif
#ifndef REP_CONV
#define REP_CONV 1
#endif
#ifndef REP_GIN
#define REP_GIN 1
#endif
#ifndef REP_GOUT
#define REP_GOUT 1
#endif
#ifndef REP_PERM
#define REP_PERM 1
#endif
#ifndef REP_MOEA
#define REP_MOEA 1
#endif
#ifndef REP_MOEB
#define REP_MOEB 1
#endif
#ifndef REP_LNF
#define REP_LNF 1
#endif
#ifndef MIXREP_RET
#define MIXREP_RET 1
#endif
#ifndef MIXREP_ML
#define MIXREP_ML 1
#endif
#ifndef MIXREP_GLA
#define MIXREP_GLA 1
#endif
#ifndef MIXREP_SSD
#define MIXREP_SSD 1
#endif
struct Args { Params P; int ph_lo, ph_hi; };
typedef __attribute__((address_space(4))) const unsigned char* kargp_t;
__device__ __forceinline__ const Params& kparams() {
    kargp_t p = (kargp_t)__builtin_amdgcn_kernarg_segment_ptr();
    asm volatile("" : "+s"(p));
    return *(const Params*)p;
}

__device__ __forceinline__ int kphase_lo() { kargp_t p = (kargp_t)__builtin_amdgcn_kernarg_segment_ptr(); asm volatile("" : "+s"(p)); return ((const Args*)p)->ph_lo; }
__device__ __forceinline__ int kphase_hi() { kargp_t p = (kargp_t)__builtin_amdgcn_kernarg_segment_ptr(); asm volatile("" : "+s"(p)); return ((const Args*)p)->ph_hi; }
__device__ __forceinline__ void grid_barrier(LAS unsigned char* lds) {
    XcdBarrier b; b.bar = (unsigned*)(kparams().ws + WS_CTL) + CW_BAR; b.x = xb_xcc_id(); b.st = (volatile LAS unsigned*)(lds + LDS_BARW);
    tp_begin(lds, 900); xcd_barrier(b); tp_end(lds, 900);
}
template <int LAYER>
__device__ __forceinline__ void layer_phases(LAS unsigned char* lds) {
#define IN(k) (kphase_lo() <= (k) && (k) < kphase_hi())
#define SEAM(k) do { if (IN(k) && IN((k) + 1)) grid_barrier(lds); } while (0)
    constexpr int PB = 1 + 8 * LAYER;
    const int bid = blockIdx.x, nb = gridDim.x;
    if (IN(PB + 0)) {
        const Params& P = kparams();
        pg8::EpiStore E{(bf16_t*)(P.ws + WS_BIG), NP};
        constexpr unsigned M8 = LAYER ? INPROJ_FP8MASK1 : INPROJ_FP8MASK0, M16 = ALLTILES & ~M8;
        for (int rep = 0; rep < REP_GIN; ++rep) {
            if constexpr (M16 != 0u) {
                pg8::SchedCols S; S.A = (const char*)(P.out + OUT_H); S.B = (const char*)(P.ws + (LAYER ? WS_WIN1 : WS_WIN0)); S.lda = D; S.ldb = D; S.nM = T / 256; S.nN = __builtin_popcount(M16); S.G = nb; S.c = bid; S.mask = M16;
                pg8::gemm_phase(lds, S, E, D, D, D);
            }
            if constexpr (M8 != 0u) {
                pg8::SchedCols S; S.A = (const char*)(P.ws + WS_H8); S.B = (const char*)(P.ws + (LAYER ? WS_WIN8_1 : WS_WIN8_0)); S.lda = D / 2; S.ldb = D / 2; S.nM = T / 256; S.nN = __builtin_popcount(M8); S.G = nb; S.c = bid; S.mask = M8;
                pg8::gemm_phase<pg8::EpiStore, pg8::SchedCols, true, 0x7c7c7c7c, 0x77777777>(lds, S, E, D / 2, D / 2, D / 2);
            }
        }
    }
    SEAM(PB + 0);
    if (IN(PB + 1)) {
        const Params& P = kparams();
        for (int u = bid; u < 256; u += nb) {
            const int b = (u & 127) >> 2, h = u & 3;
            if (LAYER == 0) { if (u < 128) { for (int rep = 0; rep < MIXREP_RET; ++rep) { mixer_unit<MIX_RET>(P, b, h, lds, rep == MIXREP_RET - 1); __syncthreads(); }
                                               convert_moe(P, lds, u, 128); }
                              else { for (int rep = 0; rep < MIXREP_ML; ++rep) { mixer_unit<MIX_ML>(P, b, h, lds, rep == MIXREP_ML - 1); __syncthreads(); } } }
            else { if (u < 128) { for (int rep = 0; rep < MIXREP_GLA; ++rep) { mixer_unit<MIX_GLA>(P, b, h, lds, rep == MIXREP_GLA - 1); __syncthreads(); } }
                   else { for (int rep = 0; rep < MIXREP_SSD; ++rep) { mixer_unit<MIX_SSD>(P, b, h, lds, rep == MIXREP_SSD - 1); __syncthreads(); } } }
        }
    }
    SEAM(PB + 1);
    if (IN(PB + 2)) {
        const Params& P = kparams();
        pg8::SchedPlain S; S.A = (const char*)(P.ws + WS_BIG) + YOFF * 2; S.B = (const char*)(P.ws + (LAYER ? WS_WOUT1 : WS_WOUT0)); S.lda = NP; S.ldb = 2048; S.nM = T / 256; S.nN = 4; S.G = nb; S.c = bid;
        pg8::EpiResid E{(bf16_t*)(P.out + OUT_PRE1), (const bf16_t*)(P.out + OUT_H)};
        for (int rep = 0; rep < REP_GOUT; ++rep) pg8::gemm_phase(lds, S, E, 2048, NP, 2048);
    }
    SEAM(PB + 2);
    if (IN(PB + 3)) for (int rep = 0; rep < REP_ROUTE; ++rep) { phase_route(kparams(), LAYER, lds, bid, nb, 32 * (REP_ROUTE - 1 - rep)); __syncthreads(); }
    SEAM(PB + 3);
    if (IN(PB + 4)) for (int rep = 0; rep < REP_PERM; ++rep) phase_permute(kparams(), LAYER, lds, bid, nb);
    SEAM(PB + 4);
    if (IN(PB + 5)) {
        const Params& P = kparams();
        const int* tilecls = (const int*)(P.ws + WS_TILECLS);
        if constexpr (MOE_FP8(LAYER) && MOEA_FP8) {
            pg8::SchedMoeA<true> S; S.A = (const char*)(P.ws + WS_BIG + BIG_HS8); S.Wgu = (const char*)(P.ws + WS_WGU) + (size_t)LAYER * 16 * 2097152; S.tilecls = tilecls; S.nM = __builtin_amdgcn_readfirstlane(tilecls[0]); S.G = nb; S.c = bid;
            pg8::EpiSwiglu8 E{P.ws + WS_BIG + BIG_H, (const float*)(P.ws + WS_ROWGATE)};
            for (int rep = 0; rep < REP_MOEA; ++rep) pg8::gemm_phase<pg8::EpiSwiglu8, pg8::SchedMoeA<true>, true, 0x7c7c7c7c, 0x77777777>(lds, S, E, D / 2, D / 2, D / 2);
        } else if constexpr (MOE_FP8(LAYER)) {
            pg8::SchedMoeA<false> S; S.A = (const char*)(P.ws + WS_BIG + BIG_HS); S.Wgu = (const char*)(P.ws + WS_WGU) + (size_t)LAYER * 16 * 2097152; S.tilecls = tilecls; S.nM = __builtin_amdgcn_readfirstlane(tilecls[0]); S.G = nb; S.c = bid;
            pg8::EpiSwiglu8 E{P.ws + WS_BIG + BIG_H, (const float*)(P.ws + WS_ROWGATE)};
            for (int rep = 0; rep < REP_MOEA; ++rep) pg8::gemm_phase(lds, S, E, D, D, D);
        } else {
            pg8::SchedMoeA<false> S; S.A = (const char*)(P.ws + WS_BIG + BIG_HS); S.Wgu = (const char*)(P.ws + WS_WGU) + (size_t)LAYER * 16 * 2097152; S.tilecls = tilecls; S.nM = __builtin_amdgcn_readfirstlane(tilecls[0]); S.G = nb; S.c = bid;
            pg8::EpiSwiglu E{(bf16_t*)(P.ws + WS_BIG + BIG_H), (const float*)(P.ws + WS_ROWGATE)};
            for (int rep = 0; rep < REP_MOEA; ++rep) pg8::gemm_phase(lds, S, E, D, D, D);
        }
    }
    SEAM(PB + 5);
    if (IN(PB + 6)) {
        const Params& P = kparams();
        const int* tilecls = (const int*)(P.ws + WS_TILECLS);
        pg8::EpiResid E{(bf16_t*)(P.ws + WS_BIG + BIG_PRE2), (const bf16_t*)(P.ws + WS_BIG + BIG_HS)};
        if constexpr (MOE_FP8(LAYER)) {
            pg8::SchedMoeB<true> S; S.A = (const char*)(P.ws + WS_BIG + BIG_H); S.Wd = (const char*)(P.ws + WS_WD) + (size_t)LAYER * 16 * 1048576; S.tilecls = tilecls; S.nM = __builtin_amdgcn_readfirstlane(tilecls[0]); S.G = nb; S.c = bid;
            for (int rep = 0; rep < REP_MOEB; ++rep) pg8::gemm_phase<pg8::EpiResid, pg8::SchedMoeB<true>, true, 0x7c7c7c7c, 0x77777777>(lds, S, E, D / 2, D / 2, 256);
        } else {
            pg8::SchedMoeB<false> S; S.A = (const char*)(P.ws + WS_BIG + BIG_H); S.Wd = (const char*)(P.ws + WS_WD) + (size_t)LAYER * 16 * 1048576; S.tilecls = tilecls; S.nM = __builtin_amdgcn_readfirstlane(tilecls[0]); S.G = nb; S.c = bid;
            for (int rep = 0; rep < REP_MOEB; ++rep) pg8::gemm_phase(lds, S, E, D, D, 512);
        }
    }
    SEAM(PB + 6);
    if (IN(PB + 7)) for (int rep = 0; rep < REP_LNF; ++rep) phase_lnffn(kparams(), LAYER, bid, nb);
    if (LAYER == 0) SEAM(PB + 7);
#undef IN
#undef SEAM
}

__global__ void __launch_bounds__(NTHREADS, 2) mega_fwd(Args a) {
    LAS unsigned char* lds = (LAS unsigned char*)g_lds;
    if (threadIdx.x < 4) ((LAS unsigned*)(lds + LDS_BARW))[threadIdx.x] = 0u;
    if (TPROBE_ID != 0 && threadIdx.x < 4) ((LAS unsigned*)(lds + LDS_TPROBE))[threadIdx.x] = 0u;
    if ((threadIdx.x & 63) == 0) *(LAS int*)(lds + LDS_WIDTAB + 4 * hw_wave_key()) = (int)(threadIdx.x >> 6);
    __syncthreads();
    if (a.ph_hi - a.ph_lo > 1) (void)xcd_barrier_post((unsigned*)(kparams().ws + WS_CTL) + CW_BAR, (volatile LAS unsigned*)(lds + LDS_BARW));
    if (kphase_lo() <= 0 && 0 < kphase_hi()) { for (int rep = 0; rep < REP_CONV; ++rep) phase_convert(kparams(), lds, blockIdx.x, gridDim.x); if (1 < kphase_hi()) grid_barrier(lds); }
    layer_phases<0>(lds);
    layer_phases<1>(lds);
    if (TPROBE_ID != 0 && blockIdx.x == TPROBE_BLOCK && opaque_tid() == 0) {
        const unsigned long long need = ((LAS unsigned long long*)(lds + LDS_TPROBE))[0] * TPROBE_MULT, t0 = wall_clock64();
        while (wall_clock64() - t0 < need) __builtin_amdgcn_s_sleep(8);
    }
}

extern "C" void kernel_launch(void* const* d_in, const int* in_sizes, int n_in, void* d_out, int out_size, void* d_ws, size_t ws_size, hipStream_t stream) {
    static int grid = 0;
    if (!grid) {
        if (n_in != 30 || ws_size < WS_END || out_size != T * D) { fprintf(stderr, "kernel_launch: unexpected shapes n_in %d ws %zu out %d\n", n_in, ws_size, out_size); grid = -1; return; }
        int dev = 0, cus = 0, per_cu = 0;
        if (hipGetDevice(&dev) != hipSuccess || hipDeviceGetAttribute(&cus, hipDeviceAttributeMultiprocessorCount, dev) != hipSuccess) { grid = -1; return; }
        if (hipFuncSetAttribute((const void*)mega_fwd, hipFuncAttributeMaxDynamicSharedMemorySize, LDS_BYTES) != hipSuccess) { fprintf(stderr, "kernel_launch: hipFuncSetAttribute failed\n"); grid = -1; return; }
        if (hipOccupancyMaxActiveBlocksPerMultiprocessor(&per_cu, (const void*)mega_fwd, NTHREADS, LDS_BYTES) != hipSuccess || per_cu < 1)
            fprintf(stderr, "kernel_launch: note: occupancy query reports %d workgroups per CU\n", per_cu);
        grid = cus > 0 ? cus : 256;
    }
    if (grid < 0) return;
    Args a{};
    for (int i = 0; i < 30; ++i) a.P.in[i] = (const float*)d_in[i];
    a.P.out = (unsigned char*)d_out; a.P.ws = (unsigned char*)d_ws;
    (void)hipMemsetAsync((char*)d_ws + WS_CTL, 0, CTL_BYTES, stream);
    constexpr int NL = MK_N_LAUNCHES;
    if (NL == 1) { a.ph_lo = 0; a.ph_hi = NPHASES; hipLaunchKernelGGL(mega_fwd, dim3(grid), dim3(NTHREADS), LDS_BYTES, stream, a); }
    else for (int p = 0; p < NPHASES; ++p) { a.ph_lo = p; a.ph_hi = p + 1; hipLaunchKernelGGL(mega_fwd, dim3(grid), dim3(NTHREADS), LDS_BYTES, stream, a); }
}
```

```cpp
#include <hip/hip_runtime.h>
#include <cstdio>
#include <cstdint>

#ifndef MIX_LREP
#define MIX_LREP 1
#endif
#ifndef MIX_SREP
#define MIX_SREP 1
#endif
#ifndef MIX_EREP
#define MIX_EREP 1
#endif
#define GAS __attribute__((address_space(1)))
#define LAS __attribute__((address_space(3)))
typedef unsigned short bf16_t;
typedef short bf16x8 __attribute__((ext_vector_type(8)));
typedef float f32x4 __attribute__((ext_vector_type(4)));
typedef unsigned u32x4 __attribute__((ext_vector_type(4)));

constexpr int BATCH = 32, SEQ = 2048, T = BATCH * SEQ, D = 1024;
constexpr int NP = 6400;
constexpr int YOFF = 1024;
constexpr int NCLS = 24, MAXTILES = 280;
constexpr float LN_EPS = 1e-5f, NORM_EPS = 1e-6f;
constexpr float ALPHA = 1.41421356237f;
constexpr int NTHREADS_C = 512;

constexpr int C0_RQ = 0, C0_RK = 512, C0_RV = 1024, C0_MV = 2048, C0_RG = 3072, C0_MQ = 4096, C0_MK = 4608, C0_MO = 5120, C0_MI = 6144, C0_MF = 6148;
constexpr int C1_GQ = 0, C1_GK = 512, C1_GV = 1024, C1_SZ = 2048, C1_GR = 3072, C1_XS = 4096, C1_BM = 5120, C1_CM = 5632, C1_GA = 6144, C1_DT = 6160;

constexpr size_t MiB = 1u << 20;
constexpr size_t WS_CTL = 0, CTL_BYTES = 1 * MiB;
constexpr size_t WS_WIN0 = 2 * MiB;
constexpr size_t WS_WIN1 = 15 * MiB;
constexpr size_t WS_WOUT0 = 28 * MiB;
constexpr size_t WS_WOUT1 = 32 * MiB;
constexpr size_t WS_WGU = 36 * MiB;
constexpr size_t WS_WD = 100 * MiB;
constexpr size_t WS_TOKCLS = 132 * MiB;
constexpr size_t WS_TOKPOS = WS_TOKCLS + (size_t)T * 4;
constexpr size_t WS_TOKDST = WS_TOKPOS + (size_t)T * 4;
constexpr size_t WS_TOKGATE = WS_TOKDST + (size_t)T * 4;
constexpr size_t WS_ROWGATE = WS_TOKGATE + (size_t)T * 8;
constexpr size_t WS_TILECLS = WS_ROWGATE + (size_t)MAXTILES * 256 * 8;
constexpr size_t WS_BIG = 136 * MiB;
constexpr size_t BIG_HS = 0, BIG_H = 160 * MiB, BIG_PRE2 = 320 * MiB, BIG_HS8 = 480 * MiB;
constexpr size_t WS_H8 = WS_BIG + (size_t)T * NP * 2;
constexpr size_t WS_WIN8_0 = WS_H8 + (size_t)T * D;
constexpr size_t WS_WIN8_1 = WS_WIN8_0 + (size_t)NP * D;
constexpr size_t WS_END = WS_WIN8_1 + (size_t)NP * D;
static_assert(WS_TILECLS + (MAXTILES + 8) * 4 <= WS_BIG, "ws map");
static_assert(WS_END <= 1024 * MiB, "ws map");
constexpr size_t OUT_H = 0, OUT_PRE1 = 128 * MiB;
constexpr int CW_CNT = 1024;
constexpr int CW_BAR = 4096;

__device__ __forceinline__ unsigned f2bf(float f) { unsigned u = __builtin_bit_cast(unsigned, f); return (u + 0x7fffu + ((u >> 16) & 1u)) >> 16; }
__device__ __forceinline__ unsigned pk2(float lo, float hi) { return f2bf(lo) | (f2bf(hi) << 16); }
__device__ __forceinline__ float bf2f(unsigned short b) { return __builtin_bit_cast(float, ((unsigned)b) << 16); }
__device__ __forceinline__ float bflo(unsigned w) { return __builtin_bit_cast(float, w << 16); }
__device__ __forceinline__ float bfhi(unsigned w) { return __builtin_bit_cast(float, w & 0xffff0000u); }
__device__ __forceinline__ float sigmoidf_(float x) { return 1.f / (1.f + __expf(-x)); }
__device__ __forceinline__ float siluf_(float x) { return x / (1.f + __expf(-x)); }
__device__ __forceinline__ float softplusf_(float x) { return x > 20.f ? x : log1pf(expf(x)); }
__device__ __forceinline__ float logsigmoidf_(float x) { return -softplusf_(-x); }
__device__ __forceinline__ float wave_sum(float v) {
#define WS_DPP(ctrl, rm) v += __builtin_bit_cast(float, __builtin_amdgcn_update_dpp(0, __builtin_bit_cast(int, v), ctrl, rm, 0xf, false))
    WS_DPP(0x111, 0xf); WS_DPP(0x112, 0xf); WS_DPP(0x114, 0xf); WS_DPP(0x118, 0xf); WS_DPP(0x142, 0xa); WS_DPP(0x143, 0xc);
#undef WS_DPP
    return __builtin_bit_cast(float, __builtin_amdgcn_readlane(__builtin_bit_cast(int, v), 63));
}
#define LDS_WAIT() asm volatile("s_waitcnt lgkmcnt(0)" ::: "memory")
__device__ __forceinline__ unsigned pk4_fp8(float a, float b, float c, float d) { int w = __builtin_amdgcn_cvt_pk_fp8_f32(a, b, 0, false); w = __builtin_amdgcn_cvt_pk_fp8_f32(c, d, w, true); return (unsigned)w; }
#ifndef MOE_FP8
#define MOE_FP8(layer) ((layer) >= 0)
#endif
#ifndef MOEA_FP8
#define MOEA_FP8 1
#endif
#ifndef INPROJ_FP8MASK0
#define INPROJ_FP8MASK0 0x00fcfffcu
#endif
#ifndef INPROJ_FP8MASK1
#define INPROJ_FP8MASK1 0x01ffffffu
#endif
constexpr unsigned ALLTILES = 0x01ffffffu;
#ifndef INPROJ_FP8
#define INPROJ_FP8(layer) ((layer) == 1)
#endif
constexpr float H8_SCALE = 8.f, W8_SCALE = 256.f;
#ifndef TPROBE_ID
#define TPROBE_ID 0
#endif
#ifndef TPROBE_BLOCK
#define TPROBE_BLOCK 128
#endif
#ifndef TPROBE_MULT
#define TPROBE_MULT 4
#endif
constexpr int LDS_TPROBE = 163840 - 48;
__device__ __forceinline__ int opaque_tid();
__device__ __forceinline__ void tp_begin(LAS unsigned char* lds, int id) { if (TPROBE_ID != 0 && TPROBE_ID == id && opaque_tid() == 0) ((LAS unsigned long long*)(lds + LDS_TPROBE))[1] = wall_clock64(); }
__device__ __forceinline__ void tp_end(LAS unsigned char* lds, int id) { if (TPROBE_ID != 0 && TPROBE_ID == id && opaque_tid() == 0) { LAS unsigned long long* p = (LAS unsigned long long*)(lds + LDS_TPROBE); p[0] += wall_clock64() - p[1]; } }
extern __shared__ __attribute__((aligned(16))) unsigned char g_lds[];
constexpr int LDS_WIDTAB = 163840 - 512;
__device__ __forceinline__ int hw_wave_key() { return (int)__builtin_amdgcn_s_getreg((5 << 11) | 4) & 63; }
__device__ __forceinline__ int opaque_tid() {
    const int wid = __builtin_amdgcn_readfirstlane(*(volatile LAS int*)((LAS unsigned char*)g_lds + LDS_WIDTAB + 4 * hw_wave_key()));
    int t = wid * 64 + (int)__builtin_amdgcn_mbcnt_hi(~0u, __builtin_amdgcn_mbcnt_lo(~0u, 0u)); asm volatile("" : "+v"(t)); return t; }

namespace pg8 {
constexpr int BM = 256, BK = 64, HALF = 128, HTB = HALF * BK * 2, STAGE_BYTES = 8 * HTB, NXCD = 8, WGM = 8;
__host__ __device__ __forceinline__ int lds_byte(int r, int c) { const int st = (r >> 4) * 2 + (c >> 5), rr = r & 15, cc = c & 31, ob = rr * 64 + cc * 2; return st * 1024 + (ob ^ (((ob >> 9) & 1) << 5)); }
__host__ __device__ __forceinline__ void stage_rc(int b, int& R, int& C) { const int st = b / 1024, sb = b % 1024, swz = sb ^ (((sb >> 9) & 1) << 5); R = (st >> 1) * 16 + swz / 64; C = (st & 1) * 32 + (swz % 64) / 2; }
__host__ __device__ __forceinline__ int perm32(int rho) { const int n = rho >> 4, i = rho & 15; return 8 * (i >> 2) + 4 * n + (i & 3); }

struct Unit { int pm, pn; unsigned a, b0, b1; };

__device__ __forceinline__ bool static_tile(int i, int G, int c, int nM, int nN, int& pm, int& pn) {
    const int nwg = nM * nN; const int L = i * G + c; if (L >= nwg) return false;
    int wgid = L; { const int q = nwg / NXCD, r = nwg % NXCD, xcd = wgid % NXCD, off = wgid / NXCD; wgid = (xcd < r ? xcd * (q + 1) : r * (q + 1) + (xcd - r) * q) + off; }
    const int nig = WGM * nN, gid = wgid / nig, fm = gid * WGM, gsz = (nM - fm) < WGM ? (nM - fm) : WGM;
    pm = fm + ((wgid % nig) % gsz); pn = (wgid % nig) / gsz; return true;
}
template <class Tp> __device__ __forceinline__ Tp* uniform_ptr(Tp* p) {
    const unsigned long long v = (unsigned long long)p;
    const unsigned lo = __builtin_amdgcn_readfirstlane((unsigned)v), hi = __builtin_amdgcn_readfirstlane((unsigned)(v >> 32));
    return (Tp*)(((unsigned long long)hi << 32) | lo); }
__device__ __forceinline__ unsigned cvt_pk_bf16(float lo, float hi) { unsigned r; asm volatile("v_cvt_pk_bf16_f32 %0, %1, %2" : "=v"(r) : "v"(lo), "v"(hi)); return r; }

typedef int i32x8 __attribute__((ext_vector_type(8)));
typedef int i32x4v __attribute__((ext_vector_type(4)));
__device__ __forceinline__ i32x8 cat16(const bf16x8& lo, const bf16x8& hi) { const i32x4v a = __builtin_bit_cast(i32x4v, lo), b = __builtin_bit_cast(i32x4v, hi); return (i32x8){a[0], a[1], a[2], a[3], b[0], b[1], b[2], b[3]}; }
template <class Epi, class Sched, bool FP8 = false, int SCA = 0x7f7f7f7f, int SCB = 0x7f7f7f7f>
__device__ __forceinline__ void gemm_phase(LAS unsigned char* lds, const Sched& S, const Epi& E, const int K, const int lda, const int ldb) {
    const int tid = opaque_tid(), wid = __builtin_amdgcn_readfirstlane(tid >> 6), lane = tid & 63, wr = wid >> 2, wc = wid & 3, fr = lane & 15, fq = lane >> 4;
    int nt = K / BK; asm volatile("" : "+s"(nt));
    constexpr int KS = Sched::KSPLIT;
    unsigned voffA0, voffB0;
    { int R, C; stage_rc(tid * 16, R, C); const int Rb = (R & ~31) + perm32(R & 31); voffA0 = (unsigned)(R * lda + C) * 2u; voffB0 = (unsigned)(Rb * ldb + C) * 2u; }
    const unsigned q64A = 64u * lda * 2u, q64B = 64u * ldb * 2u;
    const unsigned kstep = (unsigned)(BK * 2);
    const unsigned hstepA = (unsigned)HALF * lda * 2, hstepB = (unsigned)HALF * ldb * 2;
    const __amdgpu_buffer_rsrc_t rsA = __builtin_amdgcn_make_buffer_rsrc((void*)S.A, 0, 0xffffffff, 0x00020000), rsB = __builtin_amdgcn_make_buffer_rsrc((void*)S.bbase(), 0, 0xffffffff, 0x00020000);
    const unsigned ldsw = (unsigned)wid * 1024u;
    const int aoff = lds_byte(wr * 64 + fr, fq * 8), boff = lds_byte(wc * 32 + fr, fq * 8);
#define PG8_BP(u, kt) ((KS > 0 && (kt) >= KS) ? (u).b1 + (unsigned)((kt) - KS) * kstep : (u).b0 + (unsigned)(kt) * kstep)
#define PG8_SA(b, h) (((b) * 2 + (h)) * HTB)
#define PG8_SB(b, h) ((4 + (b) * 2 + (h)) * HTB)
#define PG8_STAGEA(bufoff, soff) do { _Pragma("unroll") for (int _i = 0; _i < 2; ++_i) \
        __builtin_amdgcn_raw_ptr_buffer_load_lds(rsA, (LAS void*)(lds + (bufoff) + ldsw + _i * 8192), 16, voffA0, (int)((soff) + _i * q64A), 0, 0); } while (0)
#define PG8_STAGEB(bufoff, soff) do { _Pragma("unroll") for (int _i = 0; _i < 2; ++_i) \
        __builtin_amdgcn_raw_ptr_buffer_load_lds(rsB, (LAS void*)(lds + (bufoff) + ldsw + _i * 8192), 16, voffB0, (int)((soff) + _i * q64B), 0, 0); } while (0)
#define PG8_LDA(dst, b, h) do { _Pragma("unroll") for (int m = 0; m < 4; ++m) _Pragma("unroll") for (int k = 0; k < 2; ++k) dst[m][k] = *(const LAS bf16x8*)(lds + PG8_SA(b, h) + aoff + m * 2048 + k * 1024); } while (0)
#define PG8_LDB(dst, b, h) do { _Pragma("unroll") for (int n = 0; n < 2; ++n) _Pragma("unroll") for (int k = 0; k < 2; ++k) dst[n][k] = *(const LAS bf16x8*)(lds + PG8_SB(b, h) + boff + n * 2048 + k * 1024); } while (0)
#define PG8_MMA(ai, bj, At, Bt) do { __builtin_amdgcn_s_setprio(1); _Pragma("unroll") for (int m = 0; m < 4; ++m) _Pragma("unroll") for (int n = 0; n < 2; ++n) { \
        if constexpr (FP8) acc[ai][bj][m][n] = __builtin_amdgcn_mfma_scale_f32_16x16x128_f8f6f4(cat16(Bt[n][0], Bt[n][1]), cat16(At[m][0], At[m][1]), acc[ai][bj][m][n], 0, 0, 1, ((SCB & 0xff) << 8) | (SCA & 0xff), 0, ((SCB & 0xff) << 8) | (SCA & 0xff)); \
        else { _Pragma("unroll") for (int k = 0; k < 2; ++k) acc[ai][bj][m][n] = __builtin_amdgcn_mfma_f32_16x16x32_bf16(Bt[n][k], At[m][k], acc[ai][bj][m][n], 0, 0, 0); } } \
        __builtin_amdgcn_s_setprio(0); } while (0)
#define PG8_WAIT_V(n) asm volatile("s_waitcnt vmcnt(" #n ")" ::: "memory")
#define PG8_WAIT_L(n) asm volatile("s_waitcnt lgkmcnt(" #n ")" ::: "memory")
#define PG8_BAR __builtin_amdgcn_s_barrier()
#define PG8_SCHED __builtin_amdgcn_sched_barrier(0)
    Unit cur, nxt; int ui = 0;
    if (!S.next(0, cur)) return;
    f32x4 acc[2][2][4][2];
#pragma unroll
    for (int a = 0; a < 2; ++a)
#pragma unroll
        for (int b = 0; b < 2; ++b)
#pragma unroll
            for (int m = 0; m < 4; ++m)
#pragma unroll
                for (int n = 0; n < 2; ++n) acc[a][b][m][n] = (f32x4){0.f, 0.f, 0.f, 0.f};
    bf16x8 At[4][2], B0[2][2], B1[2][2];
    unsigned cA = cur.a;
    E.prefetch(cur, tid);
    { const unsigned cB0 = PG8_BP(cur, 0), cB1 = PG8_BP(cur, 1);
    PG8_STAGEB(PG8_SB(0, 0), cB0); PG8_STAGEA(PG8_SA(0, 0), cA); PG8_STAGEB(PG8_SB(0, 1), cB0 + hstepB); PG8_STAGEA(PG8_SA(0, 1), cA + hstepA);
    if (wr == 1) PG8_BAR;
    PG8_WAIT_V(4); PG8_BAR;
    PG8_STAGEB(PG8_SB(1, 0), cB1); PG8_STAGEA(PG8_SA(1, 0), cA + kstep); PG8_STAGEB(PG8_SB(1, 1), cB1 + hstepB);
    PG8_WAIT_V(6); PG8_BAR; }
    for (;;) {
        const bool has_next = S.next(ui + 1, nxt);
        if (!has_next) nxt = cur;
        for (int t = 0; t < nt; t += 2) {
            const bool last = (t == nt - 2);
            const unsigned a1 = cA + (unsigned)(t + 1) * kstep;
            const unsigned a2 = last ? nxt.a : cA + (unsigned)(t + 2) * kstep;
            const unsigned b2 = last ? PG8_BP(nxt, 0) : PG8_BP(cur, t + 2);
            const unsigned a3 = a2 + kstep;
            const unsigned b3 = last ? PG8_BP(nxt, 1) : PG8_BP(cur, t + 3);
            PG8_LDB(B0, 0, 0); PG8_SCHED; PG8_LDA(At, 0, 0); PG8_STAGEA(PG8_SA(1, 1), a1 + hstepA);
            PG8_WAIT_L(8); PG8_BAR; PG8_WAIT_L(0); PG8_MMA(0, 0, At, B0); PG8_BAR; PG8_SCHED;
            PG8_LDB(B1, 0, 1); PG8_STAGEB(PG8_SB(0, 0), b2);
            PG8_BAR; PG8_WAIT_L(0); PG8_MMA(0, 1, At, B1); PG8_BAR;
            PG8_LDA(At, 0, 1); PG8_STAGEA(PG8_SA(0, 0), a2);
            PG8_BAR; PG8_WAIT_L(0); PG8_MMA(1, 0, At, B0); PG8_BAR; PG8_SCHED;
            PG8_STAGEB(PG8_SB(0, 1), b2 + hstepB);
            PG8_WAIT_V(6); PG8_BAR; PG8_MMA(1, 1, At, B1); PG8_BAR;
            PG8_LDB(B0, 1, 0); PG8_SCHED; PG8_LDA(At, 1, 0); PG8_STAGEA(PG8_SA(0, 1), a2 + hstepA);
            PG8_WAIT_L(8); PG8_BAR; PG8_WAIT_L(0); PG8_MMA(0, 0, At, B0); PG8_BAR; PG8_SCHED;
            PG8_LDB(B1, 1, 1); PG8_STAGEB(PG8_SB(1, 0), b3);
            PG8_BAR; PG8_WAIT_L(0); PG8_MMA(0, 1, At, B1); PG8_BAR;
            PG8_LDA(At, 1, 1); PG8_STAGEA(PG8_SA(1, 0), a3);
            PG8_BAR; PG8_WAIT_L(0); PG8_MMA(1, 0, At, B0); PG8_BAR; PG8_SCHED;
            PG8_STAGEB(PG8_SB(1, 1), b3 + hstepB);
            PG8_WAIT_V(6); PG8_BAR; PG8_MMA(1, 1, At, B1); PG8_BAR;
        }
        E(acc, cur, wr, wc, fr, fq);
        if (!has_next) break;
#pragma unroll
        for (int a = 0; a < 2; ++a)
#pragma unroll
            for (int b = 0; b < 2; ++b)
#pragma unroll
                for (int m = 0; m < 4; ++m)
#pragma unroll
                    for (int n = 0; n < 2; ++n) acc[a][b][m][n] = (f32x4){0.f, 0.f, 0.f, 0.f};
        cur = nxt; cA = cur.a; ++ui;
        E.prefetch(cur, tid);
    }
    PG8_WAIT_V(0);
    if (wr == 0) PG8_BAR;
    PG8_BAR;
#undef PG8_BP
#undef PG8_SA
#undef PG8_SB
#undef PG8_STAGEA
#undef PG8_STAGEB
#undef PG8_LDA
#undef PG8_LDB
#undef PG8_MMA
#undef PG8_WAIT_V
#undef PG8_WAIT_L
#undef PG8_BAR
#undef PG8_SCHED
}

struct SchedPlain {
    static constexpr int KSPLIT = 0;
    const char* A; const char* B; int lda, ldb, nM, nN, G, c;
    __device__ __forceinline__ const char* bbase() const { return B; }
    __device__ __forceinline__ bool next(int i, Unit& u) const {
        if (!static_tile(i, G, c, nM, nN, u.pm, u.pn)) return false;
        u.a = (unsigned)u.pm * BM * lda * 2; u.b0 = (unsigned)u.pn * BM * ldb * 2; u.b1 = u.b0; return true;
    }
};
struct SchedCols {
    static constexpr int KSPLIT = 0;
    const char* A; const char* B; int lda, ldb, nM, nN, G, c; unsigned mask;
    __device__ __forceinline__ const char* bbase() const { return B; }
    __device__ __forceinline__ bool next(int i, Unit& u) const {
        int pnj; if (!static_tile(i, G, c, nM, nN, u.pm, pnj)) return false;
        unsigned m = mask; for (int j = 0; j < pnj; ++j) m &= m - 1u;
        u.pn = __builtin_ctz(m);
        u.a = (unsigned)u.pm * BM * lda * 2; u.b0 = (unsigned)u.pn * BM * ldb * 2; u.b1 = u.b0; return true;
    }
};
__device__ __forceinline__ void cls_experts(int cls, int& e0, int& e1) {
    const int g = cls / 6, p = cls % 6;
    const int a = p < 3 ? 0 : (p < 5 ? 1 : 2);
    const int b = p < 3 ? p + 1 : (p < 5 ? p - 1 : 3);
    e0 = 4 * g + a; e1 = 4 * g + b;
}
template <bool FP8>
struct SchedMoeA {
    static constexpr int KSPLIT = 0;
    static constexpr int RB = FP8 ? 1024 : 2048;
    const char* A; const char* Wgu; const int* tilecls; int nM, G, c;
    __device__ __forceinline__ const char* bbase() const { return Wgu; }
    __device__ __forceinline__ bool next(int i, Unit& u) const {
        if (!static_tile(i, G, c, nM, 8, u.pm, u.pn)) return false;
        int e0, e1; cls_experts(__builtin_amdgcn_readfirstlane(tilecls[8 + u.pm]), e0, e1); const int e = (u.pn >> 2) ? e1 : e0;
        u.a = (unsigned)u.pm * BM * RB; u.b0 = (unsigned)e * 2097152u + (unsigned)(u.pn & 3) * 256 * RB; u.b1 = u.b0; return true;
    }
};
template <bool FP8>
struct SchedMoeB {
    static constexpr int KSPLIT = FP8 ? 4 : 8;
    static constexpr int RA = FP8 ? 1024 : 2048, RBB = FP8 ? 512 : 1024;
    const char* A; const char* Wd; const int* tilecls; int nM, G, c;
    __device__ __forceinline__ const char* bbase() const { return Wd; }
    __device__ __forceinline__ bool next(int i, Unit& u) const {
        if (!static_tile(i, G, c, nM, 4, u.pm, u.pn)) return false;
        int e0, e1; cls_experts(__builtin_amdgcn_readfirstlane(tilecls[8 + u.pm]), e0, e1);
        u.a = (unsigned)u.pm * BM * RA;
        u.b0 = (unsigned)e0 * 1048576u + (unsigned)u.pn * 256 * RBB; u.b1 = (unsigned)e1 * 1048576u + (unsigned)u.pn * 256 * RBB; return true;
    }
};

struct EpiStore {
    bf16_t* O; int ldc;
    __device__ __forceinline__ void prefetch(const Unit&, int) const {}
    __device__ __forceinline__ void operator()(const f32x4 (&acc)[2][2][4][2], const Unit& u, int wr, int wc, int fr, int fq) const {
        const int row0 = u.pm * BM + wr * 64 + fr, col0 = u.pn * BM + wc * 32 + 8 * fq;
#pragma unroll
        for (int ai = 0; ai < 2; ++ai)
#pragma unroll
            for (int m = 0; m < 4; ++m) { bf16_t* rowp = O + (size_t)(row0 + ai * HALF + m * 16) * ldc + col0;
#pragma unroll
                for (int bj = 0; bj < 2; ++bj) { const f32x4 v0 = acc[ai][bj][m][0], v1 = acc[ai][bj][m][1];
                    u32x4 w; w.x = cvt_pk_bf16(v0[0], v0[1]); w.y = cvt_pk_bf16(v0[2], v0[3]); w.z = cvt_pk_bf16(v1[0], v1[1]); w.w = cvt_pk_bf16(v1[2], v1[3]);
                    *(u32x4*)(rowp + bj * HALF) = w; } }
    }
};
struct EpiResid {
    bf16_t* O; const bf16_t* R;
    __device__ __forceinline__ void prefetch(const Unit& u, int tid) const {
        const bf16_t* p = R + (size_t)(u.pm * BM + (tid >> 1)) * 1024 + u.pn * BM + 128 * (tid & 1);
        asm volatile("s_mov_b32 m0, %2\n\ts_nop 0\n\tglobal_load_lds_dword %0, off\n\ts_mov_b32 m0, %3\n\ts_nop 0\n\tglobal_load_lds_dword %1, off"
                     :: "v"(p), "v"(p + 64), "s"(160768u), "s"(161024u) : "memory", "m0");
    }
    __device__ __forceinline__ void operator()(const f32x4 (&acc)[2][2][4][2], const Unit& u, int wr, int wc, int fr, int fq) const {
        const int row0 = u.pm * BM + wr * 64 + fr, col0 = u.pn * BM + wc * 32 + 8 * fq;
#pragma unroll
        for (int ai = 0; ai < 2; ++ai)
#pragma unroll
            for (int m = 0; m < 4; ++m) { const size_t off = (size_t)(row0 + ai * HALF + m * 16) * 1024 + col0;
#pragma unroll
                for (int bj = 0; bj < 2; ++bj) { const f32x4 v0 = acc[ai][bj][m][0], v1 = acc[ai][bj][m][1];
                    const u32x4 r = *(const u32x4*)(R + off + bj * HALF);
                    u32x4 w; w.x = cvt_pk_bf16(v0[0] + ALPHA * bflo(r.x), v0[1] + ALPHA * bfhi(r.x)); w.y = cvt_pk_bf16(v0[2] + ALPHA * bflo(r.y), v0[3] + ALPHA * bfhi(r.y));
                    w.z = cvt_pk_bf16(v1[0] + ALPHA * bflo(r.z), v1[1] + ALPHA * bfhi(r.z)); w.w = cvt_pk_bf16(v1[2] + ALPHA * bflo(r.w), v1[3] + ALPHA * bfhi(r.w));
                    *(u32x4*)(O + off + bj * HALF) = w; } }
    }
};
struct EpiSwiglu {
    bf16_t* H; const float* rowgate;
    __device__ __forceinline__ void prefetch(const Unit&, int) const {}
    __device__ __forceinline__ void operator()(const f32x4 (&acc)[2][2][4][2], const Unit& u, int wr, int wc, int fr, int fq) const {
        const int row0 = u.pm * BM + wr * 64 + fr, ke = u.pn >> 2, col0 = 512 * ke + 128 * (u.pn & 3) + wc * 32 + 8 * fq;
#pragma unroll
        for (int ai = 0; ai < 2; ++ai)
#pragma unroll
            for (int m = 0; m < 4; ++m) { const int row = row0 + ai * HALF + m * 16; const float gt = rowgate[(size_t)row * 2 + ke];
                const f32x4 g0 = acc[ai][0][m][0], g1 = acc[ai][0][m][1], u0 = acc[ai][1][m][0], u1 = acc[ai][1][m][1];
                float o[8];
#pragma unroll
                for (int j = 0; j < 4; ++j) { o[j] = siluf_(g0[j]) * u0[j] * gt; o[4 + j] = siluf_(g1[j]) * u1[j] * gt; }
                u32x4 w; w.x = cvt_pk_bf16(o[0], o[1]); w.y = cvt_pk_bf16(o[2], o[3]); w.z = cvt_pk_bf16(o[4], o[5]); w.w = cvt_pk_bf16(o[6], o[7]);
                *(u32x4*)(H + (size_t)row * 1024 + col0) = w; }
    }
};
struct EpiSwiglu8 {
    unsigned char* H; const float* rowgate;
    __device__ __forceinline__ void prefetch(const Unit&, int) const {}
    __device__ __forceinline__ void operator()(const f32x4 (&acc)[2][2][4][2], const Unit& u, int wr, int wc, int fr, int fq) const {
        typedef unsigned u32x2 __attribute__((ext_vector_type(2)));
        const int row0 = u.pm * BM + wr * 64 + fr, ke = u.pn >> 2, col0 = 512 * ke + 128 * (u.pn & 3) + wc * 32 + 8 * fq;
        unsigned char* const H = uniform_ptr(this->H); const float* const rowgate = uniform_ptr(this->rowgate);
#pragma unroll
        for (int ai = 0; ai < 2; ++ai)
#pragma unroll
            for (int m = 0; m < 4; ++m) { const int row = row0 + ai * HALF + m * 16; const float gt = rowgate[(size_t)row * 2 + ke] * 8.f;
                const f32x4 g0 = acc[ai][0][m][0], g1 = acc[ai][0][m][1], u0 = acc[ai][1][m][0], u1 = acc[ai][1][m][1];
                float o[8];
#pragma unroll
                for (int j = 0; j < 4; ++j) { o[j] = __builtin_amdgcn_fmed3f(g0[j] * __builtin_amdgcn_rcpf(1.f + __builtin_amdgcn_exp2f(-1.4426950408889634f * g0[j])) * u0[j] * gt, -440.f, 440.f);
                    o[4 + j] = __builtin_amdgcn_fmed3f(g1[j] * __builtin_amdgcn_rcpf(1.f + __builtin_amdgcn_exp2f(-1.4426950408889634f * g1[j])) * u1[j] * gt, -440.f, 440.f); }
                *(u32x2*)(H + (size_t)row * 1024 + col0) = (u32x2){pk4_fp8(o[0], o[1], o[2], o[3]), pk4_fp8(o[4], o[5], o[6], o[7])}; }
    }
};
}

struct Params {
    const float* in[30];
    unsigned char* out;
    unsigned char* ws;
};
enum { I_X = 0, I_POS, I_WINAB, I_RETG, I_MLCW, I_MLCB, I_MLBI, I_MLBF, I_MLG, I_WOUTAB, I_WINCD, I_GLAWA, I_GLABA, I_GLAG, I_SSDCW, I_SSDCB, I_SSDDTB, I_SSDALOG, I_SSDD, I_SSDG,
       I_WOUTCD, I_WR, I_BR, I_MOEG, I_MOEU, I_MOED, I_LNMG, I_LNMB, I_LNFG, I_LNFB };

template <class ColPtr>
__device__ __forceinline__ void tr_item(const ColPtr& cp, int ldw, bf16_t* WT, int ldt, int n0, int k0, LAS float* scr, int lane) {
    const float* p = cp(n0 + (lane & 31));
#pragma unroll 8
    for (int i = 0; i < 32; ++i) { const int kk = 2 * i + (lane >> 5); scr[kk * 33 + (lane & 31)] = p ? p[(size_t)(k0 + kk) * ldw] : 0.f; }
    LDS_WAIT();
    const int c = lane & 7;
#pragma unroll
    for (int j = 0; j < 4; ++j) { const int n = (lane >> 3) + 8 * j; const LAS float* s = scr + (8 * c) * 33 + n;
        u32x4 o; o.x = pk2(s[0 * 33], s[1 * 33]); o.y = pk2(s[2 * 33], s[3 * 33]); o.z = pk2(s[4 * 33], s[5 * 33]); o.w = pk2(s[6 * 33], s[7 * 33]);
        *(u32x4*)(WT + (size_t)(n0 + n) * ldt + k0 + 8 * c) = o; }
    LDS_WAIT();
}
template <class ColPtr>
__device__ __forceinline__ void tr_item_fp8(const ColPtr& cp, int ldw, unsigned char* WT, int ldt, int n0, int k0, float scale, LAS float* scr, int lane) {
    const float* p = cp(n0 + (lane & 31));
#pragma unroll 8
    for (int i = 0; i < 32; ++i) { const int kk = 2 * i + (lane >> 5); scr[kk * 33 + (lane & 31)] = p ? p[(size_t)(k0 + kk) * ldw] * scale : 0.f; }
    LDS_WAIT();
    const int c = lane & 7;
    typedef unsigned u32x2 __attribute__((ext_vector_type(2)));
#pragma unroll
    for (int j = 0; j < 4; ++j) { const int n = (lane >> 3) + 8 * j; const LAS float* s = scr + (8 * c) * 33 + n;
        *(u32x2*)(WT + (size_t)(n0 + n) * ldt + k0 + 8 * c) = (u32x2){pk4_fp8(s[0 * 33], s[1 * 33], s[2 * 33], s[3 * 33]), pk4_fp8(s[4 * 33], s[5 * 33], s[6 * 33], s[7 * 33])}; }
    LDS_WAIT();
}
__device__ __forceinline__ int map_ab(int n) {
    if (n < 2048) return n;
    if (n < 3072) return 4096 + (n - 2048);
    if (n < 4096) return 2048 + (n - 3072);
    if (n < 4608) return 3072 + (n - 4096);
    if (n < 5120) return 3584 + (n - 4608);
    if (n < 6152) return n;
    return -1;
}
__device__ __forceinline__ int map_cd(int n) {
    if (n < 2048) return n;
    if (n < 3072) return 3088 + (n - 2048);
    if (n < 4096) return 2048 + (n - 3072);
    if (n < 5120) return 4112 + (n - 4096);
    if (n < 5632) return 5136 + (n - 5120);
    if (n < 6144) return 5648 + (n - 5632);
    if (n < 6160) return 3072 + (n - 6144);
    if (n < 6176) return 6160 + (n - 6160);
    return -1;
}
template <bool FP8, class ColPtr>
__device__ __forceinline__ void tr_block(const ColPtr& cp, int ldw, void* WT, int ldt, int n0, int k0, float scale, LAS float* tile, int tid) {
    {   const int c4 = tid & 63, r0 = tid >> 6;
        const float* p = cp(n0 + 4 * c4);
        f32x4 v[8];
#pragma unroll
        for (int i = 0; i < 8; ++i) v[i] = p ? *(const f32x4*)(p + (size_t)(k0 + r0 + 8 * i) * ldw) : (f32x4){0.f, 0.f, 0.f, 0.f};
#pragma unroll
        for (int i = 0; i < 8; ++i) { LAS float* t = tile + (r0 + 8 * i) * 257 + 4 * c4; t[0] = v[i][0] * scale; t[1] = v[i][1] * scale; t[2] = v[i][2] * scale; t[3] = v[i][3] * scale; }
    }
    __syncthreads();
    {   const int kc = tid & 7, nr = tid >> 3;
#pragma unroll
        for (int j = 0; j < 4; ++j) { const int n = nr + 64 * j; const LAS float* t = tile + (8 * kc) * 257 + n;
            if constexpr (FP8) { typedef unsigned u32x2 __attribute__((ext_vector_type(2)));
                *(u32x2*)((unsigned char*)WT + (size_t)(n0 + n) * ldt + k0 + 8 * kc) = (u32x2){pk4_fp8(t[0], t[257], t[514], t[771]), pk4_fp8(t[1028], t[1285], t[1542], t[1799])}; }
            else { u32x4 o; o.x = pk2(t[0], t[257]); o.y = pk2(t[514], t[771]); o.z = pk2(t[1028], t[1285]); o.w = pk2(t[1542], t[1799]);
                *(u32x4*)((bf16_t*)WT + (size_t)(n0 + n) * ldt + k0 + 8 * kc) = o; } }
    }
    __syncthreads();
}
__device__ __forceinline__ void convert_moe(const Params& P, LAS unsigned char* lds, int bid, int nb) {
    const int tid = opaque_tid();
    LAS float* tile = (LAS float*)lds;
    unsigned char* ws = P.ws;
    constexpr int B_GU = (1024 / 256) * (1024 / 64);
    constexpr int B_DN = (1024 / 256) * (512 / 64);
    constexpr int B_IN = (NP / 256) * (D / 64);
    constexpr int B_OUT = (1024 / 256) * (2048 / 64);
#pragma unroll 1
    for (int it = bid; it < 32 * B_GU + 32 * B_DN + B_IN + 2 * B_OUT; it += nb) {
        int r = it;
        if (r < B_IN) { const int nbk = r / (D / 64), kb = r % (D / 64);
            const float* W = P.in[I_WINCD];
            auto cp = [&](int n) { const int sc = map_cd(n); return sc < 0 ? (const float*)nullptr : W + sc; };
            if ((INPROJ_FP8MASK1 >> nbk) & 1u) tr_block<true>(cp, 6176, ws + WS_WIN8_1, D, nbk * 256, kb * 64, W8_SCALE, tile, tid); else tr_block<false>(cp, 6176, ws + WS_WIN1, D, nbk * 256, kb * 64, 1.f, tile, tid);
            continue; }
        r -= B_IN;
        if (r < 2 * B_OUT) { const int l = r / B_OUT; r %= B_OUT; const int nbk = r / 32, kb = r % 32;
            const float* W = P.in[l ? I_WOUTCD : I_WOUTAB];
            tr_block<false>([&](int n) { return W + n; }, 1024, ws + (l ? WS_WOUT1 : WS_WOUT0), 2048, nbk * 256, kb * 64, 1.f, tile, tid);
            continue; }
        r -= 2 * B_OUT;
        if (r < 32 * B_GU) { const int le = r / B_GU; r %= B_GU; const int nbk = r / 16, kb = r % 16;
            const float* Wg = P.in[I_MOEG] + (size_t)le * 1024 * 512 + 128 * nbk; const float* Wu = P.in[I_MOEU] + (size_t)le * 1024 * 512 + 128 * nbk; const int n0 = nbk * 256;
            auto cp = [&](int n) { const int wdt = n - n0; return wdt < 128 ? Wg + wdt : Wu + (wdt - 128); };
            if (MOE_FP8(le >> 4) && MOEA_FP8) tr_block<true>(cp, 512, ws + WS_WGU + (size_t)le * 2097152, 1024, n0, kb * 64, W8_SCALE, tile, tid);
            else tr_block<false>(cp, 512, ws + WS_WGU + (size_t)le * 2097152, 1024, n0, kb * 64, 1.f, tile, tid);
            continue; }
        r -= 32 * B_GU;
        { const int le = r / B_DN; r %= B_DN; const int nbk = r / 8, kb = r % 8;
            const float* W = P.in[I_MOED] + (size_t)le * 512 * 1024;
            if (MOE_FP8(le >> 4)) tr_block<true>([&](int n) { return W + n; }, 1024, ws + WS_WD + (size_t)le * 1048576, 512, nbk * 256, kb * 64, W8_SCALE, tile, tid);
            else tr_block<false>([&](int n) { return W + n; }, 1024, ws + WS_WD + (size_t)le * 1048576, 512, nbk * 256, kb * 64, 1.f, tile, tid); }
    }
}
__device__ __forceinline__ void phase_convert(const Params& P, LAS unsigned char* lds, int bid, int nb) {
    const int tid = opaque_tid();
    LAS float* tile = (LAS float*)lds;
    unsigned char* ws = P.ws;
    constexpr int B_IN = (NP / 256) * (D / 64);
    tp_begin(lds, 910);
#pragma unroll 1
    for (int it = bid; it < B_IN; it += nb) {
        const int nbk = it / (D / 64), kb = it % (D / 64);
        const float* W = P.in[I_WINAB];
        auto cp = [&](int n) { const int sc = map_ab(n); return sc < 0 ? (const float*)nullptr : W + sc; };
        if ((INPROJ_FP8MASK0 >> nbk) & 1u) tr_block<true>(cp, 6152, ws + WS_WIN8_0, D, nbk * 256, kb * 64, W8_SCALE, tile, tid); else tr_block<false>(cp, 6152, ws + WS_WIN0, D, nbk * 256, kb * 64, 1.f, tile, tid);
    }
    const int nw = blockDim.x >> 6; (void)nw;
    asm volatile("s_waitcnt vmcnt(0)" ::: "memory"); tp_end(lds, 910); tp_begin(lds, 911);
    const float* x = P.in[I_X]; bf16_t* h = (bf16_t*)(P.out + OUT_H);
    const size_t n8 = (size_t)T * D / 8;
    const size_t stride = (size_t)nb * blockDim.x;
    for (size_t i0 = (size_t)bid * blockDim.x + tid; i0 < n8; i0 += 4 * stride) {
        f32x4 a[4], b[4];
#pragma unroll
        for (int u = 0; u < 4; ++u) { const size_t i = i0 + u * stride; if (i < n8) { a[u] = *(const f32x4*)(x + i * 8); b[u] = *(const f32x4*)(x + i * 8 + 4); } }
#pragma unroll
        for (int u = 0; u < 4; ++u) { const size_t i = i0 + u * stride; if (i < n8) {
            u32x4 o; o.x = pk2(a[u][0], a[u][1]); o.y = pk2(a[u][2], a[u][3]); o.z = pk2(b[u][0], b[u][1]); o.w = pk2(b[u][2], b[u][3]);
            *(u32x4*)(h + i * 8) = o;
            typedef unsigned u32x2 __attribute__((ext_vector_type(2)));
            *(u32x2*)(ws + WS_H8 + i * 8) = (u32x2){pk4_fp8(a[u][0] * H8_SCALE, a[u][1] * H8_SCALE, a[u][2] * H8_SCALE, a[u][3] * H8_SCALE), pk4_fp8(b[u][0] * H8_SCALE, b[u][1] * H8_SCALE, b[u][2] * H8_SCALE, b[u][3] * H8_SCALE)}; } }
    }
    asm volatile("s_waitcnt vmcnt(0)" ::: "memory"); tp_end(lds, 911);
}

__device__ __forceinline__ void load_row_bf16(const bf16_t* row, int lane, float (&v)[16]) {
#pragma unroll
    for (int j = 0; j < 2; ++j) { const u32x4 w = *(const u32x4*)(row + 8 * lane + 512 * j);
        v[8 * j + 0] = bflo(w.x); v[8 * j + 1] = bfhi(w.x); v[8 * j + 2] = bflo(w.y); v[8 * j + 3] = bfhi(w.y);
        v[8 * j + 4] = bflo(w.z); v[8 * j + 5] = bfhi(w.z); v[8 * j + 6] = bflo(w.w); v[8 * j + 7] = bfhi(w.w); }
}
__device__ __forceinline__ void ln_row(float (&v)[16], const float* g, const float* b, int lane) {
    float s = 0.f;
#pragma unroll
    for (int i = 0; i < 16; ++i) s += v[i];
    const float mean = wave_sum(s) * (1.f / D); float q = 0.f;
#pragma unroll
    for (int i = 0; i < 16; ++i) { v[i] -= mean; q += v[i] * v[i]; }
    const float rstd = rsqrtf(wave_sum(q) * (1.f / D) + LN_EPS);
#pragma unroll
    for (int j = 0; j < 2; ++j) {
        const f32x4 g0 = *(const f32x4*)(g + 8 * lane + 512 * j), g1 = *(const f32x4*)(g + 8 * lane + 512 * j + 4);
        const f32x4 b0 = *(const f32x4*)(b + 8 * lane + 512 * j), b1 = *(const f32x4*)(b + 8 * lane + 512 * j + 4);
#pragma unroll
        for (int i = 0; i < 4; ++i) { v[8 * j + i] = v[8 * j + i] * rstd * g0[i] + b0[i]; v[8 * j + 4 + i] = v[8 * j + 4 + i] * rstd * g1[i] + b1[i]; }
    }
}
__device__ __forceinline__ void load_gb(const float* g, const float* b, int lane, float (&gr)[16], float (&br)[16]) {
#pragma unroll
    for (int j = 0; j < 2; ++j) {
        const f32x4 g0 = *(const f32x4*)(g + 8 * lane + 512 * j), g1 = *(const f32x4*)(g + 8 * lane + 512 * j + 4);
        const f32x4 b0 = *(const f32x4*)(b + 8 * lane + 512 * j), b1 = *(const f32x4*)(b + 8 * lane + 512 * j + 4);
#pragma unroll
        for (int i = 0; i < 4; ++i) { gr[8 * j + i] = g0[i]; gr[8 * j + 4 + i] = g1[i]; br[8 * j + i] = b0[i]; br[8 * j + 4 + i] = b1[i]; }
    }
}
__device__ __forceinline__ void ln_row_r(float (&v)[16], const float (&gr)[16], const float (&br)[16]) {
    float s = 0.f;
#pragma unroll
    for (int i = 0; i < 16; ++i) s += v[i];
    const float mean = wave_sum(s) * (1.f / D); float q = 0.f;
#pragma unroll
    for (int i = 0; i < 16; ++i) { v[i] -= mean; q += v[i] * v[i]; }
    const float rstd = rsqrtf(wave_sum(q) * (1.f / D) + LN_EPS);
#pragma unroll
    for (int i = 0; i < 16; ++i) v[i] = v[i] * rstd * gr[i] + br[i];
}
__device__ __forceinline__ void store_row_bf16(bf16_t* row, int lane, const float (&v)[16]) {
#pragma unroll
    for (int j = 0; j < 2; ++j) { u32x4 o; o.x = pk2(v[8 * j + 0], v[8 * j + 1]); o.y = pk2(v[8 * j + 2], v[8 * j + 3]); o.z = pk2(v[8 * j + 4], v[8 * j + 5]); o.w = pk2(v[8 * j + 6], v[8 * j + 7]);
        *(u32x4*)(row + 8 * lane + 512 * j) = o; }
}

__device__ __forceinline__ void phase_route(const Params& P, int layer, LAS unsigned char* lds, int bid, int nb, int cntoff) {
    const int tid = opaque_tid(), lane = tid & 63, wave = tid >> 6;
    LAS unsigned char* Bhi = lds; LAS unsigned char* Blo = lds + 32768;
    LAS float* cd = (LAS float*)(lds + 65536);
    LAS float* part = cd + 32;
    LAS int* lcnt = (LAS int*)(part + 1024);
    LAS int* lbase = lcnt + 32; LAS int* rcls = lbase + 32; LAS int* rpos = rcls + 256;
    const bf16_t* pre1 = (const bf16_t*)(P.out + OUT_PRE1);
    const float* g = P.in[I_LNMG] + layer * D; const float* b = P.in[I_LNMB] + layer * D;
    const float* Wr = P.in[I_WR]; const float* br = P.in[I_BR];
    int* tokcls = (int*)(P.ws + WS_TOKCLS); int* tokpos = (int*)(P.ws + WS_TOKPOS); float* tokgate = (float*)(P.ws + WS_TOKGATE);
    unsigned* gcnt = (unsigned*)(P.ws + WS_CTL) + CW_CNT + 64 * layer + cntoff;
#pragma unroll 1
    for (int idx = tid; idx < 2048; idx += NTHREADS_C) {
        const int s = idx >> 6, l = idx & 63, e = l & 15, k0 = 32 * s + 8 * (l >> 4);
        unsigned hi[4], lo[4];
#pragma unroll
        for (int j = 0; j < 4; ++j) {
            const float w0 = g[k0 + 2 * j] * Wr[(k0 + 2 * j) * 16 + e], w1 = g[k0 + 2 * j + 1] * Wr[(k0 + 2 * j + 1) * 16 + e];
            const unsigned h0 = f2bf(w0), h1 = f2bf(w1);
            hi[j] = h0 | (h1 << 16); lo[j] = pk2(w0 - bf2f((unsigned short)h0), w1 - bf2f((unsigned short)h1)); }
        *(LAS u32x4*)(Bhi + idx * 16) = (u32x4){hi[0], hi[1], hi[2], hi[3]};
        *(LAS u32x4*)(Blo + idx * 16) = (u32x4){lo[0], lo[1], lo[2], lo[3]};
    }
    { const int e = tid & 15, pt = tid >> 4; float cs = 0.f, ds = 0.f;
#pragma unroll 4
      for (int kk = 0; kk < 32; ++kk) { const int k = pt * 32 + kk; const float w = Wr[k * 16 + e]; cs += g[k] * w; ds += b[k] * w; }
      part[pt * 32 + e] = cs; part[pt * 32 + 16 + e] = ds; }
    __syncthreads();
    if (tid < 32) { float sacc = 0.f;
#pragma unroll 4
        for (int pt = 0; pt < 32; ++pt) sacc += part[pt * 32 + tid];
        cd[tid] = sacc; }
    __syncthreads();
    const int e = lane & 15, q = lane >> 4;
    const float ce = cd[e], de = cd[16 + e], bre = br[e];
    for (int r0 = bid * 256; r0 < T; r0 += nb * 256) {
        if (tid < 32) lcnt[tid] = 0;
        __syncthreads();
#pragma unroll 1
        for (int tile = 0; tile < 2; ++tile) {
            const int tr0 = wave * 32 + tile * 16;
            const bf16_t* arow = pre1 + (size_t)(r0 + tr0 + e) * D + 8 * q;
            f32x4 acc = (f32x4){0.f, 0.f, 0.f, 0.f}; float s1 = 0.f, s2 = 0.f;
#pragma unroll 1
            for (int s0 = 0; s0 < 32; s0 += 8) {
                u32x4 a[8];
#pragma unroll
                for (int u = 0; u < 8; ++u) a[u] = *(const u32x4*)(arow + 32 * (s0 + u));
#pragma unroll
                for (int u = 0; u < 8; ++u) {
                    const bf16x8 bh = *(const LAS bf16x8*)(Bhi + ((s0 + u) * 64 + lane) * 16), bl = *(const LAS bf16x8*)(Blo + ((s0 + u) * 64 + lane) * 16);
                    const bf16x8 af = __builtin_bit_cast(bf16x8, a[u]);
                    acc = __builtin_amdgcn_mfma_f32_16x16x32_bf16(af, bh, acc, 0, 0, 0);
                    acc = __builtin_amdgcn_mfma_f32_16x16x32_bf16(af, bl, acc, 0, 0, 0);
                    const float x0 = bflo(a[u].x), x1 = bfhi(a[u].x), x2 = bflo(a[u].y), x3 = bfhi(a[u].y), x4 = bflo(a[u].z), x5 = bfhi(a[u].z), x6 = bflo(a[u].w), x7 = bfhi(a[u].w);
                    s1 += ((x0 + x1) + (x2 + x3)) + ((x4 + x5) + (x6 + x7));
                    s2 += ((x0 * x0 + x1 * x1) + (x2 * x2 + x3 * x3)) + ((x4 * x4 + x5 * x5) + (x6 * x6 + x7 * x7));
                }
            }
            s1 += __shfl_xor(s1, 16); s1 += __shfl_xor(s1, 32); s2 += __shfl_xor(s2, 16); s2 += __shfl_xor(s2, 32);
            const float mean = s1 * (1.f / D); const float rstd = rsqrtf(fmaxf(s2 * (1.f / D) - mean * mean, 0.f) + LN_EPS);
#pragma unroll
            for (int r = 0; r < 4; ++r) {
                const int R = 4 * q + r;
                const float mr = __shfl(mean, R), rr = __shfl(rstd, R);
                const float lg = rr * (acc[r] - mr * ce) + de;
                float mx = lg;
#pragma unroll
                for (int o = 1; o < 16; o <<= 1) mx = fmaxf(mx, __shfl_xor(mx, o));
                float p = expf(lg - mx), sum = p;
#pragma unroll
                for (int o = 1; o < 16; o <<= 1) sum += __shfl_xor(sum, o);
                p = p / sum;
                const float sel = p + bre;
                int rank = 0;
#pragma unroll
                for (int o = 1; o < 4; ++o) { const float so = __shfl_xor(sel, o); const int eo = e ^ o; rank += (so > sel || (so == sel && eo < e)) ? 1 : 0; }
                float gs = rank < 2 ? sel : 0.f;
                gs += __shfl_xor(gs, 1); gs += __shfl_xor(gs, 2);
                int gi = e >> 2;
#pragma unroll
                for (int o = 4; o < 16; o <<= 1) { const float go = __shfl_xor(gs, o); const int io = __shfl_xor(gi, o); if (go > gs || (go == gs && io < gi)) { gs = go; gi = io; } }
                const bool chosen = ((e >> 2) == gi) && rank < 2;
                const unsigned long long bm = __ballot(chosen);
                const unsigned m4 = (unsigned)(bm >> (16 * q + 4 * gi)) & 0xFu;
                const int ea = __ffs((int)m4) - 1, eb = 31 - __clz((int)m4);
                const int pidx = ea == 0 ? eb - 1 : (ea == 1 ? eb + 1 : 5);
                const float pa = __shfl(p, 16 * q + 4 * gi + ea), pb = __shfl(p, 16 * q + 4 * gi + eb);
                if (e == r) { const int cls = gi * 6 + pidx; const int rl = tr0 + R; const int lp = atomicAdd((int*)&lcnt[cls], 1); rcls[rl] = cls; rpos[rl] = lp;
                    const float inv = 1.f / (pa + pb); const size_t t = (size_t)(r0 + rl); tokgate[t * 2] = pa * inv; tokgate[t * 2 + 1] = pb * inv; }
            }
        }
        __syncthreads();
        if (tid < NCLS) lbase[tid] = (int)atomicAdd(&gcnt[tid], (unsigned)lcnt[tid]);
        __syncthreads();
        if (tid < 256) { const int t = r0 + tid; const int c = rcls[tid]; tokcls[t] = c; tokpos[t] = lbase[c] + rpos[tid]; }
        __syncthreads();
    }
}
__device__ __forceinline__ void phase_permute(const Params& P, int layer, LAS unsigned char* lds, int bid, int nb) {
    const int tid = opaque_tid(), lane = tid & 63, wave = tid >> 6, nw = blockDim.x >> 6;
    LAS int* off = (LAS int*)lds;
    const unsigned* gcnt = (const unsigned*)(P.ws + WS_CTL) + CW_CNT + 64 * layer;
    int* tilecls = (int*)(P.ws + WS_TILECLS);
    if (tid == 0) { int o = 0; for (int c = 0; c < NCLS; ++c) { off[c] = o * 256; const int nt = ((int)gcnt[c] + 255) >> 8;
            if (bid == 0) for (int i = 0; i < nt; ++i) tilecls[8 + o + i] = c;
            o += nt; }
        if (bid == 0) tilecls[0] = o; }
    __syncthreads();
    const bf16_t* pre1 = (const bf16_t*)(P.out + OUT_PRE1); bf16_t* hs = (bf16_t*)(P.ws + WS_BIG + BIG_HS);
    const float* g = P.in[I_LNMG] + layer * D; const float* b = P.in[I_LNMB] + layer * D;
    const int* tokcls = (const int*)(P.ws + WS_TOKCLS); const int* tokpos = (const int*)(P.ws + WS_TOKPOS); int* tokdst = (int*)(P.ws + WS_TOKDST);
    const float* tokgate = (const float*)(P.ws + WS_TOKGATE); float* rowgate = (float*)(P.ws + WS_ROWGATE);
    float gr[16], br[16]; load_gb(g, b, lane, gr, br);
    for (int t0 = bid * nw + wave; t0 < T; t0 += 2 * nb * nw) {
        const int t1 = t0 + nb * nw; const bool has1 = t1 < T;
        float v0[16], v1[16];
        load_row_bf16(pre1 + (size_t)t0 * D, lane, v0);
        if (has1) load_row_bf16(pre1 + (size_t)t1 * D, lane, v1);
        const int dst0 = off[tokcls[t0]] + tokpos[t0]; const int dst1 = has1 ? off[tokcls[t1]] + tokpos[t1] : 0;
#pragma unroll
        for (int rr = 0; rr < 2; ++rr) {
            if (rr == 1 && !has1) break;
            float (&v)[16] = rr ? v1 : v0; const int t = rr ? t1 : t0, dst = rr ? dst1 : dst0;
            ln_row_r(v, gr, br);
            store_row_bf16(hs + (size_t)dst * D, lane, v);
            if (MOE_FP8(layer) && MOEA_FP8) { typedef unsigned u32x2 __attribute__((ext_vector_type(2)));
#pragma unroll
                for (int j = 0; j < 2; ++j) *(u32x2*)(P.ws + WS_BIG + BIG_HS8 + (size_t)dst * D + 8 * lane + 512 * j) = (u32x2){pk4_fp8(v[8 * j] * H8_SCALE, v[8 * j + 1] * H8_SCALE, v[8 * j + 2] * H8_SCALE, v[8 * j + 3] * H8_SCALE), pk4_fp8(v[8 * j + 4] * H8_SCALE, v[8 * j + 5] * H8_SCALE, v[8 * j + 6] * H8_SCALE, v[8 * j + 7] * H8_SCALE)}; }
            if (lane == 0) { tokdst[t] = dst; rowgate[(size_t)dst * 2] = tokgate[(size_t)t * 2]; rowgate[(size_t)dst * 2 + 1] = tokgate[(size_t)t * 2 + 1]; }
        }
    }
}
__device__ __forceinline__ void phase_lnffn(const Params& P, int layer, int bid, int nb) {
    const int tid = opaque_tid(), lane = tid & 63, wave = tid >> 6, nw = blockDim.x >> 6;
    const bf16_t* pre2 = (const bf16_t*)(P.ws + WS_BIG + BIG_PRE2);
    const float* g = P.in[I_LNFG] + layer * D; const float* b = P.in[I_LNFB] + layer * D;
    const int* tokdst = (const int*)(P.ws + WS_TOKDST);
    float gr[16], br[16]; load_gb(g, b, lane, gr, br);
    for (int t0 = bid * nw + wave; t0 < T; t0 += 2 * nb * nw) {
        const int t1 = t0 + nb * nw; const bool has1 = t1 < T;
        float v0[16], v1[16];
        load_row_bf16(pre2 + (size_t)tokdst[t0] * D, lane, v0);
        if (has1) load_row_bf16(pre2 + (size_t)tokdst[t1] * D, lane, v1);
#pragma unroll
        for (int rr = 0; rr < 2; ++rr) {
            if (rr == 1 && !has1) break;
            float (&v)[16] = rr ? v1 : v0; const int t = rr ? t1 : t0;
            ln_row_r(v, gr, br);
            if (layer == 0) { store_row_bf16((bf16_t*)(P.out + OUT_H) + (size_t)t * D, lane, v);
                typedef unsigned u32x2 __attribute__((ext_vector_type(2)));
#pragma unroll
                for (int j = 0; j < 2; ++j) *(u32x2*)(P.ws + WS_H8 + (size_t)t * D + 8 * lane + 512 * j) = (u32x2){pk4_fp8(v[8 * j] * H8_SCALE, v[8 * j + 1] * H8_SCALE, v[8 * j + 2] * H8_SCALE, v[8 * j + 3] * H8_SCALE), pk4_fp8(v[8 * j + 4] * H8_SCALE, v[8 * j + 5] * H8_SCALE, v[8 * j + 6] * H8_SCALE, v[8 * j + 7] * H8_SCALE)}; }
            else { float* o = (float*)P.out + (size_t)t * D;
#pragma unroll
                for (int j = 0; j < 2; ++j) { *(f32x4*)(o + 8 * lane + 512 * j) = (f32x4){v[8 * j], v[8 * j + 1], v[8 * j + 2], v[8 * j + 3]}; *(f32x4*)(o + 8 * lane + 512 * j + 4) = (f32x4){v[8 * j + 4], v[8 * j + 5], v[8 * j + 6], v[8 * j + 7]}; } }
        }
    }
}

enum { MIX_RET = 0, MIX_ML = 1, MIX_GLA = 2, MIX_SSD = 3 };
typedef short s16x4 __attribute__((ext_vector_type(4)));
__device__ __forceinline__ bf16x8 tr_frag(LAS unsigned char* p0, LAS unsigned char* p1) {
    const s16x4 a = __builtin_amdgcn_ds_read_tr16_b64_v4i16((LAS s16x4*)p0), b = __builtin_amdgcn_ds_read_tr16_b64_v4i16((LAS s16x4*)p1);
    return (bf16x8){a[0], a[1], a[2], a[3], b[0], b[1], b[2], b[3]};
}
__device__ __forceinline__ bf16x8 cat_frag(LAS unsigned char* p0, LAS unsigned char* p1) {
    const s16x4 a = *(LAS s16x4*)p0, b = *(LAS s16x4*)p1;
    return (bf16x8){a[0], a[1], a[2], a[3], b[0], b[1], b[2], b[3]};
}
__device__ __forceinline__ bf16x8 pack_acc(const f32x4& lo, const f32x4& hi) {
    u32x4 w; w.x = pg8::cvt_pk_bf16(lo[0], lo[1]); w.y = pg8::cvt_pk_bf16(lo[2], lo[3]); w.z = pg8::cvt_pk_bf16(hi[0], hi[1]); w.w = pg8::cvt_pk_bf16(hi[2], hi[3]);
    return __builtin_bit_cast(bf16x8, w);
}
__device__ __forceinline__ void unpack8(const u32x4& w, float (&v)[8]) {
    v[0] = bflo(w.x); v[1] = bfhi(w.x); v[2] = bflo(w.y); v[3] = bfhi(w.y); v[4] = bflo(w.z); v[5] = bfhi(w.z); v[6] = bflo(w.w); v[7] = bfhi(w.w);
}
__device__ __forceinline__ u32x4 pack8(const float (&v)[8]) {
    u32x4 w; w.x = pg8::cvt_pk_bf16(v[0], v[1]); w.y = pg8::cvt_pk_bf16(v[2], v[3]); w.z = pg8::cvt_pk_bf16(v[4], v[5]); w.w = pg8::cvt_pk_bf16(v[6], v[7]); return w;
}

template <int CTRL, int RM> __device__ __forceinline__ float dpp_take(float old, float v) { return __builtin_bit_cast(float, __builtin_amdgcn_update_dpp(__builtin_bit_cast(int, old), __builtin_bit_cast(int, v), CTRL, RM, 0xf, false)); }
__device__ __forceinline__ float wave_scan_add(float v) {
    v += dpp_take<0x111, 0xf>(0.f, v); v += dpp_take<0x112, 0xf>(0.f, v); v += dpp_take<0x114, 0xf>(0.f, v); v += dpp_take<0x118, 0xf>(0.f, v);
    v += dpp_take<0x142, 0xa>(0.f, v); v += dpp_take<0x143, 0xc>(0.f, v); return v; }
__device__ __forceinline__ float wave_scan_max(float v) {
    const float ni = -3.0e38f;
    v = fmaxf(v, dpp_take<0x111, 0xf>(ni, v)); v = fmaxf(v, dpp_take<0x112, 0xf>(ni, v)); v = fmaxf(v, dpp_take<0x114, 0xf>(ni, v)); v = fmaxf(v, dpp_take<0x118, 0xf>(ni, v));
    v = fmaxf(v, dpp_take<0x142, 0xa>(ni, v)); v = fmaxf(v, dpp_take<0x143, 0xc>(ni, v)); return v; }
__device__ __forceinline__ float fexp(float x) { return __builtin_amdgcn_exp2f(x * 1.4426950408889634f); }
__device__ __forceinline__ float frcp(float x) { return __builtin_amdgcn_rcpf(x); }
__device__ __forceinline__ float fsigmoid(float x) { return frcp(1.f + fexp(-x)); }
__device__ __forceinline__ float fsilu(float x) { return x * fsigmoid(x); }
__device__ __forceinline__ float fsoftplus(float x) {
    const float u = fexp(-fabsf(x));
    const float l = u < 0.01f ? u * (1.f - u * (0.5f - u * 0.33333333f)) : __builtin_amdgcn_logf(1.f + u) * 0.6931471805599453f;
    return fmaxf(x, 0.f) + l;
}
__device__ __forceinline__ float flogsigmoid(float x) { return -fsoftplus(-x); }

template <int NR>
__device__ __forceinline__ void conv_rows(const bf16_t* src, const int trow0, const LAS float* wl, const int ldw, float (&o)[NR][8]) {
    float x[NR + 3][8];
#pragma unroll
    for (int i = 0; i < NR + 3; ++i) {
        if (trow0 + i - 3 >= 0) { const u32x4 xw = *(const u32x4*)(src + (ptrdiff_t)(i - 3) * NP); unpack8(xw, x[i]); }
        else {
#pragma unroll
            for (int j = 0; j < 8; ++j) x[i][j] = 0.f; }
    }
    float wv[5][8];
#pragma unroll
    for (int k = 0; k < 5; ++k) { const f32x4 w0 = *(const LAS f32x4*)(wl + k * ldw), w1 = *(const LAS f32x4*)(wl + k * ldw + 4);
#pragma unroll
        for (int j = 0; j < 4; ++j) { wv[k][j] = w0[j]; wv[k][4 + j] = w1[j]; } }
#pragma unroll
    for (int r = 0; r < NR; ++r)
#pragma unroll
        for (int j = 0; j < 8; ++j) { float a = wv[4][j];
#pragma unroll
            for (int k = 0; k < 4; ++k) a += wv[k][j] * x[r + k][j];
            o[r][j] = fsilu(a); }
}

template <int MIX>
__device__ __forceinline__ void mixer_unit(const Params& P, const int b, const int h, LAS unsigned char* lds, const bool dostore) {
    const int tid0 = opaque_tid(), w = __builtin_amdgcn_readfirstlane(tid0 >> 6);
    typedef unsigned u32x2 __attribute__((ext_vector_type(2)));
    constexpr int RSQ = 288, RSV = 544, RSP = 144;
    constexpr int SZQ = 64 * RSQ, SZV = 64 * RSV, SZP = 64 * RSP;
    constexpr int OQ = 0, OK1 = SZQ, OV = 2 * SZQ, O3 = 2 * SZQ + SZV;
    constexpr int OK2 = (MIX == MIX_ML || MIX == MIX_GLA) ? O3 : OK1;
    constexpr int OV2 = (MIX == MIX_SSD) ? O3 : OV;
    constexpr int OP = MIX == MIX_RET ? O3 : (MIX == MIX_SSD ? O3 + SZV : O3 + SZQ);
    constexpr int NPV = MIX == MIX_SSD ? 4 : 1;
    constexpr int OT = OP + NPV * SZP;
    constexpr int OY = OV2;
    LAS float* tab = (LAS float*)(lds + OT);
    constexpr int TGN = MIX == MIX_GLA ? 8832 : MIX == MIX_ML ? 648 : MIX == MIX_SSD ? 512 : 0;
    constexpr int TCW = MIX == MIX_ML ? 904 : 768;
    static_assert(OT + (MIX == MIX_GLA ? 11776 : MIX == MIX_SSD ? 3328 : 2184) * 4 <= 163840 - 1024, "lds map");
    bf16_t* proj = (bf16_t*)(P.ws + WS_BIG);
    const size_t row0b = (size_t)b * SEQ;
    constexpr int GIDX = MIX == MIX_RET ? I_RETG : MIX == MIX_ML ? I_MLG : MIX == MIX_GLA ? I_GLAG : I_SSDG;
    if (tid0 < 256) tab[TGN + tid0] = P.in[GIDX][h * 256 + tid0];
    if constexpr (MIX == MIX_ML) {
        for (int i = tid0; i < 1280; i += NTHREADS_C) { const int k = i >> 8, j = i & 255; const int chn = (j >> 7) * 512 + h * 128 + (j & 127);
            tab[TCW + i] = k < 4 ? P.in[I_MLCW][k * 1024 + chn] : P.in[I_MLCB][chn]; }
        if (tid0 < 128) tab[512 + tid0] = 0.f; if (tid0 == 0) tab[641] = 0.f;
    }
    if constexpr (MIX == MIX_GLA) {
        for (int i = tid0; i < 2048; i += NTHREADS_C) tab[9088 + i] = P.in[I_GLAWA][(i >> 7) * 512 + h * 128 + (i & 127)];
        if (tid0 < 128) tab[9088 + 2048 + tid0] = P.in[I_GLABA][h * 128 + tid0];
    }
    if constexpr (MIX == MIX_SSD) {
        for (int i = tid0; i < 2560; i += NTHREADS_C) { const int k = i >> 9, j = i & 511; const int chn = j < 256 ? h * 256 + j : (j < 384 ? 1024 + h * 128 + (j - 256) : 1536 + h * 128 + (j - 384));
            tab[TCW + i] = k < 4 ? P.in[I_SSDCW][k * 2048 + chn] : P.in[I_SSDCB][chn]; }
    }
    __syncthreads();
    f32x4 Sacc[8][2];
#pragma unroll
    for (int rt = 0; rt < 8; ++rt)
#pragma unroll
        for (int ct = 0; ct < 2; ++ct) Sacc[rt][ct] = (f32x4){0.f, 0.f, 0.f, 0.f};
    float gam = 1.f, lg2gam = 0.f, g63 = 1.f;
    float rinv[4] = {0.f, 0.f, 0.f, 0.f};
    if constexpr (MIX == MIX_RET) { gam = 1.f - __builtin_amdgcn_exp2f(-5.f - (float)h); lg2gam = __builtin_amdgcn_logf(gam); g63 = __builtin_amdgcn_exp2f(63.f * lg2gam);
#pragma unroll
        for (int i2 = 0; i2 < 4; ++i2) rinv[i2] = __builtin_amdgcn_exp2f(-(float)(2 * (4 * (tid0 & 15) + i2)) * (13.287712379549449f / 128.f)) * 0.15915494309189535f; }

    tp_begin(lds, 100 * MIX + 9);
    unsigned short gpre0 = 0, gpre1 = 0;
    if constexpr (MIX == MIX_ML) { if (w == 0) { const bf16_t* rp = proj + (row0b + (tid0 & 63)) * NP; gpre0 = rp[C0_MI + h]; gpre1 = rp[C0_MF + h]; } }
    if constexpr (MIX == MIX_SSD) { if (w < 4) gpre0 = proj[(row0b + (tid0 & 63)) * NP + C1_DT + 4 * h + w]; }
#pragma unroll 1
    for (int ch = 0; ch < SEQ / 64; ++ch) {
        int tid = tid0; asm volatile("" : "+v"(tid));
        const int lane = tid & 63, c = lane & 15, g = lane >> 4, q4 = (lane >> 2) & 3, p4 = lane & 3;
        const size_t row0 = row0b + (size_t)ch * 64;
        tp_begin(lds, 100 * MIX + 1);
        if constexpr (MIX == MIX_RET) {
            const int* pos = (const int*)P.in[I_POS];
#pragma unroll
            for (int i = 0; i < 2; ++i) {
                const int pi = tid + 512 * i, r = pi >> 4, c8 = pi & 15;
                const bf16_t* rp = proj + (row0 + r) * NP + h * 128 + 8 * c8;
                const u32x4 qw = *(const u32x4*)(rp + C0_RQ), kw = *(const u32x4*)(rp + C0_RK);
                float qv[8], kv[8]; unpack8(qw, qv); unpack8(kw, kv);
                const float ps = (float)pos[row0 + r];
                const float fq = __builtin_amdgcn_exp2f((float)r * lg2gam), fk = 0.08838834764831845f * __builtin_amdgcn_exp2f(-(float)r * lg2gam);
#pragma unroll
                for (int i2 = 0; i2 < 4; ++i2) {
                    const float tr = __builtin_amdgcn_fractf(ps * rinv[i2]);
                    const float sn = __builtin_amdgcn_sinf(tr), cs = __builtin_amdgcn_cosf(tr);
                    const float q0 = qv[2 * i2], q1 = qv[2 * i2 + 1], k0 = kv[2 * i2], k1 = kv[2 * i2 + 1];
                    qv[2 * i2] = (q0 * cs - q1 * sn) * fq; qv[2 * i2 + 1] = (q0 * sn + q1 * cs) * fq;
                    kv[2 * i2] = (k0 * cs - k1 * sn) * fk; kv[2 * i2 + 1] = (k0 * sn + k1 * cs) * fk;
                }
                *(LAS u32x4*)(lds + OQ + RSQ * r + 16 * c8) = pack8(qv);
                *(LAS u32x4*)(lds + OK1 + RSQ * r + 16 * c8) = pack8(kv);
            }
#pragma unroll
            for (int i = 0; i < 4; ++i) {
                const int pi = tid + 512 * i, r = pi >> 5, c8 = pi & 31;
                *(LAS u32x4*)(lds + OV + RSV * r + 16 * c8) = *(const u32x4*)(proj + (row0 + r) * NP + C0_RV + h * 256 + 8 * c8);
            }
        }
        if constexpr (MIX == MIX_GLA) {
            if (tid < 128) *(LAS u32x4*)(tab + 11264 + 4 * tid) = *(const u32x4*)(proj + (row0 + (tid >> 1)) * NP + C1_GA + 8 * (tid & 1));
            __syncthreads();
            {
                const int d = tid & 127, tq = tid >> 7;
                const float ba = tab[9088 + 2048 + d];
                float wv[16];
#pragma unroll
                for (int r = 0; r < 16; ++r) wv[r] = tab[9088 + r * 128 + d];
                float run = 0.f;
#pragma unroll 4
                for (int i = 0; i < 16; ++i) {
                    const int t = 16 * tq + i;
                    const u32x4 g0 = *(LAS u32x4*)(tab + 11264 + 8 * t), g1 = *(LAS u32x4*)(tab + 11264 + 8 * t + 4); float gv[8], gv2[8]; unpack8(g0, gv); unpack8(g1, gv2);
                    float a = ba;
#pragma unroll
                    for (int r = 0; r < 8; ++r) a += gv[r] * wv[r] + gv2[r] * wv[8 + r];
                    run += flogsigmoid(a) * (1.f / 16.f);
                    tab[t * 128 + d] = run;
                }
                tab[8192 + tq * 128 + d] = run;
            }
            __syncthreads();
            if (tid < 128) tab[8704 + tid] = fexp((tab[8192 + tid] + tab[8192 + 128 + tid]) + (tab[8192 + 256 + tid] + tab[8192 + 384 + tid]));
            __syncthreads();
#pragma unroll
            for (int i = 0; i < 2; ++i) {
                const int pi = tid + 512 * i, r = pi >> 4, c8 = pi & 15, tq = r >> 4;
                const bf16_t* rp = proj + (row0 + r) * NP + h * 128 + 8 * c8;
                const u32x4 qw = *(const u32x4*)(rp + C1_GQ), kw = *(const u32x4*)(rp + C1_GK);
                float qv[8], kv[8], k2[8]; unpack8(qw, qv); unpack8(kw, kv);
#pragma unroll
                for (int hh = 0; hh < 2; ++hh) {
                    const int d0 = 8 * c8 + 4 * hh;
                    f32x4 bc = *(LAS f32x4*)(tab + r * 128 + d0);
                    const f32x4 t0 = *(LAS f32x4*)(tab + 8192 + d0), t1 = *(LAS f32x4*)(tab + 8192 + 128 + d0), t2 = *(LAS f32x4*)(tab + 8192 + 256 + d0), t3 = *(LAS f32x4*)(tab + 8192 + 384 + d0);
                    if (tq > 0) bc = bc + t0; if (tq > 1) bc = bc + t1; if (tq > 2) bc = bc + t2;
                    const f32x4 bt = (t0 + t1) + (t2 + t3);
                    const f32x4 dcv = *(LAS f32x4*)(tab + 8704 + d0);
#pragma unroll
                    for (int j = 0; j < 4; ++j) { const float e1 = fexp(bc[j]), e2 = frcp(e1), kk = kv[4 * hh + j] * e2;
                        qv[4 * hh + j] = qv[4 * hh + j] * 0.08838834764831845f * e1; kv[4 * hh + j] = kk; k2[4 * hh + j] = kk * dcv[j]; }
                }
                *(LAS u32x4*)(lds + OQ + RSQ * r + 16 * c8) = pack8(qv);
                *(LAS u32x4*)(lds + OK1 + RSQ * r + 16 * c8) = pack8(kv);
                *(LAS u32x4*)(lds + OK2 + RSQ * r + 16 * c8) = pack8(k2);
            }
#pragma unroll
            for (int i = 0; i < 4; ++i) {
                const int pi = tid + 512 * i, r = pi >> 5, c8 = pi & 31;
                *(LAS u32x4*)(lds + OV + RSV * r + 16 * c8) = *(const u32x4*)(proj + (row0 + r) * NP + C1_GV + h * 256 + 8 * c8);
            }
        }
        if constexpr (MIX == MIX_ML) {
            if (w == 0) {
                const float ip = bf2f(gpre0) + P.in[I_MLBI][h], lf = flogsigmoid(bf2f(gpre1) + P.in[I_MLBF][h]);
                const float bc = wave_scan_add(lf);
                const float u = ip - bc; const float pm = wave_scan_max(u);
                const float mst = tab[641];
                const float M = fmaxf(mst, pm), M63 = __shfl(M, 63), bt = __shfl(bc, 63);
                tab[lane] = u; tab[64 + lane] = M; tab[128 + lane] = fexp(u - M63); tab[192 + lane] = fexp(mst - M); tab[256 + lane] = fexp(-bc - M);
                if (lane == 0) { tab[640] = fexp(mst - M63); tab[642] = bt + M63; }
            }
            {
                const int c16 = tid & 31, r0 = (tid >> 5) * 4, isk = c16 >> 4, c8 = c16 & 15;
                float o[4][8];
                conv_rows<4>(proj + (row0 + r0) * NP + (isk ? C0_MK : C0_MQ) + h * 128 + 8 * c8, ch * 64 + r0, tab + TCW + 8 * c16, 256, o);
#pragma unroll
                for (int r = 0; r < 4; ++r) {
                    if (isk) {
#pragma unroll
                        for (int j = 0; j < 8; ++j) o[r][j] *= 0.08838834764831845f; }
                    *(LAS u32x4*)(lds + (isk ? OK1 : OQ) + RSQ * (r0 + r) + 16 * c8) = pack8(o[r]); }
            }
#pragma unroll
            for (int i = 0; i < 4; ++i) {
                const int pi = tid + 512 * i, r = pi >> 5, c8 = pi & 31;
                *(LAS u32x4*)(lds + OV + RSV * r + 16 * c8) = *(const u32x4*)(proj + (row0 + r) * NP + C0_MV + h * 256 + 8 * c8);
            }
            __syncthreads();
            tp_end(lds, 100 * MIX + 1); tp_begin(lds, 100 * MIX + 6);
#pragma unroll
            for (int i = 0; i < 2; ++i) {
                const int pi = tid + 512 * i, r = pi >> 4, c8 = pi & 15;
                const u32x4 kw = *(LAS u32x4*)(lds + OK1 + RSQ * r + 16 * c8); float kv[8]; unpack8(kw, kv); const float es = tab[128 + r];
#pragma unroll
                for (int j = 0; j < 8; ++j) kv[j] *= es;
                *(LAS u32x4*)(lds + OK2 + RSQ * r + 16 * c8) = pack8(kv);
            }
            {
                const int t = tid >> 3, part = tid & 7; float a = 0.f;
#pragma unroll
                for (int i = 0; i < 2; ++i) { const u32x4 qw = *(LAS u32x4*)(lds + OQ + RSQ * t + 2 * (16 * part + 8 * i)); float qv[8]; unpack8(qw, qv);
                    const f32x4 n0 = *(LAS f32x4*)(tab + 512 + 16 * part + 8 * i), n1 = *(LAS f32x4*)(tab + 512 + 16 * part + 8 * i + 4);
#pragma unroll
                    for (int j = 0; j < 4; ++j) a += qv[j] * n0[j] + qv[4 + j] * n1[j]; }
                a += __shfl_xor(a, 1); a += __shfl_xor(a, 2); a += __shfl_xor(a, 4);
                if (part == 0) tab[448 + t] = a;
            }
        }
        if constexpr (MIX == MIX_SSD) {
            if (w < 4) {
                const int hd = 4 * h + w;
                const float dt = fsoftplus(bf2f(gpre0) + P.in[I_SSDDTB][hd]);
                const float cm = wave_scan_add(dt * (-fexp(P.in[I_SSDALOG][hd])));
                tab[lane * 4 + w] = cm; tab[256 + lane * 4 + w] = dt;
            }
            {
                const int c32 = tid & 31, r0 = (tid >> 5) * 4, isc = c32 >> 4, c8 = c32 & 15, hr = c32 >> 3;
                float o[4][8], ox[4][8];
                conv_rows<4>(proj + (row0 + r0) * NP + (isc ? C1_CM : C1_BM) + h * 128 + 8 * c8, ch * 64 + r0, tab + TCW + 256 + 8 * c32, 512, o);
                conv_rows<4>(proj + (row0 + r0) * NP + C1_XS + h * 256 + 8 * c32, ch * 64 + r0, tab + TCW + 8 * c32, 512, ox);
#pragma unroll
                for (int r = 0; r < 4; ++r) *(LAS u32x4*)(lds + (isc ? OQ : OK1) + RSQ * (r0 + r) + 16 * c8) = pack8(o[r]);
                __syncthreads();
                tp_end(lds, 100 * MIX + 1); tp_begin(lds, 100 * MIX + 6);
                const float last = tab[63 * 4 + hr];
#pragma unroll
                for (int r = 0; r < 4; ++r) { const float dt = tab[256 + (r0 + r) * 4 + hr], e2 = fexp(last - tab[(r0 + r) * 4 + hr]); float o2[8];
#pragma unroll
                    for (int j = 0; j < 8; ++j) { ox[r][j] *= dt; o2[j] = ox[r][j] * e2; }
                    *(LAS u32x4*)(lds + OV + RSV * (r0 + r) + 16 * c32) = pack8(ox[r]);
                    *(LAS u32x4*)(lds + OV2 + RSV * (r0 + r) + 16 * c32) = pack8(o2); }
            }
        }
        __syncthreads();
        tp_end(lds, (MIX == MIX_ML || MIX == MIX_SSD) ? 100 * MIX + 6 : 100 * MIX + 1); tp_begin(lds, 100 * MIX + 2);
        if (ch + 1 < SEQ / 64) {
            const int sl = tid & 15;
            int col = -1;
            if constexpr (MIX == MIX_RET) col = sl < 2 ? C0_RQ + h * 128 + 64 * sl : sl < 4 ? C0_RK + h * 128 + 64 * (sl - 2) : sl < 8 ? C0_RV + h * 256 + 64 * (sl - 4) : sl < 12 ? C0_RG + h * 256 + 64 * (sl - 8) : -1;
            if constexpr (MIX == MIX_ML) col = sl < 2 ? C0_MQ + h * 128 + 64 * sl : sl < 4 ? C0_MK + h * 128 + 64 * (sl - 2) : sl < 8 ? C0_MV + h * 256 + 64 * (sl - 4) : sl < 12 ? C0_MO + h * 256 + 64 * (sl - 8) : sl == 12 ? C0_MI : -1;
            if constexpr (MIX == MIX_GLA) col = sl < 2 ? C1_GQ + h * 128 + 64 * sl : sl < 4 ? C1_GK + h * 128 + 64 * (sl - 2) : sl < 8 ? C1_GV + h * 256 + 64 * (sl - 4) : sl < 12 ? C1_GR + h * 256 + 64 * (sl - 8) : sl == 12 ? C1_GA : -1;
            if constexpr (MIX == MIX_SSD) col = sl < 4 ? C1_XS + h * 256 + 64 * sl : sl < 6 ? C1_BM + h * 128 + 64 * (sl - 4) : sl < 8 ? C1_CM + h * 128 + 64 * (sl - 6) : sl < 12 ? C1_SZ + h * 256 + 64 * (sl - 8) : sl == 12 ? C1_DT : -1;
            if (col >= 0) { const bf16_t* nbp = proj + (row0 + 64 + (tid >> 4)) * NP + col;
                const unsigned pfl = 157696u + (unsigned)w * 512u;
                asm volatile("s_mov_b32 m0, %2\n\ts_nop 0\n\tglobal_load_lds_dword %0, off\n\ts_mov_b32 m0, %3\n\ts_nop 0\n\tglobal_load_lds_dword %1, off"
                             :: "v"(nbp), "v"(nbp + (size_t)32 * NP), "s"(pfl), "s"(pfl + 256u) : "memory", "m0"); }
        }
        {
            const int tt = w >> 1; float rsum = 0.f;
#pragma unroll
            for (int si = 0; si < 2; ++si) {
                const int ss = 2 * (w & 1) + si;
                f32x4 acc = (f32x4){0.f, 0.f, 0.f, 0.f};
#pragma unroll
                for (int ks = 0; ks < 4; ++ks) {
                    const bf16x8 a = *(LAS bf16x8*)(lds + OK1 + RSQ * (16 * ss + c) + 2 * (32 * ks + 8 * g));
                    const bf16x8 bq = *(LAS bf16x8*)(lds + OQ + RSQ * (16 * tt + c) + 2 * (32 * ks + 8 * g));
                    acc = __builtin_amdgcn_mfma_f32_16x16x32_bf16(a, bq, acc, 0, 0, 0);
                }
                const int t = 16 * tt + c, s0 = 16 * ss + 4 * g;
                if constexpr (MIX == MIX_SSD) {
                    const f32x4 ct_ = *(LAS f32x4*)(tab + t * 4);
#pragma unroll
                    for (int hr = 0; hr < 4; ++hr) { float pv[4];
#pragma unroll
                        for (int r = 0; r < 4; ++r) pv[r] = (s0 + r <= t) ? acc[r] * fexp(ct_[hr] - tab[(s0 + r) * 4 + hr]) : 0.f;
                        *(LAS u32x2*)(lds + OP + hr * SZP + RSP * t + 2 * s0) = (u32x2){pg8::cvt_pk_bf16(pv[0], pv[1]), pg8::cvt_pk_bf16(pv[2], pv[3])}; }
                } else {
                    float pv[4];
                    if constexpr (MIX == MIX_ML) { const f32x4 us = *(LAS f32x4*)(tab + s0); const float Mt = tab[64 + t];
#pragma unroll
                        for (int r = 0; r < 4; ++r) { pv[r] = (s0 + r <= t) ? acc[r] * fexp(us[r] - Mt) : 0.f; rsum += pv[r]; } }
                    else {
#pragma unroll
                        for (int r = 0; r < 4; ++r) pv[r] = (s0 + r <= t) ? acc[r] : 0.f; }
                    *(LAS u32x2*)(lds + OP + RSP * t + 2 * s0) = (u32x2){pg8::cvt_pk_bf16(pv[0], pv[1]), pg8::cvt_pk_bf16(pv[2], pv[3])};
                }
            }
            if constexpr (MIX == MIX_ML) { rsum += __shfl_xor(rsum, 16); rsum += __shfl_xor(rsum, 32); if (g == 0) tab[320 + (w & 1) * 64 + 16 * tt + c] = rsum; }
        }
        __syncthreads();
        tp_end(lds, 100 * MIX + 2); tp_begin(lds, 100 * MIX + 3);
        f32x4 Yacc[2][4];
#pragma unroll
        for (int ct = 0; ct < 2; ++ct)
#pragma unroll
            for (int tt = 0; tt < 4; ++tt) Yacc[ct][tt] = (f32x4){0.f, 0.f, 0.f, 0.f};
#pragma unroll
        for (int kd = 0; kd < 4; ++kd) {
            bf16x8 qf[4];
#pragma unroll
            for (int tt = 0; tt < 4; ++tt) { LAS unsigned char* qp = lds + OQ + RSQ * (16 * tt + c) + 2 * (32 * kd + 4 * g); qf[tt] = cat_frag(qp, qp + 32); }
#pragma unroll
            for (int ct = 0; ct < 2; ++ct) { const bf16x8 sf = pack_acc(Sacc[2 * kd][ct], Sacc[2 * kd + 1][ct]);
#pragma unroll
                for (int tt = 0; tt < 4; ++tt) Yacc[ct][tt] = __builtin_amdgcn_mfma_f32_16x16x32_bf16(sf, qf[tt], Yacc[ct][tt], 0, 0, 0); }
        }
        if constexpr (MIX != MIX_GLA) {
#pragma unroll
            for (int tt = 0; tt < 4; ++tt) {
                float rs = gam;
                if constexpr (MIX == MIX_ML) rs = tab[192 + 16 * tt + c];
                if constexpr (MIX == MIX_SSD) rs = fexp(tab[(16 * tt + c) * 4 + (w >> 1)]);
#pragma unroll
                for (int ct = 0; ct < 2; ++ct) Yacc[ct][tt] = Yacc[ct][tt] * rs;
            }
        }
        bf16x8 Vf[2][2];
#pragma unroll
        for (int ks = 0; ks < 2; ++ks)
#pragma unroll
            for (int ct = 0; ct < 2; ++ct) { LAS unsigned char* vp = lds + OV + RSV * (32 * ks + 8 * g + q4) + 2 * (32 * w + 16 * ct) + 8 * p4; Vf[ks][ct] = tr_frag(vp, vp + 4 * RSV); }
#pragma unroll
        for (int ks = 0; ks < 2; ++ks)
#pragma unroll
            for (int tt = 0; tt < 4; ++tt) { const bf16x8 pf = *(LAS bf16x8*)(lds + OP + (MIX == MIX_SSD ? (w >> 1) * SZP : 0) + RSP * (16 * tt + c) + 2 * (32 * ks + 8 * g));
#pragma unroll
                for (int ct = 0; ct < 2; ++ct) Yacc[ct][tt] = __builtin_amdgcn_mfma_f32_16x16x32_bf16(Vf[ks][ct], pf, Yacc[ct][tt], 0, 0, 0); }
        if constexpr (MIX == MIX_GLA) {
#pragma unroll
            for (int rt = 0; rt < 8; ++rt) { const f32x4 dc = *(LAS f32x4*)(tab + 8704 + 16 * rt + 4 * g);
#pragma unroll
                for (int ct = 0; ct < 2; ++ct) Sacc[rt][ct] = Sacc[rt][ct] * dc; }
        } else {
            float dc = gam;
            if constexpr (MIX == MIX_ML) dc = tab[640];
            if constexpr (MIX == MIX_SSD) dc = fexp(tab[63 * 4 + (w >> 1)]);
#pragma unroll
            for (int rt = 0; rt < 8; ++rt)
#pragma unroll
                for (int ct = 0; ct < 2; ++ct) Sacc[rt][ct] = Sacc[rt][ct] * dc;
        }
        if constexpr (MIX == MIX_SSD) {
#pragma unroll
            for (int ks = 0; ks < 2; ++ks)
#pragma unroll
                for (int ct = 0; ct < 2; ++ct) { LAS unsigned char* vp = lds + OV2 + RSV * (32 * ks + 8 * g + q4) + 2 * (32 * w + 16 * ct) + 8 * p4; Vf[ks][ct] = tr_frag(vp, vp + 4 * RSV); }
        }
#pragma unroll
        for (int rt = 0; rt < 8; ++rt)
#pragma unroll
            for (int ks = 0; ks < 2; ++ks) { LAS unsigned char* kp = lds + OK2 + RSQ * (32 * ks + 8 * g + q4) + 2 * (16 * rt) + 8 * p4; const bf16x8 kf = tr_frag(kp, kp + 4 * RSQ);
#pragma unroll
                for (int ct = 0; ct < 2; ++ct) Sacc[rt][ct] = __builtin_amdgcn_mfma_f32_16x16x32_bf16(kf, Vf[ks][ct], Sacc[rt][ct], 0, 0, 0); }
        if constexpr (MIX == MIX_RET) {
#pragma unroll
            for (int rt = 0; rt < 8; ++rt)
#pragma unroll
                for (int ct = 0; ct < 2; ++ct) Sacc[rt][ct] = Sacc[rt][ct] * g63;
        }
        if constexpr (MIX == MIX_ML) {
            if (tid < 128) { float a = 0.f;
#pragma unroll 8
                for (int s = 0; s < 64; ++s) a += bf2f(*(LAS unsigned short*)(lds + OK2 + RSQ * s + 2 * tid));
                tab[512 + tid] = tab[640] * tab[512 + tid] + a; }
        }
        __syncthreads();
        tp_end(lds, 100 * MIX + 3); tp_begin(lds, 100 * MIX + 4);
#pragma unroll
        for (int ct = 0; ct < 2; ++ct)
#pragma unroll
            for (int tt = 0; tt < 4; ++tt)
                *(LAS u32x2*)(lds + OY + RSV * (16 * tt + c) + 2 * (32 * w + 16 * ct + 4 * g)) = (u32x2){pg8::cvt_pk_bf16(Yacc[ct][tt][0], Yacc[ct][tt][1]), pg8::cvt_pk_bf16(Yacc[ct][tt][2], Yacc[ct][tt][3])};
        __syncthreads();
        tp_end(lds, 100 * MIX + 4); tp_begin(lds, 100 * MIX + 5);
        {
            const int t = tid >> 3, part = tid & 7;
            float y[32];
#pragma unroll
            for (int i = 0; i < 4; ++i) { const u32x4 yw = *(LAS u32x4*)(lds + OY + RSV * t + 2 * (32 * part + 8 * i)); float t8[8]; unpack8(yw, t8);
#pragma unroll
                for (int j = 0; j < 8; ++j) y[8 * i + j] = t8[j]; }
            constexpr int GCOL = MIX == MIX_RET ? C0_RG : MIX == MIX_ML ? C0_MO : MIX == MIX_GLA ? C1_GR : C1_SZ;
            constexpr int OCOL = MIX == MIX_RET ? C0_RV : MIX == MIX_ML ? C0_MV : MIX == MIX_GLA ? C1_GV : C1_SZ;
            bf16_t* rp = proj + (row0 + t) * NP + h * 256 + 32 * part;
            u32x4 gw[4];
#pragma unroll
            for (int i = 0; i < 4; ++i) gw[i] = *(const u32x4*)(rp + GCOL + 8 * i);
            if constexpr (MIX == MIX_ML) {
                const float den = (tab[320 + t] + tab[384 + t]) + tab[192 + t] * tab[448 + t];
                const float idn = frcp(fmaxf(fabsf(den), tab[256 + t]));
#pragma unroll
                for (int i = 0; i < 4; ++i) { float gt[8]; unpack8(gw[i], gt);
#pragma unroll
                    for (int j = 0; j < 8; ++j) y[8 * i + j] = y[8 * i + j] * idn * fsigmoid(gt[j]); }
            }
            if constexpr (MIX == MIX_SSD) {
                const int hd = 4 * h + (part >> 1); const float dsk = P.in[I_SSDD][hd] * frcp(tab[256 + t * 4 + (part >> 1)]);
#pragma unroll
                for (int i = 0; i < 4; ++i) { const u32x4 xw = *(LAS u32x4*)(lds + OV + RSV * t + 2 * (32 * part + 8 * i)); float t8[8], gt[8]; unpack8(xw, t8); unpack8(gw[i], gt);
#pragma unroll
                    for (int j = 0; j < 8; ++j) y[8 * i + j] = (y[8 * i + j] + dsk * t8[j]) * fsilu(gt[j]); }
            }
            float mean = 0.f;
            if constexpr (MIX == MIX_RET || MIX == MIX_ML) {
                float s1 = 0.f;
#pragma unroll
                for (int j = 0; j < 32; ++j) s1 += y[j];
                s1 += __shfl_xor(s1, 1); s1 += __shfl_xor(s1, 2); s1 += __shfl_xor(s1, 4);
                mean = s1 * (1.f / 256.f);
            }
            float s2 = 0.f;
#pragma unroll
            for (int j = 0; j < 32; ++j) { y[j] -= mean; s2 += y[j] * y[j]; }
            s2 += __shfl_xor(s2, 1); s2 += __shfl_xor(s2, 2); s2 += __shfl_xor(s2, 4);
            const float rstd = __builtin_amdgcn_rsqf(s2 * (1.f / 256.f) + NORM_EPS);
#pragma unroll
            for (int i = 0; i < 4; ++i) {
                const f32x4 n0 = *(LAS f32x4*)(tab + TGN + 32 * part + 8 * i), n1 = *(LAS f32x4*)(tab + TGN + 32 * part + 8 * i + 4); float o[8];
#pragma unroll
                for (int j = 0; j < 4; ++j) { o[j] = y[8 * i + j] * rstd * n0[j]; o[4 + j] = y[8 * i + 4 + j] * rstd * n1[j]; }
                if constexpr (MIX == MIX_RET || MIX == MIX_GLA) { float gt[8]; unpack8(gw[i], gt);
#pragma unroll
                    for (int j = 0; j < 8; ++j) o[j] *= fsilu(gt[j]); }
                if (dostore) *(u32x4*)(rp + OCOL + 8 * i) = pack8(o);
            }
            if constexpr (MIX == MIX_ML) { if (tid == 0) tab[641] = tab[642]; }
        }
        if (ch + 1 < SEQ / 64) {
            if constexpr (MIX == MIX_ML) { if (w == 0) { const bf16_t* rp = proj + (row0 + 64 + lane) * NP; gpre0 = rp[C0_MI + h]; gpre1 = rp[C0_MF + h]; } }
            if constexpr (MIX == MIX_SSD) { if (w < 4) gpre0 = proj[(row0 + 64 + lane) * NP + C1_DT + 4 * h + w]; }
        }
        __syncthreads();
        tp_end(lds, 100 * MIX + 5);
    }
    tp_end(lds, 100 * MIX + 9);
}

#define XB_TMO      128
#define XB_XCNT(j)  (256  + 64 * (j))
#define XB_XSUB(j)  (1280 + 64 * (j))
#define XB_XGEN(j)  (2304 + 64 * (j))
#define XB_TOP      3328
#define XB_TOPGEN   3392
#define XCD_BAR_WORDS 3456
#define XB_SPIN_CAP (1u << 18)
__device__ __forceinline__ unsigned xb_ld(unsigned* p)              { return __hip_atomic_load(p, __ATOMIC_RELAXED, __HIP_MEMORY_SCOPE_AGENT); }
__device__ __forceinline__ unsigned xb_add(unsigned* p, unsigned v) { return __hip_atomic_fetch_add(p, v, __ATOMIC_RELAXED, __HIP_MEMORY_SCOPE_AGENT); }
__device__ __forceinline__ unsigned xb_xcc_id() { return (unsigned)__builtin_amdgcn_s_getreg((3 << 11) | 20) & 0xFu; }
#define XB_SPIN(cond, bar) do { unsigned _sp = 0; while (cond) { __builtin_amdgcn_s_sleep(1); \
    if ((++_sp & 255u) == 0u) { if (xb_ld(&(bar)[XB_TMO])) break; if (_sp > XB_SPIN_CAP) { atomicAdd(&(bar)[XB_TMO], 1u); break; } } } } while (0)
struct XcdBarrier { unsigned* bar; unsigned x; volatile LAS unsigned* st; };
__device__ __forceinline__ XcdBarrier xcd_barrier_post(unsigned* bar, volatile LAS unsigned* st) {
    XcdBarrier b; b.bar = bar; b.x = xb_xcc_id(); b.st = st;
    if (opaque_tid() == 0) (void)xb_add(&bar[XB_XCNT(b.x)], 1u);
    return b;
}
__device__ __forceinline__ void xcd_barrier_complete(unsigned* bar, unsigned x, unsigned& nloc, unsigned& nx) {
    const unsigned G = gridDim.x * gridDim.y * gridDim.z;
    unsigned sum, cnt, mine, sp = 0u;
    for (;;) {
        sum = 0u; cnt = 0u; mine = 0u;
#pragma unroll
        for (unsigned j = 0; j < 16; ++j) { const unsigned c = xb_ld(&bar[XB_XCNT(j)]); sum += c; cnt += (c > 0u) ? 1u : 0u; mine = (j == x) ? c : mine; }
        if (sum == G) break;
        __builtin_amdgcn_s_sleep(1);
        if ((++sp & 255u) == 0u) { if (xb_ld(&bar[XB_TMO])) break; if (sp > XB_SPIN_CAP) { atomicAdd(&bar[XB_TMO], 1u); break; } }
    }
    nloc = mine > 0u ? mine : 1u; nx = cnt > 0u ? cnt : 1u;
}
__device__ __forceinline__ void xcd_barrier(const XcdBarrier& b) {
    asm volatile("s_waitcnt vmcnt(0)" ::: "memory");
    __syncthreads();
    if (opaque_tid() == 0) {
        unsigned* bar = b.bar;
        __builtin_amdgcn_s_waitcnt(0);
        unsigned nloc = b.st[0], nx = b.st[1];
        if (nloc == 0u) { xcd_barrier_complete(bar, b.x, nloc, nx); b.st[0] = nloc; b.st[1] = nx; }
        const unsigned old = xb_add(&bar[XB_XSUB(b.x)], 1u);
        const unsigned gen = old / nloc;
        if (old + 1u == (gen + 1u) * nloc) {
            __builtin_amdgcn_fence(__ATOMIC_RELEASE, "agent");
            asm volatile("s_waitcnt vmcnt(0)" ::: "memory");
            const unsigned og = xb_add(&bar[XB_TOP], 1u);
            const unsigned tg = og / nx;
            if (og + 1u == (tg + 1u) * nx) xb_add(&bar[XB_TOPGEN], 1u);
            else XB_SPIN(xb_ld(&bar[XB_TOPGEN]) == tg, bar);
            __builtin_amdgcn_fence(__ATOMIC_ACQUIRE, "agent");
            xb_add(&bar[XB_XGEN(b.x)], 1u);
            asm volatile("s_waitcnt vmcnt(0)" ::: "memory");
        } else {
            XB_SPIN(xb_ld(&bar[XB_XGEN(b.x)]) == gen, bar);
            __builtin_amdgcn_fence(__ATOMIC_ACQUIRE, "agent");
            asm volatile("s_waitcnt vmcnt(0)" ::: "memory");
        }
    }
    __syncthreads();
}

constexpr int NTHREADS = 512;
constexpr int RING_BYTES = 131072;
constexpr int LDS_BYTES = 163840;
constexpr int LDS_BARW = LDS_BYTES - 16;
constexpr int NPHASES = 17;
#ifndef MK_N_LAUNCHES
#define MK_N_LAUNCHES 1
#endif

#ifndef REP_ROUTE
#define REP_ROUTE 1
#endif
#ifndef REP_CONV
#define REP_CONV 1
#endif
#ifndef REP_GIN
#define REP_GIN 1
#endif
#ifndef REP_GOUT
#define REP_GOUT 1
#endif
#ifndef REP_PERM
#define REP_PERM 1
#endif
#ifndef REP_MOEA
#define REP_MOEA 1
#endif
#ifndef REP_MOEB
#define REP_MOEB 1
#endif
#ifndef REP_LNF
#define REP_LNF 1
#endif
#ifndef MIXREP_RET
#define MIXREP_RET 1
#endif
#ifndef MIXREP_ML
#define MIXREP_ML 1
#endif
#ifndef MIXREP_GLA
#define MIXREP_GLA 1
#endif
#ifndef MIXREP_SSD
#define MIXREP_SSD 1
#endif
struct Args { Params P; int ph_lo, ph_hi; };
typedef __attribute__((address_space(4))) const unsigned char* kargp_t;
__device__ __forceinline__ const Params& kparams() {
    kargp_t p = (kargp_t)__builtin_amdgcn_kernarg_segment_ptr();
    asm volatile("" : "+s"(p));
    return *(const Params*)p;
}

__device__ __forceinline__ int kphase_lo() { kargp_t p = (kargp_t)__builtin_amdgcn_kernarg_segment_ptr(); asm volatile("" : "+s"(p)); return ((const Args*)p)->ph_lo; }
__device__ __forceinline__ int kphase_hi() { kargp_t p = (kargp_t)__builtin_amdgcn_kernarg_segment_ptr(); asm volatile("" : "+s"(p)); return ((const Args*)p)->ph_hi; }
__device__ __forceinline__ void grid_barrier(LAS unsigned char* lds) {
    XcdBarrier b; b.bar = (unsigned*)(kparams().ws + WS_CTL) + CW_BAR; b.x = xb_xcc_id(); b.st = (volatile LAS unsigned*)(lds + LDS_BARW);
    tp_begin(lds, 900); xcd_barrier(b); tp_end(lds, 900);
}
template <int LAYER>
__device__ __forceinline__ void layer_phases(LAS unsigned char* lds) {
#define IN(k) (kphase_lo() <= (k) && (k) < kphase_hi())
#define SEAM(k) do { if (IN(k) && IN((k) + 1)) grid_barrier(lds); } while (0)
    constexpr int PB = 1 + 8 * LAYER;
    const int bid = blockIdx.x, nb = gridDim.x;
    if (IN(PB + 0)) {
        const Params& P = kparams();
        pg8::EpiStore E{(bf16_t*)(P.ws + WS_BIG), NP};
        constexpr unsigned M8 = LAYER ? INPROJ_FP8MASK1 : INPROJ_FP8MASK0, M16 = ALLTILES & ~M8;
        for (int rep = 0; rep < REP_GIN; ++rep) {
            if constexpr (M16 != 0u) {
                pg8::SchedCols S; S.A = (const char*)(P.out + OUT_H); S.B = (const char*)(P.ws + (LAYER ? WS_WIN1 : WS_WIN0)); S.lda = D; S.ldb = D; S.nM = T / 256; S.nN = __builtin_popcount(M16); S.G = nb; S.c = bid; S.mask = M16;
                pg8::gemm_phase(lds, S, E, D, D, D);
            }
            if constexpr (M8 != 0u) {
                pg8::SchedCols S; S.A = (const char*)(P.ws + WS_H8); S.B = (const char*)(P.ws + (LAYER ? WS_WIN8_1 : WS_WIN8_0)); S.lda = D / 2; S.ldb = D / 2; S.nM = T / 256; S.nN = __builtin_popcount(M8); S.G = nb; S.c = bid; S.mask = M8;
                pg8::gemm_phase<pg8::EpiStore, pg8::SchedCols, true, 0x7c7c7c7c, 0x77777777>(lds, S, E, D / 2, D / 2, D / 2);
            }
        }
    }
    SEAM(PB + 0);
    if (IN(PB + 1)) {
        const Params& P = kparams();
        for (int u = bid; u < 256; u += nb) {
            const int b = (u & 127) >> 2, h = u & 3;
            if (LAYER == 0) { if (u < 128) { for (int rep = 0; rep < MIXREP_RET; ++rep) { mixer_unit<MIX_RET>(P, b, h, lds, rep == MIXREP_RET - 1); __syncthreads(); }
                                               convert_moe(P, lds, u, 128); }
                              else { for (int rep = 0; rep < MIXREP_ML; ++rep) { mixer_unit<MIX_ML>(P, b, h, lds, rep == MIXREP_ML - 1); __syncthreads(); } } }
            else { if (u < 128) { for (int rep = 0; rep < MIXREP_GLA; ++rep) { mixer_unit<MIX_GLA>(P, b, h, lds, rep == MIXREP_GLA - 1); __syncthreads(); } }
                   else { for (int rep = 0; rep < MIXREP_SSD; ++rep) { mixer_unit<MIX_SSD>(P, b, h, lds, rep == MIXREP_SSD - 1); __syncthreads(); } } }
        }
    }
    SEAM(PB + 1);
    if (IN(PB + 2)) {
        const Params& P = kparams();
        pg8::SchedPlain S; S.A = (const char*)(P.ws + WS_BIG) + YOFF * 2; S.B = (const char*)(P.ws + (LAYER ? WS_WOUT1 : WS_WOUT0)); S.lda = NP; S.ldb = 2048; S.nM = T / 256; S.nN = 4; S.G = nb; S.c = bid;
        pg8::EpiResid E{(bf16_t*)(P.out + OUT_PRE1), (const bf16_t*)(P.out + OUT_H)};
        for (int rep = 0; rep < REP_GOUT; ++rep) pg8::gemm_phase(lds, S, E, 2048, NP, 2048);
    }
    SEAM(PB + 2);
    if (IN(PB + 3)) for (int rep = 0; rep < REP_ROUTE; ++rep) { phase_route(kparams(), LAYER, lds, bid, nb, 32 * (REP_ROUTE - 1 - rep)); __syncthreads(); }
    SEAM(PB + 3);
    if (IN(PB + 4)) for (int rep = 0; rep < REP_PERM; ++rep) phase_permute(kparams(), LAYER, lds, bid, nb);
    SEAM(PB + 4);
    if (IN(PB + 5)) {
        const Params& P = kparams();
        const int* tilecls = (const int*)(P.ws + WS_TILECLS);
        if constexpr (MOE_FP8(LAYER) && MOEA_FP8) {
            pg8::SchedMoeA<true> S; S.A = (const char*)(P.ws + WS_BIG + BIG_HS8); S.Wgu = (const char*)(P.ws + WS_WGU) + (size_t)LAYER * 16 * 2097152; S.tilecls = tilecls; S.nM = __builtin_amdgcn_readfirstlane(tilecls[0]); S.G = nb; S.c = bid;
            pg8::EpiSwiglu8 E{P.ws + WS_BIG + BIG_H, (const float*)(P.ws + WS_ROWGATE)};
            for (int rep = 0; rep < REP_MOEA; ++rep) pg8::gemm_phase<pg8::EpiSwiglu8, pg8::SchedMoeA<true>, true, 0x7c7c7c7c, 0x77777777>(lds, S, E, D / 2, D / 2, D / 2);
        } else if constexpr (MOE_FP8(LAYER)) {
            pg8::SchedMoeA<false> S; S.A = (const char*)(P.ws + WS_BIG + BIG_HS); S.Wgu = (const char*)(P.ws + WS_WGU) + (size_t)LAYER * 16 * 2097152; S.tilecls = tilecls; S.nM = __builtin_amdgcn_readfirstlane(tilecls[0]); S.G = nb; S.c = bid;
            pg8::EpiSwiglu8 E{P.ws + WS_BIG + BIG_H, (const float*)(P.ws + WS_ROWGATE)};
            for (int rep = 0; rep < REP_MOEA; ++rep) pg8::gemm_phase(lds, S, E, D, D, D);
        } else {
            pg8::SchedMoeA<false> S; S.A = (const char*)(P.ws + WS_BIG + BIG_HS); S.Wgu = (const char*)(P.ws + WS_WGU) + (size_t)LAYER * 16 * 2097152; S.tilecls = tilecls; S.nM = __builtin_amdgcn_readfirstlane(tilecls[0]); S.G = nb; S.c = bid;
            pg8::EpiSwiglu E{(bf16_t*)(P.ws + WS_BIG + BIG_H), (const float*)(P.ws + WS_ROWGATE)};
            for (int rep = 0; rep < REP_MOEA; ++rep) pg8::gemm_phase(lds, S, E, D, D, D);
        }
    }
    SEAM(PB + 5);
    if (IN(PB + 6)) {
        const Params& P = kparams();
        const int* tilecls = (const int*)(P.ws + WS_TILECLS);
        pg8::EpiResid E{(bf16_t*)(P.ws + WS_BIG + BIG_PRE2), (const bf16_t*)(P.ws + WS_BIG + BIG_HS)};
        if constexpr (MOE_FP8(LAYER)) {
            pg8::SchedMoeB<true> S; S.A = (const char*)(P.ws + WS_BIG + BIG_H); S.Wd = (const char*)(P.ws + WS_WD) + (size_t)LAYER * 16 * 1048576; S.tilecls = tilecls; S.nM = __builtin_amdgcn_readfirstlane(tilecls[0]); S.G = nb; S.c = bid;
            for (int rep = 0; rep < REP_MOEB; ++rep) pg8::gemm_phase<pg8::EpiResid, pg8::SchedMoeB<true>, true, 0x7c7c7c7c, 0x77777777>(lds, S, E, D / 2, D / 2, 256);
        } else {
            pg8::SchedMoeB<false> S; S.A = (const char*)(P.ws + WS_BIG + BIG_H); S.Wd = (const char*)(P.ws + WS_WD) + (size_t)LAYER * 16 * 1048576; S.tilecls = tilecls; S.nM = __builtin_amdgcn_readfirstlane(tilecls[0]); S.G = nb; S.c = bid;
            for (int rep = 0; rep < REP_MOEB; ++rep) pg8::gemm_phase(lds, S, E, D, D, 512);
        }
    }
    SEAM(PB + 6);
    if (IN(PB + 7)) for (int rep = 0; rep < REP_LNF; ++rep) phase_lnffn(kparams(), LAYER, bid, nb);
    if (LAYER == 0) SEAM(PB + 7);
#undef IN
#undef SEAM
}

__global__ void __launch_bounds__(NTHREADS, 2) mega_fwd(Args a) {
    LAS unsigned char* lds = (LAS unsigned char*)g_lds;
    if (threadIdx.x < 4) ((LAS unsigned*)(lds + LDS_BARW))[threadIdx.x] = 0u;
    if (TPROBE_ID != 0 && threadIdx.x < 4) ((LAS unsigned*)(lds + LDS_TPROBE))[threadIdx.x] = 0u;
    if ((threadIdx.x & 63) == 0) *(LAS int*)(lds + LDS_WIDTAB + 4 * hw_wave_key()) = (int)(threadIdx.x >> 6);
    __syncthreads();
    if (a.ph_hi - a.ph_lo > 1) (void)xcd_barrier_post((unsigned*)(kparams().ws + WS_CTL) + CW_BAR, (volatile LAS unsigned*)(lds + LDS_BARW));
    if (kphase_lo() <= 0 && 0 < kphase_hi()) { for (int rep = 0; rep < REP_CONV; ++rep) phase_convert(kparams(), lds, blockIdx.x, gridDim.x); if (1 < kphase_hi()) grid_barrier(lds); }
    layer_phases<0>(lds);
    layer_phases<1>(lds);
    if (TPROBE_ID != 0 && blockIdx.x == TPROBE_BLOCK && opaque_tid() == 0) {
        const unsigned long long need = ((LAS unsigned long long*)(lds + LDS_TPROBE))[0] * TPROBE_MULT, t0 = wall_clock64();
        while (wall_clock64() - t0 < need) __builtin_amdgcn_s_sleep(8);
    }
}

extern "C" void kernel_launch(void* const* d_in, const int* in_sizes, int n_in, void* d_out, int out_size, void* d_ws, size_t ws_size, hipStream_t stream) {
    static int grid = 0;
    if (!grid) {
        if (n_in != 30 || ws_size < WS_END || out_size != T * D) { fprintf(stderr, "kernel_launch: unexpected shapes n_in %d ws %zu out %d\n", n_in, ws_size, out_size); grid = -1; return; }
        int dev = 0, cus = 0, per_cu = 0;
        if (hipGetDevice(&dev) != hipSuccess || hipDeviceGetAttribute(&cus, hipDeviceAttributeMultiprocessorCount, dev) != hipSuccess) { grid = -1; return; }
        if (hipFuncSetAttribute((const void*)mega_fwd, hipFuncAttributeMaxDynamicSharedMemorySize, LDS_BYTES) != hipSuccess) { fprintf(stderr, "kernel_launch: hipFuncSetAttribute failed\n"); grid = -1; return; }
        if (hipOccupancyMaxActiveBlocksPerMultiprocessor(&per_cu, (const void*)mega_fwd, NTHREADS, LDS_BYTES) != hipSuccess || per_cu < 1)
            fprintf(stderr, "kernel_launch: note: occupancy query reports %d workgroups per CU\n", per_cu);
        grid = cus > 0 ? cus : 256;
    }
    if (grid < 0) return;
    Args a{};
    for (int i = 0; i < 30; ++i) a.P.in[i] = (const float*)d_in[i];
    a.P.out = (unsigned char*)d_out; a.P.ws = (unsigned char*)d_ws;
    (void)hipMemsetAsync((char*)d_ws + WS_CTL, 0, CTL_BYTES, stream);
    constexpr int NL = MK_N_LAUNCHES;
    if (NL == 1) { a.ph_lo = 0; a.ph_hi = NPHASES; hipLaunchKernelGGL(mega_fwd, dim3(grid), dim3(NTHREADS), LDS_BYTES, stream, a); }
    else for (int p = 0; p < NPHASES; ++p) { a.ph_lo = p; a.ph_hi = p + 1; hipLaunchKernelGGL(mega_fwd, dim3(grid), dim3(NTHREADS), LDS_BYTES, stream, a); }
}
```

```cpp
#include <hip/hip_runtime.h>
#include <cstdio>
#include <cstdint>

#ifndef MIX_LREP
#define MIX_LREP 1
#endif
#ifndef MIX_SREP
#define MIX_SREP 1
#endif
#ifndef MIX_EREP
#define MIX_EREP 1
#endif
#define GAS __attribute__((address_space(1)))
#define LAS __attribute__((address_space(3)))
typedef unsigned short bf16_t;
typedef short bf16x8 __attribute__((ext_vector_type(8)));
typedef float f32x4 __attribute__((ext_vector_type(4)));
typedef unsigned u32x4 __attribute__((ext_vector_type(4)));

constexpr int BATCH = 32, SEQ = 2048, T = BATCH * SEQ, D = 1024;
constexpr int NP = 6400;
constexpr int YOFF = 1024;
constexpr int NCLS = 24, MAXTILES = 280;
constexpr float LN_EPS = 1e-5f, NORM_EPS = 1e-6f;
constexpr float ALPHA = 1.41421356237f;
constexpr int NTHREADS_C = 512;

constexpr int C0_RQ = 0, C0_RK = 512, C0_RV = 1024, C0_MV = 2048, C0_RG = 3072, C0_MQ = 4096, C0_MK = 4608, C0_MO = 5120, C0_MI = 6144, C0_MF = 6148;
constexpr int C1_GQ = 0, C1_GK = 512, C1_GV = 1024, C1_SZ = 2048, C1_GR = 3072, C1_XS = 4096, C1_BM = 5120, C1_CM = 5632, C1_GA = 6144, C1_DT = 6160;

constexpr size_t MiB = 1u << 20;
constexpr size_t WS_CTL = 0, CTL_BYTES = 1 * MiB;
constexpr size_t WS_WIN0 = 2 * MiB;
constexpr size_t WS_WIN1 = 15 * MiB;
constexpr size_t WS_WOUT0 = 28 * MiB;
constexpr size_t WS_WOUT1 = 32 * MiB;
constexpr size_t WS_WGU = 36 * MiB;
constexpr size_t WS_WD = 100 * MiB;
constexpr size_t WS_TOKCLS = 132 * MiB;
constexpr size_t WS_TOKPOS = WS_TOKCLS + (size_t)T * 4;
constexpr size_t WS_TOKDST = WS_TOKPOS + (size_t)T * 4;
constexpr size_t WS_TOKGATE = WS_TOKDST + (size_t)T * 4;
constexpr size_t WS_ROWGATE = WS_TOKGATE + (size_t)T * 8;
constexpr size_t WS_TILECLS = WS_ROWGATE + (size_t)MAXTILES * 256 * 8;
constexpr size_t WS_BIG = 136 * MiB;
constexpr size_t BIG_HS = 0, BIG_H = 160 * MiB, BIG_PRE2 = 320 * MiB, BIG_HS8 = 480 * MiB;
constexpr size_t WS_H8 = WS_BIG + (size_t)T * NP * 2;
constexpr size_t WS_WIN8_0 = WS_H8 + (size_t)T * D;
constexpr size_t WS_WIN8_1 = WS_WIN8_0 + (size_t)NP * D;
constexpr size_t WS_END = WS_WIN8_1 + (size_t)NP * D;
static_assert(WS_TILECLS + (MAXTILES + 8) * 4 <= WS_BIG, "ws map");
static_assert(WS_END <= 1024 * MiB, "ws map");
constexpr size_t OUT_H = 0, OUT_PRE1 = 128 * MiB;
constexpr int CW_CNT = 1024;
constexpr int CW_BAR = 4096;

__device__ __forceinline__ unsigned f2bf(float f) { unsigned u = __builtin_bit_cast(unsigned, f); return (u + 0x7fffu + ((u >> 16) & 1u)) >> 16; }
__device__ __forceinline__ unsigned pk2(float lo, float hi) { return f2bf(lo) | (f2bf(hi) << 16); }
__device__ __forceinline__ float bf2f(unsigned short b) { return __builtin_bit_cast(float, ((unsigned)b) << 16); }
__device__ __forceinline__ float bflo(unsigned w) { return __builtin_bit_cast(float, w << 16); }
__device__ __forceinline__ float bfhi(unsigned w) { return __builtin_bit_cast(float, w & 0xffff0000u); }
__device__ __forceinline__ float sigmoidf_(float x) { return 1.f / (1.f + __expf(-x)); }
__device__ __forceinline__ float siluf_(float x) { return x / (1.f + __expf(-x)); }
__device__ __forceinline__ float softplusf_(float x) { return x > 20.f ? x : log1pf(expf(x)); }
__device__ __forceinline__ float logsigmoidf_(float x) { return -softplusf_(-x); }
__device__ __forceinline__ float wave_sum(float v) {
#define WS_DPP(ctrl, rm) v += __builtin_bit_cast(float, __builtin_amdgcn_update_dpp(0, __builtin_bit_cast(int, v), ctrl, rm, 0xf, false))
    WS_DPP(0x111, 0xf); WS_DPP(0x112, 0xf); WS_DPP(0x114, 0xf); WS_DPP(0x118, 0xf); WS_DPP(0x142, 0xa); WS_DPP(0x143, 0xc);
#undef WS_DPP
    return __builtin_bit_cast(float, __builtin_amdgcn_readlane(__builtin_bit_cast(int, v), 63));
}
#define LDS_WAIT() asm volatile("s_waitcnt lgkmcnt(0)" ::: "memory")
__device__ __forceinline__ unsigned pk4_fp8(float a, float b, float c, float d) { int w = __builtin_amdgcn_cvt_pk_fp8_f32(a, b, 0, false); w = __builtin_amdgcn_cvt_pk_fp8_f32(c, d, w, true); return (unsigned)w; }
#ifndef MOE_FP8
#define MOE_FP8(layer) ((layer) >= 0)
#endif
#ifndef MOEA_FP8
#define MOEA_FP8 1
#endif
#ifndef INPROJ_FP8MASK0
#define INPROJ_FP8MASK0 0x00fcfffcu
#endif
#ifndef INPROJ_FP8MASK1
#define INPROJ_FP8MASK1 0x01ffffffu
#endif
constexpr unsigned ALLTILES = 0x01ffffffu;
#ifndef INPROJ_FP8
#define INPROJ_FP8(layer) ((layer) == 1)
#endif
constexpr float H8_SCALE = 8.f, W8_SCALE = 256.f;
#ifndef TPROBE_ID
#define TPROBE_ID 0
#endif
#ifndef TPROBE_BLOCK
#define TPROBE_BLOCK 128
#endif
#ifndef TPROBE_MULT
#define TPROBE_MULT 4
#endif
constexpr int LDS_TPROBE = 163840 - 48;
__device__ __forceinline__ int opaque_tid();
__device__ __forceinline__ void tp_begin(LAS unsigned char* lds, int id) { if (TPROBE_ID != 0 && TPROBE_ID == id && opaque_tid() == 0) ((LAS unsigned long long*)(lds + LDS_TPROBE))[1] = wall_clock64(); }
__device__ __forceinline__ void tp_end(LAS unsigned char* lds, int id) { if (TPROBE_ID != 0 && TPROBE_ID == id && opaque_tid() == 0) { LAS unsigned long long* p = (LAS unsigned long long*)(lds + LDS_TPROBE); p[0] += wall_clock64() - p[1]; } }
extern __shared__ __attribute__((aligned(16))) unsigned char g_lds[];
constexpr int LDS_WIDTAB = 163840 - 512;
__device__ __forceinline__ int hw_wave_key() { return (int)__builtin_amdgcn_s_getreg((5 << 11) | 4) & 63; }
__device__ __forceinline__ int opaque_tid() {
    const int wid = __builtin_amdgcn_readfirstlane(*(volatile LAS int*)((LAS unsigned char*)g_lds + LDS_WIDTAB + 4 * hw_wave_key()));
    int t = wid * 64 + (int)__builtin_amdgcn_mbcnt_hi(~0u, __builtin_amdgcn_mbcnt_lo(~0u, 0u)); asm volatile("" : "+v"(t)); return t; }

namespace pg8 {
constexpr int BM = 256, BK = 64, HALF = 128, HTB = HALF * BK * 2, STAGE_BYTES = 8 * HTB, NXCD = 8, WGM = 8;
__host__ __device__ __forceinline__ int lds_byte(int r, int c) { const int st = (r >> 4) * 2 + (c >> 5), rr = r & 15, cc = c & 31, ob = rr * 64 + cc * 2; return st * 1024 + (ob ^ (((ob >> 9) & 1) << 5)); }
__host__ __device__ __forceinline__ void stage_rc(int b, int& R, int& C) { const int st = b / 1024, sb = b % 1024, swz = sb ^ (((sb >> 9) & 1) << 5); R = (st >> 1) * 16 + swz / 64; C = (st & 1) * 32 + (swz % 64) / 2; }
__host__ __device__ __forceinline__ int perm32(int rho) { const int n = rho >> 4, i = rho & 15; return 8 * (i >> 2) + 4 * n + (i & 3); }

struct Unit { int pm, pn; unsigned a, b0, b1; };

__device__ __forceinline__ bool static_tile(int i, int G, int c, int nM, int nN, int& pm, int& pn) {
    const int nwg = nM * nN; const int L = i * G + c; if (L >= nwg) return false;
    int wgid = L; { const int q = nwg / NXCD, r = nwg % NXCD, xcd = wgid % NXCD, off = wgid / NXCD; wgid = (xcd < r ? xcd * (q + 1) : r * (q + 1) + (xcd - r) * q) + off; }
    const int nig = WGM * nN, gid = wgid / nig, fm = gid * WGM, gsz = (nM - fm) < WGM ? (nM - fm) : WGM;
    pm = fm + ((wgid % nig) % gsz); pn = (wgid % nig) / gsz; return true;
}
template <class Tp> __device__ __forceinline__ Tp* uniform_ptr(Tp* p) {
    const unsigned long long v = (unsigned long long)p;
    const unsigned lo = __builtin_amdgcn_readfirstlane((unsigned)v), hi = __builtin_amdgcn_readfirstlane((unsigned)(v >> 32));
    return (Tp*)(((unsigned long long)hi << 32) | lo); }
__device__ __forceinline__ unsigned cvt_pk_bf16(float lo, float hi) { unsigned r; asm volatile("v_cvt_pk_bf16_f32 %0, %1, %2" : "=v"(r) : "v"(lo), "v"(hi)); return r; }

typedef int i32x8 __attribute__((ext_vector_type(8)));
typedef int i32x4v __attribute__((ext_vector_type(4)));
__device__ __forceinline__ i32x8 cat16(const bf16x8& lo, const bf16x8& hi) { const i32x4v a = __builtin_bit_cast(i32x4v, lo), b = __builtin_bit_cast(i32x4v, hi); return (i32x8){a[0], a[1], a[2], a[3], b[0], b[1], b[2], b[3]}; }
template <class Epi, class Sched, bool FP8 = false, int SCA = 0x7f7f7f7f, int SCB = 0x7f7f7f7f>
__device__ __forceinline__ void gemm_phase(LAS unsigned char* lds, const Sched& S, const Epi& E, const int K, const int lda, const int ldb) {
    const int tid = opaque_tid(), wid = __builtin_amdgcn_readfirstlane(tid >> 6), lane = tid & 63, wr = wid >> 2, wc = wid & 3, fr = lane & 15, fq = lane >> 4;
    int nt = K / BK; asm volatile("" : "+s"(nt));
    constexpr int KS = Sched::KSPLIT;
    unsigned voffA0, voffB0;
    { int R, C; stage_rc(tid * 16, R, C); const int Rb = (R & ~31) + perm32(R & 31); voffA0 = (unsigned)(R * lda + C) * 2u; voffB0 = (unsigned)(Rb * ldb + C) * 2u; }
    const unsigned q64A = 64u * lda * 2u, q64B = 64u * ldb * 2u;
    const unsigned kstep = (unsigned)(BK * 2);
    const unsigned hstepA = (unsigned)HALF * lda * 2, hstepB = (unsigned)HALF * ldb * 2;
    const __amdgpu_buffer_rsrc_t rsA = __builtin_amdgcn_make_buffer_rsrc((void*)S.A, 0, 0xffffffff, 0x00020000), rsB = __builtin_amdgcn_make_buffer_rsrc((void*)S.bbase(), 0, 0xffffffff, 0x00020000);
    const unsigned ldsw = (unsigned)wid * 1024u;
    const int aoff = lds_byte(wr * 64 + fr, fq * 8), boff = lds_byte(wc * 32 + fr, fq * 8);
#define PG8_BP(u, kt) ((KS > 0 && (kt) >= KS) ? (u).b1 + (unsigned)((kt) - KS) * kstep : (u).b0 + (unsigned)(kt) * kstep)
#define PG8_SA(b, h) (((b) * 2 + (h)) * HTB)
#define PG8_SB(b, h) ((4 + (b) * 2 + (h)) * HTB)
#define PG8_STAGEA(bufoff, soff) do { _Pragma("unroll") for (int _i = 0; _i < 2; ++_i) \
        __builtin_amdgcn_raw_ptr_buffer_load_lds(rsA, (LAS void*)(lds + (bufoff) + ldsw + _i * 8192), 16, voffA0, (int)((soff) + _i * q64A), 0, 0); } while (0)
#define PG8_STAGEB(bufoff, soff) do { _Pragma("unroll") for (int _i = 0; _i < 2; ++_i) \
        __builtin_amdgcn_raw_ptr_buffer_load_lds(rsB, (LAS void*)(lds + (bufoff) + ldsw + _i * 8192), 16, voffB0, (int)((soff) + _i * q64B), 0, 0); } while (0)
#define PG8_LDA(dst, b, h) do { _Pragma("unroll") for (int m = 0; m < 4; ++m) _Pragma("unroll") for (int k = 0; k < 2; ++k) dst[m][k] = *(const LAS bf16x8*)(lds + PG8_SA(b, h) + aoff + m * 2048 + k * 1024); } while (0)
#define PG8_LDB(dst, b, h) do { _Pragma("unroll") for (int n = 0; n < 2; ++n) _Pragma("unroll") for (int k = 0; k < 2; ++k) dst[n][k] = *(const LAS bf16x8*)(lds + PG8_SB(b, h) + boff + n * 2048 + k * 1024); } while (0)
#define PG8_MMA(ai, bj, At, Bt) do { __builtin_amdgcn_s_setprio(1); _Pragma("unroll") for (int m = 0; m < 4; ++m) _Pragma("unroll") for (int n = 0; n < 2; ++n) { \
        if constexpr (FP8) acc[ai][bj][m][n] = __builtin_amdgcn_mfma_scale_f32_16x16x128_f8f6f4(cat16(Bt[n][0], Bt[n][1]), cat16(At[m][0], At[m][1]), acc[ai][bj][m][n], 0, 0, 1, ((SCB & 0xff) << 8) | (SCA & 0xff), 0, ((SCB & 0xff) << 8) | (SCA & 0xff)); \
        else { _Pragma("unroll") for (int k = 0; k < 2; ++k) acc[ai][bj][m][n] = __builtin_amdgcn_mfma_f32_16x16x32_bf16(Bt[n][k], At[m][k], acc[ai][bj][m][n], 0, 0, 0); } } \
        __builtin_amdgcn_s_setprio(0); } while (0)
#define PG8_WAIT_V(n) asm volatile("s_waitcnt vmcnt(" #n ")" ::: "memory")
#define PG8_WAIT_L(n) asm volatile("s_waitcnt lgkmcnt(" #n ")" ::: "memory")
#define PG8_BAR __builtin_amdgcn_s_barrier()
#define PG8_SCHED __builtin_amdgcn_sched_barrier(0)
    Unit cur, nxt; int ui = 0;
    if (!S.next(0, cur)) return;
    f32x4 acc[2][2][4][2];
#pragma unroll
    for (int a = 0; a < 2; ++a)
#pragma unroll
        for (int b = 0; b < 2; ++b)
#pragma unroll
            for (int m = 0; m < 4; ++m)
#pragma unroll
                for (int n = 0; n < 2; ++n) acc[a][b][m][n] = (f32x4){0.f, 0.f, 0.f, 0.f};
    bf16x8 At[4][2], B0[2][2], B1[2][2];
    unsigned cA = cur.a;
    E.prefetch(cur, tid);
    { const unsigned cB0 = PG8_BP(cur, 0), cB1 = PG8_BP(cur, 1);
    PG8_STAGEB(PG8_SB(0, 0), cB0); PG8_STAGEA(PG8_SA(0, 0), cA); PG8_STAGEB(PG8_SB(0, 1), cB0 + hstepB); PG8_STAGEA(PG8_SA(0, 1), cA + hstepA);
    if (wr == 1) PG8_BAR;
    PG8_WAIT_V(4); PG8_BAR;
    PG8_STAGEB(PG8_SB(1, 0), cB1); PG8_STAGEA(PG8_SA(1, 0), cA + kstep); PG8_STAGEB(PG8_SB(1, 1), cB1 + hstepB);
    PG8_WAIT_V(6); PG8_BAR; }
    for (;;) {
        const bool has_next = S.next(ui + 1, nxt);
        if (!has_next) nxt = cur;
        for (int t = 0; t < nt; t += 2) {
            const bool last = (t == nt - 2);
            const unsigned a1 = cA + (unsigned)(t + 1) * kstep;
            const unsigned a2 = last ? nxt.a : cA + (unsigned)(t + 2) * kstep;
            const unsigned b2 = last ? PG8_BP(nxt, 0) : PG8_BP(cur, t + 2);
            const unsigned a3 = a2 + kstep;
            const unsigned b3 = last ? PG8_BP(nxt, 1) : PG8_BP(cur, t + 3);
            PG8_LDB(B0, 0, 0); PG8_SCHED; PG8_LDA(At, 0, 0); PG8_STAGEA(PG8_SA(1, 1), a1 + hstepA);
            PG8_WAIT_L(8); PG8_BAR; PG8_WAIT_L(0); PG8_MMA(0, 0, At, B0); PG8_BAR; PG8_SCHED;
            PG8_LDB(B1, 0, 1); PG8_STAGEB(PG8_SB(0, 0), b2);
            PG8_BAR; PG8_WAIT_L(0); PG8_MMA(0, 1, At, B1); PG8_BAR;
            PG8_LDA(At, 0, 1); PG8_STAGEA(PG8_SA(0, 0), a2);
            PG8_BAR; PG8_WAIT_L(0); PG8_MMA(1, 0, At, B0); PG8_BAR; PG8_SCHED;
            PG8_STAGEB(PG8_SB(0, 1), b2 + hstepB);
            PG8_WAIT_V(6); PG8_BAR; PG8_MMA(1, 1, At, B1); PG8_BAR;
            PG8_LDB(B0, 1, 0); PG8_SCHED; PG8_LDA(At, 1, 0); PG8_STAGEA(PG8_SA(0, 1), a2 + hstepA);
            PG8_WAIT_L(8); PG8_BAR; PG8_WAIT_L(0); PG8_MMA(0, 0, At, B0); PG8_BAR; PG8_SCHED;
            PG8_LDB(B1, 1, 1); PG8_STAGEB(PG8_SB(1, 0), b3);
            PG8_BAR; PG8_WAIT_L(0); PG8_MMA(0, 1, At, B1); PG8_BAR;
            PG8_LDA(At, 1, 1); PG8_STAGEA(PG8_SA(1, 0), a3);
            PG8_BAR; PG8_WAIT_L(0); PG8_MMA(1, 0, At, B0); PG8_BAR; PG8_SCHED;
            PG8_STAGEB(PG8_SB(1, 1), b3 + hstepB);
            PG8_WAIT_V(6); PG8_BAR; PG8_MMA(1, 1, At, B1); PG8_BAR;
        }
        E(acc, cur, wr, wc, fr, fq);
        if (!has_next) break;
#pragma unroll
        for (int a = 0; a < 2; ++a)
#pragma unroll
            for (int b = 0; b < 2; ++b)
#pragma unroll
                for (int m = 0; m < 4; ++m)
#pragma unroll
                    for (int n = 0; n < 2; ++n) acc[a][b][m][n] = (f32x4){0.f, 0.f, 0.f, 0.f};
        cur = nxt; cA = cur.a; ++ui;
        E.prefetch(cur, tid);
    }
    PG8_WAIT_V(0);
    if (wr == 0) PG8_BAR;
    PG8_BAR;
#undef PG8_BP
#undef PG8_SA
#undef PG8_SB
#undef PG8_STAGEA
#undef PG8_STAGEB
#undef PG8_LDA
#undef PG8_LDB
#undef PG8_MMA
#undef PG8_WAIT_V
#undef PG8_WAIT_L
#undef PG8_BAR
#undef PG8_SCHED
}

struct SchedPlain {
    static constexpr int KSPLIT = 0;
    const char* A; const char* B; int lda, ldb, nM, nN, G, c;
    __device__ __forceinline__ const char* bbase() const { return B; }
    __device__ __forceinline__ bool next(int i, Unit& u) const {
        if (!static_tile(i, G, c, nM, nN, u.pm, u.pn)) return false;
        u.a = (unsigned)u.pm * BM * lda * 2; u.b0 = (unsigned)u.pn * BM * ldb * 2; u.b1 = u.b0; return true;
    }
};
struct SchedCols {
    static constexpr int KSPLIT = 0;
    const char* A; const char* B; int lda, ldb, nM, nN, G, c; unsigned mask;
    __device__ __forceinline__ const char* bbase() const { return B; }
    __device__ __forceinline__ bool next(int i, Unit& u) const {
        int pnj; if (!static_tile(i, G, c, nM, nN, u.pm, pnj)) return false;
        unsigned m = mask; for (int j = 0; j < pnj; ++j) m &= m - 1u;
        u.pn = __builtin_ctz(m);
        u.a = (unsigned)u.pm * BM * lda * 2; u.b0 = (unsigned)u.pn * BM * ldb * 2; u.b1 = u.b0; return true;
    }
};
__device__ __forceinline__ void cls_experts(int cls, int& e0, int& e1) {
    const int g = cls / 6, p = cls % 6;
    const int a = p < 3 ? 0 : (p < 5 ? 1 : 2);
    const int b = p < 3 ? p + 1 : (p < 5 ? p - 1 : 3);
    e0 = 4 * g + a; e1 = 4 * g + b;
}
template <bool FP8>
struct SchedMoeA {
    static constexpr int KSPLIT = 0;
    static constexpr int RB = FP8 ? 1024 : 2048;
    const char* A; const char* Wgu; const int* tilecls; int nM, G, c;
    __device__ __forceinline__ const char* bbase() const { return Wgu; }
    __device__ __forceinline__ bool next(int i, Unit& u) const {
        if (!static_tile(i, G, c, nM, 8, u.pm, u.pn)) return false;
        int e0, e1; cls_experts(__builtin_amdgcn_readfirstlane(tilecls[8 + u.pm]), e0, e1); const int e = (u.pn >> 2) ? e1 : e0;
        u.a = (unsigned)u.pm * BM * RB; u.b0 = (unsigned)e * 2097152u + (unsigned)(u.pn & 3) * 256 * RB; u.b1 = u.b0; return true;
    }
};
template <bool FP8>
struct SchedMoeB {
    static constexpr int KSPLIT = FP8 ? 4 : 8;
    static constexpr int RA = FP8 ? 1024 : 2048, RBB = FP8 ? 512 : 1024;
    const char* A; const char* Wd; const int* tilecls; int nM, G, c;
    __device__ __forceinline__ const char* bbase() const { return Wd; }
    __device__ __forceinline__ bool next(int i, Unit& u) const {
        if (!static_tile(i, G, c, nM, 4, u.pm, u.pn)) return false;
        int e0, e1; cls_experts(__builtin_amdgcn_readfirstlane(tilecls[8 + u.pm]), e0, e1);
        u.a = (unsigned)u.pm * BM * RA;
        u.b0 = (unsigned)e0 * 1048576u + (unsigned)u.pn * 256 * RBB; u.b1 = (unsigned)e1 * 1048576u + (unsigned)u.pn * 256 * RBB; return true;
    }
};

struct EpiStore {
    bf16_t* O; int ldc;
    __device__ __forceinline__ void prefetch(const Unit&, int) const {}
    __device__ __forceinline__ void operator()(const f32x4 (&acc)[2][2][4][2], const Unit& u, int wr, int wc, int fr, int fq) const {
        const int row0 = u.pm * BM + wr * 64 + fr, col0 = u.pn * BM + wc * 32 + 8 * fq;
#pragma unroll
        for (int ai = 0; ai < 2; ++ai)
#pragma unroll
            for (int m = 0; m < 4; ++m) { bf16_t* rowp = O + (size_t)(row0 + ai * HALF + m * 16) * ldc + col0;
#pragma unroll
                for (int bj = 0; bj < 2; ++bj) { const f32x4 v0 = acc[ai][bj][m][0], v1 = acc[ai][bj][m][1];
                    u32x4 w; w.x = cvt_pk_bf16(v0[0], v0[1]); w.y = cvt_pk_bf16(v0[2], v0[3]); w.z = cvt_pk_bf16(v1[0], v1[1]); w.w = cvt_pk_bf16(v1[2], v1[3]);
                    *(u32x4*)(rowp + bj * HALF) = w; } }
    }
};
struct EpiResid {
    bf16_t* O; const bf16_t* R;
    __device__ __forceinline__ void prefetch(const Unit& u, int tid) const {
        const bf16_t* p = R + (size_t)(u.pm * BM + (tid >> 1)) * 1024 + u.pn * BM + 128 * (tid & 1);
        asm volatile("s_mov_b32 m0, %2\n\ts_nop 0\n\tglobal_load_lds_dword %0, off\n\ts_mov_b32 m0, %3\n\ts_nop 0\n\tglobal_load_lds_dword %1, off"
                     :: "v"(p), "v"(p + 64), "s"(160768u), "s"(161024u) : "memory", "m0");
    }
    __device__ __forceinline__ void operator()(const f32x4 (&acc)[2][2][4][2], const Unit& u, int wr, int wc, int fr, int fq) const {
        const int row0 = u.pm * BM + wr * 64 + fr, col0 = u.pn * BM + wc * 32 + 8 * fq;
#pragma unroll
        for (int ai = 0; ai < 2; ++ai)
#pragma unroll
            for (int m = 0; m < 4; ++m) { const size_t off = (size_t)(row0 + ai * HALF + m * 16) * 1024 + col0;
#pragma unroll
                for (int bj = 0; bj < 2; ++bj) { const f32x4 v0 = acc[ai][bj][m][0], v1 = acc[ai][bj][m][1];
                    const u32x4 r = *(const u32x4*)(R + off + bj * HALF);
                    u32x4 w; w.x = cvt_pk_bf16(v0[0] + ALPHA * bflo(r.x), v0[1] + ALPHA * bfhi(r.x)); w.y = cvt_pk_bf16(v0[2] + ALPHA * bflo(r.y), v0[3] + ALPHA * bfhi(r.y));
                    w.z = cvt_pk_bf16(v1[0] + ALPHA * bflo(r.z), v1[1] + ALPHA * bfhi(r.z)); w.w = cvt_pk_bf16(v1[2] + ALPHA * bflo(r.w), v1[3] + ALPHA * bfhi(r.w));
                    *(u32x4*)(O + off + bj * HALF) = w; } }
    }
};
struct EpiSwiglu {
    bf16_t* H; const float* rowgate;
    __device__ __forceinline__ void prefetch(const Unit&, int) const {}
    __device__ __forceinline__ void operator()(const f32x4 (&acc)[2][2][4][2], const Unit& u, int wr, int wc, int fr, int fq) const {
        const int row0 = u.pm * BM + wr * 64 + fr, ke = u.pn >> 2, col0 = 512 * ke + 128 * (u.pn & 3) + wc * 32 + 8 * fq;
#pragma unroll
        for (int ai = 0; ai < 2; ++ai)
#pragma unroll
            for (int m = 0; m < 4; ++m) { const int row = row0 + ai * HALF + m * 16; const float gt = rowgate[(size_t)row * 2 + ke];
                const f32x4 g0 = acc[ai][0][m][0], g1 = acc[ai][0][m][1], u0 = acc[ai][1][m][0], u1 = acc[ai][1][m][1];
                float o[8];
#pragma unroll
                for (int j = 0; j < 4; ++j) { o[j] = siluf_(g0[j]) * u0[j] * gt; o[4 + j] = siluf_(g1[j]) * u1[j] * gt; }
                u32x4 w; w.x = cvt_pk_bf16(o[0], o[1]); w.y = cvt_pk_bf16(o[2], o[3]); w.z = cvt_pk_bf16(o[4], o[5]); w.w = cvt_pk_bf16(o[6], o[7]);
                *(u32x4*)(H + (size_t)row * 1024 + col0) = w; }
    }
};
struct EpiSwiglu8 {
    unsigned char* H; const float* rowgate;
    __device__ __forceinline__ void prefetch(const Unit&, int) const {}
    __device__ __forceinline__ void operator()(const f32x4 (&acc)[2][2][4][2], const Unit& u, int wr, int wc, int fr, int fq) const {
        typedef unsigned u32x2 __attribute__((ext_vector_type(2)));
        const int row0 = u.pm * BM + wr * 64 + fr, ke = u.pn >> 2, col0 = 512 * ke + 128 * (u.pn & 3) + wc * 32 + 8 * fq;
        unsigned char* const H = uniform_ptr(this->H); const float* const rowgate = uniform_ptr(this->rowgate);
#pragma unroll
        for (int ai = 0; ai < 2; ++ai)
#pragma unroll
            for (int m = 0; m < 4; ++m) { const int row = row0 + ai * HALF + m * 16; const float gt = rowgate[(size_t)row * 2 + ke] * 8.f;
                const f32x4 g0 = acc[ai][0][m][0], g1 = acc[ai][0][m][1], u0 = acc[ai][1][m][0], u1 = acc[ai][1][m][1];
                float o[8];
#pragma unroll
                for (int j = 0; j < 4; ++j) { o[j] = __builtin_amdgcn_fmed3f(g0[j] * __builtin_amdgcn_rcpf(1.f + __builtin_amdgcn_exp2f(-1.4426950408889634f * g0[j])) * u0[j] * gt, -440.f, 440.f);
                    o[4 + j] = __builtin_amdgcn_fmed3f(g1[j] * __builtin_amdgcn_rcpf(1.f + __builtin_amdgcn_exp2f(-1.4426950408889634f * g1[j])) * u1[j] * gt, -440.f, 440.f); }
                *(u32x2*)(H + (size_t)row * 1024 + col0) = (u32x2){pk4_fp8(o[0], o[1], o[2], o[3]), pk4_fp8(o[4], o[5], o[6], o[7])}; }
    }
};
}

struct Params {
    const float* in[30];
    unsigned char* out;
    unsigned char* ws;
};
enum { I_X = 0, I_POS, I_WINAB, I_RETG, I_MLCW, I_MLCB, I_MLBI, I_MLBF, I_MLG, I_WOUTAB, I_WINCD, I_GLAWA, I_GLABA, I_GLAG, I_SSDCW, I_SSDCB, I_SSDDTB, I_SSDALOG, I_SSDD, I_SSDG,
       I_WOUTCD, I_WR, I_BR, I_MOEG, I_MOEU, I_MOED, I_LNMG, I_LNMB, I_LNFG, I_LNFB };

template <class ColPtr>
__device__ __forceinline__ void tr_item(const ColPtr& cp, int ldw, bf16_t* WT, int ldt, int n0, int k0, LAS float* scr, int lane) {
    const float* p = cp(n0 + (lane & 31));
#pragma unroll 8
    for (int i = 0; i < 32; ++i) { const int kk = 2 * i + (lane >> 5); scr[kk * 33 + (lane & 31)] = p ? p[(size_t)(k0 + kk) * ldw] : 0.f; }
    LDS_WAIT();
    const int c = lane & 7;
#pragma unroll
    for (int j = 0; j < 4; ++j) { const int n = (lane >> 3) + 8 * j; const LAS float* s = scr + (8 * c) * 33 + n;
        u32x4 o; o.x = pk2(s[0 * 33], s[1 * 33]); o.y = pk2(s[2 * 33], s[3 * 33]); o.z = pk2(s[4 * 33], s[5 * 33]); o.w = pk2(s[6 * 33], s[7 * 33]);
        *(u32x4*)(WT + (size_t)(n0 + n) * ldt + k0 + 8 * c) = o; }
    LDS_WAIT();
}
template <class ColPtr>
__device__ __forceinline__ void tr_item_fp8(const ColPtr& cp, int ldw, unsigned char* WT, int ldt, int n0, int k0, float scale, LAS float* scr, int lane) {
    const float* p = cp(n0 + (lane & 31));
#pragma unroll 8
    for (int i = 0; i < 32; ++i) { const int kk = 2 * i + (lane >> 5); scr[kk * 33 + (lane & 31)] = p ? p[(size_t)(k0 + kk) * ldw] * scale : 0.f; }
    LDS_WAIT();
    const int c = lane & 7;
    typedef unsigned u32x2 __attribute__((ext_vector_type(2)));
#pragma unroll
    for (int j = 0; j < 4; ++j) { const int n = (lane >> 3) + 8 * j; const LAS float* s = scr + (8 * c) * 33 + n;
        *(u32x2*)(WT + (size_t)(n0 + n) * ldt + k0 + 8 * c) = (u32x2){pk4_fp8(s[0 * 33], s[1 * 33], s[2 * 33], s[3 * 33]), pk4_fp8(s[4 * 33], s[5 * 33], s[6 * 33], s[7 * 33])}; }
    LDS_WAIT();
}
__device__ __forceinline__ int map_ab(int n) {
    if (n < 2048) return n;
    if (n < 3072) return 4096 + (n - 2048);
    if (n < 4096) return 2048 + (n - 3072);
    if (n < 4608) return 3072 + (n - 4096);
    if (n < 5120) return 3584 + (n - 4608);
    if (n < 6152) return n;
    return -1;
}
__device__ __forceinline__ int map_cd(int n) {
    if (n < 2048) return n;
    if (n < 3072) return 3088 + (n - 2048);
    if (n < 4096) return 2048 + (n - 3072);
    if (n < 5120) return 4112 + (n - 4096);
    if (n < 5632) return 5136 + (n - 5120);
    if (n < 6144) return 5648 + (n - 5632);
    if (n < 6160) return 3072 + (n - 6144);
    if (n < 6176) return 6160 + (n - 6160);
    return -1;
}
template <bool FP8, class ColPtr>
__device__ __forceinline__ void tr_block(const ColPtr& cp, int ldw, void* WT, int ldt, int n0, int k0, float scale, LAS float* tile, int tid) {
    {   const int c4 = tid & 63, r0 = tid >> 6;
        const float* p = cp(n0 + 4 * c4);
        f32x4 v[8];
#pragma unroll
        for (int i = 0; i < 8; ++i) v[i] = p ? *(const f32x4*)(p + (size_t)(k0 + r0 + 8 * i) * ldw) : (f32x4){0.f, 0.f, 0.f, 0.f};
#pragma unroll
        for (int i = 0; i < 8; ++i) { LAS float* t = tile + (r0 + 8 * i) * 257 + 4 * c4; t[0] = v[i][0] * scale; t[1] = v[i][1] * scale; t[2] = v[i][2] * scale; t[3] = v[i][3] * scale; }
    }
    __syncthreads();
    {   const int kc = tid & 7, nr = tid >> 3;
#pragma unroll
        for (int j = 0; j < 4; ++j) { const int n = nr + 64 * j; const LAS float* t = tile + (8 * kc) * 257 + n;
            if constexpr (FP8) { typedef unsigned u32x2 __attribute__((ext_vector_type(2)));
                *(u32x2*)((unsigned char*)WT + (size_t)(n0 + n) * ldt + k0 + 8 * kc) = (u32x2){pk4_fp8(t[0], t[257], t[514], t[771]), pk4_fp8(t[1028], t[1285], t[1542], t[1799])}; }
            else { u32x4 o; o.x = pk2(t[0], t[257]); o.y = pk2(t[514], t[771]); o.z = pk2(t[1028], t[1285]); o.w = pk2(t[1542], t[1799]);
                *(u32x4*)((bf16_t*)WT + (size_t)(n0 + n) * ldt + k0 + 8 * kc) = o; } }
    }
    __syncthreads();
}
__device__ __forceinline__ void convert_moe(const Params& P, LAS unsigned char* lds, int bid, int nb) {
    const int tid = opaque_tid();
    LAS float* tile = (LAS float*)lds;
    unsigned char* ws = P.ws;
    constexpr int B_GU = (1024 / 256) * (1024 / 64);
    constexpr int B_DN = (1024 / 256) * (512 / 64);
    constexpr int B_IN = (NP / 256) * (D / 64);
    constexpr int B_OUT = (1024 / 256) * (2048 / 64);
#pragma unroll 1
    for (int it = bid; it < 32 * B_GU + 32 * B_DN + B_IN + 2 * B_OUT; it += nb) {
        int r = it;
        if (r < B_IN) { const int nbk = r / (D / 64), kb = r % (D / 64);
            const float* W = P.in[I_WINCD];
            auto cp = [&](int n) { const int sc = map_cd(n); return sc < 0 ? (const float*)nullptr : W + sc; };
            if ((INPROJ_FP8MASK1 >> nbk) & 1u) tr_block<true>(cp, 6176, ws + WS_WIN8_1, D, nbk * 256, kb * 64, W8_SCALE, tile, tid); else tr_block<false>(cp, 6176, ws + WS_WIN1, D, nbk * 256, kb * 64, 1.f, tile, tid);
            continue; }
        r -= B_IN;
        if (r < 2 * B_OUT) { const int l = r / B_OUT; r %= B_OUT; const int nbk = r / 32, kb = r % 32;
            const float* W = P.in[l ? I_WOUTCD : I_WOUTAB];
            tr_block<false>([&](int n) { return W + n; }, 1024, ws + (l ? WS_WOUT1 : WS_WOUT0), 2048, nbk * 256, kb * 64, 1.f, tile, tid);
            continue; }
        r -= 2 * B_OUT;
        if (r < 32 * B_GU) { const int le = r / B_GU; r %= B_GU; const int nbk = r / 16, kb = r % 16;
            const float* Wg = P.in[I_MOEG] + (size_t)le * 1024 * 512 + 128 * nbk; const float* Wu = P.in[I_MOEU] + (size_t)le * 1024 * 512 + 128 * nbk; const int n0 = nbk * 256;
            auto cp = [&](int n) { const int wdt = n - n0; return wdt < 128 ? Wg + wdt : Wu + (wdt - 128); };
            if (MOE_FP8(le >> 4) && MOEA_FP8) tr_block<true>(cp, 512, ws + WS_WGU + (size_t)le * 2097152, 1024, n0, kb * 64, W8_SCALE, tile, tid);
            else tr_block<false>(cp, 512, ws + WS_WGU + (size_t)le * 2097152, 1024, n0, kb * 64, 1.f, tile, tid);
            continue; }
        r -= 32 * B_GU;
        { const int le = r / B_DN; r %= B_DN; const int nbk = r / 8, kb = r % 8;
            const float* W = P.in[I_MOED] + (size_t)le * 512 * 1024;
            if (MOE_FP8(le >> 4)) tr_block<true>([&](int n) { return W + n; }, 1024, ws + WS_WD + (size_t)le * 1048576, 512, nbk * 256, kb * 64, W8_SCALE, tile, tid);
            else tr_block<false>([&](int n) { return W + n; }, 1024, ws + WS_WD + (size_t)le * 1048576, 512, nbk * 256, kb * 64, 1.f, tile, tid); }
    }
}
__device__ __forceinline__ void phase_convert(const Params& P, LAS unsigned char* lds, int bid, int nb) {
    const int tid = opaque_tid();
    LAS float* tile = (LAS float*)lds;
    unsigned char* ws = P.ws;
    constexpr int B_IN = (NP / 256) * (D / 64);
    tp_begin(lds, 910);
#pragma unroll 1
    for (int it = bid; it < B_IN; it += nb) {
        const int nbk = it / (D / 64), kb = it % (D / 64);
        const float* W = P.in[I_WINAB];
        auto cp = [&](int n) { const int sc = map_ab(n); return sc < 0 ? (const float*)nullptr : W + sc; };
        if ((INPROJ_FP8MASK0 >> nbk) & 1u) tr_block<true>(cp, 6152, ws + WS_WIN8_0, D, nbk * 256, kb * 64, W8_SCALE, tile, tid); else tr_block<false>(cp, 6152, ws + WS_WIN0, D, nbk * 256, kb * 64, 1.f, tile, tid);
    }
    const int nw = blockDim.x >> 6; (void)nw;
    asm volatile("s_waitcnt vmcnt(0)" ::: "memory"); tp_end(lds, 910); tp_begin(lds, 911);
    const float* x = P.in[I_X]; bf16_t* h = (bf16_t*)(P.out + OUT_H);
    const size_t n8 = (size_t)T * D / 8;
    const size_t stride = (size_t)nb * blockDim.x;
    for (size_t i0 = (size_t)bid * blockDim.x + tid; i0 < n8; i0 += 4 * stride) {
        f32x4 a[4], b[4];
#pragma unroll
        for (int u = 0; u < 4; ++u) { const size_t i = i0 + u * stride; if (i < n8) { a[u] = *(const f32x4*)(x + i * 8); b[u] = *(const f32x4*)(x + i * 8 + 4); } }
#pragma unroll
        for (int u = 0; u < 4; ++u) { const size_t i = i0 + u * stride; if (i < n8) {
            u32x4 o; o.x = pk2(a[u][0], a[u][1]); o.y = pk2(a[u][2], a[u][3]); o.z = pk2(b[u][0], b[u][1]); o.w = pk2(b[u][2], b[u][3]);
            *(u32x4*)(h + i * 8) = o;
            typedef unsigned u32x2 __attribute__((ext_vector_type(2)));
            *(u32x2*)(ws + WS_H8 + i * 8) = (u32x2){pk4_fp8(a[u][0] * H8_SCALE, a[u][1] * H8_SCALE, a[u][2] * H8_SCALE, a[u][3] * H8_SCALE), pk4_fp8(b[u][0] * H8_SCALE, b[u][1] * H8_SCALE, b[u][2] * H8_SCALE, b[u][3] * H8_SCALE)}; } }
    }
    asm volatile("s_waitcnt vmcnt(0)" ::: "memory"); tp_end(lds, 911);
}

__device__ __forceinline__ void load_row_bf16(const bf16_t* row, int lane, float (&v)[16]) {
#pragma unroll
    for (int j = 0; j < 2; ++j) { const u32x4 w = *(const u32x4*)(row + 8 * lane + 512 * j);
        v[8 * j + 0] = bflo(w.x); v[8 * j + 1] = bfhi(w.x); v[8 * j + 2] = bflo(w.y); v[8 * j + 3] = bfhi(w.y);
        v[8 * j + 4] = bflo(w.z); v[8 * j + 5] = bfhi(w.z); v[8 * j + 6] = bflo(w.w); v[8 * j + 7] = bfhi(w.w); }
}
__device__ __forceinline__ void ln_row(float (&v)[16], const float* g, const float* b, int lane) {
    float s = 0.f;
#pragma unroll
    for (int i = 0; i < 16; ++i) s += v[i];
    const float mean = wave_sum(s) * (1.f / D); float q = 0.f;
#pragma unroll
    for (int i = 0; i < 16; ++i) { v[i] -= mean; q += v[i] * v[i]; }
    const float rstd = rsqrtf(wave_sum(q) * (1.f / D) + LN_EPS);
#pragma unroll
    for (int j = 0; j < 2; ++j) {
        const f32x4 g0 = *(const f32x4*)(g + 8 * lane + 512 * j), g1 = *(const f32x4*)(g + 8 * lane + 512 * j + 4);
        const f32x4 b0 = *(const f32x4*)(b + 8 * lane + 512 * j), b1 = *(const f32x4*)(b + 8 * lane + 512 * j + 4);
#pragma unroll
        for (int i = 0; i < 4; ++i) { v[8 * j + i] = v[8 * j + i] * rstd * g0[i] + b0[i]; v[8 * j + 4 + i] = v[8 * j + 4 + i] * rstd * g1[i] + b1[i]; }
    }
}
__device__ __forceinline__ void load_gb(const float* g, const float* b, int lane, float (&gr)[16], float (&br)[16]) {
#pragma unroll
    for (int j = 0; j < 2; ++j) {
        const f32x4 g0 = *(const f32x4*)(g + 8 * lane + 512 * j), g1 = *(const f32x4*)(g + 8 * lane + 512 * j + 4);
        const f32x4 b0 = *(const f32x4*)(b + 8 * lane + 512 * j), b1 = *(const f32x4*)(b + 8 * lane + 512 * j + 4);
#pragma unroll
        for (int i = 0; i < 4; ++i) { gr[8 * j + i] = g0[i]; gr[8 * j + 4 + i] = g1[i]; br[8 * j + i] = b0[i]; br[8 * j + 4 + i] = b1[i]; }
    }
}
__device__ __forceinline__ void ln_row_r(float (&v)[16], const float (&gr)[16], const float (&br)[16]) {
    float s = 0.f;
#pragma unroll
    for (int i = 0; i < 16; ++i) s += v[i];
    const float mean = wave_sum(s) * (1.f / D); float q = 0.f;
#pragma unroll
    for (int i = 0; i < 16; ++i) { v[i] -= mean; q += v[i] * v[i]; }
    const float rstd = rsqrtf(wave_sum(q) * (1.f / D) + LN_EPS);
#pragma unroll
    for (int i = 0; i < 16; ++i) v[i] = v[i] * rstd * gr[i] + br[i];
}
__device__ __forceinline__ void store_row_bf16(bf16_t* row, int lane, const float (&v)[16]) {
#pragma unroll
    for (int j = 0; j < 2; ++j) { u32x4 o; o.x = pk2(v[8 * j + 0], v[8 * j + 1]); o.y = pk2(v[8 * j + 2], v[8 * j + 3]); o.z = pk2(v[8 * j + 4], v[8 * j + 5]); o.w = pk2(v[8 * j + 6], v[8 * j + 7]);
        *(u32x4*)(row + 8 * lane + 512 * j) = o; }
}

__device__ __forceinline__ void phase_route(const Params& P, int layer, LAS unsigned char* lds, int bid, int nb, int cntoff) {
    const int tid = opaque_tid(), lane = tid & 63, wave = tid >> 6;
    LAS unsigned char* Bhi = lds; LAS unsigned char* Blo = lds + 32768;
    LAS float* cd = (LAS float*)(lds + 65536);
    LAS float* part = cd + 32;
    LAS int* lcnt = (LAS int*)(part + 1024);
    LAS int* lbase = lcnt + 32; LAS int* rcls = lbase + 32; LAS int* rpos = rcls + 256;
    const bf16_t* pre1 = (const bf16_t*)(P.out + OUT_PRE1);
    const float* g = P.in[I_LNMG] + layer * D; const float* b = P.in[I_LNMB] + layer * D;
    const float* Wr = P.in[I_WR]; const float* br = P.in[I_BR];
    int* tokcls = (int*)(P.ws + WS_TOKCLS); int* tokpos = (int*)(P.ws + WS_TOKPOS); float* tokgate = (float*)(P.ws + WS_TOKGATE);
    unsigned* gcnt = (unsigned*)(P.ws + WS_CTL) + CW_CNT + 64 * layer + cntoff;
#pragma unroll 1
    for (int idx = tid; idx < 2048; idx += NTHREADS_C) {
        const int s = idx >> 6, l = idx & 63, e = l & 15, k0 = 32 * s + 8 * (l >> 4);
        unsigned hi[4], lo[4];
#pragma unroll
        for (int j = 0; j < 4; ++j) {
            const float w0 = g[k0 + 2 * j] * Wr[(k0 + 2 * j) * 16 + e], w1 = g[k0 + 2 * j + 1] * Wr[(k0 + 2 * j + 1) * 16 + e];
            const unsigned h0 = f2bf(w0), h1 = f2bf(w1);
            hi[j] = h0 | (h1 << 16); lo[j] = pk2(w0 - bf2f((unsigned short)h0), w1 - bf2f((unsigned short)h1)); }
        *(LAS u32x4*)(Bhi + idx * 16) = (u32x4){hi[0], hi[1], hi[2], hi[3]};
        *(LAS u32x4*)(Blo + idx * 16) = (u32x4){lo[0], lo[1], lo[2], lo[3]};
    }
    { const int e = tid & 15, pt = tid >> 4; float cs = 0.f, ds = 0.f;
#pragma unroll 4
      for (int kk = 0; kk < 32; ++kk) { const int k = pt * 32 + kk; const float w = Wr[k * 16 + e]; cs += g[k] * w; ds += b[k] * w; }
      part[pt * 32 + e] = cs; part[pt * 32 + 16 + e] = ds; }
    __syncthreads();
    if (tid < 32) { float sacc = 0.f;
#pragma unroll 4
        for (int pt = 0; pt < 32; ++pt) sacc += part[pt * 32 + tid];
        cd[tid] = sacc; }
    __syncthreads();
    const int e = lane & 15, q = lane >> 4;
    const float ce = cd[e], de = cd[16 + e], bre = br[e];
    for (int r0 = bid * 256; r0 < T; r0 += nb * 256) {
        if (tid < 32) lcnt[tid] = 0;
        __syncthreads();
#pragma unroll 1
        for (int tile = 0; tile < 2; ++tile) {
            const int tr0 = wave * 32 + tile * 16;
            const bf16_t* arow = pre1 + (size_t)(r0 + tr0 + e) * D + 8 * q;
            f32x4 acc = (f32x4){0.f, 0.f, 0.f, 0.f}; float s1 = 0.f, s2 = 0.f;
#pragma unroll 1
            for (int s0 = 0; s0 < 32; s0 += 8) {
                u32x4 a[8];
#pragma unroll
                for (int u = 0; u < 8; ++u) a[u] = *(const u32x4*)(arow + 32 * (s0 + u));
#pragma unroll
                for (int u = 0; u < 8; ++u) {
                    const bf16x8 bh = *(const LAS bf16x8*)(Bhi + ((s0 + u) * 64 + lane) * 16), bl = *(const LAS bf16x8*)(Blo + ((s0 + u) * 64 + lane) * 16);
                    const bf16x8 af = __builtin_bit_cast(bf16x8, a[u]);
                    acc = __builtin_amdgcn_mfma_f32_16x16x32_bf16(af, bh, acc, 0, 0, 0);
                    acc = __builtin_amdgcn_mfma_f32_16x16x32_bf16(af, bl, acc, 0, 0, 0);
                    const float x0 = bflo(a[u].x), x1 = bfhi(a[u].x), x2 = bflo(a[u].y), x3 = bfhi(a[u].y), x4 = bflo(a[u].z), x5 = bfhi(a[u].z), x6 = bflo(a[u].w), x7 = bfhi(a[u].w);
                    s1 += ((x0 + x1) + (x2 + x3)) + ((x4 + x5) + (x6 + x7));
                    s2 += ((x0 * x0 + x1 * x1) + (x2 * x2 + x3 * x3)) + ((x4 * x4 + x5 * x5) + (x6 * x6 + x7 * x7));
                }
            }
            s1 += __shfl_xor(s1, 16); s1 += __shfl_xor(s1, 32); s2 += __shfl_xor(s2, 16); s2 += __shfl_xor(s2, 32);
            const float mean = s1 * (1.f / D); const float rstd = rsqrtf(fmaxf(s2 * (1.f / D) - mean * mean, 0.f) + LN_EPS);
#pragma unroll
            for (int r = 0; r < 4; ++r) {
                const int R = 4 * q + r;
                const float mr = __shfl(mean, R), rr = __shfl(rstd, R);
                const float lg = rr * (acc[r] - mr * ce) + de;
                float mx = lg;
#pragma unroll
                for (int o = 1; o < 16; o <<= 1) mx = fmaxf(mx, __shfl_xor(mx, o));
                float p = expf(lg - mx), sum = p;
#pragma unroll
                for (int o = 1; o < 16; o <<= 1) sum += __shfl_xor(sum, o);
                p = p / sum;
                const float sel = p + bre;
                int rank = 0;
#pragma unroll
                for (int o = 1; o < 4; ++o) { const float so = __shfl_xor(sel, o); const int eo = e ^ o; rank += (so > sel || (so == sel && eo < e)) ? 1 : 0; }
                float gs = rank < 2 ? sel : 0.f;
                gs += __shfl_xor(gs, 1); gs += __shfl_xor(gs, 2);
                int gi = e >> 2;
#pragma unroll
                for (int o = 4; o < 16; o <<= 1) { const float go = __shfl_xor(gs, o); const int io = __shfl_xor(gi, o); if (go > gs || (go == gs && io < gi)) { gs = go; gi = io; } }
                const bool chosen = ((e >> 2) == gi) && rank < 2;
                const unsigned long long bm = __ballot(chosen);
                const unsigned m4 = (unsigned)(bm >> (16 * q + 4 * gi)) & 0xFu;
                const int ea = __ffs((int)m4) - 1, eb = 31 - __clz((int)m4);
                const int pidx = ea == 0 ? eb - 1 : (ea == 1 ? eb + 1 : 5);
                const float pa = __shfl(p, 16 * q + 4 * gi + ea), pb = __shfl(p, 16 * q + 4 * gi + eb);
                if (e == r) { const int cls = gi * 6 + pidx; const int rl = tr0 + R; const int lp = atomicAdd((int*)&lcnt[cls], 1); rcls[rl] = cls; rpos[rl] = lp;
                    const float inv = 1.f / (pa + pb); const size_t t = (size_t)(r0 + rl); tokgate[t * 2] = pa * inv; tokgate[t * 2 + 1] = pb * inv; }
            }
        }
        __syncthreads();
        if (tid < NCLS) lbase[tid] = (int)atomicAdd(&gcnt[tid], (unsigned)lcnt[tid]);
        __syncthreads();
        if (tid < 256) { const int t = r0 + tid; const int c = rcls[tid]; tokcls[t] = c; tokpos[t] = lbase[c] + rpos[tid]; }
        __syncthreads();
    }
}
__device__ __forceinline__ void phase_permute(const Params& P, int layer, LAS unsigned char* lds, int bid, int nb) {
    const int tid = opaque_tid(), lane = tid & 63, wave = tid >> 6, nw = blockDim.x >> 6;
    LAS int* off = (LAS int*)lds;
    const unsigned* gcnt = (const unsigned*)(P.ws + WS_CTL) + CW_CNT + 64 * layer;
    int* tilecls = (int*)(P.ws + WS_TILECLS);
    if (tid == 0) { int o = 0; for (int c = 0; c < NCLS; ++c) { off[c] = o * 256; const int nt = ((int)gcnt[c] + 255) >> 8;
            if (bid == 0) for (int i = 0; i < nt; ++i) tilecls[8 + o + i] = c;
            o += nt; }
        if (bid == 0) tilecls[0] = o; }
    __syncthreads();
    const bf16_t* pre1 = (const bf16_t*)(P.out + OUT_PRE1); bf16_t* hs = (bf16_t*)(P.ws + WS_BIG + BIG_HS);
    const float* g = P.in[I_LNMG] + layer * D; const float* b = P.in[I_LNMB] + layer * D;
    const int* tokcls = (const int*)(P.ws + WS_TOKCLS); const int* tokpos = (const int*)(P.ws + WS_TOKPOS); int* tokdst = (int*)(P.ws + WS_TOKDST);
    const float* tokgate = (const float*)(P.ws + WS_TOKGATE); float* rowgate = (float*)(P.ws + WS_ROWGATE);
    float gr[16], br[16]; load_gb(g, b, lane, gr, br);
    for (int t0 = bid * nw + wave; t0 < T; t0 += 2 * nb * nw) {
        const int t1 = t0 + nb * nw; const bool has1 = t1 < T;
        float v0[16], v1[16];
        load_row_bf16(pre1 + (size_t)t0 * D, lane, v0);
        if (has1) load_row_bf16(pre1 + (size_t)t1 * D, lane, v1);
        const int dst0 = off[tokcls[t0]] + tokpos[t0]; const int dst1 = has1 ? off[tokcls[t1]] + tokpos[t1] : 0;
#pragma unroll
        for (int rr = 0; rr < 2; ++rr) {
            if (rr == 1 && !has1) break;
            float (&v)[16] = rr ? v1 : v0; const int t = rr ? t1 : t0, dst = rr ? dst1 : dst0;
            ln_row_r(v, gr, br);
            store_row_bf16(hs + (size_t)dst * D, lane, v);
            if (MOE_FP8(layer) && MOEA_FP8) { typedef unsigned u32x2 __attribute__((ext_vector_type(2)));
#pragma unroll
                for (int j = 0; j < 2; ++j) *(u32x2*)(P.ws + WS_BIG + BIG_HS8 + (size_t)dst * D + 8 * lane + 512 * j) = (u32x2){pk4_fp8(v[8 * j] * H8_SCALE, v[8 * j + 1] * H8_SCALE, v[8 * j + 2] * H8_SCALE, v[8 * j + 3] * H8_SCALE), pk4_fp8(v[8 * j + 4] * H8_SCALE, v[8 * j + 5] * H8_SCALE, v[8 * j + 6] * H8_SCALE, v[8 * j + 7] * H8_SCALE)}; }
            if (lane == 0) { tokdst[t] = dst; rowgate[(size_t)dst * 2] = tokgate[(size_t)t * 2]; rowgate[(size_t)dst * 2 + 1] = tokgate[(size_t)t * 2 + 1]; }
        }
    }
}
__device__ __forceinline__ void phase_lnffn(const Params& P, int layer, int bid, int nb) {
    const int tid = opaque_tid(), lane = tid & 63, wave = tid >> 6, nw = blockDim.x >> 6;
    const bf16_t* pre2 = (const bf16_t*)(P.ws + WS_BIG + BIG_PRE2);
    const float* g = P.in[I_LNFG] + layer * D; const float* b = P.in[I_LNFB] + layer * D;
    const int* tokdst = (const int*)(P.ws + WS_TOKDST);
    float gr[16], br[16]; load_gb(g, b, lane, gr, br);
    for (int t0 = bid * nw + wave; t0 < T; t0 += 2 * nb * nw) {
        const int t1 = t0 + nb * nw; const bool has1 = t1 < T;
        float v0[16], v1[16];
        load_row_bf16(pre2 + (size_t)tokdst[t0] * D, lane, v0);
        if (has1) load_row_bf16(pre2 + (size_t)tokdst[t1] * D, lane, v1);
#pragma unroll
        for (int rr = 0; rr < 2; ++rr) {
            if (rr == 1 && !has1) break;
            float (&v)[16] = rr ? v1 : v0; const int t = rr ? t1 : t0;
            ln_row_r(v, gr, br);
            if (layer == 0) { store_row_bf16((bf16_t*)(P.out + OUT_H) + (size_t)t * D, lane, v);
                typedef unsigned u32x2 __attribute__((ext_vector_type(2)));
#pragma unroll
                for (int j = 0; j < 2; ++j) *(u32x2*)(P.ws + WS_H8 + (size_t)t * D + 8 * lane + 512 * j) = (u32x2){pk4_fp8(v[8 * j] * H8_SCALE, v[8 * j + 1] * H8_SCALE, v[8 * j + 2] * H8_SCALE, v[8 * j + 3] * H8_SCALE), pk4_fp8(v[8 * j + 4] * H8_SCALE, v[8 * j + 5] * H8_SCALE, v[8 * j + 6] * H8_SCALE, v[8 * j + 7] * H8_SCALE)}; }
            else { float* o = (float*)P.out + (size_t)t * D;
#pragma unroll
                for (int j = 0; j < 2; ++j) { *(f32x4*)(o + 8 * lane + 512 * j) = (f32x4){v[8 * j], v[8 * j + 1], v[8 * j + 2], v[8 * j + 3]}; *(f32x4*)(o + 8 * lane + 512 * j + 4) = (f32x4){v[8 * j + 4], v[8 * j + 5], v[8 * j + 6], v[8 * j + 7]}; } }
        }
    }
}

enum { MIX_RET = 0, MIX_ML = 1, MIX_GLA = 2, MIX_SSD = 3 };
typedef short s16x4 __attribute__((ext_vector_type(4)));
__device__ __forceinline__ bf16x8 tr_frag(LAS unsigned char* p0, LAS unsigned char* p1) {
    const s16x4 a = __builtin_amdgcn_ds_read_tr16_b64_v4i16((LAS s16x4*)p0), b = __builtin_amdgcn_ds_read_tr16_b64_v4i16((LAS s16x4*)p1);
    return (bf16x8){a[0], a[1], a[2], a[3], b[0], b[1], b[2], b[3]};
}
__device__ __forceinline__ bf16x8 cat_frag(LAS unsigned char* p0, LAS unsigned char* p1) {
    const s16x4 a = *(LAS s16x4*)p0, b = *(LAS s16x4*)p1;
    return (bf16x8){a[0], a[1], a[2], a[3], b[0], b[1], b[2], b[3]};
}
__device__ __forceinline__ bf16x8 pack_acc(const f32x4& lo, const f32x4& hi) {
    u32x4 w; w.x = pg8::cvt_pk_bf16(lo[0], lo[1]); w.y = pg8::cvt_pk_bf16(lo[2], lo[3]); w.z = pg8::cvt_pk_bf16(hi[0], hi[1]); w.w = pg8::cvt_pk_bf16(hi[2], hi[3]);
    return __builtin_bit_cast(bf16x8, w);
}
__device__ __forceinline__ void unpack8(const u32x4& w, float (&v)[8]) {
    v[0] = bflo(w.x); v[1] = bfhi(w.x); v[2] = bflo(w.y); v[3] = bfhi(w.y); v[4] = bflo(w.z); v[5] = bfhi(w.z); v[6] = bflo(w.w); v[7] = bfhi(w.w);
}
__device__ __forceinline__ u32x4 pack8(const float (&v)[8]) {
    u32x4 w; w.x = pg8::cvt_pk_bf16(v[0], v[1]); w.y = pg8::cvt_pk_bf16(v[2], v[3]); w.z = pg8::cvt_pk_bf16(v[4], v[5]); w.w = pg8::cvt_pk_bf16(v[6], v[7]); return w;
}

template <int CTRL, int RM> __device__ __forceinline__ float dpp_take(float old, float v) { return __builtin_bit_cast(float, __builtin_amdgcn_update_dpp(__builtin_bit_cast(int, old), __builtin_bit_cast(int, v), CTRL, RM, 0xf, false)); }
__device__ __forceinline__ float wave_scan_add(float v) {
    v += dpp_take<0x111, 0xf>(0.f, v); v += dpp_take<0x112, 0xf>(0.f, v); v += dpp_take<0x114, 0xf>(0.f, v); v += dpp_take<0x118, 0xf>(0.f, v);
    v += dpp_take<0x142, 0xa>(0.f, v); v += dpp_take<0x143, 0xc>(0.f, v); return v; }
__device__ __forceinline__ float wave_scan_max(float v) {
    const float ni = -3.0e38f;
    v = fmaxf(v, dpp_take<0x111, 0xf>(ni, v)); v = fmaxf(v, dpp_take<0x112, 0xf>(ni, v)); v = fmaxf(v, dpp_take<0x114, 0xf>(ni, v)); v = fmaxf(v, dpp_take<0x118, 0xf>(ni, v));
    v = fmaxf(v, dpp_take<0x142, 0xa>(ni, v)); v = fmaxf(v, dpp_take<0x143, 0xc>(ni, v)); return v; }
__device__ __forceinline__ float fexp(float x) { return __builtin_amdgcn_exp2f(x * 1.4426950408889634f); }
__device__ __forceinline__ float frcp(float x) { return __builtin_amdgcn_rcpf(x); }
__device__ __forceinline__ float fsigmoid(float x) { return frcp(1.f + fexp(-x)); }
__device__ __forceinline__ float fsilu(float x) { return x * fsigmoid(x); }
__device__ __forceinline__ float fsoftplus(float x) {
    const float u = fexp(-fabsf(x));
    const float l = u < 0.01f ? u * (1.f - u * (0.5f - u * 0.33333333f)) : __builtin_amdgcn_logf(1.f + u) * 0.6931471805599453f;
    return fmaxf(x, 0.f) + l;
}
__device__ __forceinline__ float flogsigmoid(float x) { return -fsoftplus(-x); }

template <int NR>
__device__ __forceinline__ void conv_rows(const bf16_t* src, const int trow0, const LAS float* wl, const int ldw, float (&o)[NR][8]) {
    float x[NR + 3][8];
#pragma unroll
    for (int i = 0; i < NR + 3; ++i) {
        if (trow0 + i - 3 >= 0) { const u32x4 xw = *(const u32x4*)(src + (ptrdiff_t)(i - 3) * NP); unpack8(xw, x[i]); }
        else {
#pragma unroll
            for (int j = 0; j < 8; ++j) x[i][j] = 0.f; }
    }
    float wv[5][8];
#pragma unroll
    for (int k = 0; k < 5; ++k) { const f32x4 w0 = *(const LAS f32x4*)(wl + k * ldw), w1 = *(const LAS f32x4*)(wl + k * ldw + 4);
#pragma unroll
        for (int j = 0; j < 4; ++j) { wv[k][j] = w0[j]; wv[k][4 + j] = w1[j]; } }
#pragma unroll
    for (int r = 0; r < NR; ++r)
#pragma unroll
        for (int j = 0; j < 8; ++j) { float a = wv[4][j];
#pragma unroll
            for (int k = 0; k < 4; ++k) a += wv[k][j] * x[r + k][j];
            o[r][j] = fsilu(a); }
}

__device__ __forceinline__ void ssd_prep(const Params& P, LAS unsigned char* lds, int bid, int nb) {
    const int tid = opaque_tid();
    bf16_t* proj = (bf16_t*)(P.ws + WS_BIG);
    LAS u32x4* halo = (LAS u32x4*)lds;
    const int c32 = tid & 31, r0 = (tid >> 5) * 4;
#pragma unroll 1
    for (int it = bid; it < 256; it += nb) {
        const int unit = it >> 1, half = it & 1, b = unit >> 2, g = unit & 3;
        int col, chn;
        if (half == 0) { col = C1_XS + g * 256 + 8 * c32; chn = g * 256 + 8 * c32; }
        else if (c32 < 16) { col = C1_BM + g * 128 + 8 * c32; chn = 1024 + g * 128 + 8 * c32; }
        else { col = C1_CM + g * 128 + 8 * (c32 - 16); chn = 1536 + g * 128 + 8 * (c32 - 16); }
        float wv[5][8];
#pragma unroll
        for (int k = 0; k < 5; ++k) { const float* wp = (k < 4 ? P.in[I_SSDCW] + k * 2048 : P.in[I_SSDCB]) + chn; const f32x4 w0 = *(const f32x4*)wp, w1 = *(const f32x4*)(wp + 4);
#pragma unroll
            for (int j = 0; j < 4; ++j) { wv[k][j] = w0[j]; wv[k][4 + j] = w1[j]; } }
        bf16_t* base = proj + (size_t)b * SEQ * NP + col;
        u32x4 cur[7];
#pragma unroll
        for (int i = 0; i < 7; ++i) { const int row = r0 - 3 + i; cur[i] = row >= 0 ? *(const u32x4*)(base + (size_t)row * NP) : (u32x4){0u, 0u, 0u, 0u}; }
#pragma unroll 1
        for (int ch = 0; ch < SEQ / 64; ++ch) {
            float x[7][8];
#pragma unroll
            for (int i = 0; i < 7; ++i) unpack8(cur[i], x[i]);
            const u32x4 h0 = cur[4], h1 = cur[5], h2 = cur[6];
            __syncthreads();
            if (r0 == 60) { halo[c32] = h0; halo[32 + c32] = h1; halo[64 + c32] = h2; }
            if (ch + 1 < SEQ / 64) {
#pragma unroll
                for (int i = 0; i < 7; ++i) if (r0 >= 4 || i >= 3) cur[i] = *(const u32x4*)(base + (size_t)(64 * (ch + 1) + r0 - 3 + i) * NP);
            }
#pragma unroll
            for (int r = 0; r < 4; ++r) { float o[8];
#pragma unroll
                for (int j = 0; j < 8; ++j) { float a = wv[4][j];
#pragma unroll
                    for (int k = 0; k < 4; ++k) a += wv[k][j] * x[r + k][j];
                    o[j] = fsilu(a); }
                *(u32x4*)(base + (size_t)(64 * ch + r0 + r) * NP) = pack8(o); }
            __syncthreads();
            if (r0 == 0 && ch + 1 < SEQ / 64) { cur[0] = halo[c32]; cur[1] = halo[32 + c32]; cur[2] = halo[64 + c32]; }
        }
        __syncthreads();
    }
}

template <int MIX>
__device__ __forceinline__ void mixer_unit(const Params& P, const int b, const int h, LAS unsigned char* lds, const bool dostore) {
    const int tid0 = opaque_tid(), w = __builtin_amdgcn_readfirstlane(tid0 >> 6);
    typedef unsigned u32x2 __attribute__((ext_vector_type(2)));
    constexpr int RSQ = 288, RSV = 544, RSP = 144;
    constexpr int SZQ = 64 * RSQ, SZV = 64 * RSV, SZP = 64 * RSP;
    constexpr int OQ = 0, OK1 = SZQ, OV = 2 * SZQ, O3 = 2 * SZQ + SZV;
    constexpr int OK2 = (MIX == MIX_ML || MIX == MIX_GLA) ? O3 : OK1;
    constexpr int OV2 = (MIX == MIX_SSD) ? O3 : OV;
    constexpr int OP = MIX == MIX_RET ? O3 : (MIX == MIX_SSD ? O3 + SZV : O3 + SZQ);
    constexpr int NPV = MIX == MIX_SSD ? 4 : 1;
    constexpr int OT = OP + NPV * SZP;
    constexpr int OY = OV2;
    LAS float* tab = (LAS float*)(lds + OT);
    constexpr int TGN = MIX == MIX_GLA ? 8832 : MIX == MIX_ML ? 648 : MIX == MIX_SSD ? 512 : 0;
    constexpr int TCW = MIX == MIX_ML ? 904 : 768;
    static_assert(OT + (MIX == MIX_GLA ? 11776 : MIX == MIX_SSD ? 3328 : 2184) * 4 <= 163840 - 1024, "lds map");
    bf16_t* proj = (bf16_t*)(P.ws + WS_BIG);
    const size_t row0b = (size_t)b * SEQ;
    constexpr int GIDX = MIX == MIX_RET ? I_RETG : MIX == MIX_ML ? I_MLG : MIX == MIX_GLA ? I_GLAG : I_SSDG;
    if (tid0 < 256) tab[TGN + tid0] = P.in[GIDX][h * 256 + tid0];
    if constexpr (MIX == MIX_ML) {
        for (int i = tid0; i < 1280; i += NTHREADS_C) { const int k = i >> 8, j = i & 255; const int chn = (j >> 7) * 512 + h * 128 + (j & 127);
            tab[TCW + i] = k < 4 ? P.in[I_MLCW][k * 1024 + chn] : P.in[I_MLCB][chn]; }
        if (tid0 < 128) tab[512 + tid0] = 0.f; if (tid0 == 0) tab[641] = 0.f;
    }
    if constexpr (MIX == MIX_GLA) {
        for (int i = tid0; i < 2048; i += NTHREADS_C) tab[9088 + i] = P.in[I_GLAWA][(i >> 7) * 512 + h * 128 + (i & 127)];
        if (tid0 < 128) tab[9088 + 2048 + tid0] = P.in[I_GLABA][h * 128 + tid0];
    }
    __syncthreads();
    f32x4 Sacc[8][2];
#pragma unroll
    for (int rt = 0; rt < 8; ++rt)
#pragma unroll
        for (int ct = 0; ct < 2; ++ct) Sacc[rt][ct] = (f32x4){0.f, 0.f, 0.f, 0.f};
    float gam = 1.f, lg2gam = 0.f, g63 = 1.f;
    float rinv[4] = {0.f, 0.f, 0.f, 0.f};
    if constexpr (MIX == MIX_RET) { gam = 1.f - __builtin_amdgcn_exp2f(-5.f - (float)h); lg2gam = __builtin_amdgcn_logf(gam); g63 = __builtin_amdgcn_exp2f(63.f * lg2gam);
#pragma unroll
        for (int i2 = 0; i2 < 4; ++i2) rinv[i2] = __builtin_amdgcn_exp2f(-(float)(2 * (4 * (tid0 & 15) + i2)) * (13.287712379549449f / 128.f)) * 0.15915494309189535f; }

    tp_begin(lds, 100 * MIX + 9);
    unsigned short gpre0 = 0, gpre1 = 0;
    if constexpr (MIX == MIX_ML) { if (w == 0) { const bf16_t* rp = proj + (row0b + (tid0 & 63)) * NP; gpre0 = rp[C0_MI + h]; gpre1 = rp[C0_MF + h]; } }
    if constexpr (MIX == MIX_SSD) { if (w < 4) gpre0 = proj[(row0b + (tid0 & 63)) * NP + C1_DT + 4 * h + w]; }
#pragma unroll 1
    for (int ch = 0; ch < SEQ / 64; ++ch) {
        int tid = tid0; asm volatile("" : "+v"(tid));
        const int lane = tid & 63, c = lane & 15, g = lane >> 4, q4 = (lane >> 2) & 3, p4 = lane & 3;
        const size_t row0 = row0b + (size_t)ch * 64;
        tp_begin(lds, 100 * MIX + 1);
        if constexpr (MIX == MIX_RET) {
            const int* pos = (const int*)P.in[I_POS];
#pragma unroll
            for (int i = 0; i < 2; ++i) {
                const int pi = tid + 512 * i, r = pi >> 4, c8 = pi & 15;
                const bf16_t* rp = proj + (row0 + r) * NP + h * 128 + 8 * c8;
                const u32x4 qw = *(const u32x4*)(rp + C0_RQ), kw = *(const u32x4*)(rp + C0_RK);
                float qv[8], kv[8]; unpack8(qw, qv); unpack8(kw, kv);
                const float ps = (float)pos[row0 + r];
                const float fq = __builtin_amdgcn_exp2f((float)r * lg2gam), fk = 0.08838834764831845f * __builtin_amdgcn_exp2f(-(float)r * lg2gam);
#pragma unroll
                for (int i2 = 0; i2 < 4; ++i2) {
                    const float tr = __builtin_amdgcn_fractf(ps * rinv[i2]);
                    const float sn = __builtin_amdgcn_sinf(tr), cs = __builtin_amdgcn_cosf(tr);
                    const float q0 = qv[2 * i2], q1 = qv[2 * i2 + 1], k0 = kv[2 * i2], k1 = kv[2 * i2 + 1];
                    qv[2 * i2] = (q0 * cs - q1 * sn) * fq; qv[2 * i2 + 1] = (q0 * sn + q1 * cs) * fq;
                    kv[2 * i2] = (k0 * cs - k1 * sn) * fk; kv[2 * i2 + 1] = (k0 * sn + k1 * cs) * fk;
                }
                *(LAS u32x4*)(lds + OQ + RSQ * r + 16 * c8) = pack8(qv);
                *(LAS u32x4*)(lds + OK1 + RSQ * r + 16 * c8) = pack8(kv);
            }
#pragma unroll
            for (int i = 0; i < 4; ++i) {
                const int pi = tid + 512 * i, r = pi >> 5, c8 = pi & 31;
                *(LAS u32x4*)(lds + OV + RSV * r + 16 * c8) = *(const u32x4*)(proj + (row0 + r) * NP + C0_RV + h * 256 + 8 * c8);
            }
        }
        if constexpr (MIX == MIX_GLA) {
            if (tid < 128) *(LAS u32x4*)(tab + 11264 + 4 * tid) = *(const u32x4*)(proj + (row0 + (tid >> 1)) * NP + C1_GA + 8 * (tid & 1));
            __syncthreads();
            {
                const int d = tid & 127, tq = tid >> 7;
                const float ba = tab[9088 + 2048 + d];
                float wv[16];
#pragma unroll
                for (int r = 0; r < 16; ++r) wv[r] = tab[9088 + r * 128 + d];
                float run = 0.f;
#pragma unroll 4
                for (int i = 0; i < 16; ++i) {
                    const int t = 16 * tq + i;
                    const u32x4 g0 = *(LAS u32x4*)(tab + 11264 + 8 * t), g1 = *(LAS u32x4*)(tab + 11264 + 8 * t + 4); float gv[8], gv2[8]; unpack8(g0, gv); unpack8(g1, gv2);
                    float a = ba;
#pragma unroll
                    for (int r = 0; r < 8; ++r) a += gv[r] * wv[r] + gv2[r] * wv[8 + r];
                    run += flogsigmoid(a) * (1.f / 16.f);
                    tab[t * 128 + d] = run;
                }
                tab[8192 + tq * 128 + d] = run;
            }
            __syncthreads();
            if (tid < 128) tab[8704 + tid] = fexp((tab[8192 + tid] + tab[8192 + 128 + tid]) + (tab[8192 + 256 + tid] + tab[8192 + 384 + tid]));
            __syncthreads();
#pragma unroll
            for (int i = 0; i < 2; ++i) {
                const int pi = tid + 512 * i, r = pi >> 4, c8 = pi & 15, tq = r >> 4;
                const bf16_t* rp = proj + (row0 + r) * NP + h * 128 + 8 * c8;
                const u32x4 qw = *(const u32x4*)(rp + C1_GQ), kw = *(const u32x4*)(rp + C1_GK);
                float qv[8], kv[8], k2[8]; unpack8(qw, qv); unpack8(kw, kv);
#pragma unroll
                for (int hh = 0; hh < 2; ++hh) {
                    const int d0 = 8 * c8 + 4 * hh;
                    f32x4 bc = *(LAS f32x4*)(tab + r * 128 + d0);
                    const f32x4 t0 = *(LAS f32x4*)(tab + 8192 + d0), t1 = *(LAS f32x4*)(tab + 8192 + 128 + d0), t2 = *(LAS f32x4*)(tab + 8192 + 256 + d0), t3 = *(LAS f32x4*)(tab + 8192 + 384 + d0);
                    if (tq > 0) bc = bc + t0; if (tq > 1) bc = bc + t1; if (tq > 2) bc = bc + t2;
                    const f32x4 bt = (t0 + t1) + (t2 + t3);
                    const f32x4 dcv = *(LAS f32x4*)(tab + 8704 + d0);
#pragma unroll
                    for (int j = 0; j < 4; ++j) { const float e1 = fexp(bc[j]), e2 = frcp(e1), kk = kv[4 * hh + j] * e2;
                        qv[4 * hh + j] = qv[4 * hh + j] * 0.08838834764831845f * e1; kv[4 * hh + j] = kk; k2[4 * hh + j] = kk * dcv[j]; }
                }
                *(LAS u32x4*)(lds + OQ + RSQ * r + 16 * c8) = pack8(qv);
                *(LAS u32x4*)(lds + OK1 + RSQ * r + 16 * c8) = pack8(kv);
                *(LAS u32x4*)(lds + OK2 + RSQ * r + 16 * c8) = pack8(k2);
            }
#pragma unroll
            for (int i = 0; i < 4; ++i) {
                const int pi = tid + 512 * i, r = pi >> 5, c8 = pi & 31;
                *(LAS u32x4*)(lds + OV + RSV * r + 16 * c8) = *(const u32x4*)(proj + (row0 + r) * NP + C1_GV + h * 256 + 8 * c8);
            }
        }
        if constexpr (MIX == MIX_ML) {
            if (w == 0) {
                const float ip = bf2f(gpre0) + P.in[I_MLBI][h], lf = flogsigmoid(bf2f(gpre1) + P.in[I_MLBF][h]);
                const float bc = wave_scan_add(lf);
                const float u = ip - bc; const float pm = wave_scan_max(u);
                const float mst = tab[641];
                const float M = fmaxf(mst, pm), M63 = __shfl(M, 63), bt = __shfl(bc, 63);
                tab[lane] = u; tab[64 + lane] = M; tab[128 + lane] = fexp(u - M63); tab[192 + lane] = fexp(mst - M); tab[256 + lane] = fexp(-bc - M);
                if (lane == 0) { tab[640] = fexp(mst - M63); tab[642] = bt + M63; }
            }
            {
                const int c16 = tid & 31, r0 = (tid >> 5) * 4, isk = c16 >> 4, c8 = c16 & 15;
                float o[4][8];
                conv_rows<4>(proj + (row0 + r0) * NP + (isk ? C0_MK : C0_MQ) + h * 128 + 8 * c8, ch * 64 + r0, tab + TCW + 8 * c16, 256, o);
#pragma unroll
                for (int r = 0; r < 4; ++r) {
                    if (isk) {
#pragma unroll
                        for (int j = 0; j < 8; ++j) o[r][j] *= 0.08838834764831845f; }
                    *(LAS u32x4*)(lds + (isk ? OK1 : OQ) + RSQ * (r0 + r) + 16 * c8) = pack8(o[r]); }
            }
#pragma unroll
            for (int i = 0; i < 4; ++i) {
                const int pi = tid + 512 * i, r = pi >> 5, c8 = pi & 31;
                *(LAS u32x4*)(lds + OV + RSV * r + 16 * c8) = *(const u32x4*)(proj + (row0 + r) * NP + C0_MV + h * 256 + 8 * c8);
            }
            __syncthreads();
            tp_end(lds, 100 * MIX + 1); tp_begin(lds, 100 * MIX + 6);
#pragma unroll
            for (int i = 0; i < 2; ++i) {
                const int pi = tid + 512 * i, r = pi >> 4, c8 = pi & 15;
                const u32x4 kw = *(LAS u32x4*)(lds + OK1 + RSQ * r + 16 * c8); float kv[8]; unpack8(kw, kv); const float es = tab[128 + r];
#pragma unroll
                for (int j = 0; j < 8; ++j) kv[j] *= es;
                *(LAS u32x4*)(lds + OK2 + RSQ * r + 16 * c8) = pack8(kv);
            }
            {
                const int t = tid >> 3, part = tid & 7; float a = 0.f;
#pragma unroll
                for (int i = 0; i < 2; ++i) { const u32x4 qw = *(LAS u32x4*)(lds + OQ + RSQ * t + 2 * (16 * part + 8 * i)); float qv[8]; unpack8(qw, qv);
                    const f32x4 n0 = *(LAS f32x4*)(tab + 512 + 16 * part + 8 * i), n1 = *(LAS f32x4*)(tab + 512 + 16 * part + 8 * i + 4);
#pragma unroll
                    for (int j = 0; j < 4; ++j) a += qv[j] * n0[j] + qv[4 + j] * n1[j]; }
                a += __shfl_xor(a, 1); a += __shfl_xor(a, 2); a += __shfl_xor(a, 4);
                if (part == 0) tab[448 + t] = a;
            }
        }
        if constexpr (MIX == MIX_SSD) {
            if (w < 4) {
                const int hd = 4 * h + w;
                const float dt = fsoftplus(bf2f(gpre0) + P.in[I_SSDDTB][hd]);
                const float cm = wave_scan_add(dt * (-fexp(P.in[I_SSDALOG][hd])));
                tab[lane * 4 + w] = cm; tab[256 + lane * 4 + w] = dt;
            }
            {
                const int c32 = tid & 31, r0 = (tid >> 5) * 4, isc = c32 >> 4, c8 = c32 & 15, hr = c32 >> 3;
                u32x4 bcw[4], xw[4];
#pragma unroll
                for (int r = 0; r < 4; ++r) { bcw[r] = *(const u32x4*)(proj + (row0 + r0 + r) * NP + (isc ? C1_CM : C1_BM) + h * 128 + 8 * c8); xw[r] = *(const u32x4*)(proj + (row0 + r0 + r) * NP + C1_XS + h * 256 + 8 * c32); }
                float ox[4][8];
#pragma unroll
                for (int r = 0; r < 4; ++r) { *(LAS u32x4*)(lds + (isc ? OQ : OK1) + RSQ * (r0 + r) + 16 * c8) = bcw[r]; unpack8(xw[r], ox[r]); }
                __syncthreads();
                tp_end(lds, 100 * MIX + 1); tp_begin(lds, 100 * MIX + 6);
                const float last = tab[63 * 4 + hr];
#pragma unroll
                for (int r = 0; r < 4; ++r) { const float dt = tab[256 + (r0 + r) * 4 + hr], e2 = fexp(last - tab[(r0 + r) * 4 + hr]); float o2[8];
#pragma unroll
                    for (int j = 0; j < 8; ++j) { ox[r][j] *= dt; o2[j] = ox[r][j] * e2; }
                    *(LAS u32x4*)(lds + OV + RSV * (r0 + r) + 16 * c32) = pack8(ox[r]);
                    *(LAS u32x4*)(lds + OV2 + RSV * (r0 + r) + 16 * c32) = pack8(o2); }
            }
        }
        __syncthreads();
        tp_end(lds, (MIX == MIX_ML || MIX == MIX_SSD) ? 100 * MIX + 6 : 100 * MIX + 1); tp_begin(lds, 100 * MIX + 2);
        if (ch + 1 < SEQ / 64) {
            const int sl = tid & 15;
            int col = -1;
            if constexpr (MIX == MIX_RET) col = sl < 2 ? C0_RQ + h * 128 + 64 * sl : sl < 4 ? C0_RK + h * 128 + 64 * (sl - 2) : sl < 8 ? C0_RV + h * 256 + 64 * (sl - 4) : sl < 12 ? C0_RG + h * 256 + 64 * (sl - 8) : -1;
            if constexpr (MIX == MIX_ML) col = sl < 2 ? C0_MQ + h * 128 + 64 * sl : sl < 4 ? C0_MK + h * 128 + 64 * (sl - 2) : sl < 8 ? C0_MV + h * 256 + 64 * (sl - 4) : sl < 12 ? C0_MO + h * 256 + 64 * (sl - 8) : sl == 12 ? C0_MI : -1;
            if constexpr (MIX == MIX_GLA) col = sl < 2 ? C1_GQ + h * 128 + 64 * sl : sl < 4 ? C1_GK + h * 128 + 64 * (sl - 2) : sl < 8 ? C1_GV + h * 256 + 64 * (sl - 4) : sl < 12 ? C1_GR + h * 256 + 64 * (sl - 8) : sl == 12 ? C1_GA : -1;
            if constexpr (MIX == MIX_SSD) col = sl < 4 ? C1_XS + h * 256 + 64 * sl : sl < 6 ? C1_BM + h * 128 + 64 * (sl - 4) : sl < 8 ? C1_CM + h * 128 + 64 * (sl - 6) : sl < 12 ? C1_SZ + h * 256 + 64 * (sl - 8) : sl == 12 ? C1_DT : -1;
            if (col >= 0) { const bf16_t* nbp = proj + (row0 + 64 + (tid >> 4)) * NP + col;
                const unsigned pfl = 157696u + (unsigned)w * 512u;
                asm volatile("s_mov_b32 m0, %2\n\ts_nop 0\n\tglobal_load_lds_dword %0, off\n\ts_mov_b32 m0, %3\n\ts_nop 0\n\tglobal_load_lds_dword %1, off"
                             :: "v"(nbp), "v"(nbp + (size_t)32 * NP), "s"(pfl), "s"(pfl + 256u) : "memory", "m0"); }
        }
        {
            const int tt = w >> 1; float rsum = 0.f;
#pragma unroll
            for (int si = 0; si < 2; ++si) {
                const int ss = 2 * (w & 1) + si;
                f32x4 acc = (f32x4){0.f, 0.f, 0.f, 0.f};
#pragma unroll
                for (int ks = 0; ks < 4; ++ks) {
                    const bf16x8 a = *(LAS bf16x8*)(lds + OK1 + RSQ * (16 * ss + c) + 2 * (32 * ks + 8 * g));
                    const bf16x8 bq = *(LAS bf16x8*)(lds + OQ + RSQ * (16 * tt + c) + 2 * (32 * ks + 8 * g));
                    acc = __builtin_amdgcn_mfma_f32_16x16x32_bf16(a, bq, acc, 0, 0, 0);
                }
                const int t = 16 * tt + c, s0 = 16 * ss + 4 * g;
                if constexpr (MIX == MIX_SSD) {
                    const f32x4 ct_ = *(LAS f32x4*)(tab + t * 4);
#pragma unroll
                    for (int hr = 0; hr < 4; ++hr) { float pv[4];
#pragma unroll
                        for (int r = 0; r < 4; ++r) pv[r] = (s0 + r <= t) ? acc[r] * fexp(ct_[hr] - tab[(s0 + r) * 4 + hr]) : 0.f;
                        *(LAS u32x2*)(lds + OP + hr * SZP + RSP * t + 2 * s0) = (u32x2){pg8::cvt_pk_bf16(pv[0], pv[1]), pg8::cvt_pk_bf16(pv[2], pv[3])}; }
                } else {
                    float pv[4];
                    if constexpr (MIX == MIX_ML) { const f32x4 us = *(LAS f32x4*)(tab + s0); const float Mt = tab[64 + t];
#pragma unroll
                        for (int r = 0; r < 4; ++r) { pv[r] = (s0 + r <= t) ? acc[r] * fexp(us[r] - Mt) : 0.f; rsum += pv[r]; } }
                    else {
#pragma unroll
                        for (int r = 0; r < 4; ++r) pv[r] = (s0 + r <= t) ? acc[r] : 0.f; }
                    *(LAS u32x2*)(lds + OP + RSP * t + 2 * s0) = (u32x2){pg8::cvt_pk_bf16(pv[0], pv[1]), pg8::cvt_pk_bf16(pv[2], pv[3])};
                }
            }
            if constexpr (MIX == MIX_ML) { rsum += __shfl_xor(rsum, 16); rsum += __shfl_xor(rsum, 32); if (g == 0) tab[320 + (w & 1) * 64 + 16 * tt + c] = rsum; }
        }
        __syncthreads();
        tp_end(lds, 100 * MIX + 2); tp_begin(lds, 100 * MIX + 3);
        f32x4 Yacc[2][4];
#pragma unroll
        for (int ct = 0; ct < 2; ++ct)
#pragma unroll
            for (int tt = 0; tt < 4; ++tt) Yacc[ct][tt] = (f32x4){0.f, 0.f, 0.f, 0.f};
#pragma unroll
        for (int kd = 0; kd < 4; ++kd) {
            bf16x8 qf[4];
#pragma unroll
            for (int tt = 0; tt < 4; ++tt) { LAS unsigned char* qp = lds + OQ + RSQ * (16 * tt + c) + 2 * (32 * kd + 4 * g); qf[tt] = cat_frag(qp, qp + 32); }
#pragma unroll
            for (int ct = 0; ct < 2; ++ct) { const bf16x8 sf = pack_acc(Sacc[2 * kd][ct], Sacc[2 * kd + 1][ct]);
#pragma unroll
                for (int tt = 0; tt < 4; ++tt) Yacc[ct][tt] = __builtin_amdgcn_mfma_f32_16x16x32_bf16(sf, qf[tt], Yacc[ct][tt], 0, 0, 0); }
        }
        if constexpr (MIX != MIX_GLA) {
#pragma unroll
            for (int tt = 0; tt < 4; ++tt) {
                float rs = gam;
                if constexpr (MIX == MIX_ML) rs = tab[192 + 16 * tt + c];
                if constexpr (MIX == MIX_SSD) rs = fexp(tab[(16 * tt + c) * 4 + (w >> 1)]);
#pragma unroll
                for (int ct = 0; ct < 2; ++ct) Yacc[ct][tt] = Yacc[ct][tt] * rs;
            }
        }
        bf16x8 Vf[2][2];
#pragma unroll
        for (int ks = 0; ks < 2; ++ks)
#pragma unroll
            for (int ct = 0; ct < 2; ++ct) { LAS unsigned char* vp = lds + OV + RSV * (32 * ks + 8 * g + q4) + 2 * (32 * w + 16 * ct) + 8 * p4; Vf[ks][ct] = tr_frag(vp, vp + 4 * RSV); }
#pragma unroll
        for (int ks = 0; ks < 2; ++ks)
#pragma unroll
            for (int tt = 0; tt < 4; ++tt) { const bf16x8 pf = *(LAS bf16x8*)(lds + OP + (MIX == MIX_SSD ? (w >> 1) * SZP : 0) + RSP * (16 * tt + c) + 2 * (32 * ks + 8 * g));
#pragma unroll
                for (int ct = 0; ct < 2; ++ct) Yacc[ct][tt] = __builtin_amdgcn_mfma_f32_16x16x32_bf16(Vf[ks][ct], pf, Yacc[ct][tt], 0, 0, 0); }
        if constexpr (MIX == MIX_GLA) {
#pragma unroll
            for (int rt = 0; rt < 8; ++rt) { const f32x4 dc = *(LAS f32x4*)(tab + 8704 + 16 * rt + 4 * g);
#pragma unroll
                for (int ct = 0; ct < 2; ++ct) Sacc[rt][ct] = Sacc[rt][ct] * dc; }
        } else {
            float dc = gam;
            if constexpr (MIX == MIX_ML) dc = tab[640];
            if constexpr (MIX == MIX_SSD) dc = fexp(tab[63 * 4 + (w >> 1)]);
#pragma unroll
            for (int rt = 0; rt < 8; ++rt)
#pragma unroll
                for (int ct = 0; ct < 2; ++ct) Sacc[rt][ct] = Sacc[rt][ct] * dc;
        }
        if constexpr (MIX == MIX_SSD) {
#pragma unroll
            for (int ks = 0; ks < 2; ++ks)
#pragma unroll
                for (int ct = 0; ct < 2; ++ct) { LAS unsigned char* vp = lds + OV2 + RSV * (32 * ks + 8 * g + q4) + 2 * (32 * w + 16 * ct) + 8 * p4; Vf[ks][ct] = tr_frag(vp, vp + 4 * RSV); }
        }
#pragma unroll
        for (int rt = 0; rt < 8; ++rt)
#pragma unroll
            for (int ks = 0; ks < 2; ++ks) { LAS unsigned char* kp = lds + OK2 + RSQ * (32 * ks + 8 * g + q4) + 2 * (16 * rt) + 8 * p4; const bf16x8 kf = tr_frag(kp, kp + 4 * RSQ);
#pragma unroll
                for (int ct = 0; ct < 2; ++ct) Sacc[rt][ct] = __builtin_amdgcn_mfma_f32_16x16x32_bf16(kf, Vf[ks][ct], Sacc[rt][ct], 0, 0, 0); }
        if constexpr (MIX == MIX_RET) {
#pragma unroll
            for (int rt = 0; rt < 8; ++rt)
#pragma unroll
                for (int ct = 0; ct < 2; ++ct) Sacc[rt][ct] = Sacc[rt][ct] * g63;
        }
        if constexpr (MIX == MIX_ML) {
            if (tid < 128) { float a = 0.f;
#pragma unroll 8
                for (int s = 0; s < 64; ++s) a += bf2f(*(LAS unsigned short*)(lds + OK2 + RSQ * s + 2 * tid));
                tab[512 + tid] = tab[640] * tab[512 + tid] + a; }
        }
        __syncthreads();
        tp_end(lds, 100 * MIX + 3); tp_begin(lds, 100 * MIX + 4);
#pragma unroll
        for (int ct = 0; ct < 2; ++ct)
#pragma unroll
            for (int tt = 0; tt < 4; ++tt)
                *(LAS u32x2*)(lds + OY + RSV * (16 * tt + c) + 2 * (32 * w + 16 * ct + 4 * g)) = (u32x2){pg8::cvt_pk_bf16(Yacc[ct][tt][0], Yacc[ct][tt][1]), pg8::cvt_pk_bf16(Yacc[ct][tt][2], Yacc[ct][tt][3])};
        __syncthreads();
        tp_end(lds, 100 * MIX + 4); tp_begin(lds, 100 * MIX + 5);
        {
            const int t = tid >> 3, part = tid & 7;
            float y[32];
#pragma unroll
            for (int i = 0; i < 4; ++i) { const u32x4 yw = *(LAS u32x4*)(lds + OY + RSV * t + 2 * (32 * part + 8 * i)); float t8[8]; unpack8(yw, t8);
#pragma unroll
                for (int j = 0; j < 8; ++j) y[8 * i + j] = t8[j]; }
            constexpr int GCOL = MIX == MIX_RET ? C0_RG : MIX == MIX_ML ? C0_MO : MIX == MIX_GLA ? C1_GR : C1_SZ;
            constexpr int OCOL = MIX == MIX_RET ? C0_RV : MIX == MIX_ML ? C0_MV : MIX == MIX_GLA ? C1_GV : C1_SZ;
            bf16_t* rp = proj + (row0 + t) * NP + h * 256 + 32 * part;
            u32x4 gw[4];
#pragma unroll
            for (int i = 0; i < 4; ++i) gw[i] = *(const u32x4*)(rp + GCOL + 8 * i);
            if constexpr (MIX == MIX_ML) {
                const float den = (tab[320 + t] + tab[384 + t]) + tab[192 + t] * tab[448 + t];
                const float idn = frcp(fmaxf(fabsf(den), tab[256 + t]));
#pragma unroll
                for (int i = 0; i < 4; ++i) { float gt[8]; unpack8(gw[i], gt);
#pragma unroll
                    for (int j = 0; j < 8; ++j) y[8 * i + j] = y[8 * i + j] * idn * fsigmoid(gt[j]); }
            }
            if constexpr (MIX == MIX_SSD) {
                const int hd = 4 * h + (part >> 1); const float dsk = P.in[I_SSDD][hd] * frcp(tab[256 + t * 4 + (part >> 1)]);
#pragma unroll
                for (int i = 0; i < 4; ++i) { const u32x4 xw = *(LAS u32x4*)(lds + OV + RSV * t + 2 * (32 * part + 8 * i)); float t8[8], gt[8]; unpack8(xw, t8); unpack8(gw[i], gt);
#pragma unroll
                    for (int j = 0; j < 8; ++j) y[8 * i + j] = (y[8 * i + j] + dsk * t8[j]) * fsilu(gt[j]); }
            }
            float mean = 0.f;
            if constexpr (MIX == MIX_RET || MIX == MIX_ML) {
                float s1 = 0.f;
#pragma unroll
                for (int j = 0; j < 32; ++j) s1 += y[j];
                s1 += __shfl_xor(s1, 1); s1 += __shfl_xor(s1, 2); s1 += __shfl_xor(s1, 4);
                mean = s1 * (1.f / 256.f);
            }
            float s2 = 0.f;
#pragma unroll
            for (int j = 0; j < 32; ++j) { y[j] -= mean; s2 += y[j] * y[j]; }
            s2 += __shfl_xor(s2, 1); s2 += __shfl_xor(s2, 2); s2 += __shfl_xor(s2, 4);
            const float rstd = __builtin_amdgcn_rsqf(s2 * (1.f / 256.f) + NORM_EPS);
#pragma unroll
            for (int i = 0; i < 4; ++i) {
                const f32x4 n0 = *(LAS f32x4*)(tab + TGN + 32 * part + 8 * i), n1 = *(LAS f32x4*)(tab + TGN + 32 * part + 8 * i + 4); float o[8];
#pragma unroll
                for (int j = 0; j < 4; ++j) { o[j] = y[8 * i + j] * rstd * n0[j]; o[4 + j] = y[8 * i + 4 + j] * rstd * n1[j]; }
                if constexpr (MIX == MIX_RET || MIX == MIX_GLA) { float gt[8]; unpack8(gw[i], gt);
#pragma unroll
                    for (int j = 0; j < 8; ++j) o[j] *= fsilu(gt[j]); }
                if (dostore) *(u32x4*)(rp + OCOL + 8 * i) = pack8(o);
            }
            if constexpr (MIX == MIX_ML) { if (tid == 0) tab[641] = tab[642]; }
        }
        if (ch + 1 < SEQ / 64) {
            if constexpr (MIX == MIX_ML) { if (w == 0) { const bf16_t* rp = proj + (row0 + 64 + lane) * NP; gpre0 = rp[C0_MI + h]; gpre1 = rp[C0_MF + h]; } }
            if constexpr (MIX == MIX_SSD) { if (w < 4) gpre0 = proj[(row0 + 64 + lane) * NP + C1_DT + 4 * h + w]; }
        }
        __syncthreads();
        tp_end(lds, 100 * MIX + 5);
    }
    tp_end(lds, 100 * MIX + 9);
}

#define XB_TMO      128
#define XB_XCNT(j)  (256  + 64 * (j))
#define XB_XSUB(j)  (1280 + 64 * (j))
#define XB_XGEN(j)  (2304 + 64 * (j))
#define XB_TOP      3328
#define XB_TOPGEN   3392
#define XCD_BAR_WORDS 3456
#define XB_SPIN_CAP (1u << 18)
__device__ __forceinline__ unsigned xb_ld(unsigned* p)              { return __hip_atomic_load(p, __ATOMIC_RELAXED, __HIP_MEMORY_SCOPE_AGENT); }
__device__ __forceinline__ unsigned xb_add(unsigned* p, unsigned v) { return __hip_atomic_fetch_add(p, v, __ATOMIC_RELAXED, __HIP_MEMORY_SCOPE_AGENT); }
__device__ __forceinline__ unsigned xb_xcc_id() { return (unsigned)__builtin_amdgcn_s_getreg((3 << 11) | 20) & 0xFu; }
#define XB_SPIN(cond, bar) do { unsigned _sp = 0; while (cond) { __builtin_amdgcn_s_sleep(1); \
    if ((++_sp & 255u) == 0u) { if (xb_ld(&(bar)[XB_TMO])) break; if (_sp > XB_SPIN_CAP) { atomicAdd(&(bar)[XB_TMO], 1u); break; } } } } while (0)
struct XcdBarrier { unsigned* bar; unsigned x; volatile LAS unsigned* st; };
__device__ __forceinline__ XcdBarrier xcd_barrier_post(unsigned* bar, volatile LAS unsigned* st) {
    XcdBarrier b; b.bar = bar; b.x = xb_xcc_id(); b.st = st;
    if (opaque_tid() == 0) (void)xb_add(&bar[XB_XCNT(b.x)], 1u);
    return b;
}
__device__ __forceinline__ void xcd_barrier_complete(unsigned* bar, unsigned x, unsigned& nloc, unsigned& nx) {
    const unsigned G = gridDim.x * gridDim.y * gridDim.z;
    unsigned sum, cnt, mine, sp = 0u;
    for (;;) {
        sum = 0u; cnt = 0u; mine = 0u;
#pragma unroll
        for (unsigned j = 0; j < 16; ++j) { const unsigned c = xb_ld(&bar[XB_XCNT(j)]); sum += c; cnt += (c > 0u) ? 1u : 0u; mine = (j == x) ? c : mine; }
        if (sum == G) break;
        __builtin_amdgcn_s_sleep(1);
        if ((++sp & 255u) == 0u) { if (xb_ld(&bar[XB_TMO])) break; if (sp > XB_SPIN_CAP) { atomicAdd(&bar[XB_TMO], 1u); break; } }
    }
    nloc = mine > 0u ? mine : 1u; nx = cnt > 0u ? cnt : 1u;
}
__device__ __forceinline__ void xcd_barrier(const XcdBarrier& b) {
    asm volatile("s_waitcnt vmcnt(0)" ::: "memory");
    __syncthreads();
    if (opaque_tid() == 0) {
        unsigned* bar = b.bar;
        __builtin_amdgcn_s_waitcnt(0);
        unsigned nloc = b.st[0], nx = b.st[1];
        if (nloc == 0u) { xcd_barrier_complete(bar, b.x, nloc, nx); b.st[0] = nloc; b.st[1] = nx; }
        const unsigned old = xb_add(&bar[XB_XSUB(b.x)], 1u);
        const unsigned gen = old / nloc;
        if (old + 1u == (gen + 1u) * nloc) {
            __builtin_amdgcn_fence(__ATOMIC_RELEASE, "agent");
            asm volatile("s_waitcnt vmcnt(0)" ::: "memory");
            const unsigned og = xb_add(&bar[XB_TOP], 1u);
            const unsigned tg = og / nx;
            if (og + 1u == (tg + 1u) * nx) xb_add(&bar[XB_TOPGEN], 1u);
            else XB_SPIN(xb_ld(&bar[XB_TOPGEN]) == tg, bar);
            __builtin_amdgcn_fence(__ATOMIC_ACQUIRE, "agent");
            xb_add(&bar[XB_XGEN(b.x)], 1u);
            asm volatile("s_waitcnt vmcnt(0)" ::: "memory");
        } else {
            XB_SPIN(xb_ld(&bar[XB_XGEN(b.x)]) == gen, bar);
            __builtin_amdgcn_fence(__ATOMIC_ACQUIRE, "agent");
            asm volatile("s_waitcnt vmcnt(0)" ::: "memory");
        }
    }
    __syncthreads();
}

constexpr int NTHREADS = 512;
constexpr int RING_BYTES = 131072;
constexpr int LDS_BYTES = 163840;
constexpr int LDS_BARW = LDS_BYTES - 16;
constexpr int NPHASES = 17;
#ifndef MK_N_LAUNCHES
#define MK_N_LAUNCHES 1
#endif

#ifndef REP_ROUTE
#define REP_ROUTE 1
#endif
#ifndef REP_CONV
#define REP_CONV 1
#endif
#ifndef REP_GIN
#define REP_GIN 1
#endif
#ifndef REP_GOUT
#define REP_GOUT 1
#endif
#ifndef REP_PERM
#define REP_PERM 1
#endif
#ifndef REP_MOEA
#define REP_MOEA 1
#endif
#ifndef REP_MOEB
#define REP_MOEB 1
#endif
#ifndef REP_LNF
#define REP_LNF 1
#endif
#ifndef MIXREP_RET
#define MIXREP_RET 1
#endif
#ifndef MIXREP_ML
#define MIXREP_ML 1
#endif
#ifndef MIXREP_GLA
#define MIXREP_GLA 1
#endif
#ifndef MIXREP_SSD
#define MIXREP_SSD 1
#endif
struct Args { Params P; int ph_lo, ph_hi; };
typedef __attribute__((address_space(4))) const unsigned char* kargp_t;
__device__ __forceinline__ const Params& kparams() {
    kargp_t p = (kargp_t)__builtin_amdgcn_kernarg_segment_ptr();
    asm volatile("" : "+s"(p));
    return *(const Params*)p;
}

__device__ __forceinline__ int kphase_lo() { kargp_t p = (kargp_t)__builtin_amdgcn_kernarg_segment_ptr(); asm volatile("" : "+s"(p)); return ((const Args*)p)->ph_lo; }
__device__ __forceinline__ int kphase_hi() { kargp_t p = (kargp_t)__builtin_amdgcn_kernarg_segment_ptr(); asm volatile("" : "+s"(p)); return ((const Args*)p)->ph_hi; }
__device__ __forceinline__ void grid_barrier(LAS unsigned char* lds) {
    XcdBarrier b; b.bar = (unsigned*)(kparams().ws + WS_CTL) + CW_BAR; b.x = xb_xcc_id(); b.st = (volatile LAS unsigned*)(lds + LDS_BARW);
    tp_begin(lds, 900); xcd_barrier(b); tp_end(lds, 900);
}
template <int LAYER>
__device__ __forceinline__ void layer_phases(LAS unsigned char* lds) {
#define IN(k) (kphase_lo() <= (k) && (k) < kphase_hi())
#define SEAM(k) do { if (IN(k) && IN((k) + 1)) grid_barrier(lds); } while (0)
    constexpr int PB = 1 + 8 * LAYER;
    const int bid = blockIdx.x, nb = gridDim.x;
    if (IN(PB + 0)) {
        const Params& P = kparams();
        pg8::EpiStore E{(bf16_t*)(P.ws + WS_BIG), NP};
        constexpr unsigned M8 = LAYER ? INPROJ_FP8MASK1 : INPROJ_FP8MASK0, M16 = ALLTILES & ~M8;
        for (int rep = 0; rep < REP_GIN; ++rep) {
            if constexpr (M16 != 0u) {
                pg8::SchedCols S; S.A = (const char*)(P.out + OUT_H); S.B = (const char*)(P.ws + (LAYER ? WS_WIN1 : WS_WIN0)); S.lda = D; S.ldb = D; S.nM = T / 256; S.nN = __builtin_popcount(M16); S.G = nb; S.c = bid; S.mask = M16;
                pg8::gemm_phase(lds, S, E, D, D, D);
            }
            if constexpr (M8 != 0u) {
                pg8::SchedCols S; S.A = (const char*)(P.ws + WS_H8); S.B = (const char*)(P.ws + (LAYER ? WS_WIN8_1 : WS_WIN8_0)); S.lda = D / 2; S.ldb = D / 2; S.nM = T / 256; S.nN = __builtin_popcount(M8); S.G = nb; S.c = bid; S.mask = M8;
                pg8::gemm_phase<pg8::EpiStore, pg8::SchedCols, true, 0x7c7c7c7c, 0x77777777>(lds, S, E, D / 2, D / 2, D / 2);
            }
        }
    }
    SEAM(PB + 0);
    if (IN(PB + 1)) {
        if constexpr (LAYER == 1) { ssd_prep(kparams(), lds, bid, nb); grid_barrier(lds); }
        const Params& P = kparams();
        for (int u = bid; u < 256; u += nb) {
            const int b = (u & 127) >> 2, h = u & 3;
            if (LAYER == 0) { if (u < 128) { for (int rep = 0; rep < MIXREP_RET; ++rep) { mixer_unit<MIX_RET>(P, b, h, lds, rep == MIXREP_RET - 1); __syncthreads(); }
                                               convert_moe(P, lds, u, 128); }
                              else { for (int rep = 0; rep < MIXREP_ML; ++rep) { mixer_unit<MIX_ML>(P, b, h, lds, rep == MIXREP_ML - 1); __syncthreads(); } } }
            else { if (u < 128) { for (int rep = 0; rep < MIXREP_GLA; ++rep) { mixer_unit<MIX_GLA>(P, b, h, lds, rep == MIXREP_GLA - 1); __syncthreads(); } }
                   else { for (int rep = 0; rep < MIXREP_SSD; ++rep) { mixer_unit<MIX_SSD>(P, b, h, lds, rep == MIXREP_SSD - 1); __syncthreads(); } } }
        }
    }
    SEAM(PB + 1);
    if (IN(PB + 2)) {
        const Params& P = kparams();
        pg8::SchedPlain S; S.A = (const char*)(P.ws + WS_BIG) + YOFF * 2; S.B = (const char*)(P.ws + (LAYER ? WS_WOUT1 : WS_WOUT0)); S.lda = NP; S.ldb = 2048; S.nM = T / 256; S.nN = 4; S.G = nb; S.c = bid;
        pg8::EpiResid E{(bf16_t*)(P.out + OUT_PRE1), (const bf16_t*)(P.out + OUT_H)};
        for (int rep = 0; rep < REP_GOUT; ++rep) pg8::gemm_phase(lds, S, E, 2048, NP, 2048);
    }
    SEAM(PB + 2);
    if (IN(PB + 3)) for (int rep = 0; rep < REP_ROUTE; ++rep) { phase_route(kparams(), LAYER, lds, bid, nb, 32 * (REP_ROUTE - 1 - rep)); __syncthreads(); }
    SEAM(PB + 3);
    if (IN(PB + 4)) for (int rep = 0; rep < REP_PERM; ++rep) phase_permute(kparams(), LAYER, lds, bid, nb);
    SEAM(PB + 4);
    if (IN(PB + 5)) {
        const Params& P = kparams();
        const int* tilecls = (const int*)(P.ws + WS_TILECLS);
        if constexpr (MOE_FP8(LAYER) && MOEA_FP8) {
            pg8::SchedMoeA<true> S; S.A = (const char*)(P.ws + WS_BIG + BIG_HS8); S.Wgu = (const char*)(P.ws + WS_WGU) + (size_t)LAYER * 16 * 2097152; S.tilecls = tilecls; S.nM = __builtin_amdgcn_readfirstlane(tilecls[0]); S.G = nb; S.c = bid;
            pg8::EpiSwiglu8 E{P.ws + WS_BIG + BIG_H, (const float*)(P.ws + WS_ROWGATE)};
            for (int rep = 0; rep < REP_MOEA; ++rep) pg8::gemm_phase<pg8::EpiSwiglu8, pg8::SchedMoeA<true>, true, 0x7c7c7c7c, 0x77777777>(lds, S, E, D / 2, D / 2, D / 2);
        } else if constexpr (MOE_FP8(LAYER)) {
            pg8::SchedMoeA<false> S; S.A = (const char*)(P.ws + WS_BIG + BIG_HS); S.Wgu = (const char*)(P.ws + WS_WGU) + (size_t)LAYER * 16 * 2097152; S.tilecls = tilecls; S.nM = __builtin_amdgcn_readfirstlane(tilecls[0]); S.G = nb; S.c = bid;
            pg8::EpiSwiglu8 E{P.ws + WS_BIG + BIG_H, (const float*)(P.ws + WS_ROWGATE)};
            for (int rep = 0; rep < REP_MOEA; ++rep) pg8::gemm_phase(lds, S, E, D, D, D);
        } else {
            pg8::SchedMoeA<false> S; S.A = (const char*)(P.ws + WS_BIG + BIG_HS); S.Wgu = (const char*)(P.ws + WS_WGU) + (size_t)LAYER * 16 * 2097152; S.tilecls = tilecls; S.nM = __builtin_amdgcn_readfirstlane(tilecls[0]); S.G = nb; S.c = bid;
            pg8::EpiSwiglu E{(bf16_t*)(P.ws + WS_BIG + BIG_H), (const float*)(P.ws + WS_ROWGATE)};
            for (int rep = 0; rep < REP_MOEA; ++rep) pg8::gemm_phase(lds, S, E, D, D, D);
        }
    }
    SEAM(PB + 5);
    if (IN(PB + 6)) {
        const Params& P = kparams();
        const int* tilecls = (const int*)(P.ws + WS_TILECLS);
        pg8::EpiResid E{(bf16_t*)(P.ws + WS_BIG + BIG_PRE2), (const bf16_t*)(P.ws + WS_BIG + BIG_HS)};
        if constexpr (MOE_FP8(LAYER)) {
            pg8::SchedMoeB<true> S; S.A = (const char*)(P.ws + WS_BIG + BIG_H); S.Wd = (const char*)(P.ws + WS_WD) + (size_t)LAYER * 16 * 1048576; S.tilecls = tilecls; S.nM = __builtin_amdgcn_readfirstlane(tilecls[0]); S.G = nb; S.c = bid;
            for (int rep = 0; rep < REP_MOEB; ++rep) pg8::gemm_phase<pg8::EpiResid, pg8::SchedMoeB<true>, true, 0x7c7c7c7c, 0x77777777>(lds, S, E, D / 2, D / 2, 256);
        } else {
            pg8::SchedMoeB<false> S; S.A = (const char*)(P.ws + WS_BIG + BIG_H); S.Wd = (const char*)(P.ws + WS_WD) + (size_t)LAYER * 16 * 1048576; S.tilecls = tilecls; S.nM = __builtin_amdgcn_readfirstlane(tilecls[0]); S.G = nb; S.c = bid;
            for (int rep = 0; rep < REP_MOEB; ++rep) pg8::gemm_phase(lds, S, E, D, D, 512);
        }
    }
    SEAM(PB + 6);
    if (IN(PB + 7)) for (int rep = 0; rep < REP_LNF; ++rep) phase_lnffn(kparams(), LAYER, bid, nb);
    if (LAYER == 0) SEAM(PB + 7);
#undef IN
#undef SEAM
}

__global__ void __launch_bounds__(NTHREADS, 2) mega_fwd(Args a) {
    LAS unsigned char* lds = (LAS unsigned char*)g_lds;
    if (threadIdx.x < 4) ((LAS unsigned*)(lds + LDS_BARW))[threadIdx.x] = 0u;
    if (TPROBE_ID != 0 && threadIdx.x < 4) ((LAS unsigned*)(lds + LDS_TPROBE))[threadIdx.x] = 0u;
    if ((threadIdx.x & 63) == 0) *(LAS int*)(lds + LDS_WIDTAB + 4 * hw_wave_key()) = (int)(threadIdx.x >> 6);
    __syncthreads();
    if (a.ph_hi - a.ph_lo > 1) (void)xcd_barrier_post((unsigned*)(kparams().ws + WS_CTL) + CW_BAR, (volatile LAS unsigned*)(lds + LDS_BARW));
    if (kphase_lo() <= 0 && 0 < kphase_hi()) { for (int rep = 0; rep < REP_CONV; ++rep) phase_convert(kparams(), lds, blockIdx.x, gridDim.x); if (1 < kphase_hi()) grid_barrier(lds); }
    layer_phases<0>(lds);
    layer_phases<1>(lds);
    if (TPROBE_ID != 0 && blockIdx.x == TPROBE_BLOCK && opaque_tid() == 0) {
        const unsigned long long need = ((LAS unsigned long long*)(lds + LDS_TPROBE))[0] * TPROBE_MULT, t0 = wall_clock64();
        while (wall_clock64() - t0 < need) __builtin_amdgcn_s_sleep(8);
    }
}

extern "C" void kernel_launch(void* const* d_in, const int* in_sizes, int n_in, void* d_out, int out_size, void* d_ws, size_t ws_size, hipStream_t stream) {
    static int grid = 0;
    if (!grid) {
        if (n_in != 30 || ws_size < WS_END || out_size != T * D) { fprintf(stderr, "kernel_launch: unexpected shapes n_in %d ws %zu out %d\n", n_in, ws_size, out_size); grid = -1; return; }
        int dev = 0, cus = 0, per_cu = 0;
        if (hipGetDevice(&dev) != hipSuccess || hipDeviceGetAttribute(&cus, hipDeviceAttributeMultiprocessorCount, dev) != hipSuccess) { grid = -1; return; }
        if (hipFuncSetAttribute((const void*)mega_fwd, hipFuncAttributeMaxDynamicSharedMemorySize, LDS_BYTES) != hipSuccess) { fprintf(stderr, "kernel_launch: hipFuncSetAttribute failed\n"); grid = -1; return; }
        if (hipOccupancyMaxActiveBlocksPerMultiprocessor(&per_cu, (const void*)mega_fwd, NTHREADS, LDS_BYTES) != hipSuccess || per_cu < 1)
            fprintf(stderr, "kernel_launch: note: occupancy query reports %d workgroups per CU\n", per_cu);
        grid = cus > 0 ? cus : 256;
    }
    if (grid < 0) return;
    Args a{};
    for (int i = 0; i < 30; ++i) a.P.in[i] = (const float*)d_in[i];
    a.P.out = (unsigned char*)d_out; a.P.ws = (unsigned char*)d_ws;
    (void)hipMemsetAsync((char*)d_ws + WS_CTL, 0, CTL_BYTES, stream);
    constexpr int NL = MK_N_LAUNCHES;
    if (NL == 1) { a.ph_lo = 0; a.ph_hi = NPHASES; hipLaunchKernelGGL(mega_fwd, dim3(grid), dim3(NTHREADS), LDS_BYTES, stream, a); }
    else for (int p = 0; p < NPHASES; ++p) { a.ph_lo = p; a.ph_hi = p + 1; hipLaunchKernelGGL(mega_fwd, dim3(grid), dim3(NTHREADS), LDS_BYTES, stream, a); }
}
```

```cpp
#include <hip/hip_runtime.h>
#include <cstdio>
#include <cstdint>

#ifndef MIX_LREP
#define MIX_LREP 1
#endif
#ifndef MIX_SREP
#define MIX_SREP 1
#endif
#ifndef MIX_EREP
#define MIX_EREP 1
#endif
#define GAS __attribute__((address_space(1)))
#define LAS __attribute__((address_space(3)))
typedef unsigned short bf16_t;
typedef short bf16x8 __attribute__((ext_vector_type(8)));
typedef float f32x4 __attribute__((ext_vector_type(4)));
typedef unsigned u32x4 __attribute__((ext_vector_type(4)));

constexpr int BATCH = 32, SEQ = 2048, T = BATCH * SEQ, D = 1024;
constexpr int NP = 6400;
constexpr int YOFF = 1024;
constexpr int NCLS = 24, MAXTILES = 280;
constexpr float LN_EPS = 1e-5f, NORM_EPS = 1e-6f;
constexpr float ALPHA = 1.41421356237f;
constexpr int NTHREADS_C = 512;

constexpr int C0_RQ = 0, C0_RK = 512, C0_RV = 1024, C0_MV = 2048, C0_RG = 3072, C0_MQ = 4096, C0_MK = 4608, C0_MO = 5120, C0_MI = 6144, C0_MF = 6148;
constexpr int C1_GQ = 0, C1_GK = 512, C1_GV = 1024, C1_SZ = 2048, C1_GR = 3072, C1_XS = 4096, C1_BM = 5120, C1_CM = 5632, C1_GA = 6144, C1_DT = 6160;

constexpr size_t MiB = 1u << 20;
constexpr size_t WS_CTL = 0, CTL_BYTES = 1 * MiB;
constexpr size_t WS_WIN0 = 2 * MiB;
constexpr size_t WS_WIN1 = 15 * MiB;
constexpr size_t WS_WOUT0 = 28 * MiB;
constexpr size_t WS_WOUT1 = 32 * MiB;
constexpr size_t WS_WGU = 36 * MiB;
constexpr size_t WS_WD = 100 * MiB;
constexpr size_t WS_TOKCLS = 132 * MiB;
constexpr size_t WS_TOKPOS = WS_TOKCLS + (size_t)T * 4;
constexpr size_t WS_TOKDST = WS_TOKPOS + (size_t)T * 4;
constexpr size_t WS_TOKGATE = WS_TOKDST + (size_t)T * 4;
constexpr size_t WS_ROWGATE = WS_TOKGATE + (size_t)T * 8;
constexpr size_t WS_TILECLS = WS_ROWGATE + (size_t)MAXTILES * 256 * 8;
constexpr size_t WS_BIG = 136 * MiB;
constexpr size_t BIG_HS = 0, BIG_H = 160 * MiB, BIG_PRE2 = 320 * MiB, BIG_HS8 = 480 * MiB;
constexpr size_t WS_H8 = WS_BIG + (size_t)T * NP * 2;
constexpr size_t WS_WIN8_0 = WS_H8 + (size_t)T * D;
constexpr size_t WS_WIN8_1 = WS_WIN8_0 + (size_t)NP * D;
constexpr size_t WS_END = WS_WIN8_1 + (size_t)NP * D;
static_assert(WS_TILECLS + (MAXTILES + 8) * 4 <= WS_BIG, "ws map");
static_assert(WS_END <= 1024 * MiB, "ws map");
constexpr size_t OUT_H = 0, OUT_PRE1 = 128 * MiB;
constexpr int CW_CNT = 1024;
constexpr int CW_BAR = 4096;

__device__ __forceinline__ unsigned f2bf(float f) { unsigned u = __builtin_bit_cast(unsigned, f); return (u + 0x7fffu + ((u >> 16) & 1u)) >> 16; }
__device__ __forceinline__ unsigned pk2(float lo, float hi) { return f2bf(lo) | (f2bf(hi) << 16); }
__device__ __forceinline__ float bf2f(unsigned short b) { return __builtin_bit_cast(float, ((unsigned)b) << 16); }
__device__ __forceinline__ float bflo(unsigned w) { return __builtin_bit_cast(float, w << 16); }
__device__ __forceinline__ float bfhi(unsigned w) { return __builtin_bit_cast(float, w & 0xffff0000u); }
__device__ __forceinline__ float sigmoidf_(float x) { return 1.f / (1.f + __expf(-x)); }
__device__ __forceinline__ float siluf_(float x) { return x / (1.f + __expf(-x)); }
__device__ __forceinline__ float softplusf_(float x) { return x > 20.f ? x : log1pf(expf(x)); }
__device__ __forceinline__ float logsigmoidf_(float x) { return -softplusf_(-x); }
__device__ __forceinline__ float wave_sum(float v) {
#define WS_DPP(ctrl, rm) v += __builtin_bit_cast(float, __builtin_amdgcn_update_dpp(0, __builtin_bit_cast(int, v), ctrl, rm, 0xf, false))
    WS_DPP(0x111, 0xf); WS_DPP(0x112, 0xf); WS_DPP(0x114, 0xf); WS_DPP(0x118, 0xf); WS_DPP(0x142, 0xa); WS_DPP(0x143, 0xc);
#undef WS_DPP
    return __builtin_bit_cast(float, __builtin_amdgcn_readlane(__builtin_bit_cast(int, v), 63));
}
#define LDS_WAIT() asm volatile("s_waitcnt lgkmcnt(0)" ::: "memory")
__device__ __forceinline__ unsigned pk4_fp8(float a, float b, float c, float d) { int w = __builtin_amdgcn_cvt_pk_fp8_f32(a, b, 0, false); w = __builtin_amdgcn_cvt_pk_fp8_f32(c, d, w, true); return (unsigned)w; }
#ifndef MOE_FP8
#define MOE_FP8(layer) ((layer) >= 0)
#endif
#ifndef MOEA_FP8
#define MOEA_FP8 1
#endif
#ifndef INPROJ_FP8MASK0
#define INPROJ_FP8MASK0 0x00fcfffcu
#endif
#ifndef INPROJ_FP8MASK1
#define INPROJ_FP8MASK1 0x01ffffffu
#endif
constexpr unsigned ALLTILES = 0x01ffffffu;
#ifndef INPROJ_FP8
#define INPROJ_FP8(layer) ((layer) == 1)
#endif
constexpr float H8_SCALE = 8.f, W8_SCALE = 256.f;
#ifndef TPROBE_ID
#define TPROBE_ID 0
#endif
#ifndef TPROBE_BLOCK
#define TPROBE_BLOCK 128
#endif
#ifndef TPROBE_MULT
#define TPROBE_MULT 4
#endif
constexpr int LDS_TPROBE = 163840 - 48;
__device__ __forceinline__ int opaque_tid();
__device__ __forceinline__ void tp_begin(LAS unsigned char* lds, int id) { if (TPROBE_ID != 0 && TPROBE_ID == id && opaque_tid() == 0) ((LAS unsigned long long*)(lds + LDS_TPROBE))[1] = wall_clock64(); }
__device__ __forceinline__ void tp_end(LAS unsigned char* lds, int id) { if (TPROBE_ID != 0 && TPROBE_ID == id && opaque_tid() == 0) { LAS unsigned long long* p = (LAS unsigned long long*)(lds + LDS_TPROBE); p[0] += wall_clock64() - p[1]; } }
extern __shared__ __attribute__((aligned(16))) unsigned char g_lds[];
constexpr int LDS_WIDTAB = 163840 - 512;
__device__ __forceinline__ int hw_wave_key() { return (int)__builtin_amdgcn_s_getreg((5 << 11) | 4) & 63; }
__device__ __forceinline__ int opaque_tid() {
    const int wid = __builtin_amdgcn_readfirstlane(*(volatile LAS int*)((LAS unsigned char*)g_lds + LDS_WIDTAB + 4 * hw_wave_key()));
    int t = wid * 64 + (int)__builtin_amdgcn_mbcnt_hi(~0u, __builtin_amdgcn_mbcnt_lo(~0u, 0u)); asm volatile("" : "+v"(t)); return t; }

namespace pg8 {
constexpr int BM = 256, BK = 64, HALF = 128, HTB = HALF * BK * 2, STAGE_BYTES = 8 * HTB, NXCD = 8, WGM = 8;
__host__ __device__ __forceinline__ int lds_byte(int r, int c) { const int st = (r >> 4) * 2 + (c >> 5), rr = r & 15, cc = c & 31, ob = rr * 64 + cc * 2; return st * 1024 + (ob ^ (((ob >> 9) & 1) << 5)); }
__host__ __device__ __forceinline__ void stage_rc(int b, int& R, int& C) { const int st = b / 1024, sb = b % 1024, swz = sb ^ (((sb >> 9) & 1) << 5); R = (st >> 1) * 16 + swz / 64; C = (st & 1) * 32 + (swz % 64) / 2; }
__host__ __device__ __forceinline__ int perm32(int rho) { const int n = rho >> 4, i = rho & 15; return 8 * (i >> 2) + 4 * n + (i & 3); }

struct Unit { int pm, pn; unsigned a, b0, b1; };

__device__ __forceinline__ bool static_tile(int i, int G, int c, int nM, int nN, int& pm, int& pn) {
    const int nwg = nM * nN; const int L = i * G + c; if (L >= nwg) return false;
    int wgid = L; { const int q = nwg / NXCD, r = nwg % NXCD, xcd = wgid % NXCD, off = wgid / NXCD; wgid = (xcd < r ? xcd * (q + 1) : r * (q + 1) + (xcd - r) * q) + off; }
    const int nig = WGM * nN, gid = wgid / nig, fm = gid * WGM, gsz = (nM - fm) < WGM ? (nM - fm) : WGM;
    pm = fm + ((wgid % nig) % gsz); pn = (wgid % nig) / gsz; return true;
}
template <class Tp> __device__ __forceinline__ Tp* uniform_ptr(Tp* p) {
    const unsigned long long v = (unsigned long long)p;
    const unsigned lo = __builtin_amdgcn_readfirstlane((unsigned)v), hi = __builtin_amdgcn_readfirstlane((unsigned)(v >> 32));
    return (Tp*)(((unsigned long long)hi << 32) | lo); }
__device__ __forceinline__ unsigned cvt_pk_bf16(float lo, float hi) { unsigned r; asm volatile("v_cvt_pk_bf16_f32 %0, %1, %2" : "=v"(r) : "v"(lo), "v"(hi)); return r; }

typedef int i32x8 __attribute__((ext_vector_type(8)));
typedef int i32x4v __attribute__((ext_vector_type(4)));
__device__ __forceinline__ i32x8 cat16(const bf16x8& lo, const bf16x8& hi) { const i32x4v a = __builtin_bit_cast(i32x4v, lo), b = __builtin_bit_cast(i32x4v, hi); return (i32x8){a[0], a[1], a[2], a[3], b[0], b[1], b[2], b[3]}; }
#ifndef PG8_SP2
#define PG8_SP2 true
#endif
#ifndef PG8_ALIGN
#define PG8_ALIGN true
#endif
template <class Epi, class Sched, bool FP8 = false, int SCA = 0x7f7f7f7f, int SCB = 0x7f7f7f7f, bool SP2 = PG8_SP2, bool ALIGN_EPI = PG8_ALIGN>
__device__ __forceinline__ void gemm_phase(LAS unsigned char* lds, const Sched& S, const Epi& E, const int K, const int lda, const int ldb) {
    const int tid = opaque_tid(), wid = __builtin_amdgcn_readfirstlane(tid >> 6), lane = tid & 63, wr = wid >> 2, wc = wid & 3, fr = lane & 15, fq = lane >> 4;
    int nt = K / BK; asm volatile("" : "+s"(nt));
    constexpr int KS = Sched::KSPLIT;
    unsigned voffA0, voffB0;
    { int R, C; stage_rc(tid * 16, R, C); const int Rb = (R & ~31) + perm32(R & 31); voffA0 = (unsigned)(R * lda + C) * 2u; voffB0 = (unsigned)(Rb * ldb + C) * 2u; }
    const unsigned q64A = 64u * lda * 2u, q64B = 64u * ldb * 2u;
    const unsigned kstep = (unsigned)(BK * 2);
    const unsigned hstepA = (unsigned)HALF * lda * 2, hstepB = (unsigned)HALF * ldb * 2;
    const __amdgpu_buffer_rsrc_t rsA = __builtin_amdgcn_make_buffer_rsrc((void*)S.A, 0, 0xffffffff, 0x00020000), rsB = __builtin_amdgcn_make_buffer_rsrc((void*)S.bbase(), 0, 0xffffffff, 0x00020000);
    const unsigned ldsw = (unsigned)wid * 1024u;
    const int aoff = lds_byte(wr * 64 + fr, fq * 8), boff = lds_byte(wc * 32 + fr, fq * 8);
#define PG8_BP(u, kt) ((KS > 0 && (kt) >= KS) ? (u).b1 + (unsigned)((kt) - KS) * kstep : (u).b0 + (unsigned)(kt) * kstep)
#define PG8_SA(b, h) (((b) * 2 + (h)) * HTB)
#define PG8_SB(b, h) ((4 + (b) * 2 + (h)) * HTB)
#define PG8_STAGEA(bufoff, soff) do { _Pragma("unroll") for (int _i = 0; _i < 2; ++_i) \
        __builtin_amdgcn_raw_ptr_buffer_load_lds(rsA, (LAS void*)(lds + (bufoff) + ldsw + _i * 8192), 16, voffA0, (int)((soff) + _i * q64A), 0, 0); } while (0)
#define PG8_STAGEB(bufoff, soff) do { _Pragma("unroll") for (int _i = 0; _i < 2; ++_i) \
        __builtin_amdgcn_raw_ptr_buffer_load_lds(rsB, (LAS void*)(lds + (bufoff) + ldsw + _i * 8192), 16, voffB0, (int)((soff) + _i * q64B), 0, 0); } while (0)
#define PG8_LDA(dst, b, h) do { _Pragma("unroll") for (int m = 0; m < 4; ++m) _Pragma("unroll") for (int k = 0; k < 2; ++k) dst[m][k] = *(const LAS bf16x8*)(lds + PG8_SA(b, h) + aoff + m * 2048 + k * 1024); } while (0)
#define PG8_LDB(dst, b, h) do { _Pragma("unroll") for (int n = 0; n < 2; ++n) _Pragma("unroll") for (int k = 0; k < 2; ++k) dst[n][k] = *(const LAS bf16x8*)(lds + PG8_SB(b, h) + boff + n * 2048 + k * 1024); } while (0)
#define PG8_MMA(ai, bj, At, Bt) do { __builtin_amdgcn_s_setprio(1); _Pragma("unroll") for (int m = 0; m < 4; ++m) _Pragma("unroll") for (int n = 0; n < 2; ++n) { \
        if constexpr (FP8) acc[ai][bj][m][n] = __builtin_amdgcn_mfma_scale_f32_16x16x128_f8f6f4(cat16(Bt[n][0], Bt[n][1]), cat16(At[m][0], At[m][1]), acc[ai][bj][m][n], 0, 0, 1, ((SCB & 0xff) << 8) | (SCA & 0xff), 0, ((SCB & 0xff) << 8) | (SCA & 0xff)); \
        else { _Pragma("unroll") for (int k = 0; k < 2; ++k) acc[ai][bj][m][n] = __builtin_amdgcn_mfma_f32_16x16x32_bf16(Bt[n][k], At[m][k], acc[ai][bj][m][n], 0, 0, 0); } } \
        __builtin_amdgcn_s_setprio(0); } while (0)
#define PG8_WAIT_V(n) asm volatile("s_waitcnt vmcnt(" #n ")" ::: "memory")
#define PG8_WAIT_L(n) asm volatile("s_waitcnt lgkmcnt(" #n ")" ::: "memory")
#define PG8_BAR __builtin_amdgcn_s_barrier()
#define PG8_SCHED __builtin_amdgcn_sched_barrier(0)
    Unit cur, nxt; int ui = 0;
    if (!S.next(0, cur)) return;
    f32x4 acc[2][2][4][2];
#pragma unroll
    for (int a = 0; a < 2; ++a)
#pragma unroll
        for (int b = 0; b < 2; ++b)
#pragma unroll
            for (int m = 0; m < 4; ++m)
#pragma unroll
                for (int n = 0; n < 2; ++n) acc[a][b][m][n] = (f32x4){0.f, 0.f, 0.f, 0.f};
    bf16x8 At[4][2], B0[2][2], B1[2][2];
    unsigned cA = cur.a;
    E.prefetch(cur, tid);
    { const unsigned cB0 = PG8_BP(cur, 0), cB1 = PG8_BP(cur, 1);
    if constexpr (SP2) {
        PG8_STAGEB(PG8_SB(0, 0), cB0); PG8_STAGEB(PG8_SB(0, 1), cB0 + hstepB); PG8_STAGEA(PG8_SA(0, 0), cA); PG8_STAGEA(PG8_SA(0, 1), cA + hstepA);
        if (wr == 1) PG8_BAR;
        PG8_WAIT_V(2); PG8_BAR;
        PG8_STAGEB(PG8_SB(1, 0), cB1); PG8_STAGEA(PG8_SA(1, 0), cA + kstep); PG8_STAGEB(PG8_SB(1, 1), cB1 + hstepB);
        PG8_WAIT_V(6); PG8_BAR;
    } else {
    PG8_STAGEB(PG8_SB(0, 0), cB0); PG8_STAGEA(PG8_SA(0, 0), cA); PG8_STAGEB(PG8_SB(0, 1), cB0 + hstepB); PG8_STAGEA(PG8_SA(0, 1), cA + hstepA);
    if (wr == 1) PG8_BAR;
    PG8_WAIT_V(4); PG8_BAR;
    PG8_STAGEB(PG8_SB(1, 0), cB1); PG8_STAGEA(PG8_SA(1, 0), cA + kstep); PG8_STAGEB(PG8_SB(1, 1), cB1 + hstepB);
    PG8_WAIT_V(6); PG8_BAR; } }
    for (;;) {
        const bool has_next = S.next(ui + 1, nxt);
        if (!has_next) nxt = cur;
        for (int t = 0; t < nt; t += 2) {
            const bool last = (t == nt - 2);
            const unsigned a1 = cA + (unsigned)(t + 1) * kstep;
            const unsigned a2 = last ? nxt.a : cA + (unsigned)(t + 2) * kstep;
            const unsigned b2 = last ? PG8_BP(nxt, 0) : PG8_BP(cur, t + 2);
            const unsigned a3 = a2 + kstep;
            const unsigned b3 = last ? PG8_BP(nxt, 1) : PG8_BP(cur, t + 3);
            if constexpr (SP2) {
            PG8_LDB(B0, 0, 0); PG8_LDB(B1, 0, 1); PG8_SCHED; PG8_LDA(At, 0, 0); PG8_STAGEA(PG8_SA(1, 1), a1 + hstepA);
            PG8_WAIT_V(8); PG8_WAIT_L(0); PG8_BAR; PG8_MMA(0, 0, At, B0); PG8_MMA(0, 1, At, B1); PG8_BAR; PG8_SCHED;
            PG8_LDA(At, 0, 1); PG8_STAGEB(PG8_SB(0, 0), b2); PG8_STAGEB(PG8_SB(0, 1), b2 + hstepB); PG8_STAGEA(PG8_SA(0, 0), a2);
            PG8_WAIT_V(8); PG8_WAIT_L(0); PG8_BAR; PG8_MMA(1, 0, At, B0); PG8_MMA(1, 1, At, B1); PG8_BAR; PG8_SCHED;
            PG8_LDB(B0, 1, 0); PG8_LDB(B1, 1, 1); PG8_SCHED; PG8_LDA(At, 1, 0); PG8_STAGEA(PG8_SA(0, 1), a2 + hstepA);
            PG8_WAIT_V(8); PG8_WAIT_L(0); PG8_BAR; PG8_MMA(0, 0, At, B0); PG8_MMA(0, 1, At, B1); PG8_BAR; PG8_SCHED;
            PG8_LDA(At, 1, 1); PG8_STAGEB(PG8_SB(1, 0), b3); PG8_STAGEB(PG8_SB(1, 1), b3 + hstepB); PG8_STAGEA(PG8_SA(1, 0), a3);
            PG8_WAIT_V(8); PG8_WAIT_L(0); PG8_BAR; PG8_MMA(1, 0, At, B0); PG8_MMA(1, 1, At, B1); PG8_BAR; PG8_SCHED;
            } else {
            PG8_LDB(B0, 0, 0); PG8_SCHED; PG8_LDA(At, 0, 0); PG8_STAGEA(PG8_SA(1, 1), a1 + hstepA);
            PG8_WAIT_L(8); PG8_BAR; PG8_WAIT_L(0); PG8_MMA(0, 0, At, B0); PG8_BAR; PG8_SCHED;
            PG8_LDB(B1, 0, 1); PG8_STAGEB(PG8_SB(0, 0), b2);
            PG8_BAR; PG8_WAIT_L(0); PG8_MMA(0, 1, At, B1); PG8_BAR;
            PG8_LDA(At, 0, 1); PG8_STAGEA(PG8_SA(0, 0), a2);
            PG8_BAR; PG8_WAIT_L(0); PG8_MMA(1, 0, At, B0); PG8_BAR; PG8_SCHED;
            PG8_STAGEB(PG8_SB(0, 1), b2 + hstepB);
            PG8_WAIT_V(6); PG8_BAR; PG8_MMA(1, 1, At, B1); PG8_BAR;
            PG8_LDB(B0, 1, 0); PG8_SCHED; PG8_LDA(At, 1, 0); PG8_STAGEA(PG8_SA(0, 1), a2 + hstepA);
            PG8_WAIT_L(8); PG8_BAR; PG8_WAIT_L(0); PG8_MMA(0, 0, At, B0); PG8_BAR; PG8_SCHED;
            PG8_LDB(B1, 1, 1); PG8_STAGEB(PG8_SB(1, 0), b3);
            PG8_BAR; PG8_WAIT_L(0); PG8_MMA(0, 1, At, B1); PG8_BAR;
            PG8_LDA(At, 1, 1); PG8_STAGEA(PG8_SA(1, 0), a3);
            PG8_BAR; PG8_WAIT_L(0); PG8_MMA(1, 0, At, B0); PG8_BAR; PG8_SCHED;
            PG8_STAGEB(PG8_SB(1, 1), b3 + hstepB);
            PG8_WAIT_V(6); PG8_BAR; PG8_MMA(1, 1, At, B1); PG8_BAR;
            }
        }
        if constexpr (ALIGN_EPI) { if (wr == 0) PG8_BAR; }
        E(acc, cur, wr, wc, fr, fq);
        if (!has_next) break;
#pragma unroll
        for (int a = 0; a < 2; ++a)
#pragma unroll
            for (int b = 0; b < 2; ++b)
#pragma unroll
                for (int m = 0; m < 4; ++m)
#pragma unroll
                    for (int n = 0; n < 2; ++n) acc[a][b][m][n] = (f32x4){0.f, 0.f, 0.f, 0.f};
        cur = nxt; cA = cur.a; ++ui;
        E.prefetch(cur, tid);
        if constexpr (ALIGN_EPI) { if (wr == 1) PG8_BAR; }
    }
    PG8_WAIT_V(0);
    if constexpr (!ALIGN_EPI) { if (wr == 0) PG8_BAR; }
    PG8_BAR;
#undef PG8_BP
#undef PG8_SA
#undef PG8_SB
#undef PG8_STAGEA
#undef PG8_STAGEB
#undef PG8_LDA
#undef PG8_LDB
#undef PG8_MMA
#undef PG8_WAIT_V
#undef PG8_WAIT_L
#undef PG8_BAR
#undef PG8_SCHED
}

struct SchedPlain {
    static constexpr int KSPLIT = 0;
    const char* A; const char* B; int lda, ldb, nM, nN, G, c;
    __device__ __forceinline__ const char* bbase() const { return B; }
    __device__ __forceinline__ bool next(int i, Unit& u) const {
        if (!static_tile(i, G, c, nM, nN, u.pm, u.pn)) return false;
        u.a = (unsigned)u.pm * BM * lda * 2; u.b0 = (unsigned)u.pn * BM * ldb * 2; u.b1 = u.b0; return true;
    }
};
struct SchedCols {
    static constexpr int KSPLIT = 0;
    const char* A; const char* B; int lda, ldb, nM, nN, G, c; unsigned mask;
    __device__ __forceinline__ const char* bbase() const { return B; }
    __device__ __forceinline__ bool next(int i, Unit& u) const {
        int pnj; if (!static_tile(i, G, c, nM, nN, u.pm, pnj)) return false;
        unsigned m = mask; for (int j = 0; j < pnj; ++j) m &= m - 1u;
        u.pn = __builtin_ctz(m);
        u.a = (unsigned)u.pm * BM * lda * 2; u.b0 = (unsigned)u.pn * BM * ldb * 2; u.b1 = u.b0; return true;
    }
};
__device__ __forceinline__ void cls_experts(int cls, int& e0, int& e1) {
    const int g = cls / 6, p = cls % 6;
    const int a = p < 3 ? 0 : (p < 5 ? 1 : 2);
    const int b = p < 3 ? p + 1 : (p < 5 ? p - 1 : 3);
    e0 = 4 * g + a; e1 = 4 * g + b;
}
template <bool FP8>
struct SchedMoeA {
    static constexpr int KSPLIT = 0;
    static constexpr int RB = FP8 ? 1024 : 2048;
    const char* A; const char* Wgu; const int* tilecls; int nM, G, c;
    __device__ __forceinline__ const char* bbase() const { return Wgu; }
    __device__ __forceinline__ bool next(int i, Unit& u) const {
        if (!static_tile(i, G, c, nM, 8, u.pm, u.pn)) return false;
        int e0, e1; cls_experts(__builtin_amdgcn_readfirstlane(tilecls[8 + u.pm]), e0, e1); const int e = (u.pn >> 2) ? e1 : e0;
        u.a = (unsigned)u.pm * BM * RB; u.b0 = (unsigned)e * 2097152u + (unsigned)(u.pn & 3) * 256 * RB; u.b1 = u.b0; return true;
    }
};
template <bool FP8>
struct SchedMoeB {
    static constexpr int KSPLIT = FP8 ? 4 : 8;
    static constexpr int RA = FP8 ? 1024 : 2048, RBB = FP8 ? 512 : 1024;
    const char* A; const char* Wd; const int* tilecls; int nM, G, c;
    __device__ __forceinline__ const char* bbase() const { return Wd; }
    __device__ __forceinline__ bool next(int i, Unit& u) const {
        if (!static_tile(i, G, c, nM, 4, u.pm, u.pn)) return false;
        int e0, e1; cls_experts(__builtin_amdgcn_readfirstlane(tilecls[8 + u.pm]), e0, e1);
        u.a = (unsigned)u.pm * BM * RA;
        u.b0 = (unsigned)e0 * 1048576u + (unsigned)u.pn * 256 * RBB; u.b1 = (unsigned)e1 * 1048576u + (unsigned)u.pn * 256 * RBB; return true;
    }
};

struct EpiStore {
    bf16_t* O; int ldc;
    __device__ __forceinline__ void prefetch(const Unit&, int) const {}
    __device__ __forceinline__ void operator()(const f32x4 (&acc)[2][2][4][2], const Unit& u, int wr, int wc, int fr, int fq) const {
        const int row0 = u.pm * BM + wr * 64 + fr, col0 = u.pn * BM + wc * 32 + 8 * fq;
#pragma unroll
        for (int ai = 0; ai < 2; ++ai)
#pragma unroll
            for (int m = 0; m < 4; ++m) { bf16_t* rowp = O + (size_t)(row0 + ai * HALF + m * 16) * ldc + col0;
#pragma unroll
                for (int bj = 0; bj < 2; ++bj) { const f32x4 v0 = acc[ai][bj][m][0], v1 = acc[ai][bj][m][1];
                    u32x4 w; w.x = cvt_pk_bf16(v0[0], v0[1]); w.y = cvt_pk_bf16(v0[2], v0[3]); w.z = cvt_pk_bf16(v1[0], v1[1]); w.w = cvt_pk_bf16(v1[2], v1[3]);
                    *(u32x4*)(rowp + bj * HALF) = w; } }
    }
};
struct EpiResid {
    bf16_t* O; const bf16_t* R;
    __device__ __forceinline__ void prefetch(const Unit& u, int tid) const {
        const bf16_t* p = R + (size_t)(u.pm * BM + (tid >> 1)) * 1024 + u.pn * BM + 128 * (tid & 1);
        asm volatile("s_mov_b32 m0, %2\n\ts_nop 0\n\tglobal_load_lds_dword %0, off\n\ts_mov_b32 m0, %3\n\ts_nop 0\n\tglobal_load_lds_dword %1, off"
                     :: "v"(p), "v"(p + 64), "s"(160768u), "s"(161024u) : "memory", "m0");
    }
    __device__ __forceinline__ void operator()(const f32x4 (&acc)[2][2][4][2], const Unit& u, int wr, int wc, int fr, int fq) const {
        const int row0 = u.pm * BM + wr * 64 + fr, col0 = u.pn * BM + wc * 32 + 8 * fq;
#pragma unroll
        for (int ai = 0; ai < 2; ++ai)
#pragma unroll
            for (int m = 0; m < 4; ++m) { const size_t off = (size_t)(row0 + ai * HALF + m * 16) * 1024 + col0;
#pragma unroll
                for (int bj = 0; bj < 2; ++bj) { const f32x4 v0 = acc[ai][bj][m][0], v1 = acc[ai][bj][m][1];
                    const u32x4 r = *(const u32x4*)(R + off + bj * HALF);
                    u32x4 w; w.x = cvt_pk_bf16(v0[0] + ALPHA * bflo(r.x), v0[1] + ALPHA * bfhi(r.x)); w.y = cvt_pk_bf16(v0[2] + ALPHA * bflo(r.y), v0[3] + ALPHA * bfhi(r.y));
                    w.z = cvt_pk_bf16(v1[0] + ALPHA * bflo(r.z), v1[1] + ALPHA * bfhi(r.z)); w.w = cvt_pk_bf16(v1[2] + ALPHA * bflo(r.w), v1[3] + ALPHA * bfhi(r.w));
                    *(u32x4*)(O + off + bj * HALF) = w; } }
    }
};
struct EpiSwiglu {
    bf16_t* H; const float* rowgate;
    __device__ __forceinline__ void prefetch(const Unit&, int) const {}
    __device__ __forceinline__ void operator()(const f32x4 (&acc)[2][2][4][2], const Unit& u, int wr, int wc, int fr, int fq) const {
        const int row0 = u.pm * BM + wr * 64 + fr, ke = u.pn >> 2, col0 = 512 * ke + 128 * (u.pn & 3) + wc * 32 + 8 * fq;
#pragma unroll
        for (int ai = 0; ai < 2; ++ai)
#pragma unroll
            for (int m = 0; m < 4; ++m) { const int row = row0 + ai * HALF + m * 16; const float gt = rowgate[(size_t)row * 2 + ke];
                const f32x4 g0 = acc[ai][0][m][0], g1 = acc[ai][0][m][1], u0 = acc[ai][1][m][0], u1 = acc[ai][1][m][1];
                float o[8];
#pragma unroll
                for (int j = 0; j < 4; ++j) { o[j] = siluf_(g0[j]) * u0[j] * gt; o[4 + j] = siluf_(g1[j]) * u1[j] * gt; }
                u32x4 w; w.x = cvt_pk_bf16(o[0], o[1]); w.y = cvt_pk_bf16(o[2], o[3]); w.z = cvt_pk_bf16(o[4], o[5]); w.w = cvt_pk_bf16(o[6], o[7]);
                *(u32x4*)(H + (size_t)row * 1024 + col0) = w; }
    }
};
struct EpiSwiglu8 {
    unsigned char* H; const float* rowgate;
    __device__ __forceinline__ void prefetch(const Unit&, int) const {}
    __device__ __forceinline__ void operator()(const f32x4 (&acc)[2][2][4][2], const Unit& u, int wr, int wc, int fr, int fq) const {
        typedef unsigned u32x2 __attribute__((ext_vector_type(2)));
        const int row0 = u.pm * BM + wr * 64 + fr, ke = u.pn >> 2, col0 = 512 * ke + 128 * (u.pn & 3) + wc * 32 + 8 * fq;
        unsigned char* const H = uniform_ptr(this->H); const float* const rowgate = uniform_ptr(this->rowgate);
#pragma unroll
        for (int ai = 0; ai < 2; ++ai)
#pragma unroll
            for (int m = 0; m < 4; ++m) { const int row = row0 + ai * HALF + m * 16; const float gt = rowgate[(size_t)row * 2 + ke] * 8.f;
                const f32x4 g0 = acc[ai][0][m][0], g1 = acc[ai][0][m][1], u0 = acc[ai][1][m][0], u1 = acc[ai][1][m][1];
                float o[8];
#pragma unroll
                for (int j = 0; j < 4; ++j) { o[j] = __builtin_amdgcn_fmed3f(g0[j] * __builtin_amdgcn_rcpf(1.f + __builtin_amdgcn_exp2f(-1.4426950408889634f * g0[j])) * u0[j] * gt, -440.f, 440.f);
                    o[4 + j] = __builtin_amdgcn_fmed3f(g1[j] * __builtin_amdgcn_rcpf(1.f + __builtin_amdgcn_exp2f(-1.4426950408889634f * g1[j])) * u1[j] * gt, -440.f, 440.f); }
                *(u32x2*)(H + (size_t)row * 1024 + col0) = (u32x2){pk4_fp8(o[0], o[1], o[2], o[3]), pk4_fp8(o[4], o[5], o[6], o[7])}; }
    }
};
}

struct Params {
    const float* in[30];
    unsigned char* out;
    unsigned char* ws;
};
enum { I_X = 0, I_POS, I_WINAB, I_RETG, I_MLCW, I_MLCB, I_MLBI, I_MLBF, I_MLG, I_WOUTAB, I_WINCD, I_GLAWA, I_GLABA, I_GLAG, I_SSDCW, I_SSDCB, I_SSDDTB, I_SSDALOG, I_SSDD, I_SSDG,
       I_WOUTCD, I_WR, I_BR, I_MOEG, I_MOEU, I_MOED, I_LNMG, I_LNMB, I_LNFG, I_LNFB };

template <class ColPtr>
__device__ __forceinline__ void tr_item(const ColPtr& cp, int ldw, bf16_t* WT, int ldt, int n0, int k0, LAS float* scr, int lane) {
    const float* p = cp(n0 + (lane & 31));
#pragma unroll 8
    for (int i = 0; i < 32; ++i) { const int kk = 2 * i + (lane >> 5); scr[kk * 33 + (lane & 31)] = p ? p[(size_t)(k0 + kk) * ldw] : 0.f; }
    LDS_WAIT();
    const int c = lane & 7;
#pragma unroll
    for (int j = 0; j < 4; ++j) { const int n = (lane >> 3) + 8 * j; const LAS float* s = scr + (8 * c) * 33 + n;
        u32x4 o; o.x = pk2(s[0 * 33], s[1 * 33]); o.y = pk2(s[2 * 33], s[3 * 33]); o.z = pk2(s[4 * 33], s[5 * 33]); o.w = pk2(s[6 * 33], s[7 * 33]);
        *(u32x4*)(WT + (size_t)(n0 + n) * ldt + k0 + 8 * c) = o; }
    LDS_WAIT();
}
template <class ColPtr>
__device__ __forceinline__ void tr_item_fp8(const ColPtr& cp, int ldw, unsigned char* WT, int ldt, int n0, int k0, float scale, LAS float* scr, int lane) {
    const float* p = cp(n0 + (lane & 31));
#pragma unroll 8
    for (int i = 0; i < 32; ++i) { const int kk = 2 * i + (lane >> 5); scr[kk * 33 + (lane & 31)] = p ? p[(size_t)(k0 + kk) * ldw] * scale : 0.f; }
    LDS_WAIT();
    const int c = lane & 7;
    typedef unsigned u32x2 __attribute__((ext_vector_type(2)));
#pragma unroll
    for (int j = 0; j < 4; ++j) { const int n = (lane >> 3) + 8 * j; const LAS float* s = scr + (8 * c) * 33 + n;
        *(u32x2*)(WT + (size_t)(n0 + n) * ldt + k0 + 8 * c) = (u32x2){pk4_fp8(s[0 * 33], s[1 * 33], s[2 * 33], s[3 * 33]), pk4_fp8(s[4 * 33], s[5 * 33], s[6 * 33], s[7 * 33])}; }
    LDS_WAIT();
}
__device__ __forceinline__ int map_ab(int n) {
    if (n < 2048) return n;
    if (n < 3072) return 4096 + (n - 2048);
    if (n < 4096) return 2048 + (n - 3072);
    if (n < 4608) return 3072 + (n - 4096);
    if (n < 5120) return 3584 + (n - 4608);
    if (n < 6152) return n;
    return -1;
}
__device__ __forceinline__ int map_cd(int n) {
    if (n < 2048) return n;
    if (n < 3072) return 3088 + (n - 2048);
    if (n < 4096) return 2048 + (n - 3072);
    if (n < 5120) return 4112 + (n - 4096);
    if (n < 5632) return 5136 + (n - 5120);
    if (n < 6144) return 5648 + (n - 5632);
    if (n < 6160) return 3072 + (n - 6144);
    if (n < 6176) return 6160 + (n - 6160);
    return -1;
}
template <bool FP8, class ColPtr>
__device__ __forceinline__ void tr_block(const ColPtr& cp, int ldw, void* WT, int ldt, int n0, int k0, float scale, LAS float* tile, int tid) {
    {   const int c4 = tid & 63, r0 = tid >> 6;
        const float* p = cp(n0 + 4 * c4);
        f32x4 v[8];
#pragma unroll
        for (int i = 0; i < 8; ++i) v[i] = p ? *(const f32x4*)(p + (size_t)(k0 + r0 + 8 * i) * ldw) : (f32x4){0.f, 0.f, 0.f, 0.f};
#pragma unroll
        for (int i = 0; i < 8; ++i) { LAS float* t = tile + (r0 + 8 * i) * 257 + 4 * c4; t[0] = v[i][0] * scale; t[1] = v[i][1] * scale; t[2] = v[i][2] * scale; t[3] = v[i][3] * scale; }
    }
    __syncthreads();
    {   const int kc = tid & 7, nr = tid >> 3;
#pragma unroll
        for (int j = 0; j < 4; ++j) { const int n = nr + 64 * j; const LAS float* t = tile + (8 * kc) * 257 + n;
            if constexpr (FP8) { typedef unsigned u32x2 __attribute__((ext_vector_type(2)));
                *(u32x2*)((unsigned char*)WT + (size_t)(n0 + n) * ldt + k0 + 8 * kc) = (u32x2){pk4_fp8(t[0], t[257], t[514], t[771]), pk4_fp8(t[1028], t[1285], t[1542], t[1799])}; }
            else { u32x4 o; o.x = pk2(t[0], t[257]); o.y = pk2(t[514], t[771]); o.z = pk2(t[1028], t[1285]); o.w = pk2(t[1542], t[1799]);
                *(u32x4*)((bf16_t*)WT + (size_t)(n0 + n) * ldt + k0 + 8 * kc) = o; } }
    }
    __syncthreads();
}
__device__ __forceinline__ void convert_moe(const Params& P, LAS unsigned char* lds, int bid, int nb) {
    const int tid = opaque_tid();
    LAS float* tile = (LAS float*)lds;
    unsigned char* ws = P.ws;
    constexpr int B_GU = (1024 / 256) * (1024 / 64);
    constexpr int B_DN = (1024 / 256) * (512 / 64);
    constexpr int B_IN = (NP / 256) * (D / 64);
    constexpr int B_OUT = (1024 / 256) * (2048 / 64);
#pragma unroll 1
    for (int it = bid; it < 32 * B_GU + 32 * B_DN + B_IN + 2 * B_OUT; it += nb) {
        int r = it;
        if (r < B_IN) { const int nbk = r / (D / 64), kb = r % (D / 64);
            const float* W = P.in[I_WINCD];
            auto cp = [&](int n) { const int sc = map_cd(n); return sc < 0 ? (const float*)nullptr : W + sc; };
            if ((INPROJ_FP8MASK1 >> nbk) & 1u) tr_block<true>(cp, 6176, ws + WS_WIN8_1, D, nbk * 256, kb * 64, W8_SCALE, tile, tid); else tr_block<false>(cp, 6176, ws + WS_WIN1, D, nbk * 256, kb * 64, 1.f, tile, tid);
            continue; }
        r -= B_IN;
        if (r < 2 * B_OUT) { const int l = r / B_OUT; r %= B_OUT; const int nbk = r / 32, kb = r % 32;
            const float* W = P.in[l ? I_WOUTCD : I_WOUTAB];
            tr_block<false>([&](int n) { return W + n; }, 1024, ws + (l ? WS_WOUT1 : WS_WOUT0), 2048, nbk * 256, kb * 64, 1.f, tile, tid);
            continue; }
        r -= 2 * B_OUT;
        if (r < 32 * B_GU) { const int le = r / B_GU; r %= B_GU; const int nbk = r / 16, kb = r % 16;
            const float* Wg = P.in[I_MOEG] + (size_t)le * 1024 * 512 + 128 * nbk; const float* Wu = P.in[I_MOEU] + (size_t)le * 1024 * 512 + 128 * nbk; const int n0 = nbk * 256;
            auto cp = [&](int n) { const int wdt = n - n0; return wdt < 128 ? Wg + wdt : Wu + (wdt - 128); };
            if (MOE_FP8(le >> 4) && MOEA_FP8) tr_block<true>(cp, 512, ws + WS_WGU + (size_t)le * 2097152, 1024, n0, kb * 64, W8_SCALE, tile, tid);
            else tr_block<false>(cp, 512, ws + WS_WGU + (size_t)le * 2097152, 1024, n0, kb * 64, 1.f, tile, tid);
            continue; }
        r -= 32 * B_GU;
        { const int le = r / B_DN; r %= B_DN; const int nbk = r / 8, kb = r % 8;
            const float* W = P.in[I_MOED] + (size_t)le * 512 * 1024;
            if (MOE_FP8(le >> 4)) tr_block<true>([&](int n) { return W + n; }, 1024, ws + WS_WD + (size_t)le * 1048576, 512, nbk * 256, kb * 64, W8_SCALE, tile, tid);
            else tr_block<false>([&](int n) { return W + n; }, 1024, ws + WS_WD + (size_t)le * 1048576, 512, nbk * 256, kb * 64, 1.f, tile, tid); }
    }
}
__device__ __forceinline__ void phase_convert(const Params& P, LAS unsigned char* lds, int bid, int nb) {
    const int tid = opaque_tid();
    LAS float* tile = (LAS float*)lds;
    unsigned char* ws = P.ws;
    constexpr int B_IN = (NP / 256) * (D / 64);
    tp_begin(lds, 910);
#pragma unroll 1
    for (int it = bid; it < B_IN; it += nb) {
        const int nbk = it / (D / 64), kb = it % (D / 64);
        const float* W = P.in[I_WINAB];
        auto cp = [&](int n) { const int sc = map_ab(n); return sc < 0 ? (const float*)nullptr : W + sc; };
        if ((INPROJ_FP8MASK0 >> nbk) & 1u) tr_block<true>(cp, 6152, ws + WS_WIN8_0, D, nbk * 256, kb * 64, W8_SCALE, tile, tid); else tr_block<false>(cp, 6152, ws + WS_WIN0, D, nbk * 256, kb * 64, 1.f, tile, tid);
    }
    const int nw = blockDim.x >> 6; (void)nw;
    asm volatile("s_waitcnt vmcnt(0)" ::: "memory"); tp_end(lds, 910); tp_begin(lds, 911);
    const float* x = P.in[I_X]; bf16_t* h = (bf16_t*)(P.out + OUT_H);
    const size_t n8 = (size_t)T * D / 8;
    const size_t stride = (size_t)nb * blockDim.x;
    for (size_t i0 = (size_t)bid * blockDim.x + tid; i0 < n8; i0 += 4 * stride) {
        f32x4 a[4], b[4];
#pragma unroll
        for (int u = 0; u < 4; ++u) { const size_t i = i0 + u * stride; if (i < n8) { a[u] = *(const f32x4*)(x + i * 8); b[u] = *(const f32x4*)(x + i * 8 + 4); } }
#pragma unroll
        for (int u = 0; u < 4; ++u) { const size_t i = i0 + u * stride; if (i < n8) {
            u32x4 o; o.x = pk2(a[u][0], a[u][1]); o.y = pk2(a[u][2], a[u][3]); o.z = pk2(b[u][0], b[u][1]); o.w = pk2(b[u][2], b[u][3]);
            *(u32x4*)(h + i * 8) = o;
            typedef unsigned u32x2 __attribute__((ext_vector_type(2)));
            *(u32x2*)(ws + WS_H8 + i * 8) = (u32x2){pk4_fp8(a[u][0] * H8_SCALE, a[u][1] * H8_SCALE, a[u][2] * H8_SCALE, a[u][3] * H8_SCALE), pk4_fp8(b[u][0] * H8_SCALE, b[u][1] * H8_SCALE, b[u][2] * H8_SCALE, b[u][3] * H8_SCALE)}; } }
    }
    asm volatile("s_waitcnt vmcnt(0)" ::: "memory"); tp_end(lds, 911);
}

__device__ __forceinline__ void load_row_bf16(const bf16_t* row, int lane, float (&v)[16]) {
#pragma unroll
    for (int j = 0; j < 2; ++j) { const u32x4 w = *(const u32x4*)(row + 8 * lane + 512 * j);
        v[8 * j + 0] = bflo(w.x); v[8 * j + 1] = bfhi(w.x); v[8 * j + 2] = bflo(w.y); v[8 * j + 3] = bfhi(w.y);
        v[8 * j + 4] = bflo(w.z); v[8 * j + 5] = bfhi(w.z); v[8 * j + 6] = bflo(w.w); v[8 * j + 7] = bfhi(w.w); }
}
__device__ __forceinline__ void ln_row(float (&v)[16], const float* g, const float* b, int lane) {
    float s = 0.f;
#pragma unroll
    for (int i = 0; i < 16; ++i) s += v[i];
    const float mean = wave_sum(s) * (1.f / D); float q = 0.f;
#pragma unroll
    for (int i = 0; i < 16; ++i) { v[i] -= mean; q += v[i] * v[i]; }
    const float rstd = rsqrtf(wave_sum(q) * (1.f / D) + LN_EPS);
#pragma unroll
    for (int j = 0; j < 2; ++j) {
        const f32x4 g0 = *(const f32x4*)(g + 8 * lane + 512 * j), g1 = *(const f32x4*)(g + 8 * lane + 512 * j + 4);
        const f32x4 b0 = *(const f32x4*)(b + 8 * lane + 512 * j), b1 = *(const f32x4*)(b + 8 * lane + 512 * j + 4);
#pragma unroll
        for (int i = 0; i < 4; ++i) { v[8 * j + i] = v[8 * j + i] * rstd * g0[i] + b0[i]; v[8 * j + 4 + i] = v[8 * j + 4 + i] * rstd * g1[i] + b1[i]; }
    }
}
__device__ __forceinline__ void load_gb(const float* g, const float* b, int lane, float (&gr)[16], float (&br)[16]) {
#pragma unroll
    for (int j = 0; j < 2; ++j) {
        const f32x4 g0 = *(const f32x4*)(g + 8 * lane + 512 * j), g1 = *(const f32x4*)(g + 8 * lane + 512 * j + 4);
        const f32x4 b0 = *(const f32x4*)(b + 8 * lane + 512 * j), b1 = *(const f32x4*)(b + 8 * lane + 512 * j + 4);
#pragma unroll
        for (int i = 0; i < 4; ++i) { gr[8 * j + i] = g0[i]; gr[8 * j + 4 + i] = g1[i]; br[8 * j + i] = b0[i]; br[8 * j + 4 + i] = b1[i]; }
    }
}
__device__ __forceinline__ void ln_row_r(float (&v)[16], const float (&gr)[16], const float (&br)[16]) {
    float s = 0.f;
#pragma unroll
    for (int i = 0; i < 16; ++i) s += v[i];
    const float mean = wave_sum(s) * (1.f / D); float q = 0.f;
#pragma unroll
    for (int i = 0; i < 16; ++i) { v[i] -= mean; q += v[i] * v[i]; }
    const float rstd = rsqrtf(wave_sum(q) * (1.f / D) + LN_EPS);
#pragma unroll
    for (int i = 0; i < 16; ++i) v[i] = v[i] * rstd * gr[i] + br[i];
}
__device__ __forceinline__ void store_row_bf16(bf16_t* row, int lane, const float (&v)[16]) {
#pragma unroll
    for (int j = 0; j < 2; ++j) { u32x4 o; o.x = pk2(v[8 * j + 0], v[8 * j + 1]); o.y = pk2(v[8 * j + 2], v[8 * j + 3]); o.z = pk2(v[8 * j + 4], v[8 * j + 5]); o.w = pk2(v[8 * j + 6], v[8 * j + 7]);
        *(u32x4*)(row + 8 * lane + 512 * j) = o; }
}

__device__ __forceinline__ void phase_route(const Params& P, int layer, LAS unsigned char* lds, int bid, int nb, int cntoff) {
    const int tid = opaque_tid(), lane = tid & 63, wave = tid >> 6;
    LAS unsigned char* Bhi = lds; LAS unsigned char* Blo = lds + 32768;
    LAS float* cd = (LAS float*)(lds + 65536);
    LAS float* part = cd + 32;
    LAS int* lcnt = (LAS int*)(part + 1024);
    LAS int* lbase = lcnt + 32; LAS int* rcls = lbase + 32; LAS int* rpos = rcls + 256;
    const bf16_t* pre1 = (const bf16_t*)(P.out + OUT_PRE1);
    const float* g = P.in[I_LNMG] + layer * D; const float* b = P.in[I_LNMB] + layer * D;
    const float* Wr = P.in[I_WR]; const float* br = P.in[I_BR];
    int* tokcls = (int*)(P.ws + WS_TOKCLS); int* tokpos = (int*)(P.ws + WS_TOKPOS); float* tokgate = (float*)(P.ws + WS_TOKGATE);
    unsigned* gcnt = (unsigned*)(P.ws + WS_CTL) + CW_CNT + 64 * layer + cntoff;
#pragma unroll 1
    for (int idx = tid; idx < 2048; idx += NTHREADS_C) {
        const int s = idx >> 6, l = idx & 63, e = l & 15, k0 = 32 * s + 8 * (l >> 4);
        unsigned hi[4], lo[4];
#pragma unroll
        for (int j = 0; j < 4; ++j) {
            const float w0 = g[k0 + 2 * j] * Wr[(k0 + 2 * j) * 16 + e], w1 = g[k0 + 2 * j + 1] * Wr[(k0 + 2 * j + 1) * 16 + e];
            const unsigned h0 = f2bf(w0), h1 = f2bf(w1);
            hi[j] = h0 | (h1 << 16); lo[j] = pk2(w0 - bf2f((unsigned short)h0), w1 - bf2f((unsigned short)h1)); }
        *(LAS u32x4*)(Bhi + idx * 16) = (u32x4){hi[0], hi[1], hi[2], hi[3]};
        *(LAS u32x4*)(Blo + idx * 16) = (u32x4){lo[0], lo[1], lo[2], lo[3]};
    }
    { const int e = tid & 15, pt = tid >> 4; float cs = 0.f, ds = 0.f;
#pragma unroll 4
      for (int kk = 0; kk < 32; ++kk) { const int k = pt * 32 + kk; const float w = Wr[k * 16 + e]; cs += g[k] * w; ds += b[k] * w; }
      part[pt * 32 + e] = cs; part[pt * 32 + 16 + e] = ds; }
    __syncthreads();
    if (tid < 32) { float sacc = 0.f;
#pragma unroll 4
        for (int pt = 0; pt < 32; ++pt) sacc += part[pt * 32 + tid];
        cd[tid] = sacc; }
    __syncthreads();
    const int e = lane & 15, q = lane >> 4;
    const float ce = cd[e], de = cd[16 + e], bre = br[e];
    for (int r0 = bid * 256; r0 < T; r0 += nb * 256) {
        if (tid < 32) lcnt[tid] = 0;
        __syncthreads();
#pragma unroll 1
        for (int tile = 0; tile < 2; ++tile) {
            const int tr0 = wave * 32 + tile * 16;
            const bf16_t* arow = pre1 + (size_t)(r0 + tr0 + e) * D + 8 * q;
            f32x4 acc = (f32x4){0.f, 0.f, 0.f, 0.f}; float s1 = 0.f, s2 = 0.f;
#pragma unroll 1
            for (int s0 = 0; s0 < 32; s0 += 8) {
                u32x4 a[8];
#pragma unroll
                for (int u = 0; u < 8; ++u) a[u] = *(const u32x4*)(arow + 32 * (s0 + u));
#pragma unroll
                for (int u = 0; u < 8; ++u) {
                    const bf16x8 bh = *(const LAS bf16x8*)(Bhi + ((s0 + u) * 64 + lane) * 16), bl = *(const LAS bf16x8*)(Blo + ((s0 + u) * 64 + lane) * 16);
                    const bf16x8 af = __builtin_bit_cast(bf16x8, a[u]);
                    acc = __builtin_amdgcn_mfma_f32_16x16x32_bf16(af, bh, acc, 0, 0, 0);
                    acc = __builtin_amdgcn_mfma_f32_16x16x32_bf16(af, bl, acc, 0, 0, 0);
                    const float x0 = bflo(a[u].x), x1 = bfhi(a[u].x), x2 = bflo(a[u].y), x3 = bfhi(a[u].y), x4 = bflo(a[u].z), x5 = bfhi(a[u].z), x6 = bflo(a[u].w), x7 = bfhi(a[u].w);
                    s1 += ((x0 + x1) + (x2 + x3)) + ((x4 + x5) + (x6 + x7));
                    s2 += ((x0 * x0 + x1 * x1) + (x2 * x2 + x3 * x3)) + ((x4 * x4 + x5 * x5) + (x6 * x6 + x7 * x7));
                }
            }
            s1 += __shfl_xor(s1, 16); s1 += __shfl_xor(s1, 32); s2 += __shfl_xor(s2, 16); s2 += __shfl_xor(s2, 32);
            const float mean = s1 * (1.f / D); const float rstd = rsqrtf(fmaxf(s2 * (1.f / D) - mean * mean, 0.f) + LN_EPS);
#pragma unroll
            for (int r = 0; r < 4; ++r) {
                const int R = 4 * q + r;
                const float mr = __shfl(mean, R), rr = __shfl(rstd, R);
                const float lg = rr * (acc[r] - mr * ce) + de;
                float mx = lg;
#pragma unroll
                for (int o = 1; o < 16; o <<= 1) mx = fmaxf(mx, __shfl_xor(mx, o));
                float p = expf(lg - mx), sum = p;
#pragma unroll
                for (int o = 1; o < 16; o <<= 1) sum += __shfl_xor(sum, o);
                p = p / sum;
                const float sel = p + bre;
                int rank = 0;
#pragma unroll
                for (int o = 1; o < 4; ++o) { const float so = __shfl_xor(sel, o); const int eo = e ^ o; rank += (so > sel || (so == sel && eo < e)) ? 1 : 0; }
                float gs = rank < 2 ? sel : 0.f;
                gs += __shfl_xor(gs, 1); gs += __shfl_xor(gs, 2);
                int gi = e >> 2;
#pragma unroll
                for (int o = 4; o < 16; o <<= 1) { const float go = __shfl_xor(gs, o); const int io = __shfl_xor(gi, o); if (go > gs || (go == gs && io < gi)) { gs = go; gi = io; } }
                const bool chosen = ((e >> 2) == gi) && rank < 2;
                const unsigned long long bm = __ballot(chosen);
                const unsigned m4 = (unsigned)(bm >> (16 * q + 4 * gi)) & 0xFu;
                const int ea = __ffs((int)m4) - 1, eb = 31 - __clz((int)m4);
                const int pidx = ea == 0 ? eb - 1 : (ea == 1 ? eb + 1 : 5);
                const float pa = __shfl(p, 16 * q + 4 * gi + ea), pb = __shfl(p, 16 * q + 4 * gi + eb);
                if (e == r) { const int cls = gi * 6 + pidx; const int rl = tr0 + R; const int lp = atomicAdd((int*)&lcnt[cls], 1); rcls[rl] = cls; rpos[rl] = lp;
                    const float inv = 1.f / (pa + pb); const size_t t = (size_t)(r0 + rl); tokgate[t * 2] = pa * inv; tokgate[t * 2 + 1] = pb * inv; }
            }
        }
        __syncthreads();
        if (tid < NCLS) lbase[tid] = (int)atomicAdd(&gcnt[tid], (unsigned)lcnt[tid]);
        __syncthreads();
        if (tid < 256) { const int t = r0 + tid; const int c = rcls[tid]; tokcls[t] = c; tokpos[t] = lbase[c] + rpos[tid]; }
        __syncthreads();
    }
}
__device__ __forceinline__ void phase_permute(const Params& P, int layer, LAS unsigned char* lds, int bid, int nb) {
    const int tid = opaque_tid(), lane = tid & 63, wave = tid >> 6, nw = blockDim.x >> 6;
    LAS int* off = (LAS int*)lds;
    const unsigned* gcnt = (const unsigned*)(P.ws + WS_CTL) + CW_CNT + 64 * layer;
    int* tilecls = (int*)(P.ws + WS_TILECLS);
    if (tid == 0) { int o = 0; for (int c = 0; c < NCLS; ++c) { off[c] = o * 256; const int nt = ((int)gcnt[c] + 255) >> 8;
            if (bid == 0) for (int i = 0; i < nt; ++i) tilecls[8 + o + i] = c;
            o += nt; }
        if (bid == 0) tilecls[0] = o; }
    __syncthreads();
    const bf16_t* pre1 = (const bf16_t*)(P.out + OUT_PRE1); bf16_t* hs = (bf16_t*)(P.ws + WS_BIG + BIG_HS);
    const float* g = P.in[I_LNMG] + layer * D; const float* b = P.in[I_LNMB] + layer * D;
    const int* tokcls = (const int*)(P.ws + WS_TOKCLS); const int* tokpos = (const int*)(P.ws + WS_TOKPOS); int* tokdst = (int*)(P.ws + WS_TOKDST);
    const float* tokgate = (const float*)(P.ws + WS_TOKGATE); float* rowgate = (float*)(P.ws + WS_ROWGATE);
    float gr[16], br[16]; load_gb(g, b, lane, gr, br);
    for (int t0 = bid * nw + wave; t0 < T; t0 += 2 * nb * nw) {
        const int t1 = t0 + nb * nw; const bool has1 = t1 < T;
        float v0[16], v1[16];
        load_row_bf16(pre1 + (size_t)t0 * D, lane, v0);
        if (has1) load_row_bf16(pre1 + (size_t)t1 * D, lane, v1);
        const int dst0 = off[tokcls[t0]] + tokpos[t0]; const int dst1 = has1 ? off[tokcls[t1]] + tokpos[t1] : 0;
#pragma unroll
        for (int rr = 0; rr < 2; ++rr) {
            if (rr == 1 && !has1) break;
            float (&v)[16] = rr ? v1 : v0; const int t = rr ? t1 : t0, dst = rr ? dst1 : dst0;
            ln_row_r(v, gr, br);
            store_row_bf16(hs + (size_t)dst * D, lane, v);
            if (MOE_FP8(layer) && MOEA_FP8) { typedef unsigned u32x2 __attribute__((ext_vector_type(2)));
#pragma unroll
                for (int j = 0; j < 2; ++j) *(u32x2*)(P.ws + WS_BIG + BIG_HS8 + (size_t)dst * D + 8 * lane + 512 * j) = (u32x2){pk4_fp8(v[8 * j] * H8_SCALE, v[8 * j + 1] * H8_SCALE, v[8 * j + 2] * H8_SCALE, v[8 * j + 3] * H8_SCALE), pk4_fp8(v[8 * j + 4] * H8_SCALE, v[8 * j + 5] * H8_SCALE, v[8 * j + 6] * H8_SCALE, v[8 * j + 7] * H8_SCALE)}; }
            if (lane == 0) { tokdst[t] = dst; rowgate[(size_t)dst * 2] = tokgate[(size_t)t * 2]; rowgate[(size_t)dst * 2 + 1] = tokgate[(size_t)t * 2 + 1]; }
        }
    }
}
__device__ __forceinline__ void phase_lnffn(const Params& P, int layer, int bid, int nb) {
    const int tid = opaque_tid(), lane = tid & 63, wave = tid >> 6, nw = blockDim.x >> 6;
    const bf16_t* pre2 = (const bf16_t*)(P.ws + WS_BIG + BIG_PRE2);
    const float* g = P.in[I_LNFG] + layer * D; const float* b = P.in[I_LNFB] + layer * D;
    const int* tokdst = (const int*)(P.ws + WS_TOKDST);
    float gr[16], br[16]; load_gb(g, b, lane, gr, br);
    for (int t0 = bid * nw + wave; t0 < T; t0 += 2 * nb * nw) {
        const int t1 = t0 + nb * nw; const bool has1 = t1 < T;
        float v0[16], v1[16];
        load_row_bf16(pre2 + (size_t)tokdst[t0] * D, lane, v0);
        if (has1) load_row_bf16(pre2 + (size_t)tokdst[t1] * D, lane, v1);
#pragma unroll
        for (int rr = 0; rr < 2; ++rr) {
            if (rr == 1 && !has1) break;
            float (&v)[16] = rr ? v1 : v0; const int t = rr ? t1 : t0;
            ln_row_r(v, gr, br);
            if (layer == 0) { store_row_bf16((bf16_t*)(P.out + OUT_H) + (size_t)t * D, lane, v);
                typedef unsigned u32x2 __attribute__((ext_vector_type(2)));
#pragma unroll
                for (int j = 0; j < 2; ++j) *(u32x2*)(P.ws + WS_H8 + (size_t)t * D + 8 * lane + 512 * j) = (u32x2){pk4_fp8(v[8 * j] * H8_SCALE, v[8 * j + 1] * H8_SCALE, v[8 * j + 2] * H8_SCALE, v[8 * j + 3] * H8_SCALE), pk4_fp8(v[8 * j + 4] * H8_SCALE, v[8 * j + 5] * H8_SCALE, v[8 * j + 6] * H8_SCALE, v[8 * j + 7] * H8_SCALE)}; }
            else { float* o = (float*)P.out + (size_t)t * D;
#pragma unroll
                for (int j = 0; j < 2; ++j) { *(f32x4*)(o + 8 * lane + 512 * j) = (f32x4){v[8 * j], v[8 * j + 1], v[8 * j + 2], v[8 * j + 3]}; *(f32x4*)(o + 8 * lane + 512 * j + 4) = (f32x4){v[8 * j + 4], v[8 * j + 5], v[8 * j + 6], v[8 * j + 7]}; } }
        }
    }
}

enum { MIX_RET = 0, MIX_ML = 1, MIX_GLA = 2, MIX_SSD = 3 };
typedef short s16x4 __attribute__((ext_vector_type(4)));
__device__ __forceinline__ bf16x8 tr_frag(LAS unsigned char* p0, LAS unsigned char* p1) {
    const s16x4 a = __builtin_amdgcn_ds_read_tr16_b64_v4i16((LAS s16x4*)p0), b = __builtin_amdgcn_ds_read_tr16_b64_v4i16((LAS s16x4*)p1);
    return (bf16x8){a[0], a[1], a[2], a[3], b[0], b[1], b[2], b[3]};
}
__device__ __forceinline__ bf16x8 cat_frag(LAS unsigned char* p0, LAS unsigned char* p1) {
    const s16x4 a = *(LAS s16x4*)p0, b = *(LAS s16x4*)p1;
    return (bf16x8){a[0], a[1], a[2], a[3], b[0], b[1], b[2], b[3]};
}
__device__ __forceinline__ bf16x8 pack_acc(const f32x4& lo, const f32x4& hi) {
    u32x4 w; w.x = pg8::cvt_pk_bf16(lo[0], lo[1]); w.y = pg8::cvt_pk_bf16(lo[2], lo[3]); w.z = pg8::cvt_pk_bf16(hi[0], hi[1]); w.w = pg8::cvt_pk_bf16(hi[2], hi[3]);
    return __builtin_bit_cast(bf16x8, w);
}
__device__ __forceinline__ void unpack8(const u32x4& w, float (&v)[8]) {
    v[0] = bflo(w.x); v[1] = bfhi(w.x); v[2] = bflo(w.y); v[3] = bfhi(w.y); v[4] = bflo(w.z); v[5] = bfhi(w.z); v[6] = bflo(w.w); v[7] = bfhi(w.w);
}
__device__ __forceinline__ u32x4 pack8(const float (&v)[8]) {
    u32x4 w; w.x = pg8::cvt_pk_bf16(v[0], v[1]); w.y = pg8::cvt_pk_bf16(v[2], v[3]); w.z = pg8::cvt_pk_bf16(v[4], v[5]); w.w = pg8::cvt_pk_bf16(v[6], v[7]); return w;
}

template <int CTRL, int RM> __device__ __forceinline__ float dpp_take(float old, float v) { return __builtin_bit_cast(float, __builtin_amdgcn_update_dpp(__builtin_bit_cast(int, old), __builtin_bit_cast(int, v), CTRL, RM, 0xf, false)); }
__device__ __forceinline__ float wave_scan_add(float v) {
    v += dpp_take<0x111, 0xf>(0.f, v); v += dpp_take<0x112, 0xf>(0.f, v); v += dpp_take<0x114, 0xf>(0.f, v); v += dpp_take<0x118, 0xf>(0.f, v);
    v += dpp_take<0x142, 0xa>(0.f, v); v += dpp_take<0x143, 0xc>(0.f, v); return v; }
__device__ __forceinline__ float wave_scan_max(float v) {
    const float ni = -3.0e38f;
    v = fmaxf(v, dpp_take<0x111, 0xf>(ni, v)); v = fmaxf(v, dpp_take<0x112, 0xf>(ni, v)); v = fmaxf(v, dpp_take<0x114, 0xf>(ni, v)); v = fmaxf(v, dpp_take<0x118, 0xf>(ni, v));
    v = fmaxf(v, dpp_take<0x142, 0xa>(ni, v)); v = fmaxf(v, dpp_take<0x143, 0xc>(ni, v)); return v; }
__device__ __forceinline__ float fexp(float x) { return __builtin_amdgcn_exp2f(x * 1.4426950408889634f); }
__device__ __forceinline__ float frcp(float x) { return __builtin_amdgcn_rcpf(x); }
__device__ __forceinline__ float fsigmoid(float x) { return frcp(1.f + fexp(-x)); }
__device__ __forceinline__ float fsilu(float x) { return x * fsigmoid(x); }
__device__ __forceinline__ float fsoftplus(float x) {
    const float u = fexp(-fabsf(x));
    const float l = u < 0.01f ? u * (1.f - u * (0.5f - u * 0.33333333f)) : __builtin_amdgcn_logf(1.f + u) * 0.6931471805599453f;
    return fmaxf(x, 0.f) + l;
}
__device__ __forceinline__ float flogsigmoid(float x) { return -fsoftplus(-x); }

template <int NR>
__device__ __forceinline__ void conv_rows(const bf16_t* src, const int trow0, const LAS float* wl, const int ldw, float (&o)[NR][8]) {
    float x[NR + 3][8];
#pragma unroll
    for (int i = 0; i < NR + 3; ++i) {
        if (trow0 + i - 3 >= 0) { const u32x4 xw = *(const u32x4*)(src + (ptrdiff_t)(i - 3) * NP); unpack8(xw, x[i]); }
        else {
#pragma unroll
            for (int j = 0; j < 8; ++j) x[i][j] = 0.f; }
    }
    float wv[5][8];
#pragma unroll
    for (int k = 0; k < 5; ++k) { const f32x4 w0 = *(const LAS f32x4*)(wl + k * ldw), w1 = *(const LAS f32x4*)(wl + k * ldw + 4);
#pragma unroll
        for (int j = 0; j < 4; ++j) { wv[k][j] = w0[j]; wv[k][4 + j] = w1[j]; } }
#pragma unroll
    for (int r = 0; r < NR; ++r)
#pragma unroll
        for (int j = 0; j < 8; ++j) { float a = wv[4][j];
#pragma unroll
            for (int k = 0; k < 4; ++k) a += wv[k][j] * x[r + k][j];
            o[r][j] = fsilu(a); }
}

__device__ __forceinline__ void ssd_prep(const Params& P, LAS unsigned char* lds, int bid, int nb) {
    const int tid = opaque_tid();
    bf16_t* proj = (bf16_t*)(P.ws + WS_BIG);
    LAS u32x4* halo = (LAS u32x4*)lds;
    const int c32 = tid & 31, r0 = (tid >> 5) * 4;
#pragma unroll 1
    for (int it = bid; it < 256; it += nb) {
        const int unit = it >> 1, half = it & 1, b = unit >> 2, g = unit & 3;
        int col, chn;
        if (half == 0) { col = C1_XS + g * 256 + 8 * c32; chn = g * 256 + 8 * c32; }
        else if (c32 < 16) { col = C1_BM + g * 128 + 8 * c32; chn = 1024 + g * 128 + 8 * c32; }
        else { col = C1_CM + g * 128 + 8 * (c32 - 16); chn = 1536 + g * 128 + 8 * (c32 - 16); }
        float wv[5][8];
#pragma unroll
        for (int k = 0; k < 5; ++k) { const float* wp = (k < 4 ? P.in[I_SSDCW] + k * 2048 : P.in[I_SSDCB]) + chn; const f32x4 w0 = *(const f32x4*)wp, w1 = *(const f32x4*)(wp + 4);
#pragma unroll
            for (int j = 0; j < 4; ++j) { wv[k][j] = w0[j]; wv[k][4 + j] = w1[j]; } }
        bf16_t* base = proj + (size_t)b * SEQ * NP + col;
        u32x4 cur[7];
#pragma unroll
        for (int i = 0; i < 7; ++i) { const int row = r0 - 3 + i; cur[i] = row >= 0 ? *(const u32x4*)(base + (size_t)row * NP) : (u32x4){0u, 0u, 0u, 0u}; }
#pragma unroll 1
        for (int ch = 0; ch < SEQ / 64; ++ch) {
            float x[7][8];
#pragma unroll
            for (int i = 0; i < 7; ++i) unpack8(cur[i], x[i]);
            const u32x4 h0 = cur[4], h1 = cur[5], h2 = cur[6];
            __syncthreads();
            if (r0 == 60) { halo[c32] = h0; halo[32 + c32] = h1; halo[64 + c32] = h2; }
            if (ch + 1 < SEQ / 64) {
#pragma unroll
                for (int i = 0; i < 7; ++i) if (r0 >= 4 || i >= 3) cur[i] = *(const u32x4*)(base + (size_t)(64 * (ch + 1) + r0 - 3 + i) * NP);
            }
#pragma unroll
            for (int r = 0; r < 4; ++r) { float o[8];
#pragma unroll
                for (int j = 0; j < 8; ++j) { float a = wv[4][j];
#pragma unroll
                    for (int k = 0; k < 4; ++k) a += wv[k][j] * x[r + k][j];
                    o[j] = fsilu(a); }
                *(u32x4*)(base + (size_t)(64 * ch + r0 + r) * NP) = pack8(o); }
            __syncthreads();
            if (r0 == 0 && ch + 1 < SEQ / 64) { cur[0] = halo[c32]; cur[1] = halo[32 + c32]; cur[2] = halo[64 + c32]; }
        }
        __syncthreads();
    }
}

template <int MIX>
__device__ __forceinline__ void mixer_unit(const Params& P, const int b, const int h, LAS unsigned char* lds, const bool dostore) {
    const int tid0 = opaque_tid(), w = __builtin_amdgcn_readfirstlane(tid0 >> 6);
    typedef unsigned u32x2 __attribute__((ext_vector_type(2)));
    constexpr int RSQ = 288, RSV = 544, RSP = 144;
    constexpr int SZQ = 64 * RSQ, SZV = 64 * RSV, SZP = 64 * RSP;
    constexpr int OQ = 0, OK1 = SZQ, OV = 2 * SZQ, O3 = 2 * SZQ + SZV;
    constexpr int OK2 = (MIX == MIX_ML || MIX == MIX_GLA) ? O3 : OK1;
    constexpr int OV2 = (MIX == MIX_SSD) ? O3 : OV;
    constexpr int OP = MIX == MIX_RET ? O3 : (MIX == MIX_SSD ? O3 + SZV : O3 + SZQ);
    constexpr int NPV = MIX == MIX_SSD ? 4 : 1;
    constexpr int OT = OP + NPV * SZP;
    constexpr int OY = OV2;
    LAS float* tab = (LAS float*)(lds + OT);
    constexpr int TGN = MIX == MIX_GLA ? 8832 : MIX == MIX_ML ? 648 : MIX == MIX_SSD ? 512 : 0;
    constexpr int TCW = MIX == MIX_ML ? 904 : 768;
    static_assert(OT + (MIX == MIX_GLA ? 11776 : MIX == MIX_SSD ? 3328 : 2184) * 4 <= 163840 - 1024, "lds map");
    bf16_t* proj = (bf16_t*)(P.ws + WS_BIG);
    const size_t row0b = (size_t)b * SEQ;
    constexpr int GIDX = MIX == MIX_RET ? I_RETG : MIX == MIX_ML ? I_MLG : MIX == MIX_GLA ? I_GLAG : I_SSDG;
    if (tid0 < 256) tab[TGN + tid0] = P.in[GIDX][h * 256 + tid0];
    if constexpr (MIX == MIX_ML) {
        for (int i = tid0; i < 1280; i += NTHREADS_C) { const int k = i >> 8, j = i & 255; const int chn = (j >> 7) * 512 + h * 128 + (j & 127);
            tab[TCW + i] = k < 4 ? P.in[I_MLCW][k * 1024 + chn] : P.in[I_MLCB][chn]; }
        if (tid0 < 128) tab[512 + tid0] = 0.f; if (tid0 == 0) tab[641] = 0.f;
    }
    if constexpr (MIX == MIX_GLA) {
        for (int i = tid0; i < 2048; i += NTHREADS_C) tab[9088 + i] = P.in[I_GLAWA][(i >> 7) * 512 + h * 128 + (i & 127)];
        if (tid0 < 128) tab[9088 + 2048 + tid0] = P.in[I_GLABA][h * 128 + tid0];
    }
    __syncthreads();
    f32x4 Sacc[8][2];
#pragma unroll
    for (int rt = 0; rt < 8; ++rt)
#pragma unroll
        for (int ct = 0; ct < 2; ++ct) Sacc[rt][ct] = (f32x4){0.f, 0.f, 0.f, 0.f};
    float gam = 1.f, lg2gam = 0.f, g63 = 1.f;
    float rinv[4] = {0.f, 0.f, 0.f, 0.f};
    if constexpr (MIX == MIX_RET) { gam = 1.f - __builtin_amdgcn_exp2f(-5.f - (float)h); lg2gam = __builtin_amdgcn_logf(gam); g63 = __builtin_amdgcn_exp2f(63.f * lg2gam);
#pragma unroll
        for (int i2 = 0; i2 < 4; ++i2) rinv[i2] = __builtin_amdgcn_exp2f(-(float)(2 * (4 * (tid0 & 15) + i2)) * (13.287712379549449f / 128.f)) * 0.15915494309189535f; }

    tp_begin(lds, 100 * MIX + 9);
    unsigned short gpre0 = 0, gpre1 = 0;
    if constexpr (MIX == MIX_ML) { if (w == 0) { const bf16_t* rp = proj + (row0b + (tid0 & 63)) * NP; gpre0 = rp[C0_MI + h]; gpre1 = rp[C0_MF + h]; } }
    if constexpr (MIX == MIX_SSD) { if (w < 4) gpre0 = proj[(row0b + (tid0 & 63)) * NP + C1_DT + 4 * h + w]; }
#pragma unroll 1
    for (int ch = 0; ch < SEQ / 64; ++ch) {
        int tid = tid0; asm volatile("" : "+v"(tid));
        const int lane = tid & 63, c = lane & 15, g = lane >> 4, q4 = (lane >> 2) & 3, p4 = lane & 3;
        const size_t row0 = row0b + (size_t)ch * 64;
        tp_begin(lds, 100 * MIX + 1);
        if constexpr (MIX == MIX_RET) {
            const int* pos = (const int*)P.in[I_POS];
#pragma unroll
            for (int i = 0; i < 2; ++i) {
                const int pi = tid + 512 * i, r = pi >> 4, c8 = pi & 15;
                const bf16_t* rp = proj + (row0 + r) * NP + h * 128 + 8 * c8;
                const u32x4 qw = *(const u32x4*)(rp + C0_RQ), kw = *(const u32x4*)(rp + C0_RK);
                float qv[8], kv[8]; unpack8(qw, qv); unpack8(kw, kv);
                const float ps = (float)pos[row0 + r];
                const float fq = __builtin_amdgcn_exp2f((float)r * lg2gam), fk = 0.08838834764831845f * __builtin_amdgcn_exp2f(-(float)r * lg2gam);
#pragma unroll
                for (int i2 = 0; i2 < 4; ++i2) {
                    const float tr = __builtin_amdgcn_fractf(ps * rinv[i2]);
                    const float sn = __builtin_amdgcn_sinf(tr), cs = __builtin_amdgcn_cosf(tr);
                    const float q0 = qv[2 * i2], q1 = qv[2 * i2 + 1], k0 = kv[2 * i2], k1 = kv[2 * i2 + 1];
                    qv[2 * i2] = (q0 * cs - q1 * sn) * fq; qv[2 * i2 + 1] = (q0 * sn + q1 * cs) * fq;
                    kv[2 * i2] = (k0 * cs - k1 * sn) * fk; kv[2 * i2 + 1] = (k0 * sn + k1 * cs) * fk;
                }
                *(LAS u32x4*)(lds + OQ + RSQ * r + 16 * c8) = pack8(qv);
                *(LAS u32x4*)(lds + OK1 + RSQ * r + 16 * c8) = pack8(kv);
            }
#pragma unroll
            for (int i = 0; i < 4; ++i) {
                const int pi = tid + 512 * i, r = pi >> 5, c8 = pi & 31;
                *(LAS u32x4*)(lds + OV + RSV * r + 16 * c8) = *(const u32x4*)(proj + (row0 + r) * NP + C0_RV + h * 256 + 8 * c8);
            }
        }
        if constexpr (MIX == MIX_GLA) {
            if (tid < 128) *(LAS u32x4*)(tab + 11264 + 4 * tid) = *(const u32x4*)(proj + (row0 + (tid >> 1)) * NP + C1_GA + 8 * (tid & 1));
            __syncthreads();
            {
                const int d = tid & 127, tq = tid >> 7;
                const float ba = tab[9088 + 2048 + d];
                float wv[16];
#pragma unroll
                for (int r = 0; r < 16; ++r) wv[r] = tab[9088 + r * 128 + d];
                float run = 0.f;
#pragma unroll 4
                for (int i = 0; i < 16; ++i) {
                    const int t = 16 * tq + i;
                    const u32x4 g0 = *(LAS u32x4*)(tab + 11264 + 8 * t), g1 = *(LAS u32x4*)(tab + 11264 + 8 * t + 4); float gv[8], gv2[8]; unpack8(g0, gv); unpack8(g1, gv2);
                    float a = ba;
#pragma unroll
                    for (int r = 0; r < 8; ++r) a += gv[r] * wv[r] + gv2[r] * wv[8 + r];
                    run += flogsigmoid(a) * (1.f / 16.f);
                    tab[t * 128 + d] = run;
                }
                tab[8192 + tq * 128 + d] = run;
            }
            __syncthreads();
            if (tid < 128) tab[8704 + tid] = fexp((tab[8192 + tid] + tab[8192 + 128 + tid]) + (tab[8192 + 256 + tid] + tab[8192 + 384 + tid]));
            __syncthreads();
#pragma unroll
            for (int i = 0; i < 2; ++i) {
                const int pi = tid + 512 * i, r = pi >> 4, c8 = pi & 15, tq = r >> 4;
                const bf16_t* rp = proj + (row0 + r) * NP + h * 128 + 8 * c8;
                const u32x4 qw = *(const u32x4*)(rp + C1_GQ), kw = *(const u32x4*)(rp + C1_GK);
                float qv[8], kv[8], k2[8]; unpack8(qw, qv); unpack8(kw, kv);
#pragma unroll
                for (int hh = 0; hh < 2; ++hh) {
                    const int d0 = 8 * c8 + 4 * hh;
                    f32x4 bc = *(LAS f32x4*)(tab + r * 128 + d0);
                    const f32x4 t0 = *(LAS f32x4*)(tab + 8192 + d0), t1 = *(LAS f32x4*)(tab + 8192 + 128 + d0), t2 = *(LAS f32x4*)(tab + 8192 + 256 + d0), t3 = *(LAS f32x4*)(tab + 8192 + 384 + d0);
                    if (tq > 0) bc = bc + t0; if (tq > 1) bc = bc + t1; if (tq > 2) bc = bc + t2;
                    const f32x4 bt = (t0 + t1) + (t2 + t3);
                    const f32x4 dcv = *(LAS f32x4*)(tab + 8704 + d0);
#pragma unroll
                    for (int j = 0; j < 4; ++j) { const float e1 = fexp(bc[j]), e2 = frcp(e1), kk = kv[4 * hh + j] * e2;
                        qv[4 * hh + j] = qv[4 * hh + j] * 0.08838834764831845f * e1; kv[4 * hh + j] = kk; k2[4 * hh + j] = kk * dcv[j]; }
                }
                *(LAS u32x4*)(lds + OQ + RSQ * r + 16 * c8) = pack8(qv);
                *(LAS u32x4*)(lds + OK1 + RSQ * r + 16 * c8) = pack8(kv);
                *(LAS u32x4*)(lds + OK2 + RSQ * r + 16 * c8) = pack8(k2);
            }
#pragma unroll
            for (int i = 0; i < 4; ++i) {
                const int pi = tid + 512 * i, r = pi >> 5, c8 = pi & 31;
                *(LAS u32x4*)(lds + OV + RSV * r + 16 * c8) = *(const u32x4*)(proj + (row0 + r) * NP + C1_GV + h * 256 + 8 * c8);
            }
        }
        if constexpr (MIX == MIX_ML) {
            if (w == 0) {
                const float ip = bf2f(gpre0) + P.in[I_MLBI][h], lf = flogsigmoid(bf2f(gpre1) + P.in[I_MLBF][h]);
                const float bc = wave_scan_add(lf);
                const float u = ip - bc; const float pm = wave_scan_max(u);
                const float mst = tab[641];
                const float M = fmaxf(mst, pm), M63 = __shfl(M, 63), bt = __shfl(bc, 63);
                tab[lane] = u; tab[64 + lane] = M; tab[128 + lane] = fexp(u - M63); tab[192 + lane] = fexp(mst - M); tab[256 + lane] = fexp(-bc - M);
                if (lane == 0) { tab[640] = fexp(mst - M63); tab[642] = bt + M63; }
            }
            {
                const int c16 = tid & 31, r0 = (tid >> 5) * 4, isk = c16 >> 4, c8 = c16 & 15;
                float o[4][8];
                conv_rows<4>(proj + (row0 + r0) * NP + (isk ? C0_MK : C0_MQ) + h * 128 + 8 * c8, ch * 64 + r0, tab + TCW + 8 * c16, 256, o);
#pragma unroll
                for (int r = 0; r < 4; ++r) {
                    if (isk) {
#pragma unroll
                        for (int j = 0; j < 8; ++j) o[r][j] *= 0.08838834764831845f; }
                    *(LAS u32x4*)(lds + (isk ? OK1 : OQ) + RSQ * (r0 + r) + 16 * c8) = pack8(o[r]); }
            }
#pragma unroll
            for (int i = 0; i < 4; ++i) {
                const int pi = tid + 512 * i, r = pi >> 5, c8 = pi & 31;
                *(LAS u32x4*)(lds + OV + RSV * r + 16 * c8) = *(const u32x4*)(proj + (row0 + r) * NP + C0_MV + h * 256 + 8 * c8);
            }
            __syncthreads();
            tp_end(lds, 100 * MIX + 1); tp_begin(lds, 100 * MIX + 6);
#pragma unroll
            for (int i = 0; i < 2; ++i) {
                const int pi = tid + 512 * i, r = pi >> 4, c8 = pi & 15;
                const u32x4 kw = *(LAS u32x4*)(lds + OK1 + RSQ * r + 16 * c8); float kv[8]; unpack8(kw, kv); const float es = tab[128 + r];
#pragma unroll
                for (int j = 0; j < 8; ++j) kv[j] *= es;
                *(LAS u32x4*)(lds + OK2 + RSQ * r + 16 * c8) = pack8(kv);
            }
            {
                const int t = tid >> 3, part = tid & 7; float a = 0.f;
#pragma unroll
                for (int i = 0; i < 2; ++i) { const u32x4 qw = *(LAS u32x4*)(lds + OQ + RSQ * t + 2 * (16 * part + 8 * i)); float qv[8]; unpack8(qw, qv);
                    const f32x4 n0 = *(LAS f32x4*)(tab + 512 + 16 * part + 8 * i), n1 = *(LAS f32x4*)(tab + 512 + 16 * part + 8 * i + 4);
#pragma unroll
                    for (int j = 0; j < 4; ++j) a += qv[j] * n0[j] + qv[4 + j] * n1[j]; }
                a += __shfl_xor(a, 1); a += __shfl_xor(a, 2); a += __shfl_xor(a, 4);
                if (part == 0) tab[448 + t] = a;
            }
        }
        if constexpr (MIX == MIX_SSD) {
            if (w < 4) {
                const int hd = 4 * h + w;
                const float dt = fsoftplus(bf2f(gpre0) + P.in[I_SSDDTB][hd]);
                const float cm = wave_scan_add(dt * (-fexp(P.in[I_SSDALOG][hd])));
                tab[lane * 4 + w] = cm; tab[256 + lane * 4 + w] = dt;
            }
            {
                const int c32 = tid & 31, r0 = (tid >> 5) * 4, isc = c32 >> 4, c8 = c32 & 15, hr = c32 >> 3;
                u32x4 bcw[4], xw[4];
#pragma unroll
                for (int r = 0; r < 4; ++r) { bcw[r] = *(const u32x4*)(proj + (row0 + r0 + r) * NP + (isc ? C1_CM : C1_BM) + h * 128 + 8 * c8); xw[r] = *(const u32x4*)(proj + (row0 + r0 + r) * NP + C1_XS + h * 256 + 8 * c32); }
                float ox[4][8];
#pragma unroll
                for (int r = 0; r < 4; ++r) { *(LAS u32x4*)(lds + (isc ? OQ : OK1) + RSQ * (r0 + r) + 16 * c8) = bcw[r]; unpack8(xw[r], ox[r]); }
                __syncthreads();
                tp_end(lds, 100 * MIX + 1); tp_begin(lds, 100 * MIX + 6);
                const float last = tab[63 * 4 + hr];
#pragma unroll
                for (int r = 0; r < 4; ++r) { const float dt = tab[256 + (r0 + r) * 4 + hr], e2 = fexp(last - tab[(r0 + r) * 4 + hr]); float o2[8];
#pragma unroll
                    for (int j = 0; j < 8; ++j) { ox[r][j] *= dt; o2[j] = ox[r][j] * e2; }
                    *(LAS u32x4*)(lds + OV + RSV * (r0 + r) + 16 * c32) = pack8(ox[r]);
                    *(LAS u32x4*)(lds + OV2 + RSV * (r0 + r) + 16 * c32) = pack8(o2); }
            }
        }
        __syncthreads();
        tp_end(lds, (MIX == MIX_ML || MIX == MIX_SSD) ? 100 * MIX + 6 : 100 * MIX + 1); tp_begin(lds, 100 * MIX + 2);
        if (ch + 1 < SEQ / 64) {
            const int sl = tid & 15;
            int col = -1;
            if constexpr (MIX == MIX_RET) col = sl < 2 ? C0_RQ + h * 128 + 64 * sl : sl < 4 ? C0_RK + h * 128 + 64 * (sl - 2) : sl < 8 ? C0_RV + h * 256 + 64 * (sl - 4) : sl < 12 ? C0_RG + h * 256 + 64 * (sl - 8) : -1;
            if constexpr (MIX == MIX_ML) col = sl < 2 ? C0_MQ + h * 128 + 64 * sl : sl < 4 ? C0_MK + h * 128 + 64 * (sl - 2) : sl < 8 ? C0_MV + h * 256 + 64 * (sl - 4) : sl < 12 ? C0_MO + h * 256 + 64 * (sl - 8) : sl == 12 ? C0_MI : -1;
            if constexpr (MIX == MIX_GLA) col = sl < 2 ? C1_GQ + h * 128 + 64 * sl : sl < 4 ? C1_GK + h * 128 + 64 * (sl - 2) : sl < 8 ? C1_GV + h * 256 + 64 * (sl - 4) : sl < 12 ? C1_GR + h * 256 + 64 * (sl - 8) : sl == 12 ? C1_GA : -1;
            if constexpr (MIX == MIX_SSD) col = sl < 4 ? C1_XS + h * 256 + 64 * sl : sl < 6 ? C1_BM + h * 128 + 64 * (sl - 4) : sl < 8 ? C1_CM + h * 128 + 64 * (sl - 6) : sl < 12 ? C1_SZ + h * 256 + 64 * (sl - 8) : sl == 12 ? C1_DT : -1;
            if (col >= 0) { const bf16_t* nbp = proj + (row0 + 64 + (tid >> 4)) * NP + col;
                const unsigned pfl = 157696u + (unsigned)w * 512u;
                asm volatile("s_mov_b32 m0, %2\n\ts_nop 0\n\tglobal_load_lds_dword %0, off\n\ts_mov_b32 m0, %3\n\ts_nop 0\n\tglobal_load_lds_dword %1, off"
                             :: "v"(nbp), "v"(nbp + (size_t)32 * NP), "s"(pfl), "s"(pfl + 256u) : "memory", "m0"); }
        }
        {
            const int tt = w >> 1; float rsum = 0.f;
#pragma unroll
            for (int si = 0; si < 2; ++si) {
                const int ss = 2 * (w & 1) + si;
                f32x4 acc = (f32x4){0.f, 0.f, 0.f, 0.f};
#pragma unroll
                for (int ks = 0; ks < 4; ++ks) {
                    const bf16x8 a = *(LAS bf16x8*)(lds + OK1 + RSQ * (16 * ss + c) + 2 * (32 * ks + 8 * g));
                    const bf16x8 bq = *(LAS bf16x8*)(lds + OQ + RSQ * (16 * tt + c) + 2 * (32 * ks + 8 * g));
                    acc = __builtin_amdgcn_mfma_f32_16x16x32_bf16(a, bq, acc, 0, 0, 0);
                }
                const int t = 16 * tt + c, s0 = 16 * ss + 4 * g;
                if constexpr (MIX == MIX_SSD) {
                    const f32x4 ct_ = *(LAS f32x4*)(tab + t * 4);
#pragma unroll
                    for (int hr = 0; hr < 4; ++hr) { float pv[4];
#pragma unroll
                        for (int r = 0; r < 4; ++r) pv[r] = (s0 + r <= t) ? acc[r] * fexp(ct_[hr] - tab[(s0 + r) * 4 + hr]) : 0.f;
                        *(LAS u32x2*)(lds + OP + hr * SZP + RSP * t + 2 * s0) = (u32x2){pg8::cvt_pk_bf16(pv[0], pv[1]), pg8::cvt_pk_bf16(pv[2], pv[3])}; }
                } else {
                    float pv[4];
                    if constexpr (MIX == MIX_ML) { const f32x4 us = *(LAS f32x4*)(tab + s0); const float Mt = tab[64 + t];
#pragma unroll
                        for (int r = 0; r < 4; ++r) { pv[r] = (s0 + r <= t) ? acc[r] * fexp(us[r] - Mt) : 0.f; rsum += pv[r]; } }
                    else {
#pragma unroll
                        for (int r = 0; r < 4; ++r) pv[r] = (s0 + r <= t) ? acc[r] : 0.f; }
                    *(LAS u32x2*)(lds + OP + RSP * t + 2 * s0) = (u32x2){pg8::cvt_pk_bf16(pv[0], pv[1]), pg8::cvt_pk_bf16(pv[2], pv[3])};
                }
            }
            if constexpr (MIX == MIX_ML) { rsum += __shfl_xor(rsum, 16); rsum += __shfl_xor(rsum, 32); if (g == 0) tab[320 + (w & 1) * 64 + 16 * tt + c] = rsum; }
        }
        __syncthreads();
        tp_end(lds, 100 * MIX + 2); tp_begin(lds, 100 * MIX + 3);
        f32x4 Yacc[2][4];
#pragma unroll
        for (int ct = 0; ct < 2; ++ct)
#pragma unroll
            for (int tt = 0; tt < 4; ++tt) Yacc[ct][tt] = (f32x4){0.f, 0.f, 0.f, 0.f};
#pragma unroll
        for (int kd = 0; kd < 4; ++kd) {
            bf16x8 qf[4];
#pragma unroll
            for (int tt = 0; tt < 4; ++tt) { LAS unsigned char* qp = lds + OQ + RSQ * (16 * tt + c) + 2 * (32 * kd + 4 * g); qf[tt] = cat_frag(qp, qp + 32); }
#pragma unroll
            for (int ct = 0; ct < 2; ++ct) { const bf16x8 sf = pack_acc(Sacc[2 * kd][ct], Sacc[2 * kd + 1][ct]);
#pragma unroll
                for (int tt = 0; tt < 4; ++tt) Yacc[ct][tt] = __builtin_amdgcn_mfma_f32_16x16x32_bf16(sf, qf[tt], Yacc[ct][tt], 0, 0, 0); }
        }
        if constexpr (MIX != MIX_GLA) {
#pragma unroll
            for (int tt = 0; tt < 4; ++tt) {
                float rs = gam;
                if constexpr (MIX == MIX_ML) rs = tab[192 + 16 * tt + c];
                if constexpr (MIX == MIX_SSD) rs = fexp(tab[(16 * tt + c) * 4 + (w >> 1)]);
#pragma unroll
                for (int ct = 0; ct < 2; ++ct) Yacc[ct][tt] = Yacc[ct][tt] * rs;
            }
        }
        bf16x8 Vf[2][2];
#pragma unroll
        for (int ks = 0; ks < 2; ++ks)
#pragma unroll
            for (int ct = 0; ct < 2; ++ct) { LAS unsigned char* vp = lds + OV + RSV * (32 * ks + 8 * g + q4) + 2 * (32 * w + 16 * ct) + 8 * p4; Vf[ks][ct] = tr_frag(vp, vp + 4 * RSV); }
#pragma unroll
        for (int ks = 0; ks < 2; ++ks)
#pragma unroll
            for (int tt = 0; tt < 4; ++tt) { const bf16x8 pf = *(LAS bf16x8*)(lds + OP + (MIX == MIX_SSD ? (w >> 1) * SZP : 0) + RSP * (16 * tt + c) + 2 * (32 * ks + 8 * g));
#pragma unroll
                for (int ct = 0; ct < 2; ++ct) Yacc[ct][tt] = __builtin_amdgcn_mfma_f32_16x16x32_bf16(Vf[ks][ct], pf, Yacc[ct][tt], 0, 0, 0); }
        if constexpr (MIX == MIX_GLA) {
#pragma unroll
            for (int rt = 0; rt < 8; ++rt) { const f32x4 dc = *(LAS f32x4*)(tab + 8704 + 16 * rt + 4 * g);
#pragma unroll
                for (int ct = 0; ct < 2; ++ct) Sacc[rt][ct] = Sacc[rt][ct] * dc; }
        } else {
            float dc = gam;
            if constexpr (MIX == MIX_ML) dc = tab[640];
            if constexpr (MIX == MIX_SSD) dc = fexp(tab[63 * 4 + (w >> 1)]);
#pragma unroll
            for (int rt = 0; rt < 8; ++rt)
#pragma unroll
                for (int ct = 0; ct < 2; ++ct) Sacc[rt][ct] = Sacc[rt][ct] * dc;
        }
        if constexpr (MIX == MIX_SSD) {
#pragma unroll
            for (int ks = 0; ks < 2; ++ks)
#pragma unroll
                for (int ct = 0; ct < 2; ++ct) { LAS unsigned char* vp = lds + OV2 + RSV * (32 * ks + 8 * g + q4) + 2 * (32 * w + 16 * ct) + 8 * p4; Vf[ks][ct] = tr_frag(vp, vp + 4 * RSV); }
        }
#pragma unroll
        for (int rt = 0; rt < 8; ++rt)
#pragma unroll
            for (int ks = 0; ks < 2; ++ks) { LAS unsigned char* kp = lds + OK2 + RSQ * (32 * ks + 8 * g + q4) + 2 * (16 * rt) + 8 * p4; const bf16x8 kf = tr_frag(kp, kp + 4 * RSQ);
#pragma unroll
                for (int ct = 0; ct < 2; ++ct) Sacc[rt][ct] = __builtin_amdgcn_mfma_f32_16x16x32_bf16(kf, Vf[ks][ct], Sacc[rt][ct], 0, 0, 0); }
        if constexpr (MIX == MIX_RET) {
#pragma unroll
            for (int rt = 0; rt < 8; ++rt)
#pragma unroll
                for (int ct = 0; ct < 2; ++ct) Sacc[rt][ct] = Sacc[rt][ct] * g63;
        }
        if constexpr (MIX == MIX_ML) {
            if (tid < 128) { float a = 0.f;
#pragma unroll 8
                for (int s = 0; s < 64; ++s) a += bf2f(*(LAS unsigned short*)(lds + OK2 + RSQ * s + 2 * tid));
                tab[512 + tid] = tab[640] * tab[512 + tid] + a; }
        }
        __syncthreads();
        tp_end(lds, 100 * MIX + 3); tp_begin(lds, 100 * MIX + 4);
#pragma unroll
        for (int ct = 0; ct < 2; ++ct)
#pragma unroll
            for (int tt = 0; tt < 4; ++tt)
                *(LAS u32x2*)(lds + OY + RSV * (16 * tt + c) + 2 * (32 * w + 16 * ct + 4 * g)) = (u32x2){pg8::cvt_pk_bf16(Yacc[ct][tt][0], Yacc[ct][tt][1]), pg8::cvt_pk_bf16(Yacc[ct][tt][2], Yacc[ct][tt][3])};
        __syncthreads();
        tp_end(lds, 100 * MIX + 4); tp_begin(lds, 100 * MIX + 5);
        {
            const int t = tid >> 3, part = tid & 7;
            float y[32];
#pragma unroll
            for (int i = 0; i < 4; ++i) { const u32x4 yw = *(LAS u32x4*)(lds + OY + RSV * t + 2 * (32 * part + 8 * i)); float t8[8]; unpack8(yw, t8);
#pragma unroll
                for (int j = 0; j < 8; ++j) y[8 * i + j] = t8[j]; }
            constexpr int GCOL = MIX == MIX_RET ? C0_RG : MIX == MIX_ML ? C0_MO : MIX == MIX_GLA ? C1_GR : C1_SZ;
            constexpr int OCOL = MIX == MIX_RET ? C0_RV : MIX == MIX_ML ? C0_MV : MIX == MIX_GLA ? C1_GV : C1_SZ;
            bf16_t* rp = proj + (row0 + t) * NP + h * 256 + 32 * part;
            u32x4 gw[4];
#pragma unroll
            for (int i = 0; i < 4; ++i) gw[i] = *(const u32x4*)(rp + GCOL + 8 * i);
            if constexpr (MIX == MIX_ML) {
                const float den = (tab[320 + t] + tab[384 + t]) + tab[192 + t] * tab[448 + t];
                const float idn = frcp(fmaxf(fabsf(den), tab[256 + t]));
#pragma unroll
                for (int i = 0; i < 4; ++i) { float gt[8]; unpack8(gw[i], gt);
#pragma unroll
                    for (int j = 0; j < 8; ++j) y[8 * i + j] = y[8 * i + j] * idn * fsigmoid(gt[j]); }
            }
            if constexpr (MIX == MIX_SSD) {
                const int hd = 4 * h + (part >> 1); const float dsk = P.in[I_SSDD][hd] * frcp(tab[256 + t * 4 + (part >> 1)]);
#pragma unroll
                for (int i = 0; i < 4; ++i) { const u32x4 xw = *(LAS u32x4*)(lds + OV + RSV * t + 2 * (32 * part + 8 * i)); float t8[8], gt[8]; unpack8(xw, t8); unpack8(gw[i], gt);
#pragma unroll
                    for (int j = 0; j < 8; ++j) y[8 * i + j] = (y[8 * i + j] + dsk * t8[j]) * fsilu(gt[j]); }
            }
            float mean = 0.f;
            if constexpr (MIX == MIX_RET || MIX == MIX_ML) {
                float s1 = 0.f;
#pragma unroll
                for (int j = 0; j < 32; ++j) s1 += y[j];
                s1 += __shfl_xor(s1, 1); s1 += __shfl_xor(s1, 2); s1 += __shfl_xor(s1, 4);
                mean = s1 * (1.f / 256.f);
            }
            float s2 = 0.f;
#pragma unroll
            for (int j = 0; j < 32; ++j) { y[j] -= mean; s2 += y[j] * y[j]; }
            s2 += __shfl_xor(s2, 1); s2 += __shfl_xor(s2, 2); s2 += __shfl_xor(s2, 4);
            const float rstd = __builtin_amdgcn_rsqf(s2 * (1.f / 256.f) + NORM_EPS);
#pragma unroll
            for (int i = 0; i < 4; ++i) {
                const f32x4 n0 = *(LAS f32x4*)(tab + TGN + 32 * part + 8 * i), n1 = *(LAS f32x4*)(tab + TGN + 32 * part + 8 * i + 4); float o[8];
#pragma unroll
                for (int j = 0; j < 4; ++j) { o[j] = y[8 * i + j] * rstd * n0[j]; o[4 + j] = y[8 * i + 4 + j] * rstd * n1[j]; }
                if constexpr (MIX == MIX_RET || MIX == MIX_GLA) { float gt[8]; unpack8(gw[i], gt);
#pragma unroll
                    for (int j = 0; j < 8; ++j) o[j] *= fsilu(gt[j]); }
                if (dostore) *(u32x4*)(rp + OCOL + 8 * i) = pack8(o);
            }
            if constexpr (MIX == MIX_ML) { if (tid == 0) tab[641] = tab[642]; }
        }
        if (ch + 1 < SEQ / 64) {
            if constexpr (MIX == MIX_ML) { if (w == 0) { const bf16_t* rp = proj + (row0 + 64 + lane) * NP; gpre0 = rp[C0_MI + h]; gpre1 = rp[C0_MF + h]; } }
            if constexpr (MIX == MIX_SSD) { if (w < 4) gpre0 = proj[(row0 + 64 + lane) * NP + C1_DT + 4 * h + w]; }
        }
        __syncthreads();
        tp_end(lds, 100 * MIX + 5);
    }
    tp_end(lds, 100 * MIX + 9);
}

#define XB_TMO      128
#define XB_XCNT(j)  (256  + 64 * (j))
#define XB_XSUB(j)  (1280 + 64 * (j))
#define XB_XGEN(j)  (2304 + 64 * (j))
#define XB_TOP      3328
#define XB_TOPGEN   3392
#define XCD_BAR_WORDS 3456
#define XB_SPIN_CAP (1u << 18)
__device__ __forceinline__ unsigned xb_ld(unsigned* p)              { return __hip_atomic_load(p, __ATOMIC_RELAXED, __HIP_MEMORY_SCOPE_AGENT); }
__device__ __forceinline__ unsigned xb_add(unsigned* p, unsigned v) { return __hip_atomic_fetch_add(p, v, __ATOMIC_RELAXED, __HIP_MEMORY_SCOPE_AGENT); }
__device__ __forceinline__ unsigned xb_xcc_id() { return (unsigned)__builtin_amdgcn_s_getreg((3 << 11) | 20) & 0xFu; }
#define XB_SPIN(cond, bar) do { unsigned _sp = 0; while (cond) { __builtin_amdgcn_s_sleep(1); \
    if ((++_sp & 255u) == 0u) { if (xb_ld(&(bar)[XB_TMO])) break; if (_sp > XB_SPIN_CAP) { atomicAdd(&(bar)[XB_TMO], 1u); break; } } } } while (0)
struct XcdBarrier { unsigned* bar; unsigned x; volatile LAS unsigned* st; };
__device__ __forceinline__ XcdBarrier xcd_barrier_post(unsigned* bar, volatile LAS unsigned* st) {
    XcdBarrier b; b.bar = bar; b.x = xb_xcc_id(); b.st = st;
    if (opaque_tid() == 0) (void)xb_add(&bar[XB_XCNT(b.x)], 1u);
    return b;
}
__device__ __forceinline__ void xcd_barrier_complete(unsigned* bar, unsigned x, unsigned& nloc, unsigned& nx) {
    const unsigned G = gridDim.x * gridDim.y * gridDim.z;
    unsigned sum, cnt, mine, sp = 0u;
    for (;;) {
        sum = 0u; cnt = 0u; mine = 0u;
#pragma unroll
        for (unsigned j = 0; j < 16; ++j) { const unsigned c = xb_ld(&bar[XB_XCNT(j)]); sum += c; cnt += (c > 0u) ? 1u : 0u; mine = (j == x) ? c : mine; }
        if (sum == G) break;
        __builtin_amdgcn_s_sleep(1);
        if ((++sp & 255u) == 0u) { if (xb_ld(&bar[XB_TMO])) break; if (sp > XB_SPIN_CAP) { atomicAdd(&bar[XB_TMO], 1u); break; } }
    }
    nloc = mine > 0u ? mine : 1u; nx = cnt > 0u ? cnt : 1u;
}
__device__ __forceinline__ void xcd_barrier(const XcdBarrier& b) {
    asm volatile("s_waitcnt vmcnt(0)" ::: "memory");
    __syncthreads();
    if (opaque_tid() == 0) {
        unsigned* bar = b.bar;
        __builtin_amdgcn_s_waitcnt(0);
        unsigned nloc = b.st[0], nx = b.st[1];
        if (nloc == 0u) { xcd_barrier_complete(bar, b.x, nloc, nx); b.st[0] = nloc; b.st[1] = nx; }
        const unsigned old = xb_add(&bar[XB_XSUB(b.x)], 1u);
        const unsigned gen = old / nloc;
        if (old + 1u == (gen + 1u) * nloc) {
            __builtin_amdgcn_fence(__ATOMIC_RELEASE, "agent");
            asm volatile("s_waitcnt vmcnt(0)" ::: "memory");
            const unsigned og = xb_add(&bar[XB_TOP], 1u);
            const unsigned tg = og / nx;
            if (og + 1u == (tg + 1u) * nx) xb_add(&bar[XB_TOPGEN], 1u);
            else XB_SPIN(xb_ld(&bar[XB_TOPGEN]) == tg, bar);
            __builtin_amdgcn_fence(__ATOMIC_ACQUIRE, "agent");
            xb_add(&bar[XB_XGEN(b.x)], 1u);
            asm volatile("s_waitcnt vmcnt(0)" ::: "memory");
        } else {
            XB_SPIN(xb_ld(&bar[XB_XGEN(b.x)]) == gen, bar);
            __builtin_amdgcn_fence(__ATOMIC_ACQUIRE, "agent");
            asm volatile("s_waitcnt vmcnt(0)" ::: "memory");
        }
    }
    __syncthreads();
}

constexpr int NTHREADS = 512;
constexpr int RING_BYTES = 131072;
constexpr int LDS_BYTES = 163840;
constexpr int LDS_BARW = LDS_BYTES - 16;
constexpr int NPHASES = 17;
#ifndef MK_N_LAUNCHES
#define MK_N_LAUNCHES 1
#endif

#ifndef REP_ROUTE
#define REP_ROUTE 1
#endif
#ifndef REP_CONV
#define REP_CONV 1
#endif
#ifndef REP_GIN
#define REP_GIN 1
#endif
#ifndef REP_GOUT
#define REP_GOUT 1
#endif
#ifndef REP_PERM
#define REP_PERM 1
#endif
#ifndef REP_MOEA
#define REP_MOEA 1
#endif
#ifndef REP_MOEB
#define REP_MOEB 1
#endif
#ifndef REP_LNF
#define REP_LNF 1
#endif
#ifndef MIXREP_RET
#define MIXREP_RET 1
#endif
#ifndef MIXREP_ML
#define MIXREP_ML 1
#endif
#ifndef MIXREP_GLA
#define MIXREP_GLA 1
#endif
#ifndef MIXREP_SSD
#define MIXREP_SSD 1
#endif
struct Args { Params P; int ph_lo, ph_hi; };
typedef __attribute__((address_space(4))) const unsigned char* kargp_t;
__device__ __forceinline__ const Params& kparams() {
    kargp_t p = (kargp_t)__builtin_amdgcn_kernarg_segment_ptr();
    asm volatile("" : "+s"(p));
    return *(const Params*)p;
}

__device__ __forceinline__ int kphase_lo() { kargp_t p = (kargp_t)__builtin_amdgcn_kernarg_segment_ptr(); asm volatile("" : "+s"(p)); return ((const Args*)p)->ph_lo; }
__device__ __forceinline__ int kphase_hi() { kargp_t p = (kargp_t)__builtin_amdgcn_kernarg_segment_ptr(); asm volatile("" : "+s"(p)); return ((const Args*)p)->ph_hi; }
__device__ __forceinline__ void grid_barrier(LAS unsigned char* lds) {
    XcdBarrier b; b.bar = (unsigned*)(kparams().ws + WS_CTL) + CW_BAR; b.x = xb_xcc_id(); b.st = (volatile LAS unsigned*)(lds + LDS_BARW);
    tp_begin(lds, 900); xcd_barrier(b); tp_end(lds, 900);
}
template <int LAYER>
__device__ __forceinline__ void layer_phases(LAS unsigned char* lds) {
#define IN(k) (kphase_lo() <= (k) && (k) < kphase_hi())
#define SEAM(k) do { if (IN(k) && IN((k) + 1)) grid_barrier(lds); } while (0)
    constexpr int PB = 1 + 8 * LAYER;
    const int bid = blockIdx.x, nb = gridDim.x;
    if (IN(PB + 0)) {
        const Params& P = kparams();
        pg8::EpiStore E{(bf16_t*)(P.ws + WS_BIG), NP};
        constexpr unsigned M8 = LAYER ? INPROJ_FP8MASK1 : INPROJ_FP8MASK0, M16 = ALLTILES & ~M8;
        for (int rep = 0; rep < REP_GIN; ++rep) {
            if constexpr (M16 != 0u) {
                pg8::SchedCols S; S.A = (const char*)(P.out + OUT_H); S.B = (const char*)(P.ws + (LAYER ? WS_WIN1 : WS_WIN0)); S.lda = D; S.ldb = D; S.nM = T / 256; S.nN = __builtin_popcount(M16); S.G = nb; S.c = bid; S.mask = M16;
                pg8::gemm_phase(lds, S, E, D, D, D);
            }
            if constexpr (M8 != 0u) {
                pg8::SchedCols S; S.A = (const char*)(P.ws + WS_H8); S.B = (const char*)(P.ws + (LAYER ? WS_WIN8_1 : WS_WIN8_0)); S.lda = D / 2; S.ldb = D / 2; S.nM = T / 256; S.nN = __builtin_popcount(M8); S.G = nb; S.c = bid; S.mask = M8;
                pg8::gemm_phase<pg8::EpiStore, pg8::SchedCols, true, 0x7c7c7c7c, 0x77777777>(lds, S, E, D / 2, D / 2, D / 2);
            }
        }
    }
    SEAM(PB + 0);
    if (IN(PB + 1)) {
        if constexpr (LAYER == 1) { ssd_prep(kparams(), lds, bid, nb); grid_barrier(lds); }
        const Params& P = kparams();
        for (int u = bid; u < 256; u += nb) {
            const int b = (u & 127) >> 2, h = u & 3;
            if (LAYER == 0) { if (u < 128) { for (int rep = 0; rep < MIXREP_RET; ++rep) { mixer_unit<MIX_RET>(P, b, h, lds, rep == MIXREP_RET - 1); __syncthreads(); }
                                               convert_moe(P, lds, u, 128); }
                              else { for (int rep = 0; rep < MIXREP_ML; ++rep) { mixer_unit<MIX_ML>(P, b, h, lds, rep == MIXREP_ML - 1); __syncthreads(); } } }
            else { if (u < 128) { for (int rep = 0; rep < MIXREP_GLA; ++rep) { mixer_unit<MIX_GLA>(P, b, h, lds, rep == MIXREP_GLA - 1); __syncthreads(); } }
                   else { for (int rep = 0; rep < MIXREP_SSD; ++rep) { mixer_unit<MIX_SSD>(P, b, h, lds, rep == MIXREP_SSD - 1); __syncthreads(); } } }
        }
    }
    SEAM(PB + 1);
    if (IN(PB + 2)) {
        const Params& P = kparams();
        pg8::SchedPlain S; S.A = (const char*)(P.ws + WS_BIG) + YOFF * 2; S.B = (const char*)(P.ws + (LAYER ? WS_WOUT1 : WS_WOUT0)); S.lda = NP; S.ldb = 2048; S.nM = T / 256; S.nN = 4; S.G = nb; S.c = bid;
        pg8::EpiResid E{(bf16_t*)(P.out + OUT_PRE1), (const bf16_t*)(P.out + OUT_H)};
        for (int rep = 0; rep < REP_GOUT; ++rep) pg8::gemm_phase(lds, S, E, 2048, NP, 2048);
    }
    SEAM(PB + 2);
    if (IN(PB + 3)) for (int rep = 0; rep < REP_ROUTE; ++rep) { phase_route(kparams(), LAYER, lds, bid, nb, 32 * (REP_ROUTE - 1 - rep)); __syncthreads(); }
    SEAM(PB + 3);
    if (IN(PB + 4)) for (int rep = 0; rep < REP_PERM; ++rep) phase_permute(kparams(), LAYER, lds, bid, nb);
    SEAM(PB + 4);
    if (IN(PB + 5)) {
        const Params& P = kparams();
        const int* tilecls = (const int*)(P.ws + WS_TILECLS);
        if constexpr (MOE_FP8(LAYER) && MOEA_FP8) {
            pg8::SchedMoeA<true> S; S.A = (const char*)(P.ws + WS_BIG + BIG_HS8); S.Wgu = (const char*)(P.ws + WS_WGU) + (size_t)LAYER * 16 * 2097152; S.tilecls = tilecls; S.nM = __builtin_amdgcn_readfirstlane(tilecls[0]); S.G = nb; S.c = bid;
            pg8::EpiSwiglu8 E{P.ws + WS_BIG + BIG_H, (const float*)(P.ws + WS_ROWGATE)};
            for (int rep = 0; rep < REP_MOEA; ++rep) pg8::gemm_phase<pg8::EpiSwiglu8, pg8::SchedMoeA<true>, true, 0x7c7c7c7c, 0x77777777>(lds, S, E, D / 2, D / 2, D / 2);
        } else if constexpr (MOE_FP8(LAYER)) {
            pg8::SchedMoeA<false> S; S.A = (const char*)(P.ws + WS_BIG + BIG_HS); S.Wgu = (const char*)(P.ws + WS_WGU) + (size_t)LAYER * 16 * 2097152; S.tilecls = tilecls; S.nM = __builtin_amdgcn_readfirstlane(tilecls[0]); S.G = nb; S.c = bid;
            pg8::EpiSwiglu8 E{P.ws + WS_BIG + BIG_H, (const float*)(P.ws + WS_ROWGATE)};
            for (int rep = 0; rep < REP_MOEA; ++rep) pg8::gemm_phase(lds, S, E, D, D, D);
        } else {
            pg8::SchedMoeA<false> S; S.A = (const char*)(P.ws + WS_BIG + BIG_HS); S.Wgu = (const char*)(P.ws + WS_WGU) + (size_t)LAYER * 16 * 2097152; S.tilecls = tilecls; S.nM = __builtin_amdgcn_readfirstlane(tilecls[0]); S.G = nb; S.c = bid;
            pg8::EpiSwiglu E{(bf16_t*)(P.ws + WS_BIG + BIG_H), (const float*)(P.ws + WS_ROWGATE)};
            for (int rep = 0; rep < REP_MOEA; ++rep) pg8::gemm_phase(lds, S, E, D, D, D);
        }
    }
    SEAM(PB + 5);
    if (IN(PB + 6)) {
        const Params& P = kparams();
        const int* tilecls = (const int*)(P.ws + WS_TILECLS);
        pg8::EpiResid E{(bf16_t*)(P.ws + WS_BIG + BIG_PRE2), (const bf16_t*)(P.ws + WS_BIG + BIG_HS)};
        if constexpr (MOE_FP8(LAYER)) {
            pg8::SchedMoeB<true> S; S.A = (const char*)(P.ws + WS_BIG + BIG_H); S.Wd = (const char*)(P.ws + WS_WD) + (size_t)LAYER * 16 * 1048576; S.tilecls = tilecls; S.nM = __builtin_amdgcn_readfirstlane(tilecls[0]); S.G = nb; S.c = bid;
            for (int rep = 0; rep < REP_MOEB; ++rep) pg8::gemm_phase<pg8::EpiResid, pg8::SchedMoeB<true>, true, 0x7c7c7c7c, 0x77777777>(lds, S, E, D / 2, D / 2, 256);
        } else {
            pg8::SchedMoeB<false> S; S.A = (const char*)(P.ws + WS_BIG + BIG_H); S.Wd = (const char*)(P.ws + WS_WD) + (size_t)LAYER * 16 * 1048576; S.tilecls = tilecls; S.nM = __builtin_amdgcn_readfirstlane(tilecls[0]); S.G = nb; S.c = bid;
            for (int rep = 0; rep < REP_MOEB; ++rep) pg8::gemm_phase(lds, S, E, D, D, 512);
        }
    }
    SEAM(PB + 6);
    if (IN(PB + 7)) for (int rep = 0; rep < REP_LNF; ++rep) phase_lnffn(kparams(), LAYER, bid, nb);
    if (LAYER == 0) SEAM(PB + 7);
#undef IN
#undef SEAM
}

__global__ void __launch_bounds__(NTHREADS, 2) mega_fwd(Args a) {
    LAS unsigned char* lds = (LAS unsigned char*)g_lds;
    if (threadIdx.x < 4) ((LAS unsigned*)(lds + LDS_BARW))[threadIdx.x] = 0u;
    if (TPROBE_ID != 0 && threadIdx.x < 4) ((LAS unsigned*)(lds + LDS_TPROBE))[threadIdx.x] = 0u;
    if ((threadIdx.x & 63) == 0) *(LAS int*)(lds + LDS_WIDTAB + 4 * hw_wave_key()) = (int)(threadIdx.x >> 6);
    __syncthreads();
    if (a.ph_hi - a.ph_lo > 1) (void)xcd_barrier_post((unsigned*)(kparams().ws + WS_CTL) + CW_BAR, (volatile LAS unsigned*)(lds + LDS_BARW));
    if (kphase_lo() <= 0 && 0 < kphase_hi()) { for (int rep = 0; rep < REP_CONV; ++rep) phase_convert(kparams(), lds, blockIdx.x, gridDim.x); if (1 < kphase_hi()) grid_barrier(lds); }
    layer_phases<0>(lds);
    layer_phases<1>(lds);
    if (TPROBE_ID != 0 && blockIdx.x == TPROBE_BLOCK && opaque_tid() == 0) {
        const unsigned long long need = ((LAS unsigned long long*)(lds + LDS_TPROBE))[0] * TPROBE_MULT, t0 = wall_clock64();
        while (wall_clock64() - t0 < need) __builtin_amdgcn_s_sleep(8);
    }
}

extern "C" void kernel_launch(void* const* d_in, const int* in_sizes, int n_in, void* d_out, int out_size, void* d_ws, size_t ws_size, hipStream_t stream) {
    static int grid = 0;
    if (!grid) {
        if (n_in != 30 || ws_size < WS_END || out_size != T * D) { fprintf(stderr, "kernel_launch: unexpected shapes n_in %d ws %zu out %d\n", n_in, ws_size, out_size); grid = -1; return; }
        int dev = 0, cus = 0, per_cu = 0;
        if (hipGetDevice(&dev) != hipSuccess || hipDeviceGetAttribute(&cus, hipDeviceAttributeMultiprocessorCount, dev) != hipSuccess) { grid = -1; return; }
        if (hipFuncSetAttribute((const void*)mega_fwd, hipFuncAttributeMaxDynamicSharedMemorySize, LDS_BYTES) != hipSuccess) { fprintf(stderr, "kernel_launch: hipFuncSetAttribute failed\n"); grid = -1; return; }
        if (hipOccupancyMaxActiveBlocksPerMultiprocessor(&per_cu, (const void*)mega_fwd, NTHREADS, LDS_BYTES) != hipSuccess || per_cu < 1)
            fprintf(stderr, "kernel_launch: note: occupancy query reports %d workgroups per CU\n", per_cu);
        grid = cus > 0 ? cus : 256;
    }
    if (grid < 0) return;
    Args a{};
    for (int i = 0; i < 30; ++i) a.P.in[i] = (const float*)d_in[i];
    a.P.out = (unsigned char*)d_out; a.P.ws = (unsigned char*)d_ws;
    (void)hipMemsetAsync((char*)d_ws + WS_CTL, 0, CTL_BYTES, stream);
    constexpr int NL = MK_N_LAUNCHES;
    if (NL == 1) { a.ph_lo = 0; a.ph_hi = NPHASES; hipLaunchKernelGGL(mega_fwd, dim3(grid), dim3(NTHREADS), LDS_BYTES, stream, a); }
    else for (int p = 0; p < NPHASES; ++p) { a.ph_lo = p; a.ph_hi = p + 1; hipLaunchKernelGGL(mega_fwd, dim3(grid), dim3(NTHREADS), LDS_BYTES, stream, a); }
}
```

```cpp
#include <hip/hip_runtime.h>
#include <cstdio>
#include <cstdint>

#ifndef MIX_LREP
#define MIX_LREP 1
#endif
#ifndef MIX_SREP
#define MIX_SREP 1
#endif
#ifndef MIX_EREP
#define MIX_EREP 1
#endif
#define GAS __attribute__((address_space(1)))
#define LAS __attribute__((address_space(3)))
typedef unsigned short bf16_t;
typedef short bf16x8 __attribute__((ext_vector_type(8)));
typedef float f32x4 __attribute__((ext_vector_type(4)));
typedef unsigned u32x4 __attribute__((ext_vector_type(4)));

constexpr int BATCH = 32, SEQ = 2048, T = BATCH * SEQ, D = 1024;
constexpr int NP = 6400;
constexpr int YOFF = 1024;
constexpr int NCLS = 24, MAXTILES = 280;
constexpr float LN_EPS = 1e-5f, NORM_EPS = 1e-6f;
constexpr float ALPHA = 1.41421356237f;
constexpr int NTHREADS_C = 512;

constexpr int C0_RQ = 0, C0_RK = 512, C0_RV = 1024, C0_MV = 2048, C0_RG = 3072, C0_MQ = 4096, C0_MK = 4608, C0_MO = 5120, C0_MI = 6144, C0_MF = 6148;
constexpr int C1_GQ = 0, C1_GK = 512, C1_GV = 1024, C1_SZ = 2048, C1_GR = 3072, C1_XS = 4096, C1_BM = 5120, C1_CM = 5632, C1_GA = 6144, C1_DT = 6160;

constexpr size_t MiB = 1u << 20;
constexpr size_t WS_CTL = 0, CTL_BYTES = 1 * MiB;
constexpr size_t WS_WIN0 = 2 * MiB;
constexpr size_t WS_WIN1 = 15 * MiB;
constexpr size_t WS_WOUT0 = 28 * MiB;
constexpr size_t WS_WOUT1 = 32 * MiB;
constexpr size_t WS_WGU = 36 * MiB;
constexpr size_t WS_WD = 100 * MiB;
constexpr size_t WS_TOKCLS = 132 * MiB;
constexpr size_t WS_TOKPOS = WS_TOKCLS + (size_t)T * 4;
constexpr size_t WS_TOKDST = WS_TOKPOS + (size_t)T * 4;
constexpr size_t WS_TOKGATE = WS_TOKDST + (size_t)T * 4;
constexpr size_t WS_ROWGATE = WS_TOKGATE + (size_t)T * 8;
constexpr size_t WS_TILECLS = WS_ROWGATE + (size_t)MAXTILES * 256 * 8;
constexpr size_t WS_BIG = 136 * MiB;
constexpr size_t BIG_HS = 0, BIG_H = 160 * MiB, BIG_PRE2 = 320 * MiB, BIG_HS8 = 480 * MiB;
constexpr size_t WS_H8 = WS_BIG + (size_t)T * NP * 2;
constexpr size_t WS_WIN8_0 = WS_H8 + (size_t)T * D;
constexpr size_t WS_WIN8_1 = WS_WIN8_0 + (size_t)NP * D;
constexpr size_t WS_END = WS_WIN8_1 + (size_t)NP * D;
static_assert(WS_TILECLS + (MAXTILES + 8) * 4 <= WS_BIG, "ws map");
static_assert(WS_END <= 1024 * MiB, "ws map");
constexpr size_t OUT_H = 0, OUT_PRE1 = 128 * MiB;
constexpr int CW_CNT = 1024;
constexpr int CW_BAR = 4096;

__device__ __forceinline__ unsigned f2bf(float f) { unsigned u = __builtin_bit_cast(unsigned, f); return (u + 0x7fffu + ((u >> 16) & 1u)) >> 16; }
__device__ __forceinline__ unsigned pk2(float lo, float hi) { return f2bf(lo) | (f2bf(hi) << 16); }
__device__ __forceinline__ float bf2f(unsigned short b) { return __builtin_bit_cast(float, ((unsigned)b) << 16); }
__device__ __forceinline__ float bflo(unsigned w) { return __builtin_bit_cast(float, w << 16); }
__device__ __forceinline__ float bfhi(unsigned w) { return __builtin_bit_cast(float, w & 0xffff0000u); }
__device__ __forceinline__ float sigmoidf_(float x) { return 1.f / (1.f + __expf(-x)); }
__device__ __forceinline__ float siluf_(float x) { return x / (1.f + __expf(-x)); }
__device__ __forceinline__ float softplusf_(float x) { return x > 20.f ? x : log1pf(expf(x)); }
__device__ __forceinline__ float logsigmoidf_(float x) { return -softplusf_(-x); }
__device__ __forceinline__ float wave_sum(float v) {
#define WS_DPP(ctrl, rm) v += __builtin_bit_cast(float, __builtin_amdgcn_update_dpp(0, __builtin_bit_cast(int, v), ctrl, rm, 0xf, false))
    WS_DPP(0x111, 0xf); WS_DPP(0x112, 0xf); WS_DPP(0x114, 0xf); WS_DPP(0x118, 0xf); WS_DPP(0x142, 0xa); WS_DPP(0x143, 0xc);
#undef WS_DPP
    return __builtin_bit_cast(float, __builtin_amdgcn_readlane(__builtin_bit_cast(int, v), 63));
}
#define LDS_WAIT() asm volatile("s_waitcnt lgkmcnt(0)" ::: "memory")
__device__ __forceinline__ unsigned pk4_fp8(float a, float b, float c, float d) { int w = __builtin_amdgcn_cvt_pk_fp8_f32(a, b, 0, false); w = __builtin_amdgcn_cvt_pk_fp8_f32(c, d, w, true); return (unsigned)w; }
#ifndef MOE_FP8
#define MOE_FP8(layer) ((layer) >= 0)
#endif
#ifndef MOEA_FP8
#define MOEA_FP8 1
#endif
#ifndef INPROJ_FP8MASK0
#define INPROJ_FP8MASK0 0x00fcfffcu
#endif
#ifndef INPROJ_FP8MASK1
#define INPROJ_FP8MASK1 0x01ffffffu
#endif
constexpr unsigned ALLTILES = 0x01ffffffu;
#ifndef INPROJ_FP8
#define INPROJ_FP8(layer) ((layer) == 1)
#endif
constexpr float H8_SCALE = 8.f, W8_SCALE = 256.f;
#ifndef TPROBE_ID
#define TPROBE_ID 0
#endif
#ifndef TPROBE_BLOCK
#define TPROBE_BLOCK 128
#endif
#ifndef TPROBE_MULT
#define TPROBE_MULT 4
#endif
constexpr int LDS_TPROBE = 163840 - 48;
__device__ __forceinline__ int opaque_tid();
__device__ __forceinline__ void tp_begin(LAS unsigned char* lds, int id) { if (TPROBE_ID != 0 && TPROBE_ID == id && opaque_tid() == 0) ((LAS unsigned long long*)(lds + LDS_TPROBE))[1] = wall_clock64(); }
__device__ __forceinline__ void tp_end(LAS unsigned char* lds, int id) { if (TPROBE_ID != 0 && TPROBE_ID == id && opaque_tid() == 0) { LAS unsigned long long* p = (LAS unsigned long long*)(lds + LDS_TPROBE); p[0] += wall_clock64() - p[1]; } }
extern __shared__ __attribute__((aligned(16))) unsigned char g_lds[];
constexpr int LDS_WIDTAB = 163840 - 512;
__device__ __forceinline__ int hw_wave_key() { return (int)__builtin_amdgcn_s_getreg((5 << 11) | 4) & 63; }
__device__ __forceinline__ int opaque_tid() {
    const int wid = __builtin_amdgcn_readfirstlane(*(volatile LAS int*)((LAS unsigned char*)g_lds + LDS_WIDTAB + 4 * hw_wave_key()));
    int t = wid * 64 + (int)__builtin_amdgcn_mbcnt_hi(~0u, __builtin_amdgcn_mbcnt_lo(~0u, 0u)); asm volatile("" : "+v"(t)); return t; }

namespace pg8 {
constexpr int BM = 256, BK = 64, HALF = 128, HTB = HALF * BK * 2, STAGE_BYTES = 8 * HTB, NXCD = 8, WGM = 8;
__host__ __device__ __forceinline__ int lds_byte(int r, int c) { const int st = (r >> 4) * 2 + (c >> 5), rr = r & 15, cc = c & 31, ob = rr * 64 + cc * 2; return st * 1024 + (ob ^ (((ob >> 9) & 1) << 5)); }
__host__ __device__ __forceinline__ void stage_rc(int b, int& R, int& C) { const int st = b / 1024, sb = b % 1024, swz = sb ^ (((sb >> 9) & 1) << 5); R = (st >> 1) * 16 + swz / 64; C = (st & 1) * 32 + (swz % 64) / 2; }
__host__ __device__ __forceinline__ int perm32(int rho) { const int n = rho >> 4, i = rho & 15; return 8 * (i >> 2) + 4 * n + (i & 3); }

struct Unit { int pm, pn; unsigned a, b0, b1; };

__device__ __forceinline__ bool static_tile(int i, int G, int c, int nM, int nN, int& pm, int& pn) {
    const int nwg = nM * nN; const int L = i * G + c; if (L >= nwg) return false;
    int wgid = L; { const int q = nwg / NXCD, r = nwg % NXCD, xcd = wgid % NXCD, off = wgid / NXCD; wgid = (xcd < r ? xcd * (q + 1) : r * (q + 1) + (xcd - r) * q) + off; }
    const int nig = WGM * nN, gid = wgid / nig, fm = gid * WGM, gsz = (nM - fm) < WGM ? (nM - fm) : WGM;
    pm = fm + ((wgid % nig) % gsz); pn = (wgid % nig) / gsz; return true;
}
template <class Tp> __device__ __forceinline__ Tp* uniform_ptr(Tp* p) {
    const unsigned long long v = (unsigned long long)p;
    const unsigned lo = __builtin_amdgcn_readfirstlane((unsigned)v), hi = __builtin_amdgcn_readfirstlane((unsigned)(v >> 32));
    return (Tp*)(((unsigned long long)hi << 32) | lo); }
__device__ __forceinline__ unsigned cvt_pk_bf16(float lo, float hi) { unsigned r; asm volatile("v_cvt_pk_bf16_f32 %0, %1, %2" : "=v"(r) : "v"(lo), "v"(hi)); return r; }

typedef int i32x8 __attribute__((ext_vector_type(8)));
typedef int i32x4v __attribute__((ext_vector_type(4)));
__device__ __forceinline__ i32x8 cat16(const bf16x8& lo, const bf16x8& hi) { const i32x4v a = __builtin_bit_cast(i32x4v, lo), b = __builtin_bit_cast(i32x4v, hi); return (i32x8){a[0], a[1], a[2], a[3], b[0], b[1], b[2], b[3]}; }
#ifndef PG8_SP2
#define PG8_SP2 true
#endif
#ifndef PG8_ALIGN
#define PG8_ALIGN true
#endif
template <class Epi, class Sched, bool FP8 = false, int SCA = 0x7f7f7f7f, int SCB = 0x7f7f7f7f, bool SP2 = PG8_SP2, bool ALIGN_EPI = PG8_ALIGN>
__device__ __forceinline__ void gemm_phase(LAS unsigned char* lds, const Sched& S, const Epi& E, const int K, const int lda, const int ldb) {
    const int tid = opaque_tid(), wid = __builtin_amdgcn_readfirstlane(tid >> 6), lane = tid & 63, wr = wid >> 2, wc = wid & 3, fr = lane & 15, fq = lane >> 4;
    int nt = K / BK; asm volatile("" : "+s"(nt));
    constexpr int KS = Sched::KSPLIT;
    unsigned voffA0, voffB0;
    { int R, C; stage_rc(tid * 16, R, C); const int Rb = (R & ~31) + perm32(R & 31); voffA0 = (unsigned)(R * lda + C) * 2u; voffB0 = (unsigned)(Rb * ldb + C) * 2u; }
    const unsigned q64A = 64u * lda * 2u, q64B = 64u * ldb * 2u;
    const unsigned kstep = (unsigned)(BK * 2);
    const unsigned hstepA = (unsigned)HALF * lda * 2, hstepB = (unsigned)HALF * ldb * 2;
    const __amdgpu_buffer_rsrc_t rsA = __builtin_amdgcn_make_buffer_rsrc((void*)S.A, 0, 0xffffffff, 0x00020000), rsB = __builtin_amdgcn_make_buffer_rsrc((void*)S.bbase(), 0, 0xffffffff, 0x00020000);
    const unsigned ldsw = (unsigned)wid * 1024u;
    const int aoff = lds_byte(wr * 64 + fr, fq * 8), boff = lds_byte(wc * 32 + fr, fq * 8);
#define PG8_BP(u, kt) ((KS > 0 && (kt) >= KS) ? (u).b1 + (unsigned)((kt) - KS) * kstep : (u).b0 + (unsigned)(kt) * kstep)
#define PG8_SA(b, h) (((b) * 2 + (h)) * HTB)
#define PG8_SB(b, h) ((4 + (b) * 2 + (h)) * HTB)
#define PG8_STAGEA(bufoff, soff) do { _Pragma("unroll") for (int _i = 0; _i < 2; ++_i) \
        __builtin_amdgcn_raw_ptr_buffer_load_lds(rsA, (LAS void*)(lds + (bufoff) + ldsw + _i * 8192), 16, voffA0, (int)((soff) + _i * q64A), 0, 0); } while (0)
#define PG8_STAGEB(bufoff, soff) do { _Pragma("unroll") for (int _i = 0; _i < 2; ++_i) \
        __builtin_amdgcn_raw_ptr_buffer_load_lds(rsB, (LAS void*)(lds + (bufoff) + ldsw + _i * 8192), 16, voffB0, (int)((soff) + _i * q64B), 0, 0); } while (0)
#define PG8_LDA(dst, b, h) do { _Pragma("unroll") for (int m = 0; m < 4; ++m) _Pragma("unroll") for (int k = 0; k < 2; ++k) dst[m][k] = *(const LAS bf16x8*)(lds + PG8_SA(b, h) + aoff + m * 2048 + k * 1024); } while (0)
#define PG8_LDB(dst, b, h) do { _Pragma("unroll") for (int n = 0; n < 2; ++n) _Pragma("unroll") for (int k = 0; k < 2; ++k) dst[n][k] = *(const LAS bf16x8*)(lds + PG8_SB(b, h) + boff + n * 2048 + k * 1024); } while (0)
#define PG8_MMA(ai, bj, At, Bt) do { __builtin_amdgcn_s_setprio(1); _Pragma("unroll") for (int m = 0; m < 4; ++m) _Pragma("unroll") for (int n = 0; n < 2; ++n) { \
        if constexpr (FP8) acc[ai][bj][m][n] = __builtin_amdgcn_mfma_scale_f32_16x16x128_f8f6f4(cat16(Bt[n][0], Bt[n][1]), cat16(At[m][0], At[m][1]), acc[ai][bj][m][n], 0, 0, 1, ((SCB & 0xff) << 8) | (SCA & 0xff), 0, ((SCB & 0xff) << 8) | (SCA & 0xff)); \
        else { _Pragma("unroll") for (int k = 0; k < 2; ++k) acc[ai][bj][m][n] = __builtin_amdgcn_mfma_f32_16x16x32_bf16(Bt[n][k], At[m][k], acc[ai][bj][m][n], 0, 0, 0); } } \
        __builtin_amdgcn_s_setprio(0); } while (0)
#define PG8_WAIT_V(n) asm volatile("s_waitcnt vmcnt(" #n ")" ::: "memory")
#define PG8_WAIT_L(n) asm volatile("s_waitcnt lgkmcnt(" #n ")" ::: "memory")
#define PG8_BAR __builtin_amdgcn_s_barrier()
#define PG8_SCHED __builtin_amdgcn_sched_barrier(0)
    Unit cur, nxt; int ui = 0;
    if (!S.next(0, cur)) return;
    f32x4 acc[2][2][4][2];
#pragma unroll
    for (int a = 0; a < 2; ++a)
#pragma unroll
        for (int b = 0; b < 2; ++b)
#pragma unroll
            for (int m = 0; m < 4; ++m)
#pragma unroll
                for (int n = 0; n < 2; ++n) acc[a][b][m][n] = (f32x4){0.f, 0.f, 0.f, 0.f};
    bf16x8 At[4][2], B0[2][2], B1[2][2];
    unsigned cA = cur.a;
    E.prefetch(cur, tid);
    { const unsigned cB0 = PG8_BP(cur, 0), cB1 = PG8_BP(cur, 1);
    if constexpr (SP2) {
        PG8_STAGEB(PG8_SB(0, 0), cB0); PG8_STAGEB(PG8_SB(0, 1), cB0 + hstepB); PG8_STAGEA(PG8_SA(0, 0), cA); PG8_STAGEA(PG8_SA(0, 1), cA + hstepA);
        if (wr == 1) PG8_BAR;
        PG8_WAIT_V(2); PG8_BAR;
        PG8_STAGEB(PG8_SB(1, 0), cB1); PG8_STAGEA(PG8_SA(1, 0), cA + kstep); PG8_STAGEB(PG8_SB(1, 1), cB1 + hstepB);
        PG8_WAIT_V(6); PG8_BAR;
    } else {
    PG8_STAGEB(PG8_SB(0, 0), cB0); PG8_STAGEA(PG8_SA(0, 0), cA); PG8_STAGEB(PG8_SB(0, 1), cB0 + hstepB); PG8_STAGEA(PG8_SA(0, 1), cA + hstepA);
    if (wr == 1) PG8_BAR;
    PG8_WAIT_V(4); PG8_BAR;
    PG8_STAGEB(PG8_SB(1, 0), cB1); PG8_STAGEA(PG8_SA(1, 0), cA + kstep); PG8_STAGEB(PG8_SB(1, 1), cB1 + hstepB);
    PG8_WAIT_V(6); PG8_BAR; } }
    for (;;) {
        const bool has_next = S.next(ui + 1, nxt);
        if (!has_next) nxt = cur;
        for (int t = 0; t < nt; t += 2) {
            const bool last = (t == nt - 2);
            const unsigned a1 = cA + (unsigned)(t + 1) * kstep;
            const unsigned a2 = last ? nxt.a : cA + (unsigned)(t + 2) * kstep;
            const unsigned b2 = last ? PG8_BP(nxt, 0) : PG8_BP(cur, t + 2);
            const unsigned a3 = a2 + kstep;
            const unsigned b3 = last ? PG8_BP(nxt, 1) : PG8_BP(cur, t + 3);
            if constexpr (SP2) {
            PG8_LDB(B0, 0, 0); PG8_LDB(B1, 0, 1); PG8_SCHED; PG8_LDA(At, 0, 0); PG8_STAGEA(PG8_SA(1, 1), a1 + hstepA);
            PG8_WAIT_V(8); PG8_WAIT_L(0); PG8_BAR; PG8_MMA(0, 0, At, B0); PG8_MMA(0, 1, At, B1); PG8_BAR; PG8_SCHED;
            PG8_LDA(At, 0, 1); PG8_STAGEB(PG8_SB(0, 0), b2); PG8_STAGEB(PG8_SB(0, 1), b2 + hstepB); PG8_STAGEA(PG8_SA(0, 0), a2);
            PG8_WAIT_V(8); PG8_WAIT_L(0); PG8_BAR; PG8_MMA(1, 0, At, B0); PG8_MMA(1, 1, At, B1); PG8_BAR; PG8_SCHED;
            PG8_LDB(B0, 1, 0); PG8_LDB(B1, 1, 1); PG8_SCHED; PG8_LDA(At, 1, 0); PG8_STAGEA(PG8_SA(0, 1), a2 + hstepA);
            PG8_WAIT_V(8); PG8_WAIT_L(0); PG8_BAR; PG8_MMA(0, 0, At, B0); PG8_MMA(0, 1, At, B1); PG8_BAR; PG8_SCHED;
            PG8_LDA(At, 1, 1); PG8_STAGEB(PG8_SB(1, 0), b3); PG8_STAGEB(PG8_SB(1, 1), b3 + hstepB); PG8_STAGEA(PG8_SA(1, 0), a3);
            PG8_WAIT_V(8); PG8_WAIT_L(0); PG8_BAR; PG8_MMA(1, 0, At, B0); PG8_MMA(1, 1, At, B1); PG8_BAR; PG8_SCHED;
            } else {
            PG8_LDB(B0, 0, 0); PG8_SCHED; PG8_LDA(At, 0, 0); PG8_STAGEA(PG8_SA(1, 1), a1 + hstepA);
            PG8_WAIT_L(8); PG8_BAR; PG8_WAIT_L(0); PG8_MMA(0, 0, At, B0); PG8_BAR; PG8_SCHED;
            PG8_LDB(B1, 0, 1); PG8_STAGEB(PG8_SB(0, 0), b2);
            PG8_BAR; PG8_WAIT_L(0); PG8_MMA(0, 1, At, B1); PG8_BAR;
            PG8_LDA(At, 0, 1); PG8_STAGEA(PG8_SA(0, 0), a2);
            PG8_BAR; PG8_WAIT_L(0); PG8_MMA(1, 0, At, B0); PG8_BAR; PG8_SCHED;
            PG8_STAGEB(PG8_SB(0, 1), b2 + hstepB);
            PG8_WAIT_V(6); PG8_BAR; PG8_MMA(1, 1, At, B1); PG8_BAR;
            PG8_LDB(B0, 1, 0); PG8_SCHED; PG8_LDA(At, 1, 0); PG8_STAGEA(PG8_SA(0, 1), a2 + hstepA);
            PG8_WAIT_L(8); PG8_BAR; PG8_WAIT_L(0); PG8_MMA(0, 0, At, B0); PG8_BAR; PG8_SCHED;
            PG8_LDB(B1, 1, 1); PG8_STAGEB(PG8_SB(1, 0), b3);
            PG8_BAR; PG8_WAIT_L(0); PG8_MMA(0, 1, At, B1); PG8_BAR;
            PG8_LDA(At, 1, 1); PG8_STAGEA(PG8_SA(1, 0), a3);
            PG8_BAR; PG8_WAIT_L(0); PG8_MMA(1, 0, At, B0); PG8_BAR; PG8_SCHED;
            PG8_STAGEB(PG8_SB(1, 1), b3 + hstepB);
            PG8_WAIT_V(6); PG8_BAR; PG8_MMA(1, 1, At, B1); PG8_BAR;
            }
        }
        if constexpr (ALIGN_EPI) { if (wr == 0) PG8_BAR; }
        E(acc, cur, wr, wc, fr, fq);
        if (!has_next) break;
#pragma unroll
        for (int a = 0; a < 2; ++a)
#pragma unroll
            for (int b = 0; b < 2; ++b)
#pragma unroll
                for (int m = 0; m < 4; ++m)
#pragma unroll
                    for (int n = 0; n < 2; ++n) acc[a][b][m][n] = (f32x4){0.f, 0.f, 0.f, 0.f};
        cur = nxt; cA = cur.a; ++ui;
        E.prefetch(cur, tid);
        if constexpr (ALIGN_EPI) { if (wr == 1) PG8_BAR; }
    }
    PG8_WAIT_V(0);
    if constexpr (!ALIGN_EPI) { if (wr == 0) PG8_BAR; }
    PG8_BAR;
#undef PG8_BP
#undef PG8_SA
#undef PG8_SB
#undef PG8_STAGEA
#undef PG8_STAGEB
#undef PG8_LDA
#undef PG8_LDB
#undef PG8_MMA
#undef PG8_WAIT_V
#undef PG8_WAIT_L
#undef PG8_BAR
#undef PG8_SCHED
}

struct SchedPlain {
    static constexpr int KSPLIT = 0;
    const char* A; const char* B; int lda, ldb, nM, nN, G, c;
    __device__ __forceinline__ const char* bbase() const { return B; }
    __device__ __forceinline__ bool next(int i, Unit& u) const {
        if (!static_tile(i, G, c, nM, nN, u.pm, u.pn)) return false;
        u.a = (unsigned)u.pm * BM * lda * 2; u.b0 = (unsigned)u.pn * BM * ldb * 2; u.b1 = u.b0; return true;
    }
};
struct SchedCols {
    static constexpr int KSPLIT = 0;
    const char* A; const char* B; int lda, ldb, nM, nN, G, c; unsigned mask;
    __device__ __forceinline__ const char* bbase() const { return B; }
    __device__ __forceinline__ bool next(int i, Unit& u) const {
        int pnj; if (!static_tile(i, G, c, nM, nN, u.pm, pnj)) return false;
        unsigned m = mask; for (int j = 0; j < pnj; ++j) m &= m - 1u;
        u.pn = __builtin_ctz(m);
        u.a = (unsigned)u.pm * BM * lda * 2; u.b0 = (unsigned)u.pn * BM * ldb * 2; u.b1 = u.b0; return true;
    }
};
__device__ __forceinline__ void cls_experts(int cls, int& e0, int& e1) {
    const int g = cls / 6, p = cls % 6;
    const int a = p < 3 ? 0 : (p < 5 ? 1 : 2);
    const int b = p < 3 ? p + 1 : (p < 5 ? p - 1 : 3);
    e0 = 4 * g + a; e1 = 4 * g + b;
}
template <bool FP8>
struct SchedMoeA {
    static constexpr int KSPLIT = 0;
    static constexpr int RB = FP8 ? 1024 : 2048;
    const char* A; const char* Wgu; const int* tilecls; int nM, G, c;
    __device__ __forceinline__ const char* bbase() const { return Wgu; }
    __device__ __forceinline__ bool next(int i, Unit& u) const {
        if (!static_tile(i, G, c, nM, 8, u.pm, u.pn)) return false;
        int e0, e1; cls_experts(__builtin_amdgcn_readfirstlane(tilecls[8 + u.pm]), e0, e1); const int e = (u.pn >> 2) ? e1 : e0;
        u.a = (unsigned)u.pm * BM * RB; u.b0 = (unsigned)e * 2097152u + (unsigned)(u.pn & 3) * 256 * RB; u.b1 = u.b0; return true;
    }
};
template <bool FP8>
struct SchedMoeB {
    static constexpr int KSPLIT = FP8 ? 4 : 8;
    static constexpr int RA = FP8 ? 1024 : 2048, RBB = FP8 ? 512 : 1024;
    const char* A; const char* Wd; const int* tilecls; int nM, G, c;
    __device__ __forceinline__ const char* bbase() const { return Wd; }
    __device__ __forceinline__ bool next(int i, Unit& u) const {
        if (!static_tile(i, G, c, nM, 4, u.pm, u.pn)) return false;
        int e0, e1; cls_experts(__builtin_amdgcn_readfirstlane(tilecls[8 + u.pm]), e0, e1);
        u.a = (unsigned)u.pm * BM * RA;
        u.b0 = (unsigned)e0 * 1048576u + (unsigned)u.pn * 256 * RBB; u.b1 = (unsigned)e1 * 1048576u + (unsigned)u.pn * 256 * RBB; return true;
    }
};

struct EpiStore {
    bf16_t* O; int ldc;
    __device__ __forceinline__ void prefetch(const Unit&, int) const {}
    __device__ __forceinline__ void operator()(const f32x4 (&acc)[2][2][4][2], const Unit& u, int wr, int wc, int fr, int fq) const {
        const int row0 = u.pm * BM + wr * 64 + fr, col0 = u.pn * BM + wc * 32 + 8 * fq;
#pragma unroll
        for (int ai = 0; ai < 2; ++ai)
#pragma unroll
            for (int m = 0; m < 4; ++m) { bf16_t* rowp = O + (size_t)(row0 + ai * HALF + m * 16) * ldc + col0;
#pragma unroll
                for (int bj = 0; bj < 2; ++bj) { const f32x4 v0 = acc[ai][bj][m][0], v1 = acc[ai][bj][m][1];
                    u32x4 w; w.x = cvt_pk_bf16(v0[0], v0[1]); w.y = cvt_pk_bf16(v0[2], v0[3]); w.z = cvt_pk_bf16(v1[0], v1[1]); w.w = cvt_pk_bf16(v1[2], v1[3]);
                    *(u32x4*)(rowp + bj * HALF) = w; } }
    }
};
struct EpiResid {
    bf16_t* O; const bf16_t* R;
    __device__ __forceinline__ void prefetch(const Unit& u, int tid) const {
        const bf16_t* p = R + (size_t)(u.pm * BM + (tid >> 1)) * 1024 + u.pn * BM + 128 * (tid & 1);
        asm volatile("s_mov_b32 m0, %2\n\ts_nop 0\n\tglobal_load_lds_dword %0, off\n\ts_mov_b32 m0, %3\n\ts_nop 0\n\tglobal_load_lds_dword %1, off"
                     :: "v"(p), "v"(p + 64), "s"(160768u), "s"(161024u) : "memory", "m0");
    }
    __device__ __forceinline__ void operator()(const f32x4 (&acc)[2][2][4][2], const Unit& u, int wr, int wc, int fr, int fq) const {
        const int row0 = u.pm * BM + wr * 64 + fr, col0 = u.pn * BM + wc * 32 + 8 * fq;
#pragma unroll
        for (int ai = 0; ai < 2; ++ai)
#pragma unroll
            for (int m = 0; m < 4; ++m) { const size_t off = (size_t)(row0 + ai * HALF + m * 16) * 1024 + col0;
#pragma unroll
                for (int bj = 0; bj < 2; ++bj) { const f32x4 v0 = acc[ai][bj][m][0], v1 = acc[ai][bj][m][1];
                    const u32x4 r = *(const u32x4*)(R + off + bj * HALF);
                    u32x4 w; w.x = cvt_pk_bf16(v0[0] + ALPHA * bflo(r.x), v0[1] + ALPHA * bfhi(r.x)); w.y = cvt_pk_bf16(v0[2] + ALPHA * bflo(r.y), v0[3] + ALPHA * bfhi(r.y));
                    w.z = cvt_pk_bf16(v1[0] + ALPHA * bflo(r.z), v1[1] + ALPHA * bfhi(r.z)); w.w = cvt_pk_bf16(v1[2] + ALPHA * bflo(r.w), v1[3] + ALPHA * bfhi(r.w));
                    *(u32x4*)(O + off + bj * HALF) = w; } }
    }
};
struct EpiSwiglu {
    bf16_t* H; const float* rowgate;
    __device__ __forceinline__ void prefetch(const Unit&, int) const {}
    __device__ __forceinline__ void operator()(const f32x4 (&acc)[2][2][4][2], const Unit& u, int wr, int wc, int fr, int fq) const {
        const int row0 = u.pm * BM + wr * 64 + fr, ke = u.pn >> 2, col0 = 512 * ke + 128 * (u.pn & 3) + wc * 32 + 8 * fq;
#pragma unroll
        for (int ai = 0; ai < 2; ++ai)
#pragma unroll
            for (int m = 0; m < 4; ++m) { const int row = row0 + ai * HALF + m * 16; const float gt = rowgate[(size_t)row * 2 + ke];
                const f32x4 g0 = acc[ai][0][m][0], g1 = acc[ai][0][m][1], u0 = acc[ai][1][m][0], u1 = acc[ai][1][m][1];
                float o[8];
#pragma unroll
                for (int j = 0; j < 4; ++j) { o[j] = siluf_(g0[j]) * u0[j] * gt; o[4 + j] = siluf_(g1[j]) * u1[j] * gt; }
                u32x4 w; w.x = cvt_pk_bf16(o[0], o[1]); w.y = cvt_pk_bf16(o[2], o[3]); w.z = cvt_pk_bf16(o[4], o[5]); w.w = cvt_pk_bf16(o[6], o[7]);
                *(u32x4*)(H + (size_t)row * 1024 + col0) = w; }
    }
};
struct EpiSwiglu8 {
    unsigned char* H; const float* rowgate;
    __device__ __forceinline__ void prefetch(const Unit&, int) const {}
    __device__ __forceinline__ void operator()(const f32x4 (&acc)[2][2][4][2], const Unit& u, int wr, int wc, int fr, int fq) const {
        typedef unsigned u32x2 __attribute__((ext_vector_type(2)));
        const int row0 = u.pm * BM + wr * 64 + fr, ke = u.pn >> 2, col0 = 512 * ke + 128 * (u.pn & 3) + wc * 32 + 8 * fq;
        unsigned char* const H = uniform_ptr(this->H); const float* const rowgate = uniform_ptr(this->rowgate);
#pragma unroll
        for (int ai = 0; ai < 2; ++ai)
#pragma unroll
            for (int m = 0; m < 4; ++m) { const int row = row0 + ai * HALF + m * 16; const float gt = rowgate[(size_t)row * 2 + ke] * 8.f;
                const f32x4 g0 = acc[ai][0][m][0], g1 = acc[ai][0][m][1], u0 = acc[ai][1][m][0], u1 = acc[ai][1][m][1];
                float o[8];
#pragma unroll
                for (int j = 0; j < 4; ++j) { o[j] = __builtin_amdgcn_fmed3f(g0[j] * __builtin_amdgcn_rcpf(1.f + __builtin_amdgcn_exp2f(-1.4426950408889634f * g0[j])) * u0[j] * gt, -440.f, 440.f);
                    o[4 + j] = __builtin_amdgcn_fmed3f(g1[j] * __builtin_amdgcn_rcpf(1.f + __builtin_amdgcn_exp2f(-1.4426950408889634f * g1[j])) * u1[j] * gt, -440.f, 440.f); }
                *(u32x2*)(H + (size_t)row * 1024 + col0) = (u32x2){pk4_fp8(o[0], o[1], o[2], o[3]), pk4_fp8(o[4], o[5], o[6], o[7])}; }
    }
};
}

struct Params {
    const float* in[30];
    unsigned char* out;
    unsigned char* ws;
};
enum { I_X = 0, I_POS, I_WINAB, I_RETG, I_MLCW, I_MLCB, I_MLBI, I_MLBF, I_MLG, I_WOUTAB, I_WINCD, I_GLAWA, I_GLABA, I_GLAG, I_SSDCW, I_SSDCB, I_SSDDTB, I_SSDALOG, I_SSDD, I_SSDG,
       I_WOUTCD, I_WR, I_BR, I_MOEG, I_MOEU, I_MOED, I_LNMG, I_LNMB, I_LNFG, I_LNFB };

template <class ColPtr>
__device__ __forceinline__ void tr_item(const ColPtr& cp, int ldw, bf16_t* WT, int ldt, int n0, int k0, LAS float* scr, int lane) {
    const float* p = cp(n0 + (lane & 31));
#pragma unroll 8
    for (int i = 0; i < 32; ++i) { const int kk = 2 * i + (lane >> 5); scr[kk * 33 + (lane & 31)] = p ? p[(size_t)(k0 + kk) * ldw] : 0.f; }
    LDS_WAIT();
    const int c = lane & 7;
#pragma unroll
    for (int j = 0; j < 4; ++j) { const int n = (lane >> 3) + 8 * j; const LAS float* s = scr + (8 * c) * 33 + n;
        u32x4 o; o.x = pk2(s[0 * 33], s[1 * 33]); o.y = pk2(s[2 * 33], s[3 * 33]); o.z = pk2(s[4 * 33], s[5 * 33]); o.w = pk2(s[6 * 33], s[7 * 33]);
        *(u32x4*)(WT + (size_t)(n0 + n) * ldt + k0 + 8 * c) = o; }
    LDS_WAIT();
}
template <class ColPtr>
__device__ __forceinline__ void tr_item_fp8(const ColPtr& cp, int ldw, unsigned char* WT, int ldt, int n0, int k0, float scale, LAS float* scr, int lane) {
    const float* p = cp(n0 + (lane & 31));
#pragma unroll 8
    for (int i = 0; i < 32; ++i) { const int kk = 2 * i + (lane >> 5); scr[kk * 33 + (lane & 31)] = p ? p[(size_t)(k0 + kk) * ldw] * scale : 0.f; }
    LDS_WAIT();
    const int c = lane & 7;
    typedef unsigned u32x2 __attribute__((ext_vector_type(2)));
#pragma unroll
    for (int j = 0; j < 4; ++j) { const int n = (lane >> 3) + 8 * j; const LAS float* s = scr + (8 * c) * 33 + n;
        *(u32x2*)(WT + (size_t)(n0 + n) * ldt + k0 + 8 * c) = (u32x2){pk4_fp8(s[0 * 33], s[1 * 33], s[2 * 33], s[3 * 33]), pk4_fp8(s[4 * 33], s[5 * 33], s[6 * 33], s[7 * 33])}; }
    LDS_WAIT();
}
__device__ __forceinline__ int map_ab(int n) {
    if (n < 2048) return n;
    if (n < 3072) return 4096 + (n - 2048);
    if (n < 4096) return 2048 + (n - 3072);
    if (n < 4608) return 3072 + (n - 4096);
    if (n < 5120) return 3584 + (n - 4608);
    if (n < 6152) return n;
    return -1;
}
__device__ __forceinline__ int map_cd(int n) {
    if (n < 2048) return n;
    if (n < 3072) return 3088 + (n - 2048);
    if (n < 4096) return 2048 + (n - 3072);
    if (n < 5120) return 4112 + (n - 4096);
    if (n < 5632) return 5136 + (n - 5120);
    if (n < 6144) return 5648 + (n - 5632);
    if (n < 6160) return 3072 + (n - 6144);
    if (n < 6176) return 6160 + (n - 6160);
    return -1;
}
template <bool FP8, class ColPtr>
__device__ __forceinline__ void tr_block(const ColPtr& cp, int ldw, void* WT, int ldt, int n0, int k0, float scale, LAS float* tile, int tid) {
    {   const int c4 = tid & 63, r0 = tid >> 6;
        const float* p = cp(n0 + 4 * c4);
        f32x4 v[8];
#pragma unroll
        for (int i = 0; i < 8; ++i) v[i] = p ? *(const f32x4*)(p + (size_t)(k0 + r0 + 8 * i) * ldw) : (f32x4){0.f, 0.f, 0.f, 0.f};
#pragma unroll
        for (int i = 0; i < 8; ++i) { LAS float* t = tile + (r0 + 8 * i) * 257 + 4 * c4; t[0] = v[i][0] * scale; t[1] = v[i][1] * scale; t[2] = v[i][2] * scale; t[3] = v[i][3] * scale; }
    }
    __syncthreads();
    {   const int kc = tid & 7, nr = tid >> 3;
#pragma unroll
        for (int j = 0; j < 4; ++j) { const int n = nr + 64 * j; const LAS float* t = tile + (8 * kc) * 257 + n;
            if constexpr (FP8) { typedef unsigned u32x2 __attribute__((ext_vector_type(2)));
                *(u32x2*)((unsigned char*)WT + (size_t)(n0 + n) * ldt + k0 + 8 * kc) = (u32x2){pk4_fp8(t[0], t[257], t[514], t[771]), pk4_fp8(t[1028], t[1285], t[1542], t[1799])}; }
            else { u32x4 o; o.x = pk2(t[0], t[257]); o.y = pk2(t[514], t[771]); o.z = pk2(t[1028], t[1285]); o.w = pk2(t[1542], t[1799]);
                *(u32x4*)((bf16_t*)WT + (size_t)(n0 + n) * ldt + k0 + 8 * kc) = o; } }
    }
    __syncthreads();
}
__device__ __forceinline__ void convert_moe(const Params& P, LAS unsigned char* lds, int bid, int nb) {
    const int tid = opaque_tid();
    LAS float* tile = (LAS float*)lds;
    unsigned char* ws = P.ws;
    constexpr int B_GU = (1024 / 256) * (1024 / 64);
    constexpr int B_DN = (1024 / 256) * (512 / 64);
    constexpr int B_IN = (NP / 256) * (D / 64);
    constexpr int B_OUT = (1024 / 256) * (2048 / 64);
#pragma unroll 1
    for (int it = bid; it < 32 * B_GU + 32 * B_DN + B_IN + 2 * B_OUT; it += nb) {
        int r = it;
        if (r < B_IN) { const int nbk = r / (D / 64), kb = r % (D / 64);
            const float* W = P.in[I_WINCD];
            auto cp = [&](int n) { const int sc = map_cd(n); return sc < 0 ? (const float*)nullptr : W + sc; };
            if ((INPROJ_FP8MASK1 >> nbk) & 1u) tr_block<true>(cp, 6176, ws + WS_WIN8_1, D, nbk * 256, kb * 64, W8_SCALE, tile, tid); else tr_block<false>(cp, 6176, ws + WS_WIN1, D, nbk * 256, kb * 64, 1.f, tile, tid);
            continue; }
        r -= B_IN;
        if (r < 2 * B_OUT) { const int l = r / B_OUT; r %= B_OUT; const int nbk = r / 32, kb = r % 32;
            const float* W = P.in[l ? I_WOUTCD : I_WOUTAB];
            tr_block<false>([&](int n) { return W + n; }, 1024, ws + (l ? WS_WOUT1 : WS_WOUT0), 2048, nbk * 256, kb * 64, 1.f, tile, tid);
            continue; }
        r -= 2 * B_OUT;
        if (r < 32 * B_GU) { const int le = r / B_GU; r %= B_GU; const int nbk = r / 16, kb = r % 16;
            const float* Wg = P.in[I_MOEG] + (size_t)le * 1024 * 512 + 128 * nbk; const float* Wu = P.in[I_MOEU] + (size_t)le * 1024 * 512 + 128 * nbk; const int n0 = nbk * 256;
            auto cp = [&](int n) { const int wdt = n - n0; return wdt < 128 ? Wg + wdt : Wu + (wdt - 128); };
            if (MOE_FP8(le >> 4) && MOEA_FP8) tr_block<true>(cp, 512, ws + WS_WGU + (size_t)le * 2097152, 1024, n0, kb * 64, W8_SCALE, tile, tid);
            else tr_block<false>(cp, 512, ws + WS_WGU + (size_t)le * 2097152, 1024, n0, kb * 64, 1.f, tile, tid);
            continue; }
        r -= 32 * B_GU;
        { const int le = r / B_DN; r %= B_DN; const int nbk = r / 8, kb = r % 8;
            const float* W = P.in[I_MOED] + (size_t)le * 512 * 1024;
            if (MOE_FP8(le >> 4)) tr_block<true>([&](int n) { return W + n; }, 1024, ws + WS_WD + (size_t)le * 1048576, 512, nbk * 256, kb * 64, W8_SCALE, tile, tid);
            else tr_block<false>([&](int n) { return W + n; }, 1024, ws + WS_WD + (size_t)le * 1048576, 512, nbk * 256, kb * 64, 1.f, tile, tid); }
    }
}
__device__ __forceinline__ void phase_convert(const Params& P, LAS unsigned char* lds, int bid, int nb) {
    const int tid = opaque_tid();
    LAS float* tile = (LAS float*)lds;
    unsigned char* ws = P.ws;
    constexpr int B_IN = (NP / 256) * (D / 64);
    tp_begin(lds, 910);
#pragma unroll 1
    for (int it = bid; it < B_IN; it += nb) {
        const int nbk = it / (D / 64), kb = it % (D / 64);
        const float* W = P.in[I_WINAB];
        auto cp = [&](int n) { const int sc = map_ab(n); return sc < 0 ? (const float*)nullptr : W + sc; };
        if ((INPROJ_FP8MASK0 >> nbk) & 1u) tr_block<true>(cp, 6152, ws + WS_WIN8_0, D, nbk * 256, kb * 64, W8_SCALE, tile, tid); else tr_block<false>(cp, 6152, ws + WS_WIN0, D, nbk * 256, kb * 64, 1.f, tile, tid);
    }
    const int nw = blockDim.x >> 6; (void)nw;
    asm volatile("s_waitcnt vmcnt(0)" ::: "memory"); tp_end(lds, 910); tp_begin(lds, 911);
    const float* x = P.in[I_X]; bf16_t* h = (bf16_t*)(P.out + OUT_H);
    const size_t n8 = (size_t)T * D / 8;
    const size_t stride = (size_t)nb * blockDim.x;
    for (size_t i0 = (size_t)bid * blockDim.x + tid; i0 < n8; i0 += 4 * stride) {
        f32x4 a[4], b[4];
#pragma unroll
        for (int u = 0; u < 4; ++u) { const size_t i = i0 + u * stride; if (i < n8) { a[u] = *(const f32x4*)(x + i * 8); b[u] = *(const f32x4*)(x + i * 8 + 4); } }
#pragma unroll
        for (int u = 0; u < 4; ++u) { const size_t i = i0 + u * stride; if (i < n8) {
            u32x4 o; o.x = pk2(a[u][0], a[u][1]); o.y = pk2(a[u][2], a[u][3]); o.z = pk2(b[u][0], b[u][1]); o.w = pk2(b[u][2], b[u][3]);
            *(u32x4*)(h + i * 8) = o;
            typedef unsigned u32x2 __attribute__((ext_vector_type(2)));
            *(u32x2*)(ws + WS_H8 + i * 8) = (u32x2){pk4_fp8(a[u][0] * H8_SCALE, a[u][1] * H8_SCALE, a[u][2] * H8_SCALE, a[u][3] * H8_SCALE), pk4_fp8(b[u][0] * H8_SCALE, b[u][1] * H8_SCALE, b[u][2] * H8_SCALE, b[u][3] * H8_SCALE)}; } }
    }
    asm volatile("s_waitcnt vmcnt(0)" ::: "memory"); tp_end(lds, 911);
}

__device__ __forceinline__ void load_row_bf16(const bf16_t* row, int lane, float (&v)[16]) {
#pragma unroll
    for (int j = 0; j < 2; ++j) { const u32x4 w = *(const u32x4*)(row + 8 * lane + 512 * j);
        v[8 * j + 0] = bflo(w.x); v[8 * j + 1] = bfhi(w.x); v[8 * j + 2] = bflo(w.y); v[8 * j + 3] = bfhi(w.y);
        v[8 * j + 4] = bflo(w.z); v[8 * j + 5] = bfhi(w.z); v[8 * j + 6] = bflo(w.w); v[8 * j + 7] = bfhi(w.w); }
}
__device__ __forceinline__ void ln_row(float (&v)[16], const float* g, const float* b, int lane) {
    float s = 0.f;
#pragma unroll
    for (int i = 0; i < 16; ++i) s += v[i];
    const float mean = wave_sum(s) * (1.f / D); float q = 0.f;
#pragma unroll
    for (int i = 0; i < 16; ++i) { v[i] -= mean; q += v[i] * v[i]; }
    const float rstd = rsqrtf(wave_sum(q) * (1.f / D) + LN_EPS);
#pragma unroll
    for (int j = 0; j < 2; ++j) {
        const f32x4 g0 = *(const f32x4*)(g + 8 * lane + 512 * j), g1 = *(const f32x4*)(g + 8 * lane + 512 * j + 4);
        const f32x4 b0 = *(const f32x4*)(b + 8 * lane + 512 * j), b1 = *(const f32x4*)(b + 8 * lane + 512 * j + 4);
#pragma unroll
        for (int i = 0; i < 4; ++i) { v[8 * j + i] = v[8 * j + i] * rstd * g0[i] + b0[i]; v[8 * j + 4 + i] = v[8 * j + 4 + i] * rstd * g1[i] + b1[i]; }
    }
}
__device__ __forceinline__ void load_gb(const float* g, const float* b, int lane, float (&gr)[16], float (&br)[16]) {
#pragma unroll
    for (int j = 0; j < 2; ++j) {
        const f32x4 g0 = *(const f32x4*)(g + 8 * lane + 512 * j), g1 = *(const f32x4*)(g + 8 * lane + 512 * j + 4);
        const f32x4 b0 = *(const f32x4*)(b + 8 * lane + 512 * j), b1 = *(const f32x4*)(b + 8 * lane + 512 * j + 4);
#pragma unroll
        for (int i = 0; i < 4; ++i) { gr[8 * j + i] = g0[i]; gr[8 * j + 4 + i] = g1[i]; br[8 * j + i] = b0[i]; br[8 * j + 4 + i] = b1[i]; }
    }
}
__device__ __forceinline__ void ln_row_r(float (&v)[16], const float (&gr)[16], const float (&br)[16]) {
    float s = 0.f;
#pragma unroll
    for (int i = 0; i < 16; ++i) s += v[i];
    const float mean = wave_sum(s) * (1.f / D); float q = 0.f;
#pragma unroll
    for (int i = 0; i < 16; ++i) { v[i] -= mean; q += v[i] * v[i]; }
    const float rstd = rsqrtf(wave_sum(q) * (1.f / D) + LN_EPS);
#pragma unroll
    for (int i = 0; i < 16; ++i) v[i] = v[i] * rstd * gr[i] + br[i];
}
__device__ __forceinline__ void store_row_bf16(bf16_t* row, int lane, const float (&v)[16]) {
#pragma unroll
    for (int j = 0; j < 2; ++j) { u32x4 o; o.x = pk2(v[8 * j + 0], v[8 * j + 1]); o.y = pk2(v[8 * j + 2], v[8 * j + 3]); o.z = pk2(v[8 * j + 4], v[8 * j + 5]); o.w = pk2(v[8 * j + 6], v[8 * j + 7]);
        *(u32x4*)(row + 8 * lane + 512 * j) = o; }
}

__device__ __forceinline__ void phase_route(const Params& P, int layer, LAS unsigned char* lds, int bid, int nb, int cntoff) {
    const int tid = opaque_tid(), lane = tid & 63, wave = tid >> 6;
    LAS unsigned char* Bhi = lds; LAS unsigned char* Blo = lds + 32768;
    LAS float* cd = (LAS float*)(lds + 65536);
    LAS float* part = cd + 32;
    LAS int* lcnt = (LAS int*)(part + 1024);
    LAS int* lbase = lcnt + 32; LAS int* rcls = lbase + 32; LAS int* rpos = rcls + 256;
    const bf16_t* pre1 = (const bf16_t*)(P.out + OUT_PRE1);
    const float* g = P.in[I_LNMG] + layer * D; const float* b = P.in[I_LNMB] + layer * D;
    const float* Wr = P.in[I_WR]; const float* br = P.in[I_BR];
    int* tokcls = (int*)(P.ws + WS_TOKCLS); int* tokpos = (int*)(P.ws + WS_TOKPOS); float* tokgate = (float*)(P.ws + WS_TOKGATE);
    unsigned* gcnt = (unsigned*)(P.ws + WS_CTL) + CW_CNT + 64 * layer + cntoff;
#pragma unroll 1
    for (int idx = tid; idx < 2048; idx += NTHREADS_C) {
        const int s = idx >> 6, l = idx & 63, e = l & 15, k0 = 32 * s + 8 * (l >> 4);
        unsigned hi[4], lo[4];
#pragma unroll
        for (int j = 0; j < 4; ++j) {
            const float w0 = g[k0 + 2 * j] * Wr[(k0 + 2 * j) * 16 + e], w1 = g[k0 + 2 * j + 1] * Wr[(k0 + 2 * j + 1) * 16 + e];
            const unsigned h0 = f2bf(w0), h1 = f2bf(w1);
            hi[j] = h0 | (h1 << 16); lo[j] = pk2(w0 - bf2f((unsigned short)h0), w1 - bf2f((unsigned short)h1)); }
        *(LAS u32x4*)(Bhi + idx * 16) = (u32x4){hi[0], hi[1], hi[2], hi[3]};
        *(LAS u32x4*)(Blo + idx * 16) = (u32x4){lo[0], lo[1], lo[2], lo[3]};
    }
    { const int e = tid & 15, pt = tid >> 4; float cs = 0.f, ds = 0.f;
#pragma unroll 4
      for (int kk = 0; kk < 32; ++kk) { const int k = pt * 32 + kk; const float w = Wr[k * 16 + e]; cs += g[k] * w; ds += b[k] * w; }
      part[pt * 32 + e] = cs; part[pt * 32 + 16 + e] = ds; }
    __syncthreads();
    if (tid < 32) { float sacc = 0.f;
#pragma unroll 4
        for (int pt = 0; pt < 32; ++pt) sacc += part[pt * 32 + tid];
        cd[tid] = sacc; }
    __syncthreads();
    const int e = lane & 15, q = lane >> 4;
    const float ce = cd[e], de = cd[16 + e], bre = br[e];
    for (int r0 = bid * 256; r0 < T; r0 += nb * 256) {
        if (tid < 32) lcnt[tid] = 0;
        __syncthreads();
#pragma unroll 1
        for (int tile = 0; tile < 2; ++tile) {
            const int tr0 = wave * 32 + tile * 16;
            const bf16_t* arow = pre1 + (size_t)(r0 + tr0 + e) * D + 8 * q;
            f32x4 acc = (f32x4){0.f, 0.f, 0.f, 0.f}; float s1 = 0.f, s2 = 0.f;
#pragma unroll 1
            for (int s0 = 0; s0 < 32; s0 += 8) {
                u32x4 a[8];
#pragma unroll
                for (int u = 0; u < 8; ++u) a[u] = *(const u32x4*)(arow + 32 * (s0 + u));
#pragma unroll
                for (int u = 0; u < 8; ++u) {
                    const bf16x8 bh = *(const LAS bf16x8*)(Bhi + ((s0 + u) * 64 + lane) * 16), bl = *(const LAS bf16x8*)(Blo + ((s0 + u) * 64 + lane) * 16);
                    const bf16x8 af = __builtin_bit_cast(bf16x8, a[u]);
                    acc = __builtin_amdgcn_mfma_f32_16x16x32_bf16(af, bh, acc, 0, 0, 0);
                    acc = __builtin_amdgcn_mfma_f32_16x16x32_bf16(af, bl, acc, 0, 0, 0);
                    const float x0 = bflo(a[u].x), x1 = bfhi(a[u].x), x2 = bflo(a[u].y), x3 = bfhi(a[u].y), x4 = bflo(a[u].z), x5 = bfhi(a[u].z), x6 = bflo(a[u].w), x7 = bfhi(a[u].w);
                    s1 += ((x0 + x1) + (x2 + x3)) + ((x4 + x5) + (x6 + x7));
                    s2 += ((x0 * x0 + x1 * x1) + (x2 * x2 + x3 * x3)) + ((x4 * x4 + x5 * x5) + (x6 * x6 + x7 * x7));
                }
            }
            s1 += __shfl_xor(s1, 16); s1 += __shfl_xor(s1, 32); s2 += __shfl_xor(s2, 16); s2 += __shfl_xor(s2, 32);
            const float mean = s1 * (1.f / D); const float rstd = rsqrtf(fmaxf(s2 * (1.f / D) - mean * mean, 0.f) + LN_EPS);
#pragma unroll
            for (int r = 0; r < 4; ++r) {
                const int R = 4 * q + r;
                const float mr = __shfl(mean, R), rr = __shfl(rstd, R);
                const float lg = rr * (acc[r] - mr * ce) + de;
                float mx = lg;
#pragma unroll
                for (int o = 1; o < 16; o <<= 1) mx = fmaxf(mx, __shfl_xor(mx, o));
                float p = expf(lg - mx), sum = p;
#pragma unroll
                for (int o = 1; o < 16; o <<= 1) sum += __shfl_xor(sum, o);
                p = p / sum;
                const float sel = p + bre;
                int rank = 0;
#pragma unroll
                for (int o = 1; o < 4; ++o) { const float so = __shfl_xor(sel, o); const int eo = e ^ o; rank += (so > sel || (so == sel && eo < e)) ? 1 : 0; }
                float gs = rank < 2 ? sel : 0.f;
                gs += __shfl_xor(gs, 1); gs += __shfl_xor(gs, 2);
                int gi = e >> 2;
#pragma unroll
                for (int o = 4; o < 16; o <<= 1) { const float go = __shfl_xor(gs, o); const int io = __shfl_xor(gi, o); if (go > gs || (go == gs && io < gi)) { gs = go; gi = io; } }
                const bool chosen = ((e >> 2) == gi) && rank < 2;
                const unsigned long long bm = __ballot(chosen);
                const unsigned m4 = (unsigned)(bm >> (16 * q + 4 * gi)) & 0xFu;
                const int ea = __ffs((int)m4) - 1, eb = 31 - __clz((int)m4);
                const int pidx = ea == 0 ? eb - 1 : (ea == 1 ? eb + 1 : 5);
                const float pa = __shfl(p, 16 * q + 4 * gi + ea), pb = __shfl(p, 16 * q + 4 * gi + eb);
                if (e == r) { const int cls = gi * 6 + pidx; const int rl = tr0 + R; const int lp = atomicAdd((int*)&lcnt[cls], 1); rcls[rl] = cls; rpos[rl] = lp;
                    const float inv = 1.f / (pa + pb); const size_t t = (size_t)(r0 + rl); tokgate[t * 2] = pa * inv; tokgate[t * 2 + 1] = pb * inv; }
            }
        }
        __syncthreads();
        if (tid < NCLS) lbase[tid] = (int)atomicAdd(&gcnt[tid], (unsigned)lcnt[tid]);
        __syncthreads();
        if (tid < 256) { const int t = r0 + tid; const int c = rcls[tid]; tokcls[t] = c; tokpos[t] = lbase[c] + rpos[tid]; }
        __syncthreads();
    }
}
__device__ __forceinline__ void phase_permute(const Params& P, int layer, LAS unsigned char* lds, int bid, int nb) {
    const int tid = opaque_tid(), lane = tid & 63, wave = tid >> 6, nw = blockDim.x >> 6;
    LAS int* off = (LAS int*)lds;
    const unsigned* gcnt = (const unsigned*)(P.ws + WS_CTL) + CW_CNT + 64 * layer;
    int* tilecls = (int*)(P.ws + WS_TILECLS);
    if (tid == 0) { int o = 0; for (int c = 0; c < NCLS; ++c) { off[c] = o * 256; const int nt = ((int)gcnt[c] + 255) >> 8;
            if (bid == 0) for (int i = 0; i < nt; ++i) tilecls[8 + o + i] = c;
            o += nt; }
        if (bid == 0) tilecls[0] = o; }
    __syncthreads();
    const bf16_t* pre1 = (const bf16_t*)(P.out + OUT_PRE1); bf16_t* hs = (bf16_t*)(P.ws + WS_BIG + BIG_HS);
    const float* g = P.in[I_LNMG] + layer * D; const float* b = P.in[I_LNMB] + layer * D;
    const int* tokcls = (const int*)(P.ws + WS_TOKCLS); const int* tokpos = (const int*)(P.ws + WS_TOKPOS); int* tokdst = (int*)(P.ws + WS_TOKDST);
    const float* tokgate = (const float*)(P.ws + WS_TOKGATE); float* rowgate = (float*)(P.ws + WS_ROWGATE);
    float gr[16], br[16]; load_gb(g, b, lane, gr, br);
    for (int t0 = bid * nw + wave; t0 < T; t0 += 2 * nb * nw) {
        const int t1 = t0 + nb * nw; const bool has1 = t1 < T;
        float v0[16], v1[16];
        load_row_bf16(pre1 + (size_t)t0 * D, lane, v0);
        if (has1) load_row_bf16(pre1 + (size_t)t1 * D, lane, v1);
        const int dst0 = off[tokcls[t0]] + tokpos[t0]; const int dst1 = has1 ? off[tokcls[t1]] + tokpos[t1] : 0;
#pragma unroll
        for (int rr = 0; rr < 2; ++rr) {
            if (rr == 1 && !has1) break;
            float (&v)[16] = rr ? v1 : v0; const int t = rr ? t1 : t0, dst = rr ? dst1 : dst0;
            ln_row_r(v, gr, br);
            store_row_bf16(hs + (size_t)dst * D, lane, v);
            if (MOE_FP8(layer) && MOEA_FP8) { typedef unsigned u32x2 __attribute__((ext_vector_type(2)));
#pragma unroll
                for (int j = 0; j < 2; ++j) *(u32x2*)(P.ws + WS_BIG + BIG_HS8 + (size_t)dst * D + 8 * lane + 512 * j) = (u32x2){pk4_fp8(v[8 * j] * H8_SCALE, v[8 * j + 1] * H8_SCALE, v[8 * j + 2] * H8_SCALE, v[8 * j + 3] * H8_SCALE), pk4_fp8(v[8 * j + 4] * H8_SCALE, v[8 * j + 5] * H8_SCALE, v[8 * j + 6] * H8_SCALE, v[8 * j + 7] * H8_SCALE)}; }
            if (lane == 0) { tokdst[t] = dst; rowgate[(size_t)dst * 2] = tokgate[(size_t)t * 2]; rowgate[(size_t)dst * 2 + 1] = tokgate[(size_t)t * 2 + 1]; }
        }
    }
}
__device__ __forceinline__ void phase_lnffn(const Params& P, int layer, int bid, int nb) {
    const int tid = opaque_tid(), lane = tid & 63, wave = tid >> 6, nw = blockDim.x >> 6;
    const bf16_t* pre2 = (const bf16_t*)(P.ws + WS_BIG + BIG_PRE2);
    const float* g = P.in[I_LNFG] + layer * D; const float* b = P.in[I_LNFB] + layer * D;
    const int* tokdst = (const int*)(P.ws + WS_TOKDST);
    float gr[16], br[16]; load_gb(g, b, lane, gr, br);
    for (int t0 = bid * nw + wave; t0 < T; t0 += 2 * nb * nw) {
        const int t1 = t0 + nb * nw; const bool has1 = t1 < T;
        float v0[16], v1[16];
        load_row_bf16(pre2 + (size_t)tokdst[t0] * D, lane, v0);
        if (has1) load_row_bf16(pre2 + (size_t)tokdst[t1] * D, lane, v1);
#pragma unroll
        for (int rr = 0; rr < 2; ++rr) {
            if (rr == 1 && !has1) break;
            float (&v)[16] = rr ? v1 : v0; const int t = rr ? t1 : t0;
            ln_row_r(v, gr, br);
            if (layer == 0) { store_row_bf16((bf16_t*)(P.out + OUT_H) + (size_t)t * D, lane, v);
                typedef unsigned u32x2 __attribute__((ext_vector_type(2)));
#pragma unroll
                for (int j = 0; j < 2; ++j) *(u32x2*)(P.ws + WS_H8 + (size_t)t * D + 8 * lane + 512 * j) = (u32x2){pk4_fp8(v[8 * j] * H8_SCALE, v[8 * j + 1] * H8_SCALE, v[8 * j + 2] * H8_SCALE, v[8 * j + 3] * H8_SCALE), pk4_fp8(v[8 * j + 4] * H8_SCALE, v[8 * j + 5] * H8_SCALE, v[8 * j + 6] * H8_SCALE, v[8 * j + 7] * H8_SCALE)}; }
            else { float* o = (float*)P.out + (size_t)t * D;
#pragma unroll
                for (int j = 0; j < 2; ++j) { *(f32x4*)(o + 8 * lane + 512 * j) = (f32x4){v[8 * j], v[8 * j + 1], v[8 * j + 2], v[8 * j + 3]}; *(f32x4*)(o + 8 * lane + 512 * j + 4) = (f32x4){v[8 * j + 4], v[8 * j + 5], v[8 * j + 6], v[8 * j + 7]}; } }
        }
    }
}

enum { MIX_RET = 0, MIX_ML = 1, MIX_GLA = 2, MIX_SSD = 3 };
typedef short s16x4 __attribute__((ext_vector_type(4)));
__device__ __forceinline__ bf16x8 tr_frag(LAS unsigned char* p0, LAS unsigned char* p1) {
    const s16x4 a = __builtin_amdgcn_ds_read_tr16_b64_v4i16((LAS s16x4*)p0), b = __builtin_amdgcn_ds_read_tr16_b64_v4i16((LAS s16x4*)p1);
    return (bf16x8){a[0], a[1], a[2], a[3], b[0], b[1], b[2], b[3]};
}
__device__ __forceinline__ bf16x8 cat_frag(LAS unsigned char* p0, LAS unsigned char* p1) {
    const s16x4 a = *(LAS s16x4*)p0, b = *(LAS s16x4*)p1;
    return (bf16x8){a[0], a[1], a[2], a[3], b[0], b[1], b[2], b[3]};
}
__device__ __forceinline__ bf16x8 pack_acc(const f32x4& lo, const f32x4& hi) {
    u32x4 w; w.x = pg8::cvt_pk_bf16(lo[0], lo[1]); w.y = pg8::cvt_pk_bf16(lo[2], lo[3]); w.z = pg8::cvt_pk_bf16(hi[0], hi[1]); w.w = pg8::cvt_pk_bf16(hi[2], hi[3]);
    return __builtin_bit_cast(bf16x8, w);
}
__device__ __forceinline__ void unpack8(const u32x4& w, float (&v)[8]) {
    v[0] = bflo(w.x); v[1] = bfhi(w.x); v[2] = bflo(w.y); v[3] = bfhi(w.y); v[4] = bflo(w.z); v[5] = bfhi(w.z); v[6] = bflo(w.w); v[7] = bfhi(w.w);
}
__device__ __forceinline__ u32x4 pack8(const float (&v)[8]) {
    u32x4 w; w.x = pg8::cvt_pk_bf16(v[0], v[1]); w.y = pg8::cvt_pk_bf16(v[2], v[3]); w.z = pg8::cvt_pk_bf16(v[4], v[5]); w.w = pg8::cvt_pk_bf16(v[6], v[7]); return w;
}

template <int CTRL, int RM> __device__ __forceinline__ float dpp_take(float old, float v) { return __builtin_bit_cast(float, __builtin_amdgcn_update_dpp(__builtin_bit_cast(int, old), __builtin_bit_cast(int, v), CTRL, RM, 0xf, false)); }
__device__ __forceinline__ float wave_scan_add(float v) {
    v += dpp_take<0x111, 0xf>(0.f, v); v += dpp_take<0x112, 0xf>(0.f, v); v += dpp_take<0x114, 0xf>(0.f, v); v += dpp_take<0x118, 0xf>(0.f, v);
    v += dpp_take<0x142, 0xa>(0.f, v); v += dpp_take<0x143, 0xc>(0.f, v); return v; }
__device__ __forceinline__ float wave_scan_max(float v) {
    const float ni = -3.0e38f;
    v = fmaxf(v, dpp_take<0x111, 0xf>(ni, v)); v = fmaxf(v, dpp_take<0x112, 0xf>(ni, v)); v = fmaxf(v, dpp_take<0x114, 0xf>(ni, v)); v = fmaxf(v, dpp_take<0x118, 0xf>(ni, v));
    v = fmaxf(v, dpp_take<0x142, 0xa>(ni, v)); v = fmaxf(v, dpp_take<0x143, 0xc>(ni, v)); return v; }
__device__ __forceinline__ float fexp(float x) { return __builtin_amdgcn_exp2f(x * 1.4426950408889634f); }
__device__ __forceinline__ float frcp(float x) { return __builtin_amdgcn_rcpf(x); }
__device__ __forceinline__ float fsigmoid(float x) { return frcp(1.f + fexp(-x)); }
__device__ __forceinline__ float fsilu(float x) { return x * fsigmoid(x); }
__device__ __forceinline__ float fsoftplus(float x) {
    const float u = fexp(-fabsf(x));
    const float l = u < 0.01f ? u * (1.f - u * (0.5f - u * 0.33333333f)) : __builtin_amdgcn_logf(1.f + u) * 0.6931471805599453f;
    return fmaxf(x, 0.f) + l;
}
__device__ __forceinline__ float flogsigmoid(float x) { return -fsoftplus(-x); }

template <int NR>
__device__ __forceinline__ void conv_load(const bf16_t* src, const int trow0, u32x4 (&raw)[NR + 3]) {
#pragma unroll
    for (int i = 0; i < NR + 3; ++i) {
        const bool ok = (i >= 3) || (trow0 + i - 3 >= 0);
        const bf16_t* p = ok ? src + (ptrdiff_t)(i - 3) * NP : src;
        raw[i] = *(const u32x4*)p;
    }
}
template <int NR>
__device__ __forceinline__ void conv_compute(const u32x4 (&raw)[NR + 3], const int trow0, const LAS float* wl, const int ldw, float (&o)[NR][8]) {
    float x[NR + 3][8];
#pragma unroll
    for (int i = 0; i < NR + 3; ++i) {
        u32x4 xw = raw[i];
        if (i < 3) { const bool ok = trow0 + i - 3 >= 0; xw.x = ok ? xw.x : 0u; xw.y = ok ? xw.y : 0u; xw.z = ok ? xw.z : 0u; xw.w = ok ? xw.w : 0u; }
        unpack8(xw, x[i]);
    }
    float wv[5][8];
#pragma unroll
    for (int k = 0; k < 5; ++k) { const f32x4 w0 = *(const LAS f32x4*)(wl + k * ldw), w1 = *(const LAS f32x4*)(wl + k * ldw + 4);
#pragma unroll
        for (int j = 0; j < 4; ++j) { wv[k][j] = w0[j]; wv[k][4 + j] = w1[j]; } }
#pragma unroll
    for (int r = 0; r < NR; ++r)
#pragma unroll
        for (int j = 0; j < 8; ++j) { float a = wv[4][j];
#pragma unroll
            for (int k = 0; k < 4; ++k) a += wv[k][j] * x[r + k][j];
            o[r][j] = fsilu(a); }
}

__device__ __forceinline__ void ssd_prep(const Params& P, LAS unsigned char* lds, int bid, int nb) {
    const int tid = opaque_tid();
    bf16_t* proj = (bf16_t*)(P.ws + WS_BIG);
    LAS u32x4* halo = (LAS u32x4*)lds;
    const int c32 = tid & 31, r0 = (tid >> 5) * 4;
#pragma unroll 1
    for (int it = bid; it < 256; it += nb) {
        const int unit = it >> 1, half = it & 1, b = unit >> 2, g = unit & 3;
        int col, chn;
        if (half == 0) { col = C1_XS + g * 256 + 8 * c32; chn = g * 256 + 8 * c32; }
        else if (c32 < 16) { col = C1_BM + g * 128 + 8 * c32; chn = 1024 + g * 128 + 8 * c32; }
        else { col = C1_CM + g * 128 + 8 * (c32 - 16); chn = 1536 + g * 128 + 8 * (c32 - 16); }
        float wv[5][8];
#pragma unroll
        for (int k = 0; k < 5; ++k) { const float* wp = (k < 4 ? P.in[I_SSDCW] + k * 2048 : P.in[I_SSDCB]) + chn; const f32x4 w0 = *(const f32x4*)wp, w1 = *(const f32x4*)(wp + 4);
#pragma unroll
            for (int j = 0; j < 4; ++j) { wv[k][j] = w0[j]; wv[k][4 + j] = w1[j]; } }
        bf16_t* base = proj + (size_t)b * SEQ * NP + col;
        u32x4 cur[7];
#pragma unroll
        for (int i = 0; i < 7; ++i) { const int row = r0 - 3 + i; cur[i] = row >= 0 ? *(const u32x4*)(base + (size_t)row * NP) : (u32x4){0u, 0u, 0u, 0u}; }
#pragma unroll 1
        for (int ch = 0; ch < SEQ / 64; ++ch) {
            float x[7][8];
#pragma unroll
            for (int i = 0; i < 7; ++i) unpack8(cur[i], x[i]);
            const u32x4 h0 = cur[4], h1 = cur[5], h2 = cur[6];
            __syncthreads();
            if (r0 == 60) { halo[c32] = h0; halo[32 + c32] = h1; halo[64 + c32] = h2; }
            if (ch + 1 < SEQ / 64) {
#pragma unroll
                for (int i = 0; i < 7; ++i) if (r0 >= 4 || i >= 3) cur[i] = *(const u32x4*)(base + (size_t)(64 * (ch + 1) + r0 - 3 + i) * NP);
            }
#pragma unroll
            for (int r = 0; r < 4; ++r) { float o[8];
#pragma unroll
                for (int j = 0; j < 8; ++j) { float a = wv[4][j];
#pragma unroll
                    for (int k = 0; k < 4; ++k) a += wv[k][j] * x[r + k][j];
                    o[j] = fsilu(a); }
                *(u32x4*)(base + (size_t)(64 * ch + r0 + r) * NP) = pack8(o); }
            __syncthreads();
            if (r0 == 0 && ch + 1 < SEQ / 64) { cur[0] = halo[c32]; cur[1] = halo[32 + c32]; cur[2] = halo[64 + c32]; }
        }
        __syncthreads();
    }
}

template <int MIX>
__device__ __forceinline__ void mixer_unit(const Params& P, const int b, const int h, LAS unsigned char* lds, const bool dostore) {
    const int tid0 = opaque_tid(), w = __builtin_amdgcn_readfirstlane(tid0 >> 6);
    typedef unsigned u32x2 __attribute__((ext_vector_type(2)));
    constexpr int RSQ = 288, RSV = 544, RSP = 144;
    constexpr int SZQ = 64 * RSQ, SZV = 64 * RSV, SZP = 64 * RSP;
    constexpr int OQ = 0, OK1 = SZQ, OV = 2 * SZQ, O3 = 2 * SZQ + SZV;
    constexpr int OK2 = (MIX == MIX_ML || MIX == MIX_GLA) ? O3 : OK1;
    constexpr int OV2 = (MIX == MIX_SSD) ? O3 : OV;
    constexpr int OP = MIX == MIX_RET ? O3 : (MIX == MIX_SSD ? O3 + SZV : O3 + SZQ);
    constexpr int NPV = MIX == MIX_SSD ? 4 : 1;
    constexpr int OT = OP + NPV * SZP;
    constexpr int OY = OV2;
    LAS float* tab = (LAS float*)(lds + OT);
    constexpr int TGN = MIX == MIX_GLA ? 8832 : MIX == MIX_ML ? 648 : MIX == MIX_SSD ? 512 : 0;
    constexpr int TCW = MIX == MIX_ML ? 904 : 768;
    static_assert(OT + (MIX == MIX_GLA ? 11776 : MIX == MIX_SSD ? 3328 : 2184) * 4 <= 163840 - 1024, "lds map");
    bf16_t* proj = (bf16_t*)(P.ws + WS_BIG);
    const size_t row0b = (size_t)b * SEQ;
    constexpr int GIDX = MIX == MIX_RET ? I_RETG : MIX == MIX_ML ? I_MLG : MIX == MIX_GLA ? I_GLAG : I_SSDG;
    if (tid0 < 256) tab[TGN + tid0] = P.in[GIDX][h * 256 + tid0];
    if constexpr (MIX == MIX_ML) {
        for (int i = tid0; i < 1280; i += NTHREADS_C) { const int k = i >> 8, j = i & 255; const int chn = (j >> 7) * 512 + h * 128 + (j & 127);
            tab[TCW + i] = k < 4 ? P.in[I_MLCW][k * 1024 + chn] : P.in[I_MLCB][chn]; }
        if (tid0 < 128) tab[512 + tid0] = 0.f; if (tid0 == 0) tab[641] = 0.f;
    }
    if constexpr (MIX == MIX_GLA) {
        for (int i = tid0; i < 2048; i += NTHREADS_C) tab[9088 + i] = P.in[I_GLAWA][(i >> 7) * 512 + h * 128 + (i & 127)];
        if (tid0 < 128) tab[9088 + 2048 + tid0] = P.in[I_GLABA][h * 128 + tid0];
    }
    __syncthreads();
    f32x4 Sacc[8][2];
#pragma unroll
    for (int rt = 0; rt < 8; ++rt)
#pragma unroll
        for (int ct = 0; ct < 2; ++ct) Sacc[rt][ct] = (f32x4){0.f, 0.f, 0.f, 0.f};
    float gam = 1.f, lg2gam = 0.f, g63 = 1.f;
    float rinv[4] = {0.f, 0.f, 0.f, 0.f};
    if constexpr (MIX == MIX_RET) { gam = 1.f - __builtin_amdgcn_exp2f(-5.f - (float)h); lg2gam = __builtin_amdgcn_logf(gam); g63 = __builtin_amdgcn_exp2f(63.f * lg2gam);
#pragma unroll
        for (int i2 = 0; i2 < 4; ++i2) rinv[i2] = __builtin_amdgcn_exp2f(-(float)(2 * (4 * (tid0 & 15) + i2)) * (13.287712379549449f / 128.f)) * 0.15915494309189535f; }

    float gpA = 0.f, gpB = 0.f, gpC = 0.f;
    if constexpr (MIX == MIX_ML) { gpA = P.in[I_MLBI][h]; gpB = P.in[I_MLBF][h]; }
    if constexpr (MIX == MIX_SSD) { const int hd = 4 * h + (w & 3); gpA = P.in[I_SSDDTB][hd]; gpB = -fexp(P.in[I_SSDALOG][hd]); gpC = P.in[I_SSDD][4 * h + ((tid0 & 7) >> 1)]; }
    gpA = __builtin_bit_cast(float, __builtin_amdgcn_readfirstlane(__builtin_bit_cast(int, gpA))); gpB = __builtin_bit_cast(float, __builtin_amdgcn_readfirstlane(__builtin_bit_cast(int, gpB)));
    tp_begin(lds, 100 * MIX + 9);
    unsigned short gpre0 = 0, gpre1 = 0;
    if constexpr (MIX == MIX_ML) { if (w == 0) { const bf16_t* rp = proj + (row0b + (tid0 & 63)) * NP; gpre0 = rp[C0_MI + h]; gpre1 = rp[C0_MF + h]; } }
    if constexpr (MIX == MIX_SSD) { if (w < 4) gpre0 = proj[(row0b + (tid0 & 63)) * NP + C1_DT + 4 * h + w]; }
#pragma unroll 1
    for (int ch = 0; ch < SEQ / 64; ++ch) {
        int tid = tid0; asm volatile("" : "+v"(tid));
        const int lane = tid & 63, c = lane & 15, g = lane >> 4, q4 = (lane >> 2) & 3, p4 = lane & 3;
        const size_t row0 = row0b + (size_t)ch * 64;
        tp_begin(lds, 100 * MIX + 1);
        if constexpr (MIX == MIX_RET) {
            const int* pos = (const int*)P.in[I_POS];
            u32x4 qw2[2], kw2[2], vw[4]; int psi[2];
#pragma unroll
            for (int i = 0; i < 2; ++i) { const int pi = tid + 512 * i, r = pi >> 4, c8 = pi & 15;
                const bf16_t* rp = proj + (row0 + r) * NP + h * 128 + 8 * c8;
                qw2[i] = *(const u32x4*)(rp + C0_RQ); kw2[i] = *(const u32x4*)(rp + C0_RK); psi[i] = pos[row0 + r]; }
#pragma unroll
            for (int i = 0; i < 4; ++i) { const int pi = tid + 512 * i, r = pi >> 5, c8 = pi & 31; vw[i] = *(const u32x4*)(proj + (row0 + r) * NP + C0_RV + h * 256 + 8 * c8); }
            __builtin_amdgcn_sched_barrier(0);
#pragma unroll
            for (int i = 0; i < 2; ++i) {
                const int pi = tid + 512 * i, r = pi >> 4, c8 = pi & 15;
                float qv[8], kv[8]; unpack8(qw2[i], qv); unpack8(kw2[i], kv);
                const float ps = (float)psi[i];
                const float fq = __builtin_amdgcn_exp2f((float)r * lg2gam), fk = 0.08838834764831845f * __builtin_amdgcn_exp2f(-(float)r * lg2gam);
#pragma unroll
                for (int i2 = 0; i2 < 4; ++i2) {
                    const float tr = __builtin_amdgcn_fractf(ps * rinv[i2]);
                    const float sn = __builtin_amdgcn_sinf(tr), cs = __builtin_amdgcn_cosf(tr);
                    const float q0 = qv[2 * i2], q1 = qv[2 * i2 + 1], k0 = kv[2 * i2], k1 = kv[2 * i2 + 1];
                    qv[2 * i2] = (q0 * cs - q1 * sn) * fq; qv[2 * i2 + 1] = (q0 * sn + q1 * cs) * fq;
                    kv[2 * i2] = (k0 * cs - k1 * sn) * fk; kv[2 * i2 + 1] = (k0 * sn + k1 * cs) * fk;
                }
                *(LAS u32x4*)(lds + OQ + RSQ * r + 16 * c8) = pack8(qv);
                *(LAS u32x4*)(lds + OK1 + RSQ * r + 16 * c8) = pack8(kv);
            }
#pragma unroll
            for (int i = 0; i < 4; ++i) { const int pi = tid + 512 * i, r = pi >> 5, c8 = pi & 31; *(LAS u32x4*)(lds + OV + RSV * r + 16 * c8) = vw[i]; }
        }
        if constexpr (MIX == MIX_GLA) {
            u32x4 gaw = (u32x4){0u, 0u, 0u, 0u}, qw2[2], kw2[2], vw[4];
            if (tid < 128) gaw = *(const u32x4*)(proj + (row0 + (tid >> 1)) * NP + C1_GA + 8 * (tid & 1));
#pragma unroll
            for (int i = 0; i < 2; ++i) { const int pi = tid + 512 * i, r = pi >> 4, c8 = pi & 15; const bf16_t* rp = proj + (row0 + r) * NP + h * 128 + 8 * c8;
                qw2[i] = *(const u32x4*)(rp + C1_GQ); kw2[i] = *(const u32x4*)(rp + C1_GK); }
#pragma unroll
            for (int i = 0; i < 4; ++i) { const int pi = tid + 512 * i, r = pi >> 5, c8 = pi & 31; vw[i] = *(const u32x4*)(proj + (row0 + r) * NP + C1_GV + h * 256 + 8 * c8); }
            __builtin_amdgcn_sched_barrier(0);
            if (tid < 128) *(LAS u32x4*)(tab + 11264 + 4 * tid) = gaw;
            __syncthreads();
            {
                const int d = tid & 127, tq = tid >> 7;
                const float ba = tab[9088 + 2048 + d];
                float wv[16];
#pragma unroll
                for (int r = 0; r < 16; ++r) wv[r] = tab[9088 + r * 128 + d];
                float run = 0.f;
#pragma unroll 4
                for (int i = 0; i < 16; ++i) {
                    const int t = 16 * tq + i;
                    const u32x4 g0 = *(LAS u32x4*)(tab + 11264 + 8 * t), g1 = *(LAS u32x4*)(tab + 11264 + 8 * t + 4); float gv[8], gv2[8]; unpack8(g0, gv); unpack8(g1, gv2);
                    float a = ba;
#pragma unroll
                    for (int r = 0; r < 8; ++r) a += gv[r] * wv[r] + gv2[r] * wv[8 + r];
                    run += flogsigmoid(a) * (1.f / 16.f);
                    tab[t * 128 + d] = run;
                }
                tab[8192 + tq * 128 + d] = run;
            }
            __syncthreads();
            if (tid < 128) tab[8704 + tid] = fexp((tab[8192 + tid] + tab[8192 + 128 + tid]) + (tab[8192 + 256 + tid] + tab[8192 + 384 + tid]));
            __syncthreads();
#pragma unroll
            for (int i = 0; i < 2; ++i) {
                const int pi = tid + 512 * i, r = pi >> 4, c8 = pi & 15, tq = r >> 4;
                float qv[8], kv[8], k2[8]; unpack8(qw2[i], qv); unpack8(kw2[i], kv);
#pragma unroll
                for (int hh = 0; hh < 2; ++hh) {
                    const int d0 = 8 * c8 + 4 * hh;
                    f32x4 bc = *(LAS f32x4*)(tab + r * 128 + d0);
                    const f32x4 t0 = *(LAS f32x4*)(tab + 8192 + d0), t1 = *(LAS f32x4*)(tab + 8192 + 128 + d0), t2 = *(LAS f32x4*)(tab + 8192 + 256 + d0), t3 = *(LAS f32x4*)(tab + 8192 + 384 + d0);
                    if (tq > 0) bc = bc + t0; if (tq > 1) bc = bc + t1; if (tq > 2) bc = bc + t2;
                    const f32x4 bt = (t0 + t1) + (t2 + t3);
                    const f32x4 dcv = *(LAS f32x4*)(tab + 8704 + d0);
#pragma unroll
                    for (int j = 0; j < 4; ++j) { const float e1 = fexp(bc[j]), e2 = frcp(e1), kk = kv[4 * hh + j] * e2;
                        qv[4 * hh + j] = qv[4 * hh + j] * 0.08838834764831845f * e1; kv[4 * hh + j] = kk; k2[4 * hh + j] = kk * dcv[j]; }
                }
                *(LAS u32x4*)(lds + OQ + RSQ * r + 16 * c8) = pack8(qv);
                *(LAS u32x4*)(lds + OK1 + RSQ * r + 16 * c8) = pack8(kv);
                *(LAS u32x4*)(lds + OK2 + RSQ * r + 16 * c8) = pack8(k2);
            }
#pragma unroll
            for (int i = 0; i < 4; ++i) { const int pi = tid + 512 * i, r = pi >> 5, c8 = pi & 31; *(LAS u32x4*)(lds + OV + RSV * r + 16 * c8) = vw[i]; }
        }
        if constexpr (MIX == MIX_ML) {
            const int c16 = tid & 31, r0 = (tid >> 5) * 4, isk = c16 >> 4, c8c = c16 & 15;
            u32x4 vw[4], raw[7];
#pragma unroll
            for (int i = 0; i < 4; ++i) { const int pi = tid + 512 * i, r = pi >> 5, c8 = pi & 31; vw[i] = *(const u32x4*)(proj + (row0 + r) * NP + C0_MV + h * 256 + 8 * c8); }
            conv_load<4>(proj + (row0 + r0) * NP + (isk ? C0_MK : C0_MQ) + h * 128 + 8 * c8c, ch * 64 + r0, raw);
            __builtin_amdgcn_sched_barrier(0);
            if (w == 0) {
                const float ip = bf2f(gpre0) + gpA, lf = flogsigmoid(bf2f(gpre1) + gpB);
                const float bc = wave_scan_add(lf);
                const float u = ip - bc; const float pm = wave_scan_max(u);
                const float mst = tab[641];
                const float M = fmaxf(mst, pm), M63 = __shfl(M, 63), bt = __shfl(bc, 63);
                tab[lane] = u; tab[64 + lane] = M; tab[128 + lane] = fexp(u - M63); tab[192 + lane] = fexp(mst - M); tab[256 + lane] = fexp(-bc - M);
                if (lane == 0) { tab[640] = fexp(mst - M63); tab[642] = bt + M63; }
            }
#pragma unroll
            for (int i = 0; i < 4; ++i) { const int pi = tid + 512 * i, r = pi >> 5, c8 = pi & 31; *(LAS u32x4*)(lds + OV + RSV * r + 16 * c8) = vw[i]; }
            {
                float o[4][8];
                conv_compute<4>(raw, ch * 64 + r0, tab + TCW + 8 * c16, 256, o);
#pragma unroll
                for (int r = 0; r < 4; ++r) {
                    if (isk) {
#pragma unroll
                        for (int j = 0; j < 8; ++j) o[r][j] *= 0.08838834764831845f; }
                    *(LAS u32x4*)(lds + (isk ? OK1 : OQ) + RSQ * (r0 + r) + 16 * c8c) = pack8(o[r]); }
            }
            __syncthreads();
            tp_end(lds, 100 * MIX + 1); tp_begin(lds, 100 * MIX + 6);
#pragma unroll
            for (int i = 0; i < 2; ++i) {
                const int pi = tid + 512 * i, r = pi >> 4, c8 = pi & 15;
                const u32x4 kw = *(LAS u32x4*)(lds + OK1 + RSQ * r + 16 * c8); float kv[8]; unpack8(kw, kv); const float es = tab[128 + r];
#pragma unroll
                for (int j = 0; j < 8; ++j) kv[j] *= es;
                *(LAS u32x4*)(lds + OK2 + RSQ * r + 16 * c8) = pack8(kv);
            }
            {
                const int t = tid >> 3, part = tid & 7; float a = 0.f;
#pragma unroll
                for (int i = 0; i < 2; ++i) { const u32x4 qw = *(LAS u32x4*)(lds + OQ + RSQ * t + 2 * (16 * part + 8 * i)); float qv[8]; unpack8(qw, qv);
                    const f32x4 n0 = *(LAS f32x4*)(tab + 512 + 16 * part + 8 * i), n1 = *(LAS f32x4*)(tab + 512 + 16 * part + 8 * i + 4);
#pragma unroll
                    for (int j = 0; j < 4; ++j) a += qv[j] * n0[j] + qv[4 + j] * n1[j]; }
                a += __shfl_xor(a, 1); a += __shfl_xor(a, 2); a += __shfl_xor(a, 4);
                if (part == 0) tab[448 + t] = a;
            }
        }
        if constexpr (MIX == MIX_SSD) {
            if (w < 4) {
                const float dt = fsoftplus(bf2f(gpre0) + gpA);
                const float cm = wave_scan_add(dt * gpB);
                tab[lane * 4 + w] = cm; tab[256 + lane * 4 + w] = dt;
            }
            {
                const int c32 = tid & 31, r0 = (tid >> 5) * 4, isc = c32 >> 4, c8 = c32 & 15, hr = c32 >> 3;
                u32x4 bcw[4], xw[4];
#pragma unroll
                for (int r = 0; r < 4; ++r) { bcw[r] = *(const u32x4*)(proj + (row0 + r0 + r) * NP + (isc ? C1_CM : C1_BM) + h * 128 + 8 * c8); xw[r] = *(const u32x4*)(proj + (row0 + r0 + r) * NP + C1_XS + h * 256 + 8 * c32); }
                float ox[4][8];
#pragma unroll
                for (int r = 0; r < 4; ++r) { *(LAS u32x4*)(lds + (isc ? OQ : OK1) + RSQ * (r0 + r) + 16 * c8) = bcw[r]; unpack8(xw[r], ox[r]); }
                __syncthreads();
                tp_end(lds, 100 * MIX + 1); tp_begin(lds, 100 * MIX + 6);
                const float last = tab[63 * 4 + hr];
#pragma unroll
                for (int r = 0; r < 4; ++r) { const float dt = tab[256 + (r0 + r) * 4 + hr], e2 = fexp(last - tab[(r0 + r) * 4 + hr]); float o2[8];
#pragma unroll
                    for (int j = 0; j < 8; ++j) { ox[r][j] *= dt; o2[j] = ox[r][j] * e2; }
                    *(LAS u32x4*)(lds + OV + RSV * (r0 + r) + 16 * c32) = pack8(ox[r]);
                    *(LAS u32x4*)(lds + OV2 + RSV * (r0 + r) + 16 * c32) = pack8(o2); }
            }
        }
        __syncthreads();
        tp_end(lds, (MIX == MIX_ML || MIX == MIX_SSD) ? 100 * MIX + 6 : 100 * MIX + 1); tp_begin(lds, 100 * MIX + 2);
        if (ch + 1 < SEQ / 64) {
            const int sl = tid & 15;
            int col = -1;
            if constexpr (MIX == MIX_RET) col = sl < 2 ? C0_RQ + h * 128 + 64 * sl : sl < 4 ? C0_RK + h * 128 + 64 * (sl - 2) : sl < 8 ? C0_RV + h * 256 + 64 * (sl - 4) : sl < 12 ? C0_RG + h * 256 + 64 * (sl - 8) : -1;
            if constexpr (MIX == MIX_ML) col = sl < 2 ? C0_MQ + h * 128 + 64 * sl : sl < 4 ? C0_MK + h * 128 + 64 * (sl - 2) : sl < 8 ? C0_MV + h * 256 + 64 * (sl - 4) : sl < 12 ? C0_MO + h * 256 + 64 * (sl - 8) : sl == 12 ? C0_MI : -1;
            if constexpr (MIX == MIX_GLA) col = sl < 2 ? C1_GQ + h * 128 + 64 * sl : sl < 4 ? C1_GK + h * 128 + 64 * (sl - 2) : sl < 8 ? C1_GV + h * 256 + 64 * (sl - 4) : sl < 12 ? C1_GR + h * 256 + 64 * (sl - 8) : sl == 12 ? C1_GA : -1;
            if constexpr (MIX == MIX_SSD) col = sl < 4 ? C1_XS + h * 256 + 64 * sl : sl < 6 ? C1_BM + h * 128 + 64 * (sl - 4) : sl < 8 ? C1_CM + h * 128 + 64 * (sl - 6) : sl < 12 ? C1_SZ + h * 256 + 64 * (sl - 8) : sl == 12 ? C1_DT : -1;
            if (col >= 0) { const bf16_t* nbp = proj + (row0 + 64 + (tid >> 4)) * NP + col;
                const unsigned pfl = 157696u + (unsigned)w * 512u;
                asm volatile("s_mov_b32 m0, %2\n\ts_nop 0\n\tglobal_load_lds_dword %0, off\n\ts_mov_b32 m0, %3\n\ts_nop 0\n\tglobal_load_lds_dword %1, off"
                             :: "v"(nbp), "v"(nbp + (size_t)32 * NP), "s"(pfl), "s"(pfl + 256u) : "memory", "m0"); }
        }
        {
            const int tt = w >> 1; float rsum = 0.f;
#pragma unroll
            for (int si = 0; si < 2; ++si) {
                const int ss = 2 * (w & 1) + si;
                f32x4 acc = (f32x4){0.f, 0.f, 0.f, 0.f};
#pragma unroll
                for (int ks = 0; ks < 4; ++ks) {
                    const bf16x8 a = *(LAS bf16x8*)(lds + OK1 + RSQ * (16 * ss + c) + 2 * (32 * ks + 8 * g));
                    const bf16x8 bq = *(LAS bf16x8*)(lds + OQ + RSQ * (16 * tt + c) + 2 * (32 * ks + 8 * g));
                    acc = __builtin_amdgcn_mfma_f32_16x16x32_bf16(a, bq, acc, 0, 0, 0);
                }
                const int t = 16 * tt + c, s0 = 16 * ss + 4 * g;
                if constexpr (MIX == MIX_SSD) {
                    const f32x4 ct_ = *(LAS f32x4*)(tab + t * 4);
                    f32x4 cs_[4];
#pragma unroll
                    for (int r = 0; r < 4; ++r) cs_[r] = *(LAS f32x4*)(tab + (s0 + r) * 4);
#pragma unroll
                    for (int hr = 0; hr < 4; ++hr) { float pv[4];
#pragma unroll
                        for (int r = 0; r < 4; ++r) { const float e = fexp(ct_[hr] - cs_[r][hr]); pv[r] = (s0 + r <= t) ? acc[r] * e : 0.f; }
                        *(LAS u32x2*)(lds + OP + hr * SZP + RSP * t + 2 * s0) = (u32x2){pg8::cvt_pk_bf16(pv[0], pv[1]), pg8::cvt_pk_bf16(pv[2], pv[3])}; }
                } else {
                    float pv[4];
                    if constexpr (MIX == MIX_ML) { const f32x4 us = *(LAS f32x4*)(tab + s0); const float Mt = tab[64 + t];
#pragma unroll
                        for (int r = 0; r < 4; ++r) { pv[r] = (s0 + r <= t) ? acc[r] * fexp(us[r] - Mt) : 0.f; rsum += pv[r]; } }
                    else {
#pragma unroll
                        for (int r = 0; r < 4; ++r) pv[r] = (s0 + r <= t) ? acc[r] : 0.f; }
                    *(LAS u32x2*)(lds + OP + RSP * t + 2 * s0) = (u32x2){pg8::cvt_pk_bf16(pv[0], pv[1]), pg8::cvt_pk_bf16(pv[2], pv[3])};
                }
            }
            if constexpr (MIX == MIX_ML) { rsum += __shfl_xor(rsum, 16); rsum += __shfl_xor(rsum, 32); if (g == 0) tab[320 + (w & 1) * 64 + 16 * tt + c] = rsum; }
        }
        __syncthreads();
        tp_end(lds, 100 * MIX + 2); tp_begin(lds, 100 * MIX + 3);
        f32x4 Yacc[2][4];
#pragma unroll
        for (int ct = 0; ct < 2; ++ct)
#pragma unroll
            for (int tt = 0; tt < 4; ++tt) Yacc[ct][tt] = (f32x4){0.f, 0.f, 0.f, 0.f};
#pragma unroll
        for (int kd = 0; kd < 4; ++kd) {
            bf16x8 qf[4];
#pragma unroll
            for (int tt = 0; tt < 4; ++tt) { LAS unsigned char* qp = lds + OQ + RSQ * (16 * tt + c) + 2 * (32 * kd + 4 * g); qf[tt] = cat_frag(qp, qp + 32); }
#pragma unroll
            for (int ct = 0; ct < 2; ++ct) { const bf16x8 sf = pack_acc(Sacc[2 * kd][ct], Sacc[2 * kd + 1][ct]);
#pragma unroll
                for (int tt = 0; tt < 4; ++tt) Yacc[ct][tt] = __builtin_amdgcn_mfma_f32_16x16x32_bf16(sf, qf[tt], Yacc[ct][tt], 0, 0, 0); }
        }
        if constexpr (MIX != MIX_GLA) {
#pragma unroll
            for (int tt = 0; tt < 4; ++tt) {
                float rs = gam;
                if constexpr (MIX == MIX_ML) rs = tab[192 + 16 * tt + c];
                if constexpr (MIX == MIX_SSD) rs = fexp(tab[(16 * tt + c) * 4 + (w >> 1)]);
#pragma unroll
                for (int ct = 0; ct < 2; ++ct) Yacc[ct][tt] = Yacc[ct][tt] * rs;
            }
        }
        bf16x8 Vf[2][2];
#pragma unroll
        for (int ks = 0; ks < 2; ++ks)
#pragma unroll
            for (int ct = 0; ct < 2; ++ct) { LAS unsigned char* vp = lds + OV + RSV * (32 * ks + 8 * g + q4) + 2 * (32 * w + 16 * ct) + 8 * p4; Vf[ks][ct] = tr_frag(vp, vp + 4 * RSV); }
#pragma unroll
        for (int ks = 0; ks < 2; ++ks)
#pragma unroll
            for (int tt = 0; tt < 4; ++tt) { const bf16x8 pf = *(LAS bf16x8*)(lds + OP + (MIX == MIX_SSD ? (w >> 1) * SZP : 0) + RSP * (16 * tt + c) + 2 * (32 * ks + 8 * g));
#pragma unroll
                for (int ct = 0; ct < 2; ++ct) Yacc[ct][tt] = __builtin_amdgcn_mfma_f32_16x16x32_bf16(Vf[ks][ct], pf, Yacc[ct][tt], 0, 0, 0); }
        if constexpr (MIX == MIX_GLA) {
#pragma unroll
            for (int rt = 0; rt < 8; ++rt) { const f32x4 dc = *(LAS f32x4*)(tab + 8704 + 16 * rt + 4 * g);
#pragma unroll
                for (int ct = 0; ct < 2; ++ct) Sacc[rt][ct] = Sacc[rt][ct] * dc; }
        } else {
            float dc = gam;
            if constexpr (MIX == MIX_ML) dc = tab[640];
            if constexpr (MIX == MIX_SSD) dc = fexp(tab[63 * 4 + (w >> 1)]);
#pragma unroll
            for (int rt = 0; rt < 8; ++rt)
#pragma unroll
                for (int ct = 0; ct < 2; ++ct) Sacc[rt][ct] = Sacc[rt][ct] * dc;
        }
        if constexpr (MIX == MIX_SSD) {
#pragma unroll
            for (int ks = 0; ks < 2; ++ks)
#pragma unroll
                for (int ct = 0; ct < 2; ++ct) { LAS unsigned char* vp = lds + OV2 + RSV * (32 * ks + 8 * g + q4) + 2 * (32 * w + 16 * ct) + 8 * p4; Vf[ks][ct] = tr_frag(vp, vp + 4 * RSV); }
        }
#pragma unroll
        for (int rt = 0; rt < 8; ++rt)
#pragma unroll
            for (int ks = 0; ks < 2; ++ks) { LAS unsigned char* kp = lds + OK2 + RSQ * (32 * ks + 8 * g + q4) + 2 * (16 * rt) + 8 * p4; const bf16x8 kf = tr_frag(kp, kp + 4 * RSQ);
#pragma unroll
                for (int ct = 0; ct < 2; ++ct) Sacc[rt][ct] = __builtin_amdgcn_mfma_f32_16x16x32_bf16(kf, Vf[ks][ct], Sacc[rt][ct], 0, 0, 0); }
        if constexpr (MIX == MIX_RET) {
#pragma unroll
            for (int rt = 0; rt < 8; ++rt)
#pragma unroll
                for (int ct = 0; ct < 2; ++ct) Sacc[rt][ct] = Sacc[rt][ct] * g63;
        }
        if constexpr (MIX == MIX_ML) {
            if (tid < 128) { float a = 0.f;
#pragma unroll 8
                for (int s = 0; s < 64; ++s) a += bf2f(*(LAS unsigned short*)(lds + OK2 + RSQ * s + 2 * tid));
                tab[512 + tid] = tab[640] * tab[512 + tid] + a; }
        }
        __syncthreads();
        tp_end(lds, 100 * MIX + 3); tp_begin(lds, 100 * MIX + 4);
        constexpr int GCOL = MIX == MIX_RET ? C0_RG : MIX == MIX_ML ? C0_MO : MIX == MIX_GLA ? C1_GR : C1_SZ;
        constexpr int OCOL = MIX == MIX_RET ? C0_RV : MIX == MIX_ML ? C0_MV : MIX == MIX_GLA ? C1_GV : C1_SZ;
        bf16_t* const erp = proj + (row0 + (tid >> 3)) * NP + h * 256 + 32 * (tid & 7);
        u32x4 gw[4];
#pragma unroll
        for (int i = 0; i < 4; ++i) gw[i] = *(const u32x4*)(erp + GCOL + 8 * i);
        __builtin_amdgcn_sched_barrier(0);
#pragma unroll
        for (int ct = 0; ct < 2; ++ct)
#pragma unroll
            for (int tt = 0; tt < 4; ++tt)
                *(LAS u32x2*)(lds + OY + RSV * (16 * tt + c) + 2 * (32 * w + 16 * ct + 4 * g)) = (u32x2){pg8::cvt_pk_bf16(Yacc[ct][tt][0], Yacc[ct][tt][1]), pg8::cvt_pk_bf16(Yacc[ct][tt][2], Yacc[ct][tt][3])};
        __syncthreads();
        tp_end(lds, 100 * MIX + 4); tp_begin(lds, 100 * MIX + 5);
        {
            const int t = tid >> 3, part = tid & 7;
            float y[32];
#pragma unroll
            for (int i = 0; i < 4; ++i) { const u32x4 yw = *(LAS u32x4*)(lds + OY + RSV * t + 2 * (32 * part + 8 * i)); float t8[8]; unpack8(yw, t8);
#pragma unroll
                for (int j = 0; j < 8; ++j) y[8 * i + j] = t8[j]; }
            bf16_t* const rp = erp;
            if constexpr (MIX == MIX_ML) {
                const float den = (tab[320 + t] + tab[384 + t]) + tab[192 + t] * tab[448 + t];
                const float idn = frcp(fmaxf(fabsf(den), tab[256 + t]));
#pragma unroll
                for (int i = 0; i < 4; ++i) { float gt[8]; unpack8(gw[i], gt);
#pragma unroll
                    for (int j = 0; j < 8; ++j) y[8 * i + j] = y[8 * i + j] * idn * fsigmoid(gt[j]); }
            }
            if constexpr (MIX == MIX_SSD) {
                const float dsk = gpC * frcp(tab[256 + t * 4 + (part >> 1)]);
#pragma unroll
                for (int i = 0; i < 4; ++i) { const u32x4 xw = *(LAS u32x4*)(lds + OV + RSV * t + 2 * (32 * part + 8 * i)); float t8[8], gt[8]; unpack8(xw, t8); unpack8(gw[i], gt);
#pragma unroll
                    for (int j = 0; j < 8; ++j) y[8 * i + j] = (y[8 * i + j] + dsk * t8[j]) * fsilu(gt[j]); }
            }
            float mean = 0.f;
            if constexpr (MIX == MIX_RET || MIX == MIX_ML) {
                float s1 = 0.f;
#pragma unroll
                for (int j = 0; j < 32; ++j) s1 += y[j];
                s1 += __shfl_xor(s1, 1); s1 += __shfl_xor(s1, 2); s1 += __shfl_xor(s1, 4);
                mean = s1 * (1.f / 256.f);
            }
            float s2 = 0.f;
#pragma unroll
            for (int j = 0; j < 32; ++j) { y[j] -= mean; s2 += y[j] * y[j]; }
            s2 += __shfl_xor(s2, 1); s2 += __shfl_xor(s2, 2); s2 += __shfl_xor(s2, 4);
            const float rstd = __builtin_amdgcn_rsqf(s2 * (1.f / 256.f) + NORM_EPS);
#pragma unroll
            for (int i = 0; i < 4; ++i) {
                const f32x4 n0 = *(LAS f32x4*)(tab + TGN + 32 * part + 8 * i), n1 = *(LAS f32x4*)(tab + TGN + 32 * part + 8 * i + 4); float o[8];
#pragma unroll
                for (int j = 0; j < 4; ++j) { o[j] = y[8 * i + j] * rstd * n0[j]; o[4 + j] = y[8 * i + 4 + j] * rstd * n1[j]; }
                if constexpr (MIX == MIX_RET || MIX == MIX_GLA) { float gt[8]; unpack8(gw[i], gt);
#pragma unroll
                    for (int j = 0; j < 8; ++j) o[j] *= fsilu(gt[j]); }
                if (dostore) *(u32x4*)(rp + OCOL + 8 * i) = pack8(o);
            }
            if constexpr (MIX == MIX_ML) { if (tid == 0) tab[641] = tab[642]; }
        }
        if (ch + 1 < SEQ / 64) {
            if constexpr (MIX == MIX_ML) { if (w == 0) { const bf16_t* rp = proj + (row0 + 64 + lane) * NP; gpre0 = rp[C0_MI + h]; gpre1 = rp[C0_MF + h]; } }
            if constexpr (MIX == MIX_SSD) { if (w < 4) gpre0 = proj[(row0 + 64 + lane) * NP + C1_DT + 4 * h + w]; }
        }
        __syncthreads();
        tp_end(lds, 100 * MIX + 5);
    }
    tp_end(lds, 100 * MIX + 9);
}

#define XB_TMO      128
#define XB_XCNT(j)  (256  + 64 * (j))
#define XB_XSUB(j)  (1280 + 64 * (j))
#define XB_XGEN(j)  (2304 + 64 * (j))
#define XB_TOP      3328
#define XB_TOPGEN   3392
#define XCD_BAR_WORDS 3456
#define XB_SPIN_CAP (1u << 18)
__device__ __forceinline__ unsigned xb_ld(unsigned* p)              { return __hip_atomic_load(p, __ATOMIC_RELAXED, __HIP_MEMORY_SCOPE_AGENT); }
__device__ __forceinline__ unsigned xb_add(unsigned* p, unsigned v) { return __hip_atomic_fetch_add(p, v, __ATOMIC_RELAXED, __HIP_MEMORY_SCOPE_AGENT); }
__device__ __forceinline__ unsigned xb_xcc_id() { return (unsigned)__builtin_amdgcn_s_getreg((3 << 11) | 20) & 0xFu; }
#define XB_SPIN(cond, bar) do { unsigned _sp = 0; while (cond) { __builtin_amdgcn_s_sleep(1); \
    if ((++_sp & 255u) == 0u) { if (xb_ld(&(bar)[XB_TMO])) break; if (_sp > XB_SPIN_CAP) { atomicAdd(&(bar)[XB_TMO], 1u); break; } } } } while (0)
struct XcdBarrier { unsigned* bar; unsigned x; volatile LAS unsigned* st; };
__device__ __forceinline__ XcdBarrier xcd_barrier_post(unsigned* bar, volatile LAS unsigned* st) {
    XcdBarrier b; b.bar = bar; b.x = xb_xcc_id(); b.st = st;
    if (opaque_tid() == 0) (void)xb_add(&bar[XB_XCNT(b.x)], 1u);
    return b;
}
__device__ __forceinline__ void xcd_barrier_complete(unsigned* bar, unsigned x, unsigned& nloc, unsigned& nx) {
    const unsigned G = gridDim.x * gridDim.y * gridDim.z;
    unsigned sum, cnt, mine, sp = 0u;
    for (;;) {
        sum = 0u; cnt = 0u; mine = 0u;
#pragma unroll
        for (unsigned j = 0; j < 16; ++j) { const unsigned c = xb_ld(&bar[XB_XCNT(j)]); sum += c; cnt += (c > 0u) ? 1u : 0u; mine = (j == x) ? c : mine; }
        if (sum == G) break;
        __builtin_amdgcn_s_sleep(1);
        if ((++sp & 255u) == 0u) { if (xb_ld(&bar[XB_TMO])) break; if (sp > XB_SPIN_CAP) { atomicAdd(&bar[XB_TMO], 1u); break; } }
    }
    nloc = mine > 0u ? mine : 1u; nx = cnt > 0u ? cnt : 1u;
}
__device__ __forceinline__ void xcd_barrier(const XcdBarrier& b) {
    asm volatile("s_waitcnt vmcnt(0)" ::: "memory");
    __syncthreads();
    if (opaque_tid() == 0) {
        unsigned* bar = b.bar;
        __builtin_amdgcn_s_waitcnt(0);
        unsigned nloc = b.st[0], nx = b.st[1];
        if (nloc == 0u) { xcd_barrier_complete(bar, b.x, nloc, nx); b.st[0] = nloc; b.st[1] = nx; }
        const unsigned old = xb_add(&bar[XB_XSUB(b.x)], 1u);
        const unsigned gen = old / nloc;
        if (old + 1u == (gen + 1u) * nloc) {
            __builtin_amdgcn_fence(__ATOMIC_RELEASE, "agent");
            asm volatile("s_waitcnt vmcnt(0)" ::: "memory");
            const unsigned og = xb_add(&bar[XB_TOP], 1u);
            const unsigned tg = og / nx;
            if (og + 1u == (tg + 1u) * nx) xb_add(&bar[XB_TOPGEN], 1u);
            else XB_SPIN(xb_ld(&bar[XB_TOPGEN]) == tg, bar);
            __builtin_amdgcn_fence(__ATOMIC_ACQUIRE, "agent");
            xb_add(&bar[XB_XGEN(b.x)], 1u);
            asm volatile("s_waitcnt vmcnt(0)" ::: "memory");
        } else {
            XB_SPIN(xb_ld(&bar[XB_XGEN(b.x)]) == gen, bar);
            __builtin_amdgcn_fence(__ATOMIC_ACQUIRE, "agent");
            asm volatile("s_waitcnt vmcnt(0)" ::: "memory");
        }
    }
    __syncthreads();
}

constexpr int NTHREADS = 512;
constexpr int RING_BYTES = 131072;
constexpr int LDS_BYTES = 163840;
constexpr int LDS_BARW = LDS_BYTES - 16;
constexpr int NPHASES = 17;
#ifndef MK_N_LAUNCHES
#define MK_N_LAUNCHES 1
#endif

#ifndef REP_ROUTE
#define REP_ROUTE 1
#endif
#ifndef REP_CONV
#define REP_CONV 1
#endif
#ifndef REP_GIN
#define REP_GIN 1
#endif
#ifndef REP_GOUT
#define REP_GOUT 1
#endif
#ifndef REP_PERM
#define REP_PERM 1
#endif
#ifndef REP_MOEA
#define REP_MOEA 1
#endif
#ifndef REP_MOEB
#define REP_MOEB 1
#endif
#ifndef REP_LNF
#define REP_LNF 1
#endif
#ifndef MIXREP_RET
#define MIXREP_RET 1
#endif
#ifndef MIXREP_ML
#define MIXREP_ML 1
#endif
#ifndef MIXREP_GLA
#define MIXREP_GLA 1
#endif
#ifndef MIXREP_SSD
#define MIXREP_SSD 1
#endif
struct Args { Params P; int ph_lo, ph_hi; };
typedef __attribute__((address_space(4))) const unsigned char* kargp_t;
__device__ __forceinline__ const Params& kparams() {
    kargp_t p = (kargp_t)__builtin_amdgcn_kernarg_segment_ptr();
    asm volatile("" : "+s"(p));
    return *(const Params*)p;
}

__device__ __forceinline__ int kphase_lo() { kargp_t p = (kargp_t)__builtin_amdgcn_kernarg_segment_ptr(); asm volatile("" : "+s"(p)); return ((const Args*)p)->ph_lo; }
__device__ __forceinline__ int kphase_hi() { kargp_t p = (kargp_t)__builtin_amdgcn_kernarg_segment_ptr(); asm volatile("" : "+s"(p)); return ((const Args*)p)->ph_hi; }
__device__ __forceinline__ void grid_barrier(LAS unsigned char* lds) {
    XcdBarrier b; b.bar = (unsigned*)(kparams().ws + WS_CTL) + CW_BAR; b.x = xb_xcc_id(); b.st = (volatile LAS unsigned*)(lds + LDS_BARW);
    tp_begin(lds, 900); xcd_barrier(b); tp_end(lds, 900);
}
template <int LAYER>
__device__ __forceinline__ void layer_phases(LAS unsigned char* lds) {
#define IN(k) (kphase_lo() <= (k) && (k) < kphase_hi())
#define SEAM(k) do { if (IN(k) && IN((k) + 1)) grid_barrier(lds); } while (0)
    constexpr int PB = 1 + 8 * LAYER;
    const int bid = blockIdx.x, nb = gridDim.x;
    if (IN(PB + 0)) {
        const Params& P = kparams();
        pg8::EpiStore E{(bf16_t*)(P.ws + WS_BIG), NP};
        constexpr unsigned M8 = LAYER ? INPROJ_FP8MASK1 : INPROJ_FP8MASK0, M16 = ALLTILES & ~M8;
        for (int rep = 0; rep < REP_GIN; ++rep) {
            if constexpr (M16 != 0u) {
                pg8::SchedCols S; S.A = (const char*)(P.out + OUT_H); S.B = (const char*)(P.ws + (LAYER ? WS_WIN1 : WS_WIN0)); S.lda = D; S.ldb = D; S.nM = T / 256; S.nN = __builtin_popcount(M16); S.G = nb; S.c = bid; S.mask = M16;
                pg8::gemm_phase(lds, S, E, D, D, D);
            }
            if constexpr (M8 != 0u) {
                pg8::SchedCols S; S.A = (const char*)(P.ws + WS_H8); S.B = (const char*)(P.ws + (LAYER ? WS_WIN8_1 : WS_WIN8_0)); S.lda = D / 2; S.ldb = D / 2; S.nM = T / 256; S.nN = __builtin_popcount(M8); S.G = nb; S.c = bid; S.mask = M8;
                pg8::gemm_phase<pg8::EpiStore, pg8::SchedCols, true, 0x7c7c7c7c, 0x77777777>(lds, S, E, D / 2, D / 2, D / 2);
            }
        }
    }
    SEAM(PB + 0);
    if (IN(PB + 1)) {
        if constexpr (LAYER == 1) { ssd_prep(kparams(), lds, bid, nb); grid_barrier(lds); }
        const Params& P = kparams();
        for (int u = bid; u < 256; u += nb) {
            const int b = (u & 127) >> 2, h = u & 3;
            if (LAYER == 0) { if (u < 128) { for (int rep = 0; rep < MIXREP_RET; ++rep) { mixer_unit<MIX_RET>(P, b, h, lds, rep == MIXREP_RET - 1); __syncthreads(); }
                                               convert_moe(P, lds, u, 128); }
                              else { for (int rep = 0; rep < MIXREP_ML; ++rep) { mixer_unit<MIX_ML>(P, b, h, lds, rep == MIXREP_ML - 1); __syncthreads(); } } }
            else { if (u < 128) { for (int rep = 0; rep < MIXREP_GLA; ++rep) { mixer_unit<MIX_GLA>(P, b, h, lds, rep == MIXREP_GLA - 1); __syncthreads(); } }
                   else { for (int rep = 0; rep < MIXREP_SSD; ++rep) { mixer_unit<MIX_SSD>(P, b, h, lds, rep == MIXREP_SSD - 1); __syncthreads(); } } }
        }
    }
    SEAM(PB + 1);
    if (IN(PB + 2)) {
        const Params& P = kparams();
        pg8::SchedPlain S; S.A = (const char*)(P.ws + WS_BIG) + YOFF * 2; S.B = (const char*)(P.ws + (LAYER ? WS_WOUT1 : WS_WOUT0)); S.lda = NP; S.ldb = 2048; S.nM = T / 256; S.nN = 4; S.G = nb; S.c = bid;
        pg8::EpiResid E{(bf16_t*)(P.out + OUT_PRE1), (const bf16_t*)(P.out + OUT_H)};
        for (int rep = 0; rep < REP_GOUT; ++rep) pg8::gemm_phase(lds, S, E, 2048, NP, 2048);
    }
    SEAM(PB + 2);
    if (IN(PB + 3)) for (int rep = 0; rep < REP_ROUTE; ++rep) { phase_route(kparams(), LAYER, lds, bid, nb, 32 * (REP_ROUTE - 1 - rep)); __syncthreads(); }
    SEAM(PB + 3);
    if (IN(PB + 4)) for (int rep = 0; rep < REP_PERM; ++rep) phase_permute(kparams(), LAYER, lds, bid, nb);
    SEAM(PB + 4);
    if (IN(PB + 5)) {
        const Params& P = kparams();
        const int* tilecls = (const int*)(P.ws + WS_TILECLS);
        if constexpr (MOE_FP8(LAYER) && MOEA_FP8) {
            pg8::SchedMoeA<true> S; S.A = (const char*)(P.ws + WS_BIG + BIG_HS8); S.Wgu = (const char*)(P.ws + WS_WGU) + (size_t)LAYER * 16 * 2097152; S.tilecls = tilecls; S.nM = __builtin_amdgcn_readfirstlane(tilecls[0]); S.G = nb; S.c = bid;
            pg8::EpiSwiglu8 E{P.ws + WS_BIG + BIG_H, (const float*)(P.ws + WS_ROWGATE)};
            for (int rep = 0; rep < REP_MOEA; ++rep) pg8::gemm_phase<pg8::EpiSwiglu8, pg8::SchedMoeA<true>, true, 0x7c7c7c7c, 0x77777777>(lds, S, E, D / 2, D / 2, D / 2);
        } else if constexpr (MOE_FP8(LAYER)) {
            pg8::SchedMoeA<false> S; S.A = (const char*)(P.ws + WS_BIG + BIG_HS); S.Wgu = (const char*)(P.ws + WS_WGU) + (size_t)LAYER * 16 * 2097152; S.tilecls = tilecls; S.nM = __builtin_amdgcn_readfirstlane(tilecls[0]); S.G = nb; S.c = bid;
            pg8::EpiSwiglu8 E{P.ws + WS_BIG + BIG_H, (const float*)(P.ws + WS_ROWGATE)};
            for (int rep = 0; rep < REP_MOEA; ++rep) pg8::gemm_phase(lds, S, E, D, D, D);
        } else {
            pg8::SchedMoeA<false> S; S.A = (const char*)(P.ws + WS_BIG + BIG_HS); S.Wgu = (const char*)(P.ws + WS_WGU) + (size_t)LAYER * 16 * 2097152; S.tilecls = tilecls; S.nM = __builtin_amdgcn_readfirstlane(tilecls[0]); S.G = nb; S.c = bid;
            pg8::EpiSwiglu E{(bf16_t*)(P.ws + WS_BIG + BIG_H), (const float*)(P.ws + WS_ROWGATE)};
            for (int rep = 0; rep < REP_MOEA; ++rep) pg8::gemm_phase(lds, S, E, D, D, D);
        }
    }
    SEAM(PB + 5);
    if (IN(PB + 6)) {
        const Params& P = kparams();
        const int* tilecls = (const int*)(P.ws + WS_TILECLS);
        pg8::EpiResid E{(bf16_t*)(P.ws + WS_BIG + BIG_PRE2), (const bf16_t*)(P.ws + WS_BIG + BIG_HS)};
        if constexpr (MOE_FP8(LAYER)) {
            pg8::SchedMoeB<true> S; S.A = (const char*)(P.ws + WS_BIG + BIG_H); S.Wd = (const char*)(P.ws + WS_WD) + (size_t)LAYER * 16 * 1048576; S.tilecls = tilecls; S.nM = __builtin_amdgcn_readfirstlane(tilecls[0]); S.G = nb; S.c = bid;
            for (int rep = 0; rep < REP_MOEB; ++rep) pg8::gemm_phase<pg8::EpiResid, pg8::SchedMoeB<true>, true, 0x7c7c7c7c, 0x77777777>(lds, S, E, D / 2, D / 2, 256);
        } else {
            pg8::SchedMoeB<false> S; S.A = (const char*)(P.ws + WS_BIG + BIG_H); S.Wd = (const char*)(P.ws + WS_WD) + (size_t)LAYER * 16 * 1048576; S.tilecls = tilecls; S.nM = __builtin_amdgcn_readfirstlane(tilecls[0]); S.G = nb; S.c = bid;
            for (int rep = 0; rep < REP_MOEB; ++rep) pg8::gemm_phase(lds, S, E, D, D, 512);
        }
    }
    SEAM(PB + 6);
    if (IN(PB + 7)) for (int rep = 0; rep < REP_LNF; ++rep) phase_lnffn(kparams(), LAYER, bid, nb);
    if (LAYER == 0) SEAM(PB + 7);
#undef IN
#undef SEAM
}

__global__ void __launch_bounds__(NTHREADS, 2) mega_fwd(Args a) {
    LAS unsigned char* lds = (LAS unsigned char*)g_lds;
    if (threadIdx.x < 4) ((LAS unsigned*)(lds + LDS_BARW))[threadIdx.x] = 0u;
    if (TPROBE_ID != 0 && threadIdx.x < 4) ((LAS unsigned*)(lds + LDS_TPROBE))[threadIdx.x] = 0u;
    if ((threadIdx.x & 63) == 0) *(LAS int*)(lds + LDS_WIDTAB + 4 * hw_wave_key()) = (int)(threadIdx.x >> 6);
    __syncthreads();
    if (a.ph_hi - a.ph_lo > 1) (void)xcd_barrier_post((unsigned*)(kparams().ws + WS_CTL) + CW_BAR, (volatile LAS unsigned*)(lds + LDS_BARW));
    if (kphase_lo() <= 0 && 0 < kphase_hi()) { for (int rep = 0; rep < REP_CONV; ++rep) phase_convert(kparams(), lds, blockIdx.x, gridDim.x); if (1 < kphase_hi()) grid_barrier(lds); }
    layer_phases<0>(lds);
    layer_phases<1>(lds);
    if (TPROBE_ID != 0 && blockIdx.x == TPROBE_BLOCK && opaque_tid() == 0) {
        const unsigned long long need = ((LAS unsigned long long*)(lds + LDS_TPROBE))[0] * TPROBE_MULT, t0 = wall_clock64();
        while (wall_clock64() - t0 < need) __builtin_amdgcn_s_sleep(8);
    }
}

extern "C" void kernel_launch(void* const* d_in, const int* in_sizes, int n_in, void* d_out, int out_size, void* d_ws, size_t ws_size, hipStream_t stream) {
    static int grid = 0;
    if (!grid) {
        if (n_in != 30 || ws_size < WS_END || out_size != T * D) { fprintf(stderr, "kernel_launch: unexpected shapes n_in %d ws %zu out %d\n", n_in, ws_size, out_size); grid = -1; return; }
        int dev = 0, cus = 0, per_cu = 0;
        if (hipGetDevice(&dev) != hipSuccess || hipDeviceGetAttribute(&cus, hipDeviceAttributeMultiprocessorCount, dev) != hipSuccess) { grid = -1; return; }
        if (hipFuncSetAttribute((const void*)mega_fwd, hipFuncAttributeMaxDynamicSharedMemorySize, LDS_BYTES) != hipSuccess) { fprintf(stderr, "kernel_launch: hipFuncSetAttribute failed\n"); grid = -1; return; }
        if (hipOccupancyMaxActiveBlocksPerMultiprocessor(&per_cu, (const void*)mega_fwd, NTHREADS, LDS_BYTES) != hipSuccess || per_cu < 1)
            fprintf(stderr, "kernel_launch: note: occupancy query reports %d workgroups per CU\n", per_cu);
        grid = cus > 0 ? cus : 256;
    }
    if (grid < 0) return;
    Args a{};
    for (int i = 0; i < 30; ++i) a.P.in[i] = (const float*)d_in[i];
    a.P.out = (unsigned char*)d_out; a.P.ws = (unsigned char*)d_ws;
    (void)hipMemsetAsync((char*)d_ws + WS_CTL, 0, CTL_BYTES, stream);
    constexpr int NL = MK_N_LAUNCHES;
    if (NL == 1) { a.ph_lo = 0; a.ph_hi = NPHASES; hipLaunchKernelGGL(mega_fwd, dim3(grid), dim3(NTHREADS), LDS_BYTES, stream, a); }
    else for (int p = 0; p < NPHASES; ++p) { a.ph_lo = p; a.ph_hi = p + 1; hipLaunchKernelGGL(mega_fwd, dim3(grid), dim3(NTHREADS), LDS_BYTES, stream, a); }
}
```

```cpp
#include <hip/hip_runtime.h>
#include <cstdio>
#include <cstdint>

#ifndef MIX_LREP
#define MIX_LREP 1
#endif
#ifndef MIX_SREP
#define MIX_SREP 1
#endif
#ifndef MIX_EREP
#define MIX_EREP 1
#endif
#define GAS __attribute__((address_space(1)))
#define LAS __attribute__((address_space(3)))
typedef unsigned short bf16_t;
typedef short bf16x8 __attribute__((ext_vector_type(8)));
typedef float f32x4 __attribute__((ext_vector_type(4)));
typedef unsigned u32x4 __attribute__((ext_vector_type(4)));

constexpr int BATCH = 32, SEQ = 2048, T = BATCH * SEQ, D = 1024;
constexpr int NP = 6400;
constexpr int YOFF = 1024;
constexpr int NCLS = 24, MAXTILES = 280;
constexpr float LN_EPS = 1e-5f, NORM_EPS = 1e-6f;
constexpr float ALPHA = 1.41421356237f;
constexpr int NTHREADS_C = 512;

constexpr int C0_RQ = 0, C0_RK = 512, C0_RV = 1024, C0_MV = 2048, C0_RG = 3072, C0_MQ = 4096, C0_MK = 4608, C0_MO = 5120, C0_MI = 6144, C0_MF = 6148;
constexpr int C1_GQ = 0, C1_GK = 512, C1_GV = 1024, C1_SZ = 2048, C1_GR = 3072, C1_XS = 4096, C1_BM = 5120, C1_CM = 5632, C1_GA = 6144, C1_DT = 6160;

constexpr size_t MiB = 1u << 20;
constexpr size_t WS_CTL = 0, CTL_BYTES = 1 * MiB;
constexpr size_t WS_WIN0 = 2 * MiB;
constexpr size_t WS_WIN1 = 15 * MiB;
constexpr size_t WS_WOUT0 = 28 * MiB;
constexpr size_t WS_WOUT1 = 32 * MiB;
constexpr size_t WS_WGU = 36 * MiB;
constexpr size_t WS_WD = 100 * MiB;
constexpr size_t WS_TOKCLS = 132 * MiB;
constexpr size_t WS_TOKPOS = WS_TOKCLS + (size_t)T * 4;
constexpr size_t WS_TOKDST = WS_TOKPOS + (size_t)T * 4;
constexpr size_t WS_TOKGATE = WS_TOKDST + (size_t)T * 4;
constexpr size_t WS_ROWGATE = WS_TOKGATE + (size_t)T * 8;
constexpr size_t WS_TILECLS = WS_ROWGATE + (size_t)MAXTILES * 256 * 8;
constexpr size_t WS_BIG = 136 * MiB;
constexpr size_t BIG_HS = 0, BIG_H = 160 * MiB, BIG_PRE2 = 320 * MiB, BIG_HS8 = 480 * MiB;
constexpr size_t WS_H8 = WS_BIG + (size_t)T * NP * 2;
constexpr size_t WS_WIN8_0 = WS_H8 + (size_t)T * D;
constexpr size_t WS_WIN8_1 = WS_WIN8_0 + (size_t)NP * D;
constexpr size_t WS_END = WS_WIN8_1 + (size_t)NP * D;
static_assert(WS_TILECLS + (MAXTILES + 8) * 4 <= WS_BIG, "ws map");
static_assert(WS_END <= 1024 * MiB, "ws map");
constexpr size_t OUT_H = 0, OUT_PRE1 = 128 * MiB;
constexpr int CW_CNT = 1024;
constexpr int CW_BAR = 4096;

__device__ __forceinline__ unsigned f2bf(float f) { unsigned u = __builtin_bit_cast(unsigned, f); return (u + 0x7fffu + ((u >> 16) & 1u)) >> 16; }
__device__ __forceinline__ unsigned pk2(float lo, float hi) { return f2bf(lo) | (f2bf(hi) << 16); }
__device__ __forceinline__ float bf2f(unsigned short b) { return __builtin_bit_cast(float, ((unsigned)b) << 16); }
__device__ __forceinline__ float bflo(unsigned w) { return __builtin_bit_cast(float, w << 16); }
__device__ __forceinline__ float bfhi(unsigned w) { return __builtin_bit_cast(float, w & 0xffff0000u); }
__device__ __forceinline__ float sigmoidf_(float x) { return 1.f / (1.f + __expf(-x)); }
__device__ __forceinline__ float siluf_(float x) { return x / (1.f + __expf(-x)); }
__device__ __forceinline__ float softplusf_(float x) { return x > 20.f ? x : log1pf(expf(x)); }
__device__ __forceinline__ float logsigmoidf_(float x) { return -softplusf_(-x); }
__device__ __forceinline__ float wave_sum(float v) {
#define WS_DPP(ctrl, rm) v += __builtin_bit_cast(float, __builtin_amdgcn_update_dpp(0, __builtin_bit_cast(int, v), ctrl, rm, 0xf, false))
    WS_DPP(0x111, 0xf); WS_DPP(0x112, 0xf); WS_DPP(0x114, 0xf); WS_DPP(0x118, 0xf); WS_DPP(0x142, 0xa); WS_DPP(0x143, 0xc);
#undef WS_DPP
    return __builtin_bit_cast(float, __builtin_amdgcn_readlane(__builtin_bit_cast(int, v), 63));
}
#define LDS_WAIT() asm volatile("s_waitcnt lgkmcnt(0)" ::: "memory")
__device__ __forceinline__ unsigned pk4_fp8(float a, float b, float c, float d) { int w = __builtin_amdgcn_cvt_pk_fp8_f32(a, b, 0, false); w = __builtin_amdgcn_cvt_pk_fp8_f32(c, d, w, true); return (unsigned)w; }
#ifndef MOE_FP8
#define MOE_FP8(layer) ((layer) >= 0)
#endif
#ifndef MOEA_FP8
#define MOEA_FP8 1
#endif
#ifndef INPROJ_FP8MASK0
#define INPROJ_FP8MASK0 0x00fcfffcu
#endif
#ifndef INPROJ_FP8MASK1
#define INPROJ_FP8MASK1 0x01ffffffu
#endif
constexpr unsigned ALLTILES = 0x01ffffffu;
#ifndef INPROJ_FP8
#define INPROJ_FP8(layer) ((layer) == 1)
#endif
constexpr float H8_SCALE = 8.f, W8_SCALE = 256.f;
#ifndef TPROBE_ID
#define TPROBE_ID 0
#endif
#ifndef TPROBE_BLOCK
#define TPROBE_BLOCK 128
#endif
#ifndef TPROBE_MULT
#define TPROBE_MULT 4
#endif
constexpr int LDS_TPROBE = 163840 - 48;
__device__ __forceinline__ int opaque_tid();
__device__ __forceinline__ void tp_begin(LAS unsigned char* lds, int id) { if (TPROBE_ID != 0 && TPROBE_ID == id && opaque_tid() == 0) ((LAS unsigned long long*)(lds + LDS_TPROBE))[1] = wall_clock64(); }
__device__ __forceinline__ void tp_end(LAS unsigned char* lds, int id) { if (TPROBE_ID != 0 && TPROBE_ID == id && opaque_tid() == 0) { LAS unsigned long long* p = (LAS unsigned long long*)(lds + LDS_TPROBE); p[0] += wall_clock64() - p[1]; } }
extern __shared__ __attribute__((aligned(16))) unsigned char g_lds[];
constexpr int LDS_WIDTAB = 163840 - 512;
__device__ __forceinline__ int hw_wave_key() { return (int)__builtin_amdgcn_s_getreg((5 << 11) | 4) & 63; }
__device__ __forceinline__ int opaque_tid() {
    const int wid = __builtin_amdgcn_readfirstlane(*(volatile LAS int*)((LAS unsigned char*)g_lds + LDS_WIDTAB + 4 * hw_wave_key()));
    int t = wid * 64 + (int)__builtin_amdgcn_mbcnt_hi(~0u, __builtin_amdgcn_mbcnt_lo(~0u, 0u)); asm volatile("" : "+v"(t)); return t; }

namespace pg8 {
constexpr int BM = 256, BK = 64, HALF = 128, HTB = HALF * BK * 2, STAGE_BYTES = 8 * HTB, NXCD = 8, WGM = 8;
__host__ __device__ __forceinline__ int lds_byte(int r, int c) { const int st = (r >> 4) * 2 + (c >> 5), rr = r & 15, cc = c & 31, ob = rr * 64 + cc * 2; return st * 1024 + (ob ^ (((ob >> 9) & 1) << 5)); }
__host__ __device__ __forceinline__ void stage_rc(int b, int& R, int& C) { const int st = b / 1024, sb = b % 1024, swz = sb ^ (((sb >> 9) & 1) << 5); R = (st >> 1) * 16 + swz / 64; C = (st & 1) * 32 + (swz % 64) / 2; }
__host__ __device__ __forceinline__ int perm32(int rho) { const int n = rho >> 4, i = rho & 15; return 8 * (i >> 2) + 4 * n + (i & 3); }

struct Unit { int pm, pn; unsigned a, b0, b1; };

__device__ __forceinline__ bool static_tile(int i, int G, int c, int nM, int nN, int& pm, int& pn) {
    const int nwg = nM * nN; const int L = i * G + c; if (L >= nwg) return false;
    int wgid = L; { const int q = nwg / NXCD, r = nwg % NXCD, xcd = wgid % NXCD, off = wgid / NXCD; wgid = (xcd < r ? xcd * (q + 1) : r * (q + 1) + (xcd - r) * q) + off; }
    const int nig = WGM * nN, gid = wgid / nig, fm = gid * WGM, gsz = (nM - fm) < WGM ? (nM - fm) : WGM;
    pm = fm + ((wgid % nig) % gsz); pn = (wgid % nig) / gsz; return true;
}
template <class Tp> __device__ __forceinline__ Tp* uniform_ptr(Tp* p) {
    const unsigned long long v = (unsigned long long)p;
    const unsigned lo = __builtin_amdgcn_readfirstlane((unsigned)v), hi = __builtin_amdgcn_readfirstlane((unsigned)(v >> 32));
    return (Tp*)(((unsigned long long)hi << 32) | lo); }
__device__ __forceinline__ unsigned cvt_pk_bf16(float lo, float hi) { unsigned r; asm volatile("v_cvt_pk_bf16_f32 %0, %1, %2" : "=v"(r) : "v"(lo), "v"(hi)); return r; }

typedef int i32x8 __attribute__((ext_vector_type(8)));
typedef int i32x4v __attribute__((ext_vector_type(4)));
__device__ __forceinline__ i32x8 cat16(const bf16x8& lo, const bf16x8& hi) { const i32x4v a = __builtin_bit_cast(i32x4v, lo), b = __builtin_bit_cast(i32x4v, hi); return (i32x8){a[0], a[1], a[2], a[3], b[0], b[1], b[2], b[3]}; }
#ifndef PG8_SP2
#define PG8_SP2 true
#endif
#ifndef PG8_ALIGN
#define PG8_ALIGN true
#endif
template <class Epi, class Sched, bool FP8 = false, int SCA = 0x7f7f7f7f, int SCB = 0x7f7f7f7f, bool SP2 = PG8_SP2, bool ALIGN_EPI = PG8_ALIGN>
__device__ __forceinline__ void gemm_phase(LAS unsigned char* lds, const Sched& S, const Epi& E, const int K, const int lda, const int ldb) {
    const int tid = opaque_tid(), wid = __builtin_amdgcn_readfirstlane(tid >> 6), lane = tid & 63, wr = wid >> 2, wc = wid & 3, fr = lane & 15, fq = lane >> 4;
    int nt = K / BK; asm volatile("" : "+s"(nt));
    constexpr int KS = Sched::KSPLIT;
    unsigned voffA0, voffB0;
    { int R, C; stage_rc(tid * 16, R, C); const int Rb = (R & ~31) + perm32(R & 31); voffA0 = (unsigned)(R * lda + C) * 2u; voffB0 = (unsigned)(Rb * ldb + C) * 2u; }
    const unsigned q64A = 64u * lda * 2u, q64B = 64u * ldb * 2u;
    const unsigned kstep = (unsigned)(BK * 2);
    const unsigned hstepA = (unsigned)HALF * lda * 2, hstepB = (unsigned)HALF * ldb * 2;
    const __amdgpu_buffer_rsrc_t rsA = __builtin_amdgcn_make_buffer_rsrc((void*)S.A, 0, 0xffffffff, 0x00020000), rsB = __builtin_amdgcn_make_buffer_rsrc((void*)S.bbase(), 0, 0xffffffff, 0x00020000);
    const unsigned ldsw = (unsigned)wid * 1024u;
    const int aoff = lds_byte(wr * 64 + fr, fq * 8), boff = lds_byte(wc * 32 + fr, fq * 8);
#define PG8_BP(u, kt) ((KS > 0 && (kt) >= KS) ? (u).b1 + (unsigned)((kt) - KS) * kstep : (u).b0 + (unsigned)(kt) * kstep)
#define PG8_SA(b, h) (((b) * 2 + (h)) * HTB)
#define PG8_SB(b, h) ((4 + (b) * 2 + (h)) * HTB)
#define PG8_STAGEA(bufoff, soff) do { _Pragma("unroll") for (int _i = 0; _i < 2; ++_i) \
        __builtin_amdgcn_raw_ptr_buffer_load_lds(rsA, (LAS void*)(lds + (bufoff) + ldsw + _i * 8192), 16, voffA0, (int)((soff) + _i * q64A), 0, 0); } while (0)
#define PG8_STAGEB(bufoff, soff) do { _Pragma("unroll") for (int _i = 0; _i < 2; ++_i) \
        __builtin_amdgcn_raw_ptr_buffer_load_lds(rsB, (LAS void*)(lds + (bufoff) + ldsw + _i * 8192), 16, voffB0, (int)((soff) + _i * q64B), 0, 0); } while (0)
#define PG8_LDA(dst, b, h) do { _Pragma("unroll") for (int m = 0; m < 4; ++m) _Pragma("unroll") for (int k = 0; k < 2; ++k) dst[m][k] = *(const LAS bf16x8*)(lds + PG8_SA(b, h) + aoff + m * 2048 + k * 1024); } while (0)
#define PG8_LDB(dst, b, h) do { _Pragma("unroll") for (int n = 0; n < 2; ++n) _Pragma("unroll") for (int k = 0; k < 2; ++k) dst[n][k] = *(const LAS bf16x8*)(lds + PG8_SB(b, h) + boff + n * 2048 + k * 1024); } while (0)
#define PG8_MMA(ai, bj, At, Bt) do { __builtin_amdgcn_s_setprio(1); _Pragma("unroll") for (int m = 0; m < 4; ++m) _Pragma("unroll") for (int n = 0; n < 2; ++n) { \
        if constexpr (FP8) acc[ai][bj][m][n] = __builtin_amdgcn_mfma_scale_f32_16x16x128_f8f6f4(cat16(Bt[n][0], Bt[n][1]), cat16(At[m][0], At[m][1]), acc[ai][bj][m][n], 0, 0, 1, ((SCB & 0xff) << 8) | (SCA & 0xff), 0, ((SCB & 0xff) << 8) | (SCA & 0xff)); \
        else { _Pragma("unroll") for (int k = 0; k < 2; ++k) acc[ai][bj][m][n] = __builtin_amdgcn_mfma_f32_16x16x32_bf16(Bt[n][k], At[m][k], acc[ai][bj][m][n], 0, 0, 0); } } \
        __builtin_amdgcn_s_setprio(0); } while (0)
#define PG8_WAIT_V(n) asm volatile("s_waitcnt vmcnt(" #n ")" ::: "memory")
#define PG8_WAIT_L(n) asm volatile("s_waitcnt lgkmcnt(" #n ")" ::: "memory")
#define PG8_BAR __builtin_amdgcn_s_barrier()
#define PG8_SCHED __builtin_amdgcn_sched_barrier(0)
    Unit cur, nxt; int ui = 0;
    if (!S.next(0, cur)) return;
    f32x4 acc[2][2][4][2];
#pragma unroll
    for (int a = 0; a < 2; ++a)
#pragma unroll
        for (int b = 0; b < 2; ++b)
#pragma unroll
            for (int m = 0; m < 4; ++m)
#pragma unroll
                for (int n = 0; n < 2; ++n) acc[a][b][m][n] = (f32x4){0.f, 0.f, 0.f, 0.f};
    bf16x8 At[4][2], B0[2][2], B1[2][2];
    unsigned cA = cur.a;
    E.prefetch(cur, tid);
    { const unsigned cB0 = PG8_BP(cur, 0), cB1 = PG8_BP(cur, 1);
    if constexpr (SP2) {
        PG8_STAGEB(PG8_SB(0, 0), cB0); PG8_STAGEB(PG8_SB(0, 1), cB0 + hstepB); PG8_STAGEA(PG8_SA(0, 0), cA); PG8_STAGEA(PG8_SA(0, 1), cA + hstepA);
        if (wr == 1) PG8_BAR;
        PG8_WAIT_V(2); PG8_BAR;
        PG8_STAGEB(PG8_SB(1, 0), cB1); PG8_STAGEA(PG8_SA(1, 0), cA + kstep); PG8_STAGEB(PG8_SB(1, 1), cB1 + hstepB);
        PG8_WAIT_V(6); PG8_BAR;
    } else {
    PG8_STAGEB(PG8_SB(0, 0), cB0); PG8_STAGEA(PG8_SA(0, 0), cA); PG8_STAGEB(PG8_SB(0, 1), cB0 + hstepB); PG8_STAGEA(PG8_SA(0, 1), cA + hstepA);
    if (wr == 1) PG8_BAR;
    PG8_WAIT_V(4); PG8_BAR;
    PG8_STAGEB(PG8_SB(1, 0), cB1); PG8_STAGEA(PG8_SA(1, 0), cA + kstep); PG8_STAGEB(PG8_SB(1, 1), cB1 + hstepB);
    PG8_WAIT_V(6); PG8_BAR; } }
    for (;;) {
        const bool has_next = S.next(ui + 1, nxt);
        if (!has_next) nxt = cur;
        for (int t = 0; t < nt; t += 2) {
            const bool last = (t == nt - 2);
            const unsigned a1 = cA + (unsigned)(t + 1) * kstep;
            const unsigned a2 = last ? nxt.a : cA + (unsigned)(t + 2) * kstep;
            const unsigned b2 = last ? PG8_BP(nxt, 0) : PG8_BP(cur, t + 2);
            const unsigned a3 = a2 + kstep;
            const unsigned b3 = last ? PG8_BP(nxt, 1) : PG8_BP(cur, t + 3);
            if constexpr (SP2) {
            PG8_LDB(B0, 0, 0); PG8_LDB(B1, 0, 1); PG8_SCHED; PG8_LDA(At, 0, 0); PG8_STAGEA(PG8_SA(1, 1), a1 + hstepA);
            PG8_WAIT_V(8); PG8_WAIT_L(0); PG8_BAR; PG8_MMA(0, 0, At, B0); PG8_MMA(0, 1, At, B1); PG8_BAR; PG8_SCHED;
            PG8_LDA(At, 0, 1); PG8_STAGEB(PG8_SB(0, 0), b2); PG8_STAGEB(PG8_SB(0, 1), b2 + hstepB); PG8_STAGEA(PG8_SA(0, 0), a2);
            PG8_WAIT_V(8); PG8_WAIT_L(0); PG8_BAR; PG8_MMA(1, 0, At, B0); PG8_MMA(1, 1, At, B1); PG8_BAR; PG8_SCHED;
            PG8_LDB(B0, 1, 0); PG8_LDB(B1, 1, 1); PG8_SCHED; PG8_LDA(At, 1, 0); PG8_STAGEA(PG8_SA(0, 1), a2 + hstepA);
            PG8_WAIT_V(8); PG8_WAIT_L(0); PG8_BAR; PG8_MMA(0, 0, At, B0); PG8_MMA(0, 1, At, B1); PG8_BAR; PG8_SCHED;
            PG8_LDA(At, 1, 1); PG8_STAGEB(PG8_SB(1, 0), b3); PG8_STAGEB(PG8_SB(1, 1), b3 + hstepB); PG8_STAGEA(PG8_SA(1, 0), a3);
            PG8_WAIT_V(8); PG8_WAIT_L(0); PG8_BAR; PG8_MMA(1, 0, At, B0); PG8_MMA(1, 1, At, B1); PG8_BAR; PG8_SCHED;
            } else {
            PG8_LDB(B0, 0, 0); PG8_SCHED; PG8_LDA(At, 0, 0); PG8_STAGEA(PG8_SA(1, 1), a1 + hstepA);
            PG8_WAIT_L(8); PG8_BAR; PG8_WAIT_L(0); PG8_MMA(0, 0, At, B0); PG8_BAR; PG8_SCHED;
            PG8_LDB(B1, 0, 1); PG8_STAGEB(PG8_SB(0, 0), b2);
            PG8_BAR; PG8_WAIT_L(0); PG8_MMA(0, 1, At, B1); PG8_BAR;
            PG8_LDA(At, 0, 1); PG8_STAGEA(PG8_SA(0, 0), a2);
            PG8_BAR; PG8_WAIT_L(0); PG8_MMA(1, 0, At, B0); PG8_BAR; PG8_SCHED;
            PG8_STAGEB(PG8_SB(0, 1), b2 + hstepB);
            PG8_WAIT_V(6); PG8_BAR; PG8_MMA(1, 1, At, B1); PG8_BAR;
            PG8_LDB(B0, 1, 0); PG8_SCHED; PG8_LDA(At, 1, 0); PG8_STAGEA(PG8_SA(0, 1), a2 + hstepA);
            PG8_WAIT_L(8); PG8_BAR; PG8_WAIT_L(0); PG8_MMA(0, 0, At, B0); PG8_BAR; PG8_SCHED;
            PG8_LDB(B1, 1, 1); PG8_STAGEB(PG8_SB(1, 0), b3);
            PG8_BAR; PG8_WAIT_L(0); PG8_MMA(0, 1, At, B1); PG8_BAR;
            PG8_LDA(At, 1, 1); PG8_STAGEA(PG8_SA(1, 0), a3);
            PG8_BAR; PG8_WAIT_L(0); PG8_MMA(1, 0, At, B0); PG8_BAR; PG8_SCHED;
            PG8_STAGEB(PG8_SB(1, 1), b3 + hstepB);
            PG8_WAIT_V(6); PG8_BAR; PG8_MMA(1, 1, At, B1); PG8_BAR;
            }
        }
        if constexpr (ALIGN_EPI) { if (wr == 0) PG8_BAR; }
        E(acc, cur, wr, wc, fr, fq);
        if (!has_next) break;
#pragma unroll
        for (int a = 0; a < 2; ++a)
#pragma unroll
            for (int b = 0; b < 2; ++b)
#pragma unroll
                for (int m = 0; m < 4; ++m)
#pragma unroll
                    for (int n = 0; n < 2; ++n) acc[a][b][m][n] = (f32x4){0.f, 0.f, 0.f, 0.f};
        cur = nxt; cA = cur.a; ++ui;
        E.prefetch(cur, tid);
        if constexpr (ALIGN_EPI) { if (wr == 1) PG8_BAR; }
    }
    PG8_WAIT_V(0);
    if constexpr (!ALIGN_EPI) { if (wr == 0) PG8_BAR; }
    PG8_BAR;
#undef PG8_BP
#undef PG8_SA
#undef PG8_SB
#undef PG8_STAGEA
#undef PG8_STAGEB
#undef PG8_LDA
#undef PG8_LDB
#undef PG8_MMA
#undef PG8_WAIT_V
#undef PG8_WAIT_L
#undef PG8_BAR
#undef PG8_SCHED
}

struct SchedPlain {
    static constexpr int KSPLIT = 0;
    const char* A; const char* B; int lda, ldb, nM, nN, G, c;
    __device__ __forceinline__ const char* bbase() const { return B; }
    __device__ __forceinline__ bool next(int i, Unit& u) const {
        if (!static_tile(i, G, c, nM, nN, u.pm, u.pn)) return false;
        u.a = (unsigned)u.pm * BM * lda * 2; u.b0 = (unsigned)u.pn * BM * ldb * 2; u.b1 = u.b0; return true;
    }
};
struct SchedCols {
    static constexpr int KSPLIT = 0;
    const char* A; const char* B; int lda, ldb, nM, nN, G, c; unsigned mask;
    __device__ __forceinline__ const char* bbase() const { return B; }
    __device__ __forceinline__ bool next(int i, Unit& u) const {
        int pnj; if (!static_tile(i, G, c, nM, nN, u.pm, pnj)) return false;
        unsigned m = mask; for (int j = 0; j < pnj; ++j) m &= m - 1u;
        u.pn = __builtin_ctz(m);
        u.a = (unsigned)u.pm * BM * lda * 2; u.b0 = (unsigned)u.pn * BM * ldb * 2; u.b1 = u.b0; return true;
    }
};
__device__ __forceinline__ void cls_experts(int cls, int& e0, int& e1) {
    const int g = cls / 6, p = cls % 6;
    const int a = p < 3 ? 0 : (p < 5 ? 1 : 2);
    const int b = p < 3 ? p + 1 : (p < 5 ? p - 1 : 3);
    e0 = 4 * g + a; e1 = 4 * g + b;
}
template <bool FP8>
struct SchedMoeA {
    static constexpr int KSPLIT = 0;
    static constexpr int RB = FP8 ? 1024 : 2048;
    const char* A; const char* Wgu; const int* tilecls; int nM, G, c;
    __device__ __forceinline__ const char* bbase() const { return Wgu; }
    __device__ __forceinline__ bool next(int i, Unit& u) const {
        if (!static_tile(i, G, c, nM, 8, u.pm, u.pn)) return false;
        int e0, e1; cls_experts(__builtin_amdgcn_readfirstlane(tilecls[8 + u.pm]), e0, e1); const int e = (u.pn >> 2) ? e1 : e0;
        u.a = (unsigned)u.pm * BM * RB; u.b0 = (unsigned)e * 2097152u + (unsigned)(u.pn & 3) * 256 * RB; u.b1 = u.b0; return true;
    }
};
template <bool FP8>
struct SchedMoeB {
    static constexpr int KSPLIT = FP8 ? 4 : 8;
    static constexpr int RA = FP8 ? 1024 : 2048, RBB = FP8 ? 512 : 1024;
    const char* A; const char* Wd; const int* tilecls; int nM, G, c;
    __device__ __forceinline__ const char* bbase() const { return Wd; }
    __device__ __forceinline__ bool next(int i, Unit& u) const {
        if (!static_tile(i, G, c, nM, 4, u.pm, u.pn)) return false;
        int e0, e1; cls_experts(__builtin_amdgcn_readfirstlane(tilecls[8 + u.pm]), e0, e1);
        u.a = (unsigned)u.pm * BM * RA;
        u.b0 = (unsigned)e0 * 1048576u + (unsigned)u.pn * 256 * RBB; u.b1 = (unsigned)e1 * 1048576u + (unsigned)u.pn * 256 * RBB; return true;
    }
};

struct EpiStore {
    bf16_t* O; int ldc;
    __device__ __forceinline__ void prefetch(const Unit&, int) const {}
    __device__ __forceinline__ void operator()(const f32x4 (&acc)[2][2][4][2], const Unit& u, int wr, int wc, int fr, int fq) const {
        const int row0 = u.pm * BM + wr * 64 + fr, col0 = u.pn * BM + wc * 32 + 8 * fq;
#pragma unroll
        for (int ai = 0; ai < 2; ++ai)
#pragma unroll
            for (int m = 0; m < 4; ++m) { bf16_t* rowp = O + (size_t)(row0 + ai * HALF + m * 16) * ldc + col0;
#pragma unroll
                for (int bj = 0; bj < 2; ++bj) { const f32x4 v0 = acc[ai][bj][m][0], v1 = acc[ai][bj][m][1];
                    u32x4 w; w.x = cvt_pk_bf16(v0[0], v0[1]); w.y = cvt_pk_bf16(v0[2], v0[3]); w.z = cvt_pk_bf16(v1[0], v1[1]); w.w = cvt_pk_bf16(v1[2], v1[3]);
                    *(u32x4*)(rowp + bj * HALF) = w; } }
    }
};
struct EpiResid {
    bf16_t* O; const bf16_t* R;
    __device__ __forceinline__ void prefetch(const Unit& u, int tid) const {
        const bf16_t* p = R + (size_t)(u.pm * BM + (tid >> 1)) * 1024 + u.pn * BM + 128 * (tid & 1);
        asm volatile("s_mov_b32 m0, %2\n\ts_nop 0\n\tglobal_load_lds_dword %0, off\n\ts_mov_b32 m0, %3\n\ts_nop 0\n\tglobal_load_lds_dword %1, off"
                     :: "v"(p), "v"(p + 64), "s"(160768u), "s"(161024u) : "memory", "m0");
    }
    __device__ __forceinline__ void operator()(const f32x4 (&acc)[2][2][4][2], const Unit& u, int wr, int wc, int fr, int fq) const {
        const GAS bf16_t* const Rp = (const GAS bf16_t*)uniform_ptr(R); GAS bf16_t* const Op = (GAS bf16_t*)uniform_ptr(O);
        const unsigned base = (unsigned)(u.pm * BM + wr * 64 + fr) * 1024u + (unsigned)(u.pn * BM + wc * 32 + 8 * fq);
#pragma unroll
        for (int ai = 0; ai < 2; ++ai) {
            u32x4 r[4][2];
#pragma unroll
            for (int m = 0; m < 4; ++m)
#pragma unroll
                for (int bj = 0; bj < 2; ++bj) r[m][bj] = *(const GAS u32x4*)(Rp + (base + (unsigned)((ai * HALF + m * 16) * 1024 + bj * HALF)));
            __builtin_amdgcn_sched_barrier(0);
#pragma unroll
            for (int m = 0; m < 4; ++m)
#pragma unroll
                for (int bj = 0; bj < 2; ++bj) { const f32x4 v0 = acc[ai][bj][m][0], v1 = acc[ai][bj][m][1]; const u32x4 rr = r[m][bj];
                    u32x4 w; w.x = cvt_pk_bf16(v0[0] + ALPHA * bflo(rr.x), v0[1] + ALPHA * bfhi(rr.x)); w.y = cvt_pk_bf16(v0[2] + ALPHA * bflo(rr.y), v0[3] + ALPHA * bfhi(rr.y));
                    w.z = cvt_pk_bf16(v1[0] + ALPHA * bflo(rr.z), v1[1] + ALPHA * bfhi(rr.z)); w.w = cvt_pk_bf16(v1[2] + ALPHA * bflo(rr.w), v1[3] + ALPHA * bfhi(rr.w));
                    *(GAS u32x4*)(Op + (base + (unsigned)((ai * HALF + m * 16) * 1024 + bj * HALF))) = w; }
            __builtin_amdgcn_sched_barrier(0);
        }
    }
};
struct EpiSwiglu {
    bf16_t* H; const float* rowgate;
    __device__ __forceinline__ void prefetch(const Unit&, int) const {}
    __device__ __forceinline__ void operator()(const f32x4 (&acc)[2][2][4][2], const Unit& u, int wr, int wc, int fr, int fq) const {
        const int row0 = u.pm * BM + wr * 64 + fr, ke = u.pn >> 2, col0 = 512 * ke + 128 * (u.pn & 3) + wc * 32 + 8 * fq;
#pragma unroll
        for (int ai = 0; ai < 2; ++ai)
#pragma unroll
            for (int m = 0; m < 4; ++m) { const int row = row0 + ai * HALF + m * 16; const float gt = rowgate[(size_t)row * 2 + ke];
                const f32x4 g0 = acc[ai][0][m][0], g1 = acc[ai][0][m][1], u0 = acc[ai][1][m][0], u1 = acc[ai][1][m][1];
                float o[8];
#pragma unroll
                for (int j = 0; j < 4; ++j) { o[j] = siluf_(g0[j]) * u0[j] * gt; o[4 + j] = siluf_(g1[j]) * u1[j] * gt; }
                u32x4 w; w.x = cvt_pk_bf16(o[0], o[1]); w.y = cvt_pk_bf16(o[2], o[3]); w.z = cvt_pk_bf16(o[4], o[5]); w.w = cvt_pk_bf16(o[6], o[7]);
                *(u32x4*)(H + (size_t)row * 1024 + col0) = w; }
    }
};
struct EpiSwiglu8 {
    unsigned char* H; const float* rowgate;
    __device__ __forceinline__ void prefetch(const Unit&, int) const {}
    __device__ __forceinline__ void operator()(const f32x4 (&acc)[2][2][4][2], const Unit& u, int wr, int wc, int fr, int fq) const {
        typedef unsigned u32x2 __attribute__((ext_vector_type(2)));
        const int row0 = u.pm * BM + wr * 64 + fr, ke = u.pn >> 2, col0 = 512 * ke + 128 * (u.pn & 3) + wc * 32 + 8 * fq;
        GAS unsigned char* const H = (GAS unsigned char*)uniform_ptr(this->H); const GAS float* const rowgate = (const GAS float*)uniform_ptr(this->rowgate);
        float gts[2][4];
#pragma unroll
        for (int ai = 0; ai < 2; ++ai)
#pragma unroll
            for (int m = 0; m < 4; ++m) gts[ai][m] = rowgate[(unsigned)(row0 + ai * HALF + m * 16) * 2u + (unsigned)ke];
        __builtin_amdgcn_sched_barrier(0);
#pragma unroll
        for (int ai = 0; ai < 2; ++ai)
#pragma unroll
            for (int m = 0; m < 4; ++m) { const int row = row0 + ai * HALF + m * 16; const float gt = gts[ai][m] * 8.f;
                const f32x4 g0 = acc[ai][0][m][0], g1 = acc[ai][0][m][1], u0 = acc[ai][1][m][0], u1 = acc[ai][1][m][1];
                float o[8];
#pragma unroll
                for (int j = 0; j < 4; ++j) { o[j] = __builtin_amdgcn_fmed3f(g0[j] * __builtin_amdgcn_rcpf(1.f + __builtin_amdgcn_exp2f(-1.4426950408889634f * g0[j])) * u0[j] * gt, -440.f, 440.f);
                    o[4 + j] = __builtin_amdgcn_fmed3f(g1[j] * __builtin_amdgcn_rcpf(1.f + __builtin_amdgcn_exp2f(-1.4426950408889634f * g1[j])) * u1[j] * gt, -440.f, 440.f); }
                *(GAS u32x2*)(H + ((unsigned)row * 1024u + (unsigned)col0)) = (u32x2){pk4_fp8(o[0], o[1], o[2], o[3]), pk4_fp8(o[4], o[5], o[6], o[7])}; }
    }
};
}

struct Params {
    const float* in[30];
    unsigned char* out;
    unsigned char* ws;
};
enum { I_X = 0, I_POS, I_WINAB, I_RETG, I_MLCW, I_MLCB, I_MLBI, I_MLBF, I_MLG, I_WOUTAB, I_WINCD, I_GLAWA, I_GLABA, I_GLAG, I_SSDCW, I_SSDCB, I_SSDDTB, I_SSDALOG, I_SSDD, I_SSDG,
       I_WOUTCD, I_WR, I_BR, I_MOEG, I_MOEU, I_MOED, I_LNMG, I_LNMB, I_LNFG, I_LNFB };

template <class ColPtr>
__device__ __forceinline__ void tr_item(const ColPtr& cp, int ldw, bf16_t* WT, int ldt, int n0, int k0, LAS float* scr, int lane) {
    const float* p = cp(n0 + (lane & 31));
#pragma unroll 8
    for (int i = 0; i < 32; ++i) { const int kk = 2 * i + (lane >> 5); scr[kk * 33 + (lane & 31)] = p ? p[(size_t)(k0 + kk) * ldw] : 0.f; }
    LDS_WAIT();
    const int c = lane & 7;
#pragma unroll
    for (int j = 0; j < 4; ++j) { const int n = (lane >> 3) + 8 * j; const LAS float* s = scr + (8 * c) * 33 + n;
        u32x4 o; o.x = pk2(s[0 * 33], s[1 * 33]); o.y = pk2(s[2 * 33], s[3 * 33]); o.z = pk2(s[4 * 33], s[5 * 33]); o.w = pk2(s[6 * 33], s[7 * 33]);
        *(u32x4*)(WT + (size_t)(n0 + n) * ldt + k0 + 8 * c) = o; }
    LDS_WAIT();
}
template <class ColPtr>
__device__ __forceinline__ void tr_item_fp8(const ColPtr& cp, int ldw, unsigned char* WT, int ldt, int n0, int k0, float scale, LAS float* scr, int lane) {
    const float* p = cp(n0 + (lane & 31));
#pragma unroll 8
    for (int i = 0; i < 32; ++i) { const int kk = 2 * i + (lane >> 5); scr[kk * 33 + (lane & 31)] = p ? p[(size_t)(k0 + kk) * ldw] * scale : 0.f; }
    LDS_WAIT();
    const int c = lane & 7;
    typedef unsigned u32x2 __attribute__((ext_vector_type(2)));
#pragma unroll
    for (int j = 0; j < 4; ++j) { const int n = (lane >> 3) + 8 * j; const LAS float* s = scr + (8 * c) * 33 + n;
        *(u32x2*)(WT + (size_t)(n0 + n) * ldt + k0 + 8 * c) = (u32x2){pk4_fp8(s[0 * 33], s[1 * 33], s[2 * 33], s[3 * 33]), pk4_fp8(s[4 * 33], s[5 * 33], s[6 * 33], s[7 * 33])}; }
    LDS_WAIT();
}
__device__ __forceinline__ int map_ab(int n) {
    if (n < 2048) return n;
    if (n < 3072) return 4096 + (n - 2048);
    if (n < 4096) return 2048 + (n - 3072);
    if (n < 4608) return 3072 + (n - 4096);
    if (n < 5120) return 3584 + (n - 4608);
    if (n < 6152) return n;
    return -1;
}
__device__ __forceinline__ int map_cd(int n) {
    if (n < 2048) return n;
    if (n < 3072) return 3088 + (n - 2048);
    if (n < 4096) return 2048 + (n - 3072);
    if (n < 5120) return 4112 + (n - 4096);
    if (n < 5632) return 5136 + (n - 5120);
    if (n < 6144) return 5648 + (n - 5632);
    if (n < 6160) return 3072 + (n - 6144);
    if (n < 6176) return 6160 + (n - 6160);
    return -1;
}
template <bool FP8, class ColPtr>
__device__ __forceinline__ void tr_block(const ColPtr& cp, int ldw, void* WT, int ldt, int n0, int k0, float scale, LAS float* tile, int tid) {
    {   const int c4 = tid & 63, r0 = tid >> 6;
        const float* p = cp(n0 + 4 * c4);
        f32x4 v[8];
#pragma unroll
        for (int i = 0; i < 8; ++i) v[i] = p ? *(const f32x4*)(p + (size_t)(k0 + r0 + 8 * i) * ldw) : (f32x4){0.f, 0.f, 0.f, 0.f};
#pragma unroll
        for (int i = 0; i < 8; ++i) { LAS float* t = tile + (r0 + 8 * i) * 257 + 4 * c4; t[0] = v[i][0] * scale; t[1] = v[i][1] * scale; t[2] = v[i][2] * scale; t[3] = v[i][3] * scale; }
    }
    __syncthreads();
    {   const int kc = tid & 7, nr = tid >> 3;
#pragma unroll
        for (int j = 0; j < 4; ++j) { const int n = nr + 64 * j; const LAS float* t = tile + (8 * kc) * 257 + n;
            if constexpr (FP8) { typedef unsigned u32x2 __attribute__((ext_vector_type(2)));
                *(u32x2*)((unsigned char*)WT + (size_t)(n0 + n) * ldt + k0 + 8 * kc) = (u32x2){pk4_fp8(t[0], t[257], t[514], t[771]), pk4_fp8(t[1028], t[1285], t[1542], t[1799])}; }
            else { u32x4 o; o.x = pk2(t[0], t[257]); o.y = pk2(t[514], t[771]); o.z = pk2(t[1028], t[1285]); o.w = pk2(t[1542], t[1799]);
                *(u32x4*)((bf16_t*)WT + (size_t)(n0 + n) * ldt + k0 + 8 * kc) = o; } }
    }
    __syncthreads();
}
__device__ __forceinline__ void convert_moe(const Params& P, LAS unsigned char* lds, int bid, int nb) {
    const int tid = opaque_tid();
    LAS float* tile = (LAS float*)lds;
    unsigned char* ws = P.ws;
    constexpr int B_GU = (1024 / 256) * (1024 / 64);
    constexpr int B_DN = (1024 / 256) * (512 / 64);
    constexpr int B_IN = (NP / 256) * (D / 64);
    constexpr int B_OUT = (1024 / 256) * (2048 / 64);
#pragma unroll 1
    for (int it = bid; it < 32 * B_GU + 32 * B_DN + B_IN + 2 * B_OUT; it += nb) {
        int r = it;
        if (r < B_IN) { const int nbk = r / (D / 64), kb = r % (D / 64);
            const float* W = P.in[I_WINCD];
            auto cp = [&](int n) { const int sc = map_cd(n); return sc < 0 ? (const float*)nullptr : W + sc; };
            if ((INPROJ_FP8MASK1 >> nbk) & 1u) tr_block<true>(cp, 6176, ws + WS_WIN8_1, D, nbk * 256, kb * 64, W8_SCALE, tile, tid); else tr_block<false>(cp, 6176, ws + WS_WIN1, D, nbk * 256, kb * 64, 1.f, tile, tid);
            continue; }
        r -= B_IN;
        if (r < 2 * B_OUT) { const int l = r / B_OUT; r %= B_OUT; const int nbk = r / 32, kb = r % 32;
            const float* W = P.in[l ? I_WOUTCD : I_WOUTAB];
            tr_block<false>([&](int n) { return W + n; }, 1024, ws + (l ? WS_WOUT1 : WS_WOUT0), 2048, nbk * 256, kb * 64, 1.f, tile, tid);
            continue; }
        r -= 2 * B_OUT;
        if (r < 32 * B_GU) { const int le = r / B_GU; r %= B_GU; const int nbk = r / 16, kb = r % 16;
            const float* Wg = P.in[I_MOEG] + (size_t)le * 1024 * 512 + 128 * nbk; const float* Wu = P.in[I_MOEU] + (size_t)le * 1024 * 512 + 128 * nbk; const int n0 = nbk * 256;
            auto cp = [&](int n) { const int wdt = n - n0; return wdt < 128 ? Wg + wdt : Wu + (wdt - 128); };
            if (MOE_FP8(le >> 4) && MOEA_FP8) tr_block<true>(cp, 512, ws + WS_WGU + (size_t)le * 2097152, 1024, n0, kb * 64, W8_SCALE, tile, tid);
            else tr_block<false>(cp, 512, ws + WS_WGU + (size_t)le * 2097152, 1024, n0, kb * 64, 1.f, tile, tid);
            continue; }
        r -= 32 * B_GU;
        { const int le = r / B_DN; r %= B_DN; const int nbk = r / 8, kb = r % 8;
            const float* W = P.in[I_MOED] + (size_t)le * 512 * 1024;
            if (MOE_FP8(le >> 4)) tr_block<true>([&](int n) { return W + n; }, 1024, ws + WS_WD + (size_t)le * 1048576, 512, nbk * 256, kb * 64, W8_SCALE, tile, tid);
            else tr_block<false>([&](int n) { return W + n; }, 1024, ws + WS_WD + (size_t)le * 1048576, 512, nbk * 256, kb * 64, 1.f, tile, tid); }
    }
}
__device__ __forceinline__ void phase_convert(const Params& P, LAS unsigned char* lds, int bid, int nb) {
    const int tid = opaque_tid();
    LAS float* tile = (LAS float*)lds;
    unsigned char* ws = P.ws;
    constexpr int B_IN = (NP / 256) * (D / 64);
    tp_begin(lds, 910);
#pragma unroll 1
    for (int it = bid; it < B_IN; it += nb) {
        const int nbk = it / (D / 64), kb = it % (D / 64);
        const float* W = P.in[I_WINAB];
        auto cp = [&](int n) { const int sc = map_ab(n); return sc < 0 ? (const float*)nullptr : W + sc; };
        if ((INPROJ_FP8MASK0 >> nbk) & 1u) tr_block<true>(cp, 6152, ws + WS_WIN8_0, D, nbk * 256, kb * 64, W8_SCALE, tile, tid); else tr_block<false>(cp, 6152, ws + WS_WIN0, D, nbk * 256, kb * 64, 1.f, tile, tid);
    }
    const int nw = blockDim.x >> 6; (void)nw;
    asm volatile("s_waitcnt vmcnt(0)" ::: "memory"); tp_end(lds, 910); tp_begin(lds, 911);
    const float* x = P.in[I_X]; bf16_t* h = (bf16_t*)(P.out + OUT_H);
    const size_t n8 = (size_t)T * D / 8;
    const size_t stride = (size_t)nb * blockDim.x;
    for (size_t i0 = (size_t)bid * blockDim.x + tid; i0 < n8; i0 += 4 * stride) {
        f32x4 a[4], b[4];
#pragma unroll
        for (int u = 0; u < 4; ++u) { const size_t i = i0 + u * stride; if (i < n8) { a[u] = *(const f32x4*)(x + i * 8); b[u] = *(const f32x4*)(x + i * 8 + 4); } }
#pragma unroll
        for (int u = 0; u < 4; ++u) { const size_t i = i0 + u * stride; if (i < n8) {
            u32x4 o; o.x = pk2(a[u][0], a[u][1]); o.y = pk2(a[u][2], a[u][3]); o.z = pk2(b[u][0], b[u][1]); o.w = pk2(b[u][2], b[u][3]);
            *(u32x4*)(h + i * 8) = o;
            typedef unsigned u32x2 __attribute__((ext_vector_type(2)));
            *(u32x2*)(ws + WS_H8 + i * 8) = (u32x2){pk4_fp8(a[u][0] * H8_SCALE, a[u][1] * H8_SCALE, a[u][2] * H8_SCALE, a[u][3] * H8_SCALE), pk4_fp8(b[u][0] * H8_SCALE, b[u][1] * H8_SCALE, b[u][2] * H8_SCALE, b[u][3] * H8_SCALE)}; } }
    }
    asm volatile("s_waitcnt vmcnt(0)" ::: "memory"); tp_end(lds, 911);
}

__device__ __forceinline__ void load_row_bf16(const bf16_t* row, int lane, float (&v)[16]) {
#pragma unroll
    for (int j = 0; j < 2; ++j) { const u32x4 w = *(const u32x4*)(row + 8 * lane + 512 * j);
        v[8 * j + 0] = bflo(w.x); v[8 * j + 1] = bfhi(w.x); v[8 * j + 2] = bflo(w.y); v[8 * j + 3] = bfhi(w.y);
        v[8 * j + 4] = bflo(w.z); v[8 * j + 5] = bfhi(w.z); v[8 * j + 6] = bflo(w.w); v[8 * j + 7] = bfhi(w.w); }
}
__device__ __forceinline__ void ln_row(float (&v)[16], const float* g, const float* b, int lane) {
    float s = 0.f;
#pragma unroll
    for (int i = 0; i < 16; ++i) s += v[i];
    const float mean = wave_sum(s) * (1.f / D); float q = 0.f;
#pragma unroll
    for (int i = 0; i < 16; ++i) { v[i] -= mean; q += v[i] * v[i]; }
    const float rstd = rsqrtf(wave_sum(q) * (1.f / D) + LN_EPS);
#pragma unroll
    for (int j = 0; j < 2; ++j) {
        const f32x4 g0 = *(const f32x4*)(g + 8 * lane + 512 * j), g1 = *(const f32x4*)(g + 8 * lane + 512 * j + 4);
        const f32x4 b0 = *(const f32x4*)(b + 8 * lane + 512 * j), b1 = *(const f32x4*)(b + 8 * lane + 512 * j + 4);
#pragma unroll
        for (int i = 0; i < 4; ++i) { v[8 * j + i] = v[8 * j + i] * rstd * g0[i] + b0[i]; v[8 * j + 4 + i] = v[8 * j + 4 + i] * rstd * g1[i] + b1[i]; }
    }
}
__device__ __forceinline__ void load_gb(const float* g, const float* b, int lane, float (&gr)[16], float (&br)[16]) {
#pragma unroll
    for (int j = 0; j < 2; ++j) {
        const f32x4 g0 = *(const f32x4*)(g + 8 * lane + 512 * j), g1 = *(const f32x4*)(g + 8 * lane + 512 * j + 4);
        const f32x4 b0 = *(const f32x4*)(b + 8 * lane + 512 * j), b1 = *(const f32x4*)(b + 8 * lane + 512 * j + 4);
#pragma unroll
        for (int i = 0; i < 4; ++i) { gr[8 * j + i] = g0[i]; gr[8 * j + 4 + i] = g1[i]; br[8 * j + i] = b0[i]; br[8 * j + 4 + i] = b1[i]; }
    }
}
__device__ __forceinline__ void ln_row_r(float (&v)[16], const float (&gr)[16], const float (&br)[16]) {
    float s = 0.f;
#pragma unroll
    for (int i = 0; i < 16; ++i) s += v[i];
    const float mean = wave_sum(s) * (1.f / D); float q = 0.f;
#pragma unroll
    for (int i = 0; i < 16; ++i) { v[i] -= mean; q += v[i] * v[i]; }
    const float rstd = rsqrtf(wave_sum(q) * (1.f / D) + LN_EPS);
#pragma unroll
    for (int i = 0; i < 16; ++i) v[i] = v[i] * rstd * gr[i] + br[i];
}
__device__ __forceinline__ void store_row_bf16(bf16_t* row, int lane, const float (&v)[16]) {
#pragma unroll
    for (int j = 0; j < 2; ++j) { u32x4 o; o.x = pk2(v[8 * j + 0], v[8 * j + 1]); o.y = pk2(v[8 * j + 2], v[8 * j + 3]); o.z = pk2(v[8 * j + 4], v[8 * j + 5]); o.w = pk2(v[8 * j + 6], v[8 * j + 7]);
        *(u32x4*)(row + 8 * lane + 512 * j) = o; }
}

__device__ __forceinline__ void phase_route(const Params& P, int layer, LAS unsigned char* lds, int bid, int nb, int cntoff) {
    const int tid = opaque_tid(), lane = tid & 63, wave = tid >> 6;
    LAS unsigned char* Bhi = lds; LAS unsigned char* Blo = lds + 32768;
    LAS float* cd = (LAS float*)(lds + 65536);
    LAS float* part = cd + 32;
    LAS int* lcnt = (LAS int*)(part + 1024);
    LAS int* lbase = lcnt + 32; LAS int* rcls = lbase + 32; LAS int* rpos = rcls + 256;
    const bf16_t* pre1 = (const bf16_t*)(P.out + OUT_PRE1);
    const float* g = P.in[I_LNMG] + layer * D; const float* b = P.in[I_LNMB] + layer * D;
    const float* Wr = P.in[I_WR]; const float* br = P.in[I_BR];
    int* tokcls = (int*)(P.ws + WS_TOKCLS); int* tokpos = (int*)(P.ws + WS_TOKPOS); float* tokgate = (float*)(P.ws + WS_TOKGATE);
    unsigned* gcnt = (unsigned*)(P.ws + WS_CTL) + CW_CNT + 64 * layer + cntoff;
#pragma unroll 1
    for (int idx = tid; idx < 2048; idx += NTHREADS_C) {
        const int s = idx >> 6, l = idx & 63, e = l & 15, k0 = 32 * s + 8 * (l >> 4);
        unsigned hi[4], lo[4];
#pragma unroll
        for (int j = 0; j < 4; ++j) {
            const float w0 = g[k0 + 2 * j] * Wr[(k0 + 2 * j) * 16 + e], w1 = g[k0 + 2 * j + 1] * Wr[(k0 + 2 * j + 1) * 16 + e];
            const unsigned h0 = f2bf(w0), h1 = f2bf(w1);
            hi[j] = h0 | (h1 << 16); lo[j] = pk2(w0 - bf2f((unsigned short)h0), w1 - bf2f((unsigned short)h1)); }
        *(LAS u32x4*)(Bhi + idx * 16) = (u32x4){hi[0], hi[1], hi[2], hi[3]};
        *(LAS u32x4*)(Blo + idx * 16) = (u32x4){lo[0], lo[1], lo[2], lo[3]};
    }
    { const int e = tid & 15, pt = tid >> 4; float cs = 0.f, ds = 0.f;
#pragma unroll 4
      for (int kk = 0; kk < 32; ++kk) { const int k = pt * 32 + kk; const float w = Wr[k * 16 + e]; cs += g[k] * w; ds += b[k] * w; }
      part[pt * 32 + e] = cs; part[pt * 32 + 16 + e] = ds; }
    __syncthreads();
    if (tid < 32) { float sacc = 0.f;
#pragma unroll 4
        for (int pt = 0; pt < 32; ++pt) sacc += part[pt * 32 + tid];
        cd[tid] = sacc; }
    __syncthreads();
    const int e = lane & 15, q = lane >> 4;
    const float ce = cd[e], de = cd[16 + e], bre = br[e];
    for (int r0 = bid * 256; r0 < T; r0 += nb * 256) {
        if (tid < 32) lcnt[tid] = 0;
        __syncthreads();
#pragma unroll 1
        for (int tile = 0; tile < 2; ++tile) {
            const int tr0 = wave * 32 + tile * 16;
            const bf16_t* arow = pre1 + (size_t)(r0 + tr0 + e) * D + 8 * q;
            f32x4 acc = (f32x4){0.f, 0.f, 0.f, 0.f}; float s1 = 0.f, s2 = 0.f;
#pragma unroll 1
            for (int s0 = 0; s0 < 32; s0 += 8) {
                u32x4 a[8];
#pragma unroll
                for (int u = 0; u < 8; ++u) a[u] = *(const u32x4*)(arow + 32 * (s0 + u));
#pragma unroll
                for (int u = 0; u < 8; ++u) {
                    const bf16x8 bh = *(const LAS bf16x8*)(Bhi + ((s0 + u) * 64 + lane) * 16), bl = *(const LAS bf16x8*)(Blo + ((s0 + u) * 64 + lane) * 16);
                    const bf16x8 af = __builtin_bit_cast(bf16x8, a[u]);
                    acc = __builtin_amdgcn_mfma_f32_16x16x32_bf16(af, bh, acc, 0, 0, 0);
                    acc = __builtin_amdgcn_mfma_f32_16x16x32_bf16(af, bl, acc, 0, 0, 0);
                    const float x0 = bflo(a[u].x), x1 = bfhi(a[u].x), x2 = bflo(a[u].y), x3 = bfhi(a[u].y), x4 = bflo(a[u].z), x5 = bfhi(a[u].z), x6 = bflo(a[u].w), x7 = bfhi(a[u].w);
                    s1 += ((x0 + x1) + (x2 + x3)) + ((x4 + x5) + (x6 + x7));
                    s2 += ((x0 * x0 + x1 * x1) + (x2 * x2 + x3 * x3)) + ((x4 * x4 + x5 * x5) + (x6 * x6 + x7 * x7));
                }
            }
            s1 += __shfl_xor(s1, 16); s1 += __shfl_xor(s1, 32); s2 += __shfl_xor(s2, 16); s2 += __shfl_xor(s2, 32);
            const float mean = s1 * (1.f / D); const float rstd = rsqrtf(fmaxf(s2 * (1.f / D) - mean * mean, 0.f) + LN_EPS);
#pragma unroll
            for (int r = 0; r < 4; ++r) {
                const int R = 4 * q + r;
                const float mr = __shfl(mean, R), rr = __shfl(rstd, R);
                const float lg = rr * (acc[r] - mr * ce) + de;
                float mx = lg;
#pragma unroll
                for (int o = 1; o < 16; o <<= 1) mx = fmaxf(mx, __shfl_xor(mx, o));
                float p = expf(lg - mx), sum = p;
#pragma unroll
                for (int o = 1; o < 16; o <<= 1) sum += __shfl_xor(sum, o);
                p = p / sum;
                const float sel = p + bre;
                int rank = 0;
#pragma unroll
                for (int o = 1; o < 4; ++o) { const float so = __shfl_xor(sel, o); const int eo = e ^ o; rank += (so > sel || (so == sel && eo < e)) ? 1 : 0; }
                float gs = rank < 2 ? sel : 0.f;
                gs += __shfl_xor(gs, 1); gs += __shfl_xor(gs, 2);
                int gi = e >> 2;
#pragma unroll
                for (int o = 4; o < 16; o <<= 1) { const float go = __shfl_xor(gs, o); const int io = __shfl_xor(gi, o); if (go > gs || (go == gs && io < gi)) { gs = go; gi = io; } }
                const bool chosen = ((e >> 2) == gi) && rank < 2;
                const unsigned long long bm = __ballot(chosen);
                const unsigned m4 = (unsigned)(bm >> (16 * q + 4 * gi)) & 0xFu;
                const int ea = __ffs((int)m4) - 1, eb = 31 - __clz((int)m4);
                const int pidx = ea == 0 ? eb - 1 : (ea == 1 ? eb + 1 : 5);
                const float pa = __shfl(p, 16 * q + 4 * gi + ea), pb = __shfl(p, 16 * q + 4 * gi + eb);
                if (e == r) { const int cls = gi * 6 + pidx; const int rl = tr0 + R; const int lp = atomicAdd((int*)&lcnt[cls], 1); rcls[rl] = cls; rpos[rl] = lp;
                    const float inv = 1.f / (pa + pb); const size_t t = (size_t)(r0 + rl); tokgate[t * 2] = pa * inv; tokgate[t * 2 + 1] = pb * inv; }
            }
        }
        __syncthreads();
        if (tid < NCLS) lbase[tid] = (int)atomicAdd(&gcnt[tid], (unsigned)lcnt[tid]);
        __syncthreads();
        if (tid < 256) { const int t = r0 + tid; const int c = rcls[tid]; tokcls[t] = c; tokpos[t] = lbase[c] + rpos[tid]; }
        __syncthreads();
    }
}
__device__ __forceinline__ void phase_permute(const Params& P, int layer, LAS unsigned char* lds, int bid, int nb) {
    const int tid = opaque_tid(), lane = tid & 63, wave = tid >> 6, nw = blockDim.x >> 6;
    LAS int* off = (LAS int*)lds;
    const unsigned* gcnt = (const unsigned*)(P.ws + WS_CTL) + CW_CNT + 64 * layer;
    int* tilecls = (int*)(P.ws + WS_TILECLS);
    if (tid == 0) { int o = 0; for (int c = 0; c < NCLS; ++c) { off[c] = o * 256; const int nt = ((int)gcnt[c] + 255) >> 8;
            if (bid == 0) for (int i = 0; i < nt; ++i) tilecls[8 + o + i] = c;
            o += nt; }
        if (bid == 0) tilecls[0] = o; }
    __syncthreads();
    const bf16_t* pre1 = (const bf16_t*)(P.out + OUT_PRE1); bf16_t* hs = (bf16_t*)(P.ws + WS_BIG + BIG_HS);
    const float* g = P.in[I_LNMG] + layer * D; const float* b = P.in[I_LNMB] + layer * D;
    const int* tokcls = (const int*)(P.ws + WS_TOKCLS); const int* tokpos = (const int*)(P.ws + WS_TOKPOS); int* tokdst = (int*)(P.ws + WS_TOKDST);
    const float* tokgate = (const float*)(P.ws + WS_TOKGATE); float* rowgate = (float*)(P.ws + WS_ROWGATE);
    float gr[16], br[16]; load_gb(g, b, lane, gr, br);
    for (int t0 = bid * nw + wave; t0 < T; t0 += 2 * nb * nw) {
        const int t1 = t0 + nb * nw; const bool has1 = t1 < T;
        float v0[16], v1[16];
        load_row_bf16(pre1 + (size_t)t0 * D, lane, v0);
        if (has1) load_row_bf16(pre1 + (size_t)t1 * D, lane, v1);
        const int dst0 = off[tokcls[t0]] + tokpos[t0]; const int dst1 = has1 ? off[tokcls[t1]] + tokpos[t1] : 0;
#pragma unroll
        for (int rr = 0; rr < 2; ++rr) {
            if (rr == 1 && !has1) break;
            float (&v)[16] = rr ? v1 : v0; const int t = rr ? t1 : t0, dst = rr ? dst1 : dst0;
            ln_row_r(v, gr, br);
            store_row_bf16(hs + (size_t)dst * D, lane, v);
            if (MOE_FP8(layer) && MOEA_FP8) { typedef unsigned u32x2 __attribute__((ext_vector_type(2)));
#pragma unroll
                for (int j = 0; j < 2; ++j) *(u32x2*)(P.ws + WS_BIG + BIG_HS8 + (size_t)dst * D + 8 * lane + 512 * j) = (u32x2){pk4_fp8(v[8 * j] * H8_SCALE, v[8 * j + 1] * H8_SCALE, v[8 * j + 2] * H8_SCALE, v[8 * j + 3] * H8_SCALE), pk4_fp8(v[8 * j + 4] * H8_SCALE, v[8 * j + 5] * H8_SCALE, v[8 * j + 6] * H8_SCALE, v[8 * j + 7] * H8_SCALE)}; }
            if (lane == 0) { tokdst[t] = dst; rowgate[(size_t)dst * 2] = tokgate[(size_t)t * 2]; rowgate[(size_t)dst * 2 + 1] = tokgate[(size_t)t * 2 + 1]; }
        }
    }
}
__device__ __forceinline__ void phase_lnffn(const Params& P, int layer, int bid, int nb) {
    const int tid = opaque_tid(), lane = tid & 63, wave = tid >> 6, nw = blockDim.x >> 6;
    const bf16_t* pre2 = (const bf16_t*)(P.ws + WS_BIG + BIG_PRE2);
    const float* g = P.in[I_LNFG] + layer * D; const float* b = P.in[I_LNFB] + layer * D;
    const int* tokdst = (const int*)(P.ws + WS_TOKDST);
    float gr[16], br[16]; load_gb(g, b, lane, gr, br);
    for (int t0 = bid * nw + wave; t0 < T; t0 += 2 * nb * nw) {
        const int t1 = t0 + nb * nw; const bool has1 = t1 < T;
        float v0[16], v1[16];
        load_row_bf16(pre2 + (size_t)tokdst[t0] * D, lane, v0);
        if (has1) load_row_bf16(pre2 + (size_t)tokdst[t1] * D, lane, v1);
#pragma unroll
        for (int rr = 0; rr < 2; ++rr) {
            if (rr == 1 && !has1) break;
            float (&v)[16] = rr ? v1 : v0; const int t = rr ? t1 : t0;
            ln_row_r(v, gr, br);
            if (layer == 0) { store_row_bf16((bf16_t*)(P.out + OUT_H) + (size_t)t * D, lane, v);
                typedef unsigned u32x2 __attribute__((ext_vector_type(2)));
#pragma unroll
                for (int j = 0; j < 2; ++j) *(u32x2*)(P.ws + WS_H8 + (size_t)t * D + 8 * lane + 512 * j) = (u32x2){pk4_fp8(v[8 * j] * H8_SCALE, v[8 * j + 1] * H8_SCALE, v[8 * j + 2] * H8_SCALE, v[8 * j + 3] * H8_SCALE), pk4_fp8(v[8 * j + 4] * H8_SCALE, v[8 * j + 5] * H8_SCALE, v[8 * j + 6] * H8_SCALE, v[8 * j + 7] * H8_SCALE)}; }
            else { float* o = (float*)P.out + (size_t)t * D;
#pragma unroll
                for (int j = 0; j < 2; ++j) { *(f32x4*)(o + 8 * lane + 512 * j) = (f32x4){v[8 * j], v[8 * j + 1], v[8 * j + 2], v[8 * j + 3]}; *(f32x4*)(o + 8 * lane + 512 * j + 4) = (f32x4){v[8 * j + 4], v[8 * j + 5], v[8 * j + 6], v[8 * j + 7]}; } }
        }
    }
}

enum { MIX_RET = 0, MIX_ML = 1, MIX_GLA = 2, MIX_SSD = 3 };
typedef short s16x4 __attribute__((ext_vector_type(4)));
__device__ __forceinline__ bf16x8 tr_frag(LAS unsigned char* p0, LAS unsigned char* p1) {
    const s16x4 a = __builtin_amdgcn_ds_read_tr16_b64_v4i16((LAS s16x4*)p0), b = __builtin_amdgcn_ds_read_tr16_b64_v4i16((LAS s16x4*)p1);
    return (bf16x8){a[0], a[1], a[2], a[3], b[0], b[1], b[2], b[3]};
}
__device__ __forceinline__ bf16x8 cat_frag(LAS unsigned char* p0, LAS unsigned char* p1) {
    const s16x4 a = *(LAS s16x4*)p0, b = *(LAS s16x4*)p1;
    return (bf16x8){a[0], a[1], a[2], a[3], b[0], b[1], b[2], b[3]};
}
__device__ __forceinline__ bf16x8 pack_acc(const f32x4& lo, const f32x4& hi) {
    u32x4 w; w.x = pg8::cvt_pk_bf16(lo[0], lo[1]); w.y = pg8::cvt_pk_bf16(lo[2], lo[3]); w.z = pg8::cvt_pk_bf16(hi[0], hi[1]); w.w = pg8::cvt_pk_bf16(hi[2], hi[3]);
    return __builtin_bit_cast(bf16x8, w);
}
__device__ __forceinline__ void unpack8(const u32x4& w, float (&v)[8]) {
    v[0] = bflo(w.x); v[1] = bfhi(w.x); v[2] = bflo(w.y); v[3] = bfhi(w.y); v[4] = bflo(w.z); v[5] = bfhi(w.z); v[6] = bflo(w.w); v[7] = bfhi(w.w);
}
__device__ __forceinline__ u32x4 pack8(const float (&v)[8]) {
    u32x4 w; w.x = pg8::cvt_pk_bf16(v[0], v[1]); w.y = pg8::cvt_pk_bf16(v[2], v[3]); w.z = pg8::cvt_pk_bf16(v[4], v[5]); w.w = pg8::cvt_pk_bf16(v[6], v[7]); return w;
}

template <int CTRL, int RM> __device__ __forceinline__ float dpp_take(float old, float v) { return __builtin_bit_cast(float, __builtin_amdgcn_update_dpp(__builtin_bit_cast(int, old), __builtin_bit_cast(int, v), CTRL, RM, 0xf, false)); }
__device__ __forceinline__ float wave_scan_add(float v) {
    v += dpp_take<0x111, 0xf>(0.f, v); v += dpp_take<0x112, 0xf>(0.f, v); v += dpp_take<0x114, 0xf>(0.f, v); v += dpp_take<0x118, 0xf>(0.f, v);
    v += dpp_take<0x142, 0xa>(0.f, v); v += dpp_take<0x143, 0xc>(0.f, v); return v; }
__device__ __forceinline__ float wave_scan_max(float v) {
    const float ni = -3.0e38f;
    v = fmaxf(v, dpp_take<0x111, 0xf>(ni, v)); v = fmaxf(v, dpp_take<0x112, 0xf>(ni, v)); v = fmaxf(v, dpp_take<0x114, 0xf>(ni, v)); v = fmaxf(v, dpp_take<0x118, 0xf>(ni, v));
    v = fmaxf(v, dpp_take<0x142, 0xa>(ni, v)); v = fmaxf(v, dpp_take<0x143, 0xc>(ni, v)); return v; }
__device__ __forceinline__ float fexp(float x) { return __builtin_amdgcn_exp2f(x * 1.4426950408889634f); }
__device__ __forceinline__ float frcp(float x) { return __builtin_amdgcn_rcpf(x); }
__device__ __forceinline__ float fsigmoid(float x) { return frcp(1.f + fexp(-x)); }
__device__ __forceinline__ float fsilu(float x) { return x * fsigmoid(x); }
__device__ __forceinline__ float fsoftplus(float x) {
    const float u = fexp(-fabsf(x));
    const float l = u < 0.01f ? u * (1.f - u * (0.5f - u * 0.33333333f)) : __builtin_amdgcn_logf(1.f + u) * 0.6931471805599453f;
    return fmaxf(x, 0.f) + l;
}
__device__ __forceinline__ float flogsigmoid(float x) { return -fsoftplus(-x); }

template <int NR>
__device__ __forceinline__ void conv_load(const bf16_t* src, const int trow0, u32x4 (&raw)[NR + 3]) {
#pragma unroll
    for (int i = 0; i < NR + 3; ++i) {
        const bool ok = (i >= 3) || (trow0 + i - 3 >= 0);
        const bf16_t* p = ok ? src + (ptrdiff_t)(i - 3) * NP : src;
        raw[i] = *(const u32x4*)p;
    }
}
template <int NR>
__device__ __forceinline__ void conv_compute(const u32x4 (&raw)[NR + 3], const int trow0, const LAS float* wl, const int ldw, float (&o)[NR][8]) {
    float x[NR + 3][8];
#pragma unroll
    for (int i = 0; i < NR + 3; ++i) {
        u32x4 xw = raw[i];
        if (i < 3) { const bool ok = trow0 + i - 3 >= 0; xw.x = ok ? xw.x : 0u; xw.y = ok ? xw.y : 0u; xw.z = ok ? xw.z : 0u; xw.w = ok ? xw.w : 0u; }
        unpack8(xw, x[i]);
    }
    float wv[5][8];
#pragma unroll
    for (int k = 0; k < 5; ++k) { const f32x4 w0 = *(const LAS f32x4*)(wl + k * ldw), w1 = *(const LAS f32x4*)(wl + k * ldw + 4);
#pragma unroll
        for (int j = 0; j < 4; ++j) { wv[k][j] = w0[j]; wv[k][4 + j] = w1[j]; } }
#pragma unroll
    for (int r = 0; r < NR; ++r)
#pragma unroll
        for (int j = 0; j < 8; ++j) { float a = wv[4][j];
#pragma unroll
            for (int k = 0; k < 4; ++k) a += wv[k][j] * x[r + k][j];
            o[r][j] = fsilu(a); }
}

__device__ __forceinline__ void ssd_prep(const Params& P, LAS unsigned char* lds, int bid, int nb) {
    const int tid = opaque_tid();
    bf16_t* proj = (bf16_t*)(P.ws + WS_BIG);
    LAS u32x4* halo = (LAS u32x4*)lds;
    const int c32 = tid & 31, r0 = (tid >> 5) * 4;
#pragma unroll 1
    for (int it = bid; it < 256; it += nb) {
        const int unit = it >> 1, half = it & 1, b = unit >> 2, g = unit & 3;
        int col, chn;
        if (half == 0) { col = C1_XS + g * 256 + 8 * c32; chn = g * 256 + 8 * c32; }
        else if (c32 < 16) { col = C1_BM + g * 128 + 8 * c32; chn = 1024 + g * 128 + 8 * c32; }
        else { col = C1_CM + g * 128 + 8 * (c32 - 16); chn = 1536 + g * 128 + 8 * (c32 - 16); }
        float wv[5][8];
#pragma unroll
        for (int k = 0; k < 5; ++k) { const float* wp = (k < 4 ? P.in[I_SSDCW] + k * 2048 : P.in[I_SSDCB]) + chn; const f32x4 w0 = *(const f32x4*)wp, w1 = *(const f32x4*)(wp + 4);
#pragma unroll
            for (int j = 0; j < 4; ++j) { wv[k][j] = w0[j]; wv[k][4 + j] = w1[j]; } }
        bf16_t* base = proj + (size_t)b * SEQ * NP + col;
        u32x4 cur[7];
#pragma unroll
        for (int i = 0; i < 7; ++i) { const int row = r0 - 3 + i; cur[i] = row >= 0 ? *(const u32x4*)(base + (size_t)row * NP) : (u32x4){0u, 0u, 0u, 0u}; }
#pragma unroll 1
        for (int ch = 0; ch < SEQ / 64; ++ch) {
            float x[7][8];
#pragma unroll
            for (int i = 0; i < 7; ++i) unpack8(cur[i], x[i]);
            const u32x4 h0 = cur[4], h1 = cur[5], h2 = cur[6];
            __syncthreads();
            if (r0 == 60) { halo[c32] = h0; halo[32 + c32] = h1; halo[64 + c32] = h2; }
            if (ch + 1 < SEQ / 64) {
#pragma unroll
                for (int i = 0; i < 7; ++i) if (r0 >= 4 || i >= 3) cur[i] = *(const u32x4*)(base + (size_t)(64 * (ch + 1) + r0 - 3 + i) * NP);
            }
#pragma unroll
            for (int r = 0; r < 4; ++r) { float o[8];
#pragma unroll
                for (int j = 0; j < 8; ++j) { float a = wv[4][j];
#pragma unroll
                    for (int k = 0; k < 4; ++k) a += wv[k][j] * x[r + k][j];
                    o[j] = fsilu(a); }
                *(u32x4*)(base + (size_t)(64 * ch + r0 + r) * NP) = pack8(o); }
            __syncthreads();
            if (r0 == 0 && ch + 1 < SEQ / 64) { cur[0] = halo[c32]; cur[1] = halo[32 + c32]; cur[2] = halo[64 + c32]; }
        }
        __syncthreads();
    }
}

template <int MIX>
__device__ __forceinline__ void mixer_unit(const Params& P, const int b, const int h, LAS unsigned char* lds, const bool dostore) {
    const int tid0 = opaque_tid(), w = __builtin_amdgcn_readfirstlane(tid0 >> 6);
    typedef unsigned u32x2 __attribute__((ext_vector_type(2)));
    constexpr int RSQ = 288, RSV = 544, RSP = 144;
    constexpr int SZQ = 64 * RSQ, SZV = 64 * RSV, SZP = 64 * RSP;
    constexpr int OQ = 0, OK1 = SZQ, OV = 2 * SZQ, O3 = 2 * SZQ + SZV;
    constexpr int OK2 = (MIX == MIX_ML || MIX == MIX_GLA) ? O3 : OK1;
    constexpr int OV2 = (MIX == MIX_SSD) ? O3 : OV;
    constexpr int OP = MIX == MIX_RET ? O3 : (MIX == MIX_SSD ? O3 + SZV : O3 + SZQ);
    constexpr int NPV = MIX == MIX_SSD ? 4 : 1;
    constexpr int OT = OP + NPV * SZP;
    constexpr int OY = OV2;
    LAS float* tab = (LAS float*)(lds + OT);
    constexpr int TGN = MIX == MIX_GLA ? 8832 : MIX == MIX_ML ? 648 : MIX == MIX_SSD ? 512 : 0;
    constexpr int TCW = MIX == MIX_ML ? 904 : 768;
    static_assert(OT + (MIX == MIX_GLA ? 11776 : MIX == MIX_SSD ? 3328 : 2184) * 4 <= 163840 - 1024, "lds map");
    bf16_t* proj = (bf16_t*)(P.ws + WS_BIG);
    const size_t row0b = (size_t)b * SEQ;
    constexpr int GIDX = MIX == MIX_RET ? I_RETG : MIX == MIX_ML ? I_MLG : MIX == MIX_GLA ? I_GLAG : I_SSDG;
    if (tid0 < 256) tab[TGN + tid0] = P.in[GIDX][h * 256 + tid0];
    if constexpr (MIX == MIX_ML) {
        for (int i = tid0; i < 1280; i += NTHREADS_C) { const int k = i >> 8, j = i & 255; const int chn = (j >> 7) * 512 + h * 128 + (j & 127);
            tab[TCW + i] = k < 4 ? P.in[I_MLCW][k * 1024 + chn] : P.in[I_MLCB][chn]; }
        if (tid0 < 128) tab[512 + tid0] = 0.f; if (tid0 == 0) tab[641] = 0.f;
    }
    if constexpr (MIX == MIX_GLA) {
        for (int i = tid0; i < 2048; i += NTHREADS_C) tab[9088 + i] = P.in[I_GLAWA][(i >> 7) * 512 + h * 128 + (i & 127)];
        if (tid0 < 128) tab[9088 + 2048 + tid0] = P.in[I_GLABA][h * 128 + tid0];
    }
    __syncthreads();
    f32x4 Sacc[8][2];
#pragma unroll
    for (int rt = 0; rt < 8; ++rt)
#pragma unroll
        for (int ct = 0; ct < 2; ++ct) Sacc[rt][ct] = (f32x4){0.f, 0.f, 0.f, 0.f};
    float gam = 1.f, lg2gam = 0.f, g63 = 1.f;
    float rinv[4] = {0.f, 0.f, 0.f, 0.f};
    if constexpr (MIX == MIX_RET) { gam = 1.f - __builtin_amdgcn_exp2f(-5.f - (float)h); lg2gam = __builtin_amdgcn_logf(gam); g63 = __builtin_amdgcn_exp2f(63.f * lg2gam);
#pragma unroll
        for (int i2 = 0; i2 < 4; ++i2) rinv[i2] = __builtin_amdgcn_exp2f(-(float)(2 * (4 * (tid0 & 15) + i2)) * (13.287712379549449f / 128.f)) * 0.15915494309189535f; }

    float gpA = 0.f, gpB = 0.f, gpC = 0.f;
    if constexpr (MIX == MIX_ML) { gpA = P.in[I_MLBI][h]; gpB = P.in[I_MLBF][h]; }
    if constexpr (MIX == MIX_SSD) { const int hd = 4 * h + (w & 3); gpA = P.in[I_SSDDTB][hd]; gpB = -fexp(P.in[I_SSDALOG][hd]); gpC = P.in[I_SSDD][4 * h + ((tid0 & 7) >> 1)]; }
    gpA = __builtin_bit_cast(float, __builtin_amdgcn_readfirstlane(__builtin_bit_cast(int, gpA))); gpB = __builtin_bit_cast(float, __builtin_amdgcn_readfirstlane(__builtin_bit_cast(int, gpB)));
    tp_begin(lds, 100 * MIX + 9);
    unsigned short gpre0 = 0, gpre1 = 0;
    if constexpr (MIX == MIX_ML) { if (w == 0) { const bf16_t* rp = proj + (row0b + (tid0 & 63)) * NP; gpre0 = rp[C0_MI + h]; gpre1 = rp[C0_MF + h]; } }
    if constexpr (MIX == MIX_SSD) { if (w < 4) gpre0 = proj[(row0b + (tid0 & 63)) * NP + C1_DT + 4 * h + w]; }
#pragma unroll 1
    for (int ch = 0; ch < SEQ / 64; ++ch) {
        int tid = tid0; asm volatile("" : "+v"(tid));
        const int lane = tid & 63, c = lane & 15, g = lane >> 4, q4 = (lane >> 2) & 3, p4 = lane & 3;
        const size_t row0 = row0b + (size_t)ch * 64;
        tp_begin(lds, 100 * MIX + 1);
        if constexpr (MIX == MIX_RET) {
            const int* pos = (const int*)P.in[I_POS];
            u32x4 qw2[2], kw2[2], vw[4]; int psi[2];
#pragma unroll
            for (int i = 0; i < 2; ++i) { const int pi = tid + 512 * i, r = pi >> 4, c8 = pi & 15;
                const bf16_t* rp = proj + (row0 + r) * NP + h * 128 + 8 * c8;
                qw2[i] = *(const u32x4*)(rp + C0_RQ); kw2[i] = *(const u32x4*)(rp + C0_RK); psi[i] = pos[row0 + r]; }
#pragma unroll
            for (int i = 0; i < 4; ++i) { const int pi = tid + 512 * i, r = pi >> 5, c8 = pi & 31; vw[i] = *(const u32x4*)(proj + (row0 + r) * NP + C0_RV + h * 256 + 8 * c8); }
            __builtin_amdgcn_sched_barrier(0);
#pragma unroll
            for (int i = 0; i < 2; ++i) {
                const int pi = tid + 512 * i, r = pi >> 4, c8 = pi & 15;
                float qv[8], kv[8]; unpack8(qw2[i], qv); unpack8(kw2[i], kv);
                const float ps = (float)psi[i];
                const float fq = __builtin_amdgcn_exp2f((float)r * lg2gam), fk = 0.08838834764831845f * __builtin_amdgcn_exp2f(-(float)r * lg2gam);
#pragma unroll
                for (int i2 = 0; i2 < 4; ++i2) {
                    const float tr = __builtin_amdgcn_fractf(ps * rinv[i2]);
                    const float sn = __builtin_amdgcn_sinf(tr), cs = __builtin_amdgcn_cosf(tr);
                    const float q0 = qv[2 * i2], q1 = qv[2 * i2 + 1], k0 = kv[2 * i2], k1 = kv[2 * i2 + 1];
                    qv[2 * i2] = (q0 * cs - q1 * sn) * fq; qv[2 * i2 + 1] = (q0 * sn + q1 * cs) * fq;
                    kv[2 * i2] = (k0 * cs - k1 * sn) * fk; kv[2 * i2 + 1] = (k0 * sn + k1 * cs) * fk;
                }
                *(LAS u32x4*)(lds + OQ + RSQ * r + 16 * c8) = pack8(qv);
                *(LAS u32x4*)(lds + OK1 + RSQ * r + 16 * c8) = pack8(kv);
            }
#pragma unroll
            for (int i = 0; i < 4; ++i) { const int pi = tid + 512 * i, r = pi >> 5, c8 = pi & 31; *(LAS u32x4*)(lds + OV + RSV * r + 16 * c8) = vw[i]; }
        }
        if constexpr (MIX == MIX_GLA) {
            u32x4 gaw = (u32x4){0u, 0u, 0u, 0u}, qw2[2], kw2[2], vw[4];
            if (tid < 128) gaw = *(const u32x4*)(proj + (row0 + (tid >> 1)) * NP + C1_GA + 8 * (tid & 1));
#pragma unroll
            for (int i = 0; i < 2; ++i) { const int pi = tid + 512 * i, r = pi >> 4, c8 = pi & 15; const bf16_t* rp = proj + (row0 + r) * NP + h * 128 + 8 * c8;
                qw2[i] = *(const u32x4*)(rp + C1_GQ); kw2[i] = *(const u32x4*)(rp + C1_GK); }
#pragma unroll
            for (int i = 0; i < 4; ++i) { const int pi = tid + 512 * i, r = pi >> 5, c8 = pi & 31; vw[i] = *(const u32x4*)(proj + (row0 + r) * NP + C1_GV + h * 256 + 8 * c8); }
            __builtin_amdgcn_sched_barrier(0);
            if (tid < 128) *(LAS u32x4*)(tab + 11264 + 4 * tid) = gaw;
            __syncthreads();
            {
                const int d = tid & 127, tq = tid >> 7;
                const float ba = tab[9088 + 2048 + d];
                float wv[16];
#pragma unroll
                for (int r = 0; r < 16; ++r) wv[r] = tab[9088 + r * 128 + d];
                float run = 0.f;
#pragma unroll 4
                for (int i = 0; i < 16; ++i) {
                    const int t = 16 * tq + i;
                    const u32x4 g0 = *(LAS u32x4*)(tab + 11264 + 8 * t), g1 = *(LAS u32x4*)(tab + 11264 + 8 * t + 4); float gv[8], gv2[8]; unpack8(g0, gv); unpack8(g1, gv2);
                    float a = ba;
#pragma unroll
                    for (int r = 0; r < 8; ++r) a += gv[r] * wv[r] + gv2[r] * wv[8 + r];
                    run += flogsigmoid(a) * (1.f / 16.f);
                    tab[t * 128 + d] = run;
                }
                tab[8192 + tq * 128 + d] = run;
            }
            __syncthreads();
            if (tid < 128) tab[8704 + tid] = fexp((tab[8192 + tid] + tab[8192 + 128 + tid]) + (tab[8192 + 256 + tid] + tab[8192 + 384 + tid]));
            __syncthreads();
#pragma unroll
            for (int i = 0; i < 2; ++i) {
                const int pi = tid + 512 * i, r = pi >> 4, c8 = pi & 15, tq = r >> 4;
                float qv[8], kv[8], k2[8]; unpack8(qw2[i], qv); unpack8(kw2[i], kv);
#pragma unroll
                for (int hh = 0; hh < 2; ++hh) {
                    const int d0 = 8 * c8 + 4 * hh;
                    f32x4 bc = *(LAS f32x4*)(tab + r * 128 + d0);
                    const f32x4 t0 = *(LAS f32x4*)(tab + 8192 + d0), t1 = *(LAS f32x4*)(tab + 8192 + 128 + d0), t2 = *(LAS f32x4*)(tab + 8192 + 256 + d0), t3 = *(LAS f32x4*)(tab + 8192 + 384 + d0);
                    if (tq > 0) bc = bc + t0; if (tq > 1) bc = bc + t1; if (tq > 2) bc = bc + t2;
                    const f32x4 bt = (t0 + t1) + (t2 + t3);
                    const f32x4 dcv = *(LAS f32x4*)(tab + 8704 + d0);
#pragma unroll
                    for (int j = 0; j < 4; ++j) { const float e1 = fexp(bc[j]), e2 = frcp(e1), kk = kv[4 * hh + j] * e2;
                        qv[4 * hh + j] = qv[4 * hh + j] * 0.08838834764831845f * e1; kv[4 * hh + j] = kk; k2[4 * hh + j] = kk * dcv[j]; }
                }
                *(LAS u32x4*)(lds + OQ + RSQ * r + 16 * c8) = pack8(qv);
                *(LAS u32x4*)(lds + OK1 + RSQ * r + 16 * c8) = pack8(kv);
                *(LAS u32x4*)(lds + OK2 + RSQ * r + 16 * c8) = pack8(k2);
            }
#pragma unroll
            for (int i = 0; i < 4; ++i) { const int pi = tid + 512 * i, r = pi >> 5, c8 = pi & 31; *(LAS u32x4*)(lds + OV + RSV * r + 16 * c8) = vw[i]; }
        }
        if constexpr (MIX == MIX_ML) {
            const int c16 = tid & 31, r0 = (tid >> 5) * 4, isk = c16 >> 4, c8c = c16 & 15;
            u32x4 vw[4], raw[7];
#pragma unroll
            for (int i = 0; i < 4; ++i) { const int pi = tid + 512 * i, r = pi >> 5, c8 = pi & 31; vw[i] = *(const u32x4*)(proj + (row0 + r) * NP + C0_MV + h * 256 + 8 * c8); }
            conv_load<4>(proj + (row0 + r0) * NP + (isk ? C0_MK : C0_MQ) + h * 128 + 8 * c8c, ch * 64 + r0, raw);
            __builtin_amdgcn_sched_barrier(0);
            if (w == 0) {
                const float ip = bf2f(gpre0) + gpA, lf = flogsigmoid(bf2f(gpre1) + gpB);
                const float bc = wave_scan_add(lf);
                const float u = ip - bc; const float pm = wave_scan_max(u);
                const float mst = tab[641];
                const float M = fmaxf(mst, pm), M63 = __shfl(M, 63), bt = __shfl(bc, 63);
                tab[lane] = u; tab[64 + lane] = M; tab[128 + lane] = fexp(u - M63); tab[192 + lane] = fexp(mst - M); tab[256 + lane] = fexp(-bc - M);
                if (lane == 0) { tab[640] = fexp(mst - M63); tab[642] = bt + M63; }
            }
#pragma unroll
            for (int i = 0; i < 4; ++i) { const int pi = tid + 512 * i, r = pi >> 5, c8 = pi & 31; *(LAS u32x4*)(lds + OV + RSV * r + 16 * c8) = vw[i]; }
            {
                float o[4][8];
                conv_compute<4>(raw, ch * 64 + r0, tab + TCW + 8 * c16, 256, o);
#pragma unroll
                for (int r = 0; r < 4; ++r) {
                    if (isk) {
#pragma unroll
                        for (int j = 0; j < 8; ++j) o[r][j] *= 0.08838834764831845f; }
                    *(LAS u32x4*)(lds + (isk ? OK1 : OQ) + RSQ * (r0 + r) + 16 * c8c) = pack8(o[r]); }
            }
            __syncthreads();
            tp_end(lds, 100 * MIX + 1); tp_begin(lds, 100 * MIX + 6);
#pragma unroll
            for (int i = 0; i < 2; ++i) {
                const int pi = tid + 512 * i, r = pi >> 4, c8 = pi & 15;
                const u32x4 kw = *(LAS u32x4*)(lds + OK1 + RSQ * r + 16 * c8); float kv[8]; unpack8(kw, kv); const float es = tab[128 + r];
#pragma unroll
                for (int j = 0; j < 8; ++j) kv[j] *= es;
                *(LAS u32x4*)(lds + OK2 + RSQ * r + 16 * c8) = pack8(kv);
            }
            {
                const int t = tid >> 3, part = tid & 7; float a = 0.f;
#pragma unroll
                for (int i = 0; i < 2; ++i) { const u32x4 qw = *(LAS u32x4*)(lds + OQ + RSQ * t + 2 * (16 * part + 8 * i)); float qv[8]; unpack8(qw, qv);
                    const f32x4 n0 = *(LAS f32x4*)(tab + 512 + 16 * part + 8 * i), n1 = *(LAS f32x4*)(tab + 512 + 16 * part + 8 * i + 4);
#pragma unroll
                    for (int j = 0; j < 4; ++j) a += qv[j] * n0[j] + qv[4 + j] * n1[j]; }
                a += __shfl_xor(a, 1); a += __shfl_xor(a, 2); a += __shfl_xor(a, 4);
                if (part == 0) tab[448 + t] = a;
            }
        }
        if constexpr (MIX == MIX_SSD) {
            if (w < 4) {
                const float dt = fsoftplus(bf2f(gpre0) + gpA);
                const float cm = wave_scan_add(dt * gpB);
                tab[lane * 4 + w] = cm; tab[256 + lane * 4 + w] = dt;
            }
            {
                const int c32 = tid & 31, r0 = (tid >> 5) * 4, isc = c32 >> 4, c8 = c32 & 15, hr = c32 >> 3;
                u32x4 bcw[4], xw[4];
#pragma unroll
                for (int r = 0; r < 4; ++r) { bcw[r] = *(const u32x4*)(proj + (row0 + r0 + r) * NP + (isc ? C1_CM : C1_BM) + h * 128 + 8 * c8); xw[r] = *(const u32x4*)(proj + (row0 + r0 + r) * NP + C1_XS + h * 256 + 8 * c32); }
                float ox[4][8];
#pragma unroll
                for (int r = 0; r < 4; ++r) { *(LAS u32x4*)(lds + (isc ? OQ : OK1) + RSQ * (r0 + r) + 16 * c8) = bcw[r]; unpack8(xw[r], ox[r]); }
                __syncthreads();
                tp_end(lds, 100 * MIX + 1); tp_begin(lds, 100 * MIX + 6);
                const float last = tab[63 * 4 + hr];
#pragma unroll
                for (int r = 0; r < 4; ++r) { const float dt = tab[256 + (r0 + r) * 4 + hr], e2 = fexp(last - tab[(r0 + r) * 4 + hr]); float o2[8];
#pragma unroll
                    for (int j = 0; j < 8; ++j) { ox[r][j] *= dt; o2[j] = ox[r][j] * e2; }
                    *(LAS u32x4*)(lds + OV + RSV * (r0 + r) + 16 * c32) = pack8(ox[r]);
                    *(LAS u32x4*)(lds + OV2 + RSV * (r0 + r) + 16 * c32) = pack8(o2); }
            }
        }
        __syncthreads();
        tp_end(lds, (MIX == MIX_ML || MIX == MIX_SSD) ? 100 * MIX + 6 : 100 * MIX + 1); tp_begin(lds, 100 * MIX + 2);
        if (ch + 1 < SEQ / 64) {
            const int sl = tid & 15;
            int col = -1;
            if constexpr (MIX == MIX_RET) col = sl < 2 ? C0_RQ + h * 128 + 64 * sl : sl < 4 ? C0_RK + h * 128 + 64 * (sl - 2) : sl < 8 ? C0_RV + h * 256 + 64 * (sl - 4) : sl < 12 ? C0_RG + h * 256 + 64 * (sl - 8) : -1;
            if constexpr (MIX == MIX_ML) col = sl < 2 ? C0_MQ + h * 128 + 64 * sl : sl < 4 ? C0_MK + h * 128 + 64 * (sl - 2) : sl < 8 ? C0_MV + h * 256 + 64 * (sl - 4) : sl < 12 ? C0_MO + h * 256 + 64 * (sl - 8) : sl == 12 ? C0_MI : -1;
            if constexpr (MIX == MIX_GLA) col = sl < 2 ? C1_GQ + h * 128 + 64 * sl : sl < 4 ? C1_GK + h * 128 + 64 * (sl - 2) : sl < 8 ? C1_GV + h * 256 + 64 * (sl - 4) : sl < 12 ? C1_GR + h * 256 + 64 * (sl - 8) : sl == 12 ? C1_GA : -1;
            if constexpr (MIX == MIX_SSD) col = sl < 4 ? C1_XS + h * 256 + 64 * sl : sl < 6 ? C1_BM + h * 128 + 64 * (sl - 4) : sl < 8 ? C1_CM + h * 128 + 64 * (sl - 6) : sl < 12 ? C1_SZ + h * 256 + 64 * (sl - 8) : sl == 12 ? C1_DT : -1;
            if (col >= 0) { const bf16_t* nbp = proj + (row0 + 64 + (tid >> 4)) * NP + col;
                const unsigned pfl = 157696u + (unsigned)w * 512u;
                asm volatile("s_mov_b32 m0, %2\n\ts_nop 0\n\tglobal_load_lds_dword %0, off\n\ts_mov_b32 m0, %3\n\ts_nop 0\n\tglobal_load_lds_dword %1, off"
                             :: "v"(nbp), "v"(nbp + (size_t)32 * NP), "s"(pfl), "s"(pfl + 256u) : "memory", "m0"); }
        }
        {
            const int tt = w >> 1; float rsum = 0.f;
#pragma unroll
            for (int si = 0; si < 2; ++si) {
                const int ss = 2 * (w & 1) + si;
                f32x4 acc = (f32x4){0.f, 0.f, 0.f, 0.f};
#pragma unroll
                for (int ks = 0; ks < 4; ++ks) {
                    const bf16x8 a = *(LAS bf16x8*)(lds + OK1 + RSQ * (16 * ss + c) + 2 * (32 * ks + 8 * g));
                    const bf16x8 bq = *(LAS bf16x8*)(lds + OQ + RSQ * (16 * tt + c) + 2 * (32 * ks + 8 * g));
                    acc = __builtin_amdgcn_mfma_f32_16x16x32_bf16(a, bq, acc, 0, 0, 0);
                }
                const int t = 16 * tt + c, s0 = 16 * ss + 4 * g;
                if constexpr (MIX == MIX_SSD) {
                    const f32x4 ct_ = *(LAS f32x4*)(tab + t * 4);
                    f32x4 cs_[4];
#pragma unroll
                    for (int r = 0; r < 4; ++r) cs_[r] = *(LAS f32x4*)(tab + (s0 + r) * 4);
#pragma unroll
                    for (int hr = 0; hr < 4; ++hr) { float pv[4];
#pragma unroll
                        for (int r = 0; r < 4; ++r) { const float e = fexp(ct_[hr] - cs_[r][hr]); pv[r] = (s0 + r <= t) ? acc[r] * e : 0.f; }
                        *(LAS u32x2*)(lds + OP + hr * SZP + RSP * t + 2 * s0) = (u32x2){pg8::cvt_pk_bf16(pv[0], pv[1]), pg8::cvt_pk_bf16(pv[2], pv[3])}; }
                } else {
                    float pv[4];
                    if constexpr (MIX == MIX_ML) { const f32x4 us = *(LAS f32x4*)(tab + s0); const float Mt = tab[64 + t];
#pragma unroll
                        for (int r = 0; r < 4; ++r) { pv[r] = (s0 + r <= t) ? acc[r] * fexp(us[r] - Mt) : 0.f; rsum += pv[r]; } }
                    else {
#pragma unroll
                        for (int r = 0; r < 4; ++r) pv[r] = (s0 + r <= t) ? acc[r] : 0.f; }
                    *(LAS u32x2*)(lds + OP + RSP * t + 2 * s0) = (u32x2){pg8::cvt_pk_bf16(pv[0], pv[1]), pg8::cvt_pk_bf16(pv[2], pv[3])};
                }
            }
            if constexpr (MIX == MIX_ML) { rsum += __shfl_xor(rsum, 16); rsum += __shfl_xor(rsum, 32); if (g == 0) tab[320 + (w & 1) * 64 + 16 * tt + c] = rsum; }
        }
        __syncthreads();
        tp_end(lds, 100 * MIX + 2); tp_begin(lds, 100 * MIX + 3);
        f32x4 Yacc[2][4];
#pragma unroll
        for (int ct = 0; ct < 2; ++ct)
#pragma unroll
            for (int tt = 0; tt < 4; ++tt) Yacc[ct][tt] = (f32x4){0.f, 0.f, 0.f, 0.f};
#pragma unroll
        for (int kd = 0; kd < 4; ++kd) {
            bf16x8 qf[4];
#pragma unroll
            for (int tt = 0; tt < 4; ++tt) { LAS unsigned char* qp = lds + OQ + RSQ * (16 * tt + c) + 2 * (32 * kd + 4 * g); qf[tt] = cat_frag(qp, qp + 32); }
#pragma unroll
            for (int ct = 0; ct < 2; ++ct) { const bf16x8 sf = pack_acc(Sacc[2 * kd][ct], Sacc[2 * kd + 1][ct]);
#pragma unroll
                for (int tt = 0; tt < 4; ++tt) Yacc[ct][tt] = __builtin_amdgcn_mfma_f32_16x16x32_bf16(sf, qf[tt], Yacc[ct][tt], 0, 0, 0); }
        }
        if constexpr (MIX != MIX_GLA) {
#pragma unroll
            for (int tt = 0; tt < 4; ++tt) {
                float rs = gam;
                if constexpr (MIX == MIX_ML) rs = tab[192 + 16 * tt + c];
                if constexpr (MIX == MIX_SSD) rs = fexp(tab[(16 * tt + c) * 4 + (w >> 1)]);
#pragma unroll
                for (int ct = 0; ct < 2; ++ct) Yacc[ct][tt] = Yacc[ct][tt] * rs;
            }
        }
        bf16x8 Vf[2][2];
#pragma unroll
        for (int ks = 0; ks < 2; ++ks)
#pragma unroll
            for (int ct = 0; ct < 2; ++ct) { LAS unsigned char* vp = lds + OV + RSV * (32 * ks + 8 * g + q4) + 2 * (32 * w + 16 * ct) + 8 * p4; Vf[ks][ct] = tr_frag(vp, vp + 4 * RSV); }
#pragma unroll
        for (int ks = 0; ks < 2; ++ks)
#pragma unroll
            for (int tt = 0; tt < 4; ++tt) { const bf16x8 pf = *(LAS bf16x8*)(lds + OP + (MIX == MIX_SSD ? (w >> 1) * SZP : 0) + RSP * (16 * tt + c) + 2 * (32 * ks + 8 * g));
#pragma unroll
                for (int ct = 0; ct < 2; ++ct) Yacc[ct][tt] = __builtin_amdgcn_mfma_f32_16x16x32_bf16(Vf[ks][ct], pf, Yacc[ct][tt], 0, 0, 0); }
        if constexpr (MIX == MIX_GLA) {
#pragma unroll
            for (int rt = 0; rt < 8; ++rt) { const f32x4 dc = *(LAS f32x4*)(tab + 8704 + 16 * rt + 4 * g);
#pragma unroll
                for (int ct = 0; ct < 2; ++ct) Sacc[rt][ct] = Sacc[rt][ct] * dc; }
        } else {
            float dc = gam;
            if constexpr (MIX == MIX_ML) dc = tab[640];
            if constexpr (MIX == MIX_SSD) dc = fexp(tab[63 * 4 + (w >> 1)]);
#pragma unroll
            for (int rt = 0; rt < 8; ++rt)
#pragma unroll
                for (int ct = 0; ct < 2; ++ct) Sacc[rt][ct] = Sacc[rt][ct] * dc;
        }
        if constexpr (MIX == MIX_SSD) {
#pragma unroll
            for (int ks = 0; ks < 2; ++ks)
#pragma unroll
                for (int ct = 0; ct < 2; ++ct) { LAS unsigned char* vp = lds + OV2 + RSV * (32 * ks + 8 * g + q4) + 2 * (32 * w + 16 * ct) + 8 * p4; Vf[ks][ct] = tr_frag(vp, vp + 4 * RSV); }
        }
#pragma unroll
        for (int rt = 0; rt < 8; ++rt)
#pragma unroll
            for (int ks = 0; ks < 2; ++ks) { LAS unsigned char* kp = lds + OK2 + RSQ * (32 * ks + 8 * g + q4) + 2 * (16 * rt) + 8 * p4; const bf16x8 kf = tr_frag(kp, kp + 4 * RSQ);
#pragma unroll
                for (int ct = 0; ct < 2; ++ct) Sacc[rt][ct] = __builtin_amdgcn_mfma_f32_16x16x32_bf16(kf, Vf[ks][ct], Sacc[rt][ct], 0, 0, 0); }
        if constexpr (MIX == MIX_RET) {
#pragma unroll
            for (int rt = 0; rt < 8; ++rt)
#pragma unroll
                for (int ct = 0; ct < 2; ++ct) Sacc[rt][ct] = Sacc[rt][ct] * g63;
        }
        if constexpr (MIX == MIX_ML) {
            if (tid < 128) { float a = 0.f;
#pragma unroll 8
                for (int s = 0; s < 64; ++s) a += bf2f(*(LAS unsigned short*)(lds + OK2 + RSQ * s + 2 * tid));
                tab[512 + tid] = tab[640] * tab[512 + tid] + a; }
        }
        __syncthreads();
        tp_end(lds, 100 * MIX + 3); tp_begin(lds, 100 * MIX + 4);
        constexpr int GCOL = MIX == MIX_RET ? C0_RG : MIX == MIX_ML ? C0_MO : MIX == MIX_GLA ? C1_GR : C1_SZ;
        constexpr int OCOL = MIX == MIX_RET ? C0_RV : MIX == MIX_ML ? C0_MV : MIX == MIX_GLA ? C1_GV : C1_SZ;
        bf16_t* const erp = proj + (row0 + (tid >> 3)) * NP + h * 256 + 32 * (tid & 7);
        u32x4 gw[4];
#pragma unroll
        for (int i = 0; i < 4; ++i) gw[i] = *(const u32x4*)(erp + GCOL + 8 * i);
        __builtin_amdgcn_sched_barrier(0);
#pragma unroll
        for (int ct = 0; ct < 2; ++ct)
#pragma unroll
            for (int tt = 0; tt < 4; ++tt)
                *(LAS u32x2*)(lds + OY + RSV * (16 * tt + c) + 2 * (32 * w + 16 * ct + 4 * g)) = (u32x2){pg8::cvt_pk_bf16(Yacc[ct][tt][0], Yacc[ct][tt][1]), pg8::cvt_pk_bf16(Yacc[ct][tt][2], Yacc[ct][tt][3])};
        __syncthreads();
        tp_end(lds, 100 * MIX + 4); tp_begin(lds, 100 * MIX + 5);
        {
            const int t = tid >> 3, part = tid & 7;
            float y[32];
#pragma unroll
            for (int i = 0; i < 4; ++i) { const u32x4 yw = *(LAS u32x4*)(lds + OY + RSV * t + 2 * (32 * part + 8 * i)); float t8[8]; unpack8(yw, t8);
#pragma unroll
                for (int j = 0; j < 8; ++j) y[8 * i + j] = t8[j]; }
            bf16_t* const rp = erp;
            if constexpr (MIX == MIX_ML) {
                const float den = (tab[320 + t] + tab[384 + t]) + tab[192 + t] * tab[448 + t];
                const float idn = frcp(fmaxf(fabsf(den), tab[256 + t]));
#pragma unroll
                for (int i = 0; i < 4; ++i) { float gt[8]; unpack8(gw[i], gt);
#pragma unroll
                    for (int j = 0; j < 8; ++j) y[8 * i + j] = y[8 * i + j] * idn * fsigmoid(gt[j]); }
            }
            if constexpr (MIX == MIX_SSD) {
                const float dsk = gpC * frcp(tab[256 + t * 4 + (part >> 1)]);
#pragma unroll
                for (int i = 0; i < 4; ++i) { const u32x4 xw = *(LAS u32x4*)(lds + OV + RSV * t + 2 * (32 * part + 8 * i)); float t8[8], gt[8]; unpack8(xw, t8); unpack8(gw[i], gt);
#pragma unroll
                    for (int j = 0; j < 8; ++j) y[8 * i + j] = (y[8 * i + j] + dsk * t8[j]) * fsilu(gt[j]); }
            }
            float mean = 0.f;
            if constexpr (MIX == MIX_RET || MIX == MIX_ML) {
                float s1 = 0.f;
#pragma unroll
                for (int j = 0; j < 32; ++j) s1 += y[j];
                s1 += __shfl_xor(s1, 1); s1 += __shfl_xor(s1, 2); s1 += __shfl_xor(s1, 4);
                mean = s1 * (1.f / 256.f);
            }
            float s2 = 0.f;
#pragma unroll
            for (int j = 0; j < 32; ++j) { y[j] -= mean; s2 += y[j] * y[j]; }
            s2 += __shfl_xor(s2, 1); s2 += __shfl_xor(s2, 2); s2 += __shfl_xor(s2, 4);
            const float rstd = __builtin_amdgcn_rsqf(s2 * (1.f / 256.f) + NORM_EPS);
#pragma unroll
            for (int i = 0; i < 4; ++i) {
                const f32x4 n0 = *(LAS f32x4*)(tab + TGN + 32 * part + 8 * i), n1 = *(LAS f32x4*)(tab + TGN + 32 * part + 8 * i + 4); float o[8];
#pragma unroll
                for (int j = 0; j < 4; ++j) { o[j] = y[8 * i + j] * rstd * n0[j]; o[4 + j] = y[8 * i + 4 + j] * rstd * n1[j]; }
                if constexpr (MIX == MIX_RET || MIX == MIX_GLA) { float gt[8]; unpack8(gw[i], gt);
#pragma unroll
                    for (int j = 0; j < 8; ++j) o[j] *= fsilu(gt[j]); }
                if (dostore) *(u32x4*)(rp + OCOL + 8 * i) = pack8(o);
            }
            if constexpr (MIX == MIX_ML) { if (tid == 0) tab[641] = tab[642]; }
        }
        if (ch + 1 < SEQ / 64) {
            if constexpr (MIX == MIX_ML) { if (w == 0) { const bf16_t* rp = proj + (row0 + 64 + lane) * NP; gpre0 = rp[C0_MI + h]; gpre1 = rp[C0_MF + h]; } }
            if constexpr (MIX == MIX_SSD) { if (w < 4) gpre0 = proj[(row0 + 64 + lane) * NP + C1_DT + 4 * h + w]; }
        }
        __syncthreads();
        tp_end(lds, 100 * MIX + 5);
    }
    tp_end(lds, 100 * MIX + 9);
}

#define XB_TMO      128
#define XB_XCNT(j)  (256  + 64 * (j))
#define XB_XSUB(j)  (1280 + 64 * (j))
#define XB_XGEN(j)  (2304 + 64 * (j))
#define XB_TOP      3328
#define XB_TOPGEN   3392
#define XCD_BAR_WORDS 3456
#define XB_SPIN_CAP (1u << 18)
__device__ __forceinline__ unsigned xb_ld(unsigned* p)              { return __hip_atomic_load(p, __ATOMIC_RELAXED, __HIP_MEMORY_SCOPE_AGENT); }
__device__ __forceinline__ unsigned xb_add(unsigned* p, unsigned v) { return __hip_atomic_fetch_add(p, v, __ATOMIC_RELAXED, __HIP_MEMORY_SCOPE_AGENT); }
__device__ __forceinline__ unsigned xb_xcc_id() { return (unsigned)__builtin_amdgcn_s_getreg((3 << 11) | 20) & 0xFu; }
#define XB_SPIN(cond, bar) do { unsigned _sp = 0; while (cond) { __builtin_amdgcn_s_sleep(1); \
    if ((++_sp & 255u) == 0u) { if (xb_ld(&(bar)[XB_TMO])) break; if (_sp > XB_SPIN_CAP) { atomicAdd(&(bar)[XB_TMO], 1u); break; } } } } while (0)
struct XcdBarrier { unsigned* bar; unsigned x; volatile LAS unsigned* st; };
__device__ __forceinline__ XcdBarrier xcd_barrier_post(unsigned* bar, volatile LAS unsigned* st) {
    XcdBarrier b; b.bar = bar; b.x = xb_xcc_id(); b.st = st;
    if (opaque_tid() == 0) (void)xb_add(&bar[XB_XCNT(b.x)], 1u);
    return b;
}
__device__ __forceinline__ void xcd_barrier_complete(unsigned* bar, unsigned x, unsigned& nloc, unsigned& nx) {
    const unsigned G = gridDim.x * gridDim.y * gridDim.z;
    unsigned sum, cnt, mine, sp = 0u;
    for (;;) {
        sum = 0u; cnt = 0u; mine = 0u;
#pragma unroll
        for (unsigned j = 0; j < 16; ++j) { const unsigned c = xb_ld(&bar[XB_XCNT(j)]); sum += c; cnt += (c > 0u) ? 1u : 0u; mine = (j == x) ? c : mine; }
        if (sum == G) break;
        __builtin_amdgcn_s_sleep(1);
        if ((++sp & 255u) == 0u) { if (xb_ld(&bar[XB_TMO])) break; if (sp > XB_SPIN_CAP) { atomicAdd(&bar[XB_TMO], 1u); break; } }
    }
    nloc = mine > 0u ? mine : 1u; nx = cnt > 0u ? cnt : 1u;
}
__device__ __forceinline__ void xcd_barrier(const XcdBarrier& b) {
    asm volatile("s_waitcnt vmcnt(0)" ::: "memory");
    __syncthreads();
    if (opaque_tid() == 0) {
        unsigned* bar = b.bar;
        __builtin_amdgcn_s_waitcnt(0);
        unsigned nloc = b.st[0], nx = b.st[1];
        if (nloc == 0u) { xcd_barrier_complete(bar, b.x, nloc, nx); b.st[0] = nloc; b.st[1] = nx; }
        const unsigned old = xb_add(&bar[XB_XSUB(b.x)], 1u);
        const unsigned gen = old / nloc;
        if (old + 1u == (gen + 1u) * nloc) {
            __builtin_amdgcn_fence(__ATOMIC_RELEASE, "agent");
            asm volatile("s_waitcnt vmcnt(0)" ::: "memory");
            const unsigned og = xb_add(&bar[XB_TOP], 1u);
            const unsigned tg = og / nx;
            if (og + 1u == (tg + 1u) * nx) xb_add(&bar[XB_TOPGEN], 1u);
            else XB_SPIN(xb_ld(&bar[XB_TOPGEN]) == tg, bar);
            __builtin_amdgcn_fence(__ATOMIC_ACQUIRE, "agent");
            xb_add(&bar[XB_XGEN(b.x)], 1u);
            asm volatile("s_waitcnt vmcnt(0)" ::: "memory");
        } else {
            XB_SPIN(xb_ld(&bar[XB_XGEN(b.x)]) == gen, bar);
            __builtin_amdgcn_fence(__ATOMIC_ACQUIRE, "agent");
            asm volatile("s_waitcnt vmcnt(0)" ::: "memory");
        }
    }
    __syncthreads();
}

constexpr int NTHREADS = 512;
constexpr int RING_BYTES = 131072;
constexpr int LDS_BYTES = 163840;
constexpr int LDS_BARW = LDS_BYTES - 16;
constexpr int NPHASES = 17;
#ifndef MK_N_LAUNCHES
#define MK_N_LAUNCHES 1
#endif

#ifndef REP_ROUTE
#define REP_ROUTE 1
#endif
#ifndef REP_CONV
#define REP_CONV 1
#endif
#ifndef REP_GIN
#define REP_GIN 1
#endif
#ifndef REP_GOUT
#define REP_GOUT 1
#endif
#ifndef REP_PERM
#define REP_PERM 1
#endif
#ifndef REP_MOEA
#define REP_MOEA 1
#endif
#ifndef REP_MOEB
#define REP_MOEB 1
#endif
#ifndef REP_LNF
#define REP_LNF 1
#endif
#ifndef MIXREP_RET
#define MIXREP_RET 1
#endif
#ifndef MIXREP_ML
#define MIXREP_ML 1
#endif
#ifndef MIXREP_GLA
#define MIXREP_GLA 1
#endif
#ifndef MIXREP_SSD
#define MIXREP_SSD 1
#endif
struct Args { Params P; int ph_lo, ph_hi; };
typedef __attribute__((address_space(4))) const unsigned char* kargp_t;
__device__ __forceinline__ const Params& kparams() {
    kargp_t p = (kargp_t)__builtin_amdgcn_kernarg_segment_ptr();
    asm volatile("" : "+s"(p));
    return *(const Params*)p;
}

__device__ __forceinline__ int kphase_lo() { kargp_t p = (kargp_t)__builtin_amdgcn_kernarg_segment_ptr(); asm volatile("" : "+s"(p)); return ((const Args*)p)->ph_lo; }
__device__ __forceinline__ int kphase_hi() { kargp_t p = (kargp_t)__builtin_amdgcn_kernarg_segment_ptr(); asm volatile("" : "+s"(p)); return ((const Args*)p)->ph_hi; }
__device__ __forceinline__ void grid_barrier(LAS unsigned char* lds) {
    XcdBarrier b; b.bar = (unsigned*)(kparams().ws + WS_CTL) + CW_BAR; b.x = xb_xcc_id(); b.st = (volatile LAS unsigned*)(lds + LDS_BARW);
    tp_begin(lds, 900); xcd_barrier(b); tp_end(lds, 900);
}
template <int LAYER>
__device__ __forceinline__ void layer_phases(LAS unsigned char* lds) {
#define IN(k) (kphase_lo() <= (k) && (k) < kphase_hi())
#define SEAM(k) do { if (IN(k) && IN((k) + 1)) grid_barrier(lds); } while (0)
    constexpr int PB = 1 + 8 * LAYER;
    const int bid = blockIdx.x, nb = gridDim.x;
    if (IN(PB + 0)) {
        const Params& P = kparams();
        pg8::EpiStore E{(bf16_t*)(P.ws + WS_BIG), NP};
        constexpr unsigned M8 = LAYER ? INPROJ_FP8MASK1 : INPROJ_FP8MASK0, M16 = ALLTILES & ~M8;
        for (int rep = 0; rep < REP_GIN; ++rep) {
            if constexpr (M16 != 0u) {
                pg8::SchedCols S; S.A = (const char*)(P.out + OUT_H); S.B = (const char*)(P.ws + (LAYER ? WS_WIN1 : WS_WIN0)); S.lda = D; S.ldb = D; S.nM = T / 256; S.nN = __builtin_popcount(M16); S.G = nb; S.c = bid; S.mask = M16;
                pg8::gemm_phase(lds, S, E, D, D, D);
            }
            if constexpr (M8 != 0u) {
                pg8::SchedCols S; S.A = (const char*)(P.ws + WS_H8); S.B = (const char*)(P.ws + (LAYER ? WS_WIN8_1 : WS_WIN8_0)); S.lda = D / 2; S.ldb = D / 2; S.nM = T / 256; S.nN = __builtin_popcount(M8); S.G = nb; S.c = bid; S.mask = M8;
                pg8::gemm_phase<pg8::EpiStore, pg8::SchedCols, true, 0x7c7c7c7c, 0x77777777>(lds, S, E, D / 2, D / 2, D / 2);
            }
        }
    }
    SEAM(PB + 0);
    if (IN(PB + 1)) {
        if constexpr (LAYER == 1) { ssd_prep(kparams(), lds, bid, nb); grid_barrier(lds); }
        const Params& P = kparams();
        for (int u = bid; u < 256; u += nb) {
            const int b = (u & 127) >> 2, h = u & 3;
            if (LAYER == 0) { if (u < 128) { for (int rep = 0; rep < MIXREP_RET; ++rep) { mixer_unit<MIX_RET>(P, b, h, lds, rep == MIXREP_RET - 1); __syncthreads(); }
                                               convert_moe(P, lds, u, 128); }
                              else { for (int rep = 0; rep < MIXREP_ML; ++rep) { mixer_unit<MIX_ML>(P, b, h, lds, rep == MIXREP_ML - 1); __syncthreads(); } } }
            else { if (u < 128) { for (int rep = 0; rep < MIXREP_GLA; ++rep) { mixer_unit<MIX_GLA>(P, b, h, lds, rep == MIXREP_GLA - 1); __syncthreads(); } }
                   else { for (int rep = 0; rep < MIXREP_SSD; ++rep) { mixer_unit<MIX_SSD>(P, b, h, lds, rep == MIXREP_SSD - 1); __syncthreads(); } } }
        }
    }
    SEAM(PB + 1);
    if (IN(PB + 2)) {
        const Params& P = kparams();
        pg8::SchedPlain S; S.A = (const char*)(P.ws + WS_BIG) + YOFF * 2; S.B = (const char*)(P.ws + (LAYER ? WS_WOUT1 : WS_WOUT0)); S.lda = NP; S.ldb = 2048; S.nM = T / 256; S.nN = 4; S.G = nb; S.c = bid;
        pg8::EpiResid E{(bf16_t*)(P.out + OUT_PRE1), (const bf16_t*)(P.out + OUT_H)};
        for (int rep = 0; rep < REP_GOUT; ++rep) pg8::gemm_phase(lds, S, E, 2048, NP, 2048);
    }
    SEAM(PB + 2);
    if (IN(PB + 3)) for (int rep = 0; rep < REP_ROUTE; ++rep) { phase_route(kparams(), LAYER, lds, bid, nb, 32 * (REP_ROUTE - 1 - rep)); __syncthreads(); }
    SEAM(PB + 3);
    if (IN(PB + 4)) for (int rep = 0; rep < REP_PERM; ++rep) phase_permute(kparams(), LAYER, lds, bid, nb);
    SEAM(PB + 4);
    if (IN(PB + 5)) {
        const Params& P = kparams();
        const int* tilecls = (const int*)(P.ws + WS_TILECLS);
        if constexpr (MOE_FP8(LAYER) && MOEA_FP8) {
            pg8::SchedMoeA<true> S; S.A = (const char*)(P.ws + WS_BIG + BIG_HS8); S.Wgu = (const char*)(P.ws + WS_WGU) + (size_t)LAYER * 16 * 2097152; S.tilecls = tilecls; S.nM = __builtin_amdgcn_readfirstlane(tilecls[0]); S.G = nb; S.c = bid;
            pg8::EpiSwiglu8 E{P.ws + WS_BIG + BIG_H, (const float*)(P.ws + WS_ROWGATE)};
            for (int rep = 0; rep < REP_MOEA; ++rep) pg8::gemm_phase<pg8::EpiSwiglu8, pg8::SchedMoeA<true>, true, 0x7c7c7c7c, 0x77777777>(lds, S, E, D / 2, D / 2, D / 2);
        } else if constexpr (MOE_FP8(LAYER)) {
            pg8::SchedMoeA<false> S; S.A = (const char*)(P.ws + WS_BIG + BIG_HS); S.Wgu = (const char*)(P.ws + WS_WGU) + (size_t)LAYER * 16 * 2097152; S.tilecls = tilecls; S.nM = __builtin_amdgcn_readfirstlane(tilecls[0]); S.G = nb; S.c = bid;
            pg8::EpiSwiglu8 E{P.ws + WS_BIG + BIG_H, (const float*)(P.ws + WS_ROWGATE)};
            for (int rep = 0; rep < REP_MOEA; ++rep) pg8::gemm_phase(lds, S, E, D, D, D);
        } else {
            pg8::SchedMoeA<false> S; S.A = (const char*)(P.ws + WS_BIG + BIG_HS); S.Wgu = (const char*)(P.ws + WS_WGU) + (size_t)LAYER * 16 * 2097152; S.tilecls = tilecls; S.nM = __builtin_amdgcn_readfirstlane(tilecls[0]); S.G = nb; S.c = bid;
            pg8::EpiSwiglu E{(bf16_t*)(P.ws + WS_BIG + BIG_H), (const float*)(P.ws + WS_ROWGATE)};
            for (int rep = 0; rep < REP_MOEA; ++rep) pg8::gemm_phase(lds, S, E, D, D, D);
        }
    }
    SEAM(PB + 5);
    if (IN(PB + 6)) {
        const Params& P = kparams();
        const int* tilecls = (const int*)(P.ws + WS_TILECLS);
        pg8::EpiResid E{(bf16_t*)(P.ws + WS_BIG + BIG_PRE2), (const bf16_t*)(P.ws + WS_BIG + BIG_HS)};
        if constexpr (MOE_FP8(LAYER)) {
            pg8::SchedMoeB<true> S; S.A = (const char*)(P.ws + WS_BIG + BIG_H); S.Wd = (const char*)(P.ws + WS_WD) + (size_t)LAYER * 16 * 1048576; S.tilecls = tilecls; S.nM = __builtin_amdgcn_readfirstlane(tilecls[0]); S.G = nb; S.c = bid;
            for (int rep = 0; rep < REP_MOEB; ++rep) pg8::gemm_phase<pg8::EpiResid, pg8::SchedMoeB<true>, true, 0x7c7c7c7c, 0x77777777>(lds, S, E, D / 2, D / 2, 256);
        } else {
            pg8::SchedMoeB<false> S; S.A = (const char*)(P.ws + WS_BIG + BIG_H); S.Wd = (const char*)(P.ws + WS_WD) + (size_t)LAYER * 16 * 1048576; S.tilecls = tilecls; S.nM = __builtin_amdgcn_readfirstlane(tilecls[0]); S.G = nb; S.c = bid;
            for (int rep = 0; rep < REP_MOEB; ++rep) pg8::gemm_phase(lds, S, E, D, D, 512);
        }
    }
    SEAM(PB + 6);
    if (IN(PB + 7)) for (int rep = 0; rep < REP_LNF; ++rep) phase_lnffn(kparams(), LAYER, bid, nb);
    if (LAYER == 0) SEAM(PB + 7);
#undef IN
#undef SEAM
}

__global__ void __launch_bounds__(NTHREADS, 2) mega_fwd(Args a) {
    LAS unsigned char* lds = (LAS unsigned char*)g_lds;
    if (threadIdx.x < 4) ((LAS unsigned*)(lds + LDS_BARW))[threadIdx.x] = 0u;
    if (TPROBE_ID != 0 && threadIdx.x < 4) ((LAS unsigned*)(lds + LDS_TPROBE))[threadIdx.x] = 0u;
    if ((threadIdx.x & 63) == 0) *(LAS int*)(lds + LDS_WIDTAB + 4 * hw_wave_key()) = (int)(threadIdx.x >> 6);
    __syncthreads();
    if (a.ph_hi - a.ph_lo > 1) (void)xcd_barrier_post((unsigned*)(kparams().ws + WS_CTL) + CW_BAR, (volatile LAS unsigned*)(lds + LDS_BARW));
    if (kphase_lo() <= 0 && 0 < kphase_hi()) { for (int rep = 0; rep < REP_CONV; ++rep) phase_convert(kparams(), lds, blockIdx.x, gridDim.x); if (1 < kphase_hi()) grid_barrier(lds); }
    layer_phases<0>(lds);
    layer_phases<1>(lds);
    if (TPROBE_ID != 0 && blockIdx.x == TPROBE_BLOCK && opaque_tid() == 0) {
        const unsigned long long need = ((LAS unsigned long long*)(lds + LDS_TPROBE))[0] * TPROBE_MULT, t0 = wall_clock64();
        while (wall_clock64() - t0 < need) __builtin_amdgcn_s_sleep(8);
    }
}

extern "C" void kernel_launch(void* const* d_in, const int* in_sizes, int n_in, void* d_out, int out_size, void* d_ws, size_t ws_size, hipStream_t stream) {
    static int grid = 0;
    if (!grid) {
        if (n_in != 30 || ws_size < WS_END || out_size != T * D) { fprintf(stderr, "kernel_launch: unexpected shapes n_in %d ws %zu out %d\n", n_in, ws_size, out_size); grid = -1; return; }
        int dev = 0, cus = 0, per_cu = 0;
        if (hipGetDevice(&dev) != hipSuccess || hipDeviceGetAttribute(&cus, hipDeviceAttributeMultiprocessorCount, dev) != hipSuccess) { grid = -1; return; }
        if (hipFuncSetAttribute((const void*)mega_fwd, hipFuncAttributeMaxDynamicSharedMemorySize, LDS_BYTES) != hipSuccess) { fprintf(stderr, "kernel_launch: hipFuncSetAttribute failed\n"); grid = -1; return; }
        if (hipOccupancyMaxActiveBlocksPerMultiprocessor(&per_cu, (const void*)mega_fwd, NTHREADS, LDS_BYTES) != hipSuccess || per_cu < 1)
            fprintf(stderr, "kernel_launch: note: occupancy query reports %d workgroups per CU\n", per_cu);
        grid = cus > 0 ? cus : 256;
    }
    if (grid < 0) return;
    Args a{};
    for (int i = 0; i < 30; ++i) a.P.in[i] = (const float*)d_in[i];
    a.P.out = (unsigned char*)d_out; a.P.ws = (unsigned char*)d_ws;
    (void)hipMemsetAsync((char*)d_ws + WS_CTL, 0, CTL_BYTES, stream);
    constexpr int NL = MK_N_LAUNCHES;
    if (NL == 1) { a.ph_lo = 0; a.ph_hi = NPHASES; hipLaunchKernelGGL(mega_fwd, dim3(grid), dim3(NTHREADS), LDS_BYTES, stream, a); }
    else for (int p = 0; p < NPHASES; ++p) { a.ph_lo = p; a.ph_hi = p + 1; hipLaunchKernelGGL(mega_fwd, dim3(grid), dim3(NTHREADS), LDS_BYTES, stream, a); }
}
```

```cpp
#include <hip/hip_runtime.h>
#include <cstdio>
#include <cstdint>

#ifndef MIX_LREP
#define MIX_LREP 1
#endif
#ifndef MIX_SREP
#define MIX_SREP 1
#endif
#ifndef MIX_EREP
#define MIX_EREP 1
#endif
#define GAS __attribute__((address_space(1)))
#define LAS __attribute__((address_space(3)))
typedef unsigned short bf16_t;
typedef short bf16x8 __attribute__((ext_vector_type(8)));
typedef float f32x4 __attribute__((ext_vector_type(4)));
typedef unsigned u32x4 __attribute__((ext_vector_type(4)));

constexpr int BATCH = 32, SEQ = 2048, T = BATCH * SEQ, D = 1024;
constexpr int NP = 6400;
constexpr int YOFF = 1024;
constexpr int NCLS = 24, MAXTILES = 280;
constexpr float LN_EPS = 1e-5f, NORM_EPS = 1e-6f;
constexpr float ALPHA = 1.41421356237f;
constexpr int NTHREADS_C = 512;

constexpr int C0_RQ = 0, C0_RK = 512, C0_RV = 1024, C0_MV = 2048, C0_RG = 3072, C0_MQ = 4096, C0_MK = 4608, C0_MO = 5120, C0_MI = 6144, C0_MF = 6148;
constexpr int C1_GQ = 0, C1_GK = 512, C1_GV = 1024, C1_SZ = 2048, C1_GR = 3072, C1_XS = 4096, C1_BM = 5120, C1_CM = 5632, C1_GA = 6144, C1_DT = 6160;

constexpr size_t MiB = 1u << 20;
constexpr size_t WS_CTL = 0, CTL_BYTES = 1 * MiB;
constexpr size_t WS_WIN0 = 2 * MiB;
constexpr size_t WS_WIN1 = 15 * MiB;
constexpr size_t WS_WOUT0 = 28 * MiB;
constexpr size_t WS_WOUT1 = 32 * MiB;
constexpr size_t WS_WGU = 36 * MiB;
constexpr size_t WS_WD = 100 * MiB;
constexpr size_t WS_TOKCLS = 132 * MiB;
constexpr size_t WS_TOKPOS = WS_TOKCLS + (size_t)T * 4;
constexpr size_t WS_TOKDST = WS_TOKPOS + (size_t)T * 4;
constexpr size_t WS_TOKGATE = WS_TOKDST + (size_t)T * 4;
constexpr size_t WS_ROWGATE = WS_TOKGATE + (size_t)T * 8;
constexpr size_t WS_TILECLS = WS_ROWGATE + (size_t)MAXTILES * 256 * 8;
constexpr size_t WS_BIG = 136 * MiB;
constexpr size_t BIG_HS = 0, BIG_H = 160 * MiB, BIG_PRE2 = 320 * MiB, BIG_HS8 = 480 * MiB;
constexpr size_t WS_H8 = WS_BIG + (size_t)T * NP * 2;
constexpr size_t WS_WIN8_0 = WS_H8 + (size_t)T * D;
constexpr size_t WS_WIN8_1 = WS_WIN8_0 + (size_t)NP * D;
constexpr size_t WS_END = WS_WIN8_1 + (size_t)NP * D;
static_assert(WS_TILECLS + (MAXTILES + 8) * 4 <= WS_BIG, "ws map");
static_assert(WS_END <= 1024 * MiB, "ws map");
constexpr size_t OUT_H = 0, OUT_PRE1 = 128 * MiB;
constexpr int CW_CNT = 1024;
constexpr int CW_BAR = 4096;

__device__ __forceinline__ unsigned f2bf(float f) { unsigned u = __builtin_bit_cast(unsigned, f); return (u + 0x7fffu + ((u >> 16) & 1u)) >> 16; }
__device__ __forceinline__ unsigned pk2(float lo, float hi) { return f2bf(lo) | (f2bf(hi) << 16); }
__device__ __forceinline__ float bf2f(unsigned short b) { return __builtin_bit_cast(float, ((unsigned)b) << 16); }
__device__ __forceinline__ float bflo(unsigned w) { return __builtin_bit_cast(float, w << 16); }
__device__ __forceinline__ float bfhi(unsigned w) { return __builtin_bit_cast(float, w & 0xffff0000u); }
__device__ __forceinline__ float sigmoidf_(float x) { return 1.f / (1.f + __expf(-x)); }
__device__ __forceinline__ float siluf_(float x) { return x / (1.f + __expf(-x)); }
__device__ __forceinline__ float softplusf_(float x) { return x > 20.f ? x : log1pf(expf(x)); }
__device__ __forceinline__ float logsigmoidf_(float x) { return -softplusf_(-x); }
__device__ __forceinline__ float wave_sum(float v) {
#define WS_DPP(ctrl, rm) v += __builtin_bit_cast(float, __builtin_amdgcn_update_dpp(0, __builtin_bit_cast(int, v), ctrl, rm, 0xf, false))
    WS_DPP(0x111, 0xf); WS_DPP(0x112, 0xf); WS_DPP(0x114, 0xf); WS_DPP(0x118, 0xf); WS_DPP(0x142, 0xa); WS_DPP(0x143, 0xc);
#undef WS_DPP
    return __builtin_bit_cast(float, __builtin_amdgcn_readlane(__builtin_bit_cast(int, v), 63));
}
#define LDS_WAIT() asm volatile("s_waitcnt lgkmcnt(0)" ::: "memory")
__device__ __forceinline__ unsigned pk4_fp8(float a, float b, float c, float d) { int w = __builtin_amdgcn_cvt_pk_fp8_f32(a, b, 0, false); w = __builtin_amdgcn_cvt_pk_fp8_f32(c, d, w, true); return (unsigned)w; }
#ifndef MOE_FP8
#define MOE_FP8(layer) ((layer) >= 0)
#endif
#ifndef MOEA_FP8
#define MOEA_FP8 1
#endif
#ifndef INPROJ_FP8MASK0
#define INPROJ_FP8MASK0 0x00fcfffcu
#endif
#ifndef INPROJ_FP8MASK1
#define INPROJ_FP8MASK1 0x01ffffffu
#endif
constexpr unsigned ALLTILES = 0x01ffffffu;
#ifndef INPROJ_FP8
#define INPROJ_FP8(layer) ((layer) == 1)
#endif
constexpr float H8_SCALE = 8.f, W8_SCALE = 256.f;
#ifndef TPROBE_ID
#define TPROBE_ID 0
#endif
#ifndef TPROBE_BLOCK
#define TPROBE_BLOCK 128
#endif
#ifndef TPROBE_MULT
#define TPROBE_MULT 4
#endif
constexpr int LDS_TPROBE = 163840 - 48;
__device__ __forceinline__ int opaque_tid();
__device__ __forceinline__ void tp_begin(LAS unsigned char* lds, int id) { if (TPROBE_ID != 0 && TPROBE_ID == id && opaque_tid() == 0) ((LAS unsigned long long*)(lds + LDS_TPROBE))[1] = wall_clock64(); }
__device__ __forceinline__ void tp_end(LAS unsigned char* lds, int id) { if (TPROBE_ID != 0 && TPROBE_ID == id && opaque_tid() == 0) { LAS unsigned long long* p = (LAS unsigned long long*)(lds + LDS_TPROBE); p[0] += wall_clock64() - p[1]; } }
extern __shared__ __attribute__((aligned(16))) unsigned char g_lds[];
constexpr int LDS_WIDTAB = 163840 - 512;
__device__ __forceinline__ int hw_wave_key() { return (int)__builtin_amdgcn_s_getreg((5 << 11) | 4) & 63; }
__device__ __forceinline__ int opaque_tid() {
    const int wid = __builtin_amdgcn_readfirstlane(*(volatile LAS int*)((LAS unsigned char*)g_lds + LDS_WIDTAB + 4 * hw_wave_key()));
    int t = wid * 64 + (int)__builtin_amdgcn_mbcnt_hi(~0u, __builtin_amdgcn_mbcnt_lo(~0u, 0u)); asm volatile("" : "+v"(t)); return t; }

namespace pg8 {
constexpr int BM = 256, BK = 64, HALF = 128, HTB = HALF * BK * 2, STAGE_BYTES = 8 * HTB, NXCD = 8, WGM = 8;
__host__ __device__ __forceinline__ int lds_byte(int r, int c) { const int st = (r >> 4) * 2 + (c >> 5), rr = r & 15, cc = c & 31, ob = rr * 64 + cc * 2; return st * 1024 + (ob ^ (((ob >> 9) & 1) << 5)); }
__host__ __device__ __forceinline__ void stage_rc(int b, int& R, int& C) { const int st = b / 1024, sb = b % 1024, swz = sb ^ (((sb >> 9) & 1) << 5); R = (st >> 1) * 16 + swz / 64; C = (st & 1) * 32 + (swz % 64) / 2; }
__host__ __device__ __forceinline__ int perm32(int rho) { const int n = rho >> 4, i = rho & 15; return 8 * (i >> 2) + 4 * n + (i & 3); }

struct Unit { int pm, pn; unsigned a, b0, b1; };

__device__ __forceinline__ bool static_tile(int i, int G, int c, int nM, int nN, int& pm, int& pn) {
    const int nwg = nM * nN; const int L = i * G + c; if (L >= nwg) return false;
    int wgid = L; { const int q = nwg / NXCD, r = nwg % NXCD, xcd = wgid % NXCD, off = wgid / NXCD; wgid = (xcd < r ? xcd * (q + 1) : r * (q + 1) + (xcd - r) * q) + off; }
    const int nig = WGM * nN, gid = wgid / nig, fm = gid * WGM, gsz = (nM - fm) < WGM ? (nM - fm) : WGM;
    pm = fm + ((wgid % nig) % gsz); pn = (wgid % nig) / gsz; return true;
}
template <class Tp> __device__ __forceinline__ Tp* uniform_ptr(Tp* p) {
    const unsigned long long v = (unsigned long long)p;
    const unsigned lo = __builtin_amdgcn_readfirstlane((unsigned)v), hi = __builtin_amdgcn_readfirstlane((unsigned)(v >> 32));
    return (Tp*)(((unsigned long long)hi << 32) | lo); }
__device__ __forceinline__ unsigned cvt_pk_bf16(float lo, float hi) { unsigned r; asm volatile("v_cvt_pk_bf16_f32 %0, %1, %2" : "=v"(r) : "v"(lo), "v"(hi)); return r; }

typedef int i32x8 __attribute__((ext_vector_type(8)));
typedef int i32x4v __attribute__((ext_vector_type(4)));
__device__ __forceinline__ i32x8 cat16(const bf16x8& lo, const bf16x8& hi) { const i32x4v a = __builtin_bit_cast(i32x4v, lo), b = __builtin_bit_cast(i32x4v, hi); return (i32x8){a[0], a[1], a[2], a[3], b[0], b[1], b[2], b[3]}; }
#ifndef PG8_SP2
#define PG8_SP2 true
#endif
#ifndef PG8_ALIGN
#define PG8_ALIGN true
#endif
template <class Epi, class Sched, bool FP8 = false, int SCA = 0x7f7f7f7f, int SCB = 0x7f7f7f7f, bool SP2 = PG8_SP2, bool ALIGN_EPI = PG8_ALIGN>
__device__ __forceinline__ void gemm_phase(LAS unsigned char* lds, const Sched& S, const Epi& E, const int K, const int lda, const int ldb) {
    const int tid = opaque_tid(), wid = __builtin_amdgcn_readfirstlane(tid >> 6), lane = tid & 63, wr = wid >> 2, wc = wid & 3, fr = lane & 15, fq = lane >> 4;
    int nt = K / BK; asm volatile("" : "+s"(nt));
    constexpr int KS = Sched::KSPLIT;
    unsigned voffA0, voffB0;
    { int R, C; stage_rc(tid * 16, R, C); const int Rb = (R & ~31) + perm32(R & 31); voffA0 = (unsigned)(R * lda + C) * 2u; voffB0 = (unsigned)(Rb * ldb + C) * 2u; }
    const unsigned q64A = 64u * lda * 2u, q64B = 64u * ldb * 2u;
    const unsigned kstep = (unsigned)(BK * 2);
    const unsigned hstepA = (unsigned)HALF * lda * 2, hstepB = (unsigned)HALF * ldb * 2;
    const __amdgpu_buffer_rsrc_t rsA = __builtin_amdgcn_make_buffer_rsrc((void*)S.A, 0, 0xffffffff, 0x00020000), rsB = __builtin_amdgcn_make_buffer_rsrc((void*)S.bbase(), 0, 0xffffffff, 0x00020000);
    const unsigned ldsw = (unsigned)wid * 1024u;
    const int aoff = lds_byte(wr * 64 + fr, fq * 8), boff = lds_byte(wc * 32 + fr, fq * 8);
#define PG8_BP(u, kt) ((KS > 0 && (kt) >= KS) ? (u).b1 + (unsigned)((kt) - KS) * kstep : (u).b0 + (unsigned)(kt) * kstep)
#define PG8_SA(b, h) (((b) * 2 + (h)) * HTB)
#define PG8_SB(b, h) ((4 + (b) * 2 + (h)) * HTB)
#define PG8_STAGEA(bufoff, soff) do { _Pragma("unroll") for (int _i = 0; _i < 2; ++_i) \
        __builtin_amdgcn_raw_ptr_buffer_load_lds(rsA, (LAS void*)(lds + (bufoff) + ldsw + _i * 8192), 16, voffA0, (int)((soff) + _i * q64A), 0, 0); } while (0)
#define PG8_STAGEB(bufoff, soff) do { _Pragma("unroll") for (int _i = 0; _i < 2; ++_i) \
        __builtin_amdgcn_raw_ptr_buffer_load_lds(rsB, (LAS void*)(lds + (bufoff) + ldsw + _i * 8192), 16, voffB0, (int)((soff) + _i * q64B), 0, 0); } while (0)
#define PG8_LDA(dst, b, h) do { _Pragma("unroll") for (int m = 0; m < 4; ++m) _Pragma("unroll") for (int k = 0; k < 2; ++k) dst[m][k] = *(const LAS bf16x8*)(lds + PG8_SA(b, h) + aoff + m * 2048 + k * 1024); } while (0)
#define PG8_LDB(dst, b, h) do { _Pragma("unroll") for (int n = 0; n < 2; ++n) _Pragma("unroll") for (int k = 0; k < 2; ++k) dst[n][k] = *(const LAS bf16x8*)(lds + PG8_SB(b, h) + boff + n * 2048 + k * 1024); } while (0)
#define PG8_MMA(ai, bj, At, Bt) do { __builtin_amdgcn_s_setprio(1); _Pragma("unroll") for (int m = 0; m < 4; ++m) _Pragma("unroll") for (int n = 0; n < 2; ++n) { \
        if constexpr (FP8) acc[ai][bj][m][n] = __builtin_amdgcn_mfma_scale_f32_16x16x128_f8f6f4(cat16(Bt[n][0], Bt[n][1]), cat16(At[m][0], At[m][1]), acc[ai][bj][m][n], 0, 0, 1, ((SCB & 0xff) << 8) | (SCA & 0xff), 0, ((SCB & 0xff) << 8) | (SCA & 0xff)); \
        else { _Pragma("unroll") for (int k = 0; k < 2; ++k) acc[ai][bj][m][n] = __builtin_amdgcn_mfma_f32_16x16x32_bf16(Bt[n][k], At[m][k], acc[ai][bj][m][n], 0, 0, 0); } } \
        __builtin_amdgcn_s_setprio(0); } while (0)
#define PG8_WAIT_V(n) asm volatile("s_waitcnt vmcnt(" #n ")" ::: "memory")
#define PG8_WAIT_L(n) asm volatile("s_waitcnt lgkmcnt(" #n ")" ::: "memory")
#define PG8_BAR __builtin_amdgcn_s_barrier()
#define PG8_SCHED __builtin_amdgcn_sched_barrier(0)
    Unit cur, nxt; int ui = 0;
    if (!S.next(0, cur)) return;
    f32x4 acc[2][2][4][2];
#pragma unroll
    for (int a = 0; a < 2; ++a)
#pragma unroll
        for (int b = 0; b < 2; ++b)
#pragma unroll
            for (int m = 0; m < 4; ++m)
#pragma unroll
                for (int n = 0; n < 2; ++n) acc[a][b][m][n] = (f32x4){0.f, 0.f, 0.f, 0.f};
    bf16x8 At[4][2], B0[2][2], B1[2][2];
    unsigned cA = cur.a;
    E.prefetch(cur, tid);
    { const unsigned cB0 = PG8_BP(cur, 0), cB1 = PG8_BP(cur, 1);
    if constexpr (SP2) {
        PG8_STAGEB(PG8_SB(0, 0), cB0); PG8_STAGEB(PG8_SB(0, 1), cB0 + hstepB); PG8_STAGEA(PG8_SA(0, 0), cA); PG8_STAGEA(PG8_SA(0, 1), cA + hstepA);
        if (wr == 1) PG8_BAR;
        PG8_WAIT_V(2); PG8_BAR;
        PG8_STAGEB(PG8_SB(1, 0), cB1); PG8_STAGEA(PG8_SA(1, 0), cA + kstep); PG8_STAGEB(PG8_SB(1, 1), cB1 + hstepB);
        PG8_WAIT_V(6); PG8_BAR;
    } else {
    PG8_STAGEB(PG8_SB(0, 0), cB0); PG8_STAGEA(PG8_SA(0, 0), cA); PG8_STAGEB(PG8_SB(0, 1), cB0 + hstepB); PG8_STAGEA(PG8_SA(0, 1), cA + hstepA);
    if (wr == 1) PG8_BAR;
    PG8_WAIT_V(4); PG8_BAR;
    PG8_STAGEB(PG8_SB(1, 0), cB1); PG8_STAGEA(PG8_SA(1, 0), cA + kstep); PG8_STAGEB(PG8_SB(1, 1), cB1 + hstepB);
    PG8_WAIT_V(6); PG8_BAR; } }
    for (;;) {
        const bool has_next = S.next(ui + 1, nxt);
        if (!has_next) nxt = cur;
        for (int t = 0; t < nt; t += 2) {
            const bool last = (t == nt - 2);
            const unsigned a1 = cA + (unsigned)(t + 1) * kstep;
            const unsigned a2 = last ? nxt.a : cA + (unsigned)(t + 2) * kstep;
            const unsigned b2 = last ? PG8_BP(nxt, 0) : PG8_BP(cur, t + 2);
            const unsigned a3 = a2 + kstep;
            const unsigned b3 = last ? PG8_BP(nxt, 1) : PG8_BP(cur, t + 3);
            if constexpr (SP2) {
            PG8_LDB(B0, 0, 0); PG8_LDB(B1, 0, 1); PG8_SCHED; PG8_LDA(At, 0, 0); PG8_STAGEA(PG8_SA(1, 1), a1 + hstepA);
            PG8_WAIT_V(8); PG8_WAIT_L(0); PG8_BAR; PG8_MMA(0, 0, At, B0); PG8_MMA(0, 1, At, B1); PG8_BAR; PG8_SCHED;
            PG8_LDA(At, 0, 1); PG8_STAGEB(PG8_SB(0, 0), b2); PG8_STAGEB(PG8_SB(0, 1), b2 + hstepB); PG8_STAGEA(PG8_SA(0, 0), a2);
            PG8_WAIT_V(8); PG8_WAIT_L(0); PG8_BAR; PG8_MMA(1, 0, At, B0); PG8_MMA(1, 1, At, B1); PG8_BAR; PG8_SCHED;
            PG8_LDB(B0, 1, 0); PG8_LDB(B1, 1, 1); PG8_SCHED; PG8_LDA(At, 1, 0); PG8_STAGEA(PG8_SA(0, 1), a2 + hstepA);
            PG8_WAIT_V(8); PG8_WAIT_L(0); PG8_BAR; PG8_MMA(0, 0, At, B0); PG8_MMA(0, 1, At, B1); PG8_BAR; PG8_SCHED;
            PG8_LDA(At, 1, 1); PG8_STAGEB(PG8_SB(1, 0), b3); PG8_STAGEB(PG8_SB(1, 1), b3 + hstepB); PG8_STAGEA(PG8_SA(1, 0), a3);
            PG8_WAIT_V(8); PG8_WAIT_L(0); PG8_BAR; PG8_MMA(1, 0, At, B0); PG8_MMA(1, 1, At, B1); PG8_BAR; PG8_SCHED;
            } else {
            PG8_LDB(B0, 0, 0); PG8_SCHED; PG8_LDA(At, 0, 0); PG8_STAGEA(PG8_SA(1, 1), a1 + hstepA);
            PG8_WAIT_L(8); PG8_BAR; PG8_WAIT_L(0); PG8_MMA(0, 0, At, B0); PG8_BAR; PG8_SCHED;
            PG8_LDB(B1, 0, 1); PG8_STAGEB(PG8_SB(0, 0), b2);
            PG8_BAR; PG8_WAIT_L(0); PG8_MMA(0, 1, At, B1); PG8_BAR;
            PG8_LDA(At, 0, 1); PG8_STAGEA(PG8_SA(0, 0), a2);
            PG8_BAR; PG8_WAIT_L(0); PG8_MMA(1, 0, At, B0); PG8_BAR; PG8_SCHED;
            PG8_STAGEB(PG8_SB(0, 1), b2 + hstepB);
            PG8_WAIT_V(6); PG8_BAR; PG8_MMA(1, 1, At, B1); PG8_BAR;
            PG8_LDB(B0, 1, 0); PG8_SCHED; PG8_LDA(At, 1, 0); PG8_STAGEA(PG8_SA(0, 1), a2 + hstepA);
            PG8_WAIT_L(8); PG8_BAR; PG8_WAIT_L(0); PG8_MMA(0, 0, At, B0); PG8_BAR; PG8_SCHED;
            PG8_LDB(B1, 1, 1); PG8_STAGEB(PG8_SB(1, 0), b3);
            PG8_BAR; PG8_WAIT_L(0); PG8_MMA(0, 1, At, B1); PG8_BAR;
            PG8_LDA(At, 1, 1); PG8_STAGEA(PG8_SA(1, 0), a3);
            PG8_BAR; PG8_WAIT_L(0); PG8_MMA(1, 0, At, B0); PG8_BAR; PG8_SCHED;
            PG8_STAGEB(PG8_SB(1, 1), b3 + hstepB);
            PG8_WAIT_V(6); PG8_BAR; PG8_MMA(1, 1, At, B1); PG8_BAR;
            }
        }
        if constexpr (ALIGN_EPI) { if (wr == 0) PG8_BAR; }
        E(acc, cur, wr, wc, fr, fq);
        if (!has_next) break;
#pragma unroll
        for (int a = 0; a < 2; ++a)
#pragma unroll
            for (int b = 0; b < 2; ++b)
#pragma unroll
                for (int m = 0; m < 4; ++m)
#pragma unroll
                    for (int n = 0; n < 2; ++n) acc[a][b][m][n] = (f32x4){0.f, 0.f, 0.f, 0.f};
        cur = nxt; cA = cur.a; ++ui;
        E.prefetch(cur, tid);
        if constexpr (ALIGN_EPI) { if (wr == 1) PG8_BAR; }
    }
    PG8_WAIT_V(0);
    if constexpr (!ALIGN_EPI) { if (wr == 0) PG8_BAR; }
    PG8_BAR;
#undef PG8_BP
#undef PG8_SA
#undef PG8_SB
#undef PG8_STAGEA
#undef PG8_STAGEB
#undef PG8_LDA
#undef PG8_LDB
#undef PG8_MMA
#undef PG8_WAIT_V
#undef PG8_WAIT_L
#undef PG8_BAR
#undef PG8_SCHED
}

struct SchedPlain {
    static constexpr int KSPLIT = 0;
    const char* A; const char* B; int lda, ldb, nM, nN, G, c;
    __device__ __forceinline__ const char* bbase() const { return B; }
    __device__ __forceinline__ bool next(int i, Unit& u) const {
        if (!static_tile(i, G, c, nM, nN, u.pm, u.pn)) return false;
        u.a = (unsigned)u.pm * BM * lda * 2; u.b0 = (unsigned)u.pn * BM * ldb * 2; u.b1 = u.b0; return true;
    }
};
struct SchedCols {
    static constexpr int KSPLIT = 0;
    const char* A; const char* B; int lda, ldb, nM, nN, G, c; unsigned mask;
    __device__ __forceinline__ const char* bbase() const { return B; }
    __device__ __forceinline__ bool next(int i, Unit& u) const {
        int pnj; if (!static_tile(i, G, c, nM, nN, u.pm, pnj)) return false;
        unsigned m = mask; for (int j = 0; j < pnj; ++j) m &= m - 1u;
        u.pn = __builtin_ctz(m);
        u.a = (unsigned)u.pm * BM * lda * 2; u.b0 = (unsigned)u.pn * BM * ldb * 2; u.b1 = u.b0; return true;
    }
};
__device__ __forceinline__ void cls_experts(int cls, int& e0, int& e1) {
    const int g = cls / 6, p = cls % 6;
    const int a = p < 3 ? 0 : (p < 5 ? 1 : 2);
    const int b = p < 3 ? p + 1 : (p < 5 ? p - 1 : 3);
    e0 = 4 * g + a; e1 = 4 * g + b;
}
template <bool FP8>
struct SchedMoeA {
    static constexpr int KSPLIT = 0;
    static constexpr int RB = FP8 ? 1024 : 2048;
    const char* A; const char* Wgu; const int* tilecls; int nM, G, c;
    __device__ __forceinline__ const char* bbase() const { return Wgu; }
    __device__ __forceinline__ bool next(int i, Unit& u) const {
        if (!static_tile(i, G, c, nM, 8, u.pm, u.pn)) return false;
        int e0, e1; cls_experts(__builtin_amdgcn_readfirstlane(tilecls[8 + u.pm]), e0, e1); const int e = (u.pn >> 2) ? e1 : e0;
        u.a = (unsigned)u.pm * BM * RB; u.b0 = (unsigned)e * 2097152u + (unsigned)(u.pn & 3) * 256 * RB; u.b1 = u.b0; return true;
    }
};
template <bool FP8>
struct SchedMoeB {
    static constexpr int KSPLIT = FP8 ? 4 : 8;
    static constexpr int RA = FP8 ? 1024 : 2048, RBB = FP8 ? 512 : 1024;
    const char* A; const char* Wd; const int* tilecls; int nM, G, c;
    __device__ __forceinline__ const char* bbase() const { return Wd; }
    __device__ __forceinline__ bool next(int i, Unit& u) const {
        if (!static_tile(i, G, c, nM, 4, u.pm, u.pn)) return false;
        int e0, e1; cls_experts(__builtin_amdgcn_readfirstlane(tilecls[8 + u.pm]), e0, e1);
        u.a = (unsigned)u.pm * BM * RA;
        u.b0 = (unsigned)e0 * 1048576u + (unsigned)u.pn * 256 * RBB; u.b1 = (unsigned)e1 * 1048576u + (unsigned)u.pn * 256 * RBB; return true;
    }
};

struct EpiStore {
    bf16_t* O; int ldc;
    __device__ __forceinline__ void prefetch(const Unit&, int) const {}
    __device__ __forceinline__ void operator()(const f32x4 (&acc)[2][2][4][2], const Unit& u, int wr, int wc, int fr, int fq) const {
        const int row0 = u.pm * BM + wr * 64 + fr, col0 = u.pn * BM + wc * 32 + 8 * fq;
#pragma unroll
        for (int ai = 0; ai < 2; ++ai)
#pragma unroll
            for (int m = 0; m < 4; ++m) { bf16_t* rowp = O + (size_t)(row0 + ai * HALF + m * 16) * ldc + col0;
#pragma unroll
                for (int bj = 0; bj < 2; ++bj) { const f32x4 v0 = acc[ai][bj][m][0], v1 = acc[ai][bj][m][1];
                    u32x4 w; w.x = cvt_pk_bf16(v0[0], v0[1]); w.y = cvt_pk_bf16(v0[2], v0[3]); w.z = cvt_pk_bf16(v1[0], v1[1]); w.w = cvt_pk_bf16(v1[2], v1[3]);
                    *(u32x4*)(rowp + bj * HALF) = w; } }
    }
};
struct EpiResid {
    bf16_t* O; const bf16_t* R;
    __device__ __forceinline__ void prefetch(const Unit& u, int tid) const {
        const bf16_t* p = R + (size_t)(u.pm * BM + (tid >> 1)) * 1024 + u.pn * BM + 128 * (tid & 1);
        asm volatile("s_mov_b32 m0, %2\n\ts_nop 0\n\tglobal_load_lds_dword %0, off\n\ts_mov_b32 m0, %3\n\ts_nop 0\n\tglobal_load_lds_dword %1, off"
                     :: "v"(p), "v"(p + 64), "s"(160768u), "s"(161024u) : "memory", "m0");
    }
    __device__ __forceinline__ void operator()(const f32x4 (&acc)[2][2][4][2], const Unit& u, int wr, int wc, int fr, int fq) const {
        const GAS bf16_t* const Rp = (const GAS bf16_t*)uniform_ptr(R); GAS bf16_t* const Op = (GAS bf16_t*)uniform_ptr(O);
        const unsigned base = (unsigned)(u.pm * BM + wr * 64 + fr) * 1024u + (unsigned)(u.pn * BM + wc * 32 + 8 * fq);
#pragma unroll
        for (int ai = 0; ai < 2; ++ai) {
            u32x4 r[4][2];
#pragma unroll
            for (int m = 0; m < 4; ++m)
#pragma unroll
                for (int bj = 0; bj < 2; ++bj) r[m][bj] = *(const GAS u32x4*)(Rp + (base + (unsigned)((ai * HALF + m * 16) * 1024 + bj * HALF)));
            __builtin_amdgcn_sched_barrier(0);
#pragma unroll
            for (int m = 0; m < 4; ++m)
#pragma unroll
                for (int bj = 0; bj < 2; ++bj) { const f32x4 v0 = acc[ai][bj][m][0], v1 = acc[ai][bj][m][1]; const u32x4 rr = r[m][bj];
                    u32x4 w; w.x = cvt_pk_bf16(v0[0] + ALPHA * bflo(rr.x), v0[1] + ALPHA * bfhi(rr.x)); w.y = cvt_pk_bf16(v0[2] + ALPHA * bflo(rr.y), v0[3] + ALPHA * bfhi(rr.y));
                    w.z = cvt_pk_bf16(v1[0] + ALPHA * bflo(rr.z), v1[1] + ALPHA * bfhi(rr.z)); w.w = cvt_pk_bf16(v1[2] + ALPHA * bflo(rr.w), v1[3] + ALPHA * bfhi(rr.w));
                    *(GAS u32x4*)(Op + (base + (unsigned)((ai * HALF + m * 16) * 1024 + bj * HALF))) = w; }
            __builtin_amdgcn_sched_barrier(0);
        }
    }
};
struct EpiSwiglu {
    bf16_t* H; const float* rowgate;
    __device__ __forceinline__ void prefetch(const Unit&, int) const {}
    __device__ __forceinline__ void operator()(const f32x4 (&acc)[2][2][4][2], const Unit& u, int wr, int wc, int fr, int fq) const {
        const int row0 = u.pm * BM + wr * 64 + fr, ke = u.pn >> 2, col0 = 512 * ke + 128 * (u.pn & 3) + wc * 32 + 8 * fq;
#pragma unroll
        for (int ai = 0; ai < 2; ++ai)
#pragma unroll
            for (int m = 0; m < 4; ++m) { const int row = row0 + ai * HALF + m * 16; const float gt = rowgate[(size_t)row * 2 + ke];
                const f32x4 g0 = acc[ai][0][m][0], g1 = acc[ai][0][m][1], u0 = acc[ai][1][m][0], u1 = acc[ai][1][m][1];
                float o[8];
#pragma unroll
                for (int j = 0; j < 4; ++j) { o[j] = siluf_(g0[j]) * u0[j] * gt; o[4 + j] = siluf_(g1[j]) * u1[j] * gt; }
                u32x4 w; w.x = cvt_pk_bf16(o[0], o[1]); w.y = cvt_pk_bf16(o[2], o[3]); w.z = cvt_pk_bf16(o[4], o[5]); w.w = cvt_pk_bf16(o[6], o[7]);
                *(u32x4*)(H + (size_t)row * 1024 + col0) = w; }
    }
};
struct EpiSwiglu8 {
    unsigned char* H; const float* rowgate;
    __device__ __forceinline__ void prefetch(const Unit&, int) const {}
    __device__ __forceinline__ void operator()(const f32x4 (&acc)[2][2][4][2], const Unit& u, int wr, int wc, int fr, int fq) const {
        typedef unsigned u32x2 __attribute__((ext_vector_type(2)));
        const int row0 = u.pm * BM + wr * 64 + fr, ke = u.pn >> 2, col0 = 512 * ke + 128 * (u.pn & 3) + wc * 32 + 8 * fq;
        GAS unsigned char* const H = (GAS unsigned char*)uniform_ptr(this->H); const GAS float* const rowgate = (const GAS float*)uniform_ptr(this->rowgate);
        float gts[2][4];
#pragma unroll
        for (int ai = 0; ai < 2; ++ai)
#pragma unroll
            for (int m = 0; m < 4; ++m) gts[ai][m] = rowgate[(unsigned)(row0 + ai * HALF + m * 16) * 2u + (unsigned)ke];
        __builtin_amdgcn_sched_barrier(0);
#pragma unroll
        for (int ai = 0; ai < 2; ++ai)
#pragma unroll
            for (int m = 0; m < 4; ++m) { const int row = row0 + ai * HALF + m * 16; const float gt = gts[ai][m] * 8.f;
                const f32x4 g0 = acc[ai][0][m][0], g1 = acc[ai][0][m][1], u0 = acc[ai][1][m][0], u1 = acc[ai][1][m][1];
                float o[8];
#pragma unroll
                for (int j = 0; j < 4; ++j) { o[j] = __builtin_amdgcn_fmed3f(g0[j] * __builtin_amdgcn_rcpf(1.f + __builtin_amdgcn_exp2f(-1.4426950408889634f * g0[j])) * u0[j] * gt, -440.f, 440.f);
                    o[4 + j] = __builtin_amdgcn_fmed3f(g1[j] * __builtin_amdgcn_rcpf(1.f + __builtin_amdgcn_exp2f(-1.4426950408889634f * g1[j])) * u1[j] * gt, -440.f, 440.f); }
                *(GAS u32x2*)(H + ((unsigned)row * 1024u + (unsigned)col0)) = (u32x2){pk4_fp8(o[0], o[1], o[2], o[3]), pk4_fp8(o[4], o[5], o[6], o[7])}; }
    }
};
}

struct Params {
    const float* in[30];
    unsigned char* out;
    unsigned char* ws;
};
enum { I_X = 0, I_POS, I_WINAB, I_RETG, I_MLCW, I_MLCB, I_MLBI, I_MLBF, I_MLG, I_WOUTAB, I_WINCD, I_GLAWA, I_GLABA, I_GLAG, I_SSDCW, I_SSDCB, I_SSDDTB, I_SSDALOG, I_SSDD, I_SSDG,
       I_WOUTCD, I_WR, I_BR, I_MOEG, I_MOEU, I_MOED, I_LNMG, I_LNMB, I_LNFG, I_LNFB };

template <class ColPtr>
__device__ __forceinline__ void tr_item(const ColPtr& cp, int ldw, bf16_t* WT, int ldt, int n0, int k0, LAS float* scr, int lane) {
    const float* p = cp(n0 + (lane & 31));
#pragma unroll 8
    for (int i = 0; i < 32; ++i) { const int kk = 2 * i + (lane >> 5); scr[kk * 33 + (lane & 31)] = p ? p[(size_t)(k0 + kk) * ldw] : 0.f; }
    LDS_WAIT();
    const int c = lane & 7;
#pragma unroll
    for (int j = 0; j < 4; ++j) { const int n = (lane >> 3) + 8 * j; const LAS float* s = scr + (8 * c) * 33 + n;
        u32x4 o; o.x = pk2(s[0 * 33], s[1 * 33]); o.y = pk2(s[2 * 33], s[3 * 33]); o.z = pk2(s[4 * 33], s[5 * 33]); o.w = pk2(s[6 * 33], s[7 * 33]);
        *(u32x4*)(WT + (size_t)(n0 + n) * ldt + k0 + 8 * c) = o; }
    LDS_WAIT();
}
template <class ColPtr>
__device__ __forceinline__ void tr_item_fp8(const ColPtr& cp, int ldw, unsigned char* WT, int ldt, int n0, int k0, float scale, LAS float* scr, int lane) {
    const float* p = cp(n0 + (lane & 31));
#pragma unroll 8
    for (int i = 0; i < 32; ++i) { const int kk = 2 * i + (lane >> 5); scr[kk * 33 + (lane & 31)] = p ? p[(size_t)(k0 + kk) * ldw] * scale : 0.f; }
    LDS_WAIT();
    const int c = lane & 7;
    typedef unsigned u32x2 __attribute__((ext_vector_type(2)));
#pragma unroll
    for (int j = 0; j < 4; ++j) { const int n = (lane >> 3) + 8 * j; const LAS float* s = scr + (8 * c) * 33 + n;
        *(u32x2*)(WT + (size_t)(n0 + n) * ldt + k0 + 8 * c) = (u32x2){pk4_fp8(s[0 * 33], s[1 * 33], s[2 * 33], s[3 * 33]), pk4_fp8(s[4 * 33], s[5 * 33], s[6 * 33], s[7 * 33])}; }
    LDS_WAIT();
}
__device__ __forceinline__ int map_ab(int n) {
    if (n < 2048) return n;
    if (n < 3072) return 4096 + (n - 2048);
    if (n < 4096) return 2048 + (n - 3072);
    if (n < 4608) return 3072 + (n - 4096);
    if (n < 5120) return 3584 + (n - 4608);
    if (n < 6152) return n;
    return -1;
}
__device__ __forceinline__ int map_cd(int n) {
    if (n < 2048) return n;
    if (n < 3072) return 3088 + (n - 2048);
    if (n < 4096) return 2048 + (n - 3072);
    if (n < 5120) return 4112 + (n - 4096);
    if (n < 5632) return 5136 + (n - 5120);
    if (n < 6144) return 5648 + (n - 5632);
    if (n < 6160) return 3072 + (n - 6144);
    if (n < 6176) return 6160 + (n - 6160);
    return -1;
}
template <bool FP8, class ColPtr>
__device__ __forceinline__ void tr_block(const ColPtr& cp, int ldw, void* WT, int ldt, int n0, int k0, float scale, LAS float* tile, int tid) {
    {   const int c4 = tid & 63, r0 = tid >> 6;
        const float* p = cp(n0 + 4 * c4);
        f32x4 v[8];
#pragma unroll
        for (int i = 0; i < 8; ++i) v[i] = p ? *(const f32x4*)(p + (size_t)(k0 + r0 + 8 * i) * ldw) : (f32x4){0.f, 0.f, 0.f, 0.f};
#pragma unroll
        for (int i = 0; i < 8; ++i) { LAS float* t = tile + (r0 + 8 * i) * 257 + 4 * c4; t[0] = v[i][0] * scale; t[1] = v[i][1] * scale; t[2] = v[i][2] * scale; t[3] = v[i][3] * scale; }
    }
    __syncthreads();
    {   const int kc = tid & 7, nr = tid >> 3;
#pragma unroll
        for (int j = 0; j < 4; ++j) { const int n = nr + 64 * j; const LAS float* t = tile + (8 * kc) * 257 + n;
            if constexpr (FP8) { typedef unsigned u32x2 __attribute__((ext_vector_type(2)));
                *(u32x2*)((unsigned char*)WT + (size_t)(n0 + n) * ldt + k0 + 8 * kc) = (u32x2){pk4_fp8(t[0], t[257], t[514], t[771]), pk4_fp8(t[1028], t[1285], t[1542], t[1799])}; }
            else { u32x4 o; o.x = pk2(t[0], t[257]); o.y = pk2(t[514], t[771]); o.z = pk2(t[1028], t[1285]); o.w = pk2(t[1542], t[1799]);
                *(u32x4*)((bf16_t*)WT + (size_t)(n0 + n) * ldt + k0 + 8 * kc) = o; } }
    }
    __syncthreads();
}
__device__ __forceinline__ void convert_moe(const Params& P, LAS unsigned char* lds, int bid, int nb) {
    const int tid = opaque_tid();
    LAS float* tile = (LAS float*)lds;
    unsigned char* ws = P.ws;
    constexpr int B_GU = (1024 / 256) * (1024 / 64);
    constexpr int B_DN = (1024 / 256) * (512 / 64);
    constexpr int B_IN = (NP / 256) * (D / 64);
    constexpr int B_OUT = (1024 / 256) * (2048 / 64);
#pragma unroll 1
    for (int it = bid; it < 32 * B_GU + 32 * B_DN + B_IN + 2 * B_OUT; it += nb) {
        int r = it;
        if (r < B_IN) { const int nbk = r / (D / 64), kb = r % (D / 64);
            const float* W = P.in[I_WINCD];
            auto cp = [&](int n) { const int sc = map_cd(n); return sc < 0 ? (const float*)nullptr : W + sc; };
            if ((INPROJ_FP8MASK1 >> nbk) & 1u) tr_block<true>(cp, 6176, ws + WS_WIN8_1, D, nbk * 256, kb * 64, W8_SCALE, tile, tid); else tr_block<false>(cp, 6176, ws + WS_WIN1, D, nbk * 256, kb * 64, 1.f, tile, tid);
            continue; }
        r -= B_IN;
        if (r < 2 * B_OUT) { const int l = r / B_OUT; r %= B_OUT; const int nbk = r / 32, kb = r % 32;
            const float* W = P.in[l ? I_WOUTCD : I_WOUTAB];
            tr_block<false>([&](int n) { return W + n; }, 1024, ws + (l ? WS_WOUT1 : WS_WOUT0), 2048, nbk * 256, kb * 64, 1.f, tile, tid);
            continue; }
        r -= 2 * B_OUT;
        if (r < 32 * B_GU) { const int le = r / B_GU; r %= B_GU; const int nbk = r / 16, kb = r % 16;
            const float* Wg = P.in[I_MOEG] + (size_t)le * 1024 * 512 + 128 * nbk; const float* Wu = P.in[I_MOEU] + (size_t)le * 1024 * 512 + 128 * nbk; const int n0 = nbk * 256;
            auto cp = [&](int n) { const int wdt = n - n0; return wdt < 128 ? Wg + wdt : Wu + (wdt - 128); };
            if (MOE_FP8(le >> 4) && MOEA_FP8) tr_block<true>(cp, 512, ws + WS_WGU + (size_t)le * 2097152, 1024, n0, kb * 64, W8_SCALE, tile, tid);
            else tr_block<false>(cp, 512, ws + WS_WGU + (size_t)le * 2097152, 1024, n0, kb * 64, 1.f, tile, tid);
            continue; }
        r -= 32 * B_GU;
        { const int le = r / B_DN; r %= B_DN; const int nbk = r / 8, kb = r % 8;
            const float* W = P.in[I_MOED] + (size_t)le * 512 * 1024;
            if (MOE_FP8(le >> 4)) tr_block<true>([&](int n) { return W + n; }, 1024, ws + WS_WD + (size_t)le * 1048576, 512, nbk * 256, kb * 64, W8_SCALE, tile, tid);
            else tr_block<false>([&](int n) { return W + n; }, 1024, ws + WS_WD + (size_t)le * 1048576, 512, nbk * 256, kb * 64, 1.f, tile, tid); }
    }
}
__device__ __forceinline__ void phase_convert(const Params& P, LAS unsigned char* lds, int bid, int nb) {
    const int tid = opaque_tid();
    LAS float* tile = (LAS float*)lds;
    unsigned char* ws = P.ws;
    constexpr int B_IN = (NP / 256) * (D / 64);
    tp_begin(lds, 910);
#pragma unroll 1
    for (int it = bid; it < B_IN; it += nb) {
        const int nbk = it / (D / 64), kb = it % (D / 64);
        const float* W = P.in[I_WINAB];
        auto cp = [&](int n) { const int sc = map_ab(n); return sc < 0 ? (const float*)nullptr : W + sc; };
        if ((INPROJ_FP8MASK0 >> nbk) & 1u) tr_block<true>(cp, 6152, ws + WS_WIN8_0, D, nbk * 256, kb * 64, W8_SCALE, tile, tid); else tr_block<false>(cp, 6152, ws + WS_WIN0, D, nbk * 256, kb * 64, 1.f, tile, tid);
    }
    const int nw = blockDim.x >> 6; (void)nw;
    asm volatile("s_waitcnt vmcnt(0)" ::: "memory"); tp_end(lds, 910); tp_begin(lds, 911);
    const float* x = P.in[I_X]; bf16_t* h = (bf16_t*)(P.out + OUT_H);
    const size_t n8 = (size_t)T * D / 8;
    const size_t stride = (size_t)nb * blockDim.x;
    for (size_t i0 = (size_t)bid * blockDim.x + tid; i0 < n8; i0 += 4 * stride) {
        f32x4 a[4], b[4];
#pragma unroll
        for (int u = 0; u < 4; ++u) { const size_t i = i0 + u * stride; if (i < n8) { a[u] = *(const f32x4*)(x + i * 8); b[u] = *(const f32x4*)(x + i * 8 + 4); } }
#pragma unroll
        for (int u = 0; u < 4; ++u) { const size_t i = i0 + u * stride; if (i < n8) {
            u32x4 o; o.x = pk2(a[u][0], a[u][1]); o.y = pk2(a[u][2], a[u][3]); o.z = pk2(b[u][0], b[u][1]); o.w = pk2(b[u][2], b[u][3]);
            *(u32x4*)(h + i * 8) = o;
            typedef unsigned u32x2 __attribute__((ext_vector_type(2)));
            *(u32x2*)(ws + WS_H8 + i * 8) = (u32x2){pk4_fp8(a[u][0] * H8_SCALE, a[u][1] * H8_SCALE, a[u][2] * H8_SCALE, a[u][3] * H8_SCALE), pk4_fp8(b[u][0] * H8_SCALE, b[u][1] * H8_SCALE, b[u][2] * H8_SCALE, b[u][3] * H8_SCALE)}; } }
    }
    asm volatile("s_waitcnt vmcnt(0)" ::: "memory"); tp_end(lds, 911);
}

__device__ __forceinline__ void load_row_bf16(const bf16_t* row, int lane, float (&v)[16]) {
#pragma unroll
    for (int j = 0; j < 2; ++j) { const u32x4 w = *(const u32x4*)(row + 8 * lane + 512 * j);
        v[8 * j + 0] = bflo(w.x); v[8 * j + 1] = bfhi(w.x); v[8 * j + 2] = bflo(w.y); v[8 * j + 3] = bfhi(w.y);
        v[8 * j + 4] = bflo(w.z); v[8 * j + 5] = bfhi(w.z); v[8 * j + 6] = bflo(w.w); v[8 * j + 7] = bfhi(w.w); }
}
__device__ __forceinline__ void ln_row(float (&v)[16], const float* g, const float* b, int lane) {
    float s = 0.f;
#pragma unroll
    for (int i = 0; i < 16; ++i) s += v[i];
    const float mean = wave_sum(s) * (1.f / D); float q = 0.f;
#pragma unroll
    for (int i = 0; i < 16; ++i) { v[i] -= mean; q += v[i] * v[i]; }
    const float rstd = rsqrtf(wave_sum(q) * (1.f / D) + LN_EPS);
#pragma unroll
    for (int j = 0; j < 2; ++j) {
        const f32x4 g0 = *(const f32x4*)(g + 8 * lane + 512 * j), g1 = *(const f32x4*)(g + 8 * lane + 512 * j + 4);
        const f32x4 b0 = *(const f32x4*)(b + 8 * lane + 512 * j), b1 = *(const f32x4*)(b + 8 * lane + 512 * j + 4);
#pragma unroll
        for (int i = 0; i < 4; ++i) { v[8 * j + i] = v[8 * j + i] * rstd * g0[i] + b0[i]; v[8 * j + 4 + i] = v[8 * j + 4 + i] * rstd * g1[i] + b1[i]; }
    }
}
__device__ __forceinline__ void load_gb(const float* g, const float* b, int lane, float (&gr)[16], float (&br)[16]) {
#pragma unroll
    for (int j = 0; j < 2; ++j) {
        const f32x4 g0 = *(const f32x4*)(g + 8 * lane + 512 * j), g1 = *(const f32x4*)(g + 8 * lane + 512 * j + 4);
        const f32x4 b0 = *(const f32x4*)(b + 8 * lane + 512 * j), b1 = *(const f32x4*)(b + 8 * lane + 512 * j + 4);
#pragma unroll
        for (int i = 0; i < 4; ++i) { gr[8 * j + i] = g0[i]; gr[8 * j + 4 + i] = g1[i]; br[8 * j + i] = b0[i]; br[8 * j + 4 + i] = b1[i]; }
    }
}
__device__ __forceinline__ void ln_row_r(float (&v)[16], const float (&gr)[16], const float (&br)[16]) {
    float s = 0.f;
#pragma unroll
    for (int i = 0; i < 16; ++i) s += v[i];
    const float mean = wave_sum(s) * (1.f / D); float q = 0.f;
#pragma unroll
    for (int i = 0; i < 16; ++i) { v[i] -= mean; q += v[i] * v[i]; }
    const float rstd = rsqrtf(wave_sum(q) * (1.f / D) + LN_EPS);
#pragma unroll
    for (int i = 0; i < 16; ++i) v[i] = v[i] * rstd * gr[i] + br[i];
}
__device__ __forceinline__ void store_row_bf16(bf16_t* row, int lane, const float (&v)[16]) {
#pragma unroll
    for (int j = 0; j < 2; ++j) { u32x4 o; o.x = pk2(v[8 * j + 0], v[8 * j + 1]); o.y = pk2(v[8 * j + 2], v[8 * j + 3]); o.z = pk2(v[8 * j + 4], v[8 * j + 5]); o.w = pk2(v[8 * j + 6], v[8 * j + 7]);
        *(u32x4*)(row + 8 * lane + 512 * j) = o; }
}

__device__ __forceinline__ void phase_route(const Params& P, int layer, LAS unsigned char* lds, int bid, int nb, int cntoff) {
    const int tid = opaque_tid(), lane = tid & 63, wave = tid >> 6;
    LAS unsigned char* Bhi = lds; LAS unsigned char* Blo = lds + 32768;
    LAS float* cd = (LAS float*)(lds + 65536);
    LAS float* part = cd + 32;
    LAS int* lcnt = (LAS int*)(part + 1024);
    LAS int* lbase = lcnt + 32; LAS int* rcls = lbase + 32; LAS int* rpos = rcls + 256;
    const bf16_t* pre1 = (const bf16_t*)(P.out + OUT_PRE1);
    const float* g = P.in[I_LNMG] + layer * D; const float* b = P.in[I_LNMB] + layer * D;
    const float* Wr = P.in[I_WR]; const float* br = P.in[I_BR];
    int* tokcls = (int*)(P.ws + WS_TOKCLS); int* tokpos = (int*)(P.ws + WS_TOKPOS); float* tokgate = (float*)(P.ws + WS_TOKGATE);
    unsigned* gcnt = (unsigned*)(P.ws + WS_CTL) + CW_CNT + 64 * layer + cntoff;
#pragma unroll 1
    for (int idx = tid; idx < 2048; idx += NTHREADS_C) {
        const int s = idx >> 6, l = idx & 63, e = l & 15, k0 = 32 * s + 8 * (l >> 4);
        unsigned hi[4], lo[4];
#pragma unroll
        for (int j = 0; j < 4; ++j) {
            const float w0 = g[k0 + 2 * j] * Wr[(k0 + 2 * j) * 16 + e], w1 = g[k0 + 2 * j + 1] * Wr[(k0 + 2 * j + 1) * 16 + e];
            const unsigned h0 = f2bf(w0), h1 = f2bf(w1);
            hi[j] = h0 | (h1 << 16); lo[j] = pk2(w0 - bf2f((unsigned short)h0), w1 - bf2f((unsigned short)h1)); }
        *(LAS u32x4*)(Bhi + idx * 16) = (u32x4){hi[0], hi[1], hi[2], hi[3]};
        *(LAS u32x4*)(Blo + idx * 16) = (u32x4){lo[0], lo[1], lo[2], lo[3]};
    }
    { const int e = tid & 15, pt = tid >> 4; float cs = 0.f, ds = 0.f;
#pragma unroll 4
      for (int kk = 0; kk < 32; ++kk) { const int k = pt * 32 + kk; const float w = Wr[k * 16 + e]; cs += g[k] * w; ds += b[k] * w; }
      part[pt * 32 + e] = cs; part[pt * 32 + 16 + e] = ds; }
    __syncthreads();
    if (tid < 32) { float sacc = 0.f;
#pragma unroll 4
        for (int pt = 0; pt < 32; ++pt) sacc += part[pt * 32 + tid];
        cd[tid] = sacc; }
    __syncthreads();
    const int e = lane & 15, q = lane >> 4;
    const float ce = cd[e], de = cd[16 + e], bre = br[e];
    for (int r0 = bid * 256; r0 < T; r0 += nb * 256) {
        if (tid < 32) lcnt[tid] = 0;
        __syncthreads();
#pragma unroll 1
        for (int tile = 0; tile < 2; ++tile) {
            const int tr0 = wave * 32 + tile * 16;
            const bf16_t* arow = pre1 + (size_t)(r0 + tr0 + e) * D + 8 * q;
            f32x4 acc = (f32x4){0.f, 0.f, 0.f, 0.f}; float s1 = 0.f, s2 = 0.f;
#pragma unroll 1
            for (int s0 = 0; s0 < 32; s0 += 8) {
                u32x4 a[8];
#pragma unroll
                for (int u = 0; u < 8; ++u) a[u] = *(const u32x4*)(arow + 32 * (s0 + u));
#pragma unroll
                for (int u = 0; u < 8; ++u) {
                    const bf16x8 bh = *(const LAS bf16x8*)(Bhi + ((s0 + u) * 64 + lane) * 16), bl = *(const LAS bf16x8*)(Blo + ((s0 + u) * 64 + lane) * 16);
                    const bf16x8 af = __builtin_bit_cast(bf16x8, a[u]);
                    acc = __builtin_amdgcn_mfma_f32_16x16x32_bf16(af, bh, acc, 0, 0, 0);
                    acc = __builtin_amdgcn_mfma_f32_16x16x32_bf16(af, bl, acc, 0, 0, 0);
                    const float x0 = bflo(a[u].x), x1 = bfhi(a[u].x), x2 = bflo(a[u].y), x3 = bfhi(a[u].y), x4 = bflo(a[u].z), x5 = bfhi(a[u].z), x6 = bflo(a[u].w), x7 = bfhi(a[u].w);
                    s1 += ((x0 + x1) + (x2 + x3)) + ((x4 + x5) + (x6 + x7));
                    s2 += ((x0 * x0 + x1 * x1) + (x2 * x2 + x3 * x3)) + ((x4 * x4 + x5 * x5) + (x6 * x6 + x7 * x7));
                }
            }
            s1 += __shfl_xor(s1, 16); s1 += __shfl_xor(s1, 32); s2 += __shfl_xor(s2, 16); s2 += __shfl_xor(s2, 32);
            const float mean = s1 * (1.f / D); const float rstd = rsqrtf(fmaxf(s2 * (1.f / D) - mean * mean, 0.f) + LN_EPS);
#pragma unroll
            for (int r = 0; r < 4; ++r) {
                const int R = 4 * q + r;
                const float mr = __shfl(mean, R), rr = __shfl(rstd, R);
                const float lg = rr * (acc[r] - mr * ce) + de;
                float mx = lg;
#pragma unroll
                for (int o = 1; o < 16; o <<= 1) mx = fmaxf(mx, __shfl_xor(mx, o));
                float p = expf(lg - mx), sum = p;
#pragma unroll
                for (int o = 1; o < 16; o <<= 1) sum += __shfl_xor(sum, o);
                p = p / sum;
                const float sel = p + bre;
                int rank = 0;
#pragma unroll
                for (int o = 1; o < 4; ++o) { const float so = __shfl_xor(sel, o); const int eo = e ^ o; rank += (so > sel || (so == sel && eo < e)) ? 1 : 0; }
                float gs = rank < 2 ? sel : 0.f;
                gs += __shfl_xor(gs, 1); gs += __shfl_xor(gs, 2);
                int gi = e >> 2;
#pragma unroll
                for (int o = 4; o < 16; o <<= 1) { const float go = __shfl_xor(gs, o); const int io = __shfl_xor(gi, o); if (go > gs || (go == gs && io < gi)) { gs = go; gi = io; } }
                const bool chosen = ((e >> 2) == gi) && rank < 2;
                const unsigned long long bm = __ballot(chosen);
                const unsigned m4 = (unsigned)(bm >> (16 * q + 4 * gi)) & 0xFu;
                const int ea = __ffs((int)m4) - 1, eb = 31 - __clz((int)m4);
                const int pidx = ea == 0 ? eb - 1 : (ea == 1 ? eb + 1 : 5);
                const float pa = __shfl(p, 16 * q + 4 * gi + ea), pb = __shfl(p, 16 * q + 4 * gi + eb);
                if (e == r) { const int cls = gi * 6 + pidx; const int rl = tr0 + R; const int lp = atomicAdd((int*)&lcnt[cls], 1); rcls[rl] = cls; rpos[rl] = lp;
                    const float inv = 1.f / (pa + pb); const size_t t = (size_t)(r0 + rl); tokgate[t * 2] = pa * inv; tokgate[t * 2 + 1] = pb * inv; }
            }
        }
        __syncthreads();
        if (tid < NCLS) lbase[tid] = (int)atomicAdd(&gcnt[tid], (unsigned)lcnt[tid]);
        __syncthreads();
        if (tid < 256) { const int t = r0 + tid; const int c = rcls[tid]; tokcls[t] = c; tokpos[t] = lbase[c] + rpos[tid]; }
        __syncthreads();
    }
}
__device__ __forceinline__ void phase_permute(const Params& P, int layer, LAS unsigned char* lds, int bid, int nb) {
    const int tid = opaque_tid(), lane = tid & 63, wave = tid >> 6, nw = blockDim.x >> 6;
    LAS int* off = (LAS int*)lds;
    const unsigned* gcnt = (const unsigned*)(P.ws + WS_CTL) + CW_CNT + 64 * layer;
    int* tilecls = (int*)(P.ws + WS_TILECLS);
    if (tid == 0) { int o = 0; for (int c = 0; c < NCLS; ++c) { off[c] = o * 256; const int nt = ((int)gcnt[c] + 255) >> 8;
            if (bid == 0) for (int i = 0; i < nt; ++i) tilecls[8 + o + i] = c;
            o += nt; }
        if (bid == 0) tilecls[0] = o; }
    __syncthreads();
    const bf16_t* pre1 = (const bf16_t*)(P.out + OUT_PRE1); bf16_t* hs = (bf16_t*)(P.ws + WS_BIG + BIG_HS);
    const float* g = P.in[I_LNMG] + layer * D; const float* b = P.in[I_LNMB] + layer * D;
    const int* tokcls = (const int*)(P.ws + WS_TOKCLS); const int* tokpos = (const int*)(P.ws + WS_TOKPOS); int* tokdst = (int*)(P.ws + WS_TOKDST);
    const float* tokgate = (const float*)(P.ws + WS_TOKGATE); float* rowgate = (float*)(P.ws + WS_ROWGATE);
    float gr[16], br[16]; load_gb(g, b, lane, gr, br);
    for (int t0 = bid * nw + wave; t0 < T; t0 += 2 * nb * nw) {
        const int t1 = t0 + nb * nw; const bool has1 = t1 < T;
        float v0[16], v1[16];
        load_row_bf16(pre1 + (size_t)t0 * D, lane, v0);
        if (has1) load_row_bf16(pre1 + (size_t)t1 * D, lane, v1);
        const int dst0 = off[tokcls[t0]] + tokpos[t0]; const int dst1 = has1 ? off[tokcls[t1]] + tokpos[t1] : 0;
#pragma unroll
        for (int rr = 0; rr < 2; ++rr) {
            if (rr == 1 && !has1) break;
            float (&v)[16] = rr ? v1 : v0; const int t = rr ? t1 : t0, dst = rr ? dst1 : dst0;
            ln_row_r(v, gr, br);
            store_row_bf16(hs + (size_t)dst * D, lane, v);
            if (MOE_FP8(layer) && MOEA_FP8) { typedef unsigned u32x2 __attribute__((ext_vector_type(2)));
#pragma unroll
                for (int j = 0; j < 2; ++j) *(u32x2*)(P.ws + WS_BIG + BIG_HS8 + (size_t)dst * D + 8 * lane + 512 * j) = (u32x2){pk4_fp8(v[8 * j] * H8_SCALE, v[8 * j + 1] * H8_SCALE, v[8 * j + 2] * H8_SCALE, v[8 * j + 3] * H8_SCALE), pk4_fp8(v[8 * j + 4] * H8_SCALE, v[8 * j + 5] * H8_SCALE, v[8 * j + 6] * H8_SCALE, v[8 * j + 7] * H8_SCALE)}; }
            if (lane == 0) { tokdst[t] = dst; rowgate[(size_t)dst * 2] = tokgate[(size_t)t * 2]; rowgate[(size_t)dst * 2 + 1] = tokgate[(size_t)t * 2 + 1]; }
        }
    }
}
__device__ __forceinline__ void phase_lnffn(const Params& P, int layer, int bid, int nb) {
    const int tid = opaque_tid(), lane = tid & 63, wave = tid >> 6, nw = blockDim.x >> 6;
    const bf16_t* pre2 = (const bf16_t*)(P.ws + WS_BIG + BIG_PRE2);
    const float* g = P.in[I_LNFG] + layer * D; const float* b = P.in[I_LNFB] + layer * D;
    const int* tokdst = (const int*)(P.ws + WS_TOKDST);
    float gr[16], br[16]; load_gb(g, b, lane, gr, br);
    for (int t0 = bid * nw + wave; t0 < T; t0 += 2 * nb * nw) {
        const int t1 = t0 + nb * nw; const bool has1 = t1 < T;
        float v0[16], v1[16];
        load_row_bf16(pre2 + (size_t)tokdst[t0] * D, lane, v0);
        if (has1) load_row_bf16(pre2 + (size_t)tokdst[t1] * D, lane, v1);
#pragma unroll
        for (int rr = 0; rr < 2; ++rr) {
            if (rr == 1 && !has1) break;
            float (&v)[16] = rr ? v1 : v0; const int t = rr ? t1 : t0;
            ln_row_r(v, gr, br);
            if (layer == 0) { store_row_bf16((bf16_t*)(P.out + OUT_H) + (size_t)t * D, lane, v);
                typedef unsigned u32x2 __attribute__((ext_vector_type(2)));
#pragma unroll
                for (int j = 0; j < 2; ++j) *(u32x2*)(P.ws + WS_H8 + (size_t)t * D + 8 * lane + 512 * j) = (u32x2){pk4_fp8(v[8 * j] * H8_SCALE, v[8 * j + 1] * H8_SCALE, v[8 * j + 2] * H8_SCALE, v[8 * j + 3] * H8_SCALE), pk4_fp8(v[8 * j + 4] * H8_SCALE, v[8 * j + 5] * H8_SCALE, v[8 * j + 6] * H8_SCALE, v[8 * j + 7] * H8_SCALE)}; }
            else { float* o = (float*)P.out + (size_t)t * D;
#pragma unroll
                for (int j = 0; j < 2; ++j) { *(f32x4*)(o + 8 * lane + 512 * j) = (f32x4){v[8 * j], v[8 * j + 1], v[8 * j + 2], v[8 * j + 3]}; *(f32x4*)(o + 8 * lane + 512 * j + 4) = (f32x4){v[8 * j + 4], v[8 * j + 5], v[8 * j + 6], v[8 * j + 7]}; } }
        }
    }
}

enum { MIX_RET = 0, MIX_ML = 1, MIX_GLA = 2, MIX_SSD = 3 };
typedef short s16x4 __attribute__((ext_vector_type(4)));
__device__ __forceinline__ bf16x8 tr_frag(LAS unsigned char* p0, LAS unsigned char* p1) {
    const s16x4 a = __builtin_amdgcn_ds_read_tr16_b64_v4i16((LAS s16x4*)p0), b = __builtin_amdgcn_ds_read_tr16_b64_v4i16((LAS s16x4*)p1);
    return (bf16x8){a[0], a[1], a[2], a[3], b[0], b[1], b[2], b[3]};
}
__device__ __forceinline__ bf16x8 cat_frag(LAS unsigned char* p0, LAS unsigned char* p1) {
    const s16x4 a = *(LAS s16x4*)p0, b = *(LAS s16x4*)p1;
    return (bf16x8){a[0], a[1], a[2], a[3], b[0], b[1], b[2], b[3]};
}
__device__ __forceinline__ bf16x8 pack_acc(const f32x4& lo, const f32x4& hi) {
    u32x4 w; w.x = pg8::cvt_pk_bf16(lo[0], lo[1]); w.y = pg8::cvt_pk_bf16(lo[2], lo[3]); w.z = pg8::cvt_pk_bf16(hi[0], hi[1]); w.w = pg8::cvt_pk_bf16(hi[2], hi[3]);
    return __builtin_bit_cast(bf16x8, w);
}
__device__ __forceinline__ void unpack8(const u32x4& w, float (&v)[8]) {
    v[0] = bflo(w.x); v[1] = bfhi(w.x); v[2] = bflo(w.y); v[3] = bfhi(w.y); v[4] = bflo(w.z); v[5] = bfhi(w.z); v[6] = bflo(w.w); v[7] = bfhi(w.w);
}
__device__ __forceinline__ u32x4 pack8(const float (&v)[8]) {
    u32x4 w; w.x = pg8::cvt_pk_bf16(v[0], v[1]); w.y = pg8::cvt_pk_bf16(v[2], v[3]); w.z = pg8::cvt_pk_bf16(v[4], v[5]); w.w = pg8::cvt_pk_bf16(v[6], v[7]); return w;
}

template <int CTRL, int RM> __device__ __forceinline__ float dpp_take(float old, float v) { return __builtin_bit_cast(float, __builtin_amdgcn_update_dpp(__builtin_bit_cast(int, old), __builtin_bit_cast(int, v), CTRL, RM, 0xf, false)); }
__device__ __forceinline__ float wave_scan_add(float v) {
    v += dpp_take<0x111, 0xf>(0.f, v); v += dpp_take<0x112, 0xf>(0.f, v); v += dpp_take<0x114, 0xf>(0.f, v); v += dpp_take<0x118, 0xf>(0.f, v);
    v += dpp_take<0x142, 0xa>(0.f, v); v += dpp_take<0x143, 0xc>(0.f, v); return v; }
__device__ __forceinline__ float wave_scan_max(float v) {
    const float ni = -3.0e38f;
    v = fmaxf(v, dpp_take<0x111, 0xf>(ni, v)); v = fmaxf(v, dpp_take<0x112, 0xf>(ni, v)); v = fmaxf(v, dpp_take<0x114, 0xf>(ni, v)); v = fmaxf(v, dpp_take<0x118, 0xf>(ni, v));
    v = fmaxf(v, dpp_take<0x142, 0xa>(ni, v)); v = fmaxf(v, dpp_take<0x143, 0xc>(ni, v)); return v; }
__device__ __forceinline__ float fexp(float x) { return __builtin_amdgcn_exp2f(x * 1.4426950408889634f); }
__device__ __forceinline__ float frcp(float x) { return __builtin_amdgcn_rcpf(x); }
__device__ __forceinline__ float fsigmoid(float x) { return frcp(1.f + fexp(-x)); }
__device__ __forceinline__ float fsilu(float x) { return x * fsigmoid(x); }
__device__ __forceinline__ float fsoftplus(float x) {
    const float u = fexp(-fabsf(x));
    const float l = u < 0.01f ? u * (1.f - u * (0.5f - u * 0.33333333f)) : __builtin_amdgcn_logf(1.f + u) * 0.6931471805599453f;
    return fmaxf(x, 0.f) + l;
}
__device__ __forceinline__ float flogsigmoid(float x) { return -fsoftplus(-x); }

template <int NR>
__device__ __forceinline__ void conv_load(const bf16_t* src, const int trow0, u32x4 (&raw)[NR + 3]) {
#pragma unroll
    for (int i = 0; i < NR + 3; ++i) {
        const bool ok = (i >= 3) || (trow0 + i - 3 >= 0);
        const bf16_t* p = ok ? src + (ptrdiff_t)(i - 3) * NP : src;
        raw[i] = *(const u32x4*)p;
    }
}
template <int NR>
__device__ __forceinline__ void conv_compute(const u32x4 (&raw)[NR + 3], const int trow0, const LAS float* wl, const int ldw, float (&o)[NR][8]) {
    float x[NR + 3][8];
#pragma unroll
    for (int i = 0; i < NR + 3; ++i) {
        u32x4 xw = raw[i];
        if (i < 3) { const bool ok = trow0 + i - 3 >= 0; xw.x = ok ? xw.x : 0u; xw.y = ok ? xw.y : 0u; xw.z = ok ? xw.z : 0u; xw.w = ok ? xw.w : 0u; }
        unpack8(xw, x[i]);
    }
    float wv[5][8];
#pragma unroll
    for (int k = 0; k < 5; ++k) { const f32x4 w0 = *(const LAS f32x4*)(wl + k * ldw), w1 = *(const LAS f32x4*)(wl + k * ldw + 4);
#pragma unroll
        for (int j = 0; j < 4; ++j) { wv[k][j] = w0[j]; wv[k][4 + j] = w1[j]; } }
#pragma unroll
    for (int r = 0; r < NR; ++r)
#pragma unroll
        for (int j = 0; j < 8; ++j) { float a = wv[4][j];
#pragma unroll
            for (int k = 0; k < 4; ++k) a += wv[k][j] * x[r + k][j];
            o[r][j] = fsilu(a); }
}

__device__ __forceinline__ void ssd_prep(const Params& P, LAS unsigned char* lds, int bid, int nb) {
    const int tid = opaque_tid();
    bf16_t* proj = (bf16_t*)(P.ws + WS_BIG);
    LAS u32x4* halo = (LAS u32x4*)lds;
    const int c32 = tid & 31, r0 = (tid >> 5) * 4;
#pragma unroll 1
    for (int it = bid; it < 256; it += nb) {
        const int unit = it >> 1, half = it & 1, b = unit >> 2, g = unit & 3;
        int col, chn;
        if (half == 0) { col = C1_XS + g * 256 + 8 * c32; chn = g * 256 + 8 * c32; }
        else if (c32 < 16) { col = C1_BM + g * 128 + 8 * c32; chn = 1024 + g * 128 + 8 * c32; }
        else { col = C1_CM + g * 128 + 8 * (c32 - 16); chn = 1536 + g * 128 + 8 * (c32 - 16); }
        float wv[5][8];
#pragma unroll
        for (int k = 0; k < 5; ++k) { const float* wp = (k < 4 ? P.in[I_SSDCW] + k * 2048 : P.in[I_SSDCB]) + chn; const f32x4 w0 = *(const f32x4*)wp, w1 = *(const f32x4*)(wp + 4);
#pragma unroll
            for (int j = 0; j < 4; ++j) { wv[k][j] = w0[j]; wv[k][4 + j] = w1[j]; } }
        bf16_t* base = proj + (size_t)b * SEQ * NP + col;
        u32x4 cur[7];
#pragma unroll
        for (int i = 0; i < 7; ++i) { const int row = r0 - 3 + i; cur[i] = row >= 0 ? *(const u32x4*)(base + (size_t)row * NP) : (u32x4){0u, 0u, 0u, 0u}; }
#pragma unroll 1
        for (int ch = 0; ch < SEQ / 64; ++ch) {
            float x[7][8];
#pragma unroll
            for (int i = 0; i < 7; ++i) unpack8(cur[i], x[i]);
            const u32x4 h0 = cur[4], h1 = cur[5], h2 = cur[6];
            __syncthreads();
            if (r0 == 60) { halo[c32] = h0; halo[32 + c32] = h1; halo[64 + c32] = h2; }
            if (ch + 1 < SEQ / 64) {
#pragma unroll
                for (int i = 0; i < 7; ++i) if (r0 >= 4 || i >= 3) cur[i] = *(const u32x4*)(base + (size_t)(64 * (ch + 1) + r0 - 3 + i) * NP);
            }
#pragma unroll
            for (int r = 0; r < 4; ++r) { float o[8];
#pragma unroll
                for (int j = 0; j < 8; ++j) { float a = wv[4][j];
#pragma unroll
                    for (int k = 0; k < 4; ++k) a += wv[k][j] * x[r + k][j];
                    o[j] = fsilu(a); }
                *(u32x4*)(base + (size_t)(64 * ch + r0 + r) * NP) = pack8(o); }
            __syncthreads();
            if (r0 == 0 && ch + 1 < SEQ / 64) { cur[0] = halo[c32]; cur[1] = halo[32 + c32]; cur[2] = halo[64 + c32]; }
        }
        __syncthreads();
    }
}

template <int MIX>
__device__ __forceinline__ void mixer_unit(const Params& P, const int b, const int h, LAS unsigned char* lds, const bool dostore) {
    const int tid0 = opaque_tid(), w = __builtin_amdgcn_readfirstlane(tid0 >> 6);
    typedef unsigned u32x2 __attribute__((ext_vector_type(2)));
    constexpr int RSQ = 288, RSV = 544, RSP = 144;
    constexpr int SZQ = 64 * RSQ, SZV = 64 * RSV, SZP = 64 * RSP;
    constexpr int OQ = 0, OK1 = SZQ, OV = 2 * SZQ, O3 = 2 * SZQ + SZV;
    constexpr int OK2 = (MIX == MIX_ML || MIX == MIX_GLA) ? O3 : OK1;
    constexpr int OV2 = (MIX == MIX_SSD) ? O3 : OV;
    constexpr int OP = MIX == MIX_RET ? O3 : (MIX == MIX_SSD ? O3 + SZV : O3 + SZQ);
    constexpr int NPV = MIX == MIX_SSD ? 4 : 1;
    constexpr int OT = OP + NPV * SZP;
    constexpr int OY = OV2;
    LAS float* tab = (LAS float*)(lds + OT);
    constexpr int TGN = MIX == MIX_GLA ? 8832 : MIX == MIX_ML ? 648 : MIX == MIX_SSD ? 512 : 0;
    constexpr int TCW = MIX == MIX_ML ? 904 : 768;
    static_assert(OT + (MIX == MIX_GLA ? 11776 : MIX == MIX_SSD ? 3328 : 2184) * 4 <= 163840 - 1024, "lds map");
    bf16_t* proj = (bf16_t*)(P.ws + WS_BIG);
    const size_t row0b = (size_t)b * SEQ;
    constexpr int GIDX = MIX == MIX_RET ? I_RETG : MIX == MIX_ML ? I_MLG : MIX == MIX_GLA ? I_GLAG : I_SSDG;
    if (tid0 < 256) tab[TGN + tid0] = P.in[GIDX][h * 256 + tid0];
    if constexpr (MIX == MIX_ML) {
        for (int i = tid0; i < 1280; i += NTHREADS_C) { const int k = i >> 8, j = i & 255; const int chn = (j >> 7) * 512 + h * 128 + (j & 127);
            tab[TCW + i] = k < 4 ? P.in[I_MLCW][k * 1024 + chn] : P.in[I_MLCB][chn]; }
        if (tid0 < 128) tab[512 + tid0] = 0.f; if (tid0 == 0) tab[641] = 0.f;
    }
    u32x4 wbh = (u32x4){0u, 0u, 0u, 0u}, wbl = (u32x4){0u, 0u, 0u, 0u}; float bav = 0.f;
    if constexpr (MIX == MIX_GLA) {
        const int d = 16 * w + (tid0 & 15), gg = (tid0 >> 4) & 3;
        if (gg < 2) { unsigned hh[8], ll[8];
#pragma unroll
            for (int k = 0; k < 8; ++k) { const float wv = P.in[I_GLAWA][(8 * gg + k) * 512 + h * 128 + d]; hh[k] = f2bf(wv); ll[k] = f2bf(wv - bf2f((unsigned short)hh[k])); }
            wbh = (u32x4){hh[0] | (hh[1] << 16), hh[2] | (hh[3] << 16), hh[4] | (hh[5] << 16), hh[6] | (hh[7] << 16)};
            wbl = (u32x4){ll[0] | (ll[1] << 16), ll[2] | (ll[3] << 16), ll[4] | (ll[5] << 16), ll[6] | (ll[7] << 16)}; }
        bav = P.in[I_GLABA][h * 128 + d];
    }
    __syncthreads();
    f32x4 Sacc[8][2];
#pragma unroll
    for (int rt = 0; rt < 8; ++rt)
#pragma unroll
        for (int ct = 0; ct < 2; ++ct) Sacc[rt][ct] = (f32x4){0.f, 0.f, 0.f, 0.f};
    float gam = 1.f, lg2gam = 0.f, g63 = 1.f;
    float rinv[4] = {0.f, 0.f, 0.f, 0.f};
    if constexpr (MIX == MIX_RET) { gam = 1.f - __builtin_amdgcn_exp2f(-5.f - (float)h); lg2gam = __builtin_amdgcn_logf(gam); g63 = __builtin_amdgcn_exp2f(63.f * lg2gam);
#pragma unroll
        for (int i2 = 0; i2 < 4; ++i2) rinv[i2] = __builtin_amdgcn_exp2f(-(float)(2 * (4 * (tid0 & 15) + i2)) * (13.287712379549449f / 128.f)) * 0.15915494309189535f; }

    float gpA = 0.f, gpB = 0.f, gpC = 0.f;
    if constexpr (MIX == MIX_ML) { gpA = P.in[I_MLBI][h]; gpB = P.in[I_MLBF][h]; }
    if constexpr (MIX == MIX_SSD) { const int hd = 4 * h + (w & 3); gpA = P.in[I_SSDDTB][hd]; gpB = -fexp(P.in[I_SSDALOG][hd]); gpC = P.in[I_SSDD][4 * h + ((tid0 & 7) >> 1)]; }
    gpA = __builtin_bit_cast(float, __builtin_amdgcn_readfirstlane(__builtin_bit_cast(int, gpA))); gpB = __builtin_bit_cast(float, __builtin_amdgcn_readfirstlane(__builtin_bit_cast(int, gpB)));
    tp_begin(lds, 100 * MIX + 9);
    unsigned short gpre0 = 0, gpre1 = 0;
    if constexpr (MIX == MIX_ML) { if (w == 0) { const bf16_t* rp = proj + (row0b + (tid0 & 63)) * NP; gpre0 = rp[C0_MI + h]; gpre1 = rp[C0_MF + h]; } }
    if constexpr (MIX == MIX_SSD) { if (w < 4) gpre0 = proj[(row0b + (tid0 & 63)) * NP + C1_DT + 4 * h + w]; }
#pragma unroll 1
    for (int ch = 0; ch < SEQ / 64; ++ch) {
        int tid = tid0; asm volatile("" : "+v"(tid));
        const int lane = tid & 63, c = lane & 15, g = lane >> 4, q4 = (lane >> 2) & 3, p4 = lane & 3;
        const size_t row0 = row0b + (size_t)ch * 64;
        tp_begin(lds, 100 * MIX + 1);
        if constexpr (MIX == MIX_RET) {
            const int* pos = (const int*)P.in[I_POS];
            u32x4 qw2[2], kw2[2], vw[4]; int psi[2];
#pragma unroll
            for (int i = 0; i < 2; ++i) { const int pi = tid + 512 * i, r = pi >> 4, c8 = pi & 15;
                const bf16_t* rp = proj + (row0 + r) * NP + h * 128 + 8 * c8;
                qw2[i] = *(const u32x4*)(rp + C0_RQ); kw2[i] = *(const u32x4*)(rp + C0_RK); psi[i] = pos[row0 + r]; }
#pragma unroll
            for (int i = 0; i < 4; ++i) { const int pi = tid + 512 * i, r = pi >> 5, c8 = pi & 31; vw[i] = *(const u32x4*)(proj + (row0 + r) * NP + C0_RV + h * 256 + 8 * c8); }
            __builtin_amdgcn_sched_barrier(0);
#pragma unroll
            for (int i = 0; i < 2; ++i) {
                const int pi = tid + 512 * i, r = pi >> 4, c8 = pi & 15;
                float qv[8], kv[8]; unpack8(qw2[i], qv); unpack8(kw2[i], kv);
                const float ps = (float)psi[i];
                const float fq = __builtin_amdgcn_exp2f((float)r * lg2gam), fk = 0.08838834764831845f * __builtin_amdgcn_exp2f(-(float)r * lg2gam);
#pragma unroll
                for (int i2 = 0; i2 < 4; ++i2) {
                    const float tr = __builtin_amdgcn_fractf(ps * rinv[i2]);
                    const float sn = __builtin_amdgcn_sinf(tr), cs = __builtin_amdgcn_cosf(tr);
                    const float q0 = qv[2 * i2], q1 = qv[2 * i2 + 1], k0 = kv[2 * i2], k1 = kv[2 * i2 + 1];
                    qv[2 * i2] = (q0 * cs - q1 * sn) * fq; qv[2 * i2 + 1] = (q0 * sn + q1 * cs) * fq;
                    kv[2 * i2] = (k0 * cs - k1 * sn) * fk; kv[2 * i2 + 1] = (k0 * sn + k1 * cs) * fk;
                }
                *(LAS u32x4*)(lds + OQ + RSQ * r + 16 * c8) = pack8(qv);
                *(LAS u32x4*)(lds + OK1 + RSQ * r + 16 * c8) = pack8(kv);
            }
#pragma unroll
            for (int i = 0; i < 4; ++i) { const int pi = tid + 512 * i, r = pi >> 5, c8 = pi & 31; *(LAS u32x4*)(lds + OV + RSV * r + 16 * c8) = vw[i]; }
        }
        if constexpr (MIX == MIX_GLA) {
            u32x4 gaw[4], qw2[2], kw2[2], vw[4];
#pragma unroll
            for (int tt = 0; tt < 4; ++tt) gaw[tt] = *(const u32x4*)(proj + (row0 + 16 * tt + c) * NP + C1_GA + 8 * (g & 1));
#pragma unroll
            for (int i = 0; i < 2; ++i) { const int pi = tid + 512 * i, r = pi >> 4, c8 = pi & 15; const bf16_t* rp = proj + (row0 + r) * NP + h * 128 + 8 * c8;
                qw2[i] = *(const u32x4*)(rp + C1_GQ); kw2[i] = *(const u32x4*)(rp + C1_GK); }
#pragma unroll
            for (int i = 0; i < 4; ++i) { const int pi = tid + 512 * i, r = pi >> 5, c8 = pi & 31; vw[i] = *(const u32x4*)(proj + (row0 + r) * NP + C1_GV + h * 256 + 8 * c8); }
            __builtin_amdgcn_sched_barrier(0);
            {
                float run = 0.f;
#pragma unroll
                for (int tt = 0; tt < 4; ++tt) {
                    u32x4 aw = gaw[tt]; if (g >= 2) aw = (u32x4){0u, 0u, 0u, 0u};
                    f32x4 a = __builtin_amdgcn_mfma_f32_16x16x32_bf16(__builtin_bit_cast(bf16x8, aw), __builtin_bit_cast(bf16x8, wbh), (f32x4){0.f, 0.f, 0.f, 0.f}, 0, 0, 0);
                    a = __builtin_amdgcn_mfma_f32_16x16x32_bf16(__builtin_bit_cast(bf16x8, aw), __builtin_bit_cast(bf16x8, wbl), a, 0, 0, 0);
                    float la[4];
#pragma unroll
                    for (int j = 0; j < 4; ++j) la[j] = flogsigmoid(a[j] + bav) * (1.f / 16.f);
                    la[1] += la[0]; la[2] += la[1]; la[3] += la[2];
                    float inc = la[3];
                    const float u1 = __shfl_up(inc, 16); if (g >= 1) inc += u1;
                    const float u2 = __shfl_up(inc, 32); if (g >= 2) inc += u2;
                    const float exc = inc - la[3] + run;
#pragma unroll
                    for (int j = 0; j < 4; ++j) tab[(16 * tt + 4 * g + j) * 128 + 16 * w + c] = la[j] + exc;
                    run += __shfl(inc, 48 + c);
                }
                if (g == 0) tab[8704 + 16 * w + c] = fexp(run);
            }
            __syncthreads();
#pragma unroll
            for (int i = 0; i < 2; ++i) {
                const int pi = tid + 512 * i, r = pi >> 4, c8 = pi & 15;
                float qv[8], kv[8], k2[8]; unpack8(qw2[i], qv); unpack8(kw2[i], kv);
#pragma unroll
                for (int hh = 0; hh < 2; ++hh) {
                    const int d0 = 8 * c8 + 4 * hh;
                    const f32x4 bc = *(LAS f32x4*)(tab + r * 128 + d0);
                    const f32x4 dcv = *(LAS f32x4*)(tab + 8704 + d0);
#pragma unroll
                    for (int j = 0; j < 4; ++j) { const float e1 = fexp(bc[j]), e2 = frcp(e1), kk = kv[4 * hh + j] * e2;
                        qv[4 * hh + j] = qv[4 * hh + j] * 0.08838834764831845f * e1; kv[4 * hh + j] = kk; k2[4 * hh + j] = kk * dcv[j]; }
                }
                *(LAS u32x4*)(lds + OQ + RSQ * r + 16 * c8) = pack8(qv);
                *(LAS u32x4*)(lds + OK1 + RSQ * r + 16 * c8) = pack8(kv);
                *(LAS u32x4*)(lds + OK2 + RSQ * r + 16 * c8) = pack8(k2);
            }
#pragma unroll
            for (int i = 0; i < 4; ++i) { const int pi = tid + 512 * i, r = pi >> 5, c8 = pi & 31; *(LAS u32x4*)(lds + OV + RSV * r + 16 * c8) = vw[i]; }
        }
        if constexpr (MIX == MIX_ML) {
            const int c16 = tid & 31, r0 = (tid >> 5) * 4, isk = c16 >> 4, c8c = c16 & 15;
            u32x4 vw[4], raw[7];
#pragma unroll
            for (int i = 0; i < 4; ++i) { const int pi = tid + 512 * i, r = pi >> 5, c8 = pi & 31; vw[i] = *(const u32x4*)(proj + (row0 + r) * NP + C0_MV + h * 256 + 8 * c8); }
            conv_load<4>(proj + (row0 + r0) * NP + (isk ? C0_MK : C0_MQ) + h * 128 + 8 * c8c, ch * 64 + r0, raw);
            __builtin_amdgcn_sched_barrier(0);
            if (w == 0) {
                const float ip = bf2f(gpre0) + gpA, lf = flogsigmoid(bf2f(gpre1) + gpB);
                const float bc = wave_scan_add(lf);
                const float u = ip - bc; const float pm = wave_scan_max(u);
                const float mst = tab[641];
                const float M = fmaxf(mst, pm), M63 = __shfl(M, 63), bt = __shfl(bc, 63);
                tab[lane] = u; tab[64 + lane] = M; tab[128 + lane] = fexp(u - M63); tab[192 + lane] = fexp(mst - M); tab[256 + lane] = fexp(-bc - M);
                if (lane == 0) { tab[640] = fexp(mst - M63); tab[642] = bt + M63; }
            }
#pragma unroll
            for (int i = 0; i < 4; ++i) { const int pi = tid + 512 * i, r = pi >> 5, c8 = pi & 31; *(LAS u32x4*)(lds + OV + RSV * r + 16 * c8) = vw[i]; }
            {
                float o[4][8];
                conv_compute<4>(raw, ch * 64 + r0, tab + TCW + 8 * c16, 256, o);
#pragma unroll
                for (int r = 0; r < 4; ++r) {
                    if (isk) {
#pragma unroll
                        for (int j = 0; j < 8; ++j) o[r][j] *= 0.08838834764831845f; }
                    *(LAS u32x4*)(lds + (isk ? OK1 : OQ) + RSQ * (r0 + r) + 16 * c8c) = pack8(o[r]); }
            }
            __syncthreads();
            tp_end(lds, 100 * MIX + 1); tp_begin(lds, 100 * MIX + 6);
#pragma unroll
            for (int i = 0; i < 2; ++i) {
                const int pi = tid + 512 * i, r = pi >> 4, c8 = pi & 15;
                const u32x4 kw = *(LAS u32x4*)(lds + OK1 + RSQ * r + 16 * c8); float kv[8]; unpack8(kw, kv); const float es = tab[128 + r];
#pragma unroll
                for (int j = 0; j < 8; ++j) kv[j] *= es;
                *(LAS u32x4*)(lds + OK2 + RSQ * r + 16 * c8) = pack8(kv);
            }
            {
                const int t = tid >> 3, part = tid & 7; float a = 0.f;
#pragma unroll
                for (int i = 0; i < 2; ++i) { const u32x4 qw = *(LAS u32x4*)(lds + OQ + RSQ * t + 2 * (16 * part + 8 * i)); float qv[8]; unpack8(qw, qv);
                    const f32x4 n0 = *(LAS f32x4*)(tab + 512 + 16 * part + 8 * i), n1 = *(LAS f32x4*)(tab + 512 + 16 * part + 8 * i + 4);
#pragma unroll
                    for (int j = 0; j < 4; ++j) a += qv[j] * n0[j] + qv[4 + j] * n1[j]; }
                a += __shfl_xor(a, 1); a += __shfl_xor(a, 2); a += __shfl_xor(a, 4);
                if (part == 0) tab[448 + t] = a;
            }
        }
        if constexpr (MIX == MIX_SSD) {
            if (w < 4) {
                const float dt = fsoftplus(bf2f(gpre0) + gpA);
                const float cm = wave_scan_add(dt * gpB);
                tab[lane * 4 + w] = cm; tab[256 + lane * 4 + w] = dt;
            }
            {
                const int c32 = tid & 31, r0 = (tid >> 5) * 4, isc = c32 >> 4, c8 = c32 & 15, hr = c32 >> 3;
                u32x4 bcw[4], xw[4];
#pragma unroll
                for (int r = 0; r < 4; ++r) { bcw[r] = *(const u32x4*)(proj + (row0 + r0 + r) * NP + (isc ? C1_CM : C1_BM) + h * 128 + 8 * c8); xw[r] = *(const u32x4*)(proj + (row0 + r0 + r) * NP + C1_XS + h * 256 + 8 * c32); }
                float ox[4][8];
#pragma unroll
                for (int r = 0; r < 4; ++r) { *(LAS u32x4*)(lds + (isc ? OQ : OK1) + RSQ * (r0 + r) + 16 * c8) = bcw[r]; unpack8(xw[r], ox[r]); }
                __syncthreads();
                tp_end(lds, 100 * MIX + 1); tp_begin(lds, 100 * MIX + 6);
                const float last = tab[63 * 4 + hr];
#pragma unroll
                for (int r = 0; r < 4; ++r) { const float dt = tab[256 + (r0 + r) * 4 + hr], e2 = fexp(last - tab[(r0 + r) * 4 + hr]); float o2[8];
#pragma unroll
                    for (int j = 0; j < 8; ++j) { ox[r][j] *= dt; o2[j] = ox[r][j] * e2; }
                    *(LAS u32x4*)(lds + OV + RSV * (r0 + r) + 16 * c32) = pack8(ox[r]);
                    *(LAS u32x4*)(lds + OV2 + RSV * (r0 + r) + 16 * c32) = pack8(o2); }
            }
        }
        __syncthreads();
        tp_end(lds, (MIX == MIX_ML || MIX == MIX_SSD) ? 100 * MIX + 6 : 100 * MIX + 1); tp_begin(lds, 100 * MIX + 2);
        if (ch + 1 < SEQ / 64) {
            const int sl = tid & 15;
            int col = -1;
            if constexpr (MIX == MIX_RET) col = sl < 2 ? C0_RQ + h * 128 + 64 * sl : sl < 4 ? C0_RK + h * 128 + 64 * (sl - 2) : sl < 8 ? C0_RV + h * 256 + 64 * (sl - 4) : sl < 12 ? C0_RG + h * 256 + 64 * (sl - 8) : -1;
            if constexpr (MIX == MIX_ML) col = sl < 2 ? C0_MQ + h * 128 + 64 * sl : sl < 4 ? C0_MK + h * 128 + 64 * (sl - 2) : sl < 8 ? C0_MV + h * 256 + 64 * (sl - 4) : sl < 12 ? C0_MO + h * 256 + 64 * (sl - 8) : sl == 12 ? C0_MI : -1;
            if constexpr (MIX == MIX_GLA) col = sl < 2 ? C1_GQ + h * 128 + 64 * sl : sl < 4 ? C1_GK + h * 128 + 64 * (sl - 2) : sl < 8 ? C1_GV + h * 256 + 64 * (sl - 4) : sl < 12 ? C1_GR + h * 256 + 64 * (sl - 8) : sl == 12 ? C1_GA : -1;
            if constexpr (MIX == MIX_SSD) col = sl < 4 ? C1_XS + h * 256 + 64 * sl : sl < 6 ? C1_BM + h * 128 + 64 * (sl - 4) : sl < 8 ? C1_CM + h * 128 + 64 * (sl - 6) : sl < 12 ? C1_SZ + h * 256 + 64 * (sl - 8) : sl == 12 ? C1_DT : -1;
            if (col >= 0) { const bf16_t* nbp = proj + (row0 + 64 + (tid >> 4)) * NP + col;
                const unsigned pfl = 157696u + (unsigned)w * 512u;
                asm volatile("s_mov_b32 m0, %2\n\ts_nop 0\n\tglobal_load_lds_dword %0, off\n\ts_mov_b32 m0, %3\n\ts_nop 0\n\tglobal_load_lds_dword %1, off"
                             :: "v"(nbp), "v"(nbp + (size_t)32 * NP), "s"(pfl), "s"(pfl + 256u) : "memory", "m0"); }
        }
        {
            const int tt = w >> 1; float rsum = 0.f;
#pragma unroll
            for (int si = 0; si < 2; ++si) {
                const int ss = 2 * (w & 1) + si;
                f32x4 acc = (f32x4){0.f, 0.f, 0.f, 0.f};
#pragma unroll
                for (int ks = 0; ks < 4; ++ks) {
                    const bf16x8 a = *(LAS bf16x8*)(lds + OK1 + RSQ * (16 * ss + c) + 2 * (32 * ks + 8 * g));
                    const bf16x8 bq = *(LAS bf16x8*)(lds + OQ + RSQ * (16 * tt + c) + 2 * (32 * ks + 8 * g));
                    acc = __builtin_amdgcn_mfma_f32_16x16x32_bf16(a, bq, acc, 0, 0, 0);
                }
                const int t = 16 * tt + c, s0 = 16 * ss + 4 * g;
                if constexpr (MIX == MIX_SSD) {
                    const f32x4 ct_ = *(LAS f32x4*)(tab + t * 4);
                    f32x4 cs_[4];
#pragma unroll
                    for (int r = 0; r < 4; ++r) cs_[r] = *(LAS f32x4*)(tab + (s0 + r) * 4);
#pragma unroll
                    for (int hr = 0; hr < 4; ++hr) { float pv[4];
#pragma unroll
                        for (int r = 0; r < 4; ++r) { const float e = fexp(ct_[hr] - cs_[r][hr]); pv[r] = (s0 + r <= t) ? acc[r] * e : 0.f; }
                        *(LAS u32x2*)(lds + OP + hr * SZP + RSP * t + 2 * s0) = (u32x2){pg8::cvt_pk_bf16(pv[0], pv[1]), pg8::cvt_pk_bf16(pv[2], pv[3])}; }
                } else {
                    float pv[4];
                    if constexpr (MIX == MIX_ML) { const f32x4 us = *(LAS f32x4*)(tab + s0); const float Mt = tab[64 + t];
#pragma unroll
                        for (int r = 0; r < 4; ++r) { pv[r] = (s0 + r <= t) ? acc[r] * fexp(us[r] - Mt) : 0.f; rsum += pv[r]; } }
                    else {
#pragma unroll
                        for (int r = 0; r < 4; ++r) pv[r] = (s0 + r <= t) ? acc[r] : 0.f; }
                    *(LAS u32x2*)(lds + OP + RSP * t + 2 * s0) = (u32x2){pg8::cvt_pk_bf16(pv[0], pv[1]), pg8::cvt_pk_bf16(pv[2], pv[3])};
                }
            }
            if constexpr (MIX == MIX_ML) { rsum += __shfl_xor(rsum, 16); rsum += __shfl_xor(rsum, 32); if (g == 0) tab[320 + (w & 1) * 64 + 16 * tt + c] = rsum; }
        }
        __syncthreads();
        tp_end(lds, 100 * MIX + 2); tp_begin(lds, 100 * MIX + 3);
        f32x4 Yacc[2][4];
#pragma unroll
        for (int ct = 0; ct < 2; ++ct)
#pragma unroll
            for (int tt = 0; tt < 4; ++tt) Yacc[ct][tt] = (f32x4){0.f, 0.f, 0.f, 0.f};
#pragma unroll
        for (int kd = 0; kd < 4; ++kd) {
            bf16x8 qf[4];
#pragma unroll
            for (int tt = 0; tt < 4; ++tt) { LAS unsigned char* qp = lds + OQ + RSQ * (16 * tt + c) + 2 * (32 * kd + 4 * g); qf[tt] = cat_frag(qp, qp + 32); }
#pragma unroll
            for (int ct = 0; ct < 2; ++ct) { const bf16x8 sf = pack_acc(Sacc[2 * kd][ct], Sacc[2 * kd + 1][ct]);
#pragma unroll
                for (int tt = 0; tt < 4; ++tt) Yacc[ct][tt] = __builtin_amdgcn_mfma_f32_16x16x32_bf16(sf, qf[tt], Yacc[ct][tt], 0, 0, 0); }
        }
        if constexpr (MIX != MIX_GLA) {
#pragma unroll
            for (int tt = 0; tt < 4; ++tt) {
                float rs = gam;
                if constexpr (MIX == MIX_ML) rs = tab[192 + 16 * tt + c];
                if constexpr (MIX == MIX_SSD) rs = fexp(tab[(16 * tt + c) * 4 + (w >> 1)]);
#pragma unroll
                for (int ct = 0; ct < 2; ++ct) Yacc[ct][tt] = Yacc[ct][tt] * rs;
            }
        }
        bf16x8 Vf[2][2];
#pragma unroll
        for (int ks = 0; ks < 2; ++ks)
#pragma unroll
            for (int ct = 0; ct < 2; ++ct) { LAS unsigned char* vp = lds + OV + RSV * (32 * ks + 8 * g + q4) + 2 * (32 * w + 16 * ct) + 8 * p4; Vf[ks][ct] = tr_frag(vp, vp + 4 * RSV); }
#pragma unroll
        for (int ks = 0; ks < 2; ++ks)
#pragma unroll
            for (int tt = 0; tt < 4; ++tt) { const bf16x8 pf = *(LAS bf16x8*)(lds + OP + (MIX == MIX_SSD ? (w >> 1) * SZP : 0) + RSP * (16 * tt + c) + 2 * (32 * ks + 8 * g));
#pragma unroll
                for (int ct = 0; ct < 2; ++ct) Yacc[ct][tt] = __builtin_amdgcn_mfma_f32_16x16x32_bf16(Vf[ks][ct], pf, Yacc[ct][tt], 0, 0, 0); }
        if constexpr (MIX == MIX_GLA) {
#pragma unroll
            for (int rt = 0; rt < 8; ++rt) { const f32x4 dc = *(LAS f32x4*)(tab + 8704 + 16 * rt + 4 * g);
#pragma unroll
                for (int ct = 0; ct < 2; ++ct) Sacc[rt][ct] = Sacc[rt][ct] * dc; }
        } else {
            float dc = gam;
            if constexpr (MIX == MIX_ML) dc = tab[640];
            if constexpr (MIX == MIX_SSD) dc = fexp(tab[63 * 4 + (w >> 1)]);
#pragma unroll
            for (int rt = 0; rt < 8; ++rt)
#pragma unroll
                for (int ct = 0; ct < 2; ++ct) Sacc[rt][ct] = Sacc[rt][ct] * dc;
        }
        if constexpr (MIX == MIX_SSD) {
#pragma unroll
            for (int ks = 0; ks < 2; ++ks)
#pragma unroll
                for (int ct = 0; ct < 2; ++ct) { LAS unsigned char* vp = lds + OV2 + RSV * (32 * ks + 8 * g + q4) + 2 * (32 * w + 16 * ct) + 8 * p4; Vf[ks][ct] = tr_frag(vp, vp + 4 * RSV); }
        }
#pragma unroll
        for (int rt = 0; rt < 8; ++rt)
#pragma unroll
            for (int ks = 0; ks < 2; ++ks) { LAS unsigned char* kp = lds + OK2 + RSQ * (32 * ks + 8 * g + q4) + 2 * (16 * rt) + 8 * p4; const bf16x8 kf = tr_frag(kp, kp + 4 * RSQ);
#pragma unroll
                for (int ct = 0; ct < 2; ++ct) Sacc[rt][ct] = __builtin_amdgcn_mfma_f32_16x16x32_bf16(kf, Vf[ks][ct], Sacc[rt][ct], 0, 0, 0); }
        if constexpr (MIX == MIX_RET) {
#pragma unroll
            for (int rt = 0; rt < 8; ++rt)
#pragma unroll
                for (int ct = 0; ct < 2; ++ct) Sacc[rt][ct] = Sacc[rt][ct] * g63;
        }
        if constexpr (MIX == MIX_ML) {
            if (tid < 128) { float a = 0.f;
#pragma unroll 8
                for (int s = 0; s < 64; ++s) a += bf2f(*(LAS unsigned short*)(lds + OK2 + RSQ * s + 2 * tid));
                tab[512 + tid] = tab[640] * tab[512 + tid] + a; }
        }
        __syncthreads();
        tp_end(lds, 100 * MIX + 3); tp_begin(lds, 100 * MIX + 4);
        constexpr int GCOL = MIX == MIX_RET ? C0_RG : MIX == MIX_ML ? C0_MO : MIX == MIX_GLA ? C1_GR : C1_SZ;
        constexpr int OCOL = MIX == MIX_RET ? C0_RV : MIX == MIX_ML ? C0_MV : MIX == MIX_GLA ? C1_GV : C1_SZ;
        bf16_t* const erp = proj + (row0 + (tid >> 3)) * NP + h * 256 + 32 * (tid & 7);
        u32x4 gw[4];
#pragma unroll
        for (int i = 0; i < 4; ++i) gw[i] = *(const u32x4*)(erp + GCOL + 8 * i);
        __builtin_amdgcn_sched_barrier(0);
#pragma unroll
        for (int ct = 0; ct < 2; ++ct)
#pragma unroll
            for (int tt = 0; tt < 4; ++tt)
                *(LAS u32x2*)(lds + OY + RSV * (16 * tt + c) + 2 * (32 * w + 16 * ct + 4 * g)) = (u32x2){pg8::cvt_pk_bf16(Yacc[ct][tt][0], Yacc[ct][tt][1]), pg8::cvt_pk_bf16(Yacc[ct][tt][2], Yacc[ct][tt][3])};
        __syncthreads();
        tp_end(lds, 100 * MIX + 4); tp_begin(lds, 100 * MIX + 5);
        {
            const int t = tid >> 3, part = tid & 7;
            float y[32];
#pragma unroll
            for (int i = 0; i < 4; ++i) { const u32x4 yw = *(LAS u32x4*)(lds + OY + RSV * t + 2 * (32 * part + 8 * i)); float t8[8]; unpack8(yw, t8);
#pragma unroll
                for (int j = 0; j < 8; ++j) y[8 * i + j] = t8[j]; }
            bf16_t* const rp = erp;
            if constexpr (MIX == MIX_ML) {
                const float den = (tab[320 + t] + tab[384 + t]) + tab[192 + t] * tab[448 + t];
                const float idn = frcp(fmaxf(fabsf(den), tab[256 + t]));
#pragma unroll
                for (int i = 0; i < 4; ++i) { float gt[8]; unpack8(gw[i], gt);
#pragma unroll
                    for (int j = 0; j < 8; ++j) y[8 * i + j] = y[8 * i + j] * idn * fsigmoid(gt[j]); }
            }
            if constexpr (MIX == MIX_SSD) {
                const float dsk = gpC * frcp(tab[256 + t * 4 + (part >> 1)]);
#pragma unroll
                for (int i = 0; i < 4; ++i) { const u32x4 xw = *(LAS u32x4*)(lds + OV + RSV * t + 2 * (32 * part + 8 * i)); float t8[8], gt[8]; unpack8(xw, t8); unpack8(gw[i], gt);
#pragma unroll
                    for (int j = 0; j < 8; ++j) y[8 * i + j] = (y[8 * i + j] + dsk * t8[j]) * fsilu(gt[j]); }
            }
            float mean = 0.f;
            if constexpr (MIX == MIX_RET || MIX == MIX_ML) {
                float s1 = 0.f;
#pragma unroll
                for (int j = 0; j < 32; ++j) s1 += y[j];
                s1 += __shfl_xor(s1, 1); s1 += __shfl_xor(s1, 2); s1 += __shfl_xor(s1, 4);
                mean = s1 * (1.f / 256.f);
            }
            float s2 = 0.f;
#pragma unroll
            for (int j = 0; j < 32; ++j) { y[j] -= mean; s2 += y[j] * y[j]; }
            s2 += __shfl_xor(s2, 1); s2 += __shfl_xor(s2, 2); s2 += __shfl_xor(s2, 4);
            const float rstd = __builtin_amdgcn_rsqf(s2 * (1.f / 256.f) + NORM_EPS);
#pragma unroll
            for (int i = 0; i < 4; ++i) {
                const f32x4 n0 = *(LAS f32x4*)(tab + TGN + 32 * part + 8 * i), n1 = *(LAS f32x4*)(tab + TGN + 32 * part + 8 * i + 4); float o[8];
#pragma unroll
                for (int j = 0; j < 4; ++j) { o[j] = y[8 * i + j] * rstd * n0[j]; o[4 + j] = y[8 * i + 4 + j] * rstd * n1[j]; }
                if constexpr (MIX == MIX_RET || MIX == MIX_GLA) { float gt[8]; unpack8(gw[i], gt);
#pragma unroll
                    for (int j = 0; j < 8; ++j) o[j] *= fsilu(gt[j]); }
                if (dostore) *(u32x4*)(rp + OCOL + 8 * i) = pack8(o);
            }
            if constexpr (MIX == MIX_ML) { if (tid == 0) tab[641] = tab[642]; }
        }
        if (ch + 1 < SEQ / 64) {
            if constexpr (MIX == MIX_ML) { if (w == 0) { const bf16_t* rp = proj + (row0 + 64 + lane) * NP; gpre0 = rp[C0_MI + h]; gpre1 = rp[C0_MF + h]; } }
            if constexpr (MIX == MIX_SSD) { if (w < 4) gpre0 = proj[(row0 + 64 + lane) * NP + C1_DT + 4 * h + w]; }
        }
        __syncthreads();
        tp_end(lds, 100 * MIX + 5);
    }
    tp_end(lds, 100 * MIX + 9);
}

#define XB_TMO      128
#define XB_XCNT(j)  (256  + 64 * (j))
#define XB_XSUB(j)  (1280 + 64 * (j))
#define XB_XGEN(j)  (2304 + 64 * (j))
#define XB_TOP      3328
#define XB_TOPGEN   3392
#define XCD_BAR_WORDS 3456
#define XB_SPIN_CAP (1u << 18)
__device__ __forceinline__ unsigned xb_ld(unsigned* p)              { return __hip_atomic_load(p, __ATOMIC_RELAXED, __HIP_MEMORY_SCOPE_AGENT); }
__device__ __forceinline__ unsigned xb_add(unsigned* p, unsigned v) { return __hip_atomic_fetch_add(p, v, __ATOMIC_RELAXED, __HIP_MEMORY_SCOPE_AGENT); }
__device__ __forceinline__ unsigned xb_xcc_id() { return (unsigned)__builtin_amdgcn_s_getreg((3 << 11) | 20) & 0xFu; }
#define XB_SPIN(cond, bar) do { unsigned _sp = 0; while (cond) { __builtin_amdgcn_s_sleep(1); \
    if ((++_sp & 255u) == 0u) { if (xb_ld(&(bar)[XB_TMO])) break; if (_sp > XB_SPIN_CAP) { atomicAdd(&(bar)[XB_TMO], 1u); break; } } } } while (0)
struct XcdBarrier { unsigned* bar; unsigned x; volatile LAS unsigned* st; };
__device__ __forceinline__ XcdBarrier xcd_barrier_post(unsigned* bar, volatile LAS unsigned* st) {
    XcdBarrier b; b.bar = bar; b.x = xb_xcc_id(); b.st = st;
    if (opaque_tid() == 0) (void)xb_add(&bar[XB_XCNT(b.x)], 1u);
    return b;
}
__device__ __forceinline__ void xcd_barrier_complete(unsigned* bar, unsigned x, unsigned& nloc, unsigned& nx) {
    const unsigned G = gridDim.x * gridDim.y * gridDim.z;
    unsigned sum, cnt, mine, sp = 0u;
    for (;;) {
        sum = 0u; cnt = 0u; mine = 0u;
#pragma unroll
        for (unsigned j = 0; j < 16; ++j) { const unsigned c = xb_ld(&bar[XB_XCNT(j)]); sum += c; cnt += (c > 0u) ? 1u : 0u; mine = (j == x) ? c : mine; }
        if (sum == G) break;
        __builtin_amdgcn_s_sleep(1);
        if ((++sp & 255u) == 0u) { if (xb_ld(&bar[XB_TMO])) break; if (sp > XB_SPIN_CAP) { atomicAdd(&bar[XB_TMO], 1u); break; } }
    }
    nloc = mine > 0u ? mine : 1u; nx = cnt > 0u ? cnt : 1u;
}
__device__ __forceinline__ void xcd_barrier(const XcdBarrier& b) {
    asm volatile("s_waitcnt vmcnt(0)" ::: "memory");
    __syncthreads();
    if (opaque_tid() == 0) {
        unsigned* bar = b.bar;
        __builtin_amdgcn_s_waitcnt(0);
        unsigned nloc = b.st[0], nx = b.st[1];
        if (nloc == 0u) { xcd_barrier_complete(bar, b.x, nloc, nx); b.st[0] = nloc; b.st[1] = nx; }
        const unsigned old = xb_add(&bar[XB_XSUB(b.x)], 1u);
        const unsigned gen = old / nloc;
        if (old + 1u == (gen + 1u) * nloc) {
            __builtin_amdgcn_fence(__ATOMIC_RELEASE, "agent");
            asm volatile("s_waitcnt vmcnt(0)" ::: "memory");
            const unsigned og = xb_add(&bar[XB_TOP], 1u);
            const unsigned tg = og / nx;
            if (og + 1u == (tg + 1u) * nx) xb_add(&bar[XB_TOPGEN], 1u);
            else XB_SPIN(xb_ld(&bar[XB_TOPGEN]) == tg, bar);
            __builtin_amdgcn_fence(__ATOMIC_ACQUIRE, "agent");
            xb_add(&bar[XB_XGEN(b.x)], 1u);
            asm volatile("s_waitcnt vmcnt(0)" ::: "memory");
        } else {
            XB_SPIN(xb_ld(&bar[XB_XGEN(b.x)]) == gen, bar);
            __builtin_amdgcn_fence(__ATOMIC_ACQUIRE, "agent");
            asm volatile("s_waitcnt vmcnt(0)" ::: "memory");
        }
    }
    __syncthreads();
}

constexpr int NTHREADS = 512;
constexpr int RING_BYTES = 131072;
constexpr int LDS_BYTES = 163840;
constexpr int LDS_BARW = LDS_BYTES - 16;
constexpr int NPHASES = 17;
#ifndef MK_N_LAUNCHES
#define MK_N_LAUNCHES 1
#endif

#ifndef REP_ROUTE
#define REP_ROUTE 1
#endif
#ifndef REP_CONV
#define REP_CONV 1
#endif
#ifndef REP_GIN
#define REP_GIN 1
#endif
#ifndef REP_GOUT
#define REP_GOUT 1
#endif
#ifndef REP_PERM
#define REP_PERM 1
#endif
#ifndef REP_MOEA
#define REP_MOEA 1
#endif
#ifndef REP_MOEB
#define REP_MOEB 1
#endif
#ifndef REP_LNF
#define REP_LNF 1
#endif
#ifndef MIXREP_RET
#define MIXREP_RET 1
#endif
#ifndef MIXREP_ML
#define MIXREP_ML 1
#endif
#ifndef MIXREP_GLA
#define MIXREP_GLA 1
#endif
#ifndef MIXREP_SSD
#define MIXREP_SSD 1
#endif
struct Args { Params P; int ph_lo, ph_hi; };
typedef __attribute__((address_space(4))) const unsigned char* kargp_t;
__device__ __forceinline__ const Params& kparams() {
    kargp_t p = (kargp_t)__builtin_amdgcn_kernarg_segment_ptr();
    asm volatile("" : "+s"(p));
    return *(const Params*)p;
}

__device__ __forceinline__ int kphase_lo() { kargp_t p = (kargp_t)__builtin_amdgcn_kernarg_segment_ptr(); asm volatile("" : "+s"(p)); return ((const Args*)p)->ph_lo; }
__device__ __forceinline__ int kphase_hi() { kargp_t p = (kargp_t)__builtin_amdgcn_kernarg_segment_ptr(); asm volatile("" : "+s"(p)); return ((const Args*)p)->ph_hi; }
__device__ __forceinline__ void grid_barrier(LAS unsigned char* lds) {
    XcdBarrier b; b.bar = (unsigned*)(kparams().ws + WS_CTL) + CW_BAR; b.x = xb_xcc_id(); b.st = (volatile LAS unsigned*)(lds + LDS_BARW);
    tp_begin(lds, 900); xcd_barrier(b); tp_end(lds, 900);
}
template <int LAYER>
__device__ __forceinline__ void layer_phases(LAS unsigned char* lds) {
#define IN(k) (kphase_lo() <= (k) && (k) < kphase_hi())
#define SEAM(k) do { if (IN(k) && IN((k) + 1)) grid_barrier(lds); } while (0)
    constexpr int PB = 1 + 8 * LAYER;
    const int bid = blockIdx.x, nb = gridDim.x;
    if (IN(PB + 0)) {
        const Params& P = kparams();
        pg8::EpiStore E{(bf16_t*)(P.ws + WS_BIG), NP};
        constexpr unsigned M8 = LAYER ? INPROJ_FP8MASK1 : INPROJ_FP8MASK0, M16 = ALLTILES & ~M8;
        for (int rep = 0; rep < REP_GIN; ++rep) {
            if constexpr (M16 != 0u) {
                pg8::SchedCols S; S.A = (const char*)(P.out + OUT_H); S.B = (const char*)(P.ws + (LAYER ? WS_WIN1 : WS_WIN0)); S.lda = D; S.ldb = D; S.nM = T / 256; S.nN = __builtin_popcount(M16); S.G = nb; S.c = bid; S.mask = M16;
                pg8::gemm_phase(lds, S, E, D, D, D);
            }
            if constexpr (M8 != 0u) {
                pg8::SchedCols S; S.A = (const char*)(P.ws + WS_H8); S.B = (const char*)(P.ws + (LAYER ? WS_WIN8_1 : WS_WIN8_0)); S.lda = D / 2; S.ldb = D / 2; S.nM = T / 256; S.nN = __builtin_popcount(M8); S.G = nb; S.c = bid; S.mask = M8;
                pg8::gemm_phase<pg8::EpiStore, pg8::SchedCols, true, 0x7c7c7c7c, 0x77777777>(lds, S, E, D / 2, D / 2, D / 2);
            }
        }
    }
    SEAM(PB + 0);
    if (IN(PB + 1)) {
        if constexpr (LAYER == 1) { ssd_prep(kparams(), lds, bid, nb); grid_barrier(lds); }
        const Params& P = kparams();
        for (int u = bid; u < 256; u += nb) {
            const int b = (u & 127) >> 2, h = u & 3;
            if (LAYER == 0) { if (u < 128) { for (int rep = 0; rep < MIXREP_RET; ++rep) { mixer_unit<MIX_RET>(P, b, h, lds, rep == MIXREP_RET - 1); __syncthreads(); }
                                               convert_moe(P, lds, u, 128); }
                              else { for (int rep = 0; rep < MIXREP_ML; ++rep) { mixer_unit<MIX_ML>(P, b, h, lds, rep == MIXREP_ML - 1); __syncthreads(); } } }
            else { if (u < 128) { for (int rep = 0; rep < MIXREP_GLA; ++rep) { mixer_unit<MIX_GLA>(P, b, h, lds, rep == MIXREP_GLA - 1); __syncthreads(); } }
                   else { for (int rep = 0; rep < MIXREP_SSD; ++rep) { mixer_unit<MIX_SSD>(P, b, h, lds, rep == MIXREP_SSD - 1); __syncthreads(); } } }
        }
    }
    SEAM(PB + 1);
    if (IN(PB + 2)) {
        const Params& P = kparams();
        pg8::SchedPlain S; S.A = (const char*)(P.ws + WS_BIG) + YOFF * 2; S.B = (const char*)(P.ws + (LAYER ? WS_WOUT1 : WS_WOUT0)); S.lda = NP; S.ldb = 2048; S.nM = T / 256; S.nN = 4; S.G = nb; S.c = bid;
        pg8::EpiResid E{(bf16_t*)(P.out + OUT_PRE1), (const bf16_t*)(P.out + OUT_H)};
        for (int rep = 0; rep < REP_GOUT; ++rep) pg8::gemm_phase(lds, S, E, 2048, NP, 2048);
    }
    SEAM(PB + 2);
    if (IN(PB + 3)) for (int rep = 0; rep < REP_ROUTE; ++rep) { phase_route(kparams(), LAYER, lds, bid, nb, 32 * (REP_ROUTE - 1 - rep)); __syncthreads(); }
    SEAM(PB + 3);
    if (IN(PB + 4)) for (int rep = 0; rep < REP_PERM; ++rep) phase_permute(kparams(), LAYER, lds, bid, nb);
    SEAM(PB + 4);
    if (IN(PB + 5)) {
        const Params& P = kparams();
        const int* tilecls = (const int*)(P.ws + WS_TILECLS);
        if constexpr (MOE_FP8(LAYER) && MOEA_FP8) {
            pg8::SchedMoeA<true> S; S.A = (const char*)(P.ws + WS_BIG + BIG_HS8); S.Wgu = (const char*)(P.ws + WS_WGU) + (size_t)LAYER * 16 * 2097152; S.tilecls = tilecls; S.nM = __builtin_amdgcn_readfirstlane(tilecls[0]); S.G = nb; S.c = bid;
            pg8::EpiSwiglu8 E{P.ws + WS_BIG + BIG_H, (const float*)(P.ws + WS_ROWGATE)};
            for (int rep = 0; rep < REP_MOEA; ++rep) pg8::gemm_phase<pg8::EpiSwiglu8, pg8::SchedMoeA<true>, true, 0x7c7c7c7c, 0x77777777>(lds, S, E, D / 2, D / 2, D / 2);
        } else if constexpr (MOE_FP8(LAYER)) {
            pg8::SchedMoeA<false> S; S.A = (const char*)(P.ws + WS_BIG + BIG_HS); S.Wgu = (const char*)(P.ws + WS_WGU) + (size_t)LAYER * 16 * 2097152; S.tilecls = tilecls; S.nM = __builtin_amdgcn_readfirstlane(tilecls[0]); S.G = nb; S.c = bid;
            pg8::EpiSwiglu8 E{P.ws + WS_BIG + BIG_H, (const float*)(P.ws + WS_ROWGATE)};
            for (int rep = 0; rep < REP_MOEA; ++rep) pg8::gemm_phase(lds, S, E, D, D, D);
        } else {
            pg8::SchedMoeA<false> S; S.A = (const char*)(P.ws + WS_BIG + BIG_HS); S.Wgu = (const char*)(P.ws + WS_WGU) + (size_t)LAYER * 16 * 2097152; S.tilecls = tilecls; S.nM = __builtin_amdgcn_readfirstlane(tilecls[0]); S.G = nb; S.c = bid;
            pg8::EpiSwiglu E{(bf16_t*)(P.ws + WS_BIG + BIG_H), (const float*)(P.ws + WS_ROWGATE)};
            for (int rep = 0; rep < REP_MOEA; ++rep) pg8::gemm_phase(lds, S, E, D, D, D);
        }
    }
    SEAM(PB + 5);
    if (IN(PB + 6)) {
        const Params& P = kparams();
        const int* tilecls = (const int*)(P.ws + WS_TILECLS);
        pg8::EpiResid E{(bf16_t*)(P.ws + WS_BIG + BIG_PRE2), (const bf16_t*)(P.ws + WS_BIG + BIG_HS)};
        if constexpr (MOE_FP8(LAYER)) {
            pg8::SchedMoeB<true> S; S.A = (const char*)(P.ws + WS_BIG + BIG_H); S.Wd = (const char*)(P.ws + WS_WD) + (size_t)LAYER * 16 * 1048576; S.tilecls = tilecls; S.nM = __builtin_amdgcn_readfirstlane(tilecls[0]); S.G = nb; S.c = bid;
            for (int rep = 0; rep < REP_MOEB; ++rep) pg8::gemm_phase<pg8::EpiResid, pg8::SchedMoeB<true>, true, 0x7c7c7c7c, 0x77777777>(lds, S, E, D / 2, D / 2, 256);
        } else {
            pg8::SchedMoeB<false> S; S.A = (const char*)(P.ws + WS_BIG + BIG_H); S.Wd = (const char*)(P.ws + WS_WD) + (size_t)LAYER * 16 * 1048576; S.tilecls = tilecls; S.nM = __builtin_amdgcn_readfirstlane(tilecls[0]); S.G = nb; S.c = bid;
            for (int rep = 0; rep < REP_MOEB; ++rep) pg8::gemm_phase(lds, S, E, D, D, 512);
        }
    }
    SEAM(PB + 6);
    if (IN(PB + 7)) for (int rep = 0; rep < REP_LNF; ++rep) phase_lnffn(kparams(), LAYER, bid, nb);
    if (LAYER == 0) SEAM(PB + 7);
#undef IN
#undef SEAM
}

__global__ void __launch_bounds__(NTHREADS, 2) mega_fwd(Args a) {
    LAS unsigned char* lds = (LAS unsigned char*)g_lds;
    if (threadIdx.x < 4) ((LAS unsigned*)(lds + LDS_BARW))[threadIdx.x] = 0u;
    if (TPROBE_ID != 0 && threadIdx.x < 4) ((LAS unsigned*)(lds + LDS_TPROBE))[threadIdx.x] = 0u;
    if ((threadIdx.x & 63) == 0) *(LAS int*)(lds + LDS_WIDTAB + 4 * hw_wave_key()) = (int)(threadIdx.x >> 6);
    __syncthreads();
    if (a.ph_hi - a.ph_lo > 1) (void)xcd_barrier_post((unsigned*)(kparams().ws + WS_CTL) + CW_BAR, (volatile LAS unsigned*)(lds + LDS_BARW));
    if (kphase_lo() <= 0 && 0 < kphase_hi()) { for (int rep = 0; rep < REP_CONV; ++rep) phase_convert(kparams(), lds, blockIdx.x, gridDim.x); if (1 < kphase_hi()) grid_barrier(lds); }
    layer_phases<0>(lds);
    layer_phases<1>(lds);
    if (TPROBE_ID != 0 && blockIdx.x == TPROBE_BLOCK && opaque_tid() == 0) {
        const unsigned long long need = ((LAS unsigned long long*)(lds + LDS_TPROBE))[0] * TPROBE_MULT, t0 = wall_clock64();
        while (wall_clock64() - t0 < need) __builtin_amdgcn_s_sleep(8);
    }
}

extern "C" void kernel_launch(void* const* d_in, const int* in_sizes, int n_in, void* d_out, int out_size, void* d_ws, size_t ws_size, hipStream_t stream) {
    static int grid = 0;
    if (!grid) {
        if (n_in != 30 || ws_size < WS_END || out_size != T * D) { fprintf(stderr, "kernel_launch: unexpected shapes n_in %d ws %zu out %d\n", n_in, ws_size, out_size); grid = -1; return; }
        int dev = 0, cus = 0, per_cu = 0;
        if (hipGetDevice(&dev) != hipSuccess || hipDeviceGetAttribute(&cus, hipDeviceAttributeMultiprocessorCount, dev) != hipSuccess) { grid = -1; return; }
        if (hipFuncSetAttribute((const void*)mega_fwd, hipFuncAttributeMaxDynamicSharedMemorySize, LDS_BYTES) != hipSuccess) { fprintf(stderr, "kernel_launch: hipFuncSetAttribute failed\n"); grid = -1; return; }
        if (hipOccupancyMaxActiveBlocksPerMultiprocessor(&per_cu, (const void*)mega_fwd, NTHREADS, LDS_BYTES) != hipSuccess || per_cu < 1)
            fprintf(stderr, "kernel_launch: note: occupancy query reports %d workgroups per CU\n", per_cu);
        grid = cus > 0 ? cus : 256;
    }
    if (grid < 0) return;
    Args a{};
    for (int i = 0; i < 30; ++i) a.P.in[i] = (const float*)d_in[i];
    a.P.out = (unsigned char*)d_out; a.P.ws = (unsigned char*)d_ws;
    (void)hipMemsetAsync((char*)d_ws + WS_CTL, 0, CTL_BYTES, stream);
    constexpr int NL = MK_N_LAUNCHES;
    if (NL == 1) { a.ph_lo = 0; a.ph_hi = NPHASES; hipLaunchKernelGGL(mega_fwd, dim3(grid), dim3(NTHREADS), LDS_BYTES, stream, a); }
    else for (int p = 0; p < NPHASES; ++p) { a.ph_lo = p; a.ph_hi = p + 1; hipLaunchKernelGGL(mega_fwd, dim3(grid), dim3(NTHREADS), LDS_BYTES, stream, a); }
}
```
